# Optimizing an MI355X kernel written in HIP

```python
import math
import jax
import jax.numpy as jnp
from jax import lax
import numpy as np

D_MODEL = 1024
BATCH = 1
SEQ = 16384
DEPTH = 2

GRID_W = 64
CTX_LEN = 256
D_HEAD = 64
ROPE_THETA = 10000.0
EPS = 1e-6
QBLOCK = 128
NEG_INF = -1e30

NA_HEADS = 4
NA_KH = 8
NA_KW = 16
DIFF_HEADS = 4
DIFF_QK_DIM = 32
SWA_HEADS = 4
SWA_KV_HEADS = 2
SWA_WINDOW = 128
GQA_HEADS = 4
GQA_KV_HEADS = 2

N_BRANCH = 4
BRANCH_W = 4 * D_HEAD

IN_WIDTHS = (NA_HEADS * D_HEAD, NA_HEADS * D_HEAD, NA_HEADS * D_HEAD,
             DIFF_HEADS * 2 * DIFF_QK_DIM, DIFF_HEADS * 2 * DIFF_QK_DIM, DIFF_HEADS * D_HEAD,
             SWA_HEADS * D_HEAD, SWA_KV_HEADS * D_HEAD, SWA_KV_HEADS * D_HEAD,
             GQA_HEADS * D_HEAD, GQA_KV_HEADS * D_HEAD, GQA_KV_HEADS * D_HEAD)
IN_WIDTH = sum(IN_WIDTHS)

PEER_HEADS = 8
N_KEYS = 128
N_EXPERTS = N_KEYS * N_KEYS
PEER_KEY_DIM = 128
PEER_TOPK = 16
PEER_BLOCK = 128

kernel_name = 'hybrid_diffusion_trunk'


def rmsnorm(x, w):
    xf = x.astype(jnp.float32)
    y = xf * lax.rsqrt(jnp.mean(xf * xf, axis=-1, keepdims=True) + EPS)
    return (y * w.astype(jnp.float32)).astype(x.dtype)


def modulate(h, shift, scale):
    return h * (1 + scale) + shift


def axial_rope_tables(n_tokens, dim):
    t = jnp.arange(n_tokens, dtype=jnp.int32)
    row = (t // GRID_W).astype(jnp.float32)
    col = (t % GRID_W).astype(jnp.float32)
    n_freq = dim // 4
    inv_freq = ROPE_THETA ** (-jnp.arange(n_freq, dtype=jnp.float32) / n_freq)
    ang_r = row[:, None] * inv_freq[None, :]
    ang_c = col[:, None] * inv_freq[None, :]
    ang = jnp.concatenate([ang_r, ang_r, ang_c, ang_c], axis=-1)
    return jnp.cos(ang), jnp.sin(ang)


def apply_axial_rope(x, cos, sin):
    shape = (1, cos.shape[0]) + (1,) * (x.ndim - 3) + (cos.shape[1],)
    cos = cos.reshape(shape).astype(x.dtype)
    sin = sin.reshape(shape).astype(x.dtype)
    x1, x2, x3, x4 = jnp.split(x, 4, axis=-1)
    rot = jnp.concatenate([-x2, x1, -x4, x3], axis=-1)
    return x * cos + rot * sin


def attend(q, k, v, sink=None):
    B, Lq, Hq, Dh = q.shape
    Hkv = k.shape[2]
    G = Hq // Hkv
    qg = q.reshape(B, Lq, Hkv, G, Dh)
    s = jnp.einsum('bqhgd,bkhd->bhgqk', qg, k).astype(jnp.float32) * (Dh ** -0.5)
    if sink is not None:
        sk = jnp.broadcast_to(sink.astype(jnp.float32).reshape(1, Hkv, G, 1, 1), s.shape[:-1] + (1,))
        s = jnp.concatenate([s, sk], axis=-1)
    p = jax.nn.softmax(s, axis=-1)
    if sink is not None:
        p = p[..., :-1]
    o = jnp.einsum('bhgqk,bkhd->bqhgd', p.astype(v.dtype), v)
    return o.reshape(B, Lq, Hq * Dh)


def diff_attend(q, k, v, lam):
    s = jnp.einsum('bqhmd,bkhmd->bhmqk', q, k).astype(jnp.float32) * (q.shape[-1] ** -0.5)
    p = jax.nn.softmax(s, axis=-1)
    a = p[:, :, 0] - lam * p[:, :, 1]
    return jnp.einsum('bhqk,bkhd->bqhd', a.astype(v.dtype), v)


def blocked_queries(fn, q):
    B, S = q.shape[:2]
    nb = S // QBLOCK
    qb = jnp.moveaxis(q.reshape((B, nb, QBLOCK) + q.shape[2:]), 1, 0)
    out = jnp.moveaxis(lax.map(fn, qb), 0, 1)
    return out.reshape((B, S) + out.shape[3:])


def neighbourhood_attention(q, k, v, kc, vc, rpb):
    B, S, H, Dh = q.shape
    rows = S // GRID_W
    kh = min(NA_KH, rows)
    r = jnp.arange(rows)
    row_start = jnp.clip(r - kh // 2, 0, rows - kh)
    band_rows = row_start[:, None] + jnp.arange(kh)[None, :]
    qg = q.reshape(B, rows, GRID_W, H, Dh)
    kg = k.reshape(B, rows, GRID_W, H, Dh)[:, band_rows]
    vg = v.reshape(B, rows, GRID_W, H, Dh)[:, band_rows]
    scale = Dh ** -0.5
    s_loc = jnp.einsum('brqhd,brjchd->bhrqjc', qg, kg).astype(jnp.float32) * scale
    qcol = jnp.arange(GRID_W)
    col_start = jnp.clip(qcol - NA_KW // 2, 0, GRID_W - NA_KW)
    col_ok = (qcol[None, :] >= col_start[:, None]) & (qcol[None, :] < col_start[:, None] + NA_KW)
    roff = band_rows - r[:, None] + (NA_KH - 1)
    coff = jnp.clip(qcol[None, :] - qcol[:, None], -(NA_KW - 1), NA_KW - 1) + (NA_KW - 1)
    bias = rpb[:, roff[:, None, :, None], coff[None, :, None, :]]
    s_loc = jnp.where(col_ok[None, None, None, :, None, :], s_loc + bias[None].astype(jnp.float32), NEG_INF)
    s_loc = s_loc.reshape(B, H, rows, GRID_W, kh * GRID_W)
    s_ctx = jnp.einsum('brqhd,bkhd->bhrqk', qg, kc).astype(jnp.float32) * scale
    p = jax.nn.softmax(jnp.concatenate([s_loc, s_ctx], axis=-1), axis=-1).astype(v.dtype)
    n_loc = kh * GRID_W
    vg = vg.reshape(B, rows, n_loc, H, Dh)
    o = (jnp.einsum('bhrqk,brkhd->brqhd', p[..., :n_loc], vg)
         + jnp.einsum('bhrqk,bkhd->brqhd', p[..., n_loc:], vc))
    return o.reshape(B, S, H * Dh)


def swa_attention(q, k, v, kc, vc, sink):
    B, S, Hq, Dh = q.shape
    Hkv = k.shape[2]
    G = Hq // Hkv
    nb = S // QBLOCK
    span = QBLOCK + 2 * SWA_WINDOW
    pad = ((0, 0), (SWA_WINDOW, SWA_WINDOW), (0, 0), (0, 0))
    kp = jnp.pad(k, pad)
    vp = jnp.pad(v, pad)
    idx = jnp.arange(nb)[:, None] * QBLOCK + jnp.arange(span)[None, :]
    kb = kp[:, idx]
    vb = vp[:, idx]
    qb = q.reshape(B, nb, QBLOCK, Hkv, G, Dh)
    scale = Dh ** -0.5
    s_loc = jnp.einsum('bnqhgd,bnkhd->bhgnqk', qb, kb).astype(jnp.float32) * scale
    qpos = jnp.arange(nb)[:, None] * QBLOCK + jnp.arange(QBLOCK)[None, :]
    kpos = idx - SWA_WINDOW
    ok = ((kpos[:, None, :] >= 0) & (kpos[:, None, :] < S)
          & (jnp.abs(qpos[:, :, None] - kpos[:, None, :]) <= SWA_WINDOW))
    s_loc = jnp.where(ok[None, None, None], s_loc, NEG_INF)
    s_ctx = jnp.einsum('bnqhgd,bkhd->bhgnqk', qb, kc).astype(jnp.float32) * scale
    s_sink = jnp.broadcast_to(sink.astype(jnp.float32).reshape(1, Hkv, G, 1, 1, 1), s_loc.shape[:-1] + (1,))
    p = jax.nn.softmax(jnp.concatenate([s_loc, s_ctx, s_sink], axis=-1), axis=-1).astype(v.dtype)
    C = kc.shape[1]
    o = (jnp.einsum('bhgnqk,bnkhd->bnqhgd', p[..., :span], vb)
         + jnp.einsum('bhgnqk,bkhd->bnqhgd', p[..., span:span + C], vc))
    return o.reshape(B, S, Hq * Dh)


def project_heads(h, w_in):
    B, L, _ = h.shape
    offsets = [int(o) for o in np.cumsum(IN_WIDTHS)[:-1]]
    (na_q, na_k, na_v, df_q, df_k, df_v, sw_q, sw_k, sw_v,
     gq_q, gq_k, gq_v) = jnp.split(h @ w_in, offsets, axis=-1)
    hd = lambda t, n: t.reshape(B, L, n, D_HEAD)
    dq = lambda t: t.reshape(B, L, DIFF_HEADS, 2, DIFF_QK_DIM)
    return (hd(na_q, NA_HEADS), hd(na_k, NA_HEADS), hd(na_v, NA_HEADS),
            dq(df_q), dq(df_k), hd(df_v, DIFF_HEADS),
            hd(sw_q, SWA_HEADS), hd(sw_k, SWA_KV_HEADS), hd(sw_v, SWA_KV_HEADS),
            hd(gq_q, GQA_HEADS), hd(gq_k, GQA_KV_HEADS), hd(gq_v, GQA_KV_HEADS))


def diff_subln(o, w, lam_init):
    B, L, H, Dh = o.shape
    return (rmsnorm(o, w) * (1.0 - lam_init)).reshape(B, L, H * Dh)


def token_mixers(h, hc, w_in, rpb, lam_p, subln_w, sink, qk_norm_w, lam_init, cos, sin, cos_d, sin_d, need_ctx):
    (na_q, na_k, na_v, df_q, df_k, df_v, sw_q, sw_k, sw_v, gq_q, gq_k, gq_v) = project_heads(h, w_in)
    (na_qc, na_kc, na_vc, df_qc, df_kc, df_vc, sw_qc, sw_kc, sw_vc, gq_qc, gq_kc, gq_vc) = project_heads(hc, w_in)
    lf = lam_p.astype(jnp.float32)
    lam = jnp.exp(jnp.sum(lf[0] * lf[1])) - jnp.exp(jnp.sum(lf[2] * lf[3])) + lam_init

    y_na = neighbourhood_attention(na_q, na_k, na_v, na_kc, na_vc, rpb)

    dk_all = jnp.concatenate([apply_axial_rope(df_k, cos_d, sin_d), df_kc], axis=1)
    dv_all = jnp.concatenate([df_v, df_vc], axis=1)
    y_df = blocked_queries(lambda qb: diff_attend(qb, dk_all, dv_all, lam), apply_axial_rope(df_q, cos_d, sin_d))
    y_df = diff_subln(y_df, subln_w, lam_init)

    y_sw = swa_attention(apply_axial_rope(sw_q, cos, sin), apply_axial_rope(sw_k, cos, sin), sw_v, sw_kc, sw_vc, sink)

    gq_q = apply_axial_rope(rmsnorm(gq_q, qk_norm_w[0]), cos, sin)
    gk_c = rmsnorm(gq_kc, qk_norm_w[1])
    gk_all = jnp.concatenate([apply_axial_rope(rmsnorm(gq_k, qk_norm_w[1]), cos, sin), gk_c], axis=1)
    gv_all = jnp.concatenate([gq_v, gq_vc], axis=1)
    y_gq = blocked_queries(lambda qb: attend(qb, gk_all, gv_all), gq_q)

    ys = jnp.stack([y_na, y_df, y_sw, y_gq], axis=2)
    if not need_ctx:
        return ys, None
    yc_na = attend(na_qc, na_kc, na_vc)
    yc_df = diff_subln(diff_attend(df_qc, df_kc, df_vc, lam), subln_w, lam_init)
    yc_sw = attend(sw_qc, sw_kc, sw_vc, sink)
    yc_gq = attend(rmsnorm(gq_qc, qk_norm_w[0]), gk_c, gq_vc)
    ysc = jnp.stack([yc_na, yc_df, yc_sw, yc_gq], axis=2)
    return ys, ysc


def merge_branches(h, ys, w_branch, w_gate, b_gate, w_out):
    B, L, D = h.shape
    gates = jax.nn.sigmoid(h @ w_gate + b_gate).reshape(B, L, N_BRANCH, D)
    br = jnp.einsum('blnw,nwd->blnd', ys, w_branch)
    return jnp.sum(gates * br, axis=2) @ w_out


def peer_ffn(h, wq, keys, u, v):
    B, L, D = h.shape
    T = B * L
    hf = h.reshape(T, D)
    q = (hf @ wq).reshape(T, PEER_HEADS, 2, PEER_KEY_DIM)
    s = jnp.einsum('thpd,phnd->thpn', q, keys).astype(jnp.float32)
    top_s, top_i = lax.top_k(s, PEER_TOPK)
    cand_s = (top_s[:, :, 0, :, None] + top_s[:, :, 1, None, :]).reshape(T, PEER_HEADS, PEER_TOPK * PEER_TOPK)
    cand_i = (top_i[:, :, 0, :, None] * N_KEYS + top_i[:, :, 1, None, :]).reshape(T, PEER_HEADS, PEER_TOPK * PEER_TOPK)
    best_s, pos = lax.top_k(cand_s, PEER_TOPK)
    expert = jnp.take_along_axis(cand_i, pos, axis=-1)
    g = jax.nn.softmax(best_s, axis=-1).astype(h.dtype)
    nb = T // PEER_BLOCK

    def one_block(args):
        xb, eb, gb = args
        a = jax.nn.gelu(jnp.einsum('td,thkd->thk', xb, u[eb]))
        return jnp.einsum('thk,thkd->td', gb * a, v[eb])

    out = lax.map(one_block, (hf.reshape(nb, PEER_BLOCK, D),
                              expert.reshape(nb, PEER_BLOCK, PEER_HEADS, PEER_TOPK),
                              g.reshape(nb, PEER_BLOCK, PEER_HEADS, PEER_TOPK)))
    return out.reshape(B, L, D)


def setup_inputs(seed: int = 0) -> dict:
    key = jax.random.key(seed)
    ks = jax.random.split(key, 24)
    nrm = lambda k, shape, s: jax.random.normal(k, shape, jnp.float32) * s
    L = DEPTH
    D = D_MODEL
    return {
        'x': nrm(ks[0], (BATCH, SEQ, D), 1.0),
        'c': nrm(ks[1], (BATCH, D), 1.0),
        'ctx': nrm(ks[2], (BATCH, CTX_LEN, D), 1.0),
        'c_ctx': nrm(ks[3], (D,), 1.0),
        'norm1_w': 1.0 + nrm(ks[4], (L, D), 0.02),
        'norm2_w': 1.0 + nrm(ks[5], (L, D), 0.02),
        'ada_w': nrm(ks[6], (L, D, 6 * D), 0.5 * D ** -0.5),
        'ada_b': nrm(ks[7], (L, 6 * D), 0.01),
        'w_in': nrm(ks[8], (L, D, IN_WIDTH), D ** -0.5),
        'na_rpb': nrm(ks[9], (L, NA_HEADS, 2 * NA_KH - 1, 2 * NA_KW - 1), 0.02),
        'diff_lam': nrm(ks[10], (L, 4, DIFF_QK_DIM), 0.1),
        'diff_subln_w': 1.0 + nrm(ks[11], (L, D_HEAD), 0.02),
        'swa_sink': nrm(ks[12], (L, SWA_HEADS), 0.5),
        'gqa_qk_norm_w': 1.0 + nrm(ks[13], (L, 2, D_HEAD), 0.02),
        'w_branch': nrm(ks[14], (L, N_BRANCH, BRANCH_W, D), BRANCH_W ** -0.5),
        'w_gate': nrm(ks[15], (L, D, N_BRANCH * D), D ** -0.5),
        'b_gate': nrm(ks[16], (L, N_BRANCH * D), 0.01),
        'w_out': nrm(ks[17], (L, D, D), D ** -0.5),
        'peer_wq': nrm(ks[18], (L, D, PEER_HEADS * 2 * PEER_KEY_DIM), D ** -0.5),
        'peer_keys': nrm(ks[19], (L, 2, PEER_HEADS, N_KEYS, PEER_KEY_DIM), PEER_KEY_DIM ** -0.5),
        'peer_u': nrm(ks[20], (L, N_EXPERTS, D), D ** -0.5),
        'peer_v': nrm(ks[21], (L, N_EXPERTS, D), PEER_HEADS ** -0.5),
        'final_norm_w': 1.0 + nrm(ks[22], (D,), 0.02),
    }


def reference(x, c, ctx, c_ctx, norm1_w, norm2_w, ada_w, ada_b, w_in, na_rpb, diff_lam, diff_subln_w,
              swa_sink, gqa_qk_norm_w, w_branch, w_gate, b_gate, w_out, peer_wq, peer_keys, peer_u, peer_v,
              final_norm_w):
    S = x.shape[1]
    cos, sin = axial_rope_tables(S, D_HEAD)
    cos_d, sin_d = axial_rope_tables(S, DIFF_QK_DIM)
    xc = ctx
    for l in range(DEPTH):
        need_ctx = l < DEPTH - 1
        lam_init = 0.8 - 0.6 * math.exp(-0.3 * l)
        mod = jax.nn.silu(c) @ ada_w[l] + ada_b[l]
        sh1, sc1, g1, sh2, sc2, g2 = [m[:, None, :] for m in jnp.split(mod, 6, axis=-1)]
        modc = jax.nn.silu(c_ctx) @ ada_w[l] + ada_b[l]
        sh1c, sc1c, g1c, sh2c, sc2c, g2c = jnp.split(modc, 6, axis=-1)

        h = modulate(rmsnorm(x, norm1_w[l]), sh1, sc1)
        hc = modulate(rmsnorm(xc, norm1_w[l]), sh1c, sc1c)
        ys, ysc = token_mixers(h, hc, w_in[l], na_rpb[l], diff_lam[l], diff_subln_w[l], swa_sink[l],
                               gqa_qk_norm_w[l], lam_init, cos, sin, cos_d, sin_d, need_ctx)
        x = x + g1 * merge_branches(h, ys, w_branch[l], w_gate[l], b_gate[l], w_out[l])
        if need_ctx:
            xc = xc + g1c * merge_branches(hc, ysc, w_branch[l], w_gate[l], b_gate[l], w_out[l])

        h2 = modulate(rmsnorm(x, norm2_w[l]), sh2, sc2)
        x = x + g2 * peer_ffn(h2, peer_wq[l], peer_keys[l], peer_u[l], peer_v[l])
        if need_ctx:
            h2c = modulate(rmsnorm(xc, norm2_w[l]), sh2c, sc2c)
            xc = xc + g2c * peer_ffn(h2c, peer_wq[l], peer_keys[l], peer_u[l], peer_v[l])
    return rmsnorm(x, final_norm_w)
```

```cpp
#define SELFCHECK 0
#include <hip/hip_runtime.h>
#include <hip/hip_cooperative_groups.h>
#include <hip/hip_bf16.h>
#include <cstdio>
#include <cstdint>
#include <cmath>
namespace cg = cooperative_groups;

#ifndef SELFCHECK
#define SELFCHECK 0
#endif

constexpr int SEQ = 16384, CTX = 256, MT = SEQ + CTX, DM = 1024, NQKV = 2560, GRIDW = 64;
constexpr int NEXP = 16384, NKEYS = 128, PEER_H = 8, TOPK = 16;
constexpr float EPS = 1e-6f, LOG2E = 1.4426950408889634f;
constexpr float C2_64 = 0.125f * LOG2E;
constexpr float C2_32 = 0.17677669529663687f * LOG2E;
constexpr int NWAVES = 8, NTHREADS = 512;

constexpr size_t MiB = 1u << 20;
constexpr size_t WS_CTL = 0, CTL_ZERO_BYTES = 1 * MiB;
constexpr size_t WS_CONST = 1 * MiB;
constexpr size_t WS_WIN = 2 * MiB;
constexpr size_t WS_WGATE = 12 * MiB;
constexpr size_t WS_WBR = 28 * MiB;
constexpr size_t WS_WOUT = 32 * MiB;
constexpr size_t WS_WSC = 36 * MiB;
constexpr size_t WS_UBF = 44 * MiB;
constexpr size_t WS_VBF = 108 * MiB;
constexpr size_t WS_X = 172 * MiB;
constexpr size_t WS_H = 237 * MiB;
constexpr size_t WS_YS = 270 * MiB;
constexpr size_t WS_R1 = 303 * MiB;
constexpr size_t WS_Q = WS_R1, WS_K = WS_Q + (size_t)20 * MT * 128, WS_V = WS_K + (size_t)12 * MT * 128;
constexpr size_t WS_END = 433 * MiB;
constexpr size_t WS_DBG = 433 * MiB;
static_assert(WS_V + (size_t)12 * MT * 128 <= WS_END && WS_R1 + (size_t)MT * 4096 * 2 <= WS_END && WS_R1 + (size_t)MT * 2048 * 4 <= WS_END, "ws map");
constexpr int CW_BAR = 4096;
constexpr int CW_CHK = 64;

constexpr int RING_BYTES = 131072;
constexpr int LDSCTL_OFF = RING_BYTES, MISC_OFF = LDSCTL_OFF + 320;
constexpr int LDS_BYTES = 147456;

#define GAS __attribute__((address_space(1)))
#define LAS __attribute__((address_space(3)))
typedef unsigned short bf16_t;
typedef unsigned v4u __attribute__((ext_vector_type(4)));
typedef unsigned v2u __attribute__((ext_vector_type(2)));
typedef float f32x4 __attribute__((ext_vector_type(4)));
typedef float f32x2 __attribute__((ext_vector_type(2)));
typedef float f32x16 __attribute__((ext_vector_type(16)));
typedef short bf16x8 __attribute__((ext_vector_type(8)));
typedef short s16x4 __attribute__((ext_vector_type(4)));
typedef __bf16 bf16x2_t __attribute__((ext_vector_type(2)));
typedef GAS unsigned gu32;
#define RLX_AGENT __ATOMIC_RELAXED, __HIP_MEMORY_SCOPE_AGENT
#define LDS_WAIT() asm volatile("s_waitcnt lgkmcnt(0)" ::: "memory")
#define VM_WAIT() asm volatile("s_waitcnt vmcnt(0)" ::: "memory")

__device__ __forceinline__ unsigned f2bf(float f) { unsigned u = __builtin_bit_cast(unsigned, f); return (u + 0x7fffu + ((u >> 16) & 1u)) >> 16; }
__device__ __forceinline__ unsigned pk2(float lo, float hi) { f32x2 v = {lo, hi}; bf16x2_t b = __builtin_convertvector(v, bf16x2_t); return __builtin_bit_cast(unsigned, b); }
__device__ __forceinline__ float bflo(unsigned w) { return __builtin_bit_cast(float, w << 16); }
__device__ __forceinline__ float bfhi(unsigned w) { return __builtin_bit_cast(float, w & 0xffff0000u); }
__device__ __forceinline__ float bf2f(bf16_t h) { return __builtin_bit_cast(float, (unsigned)h << 16); }
__device__ __forceinline__ float wave_sum(float v) {
#pragma unroll
    for (int o = 1; o < 64; o <<= 1) v += __shfl_xor(v, o);
    return v;
}
__device__ __forceinline__ float fast_exp2(float x) { return __builtin_amdgcn_exp2f(x); }
__device__ __forceinline__ float fast_rcp(float x) { return __builtin_amdgcn_rcpf(x); }
__device__ __forceinline__ float sigmoidf_(float x) { return fast_rcp(1.0f + fast_exp2(-x * LOG2E)); }
__device__ __forceinline__ float gelu_tanh(float x) {
    const float y = 0.7978845608028654f * (x + 0.044715f * x * x * x);
    const float t = 1.0f - 2.0f * fast_rcp(1.0f + fast_exp2(2.0f * LOG2E * y));
    return 0.5f * x * (1.0f + t);
}
#define XB_TMO      128
#define XB_XCNT(j)  (256  + 64 * (j))
#define XB_XSUB(j)  (1280 + 64 * (j))
#define XB_XGEN(j)  (2304 + 64 * (j))
#define XB_TOP      3328
#define XB_TOPGEN   3392
#define XCD_BAR_WORDS 3456
#define XB_SPIN_CAP (1u << 20)
__device__ __forceinline__ unsigned xb_ld(unsigned* p)              { return __hip_atomic_load(p, __ATOMIC_RELAXED, __HIP_MEMORY_SCOPE_AGENT); }
__device__ __forceinline__ unsigned xb_add(unsigned* p, unsigned v) { return __hip_atomic_fetch_add(p, v, __ATOMIC_RELAXED, __HIP_MEMORY_SCOPE_AGENT); }
__device__ __forceinline__ unsigned xb_xcc_id() { return (unsigned)__builtin_amdgcn_s_getreg((3 << 11) | 20) & 0xFu; }
#define XB_SPIN(cond, bar) do { unsigned _sp = 0; while (cond) { __builtin_amdgcn_s_sleep(1); \
    if ((++_sp & 255u) == 0u) { if (xb_ld(&(bar)[XB_TMO])) break; if (_sp > XB_SPIN_CAP) { atomicAdd(&(bar)[XB_TMO], 1u); break; } } } } while (0)
struct XcdBarrier { unsigned* bar; unsigned x; volatile LAS unsigned* st; };
__device__ __forceinline__ XcdBarrier xcd_barrier_post(unsigned* bar, volatile LAS unsigned* st) {
    XcdBarrier b; b.bar = bar; b.x = xb_xcc_id(); b.st = st;
    if (threadIdx.x == 0) (void)xb_add(&bar[XB_XCNT(b.x)], 1u);
    return b;
}
__device__ __forceinline__ void xcd_barrier_complete(unsigned* bar, unsigned x, unsigned& nloc, unsigned& nx) {
    const unsigned G = gridDim.x * gridDim.y * gridDim.z;
    unsigned sum, cnt, mine, sp = 0u;
    for (;;) {
        sum = 0u; cnt = 0u; mine = 0u;
#pragma unroll
        for (unsigned j = 0; j < 16; ++j) { const unsigned c = xb_ld(&bar[XB_XCNT(j)]); sum += c; cnt += (c > 0u) ? 1u : 0u; mine = (j == x) ? c : mine; }
        if (sum == G) break;
        __builtin_amdgcn_s_sleep(1);
        if ((++sp & 255u) == 0u) { if (xb_ld(&bar[XB_TMO])) break; if (sp > XB_SPIN_CAP) { atomicAdd(&bar[XB_TMO], 1u); break; } }
    }
    nloc = mine > 0u ? mine : 1u; nx = cnt > 0u ? cnt : 1u;
}
__device__ __forceinline__ void xcd_barrier(const XcdBarrier& b) {
    asm volatile("s_waitcnt vmcnt(0)" ::: "memory");
    __syncthreads();
    if (threadIdx.x == 0) {
        unsigned* bar = b.bar;
        __builtin_amdgcn_s_waitcnt(0);
        unsigned nloc = b.st[0], nx = b.st[1];
        if (nloc == 0u) { xcd_barrier_complete(bar, b.x, nloc, nx); b.st[0] = nloc; b.st[1] = nx; }
        const unsigned old = xb_add(&bar[XB_XSUB(b.x)], 1u);
        const unsigned gen = old / nloc;
        if (old + 1u == (gen + 1u) * nloc) {
            __builtin_amdgcn_fence(__ATOMIC_RELEASE, "agent");
            asm volatile("s_waitcnt vmcnt(0)" ::: "memory");
            const unsigned og = xb_add(&bar[XB_TOP], 1u);
            const unsigned tg = og / nx;
            if (og + 1u == (tg + 1u) * nx) xb_add(&bar[XB_TOPGEN], 1u);
            else XB_SPIN(xb_ld(&bar[XB_TOPGEN]) == tg, bar);
            __builtin_amdgcn_fence(__ATOMIC_ACQUIRE, "agent");
            xb_add(&bar[XB_XGEN(b.x)], 1u);
            asm volatile("s_waitcnt vmcnt(0)" ::: "memory");
        } else {
            XB_SPIN(xb_ld(&bar[XB_XGEN(b.x)]) == gen, bar);
            __builtin_amdgcn_fence(__ATOMIC_ACQUIRE, "agent");
            asm volatile("s_waitcnt vmcnt(0)" ::: "memory");
        }
    }
    __syncthreads();
}

namespace pg8 {
#define PG8_LAS __attribute__((address_space(3)))
constexpr int BM = 256, BK = 64, HALF = 128, HTB = HALF * BK * 2, STAGE_BYTES = 8 * HTB, NXCD = 8, WGM = 8;
__host__ __device__ __forceinline__ int lds_byte(int r, int c) { const int st = (r >> 4) * 2 + (c >> 5), rr = r & 15, cc = c & 31, ob = rr * 64 + cc * 2; return st * 1024 + (ob ^ (((ob >> 9) & 1) << 5)); }
__host__ __device__ __forceinline__ void stage_rc(int b, int& R, int& C) { const int st = b / 1024, sb = b % 1024, swz = sb ^ (((sb >> 9) & 1) << 5); R = (st >> 1) * 16 + swz / 64; C = (st & 1) * 32 + (swz % 64) / 2; }
__host__ __device__ __forceinline__ int perm32(int rho) { const int n = rho >> 4, i = rho & 15; return 8 * (i >> 2) + 4 * n + (i & 3); }

struct Unit { int pm, pn; const char* a; const char* b; };
struct Gemm { const bf16_t* A; const bf16_t* Bt; int nM, nN, K, lda, ldb, a_shift, a_pn_bytes; };

struct StaticOrder {
    int nM, nN, nwg, G, c; const char* A; const char* B; size_t a_pm, b_pn; int a_shift, a_pn;
    __device__ void init(const Gemm& g, int G_, int c_) { nM = g.nM; nN = g.nN; nwg = nM * nN; G = G_; c = c_; A = (const char*)g.A; B = (const char*)g.Bt;
        a_pm = (size_t)BM * g.lda * 2; b_pn = (size_t)BM * g.ldb * 2; a_shift = g.a_shift; a_pn = g.a_pn_bytes; }
    __device__ bool next(int i, Unit& u) const {
        const long L = (long)i * G + c; if (L >= nwg) return false;
        int wgid = (int)L; { const int q = nwg / NXCD, r = nwg % NXCD, xcd = wgid % NXCD, off = wgid / NXCD; wgid = (xcd < r ? xcd * (q + 1) : r * (q + 1) + (xcd - r) * q) + off; }
        const int nig = WGM * nN, gid = wgid / nig, fm = gid * WGM, gsz = (nM - fm) < WGM ? (nM - fm) : WGM;
        u.pm = fm + ((wgid % nig) % gsz); u.pn = (wgid % nig) / gsz;
        u.a = A + (size_t)u.pm * a_pm + (size_t)(u.pn >> a_shift) * a_pn; u.b = B + (size_t)u.pn * b_pn; return true;
    }
};

template <class Epi>
__device__ __forceinline__ void gemm_phase(PG8_LAS unsigned char* lds, const Gemm g, const StaticOrder& S, const Epi& E) {
    int tid_ = threadIdx.x; asm volatile("" : "+v"(tid_));
    const int tid = tid_, wid = __builtin_amdgcn_readfirstlane(tid >> 6), lane = tid & 63, wr = wid >> 2, wc = wid & 3, fr = lane & 15, fq = lane >> 4;
    const int K = g.K, nt = K / BK;
    unsigned voffA[2], voffB[2];
#pragma unroll
    for (int i = 0; i < 2; ++i) { int R, C; stage_rc(tid * 16 + i * 8192, R, C); const int Rb = Epi::PERM ? ((R & ~31) + perm32(R & 31)) : R;
        voffA[i] = (unsigned)(R * g.lda + C) * 2u; voffB[i] = (unsigned)(Rb * g.ldb + C) * 2u; }
    const size_t kstep = (size_t)(BK * 2);
    const size_t hstepA = (size_t)HALF * g.lda * 2, hstepB = (size_t)HALF * g.ldb * 2;
    const unsigned ldsw = (unsigned)wid * 1024u;
    const int aoff = lds_byte(wr * 64 + fr, fq * 8), boff = lds_byte(wc * 32 + fr, fq * 8);
#define PG8_SA(b, h) (((b) * 2 + (h)) * HTB)
#define PG8_SB(b, h) ((4 + (b) * 2 + (h)) * HTB)
#define PG8_STAGE(bufoff, gbase, voff) do { _Pragma("unroll") for (int _i = 0; _i < 2; ++_i) \
        __builtin_amdgcn_global_load_lds((const unsigned*)((const char*)(gbase) + (voff)[_i]), (PG8_LAS unsigned*)(lds + (bufoff) + ldsw + _i * 8192), 16, 0, 0); } while (0)
#define PG8_LDA(dst, b, h) do { _Pragma("unroll") for (int m = 0; m < 4; ++m) _Pragma("unroll") for (int k = 0; k < 2; ++k) dst[m][k] = *(const PG8_LAS bf16x8*)(lds + PG8_SA(b, h) + aoff + m * 2048 + k * 1024); } while (0)
#define PG8_LDB(dst, b, h) do { _Pragma("unroll") for (int n = 0; n < 2; ++n) _Pragma("unroll") for (int k = 0; k < 2; ++k) dst[n][k] = *(const PG8_LAS bf16x8*)(lds + PG8_SB(b, h) + boff + n * 2048 + k * 1024); } while (0)
#define PG8_MMA(ai, bj, At, Bt) do { __builtin_amdgcn_s_setprio(1); _Pragma("unroll") for (int m = 0; m < 4; ++m) _Pragma("unroll") for (int n = 0; n < 2; ++n) _Pragma("unroll") for (int k = 0; k < 2; ++k) \
        acc[ai][bj][m][n] = __builtin_amdgcn_mfma_f32_16x16x32_bf16(Bt[n][k], At[m][k], acc[ai][bj][m][n], 0, 0, 0); __builtin_amdgcn_s_setprio(0); } while (0)
#define PG8_WAIT_V(n) asm volatile("s_waitcnt vmcnt(" #n ")" ::: "memory")
#define PG8_WAIT_L(n) asm volatile("s_waitcnt lgkmcnt(" #n ")" ::: "memory")
#define PG8_BAR __builtin_amdgcn_s_barrier()
#define PG8_SCHED __builtin_amdgcn_sched_barrier(0)
    Unit cur, nxt; int ui = 0;
    if (!S.next(0, cur)) return;
    f32x4 acc[2][2][4][2];
#pragma unroll
    for (int a = 0; a < 2; ++a)
#pragma unroll
        for (int b = 0; b < 2; ++b)
#pragma unroll
            for (int m = 0; m < 4; ++m)
#pragma unroll
                for (int n = 0; n < 2; ++n) acc[a][b][m][n] = (f32x4){0.f, 0.f, 0.f, 0.f};
    bf16x8 At[4][2], B0[2][2], B1[2][2];
    const char* cA = cur.a; const char* cB = cur.b;
    PG8_STAGE(PG8_SB(0, 0), cB, voffB); PG8_STAGE(PG8_SB(0, 1), cB + hstepB, voffB); PG8_STAGE(PG8_SA(0, 0), cA, voffA); PG8_STAGE(PG8_SA(0, 1), cA + hstepA, voffA);
    if (wr == 1) PG8_BAR;
    PG8_WAIT_V(2); PG8_BAR;
    PG8_STAGE(PG8_SB(1, 0), cB + kstep, voffB); PG8_STAGE(PG8_SA(1, 0), cA + kstep, voffA); PG8_STAGE(PG8_SB(1, 1), cB + hstepB + kstep, voffB);
    PG8_WAIT_V(6); PG8_BAR;
    for (;;) {
        const bool has_next = S.next(ui + 1, nxt);
        const char* nA = has_next ? nxt.a : cA; const char* nB = has_next ? nxt.b : cB;
        for (int t = 0; t < nt; t += 2) {
            const bool last = (t == nt - 2);
            const char* a1 = cA + (size_t)(t + 1) * kstep;
            const char* a2 = last ? nA : cA + (size_t)(t + 2) * kstep; const char* b2 = last ? nB : cB + (size_t)(t + 2) * kstep;
            const char* a3 = a2 + kstep; const char* b3 = b2 + kstep;
            PG8_LDB(B0, 0, 0); PG8_LDB(B1, 0, 1); PG8_SCHED; PG8_LDA(At, 0, 0); PG8_STAGE(PG8_SA(1, 1), a1 + hstepA, voffA);
            PG8_WAIT_V(8); PG8_WAIT_L(0); PG8_BAR; PG8_MMA(0, 0, At, B0); PG8_MMA(0, 1, At, B1); PG8_BAR; PG8_SCHED;
            PG8_LDA(At, 0, 1); PG8_STAGE(PG8_SB(0, 0), b2, voffB); PG8_STAGE(PG8_SB(0, 1), b2 + hstepB, voffB); PG8_STAGE(PG8_SA(0, 0), a2, voffA);
            PG8_WAIT_V(8); PG8_WAIT_L(0); PG8_BAR; PG8_MMA(1, 0, At, B0); PG8_MMA(1, 1, At, B1); PG8_BAR; PG8_SCHED;
            PG8_LDB(B0, 1, 0); PG8_LDB(B1, 1, 1); PG8_SCHED; PG8_LDA(At, 1, 0); PG8_STAGE(PG8_SA(0, 1), a2 + hstepA, voffA);
            PG8_WAIT_V(8); PG8_WAIT_L(0); PG8_BAR; PG8_MMA(0, 0, At, B0); PG8_MMA(0, 1, At, B1); PG8_BAR; PG8_SCHED;
            PG8_LDA(At, 1, 1); PG8_STAGE(PG8_SB(1, 0), b3, voffB); PG8_STAGE(PG8_SB(1, 1), b3 + hstepB, voffB); PG8_STAGE(PG8_SA(1, 0), a3, voffA);
            PG8_WAIT_V(8); PG8_WAIT_L(0); PG8_BAR; PG8_MMA(1, 0, At, B0); PG8_MMA(1, 1, At, B1); PG8_BAR; PG8_SCHED;
        }
        if (wr == 0) PG8_BAR;
        E(acc, cur, wr, wc, fr, fq);
        if (!has_next) break;
#pragma unroll
        for (int a = 0; a < 2; ++a)
#pragma unroll
            for (int b = 0; b < 2; ++b)
#pragma unroll
                for (int m = 0; m < 4; ++m)
#pragma unroll
                    for (int n = 0; n < 2; ++n) acc[a][b][m][n] = (f32x4){0.f, 0.f, 0.f, 0.f};
        cur = nxt; cA = nA; cB = nB; ++ui;
        if (wr == 1) PG8_BAR;
    }
    PG8_WAIT_V(0);
    PG8_BAR;
#undef PG8_SA
#undef PG8_SB
#undef PG8_STAGE
#undef PG8_LDA
#undef PG8_LDB
#undef PG8_MMA
#undef PG8_WAIT_V
#undef PG8_WAIT_L
#undef PG8_BAR
#undef PG8_SCHED
}
}
namespace pg8 {
struct EpiQKV {
    static constexpr bool PERM = true;
    bf16_t *Qb, *Kb, *Vb; const float* qkw;
    __device__ __forceinline__ void operator()(const f32x4 (&acc)[2][2][4][2], const Unit& u, int wr, int wc, int fr_in, int fq_in) const {
        int fr = fr_in, fq = fq_in; asm volatile("" : "+v"(fr), "+v"(fq));
        const int hs = __builtin_amdgcn_readfirstlane(u.pn * 4 + wc);
        bf16_t* dst; int rope = 0, norm = -1, dq = 0; float scale = 1.f;
        if (hs < 4)       { dst = Qb + (size_t)hs * MT * 64; scale = C2_64; }
        else if (hs < 8)  { dst = Kb + (size_t)(hs - 4) * MT * 64; }
        else if (hs < 12) { dst = Vb + (size_t)(hs - 8) * MT * 64; }
        else if (hs < 16) { dst = Qb + (size_t)(4 + 2 * (hs - 12)) * MT * 64; rope = 2; dq = 1; scale = C2_32; }
        else if (hs < 20) { dst = Kb + (size_t)(4 + hs - 16) * MT * 64; rope = 2; }
        else if (hs < 24) { dst = Vb + (size_t)(4 + hs - 20) * MT * 64; }
        else if (hs < 28) { dst = Qb + (size_t)(12 + hs - 24) * MT * 64; rope = 1; scale = C2_64; }
        else if (hs < 30) { dst = Kb + (size_t)(8 + hs - 28) * MT * 64; rope = 1; }
        else if (hs < 32) { dst = Vb + (size_t)(8 + hs - 30) * MT * 64; }
        else if (hs < 36) { dst = Qb + (size_t)(16 + hs - 32) * MT * 64; rope = 1; norm = 0; scale = C2_64; }
        else if (hs < 38) { dst = Kb + (size_t)(10 + hs - 36) * MT * 64; rope = 1; norm = 1; }
        else              { dst = Vb + (size_t)(10 + hs - 38) * MT * 64; }
        const bool latent = u.pm < SEQ / 256;
        if (!latent) rope = 0;
        const float fstep = (rope == 2) ? (13.287712379549449f / 8.f) : (13.287712379549449f / 16.f), fbase = (rope == 2) ? 0.f : (float)(8 * (fq & 1)) * fstep;
#define INVF(k) (fast_exp2(-(fbase + (float)(k) * fstep)) * 0.15915494309189535f)
#pragma unroll
        for (int m = 0; m < 4; ++m) {
            float csn[8], ccs[8];
            if (rope == 1) { float pos = (float)(m * 16 + fr); asm volatile("" : "+v"(pos));
#pragma unroll
                for (int k = 0; k < 8; ++k) { const float rev = pos * INVF(k); csn[k] = __builtin_amdgcn_sinf(rev); ccs[k] = __builtin_amdgcn_cosf(rev); } }
#pragma unroll
            for (int ai = 0; ai < 2; ++ai) {
                const int row = u.pm * BM + ai * HALF + wr * 64 + m * 16 + fr;
                float v[16];
#pragma unroll
                for (int bj = 0; bj < 2; ++bj)
#pragma unroll
                    for (int n = 0; n < 2; ++n)
#pragma unroll
                        for (int j = 0; j < 4; ++j) v[bj * 8 + n * 4 + j] = acc[ai][bj][m][n][j];
                if (norm >= 0) {
                    float ss = 0.f;
#pragma unroll
                    for (int k = 0; k < 16; ++k) ss += v[k] * v[k];
                    ss += __shfl_xor(ss, 16); ss += __shfl_xor(ss, 32);
                    const float ri = __builtin_amdgcn_rsqf(ss * (1.f / 64.f) + EPS);
#pragma unroll
                    for (int bj = 0; bj < 2; ++bj) { const f32x4 w0 = *(const f32x4*)(qkw + norm * 64 + 32 * bj + 8 * fq), w1 = *(const f32x4*)(qkw + norm * 64 + 32 * bj + 8 * fq + 4);
#pragma unroll
                        for (int j = 0; j < 4; ++j) { v[bj * 8 + j] = v[bj * 8 + j] * ri * w0[j]; v[bj * 8 + 4 + j] = v[bj * 8 + 4 + j] * ri * w1[j]; } }
                }
                if (rope == 1) {
                    const float sgn = (fq & 2) ? 1.f : -1.f;
                    float pos = (float)(row >> 6); asm volatile("" : "+v"(pos));
#pragma unroll
                    for (int k = 0; k < 8; ++k) {
                        const float rev = pos * INVF(k); const float sn = __builtin_amdgcn_sinf(rev), cs = __builtin_amdgcn_cosf(rev);
                        const float x = v[k], pt = __shfl_xor(x, 32);
                        v[k] = x * cs + sgn * pt * sn;
                        const float y = v[8 + k], qt = __shfl_xor(y, 32);
                        v[8 + k] = y * ccs[k] + sgn * qt * csn[k];
                    }
                } else if (rope == 2) {
                    const float sgn = (fq & 1) ? 1.f : -1.f;
                    float pos = (float)(fq < 2 ? (row >> 6) : (row & 63)); asm volatile("" : "+v"(pos));
#pragma unroll
                    for (int k = 0; k < 8; ++k) {
                        const float rev = pos * INVF(k); const float sn = __builtin_amdgcn_sinf(rev), cs = __builtin_amdgcn_cosf(rev);
#pragma unroll
                        for (int bj = 0; bj < 2; ++bj) { const float x = v[bj * 8 + k], pt = __shfl_xor(x, 16); v[bj * 8 + k] = x * cs + sgn * pt * sn; }
                    }
                }
#pragma unroll
                for (int bj = 0; bj < 2; ++bj) {
                    v4u w; w.x = pk2(v[bj * 8 + 0] * scale, v[bj * 8 + 1] * scale); w.y = pk2(v[bj * 8 + 2] * scale, v[bj * 8 + 3] * scale);
                    w.z = pk2(v[bj * 8 + 4] * scale, v[bj * 8 + 5] * scale); w.w = pk2(v[bj * 8 + 6] * scale, v[bj * 8 + 7] * scale);
                    if (dq) {
                        *(v4u*)(dst + (size_t)bj * MT * 64 + (size_t)row * 64 + 32 * bj + 8 * fq) = w;
                        *(v4u*)(dst + (size_t)(1 - bj) * MT * 64 + (size_t)row * 64 + 32 * bj + 8 * fq) = (v4u){0u, 0u, 0u, 0u};
                    } else *(v4u*)(dst + (size_t)row * 64 + 32 * bj + 8 * fq) = w;
                }
                __builtin_amdgcn_sched_barrier(0);
            }
        }
#undef INVF
    }
};
struct EpiBranch {
    static constexpr bool PERM = false;
    bf16_t* Bp;
    __device__ __forceinline__ void operator()(const f32x4 (&acc)[2][2][4][2], const Unit& u, int wr, int wc, int fr_in, int fq_in) const {
        int fr = fr_in, fq = fq_in; asm volatile("" : "+v"(fr), "+v"(fq));
        const int branch = u.pn >> 2, chb = 256 * (u.pn & 3) + 32 * wc + 4 * fq;
#pragma unroll
        for (int ai = 0; ai < 2; ++ai)
#pragma unroll
            for (int m = 0; m < 4; ++m) { bf16_t* rowp = Bp + (size_t)(u.pm * BM + ai * HALF + wr * 64 + m * 16 + fr) * 4096 + branch * 4;
#pragma unroll
                for (int bj = 0; bj < 2; ++bj)
#pragma unroll
                    for (int n = 0; n < 2; ++n) { const int ch = chb + 128 * bj + 16 * n; const f32x4 a = acc[ai][bj][m][n];
                        v2u w; w.x = pk2(a[0], a[1]); w.y = pk2(a[2], a[3]); *(v2u*)(rowp + (ch >> 2) * 16) = w; } }
    }
};
struct EpiGate {
    static constexpr bool PERM = false;
    const bf16_t* Bp; bf16_t* mix; const float* bgate;
    __device__ __forceinline__ void operator()(const f32x4 (&acc)[2][2][4][2], const Unit& u, int wr, int wc, int fr_in, int fq_in) const {
        int fr = fr_in, fq = fq_in; asm volatile("" : "+v"(fr), "+v"(fq));
        const int ch = 64 * u.pn + 16 * wc + 4 * fq;
        f32x4 bias[2][2];
#pragma unroll
        for (int bj = 0; bj < 2; ++bj)
#pragma unroll
            for (int n = 0; n < 2; ++n) bias[bj][n] = *(const f32x4*)(bgate + (2 * bj + n) * 1024 + ch);
#pragma unroll
        for (int ai = 0; ai < 2; ++ai)
#pragma unroll
            for (int m = 0; m < 4; ++m) { const size_t row = (size_t)(u.pm * BM + ai * HALF + wr * 64 + m * 16 + fr);
                const v4u b01 = *(const v4u*)(Bp + row * 4096 + (ch >> 2) * 16), b23 = *(const v4u*)(Bp + row * 4096 + (ch >> 2) * 16 + 8);
                f32x4 s = {0.f, 0.f, 0.f, 0.f};
#pragma unroll
                for (int bj = 0; bj < 2; ++bj)
#pragma unroll
                    for (int n = 0; n < 2; ++n) { const f32x4 a = acc[ai][bj][m][n] + bias[bj][n];
                        const unsigned w0 = bj == 0 ? (n == 0 ? b01.x : b01.z) : (n == 0 ? b23.x : b23.z), w1 = bj == 0 ? (n == 0 ? b01.y : b01.w) : (n == 0 ? b23.y : b23.w);
                        s[0] += sigmoidf_(a[0]) * bflo(w0); s[1] += sigmoidf_(a[1]) * bfhi(w0); s[2] += sigmoidf_(a[2]) * bflo(w1); s[3] += sigmoidf_(a[3]) * bfhi(w1); }
                v2u w; w.x = pk2(s[0], s[1]); w.y = pk2(s[2], s[3]); *(v2u*)(mix + row * 1024 + ch) = w; }
    }
};
struct EpiOut {
    static constexpr bool PERM = false;
    const float* xl; const float* xc; float* X; const float* gl; const float* gc;
    __device__ __forceinline__ void operator()(const f32x4 (&acc)[2][2][4][2], const Unit& u, int wr, int wc, int fr_in, int fq_in) const {
        int fr = fr_in, fq = fq_in; asm volatile("" : "+v"(fr), "+v"(fq));
        const bool latent = u.pm < SEQ / 256; const float* gv = latent ? gl : gc; const float* xo = latent ? xl : xc - (size_t)SEQ * DM;
        const int col0 = u.pn * BM + wc * 32 + 4 * fq;
        f32x4 g[2][2];
#pragma unroll
        for (int bj = 0; bj < 2; ++bj)
#pragma unroll
            for (int n = 0; n < 2; ++n) g[bj][n] = *(const f32x4*)(gv + col0 + bj * HALF + n * 16);
#pragma unroll
        for (int ai = 0; ai < 2; ++ai)
#pragma unroll
            for (int m = 0; m < 4; ++m) { const size_t off = (size_t)(u.pm * BM + ai * HALF + wr * 64 + m * 16 + fr) * DM + col0;
#pragma unroll
                for (int bj = 0; bj < 2; ++bj)
#pragma unroll
                    for (int n = 0; n < 2; ++n) { const f32x4 o = *(const f32x4*)(xo + off + bj * HALF + n * 16); *(f32x4*)(X + off + bj * HALF + n * 16) = o + g[bj][n] * acc[ai][bj][m][n]; } }
    }
};
struct EpiS {
    static constexpr bool PERM = false;
    float* S;
    __device__ __forceinline__ void operator()(const f32x4 (&acc)[2][2][4][2], const Unit& u, int wr, int wc, int fr_in, int fq_in) const {
        int fr = fr_in, fq = fq_in; asm volatile("" : "+v"(fr), "+v"(fq));
        const int col0 = u.pn * BM + wc * 32 + 4 * fq;
#pragma unroll
        for (int ai = 0; ai < 2; ++ai)
#pragma unroll
            for (int m = 0; m < 4; ++m) { float* rowp = S + (size_t)(u.pm * BM + ai * HALF + wr * 64 + m * 16 + fr) * 2048 + col0;
#pragma unroll
                for (int bj = 0; bj < 2; ++bj)
#pragma unroll
                    for (int n = 0; n < 2; ++n) *(f32x4*)(rowp + bj * HALF + n * 16) = acc[ai][bj][m][n]; }
    }
};
}
namespace att {
using bf16 = __hip_bfloat16;
constexpr int NW = 8, QBLK = 32, QB = 256, KVBLK = 64;
__device__ __forceinline__ int crow(int r, int hi) { return (r & 3) + 8 * (r >> 2) + 4 * hi; }
#define SBAR() __builtin_amdgcn_sched_barrier(0)
constexpr int NSLOT = 3, SLOTB = 8192;
constexpr int LDS_K = 0, LDS_V = NSLOT * SLOTB, LDS_WS = 2 * NSLOT * SLOTB, LDS_OST = LDS_WS + NW * 64 * 4, LDS_RPB = LDS_OST + NW * 8192, LDS_BYTES = LDS_RPB + 2048;
static_assert(LDS_BYTES <= RING_BYTES, "attention scratch fits the ring region");
__device__ __forceinline__ void glds16(const void* gsrc, unsigned lds_dst) { unsigned keep;
    asm volatile("s_mov_b32 %0, m0\n\ts_mov_b32 m0, %2\n\ts_nop 0\n\tglobal_load_lds_dwordx4 %1, off\n\ts_mov_b32 m0, %0" : "=&s"(keep) : "v"(gsrc), "s"(lds_dst) : "memory"); }
__device__ __forceinline__ float max3f(float a, float b, float c) { float r; asm("v_max3_f32 %0, %1, %2, %3" : "=v"(r) : "v"(a), "v"(b), "v"(c)); return r; }
__device__ __forceinline__ float max2f(float a, float b) { float r; asm("v_max_f32_e32 %0, %1, %2" : "=v"(r) : "v"(a), "v"(b)); return r; }
__device__ __forceinline__ float fadd_s(float a, float b) { float r; asm("v_add_f32_e32 %0, %1, %2" : "=v"(r) : "v"(a), "v"(b)); return r; }
__device__ __forceinline__ float fsub_s(float a, float b) { float r; asm("v_sub_f32_e32 %0, %1, %2" : "=v"(r) : "v"(a), "v"(b)); return r; }
__device__ __forceinline__ unsigned cvtpk_s(float lo, float hi) { f32x2 v = {lo, hi}; bf16x2_t b = __builtin_convertvector(v, bf16x2_t); return __builtin_bit_cast(unsigned, b); }
#define WAIT_BAR(N) asm volatile("s_waitcnt vmcnt(" #N ") lgkmcnt(0)\n\ts_barrier" ::: "memory")

__device__ __forceinline__ void qkt(f32x16& p0, f32x16& p1, const char* Kslot, const bf16x8* qr, const f32x16& negm, int r32, int hi) {
    const char* kb = Kslot + hi * 1024 + r32 * 16;
#pragma unroll
    for (int d0 = 0; d0 < 4; ++d0) {
        const bf16x8 b0 = *reinterpret_cast<const bf16x8*>(kb + d0 * 2048);
        const bf16x8 b1 = *reinterpret_cast<const bf16x8*>(kb + d0 * 2048 + 512);
        if (d0 == 0) { p0 = __builtin_amdgcn_mfma_f32_32x32x16_bf16(b0, qr[0], negm, 0, 0, 0); p1 = __builtin_amdgcn_mfma_f32_32x32x16_bf16(b1, qr[0], negm, 0, 0, 0); }
        else { p0 = __builtin_amdgcn_mfma_f32_32x32x16_bf16(b0, qr[d0], p0, 0, 0, 0); p1 = __builtin_amdgcn_mfma_f32_32x32x16_bf16(b1, qr[d0], p1, 0, 0, 0); } }
}
typedef __attribute__((address_space(3))) const char* lds_cptr;
typedef short v4i16_t __attribute__((ext_vector_type(4)));
__device__ __forceinline__ void kload8(bf16x8* kf, lds_cptr kp) {
    kf[0] = *(const __attribute__((address_space(3))) bf16x8*)(kp);        kf[1] = *(const __attribute__((address_space(3))) bf16x8*)(kp + 512);
    kf[2] = *(const __attribute__((address_space(3))) bf16x8*)(kp + 2048); kf[3] = *(const __attribute__((address_space(3))) bf16x8*)(kp + 2560);
    kf[4] = *(const __attribute__((address_space(3))) bf16x8*)(kp + 4096); kf[5] = *(const __attribute__((address_space(3))) bf16x8*)(kp + 4608);
    kf[6] = *(const __attribute__((address_space(3))) bf16x8*)(kp + 6144); kf[7] = *(const __attribute__((address_space(3))) bf16x8*)(kp + 6656);
}
__device__ __forceinline__ void kload2(bf16x8* kf, lds_cptr kp, int j) { kf[2 * j] = *(const __attribute__((address_space(3))) bf16x8*)(kp + j * 2048); kf[2 * j + 1] = *(const __attribute__((address_space(3))) bf16x8*)(kp + j * 2048 + 512); }
__device__ __forceinline__ s16x4 vtr(lds_cptr p) { return __builtin_bit_cast(s16x4, __builtin_amdgcn_ds_read_tr16_b64_v4i16((__attribute__((address_space(3))) v4i16_t*)p)); }
__device__ __forceinline__ float rowmax(const f32x16& p0, const f32x16& p1) {
    float a = max3f(p0[0], p0[1], p1[0]), b = max3f(p0[2], p0[3], p1[1]); a = max3f(a, p1[2], p1[3]);
#pragma unroll
    for (int r = 4; r < 16; r += 4) { a = max3f(a, p0[r], p0[r + 1]); b = max3f(b, p0[r + 2], p0[r + 3]); a = max3f(a, p1[r], p1[r + 1]); b = max3f(b, p1[r + 2], p1[r + 3]); }
    const float m = max2f(a, b);
    auto rr = __builtin_amdgcn_permlane32_swap(__float_as_uint(m), __float_as_uint(m), false, false);
    return max2f(__uint_as_float(rr[0]), __uint_as_float(rr[1]));
}
__device__ __forceinline__ void pv(f32x16* o, int vb, bf16x8 pa0, bf16x8 pa1, bf16x8 pa2, bf16x8 pa3) {
#pragma unroll
    for (int d0 = 0; d0 < 2; ++d0) { s16x4 lo[4], hi[4];
#pragma unroll
        for (int ks = 0; ks < 4; ++ks) {
            asm volatile("ds_read_b64_tr_b16 %0,%1 offset:%c2" : "=&v"(lo[ks]) : "v"(vb), "i"(d0 * 4096 + ks * 1024) : "memory");
            asm volatile("ds_read_b64_tr_b16 %0,%1 offset:%c2" : "=&v"(hi[ks]) : "v"(vb), "i"(d0 * 4096 + ks * 1024 + 512) : "memory"); }
        asm volatile("s_waitcnt lgkmcnt(0)" ::: "memory"); SBAR();
#define PK(k) (bf16x8){lo[k][0], lo[k][1], lo[k][2], lo[k][3], hi[k][0], hi[k][1], hi[k][2], hi[k][3]}
        o[d0] = __builtin_amdgcn_mfma_f32_32x32x16_bf16(pa0, PK(0), o[d0], 0, 0, 0);
        o[d0] = __builtin_amdgcn_mfma_f32_32x32x16_bf16(pa1, PK(1), o[d0], 0, 0, 0);
        o[d0] = __builtin_amdgcn_mfma_f32_32x32x16_bf16(pa2, PK(2), o[d0], 0, 0, 0);
        o[d0] = __builtin_amdgcn_mfma_f32_32x32x16_bf16(pa3, PK(3), o[d0], 0, 0, 0);
#undef PK
    }
}

struct AU {
    const bf16* Q; const bf16* K; const bf16* V;
    bf16* O;
    int q0, NT, kbase;
    float sinkl2;
    int emode;
    float lam, oscale; const float* subw;
};

template <int MODE> __device__ __forceinline__ void amask(f32x16& p0, f32x16& p1, int t, const AU& u, int wid, int r32, int hi, const float* rpb) {
    if constexpr (MODE == 2) {
        if (t >= 4) {
            const int kp0 = u.kbase + 64 * (t - 4) + 4 * hi, qpos = u.q0 + wid * QBLK + r32;
#pragma unroll
            for (int r = 0; r < 16; ++r) { const int kv = kp0 + (r & 3) + 8 * (r >> 2);
                const bool ok0 = ((unsigned)(kv - qpos + 128) <= 256u) && ((unsigned)kv < (unsigned)SEQ);
                const bool ok1 = ((unsigned)(kv + 32 - qpos + 128) <= 256u) && ((unsigned)(kv + 32) < (unsigned)SEQ);
                if (!ok0) p0[r] = -INFINITY; if (!ok1) p1[r] = -INFINITY; }
        }
    }
    if constexpr (MODE == 1) {
        if (t >= 4) {
            const int jr = (u.kbase >> 6) + (t - 4), qr = (u.q0 >> 6) + (wid >> 1), qc = 32 * (wid & 1) + r32;
            int rs = qr - 4; rs = rs < 0 ? 0 : (rs > 248 ? 248 : rs);
            int cs = qc - 8; cs = cs < 0 ? 0 : (cs > 48 ? 48 : cs);
            const bool rowok = (unsigned)(jr - rs) < 8u;
            int ro = jr - qr + 7; ro = ro < 0 ? 0 : (ro > 14 ? 14 : ro);
            const float* brow = rpb + ro * 32;
#pragma unroll
            for (int r = 0; r < 16; ++r) { const int kc = 4 * hi + (r & 3) + 8 * (r >> 2);
                { int bi = kc - qc + 15; bi = bi < 0 ? 0 : (bi > 30 ? 30 : bi); const bool ok = rowok && ((unsigned)(kc - cs) < 16u); p0[r] = ok ? p0[r] + brow[bi] : -INFINITY; }
                { int bi = kc + 32 - qc + 15; bi = bi < 0 ? 0 : (bi > 30 ? 30 : bi); const bool ok = rowok && ((unsigned)(kc + 32 - cs) < 16u); p1[r] = ok ? p1[r] + brow[bi] : -INFINITY; } }
        }
    }
}

template <int MODE, int THRL> __device__ __forceinline__ void attn_unit(const AU& u, char* shm) {
    int tid_ = threadIdx.x; asm volatile("" : "+v"(tid_));
    const int tid = tid_, lane = tid & 63, r32 = lane & 31, hi = lane >> 5; const int wid = __builtin_amdgcn_readfirstlane(tid >> 6);
    const bf16* Qw = u.Q + (size_t)(u.q0 + wid * QBLK) * 64;
    const bf16* Kh = u.K; const bf16* Vh = u.V;
    const unsigned lds0 = (unsigned)(uintptr_t)shm;
    float* wsf = (float*)(shm + LDS_WS) + wid * 64;
    const float* rpb = (const float*)(shm + LDS_RPB);
    const int NT = u.NT;
#define KROW(t) ((t) < 4 ? SEQ + 64 * (t) : (u.kbase + 64 * ((t) - 4) < 0 ? 0 : (u.kbase + 64 * ((t) - 4) > SEQ - 64 ? SEQ - 64 : u.kbase + 64 * ((t) - 4))))
    const bf16* ksrc = Kh + (size_t)lane * 64 + wid * 8;
    const bf16* vsrc = Vh + (size_t)(16 * (wid & 3) + (lane >> 2)) * 64 + (wid >> 2) * 32 + (lane & 3) * 8;
    const unsigned kdst = lds0 + LDS_K + wid * 1024, vdst = lds0 + LDS_V + wid * 1024;
#define DMA_K(t, slot) glds16(ksrc + (size_t)KROW(t) * 64, (unsigned)__builtin_amdgcn_readfirstlane(kdst + (slot)))
#define DMA_V(t, slot) glds16(vsrc + (size_t)KROW(t) * 64, (unsigned)__builtin_amdgcn_readfirstlane(vdst + (slot)))
    const int vb0 = (int)(lds0 + LDS_V) + ((lane >> 4) & 1) * 32 + (lane & 3) * 8 + (4 * hi + ((lane & 15) >> 2)) * 64;
    const char* Kbase = shm + LDS_K; bf16x8 kf[8];
    const lds_cptr shm3 = (lds_cptr)shm; const lds_cptr kp0 = shm3 + LDS_K + hi * 1024 + r32 * 16; const lds_cptr vp0 = shm3 + LDS_V + ((lane >> 4) & 1) * 32 + (lane & 3) * 8 + (4 * hi + ((lane & 15) >> 2)) * 64;
    DMA_K(0, 0); DMA_V(0, 0); DMA_K(1, SLOTB);
    bf16x8 qr[4];
#pragma unroll
    for (int d0 = 0; d0 < 4; ++d0) qr[d0] = *reinterpret_cast<const bf16x8*>(&Qw[(size_t)r32 * 64 + d0 * 16 + hi * 8]);
    float mhat = 0.f, l_reg = 0.f; f32x16 o[2]; o[0] = f32x16{}; o[1] = f32x16{}; f32x16 negm = f32x16{}; asm volatile("" : "+v"(negm));
#define CMASK(P0, P1, t) amask<MODE>(P0, P1, (t), u, wid, r32, hi, rpb)
    bool resc = false;
#define START(P0, P1) do { const float rm = rowmax(P0, P1); resc = false; \
    { const float dl = rm; mhat = fadd_s(mhat, dl); \
      _Pragma("unroll") for (int r = 0; r < 16; ++r) { P0[r] = fsub_s(P0[r], dl); P1[r] = fsub_s(P1[r], dl); } \
      _Pragma("unroll") for (int r = 0; r < 16; ++r) negm[r] = -mhat; asm volatile("" : "+v"(negm)); } \
    _Pragma("unroll") for (int r = 0; r < 16; ++r) P0[r] = __builtin_amdgcn_exp2f(P0[r]); } while (0)
#define RESC() do { if (resc) { asm volatile("s_waitcnt lgkmcnt(0)" ::: "memory"); \
      _Pragma("unroll") for (int d_ = 0; d_ < 2; ++d_) _Pragma("unroll") for (int r = 0; r < 16; ++r) o[d_][r] *= wsf[crow(r, hi)]; } } while (0)
    f32x16 pA0, pA1, pB0, pB1;
    int sl_prev = 0, sl_cur = 0, sl_next = SLOTB;
#define ROT() do { sl_prev = sl_cur; sl_cur = sl_next; sl_next = (sl_next == (NSLOT - 1) * SLOTB) ? 0 : sl_next + SLOTB; } while (0)
    DMA_K(2, 2 * SLOTB);
    WAIT_BAR(3);
    qkt(pA0, pA1, Kbase, qr, negm, r32, hi); asm volatile("s_nop 15\n\ts_nop 7" : "+v"(pA0), "+v"(pA1));
    START(pA0, pA1);
    _Pragma("unroll") for (int r = 0; r < 16; ++r) pA1[r] = __builtin_amdgcn_exp2f(pA1[r]);
    WAIT_BAR(0);
    DMA_K(3, 0); DMA_V(1, SLOTB);
    ROT();
    kload8(kf, kp0 + sl_cur);
    WAIT_BAR(2);
    s16x4 vlo[8], vhi[8]; v4u pw0, pw1, pw2, pw3;
#define PKW(P, B) cvtpk_s(P[B], P[B + 1])
#define PAF(k) __builtin_bit_cast(bf16x8, pw##k)
#define VFR(i) (bf16x8){vlo[i][0], vlo[i][1], vlo[i][2], vlo[i][3], vhi[i][0], vhi[i][1], vhi[i][2], vhi[i][3]}
#define PIN(x) asm volatile("" : "+v"(x))
#define MX3(a, b, c) __builtin_fmaxf(__builtin_fmaxf((a), (b)), (c))
#define GAPA(MF, A0, A1, A2, A3, W0, W1, PW) do { MF; sacc += A0; sacc += A1; sacc += A2; sacc += A3; PIN(sacc); W0; W1; PIN(PW); SBAR(); } while (0)
#define EX(v) __builtin_amdgcn_exp2f(v)
#define GAPB(MF, X, B) do { MF; X[B] = EX(X[B]); X[B + 1] = EX(X[B + 1]); X[B + 2] = EX(X[B + 2]); X[B + 3] = EX(X[B + 3]); PIN(X); SBAR(); } while (0)
#define VRD(i) do { vlo[i] = vtr(vp_ + (((i) >> 2) * 4096 + ((i) & 3) * 1024)); vhi[i] = vtr(vp_ + (((i) >> 2) * 4096 + ((i) & 3) * 1024 + 512)); } while (0)
#define KRD(G, j) do { if (G) { kload2(kf, kp0 + sl_next, j); SBAR(); } } while (0)
#define STEP(C0, C1, P0, P1, t, GK, GV, GL) do { SBAR(); \
    const lds_cptr vp_ = vp0 + sl_prev; \
    VRD(0); SBAR(); float sacc = (P0[0] + P0[1]); \
    GAPA(C0 = __builtin_amdgcn_mfma_f32_32x32x16_bf16(kf[0], qr[0], negm, 0, 0, 0), P0[2], P0[3], P0[4], P0[5],     pw0[0] = PKW(P0, 0), pw0[1] = PKW(P0, 2), pw0); \
    VRD(4); SBAR(); GAPA(C1 = __builtin_amdgcn_mfma_f32_32x32x16_bf16(kf[1], qr[0], negm, 0, 0, 0), P0[6], P0[7], P0[8], P0[9],     pw0[2] = PKW(P0, 4), pw0[3] = PKW(P0, 6), pw0); \
    VRD(1); SBAR(); GAPA(C0 = __builtin_amdgcn_mfma_f32_32x32x16_bf16(kf[2], qr[1], C0, 0, 0, 0),   P0[10], P0[11], P0[12], P0[13], pw1[0] = PKW(P0, 8), pw1[1] = PKW(P0, 10), pw1); \
    VRD(5); SBAR(); GAPA(C1 = __builtin_amdgcn_mfma_f32_32x32x16_bf16(kf[3], qr[1], C1, 0, 0, 0),   P0[14], P0[15], P1[0], P1[1],   pw1[2] = PKW(P0, 12), pw1[3] = PKW(P0, 14), pw1); \
    VRD(2); SBAR(); GAPA(C0 = __builtin_amdgcn_mfma_f32_32x32x16_bf16(kf[4], qr[2], C0, 0, 0, 0),   P1[2], P1[3], P1[4], P1[5],     pw2[0] = PKW(P1, 0), pw2[1] = PKW(P1, 2), pw2); \
    VRD(6); SBAR(); GAPA(C1 = __builtin_amdgcn_mfma_f32_32x32x16_bf16(kf[5], qr[2], C1, 0, 0, 0),   P1[6], P1[7], P1[8], P1[9],     pw2[2] = PKW(P1, 4), pw2[3] = PKW(P1, 6), pw2); \
    VRD(3); SBAR(); GAPA(C0 = __builtin_amdgcn_mfma_f32_32x32x16_bf16(kf[6], qr[3], C0, 0, 0, 0),   P1[10], P1[11], P1[12], P1[13], pw3[0] = PKW(P1, 8), pw3[1] = PKW(P1, 10), pw3); \
    VRD(7); SBAR(); GAPA(C1 = __builtin_amdgcn_mfma_f32_32x32x16_bf16(kf[7], qr[3], C1, 0, 0, 0),   P1[14], P1[15], 0.f, 0.f,       pw3[2] = PKW(P1, 12), pw3[3] = PKW(P1, 14), pw3); \
    l_reg += sacc; \
    if (GK) { DMA_K((t) + 3, sl_cur); } if (GV) { DMA_V((t) + 1, sl_next); } \
    CMASK(C0, C1, t); \
    { float a = MX3(C0[0], C0[1], C1[0]), b = MX3(C0[2], C0[3], C1[1]); a = MX3(a, C1[2], C1[3]); \
      _Pragma("unroll") for (int r = 4; r < 16; r += 4) { a = MX3(a, C0[r], C0[r + 1]); b = MX3(b, C0[r + 2], C0[r + 3]); a = MX3(a, C1[r], C1[r + 1]); b = MX3(b, C1[r + 2], C1[r + 3]); } \
      float rm = __builtin_fmaxf(a, b); { auto rr = __builtin_amdgcn_permlane32_swap(__float_as_uint(rm), __float_as_uint(rm), false, false); rm = __builtin_fmaxf(__uint_as_float(rr[0]), __uint_as_float(rr[1])); } \
      resc = false; \
      if (__builtin_expect(__any(rm > (float)THRL), 0)) { const float dl = __builtin_fmaxf(rm, 0.f); mhat += dl; \
        _Pragma("unroll") for (int r = 0; r < 16; ++r) { C0[r] -= dl; C1[r] -= dl; } \
        _Pragma("unroll") for (int r = 0; r < 16; ++r) negm[r] = -mhat; asm volatile("" : "+v"(negm)); \
        const float f = __builtin_amdgcn_exp2f(-dl); l_reg *= f; if (hi == 0) wsf[r32] = f; resc = true; } } \
    SBAR(); \
    GAPB(o[0] = __builtin_amdgcn_mfma_f32_32x32x16_bf16(PAF(0), VFR(0), o[0], 0, 0, 0), C0, 0); \
    GAPB(o[1] = __builtin_amdgcn_mfma_f32_32x32x16_bf16(PAF(0), VFR(4), o[1], 0, 0, 0), C0, 4); \
    KRD(GL, 0); GAPB(o[0] = __builtin_amdgcn_mfma_f32_32x32x16_bf16(PAF(1), VFR(1), o[0], 0, 0, 0), C0, 8); \
    KRD(GL, 1); GAPB(o[1] = __builtin_amdgcn_mfma_f32_32x32x16_bf16(PAF(1), VFR(5), o[1], 0, 0, 0), C0, 12); \
    KRD(GL, 2); GAPB(o[0] = __builtin_amdgcn_mfma_f32_32x32x16_bf16(PAF(2), VFR(2), o[0], 0, 0, 0), C1, 0); \
    KRD(GL, 3); GAPB(o[1] = __builtin_amdgcn_mfma_f32_32x32x16_bf16(PAF(2), VFR(6), o[1], 0, 0, 0), C1, 4); \
    GAPB(o[0] = __builtin_amdgcn_mfma_f32_32x32x16_bf16(PAF(3), VFR(3), o[0], 0, 0, 0), C1, 8); \
    GAPB(o[1] = __builtin_amdgcn_mfma_f32_32x32x16_bf16(PAF(3), VFR(7), o[1], 0, 0, 0), C1, 12); \
    } while (0)
    int t = 1;
    for (; t + 5 < NT; t += 2) {
        STEP(pB0, pB1, pA0, pA1, t, true, true, true);     WAIT_BAR(2); RESC(); ROT();
        STEP(pA0, pA1, pB0, pB1, t + 1, true, true, true);   WAIT_BAR(2); RESC(); ROT();
    }
#define ENDW(tt) do { if ((tt) + 3 < NT) { WAIT_BAR(2); } else if ((tt) + 2 < NT) { WAIT_BAR(1); } else { WAIT_BAR(0); } } while (0)
    for (; t + 1 < NT; t += 2) {
        STEP(pB0, pB1, pA0, pA1, t, (t + 3 < NT), (t + 1 < NT), (t + 1 < NT));       ENDW(t);   RESC(); ROT();
        STEP(pA0, pA1, pB0, pB1, t + 1, (t + 4 < NT), (t + 2 < NT), (t + 2 < NT));     ENDW(t + 1); RESC(); ROT();
    }
    STEP(pB0, pB1, pA0, pA1, NT - 1, false, false, false); RESC();
    { float sacc = pB0[0] + pB0[1]; _Pragma("unroll") for (int r = 2; r < 16; ++r) sacc += pB0[r]; _Pragma("unroll") for (int r = 0; r < 16; ++r) sacc += pB1[r]; l_reg += sacc;
      pw0 = (v4u){PKW(pB0, 0), PKW(pB0, 2), PKW(pB0, 4), PKW(pB0, 6)}; pw1 = (v4u){PKW(pB0, 8), PKW(pB0, 10), PKW(pB0, 12), PKW(pB0, 14)}; pw2 = (v4u){PKW(pB1, 0), PKW(pB1, 2), PKW(pB1, 4), PKW(pB1, 6)}; pw3 = (v4u){PKW(pB1, 8), PKW(pB1, 10), PKW(pB1, 12), PKW(pB1, 14)};
      SBAR(); pv(o, vb0 + sl_cur, PAF(0), PAF(1), PAF(2), PAF(3)); }
#undef PKW
#undef PAF
#undef VFR
#undef PIN
#undef MX3
#undef GAPA
#undef GAPB
#undef EX
#undef VRD
#undef KRD
#undef STEP
#undef ENDW
    { auto rr = __builtin_amdgcn_permlane32_swap(__float_as_uint(l_reg), __float_as_uint(l_reg), false, false); l_reg = __uint_as_float(rr[0]) + __uint_as_float(rr[1]); }
    l_reg += __builtin_amdgcn_exp2f(u.sinkl2 - mhat);
    if (hi == 0) wsf[32 + r32] = l_reg; asm volatile("s_waitcnt lgkmcnt(0)" ::: "memory");
    float rli[16];
#pragma unroll
    for (int r = 0; r < 16; ++r) rli[r] = __builtin_amdgcn_rcpf(wsf[32 + crow(r, hi)]);
    if (u.emode == 0) {
        bf16* Ow = u.O + (size_t)(u.q0 + wid * QBLK) * 1024;
        bf16* stg = (bf16*)(shm + LDS_OST + wid * 8192);
#pragma unroll
        for (int r = 0; r < 16; ++r) { const int orow = crow(r, hi);
#pragma unroll
            for (int d0 = 0; d0 < 2; ++d0) stg[orow * 64 + d0 * 32 + r32] = __float2bfloat16(o[d0][r] * rli[r]); }
        asm volatile("s_waitcnt lgkmcnt(0)" ::: "memory");
#pragma unroll
        for (int i = 0; i < 4; ++i) { const int row = i * 8 + (lane >> 3), ch = lane & 7; const v4u v = *(const v4u*)(stg + row * 64 + ch * 8); *(v4u*)(Ow + (size_t)row * 1024 + ch * 8) = v; }
    } else {
        float* stf = (float*)(shm + LDS_OST + wid * 8192);
        if (u.emode == 1) {
#pragma unroll
            for (int r = 0; r < 16; ++r) { const int orow = crow(r, hi);
#pragma unroll
                for (int d0 = 0; d0 < 2; ++d0) stf[orow * 64 + d0 * 32 + r32] = o[d0][r] * rli[r]; }
        } else {
#pragma unroll
            for (int r = 0; r < 16; ++r) { const int orow = crow(r, hi);
#pragma unroll
                for (int d0 = 0; d0 < 2; ++d0) { const float y = stf[orow * 64 + d0 * 32 + r32] - u.lam * (o[d0][r] * rli[r]); stf[orow * 64 + d0 * 32 + r32] = y; } }
            asm volatile("s_waitcnt lgkmcnt(0)" ::: "memory");
            bf16* Ow = u.O + (size_t)(u.q0 + wid * QBLK) * 1024;
#pragma unroll
            for (int i = 0; i < 4; ++i) { const int row = i * 8 + (lane >> 3), ch = lane & 7;
                const f32x4 y0 = *(const f32x4*)(stf + row * 64 + ch * 8), y1 = *(const f32x4*)(stf + row * 64 + ch * 8 + 4);
                float ss = (y0[0] * y0[0] + y0[1] * y0[1]) + (y0[2] * y0[2] + y0[3] * y0[3]) + (y1[0] * y1[0] + y1[1] * y1[1]) + (y1[2] * y1[2] + y1[3] * y1[3]);
                ss += __shfl_xor(ss, 1); ss += __shfl_xor(ss, 2); ss += __shfl_xor(ss, 4);
                const float ri = __builtin_amdgcn_rsqf(ss * (1.f / 64.f) + EPS) * u.oscale;
                const f32x4 w0 = *(const f32x4*)(u.subw + ch * 8), w1 = *(const f32x4*)(u.subw + ch * 8 + 4);
                v4u v; v.x = pk2(y0[0] * ri * w0[0], y0[1] * ri * w0[1]); v.y = pk2(y0[2] * ri * w0[2], y0[3] * ri * w0[3]); v.z = pk2(y1[0] * ri * w1[0], y1[1] * ri * w1[1]); v.w = pk2(y1[2] * ri * w1[2], y1[3] * ri * w1[3]);
                *(v4u*)(Ow + (size_t)row * 1024 + ch * 8) = v; }
        }
    }
    asm volatile("s_waitcnt lgkmcnt(0)\n\ts_barrier" ::: "memory");
#undef DMA_K
#undef DMA_V
#undef KROW
#undef CMASK
#undef START
#undef RESC
#undef ROT
}

template <int MODE> __device__ __forceinline__ void attn_simple(const AU& u, char* shm) {
    int tid_ = threadIdx.x; asm volatile("" : "+v"(tid_));
    const int tid = tid_, lane = tid & 63, r32 = lane & 31, hi = lane >> 5; const int wid = __builtin_amdgcn_readfirstlane(tid >> 6);
    const bf16* Qw = u.Q + (size_t)(u.q0 + wid * QBLK) * 64;
    const unsigned lds0 = (unsigned)(uintptr_t)shm;
    float* wsf = (float*)(shm + LDS_WS) + wid * 64;
    const float* rpb = (const float*)(shm + LDS_RPB);
    const int NT = u.NT;
#define KROW(t) ((t) < 4 ? SEQ + 64 * (t) : (u.kbase + 64 * ((t) - 4) < 0 ? 0 : (u.kbase + 64 * ((t) - 4) > SEQ - 64 ? SEQ - 64 : u.kbase + 64 * ((t) - 4))))
    const bf16* ksrc = u.K + (size_t)lane * 64 + wid * 8;
    const bf16* vsrc = u.V + (size_t)(16 * (wid & 3) + (lane >> 2)) * 64 + (wid >> 2) * 32 + (lane & 3) * 8;
    const unsigned kdst = lds0 + LDS_K + wid * 1024, vdst = lds0 + LDS_V + wid * 1024;
    const int vb0 = (int)(lds0 + LDS_V) + ((lane >> 4) & 1) * 32 + (lane & 3) * 8 + (4 * hi + ((lane & 15) >> 2)) * 64;
    { const int kr = KROW(0); glds16(ksrc + (size_t)kr * 64, (unsigned)__builtin_amdgcn_readfirstlane(kdst)); glds16(vsrc + (size_t)kr * 64, (unsigned)__builtin_amdgcn_readfirstlane(vdst)); }
    bf16x8 qr[4];
#pragma unroll
    for (int d0 = 0; d0 < 4; ++d0) qr[d0] = *reinterpret_cast<const bf16x8*>(&Qw[(size_t)r32 * 64 + d0 * 16 + hi * 8]);
    float m_run = -INFINITY, l_reg = 0.f; f32x16 o[2]; o[0] = f32x16{}; o[1] = f32x16{};
    const f32x16 zero = f32x16{};
#pragma unroll 1
    for (int t = 0; t < NT; ++t) {
        const int sl = (t & 1) * SLOTB;
        asm volatile("s_waitcnt vmcnt(0) lgkmcnt(0)\n\ts_barrier" ::: "memory");
        if (t + 1 < NT) { const int kr = KROW(t + 1); const int sn = ((t + 1) & 1) * SLOTB;
            glds16(ksrc + (size_t)kr * 64, (unsigned)__builtin_amdgcn_readfirstlane(kdst + sn)); glds16(vsrc + (size_t)kr * 64, (unsigned)__builtin_amdgcn_readfirstlane(vdst + sn)); }
        f32x16 p0, p1;
        qkt(p0, p1, shm + LDS_K + sl, qr, zero, r32, hi);
        amask<MODE>(p0, p1, t, u, wid, r32, hi, rpb);
        float rm = p0[0];
#pragma unroll
        for (int r = 1; r < 16; ++r) rm = __builtin_fmaxf(rm, p0[r]);
#pragma unroll
        for (int r = 0; r < 16; ++r) rm = __builtin_fmaxf(rm, p1[r]);
        { auto rr = __builtin_amdgcn_permlane32_swap(__float_as_uint(rm), __float_as_uint(rm), false, false); rm = __builtin_fmaxf(__uint_as_float(rr[0]), __uint_as_float(rr[1])); }
        const float m_new = __builtin_fmaxf(m_run, rm);
        const float alpha = __builtin_amdgcn_exp2f(m_run - m_new); m_run = m_new;
        float sacc = 0.f;
#pragma unroll
        for (int r = 0; r < 16; ++r) { p0[r] = __builtin_amdgcn_exp2f(p0[r] - m_new); p1[r] = __builtin_amdgcn_exp2f(p1[r] - m_new); sacc += p0[r] + p1[r]; }
        l_reg = l_reg * alpha + sacc;
        if (hi == 0) wsf[r32] = alpha;
        asm volatile("s_waitcnt lgkmcnt(0)" ::: "memory");
#pragma unroll
        for (int d_ = 0; d_ < 2; ++d_)
#pragma unroll
            for (int r = 0; r < 16; ++r) o[d_][r] *= wsf[crow(r, hi)];
        v4u pw0, pw1, pw2, pw3;
        pw0 = (v4u){cvtpk_s(p0[0], p0[1]), cvtpk_s(p0[2], p0[3]), cvtpk_s(p0[4], p0[5]), cvtpk_s(p0[6], p0[7])}; pw1 = (v4u){cvtpk_s(p0[8], p0[9]), cvtpk_s(p0[10], p0[11]), cvtpk_s(p0[12], p0[13]), cvtpk_s(p0[14], p0[15])};
        pw2 = (v4u){cvtpk_s(p1[0], p1[1]), cvtpk_s(p1[2], p1[3]), cvtpk_s(p1[4], p1[5]), cvtpk_s(p1[6], p1[7])}; pw3 = (v4u){cvtpk_s(p1[8], p1[9]), cvtpk_s(p1[10], p1[11]), cvtpk_s(p1[12], p1[13]), cvtpk_s(p1[14], p1[15])};
        asm volatile("s_waitcnt lgkmcnt(0)" ::: "memory"); SBAR();
        pv(o, vb0 + sl, __builtin_bit_cast(bf16x8, pw0), __builtin_bit_cast(bf16x8, pw1), __builtin_bit_cast(bf16x8, pw2), __builtin_bit_cast(bf16x8, pw3));
    }
    { auto rr = __builtin_amdgcn_permlane32_swap(__float_as_uint(l_reg), __float_as_uint(l_reg), false, false); l_reg = __uint_as_float(rr[0]) + __uint_as_float(rr[1]); }
    l_reg += __builtin_amdgcn_exp2f(u.sinkl2 - m_run);
    asm volatile("s_waitcnt lgkmcnt(0)" ::: "memory");
    if (hi == 0) wsf[32 + r32] = l_reg; asm volatile("s_waitcnt lgkmcnt(0)" ::: "memory");
    float rli[16];
#pragma unroll
    for (int r = 0; r < 16; ++r) rli[r] = __builtin_amdgcn_rcpf(wsf[32 + crow(r, hi)]);
    {
        bf16* Ow = u.O + (size_t)(u.q0 + wid * QBLK) * 1024;
        bf16* stg = (bf16*)(shm + LDS_OST + wid * 8192);
#pragma unroll
        for (int r = 0; r < 16; ++r) { const int orow = crow(r, hi);
#pragma unroll
            for (int d0 = 0; d0 < 2; ++d0) stg[orow * 64 + d0 * 32 + r32] = __float2bfloat16(o[d0][r] * rli[r]); }
        asm volatile("s_waitcnt lgkmcnt(0)" ::: "memory");
#pragma unroll
        for (int i = 0; i < 4; ++i) { const int row = i * 8 + (lane >> 3), ch = lane & 7; const v4u v = *(const v4u*)(stg + row * 64 + ch * 8); *(v4u*)(Ow + (size_t)row * 1024 + ch * 8) = v; }
    }
    asm volatile("s_waitcnt vmcnt(0) lgkmcnt(0)\n\ts_barrier" ::: "memory");
#undef KROW
}
#undef SBAR
#undef WAIT_BAR
}
struct Args { const float* in[23]; float* out; unsigned char* ws; int flags; int pad; };
enum { I_X = 0, I_C, I_CTX, I_CCTX, I_N1W, I_N2W, I_ADAW, I_ADAB, I_WIN, I_RPB, I_DLAM, I_SUBW, I_SINK, I_QKNW, I_WBR, I_WGATE, I_BGATE, I_WOUT, I_PWQ, I_PKEYS, I_PU, I_PV, I_FNW };

struct Frame {
    LAS unsigned char* lds; volatile LAS unsigned* MISC; gu32* ctl;
    int wave, vcu, G;
};
__device__ __forceinline__ int ltid() { int t = threadIdx.x; asm volatile("" : "+v"(t)); return t; }

struct MapId   { __device__ __forceinline__ int operator()(int n) const { return n; } };
struct MapWin  { __device__ __forceinline__ int operator()(int n) const { return (n & ~255) + 128 * ((n >> 5) & 1) + 32 * ((n >> 6) & 3) + (n & 31); } };
struct MapGate { __device__ __forceinline__ int operator()(int n) const { const int br = n >> 10, ch = n & 1023; return 256 * (ch >> 6) + 128 * (br >> 1) + 32 * ((ch >> 4) & 3) + 16 * (br & 1) + (ch & 15); } };
template <class Map> __device__ __forceinline__ void transpose_item(const float* W, int K, int N, bf16_t* WT, Map mp, LAS float* scr, int item, int lane) {
    const int nblk = N / 32, kb = item / nblk, nb = item % nblk, k0 = 64 * kb, n0 = 32 * nb;
#pragma unroll 8
    for (int i = 0; i < 32; ++i) { const int kk = 2 * i + (lane >> 5); scr[kk * 33 + (lane & 31)] = W[(size_t)(k0 + kk) * N + n0 + (lane & 31)]; }
    LDS_WAIT(); asm volatile("" ::: "memory");
    const int c = lane & 7;
#pragma unroll
    for (int j = 0; j < 4; ++j) { const int n = (lane >> 3) + 8 * j; const LAS float* s = scr + (8 * c) * 33 + n;
        v4u o; o.x = pk2(s[0 * 33], s[1 * 33]); o.y = pk2(s[2 * 33], s[3 * 33]); o.z = pk2(s[4 * 33], s[5 * 33]); o.w = pk2(s[6 * 33], s[7 * 33]);
        *(GAS v4u*)(WT + (size_t)mp(n0 + n) * K + k0 + 8 * c) = o; }
    LDS_WAIT(); asm volatile("" ::: "memory");
}
__device__ __forceinline__ void modnorm_row(const float* xrow, bf16_t* orow, const float* nw, const float* sh, const float* sc, int lane) {
    const GAS f32x4* xr = (const GAS f32x4*)xrow + lane;
    f32x4 v[4]; float s = 0.f;
#pragma unroll
    for (int j = 0; j < 4; ++j) { v[j] = xr[64 * j]; s += (v[j].x * v[j].x + v[j].y * v[j].y) + (v[j].z * v[j].z + v[j].w * v[j].w); }
    const float ri = __builtin_amdgcn_rsqf(wave_sum(s) * (1.f / DM) + EPS);
    GAS v2u* o8 = (GAS v2u*)orow + lane;
#pragma unroll
    for (int j = 0; j < 4; ++j) { const int col = 256 * j + 4 * lane; const f32x4 w = *(const f32x4*)(nw + col), a = *(const f32x4*)(sc + col), b = *(const f32x4*)(sh + col);
        const f32x4 y = (v[j] * ri * w) * (1.0f + a) + b; v2u p; p.x = pk2(y.x, y.y); p.y = pk2(y.z, y.w); o8[64 * j] = p; }
}

__device__ __forceinline__ void ce_desc(float& a, float& b) { const float hi = __builtin_fmaxf(a, b), lo = __builtin_fminf(a, b); a = hi; b = lo; }
__device__ __forceinline__ void sort16_desc(float (&x)[16]) {
#pragma unroll
    for (int k = 2; k <= 16; k <<= 1)
#pragma unroll
        for (int j = k >> 1; j > 0; j >>= 1)
#pragma unroll
            for (int i = 0; i < 16; ++i) { const int l = i ^ j; if (l > i) { if ((i & k) == 0) ce_desc(x[i], x[l]); else ce_desc(x[l], x[i]); } }
}
__device__ __forceinline__ void merge16_desc(float (&top)[16], const float (&c)[16]) {
#pragma unroll
    for (int i = 0; i < 16; ++i) top[i] = __builtin_fmaxf(top[i], c[15 - i]);
#pragma unroll
    for (int j = 8; j > 0; j >>= 1)
#pragma unroll
        for (int i = 0; i < 16; ++i) { const int l = i ^ j; if (l > i) ce_desc(top[i], top[l]); }
}

struct PeerArgs { const float* S; const bf16_t* Hin; const bf16_t* U; const bf16_t* V; const float* Xin; float* Xout;
                  const float* g2l; const float* g2c;
                  bf16_t* Hout; const float* nwn; const float* shl; const float* scl; const float* shc; const float* scc;
                  float* fout; const float* fnw;
                  int nblocks; int* dbg_eid; float* dbg_gt; };
constexpr int PL_LISTS = 0, PL_EID = 40960, PL_GT = PL_EID + 16384;
__device__ __forceinline__ float dot2bf(unsigned a, unsigned b, float acc) { return __builtin_amdgcn_fdot2_f32_bf16(__builtin_bit_cast(bf16x2_t, a), __builtin_bit_cast(bf16x2_t, b), acc, false); }
__device__ __forceinline__ float dot8(const v4u a, const v4u b, float acc) {
    const unsigned a0 = a.x, a1 = a.y, a2 = a.z, a3 = a.w, b0 = b.x, b1 = b.y, b2 = b.z, b3 = b.w;
    acc = dot2bf(a0, b0, acc); acc = dot2bf(a1, b1, acc); acc = dot2bf(a2, b2, acc); acc = dot2bf(a3, b3, acc);
    return acc;
}
__device__ __forceinline__ void peer_phase(Frame& F, const PeerArgs& P) {
    const int tid = ltid(), lane = tid & 63;
    LAS unsigned* lists = (LAS unsigned*)(F.lds + PL_LISTS);
    LAS int* eid = (LAS int*)(F.lds + PL_EID);
    LAS float* gt = (LAS float*)(F.lds + PL_GT);
    for (int blk = F.vcu; blk < P.nblocks; blk += F.G) {
        const int row0 = blk * 32;
        {
            const int tok = tid >> 4, lst = tid & 15;
            const float* sp = P.S + (size_t)(row0 + tok) * 2048 + lst * 128;
            float top[16];
#pragma unroll 1
            for (int c = 0; c < 8; ++c) {
                float x[16];
#pragma unroll
                for (int q = 0; q < 4; ++q) { const f32x4 v = *(const f32x4*)(sp + c * 16 + q * 4);
#pragma unroll
                    for (int j = 0; j < 4; ++j) x[q * 4 + j] = __uint_as_float((__float_as_uint(v[j]) & ~127u) | (unsigned)(c * 16 + q * 4 + j)); }
                sort16_desc(x);
                if (c == 0) {
#pragma unroll
                    for (int i = 0; i < 16; ++i) top[i] = x[i];
                } else merge16_desc(top, x);
            }
            LAS unsigned* lp = lists + tid * 20;
#pragma unroll
            for (int q = 0; q < 4; ++q) *(LAS v4u*)(lp + q * 4) = (v4u){__float_as_uint(top[q * 4]), __float_as_uint(top[q * 4 + 1]), __float_as_uint(top[q * 4 + 2]), __float_as_uint(top[q * 4 + 3])};
        }
        __syncthreads();
        if (tid < 256) {
            const int tok = tid >> 3, hd = tid & 7;
            const LAS unsigned* la = lists + (tok * 16 + 2 * hd) * 20; const LAS unsigned* lb = la + 20;
            float av[16], bv[16];
#pragma unroll
            for (int q = 0; q < 4; ++q) { const v4u a = *(const LAS v4u*)(la + q * 4), b = *(const LAS v4u*)(lb + q * 4);
#pragma unroll
                for (int j = 0; j < 4; ++j) { av[q * 4 + j] = __uint_as_float(a[j] & ~127u); bv[q * 4 + j] = __uint_as_float(b[j] & ~127u); } }
            float c0[16], c1[16], c2[16], c3[16];
#pragma unroll
            for (int i = 0; i < 16; ++i) { c0[i] = -INFINITY; c1[i] = -INFINITY; c2[i] = -INFINITY; c3[i] = -INFINITY; }
            {
                int cnt = 0;
#pragma unroll
                for (int i = 0; i < 16; ++i)
#pragma unroll
                    for (int j = 0; j < 16; ++j) if ((i + 1) * (j + 1) <= 16) {
                        const float sm = __uint_as_float((__float_as_uint(av[i] + bv[j]) & ~255u) | (unsigned)(i * 16 + j));
                        const int slot = cnt & 15, arr = cnt >> 4;
                        if (arr == 0) c0[slot] = sm; else if (arr == 1) c1[slot] = sm; else if (arr == 2) c2[slot] = sm; else c3[slot] = sm;
                        ++cnt;
                    }
            }
            sort16_desc(c0); sort16_desc(c1); sort16_desc(c2); sort16_desc(c3);
            merge16_desc(c0, c1); merge16_desc(c0, c2); merge16_desc(c0, c3);
            float ev[16], sum = 0.f; const float m0 = __uint_as_float(__float_as_uint(c0[0]) & ~255u);
#pragma unroll
            for (int k = 0; k < 16; ++k) { ev[k] = fast_exp2((__uint_as_float(__float_as_uint(c0[k]) & ~255u) - m0) * LOG2E); sum += ev[k]; }
            const float rs = 1.0f / sum;
#pragma unroll
            for (int k = 0; k < 16; ++k) { const unsigned code = __float_as_uint(c0[k]) & 255u;
                const int ia = (int)(la[code >> 4] & 127u), ib = (int)(lb[code & 15u] & 127u);
                eid[tok * 128 + hd * 16 + k] = ia * NKEYS + ib; gt[tok * 128 + hd * 16 + k] = ev[k] * rs;
#if SELFCHECK
                P.dbg_eid[(size_t)(row0 + tok) * 128 + hd * 16 + k] = ia * NKEYS + ib; P.dbg_gt[(size_t)(row0 + tok) * 128 + hd * 16 + k] = ev[k] * rs;
#endif
            }
        }
        __syncthreads();
#pragma unroll 1
        for (int tk = 0; tk < 4; ++tk) {
            const int tok = F.wave * 4 + tk; const size_t row = (size_t)(row0 + tok);
            const bool latent = row < (size_t)SEQ;
            const bf16_t* hp = P.Hin + row * DM;
            const v4u xa = *(const v4u*)(hp + 8 * lane), xb = *(const v4u*)(hp + 512 + 8 * lane);
            float out[16];
#pragma unroll
            for (int i = 0; i < 16; ++i) out[i] = 0.f;
#pragma unroll 1
            for (int e0 = 0; e0 < 128; e0 += 4) {
                v4u ua[4], ub[4], va[4], vb[4]; float gg[4];
#pragma unroll
                for (int k = 0; k < 4; ++k) { const int id = __builtin_amdgcn_readfirstlane(eid[tok * 128 + e0 + k]); gg[k] = gt[tok * 128 + e0 + k];
                    const bf16_t* up = P.U + (size_t)id * DM; const bf16_t* vp = P.V + (size_t)id * DM;
                    ua[k] = *(const v4u*)(up + 8 * lane); ub[k] = *(const v4u*)(up + 512 + 8 * lane);
                    va[k] = *(const v4u*)(vp + 8 * lane); vb[k] = *(const v4u*)(vp + 512 + 8 * lane); }
#pragma unroll
                for (int k = 0; k < 4; ++k) {
                    float d = dot8(ua[k], xa, 0.f); d = dot8(ub[k], xb, d); d = wave_sum(d);
                    const float cf = gg[k] * gelu_tanh(d);
#if SELFCHECK
                    if (lane == 0) P.dbg_gt[(size_t)MT * 128 + row * 128 + e0 + k] = cf;
#endif
#pragma unroll
                    for (int q = 0; q < 4; ++q) { out[2 * q] += cf * bflo(va[k][q]); out[2 * q + 1] += cf * bfhi(va[k][q]); out[8 + 2 * q] += cf * bflo(vb[k][q]); out[8 + 2 * q + 1] += cf * bfhi(vb[k][q]); }
                }
            }
            const float* g2 = latent ? P.g2l : P.g2c;
            float xn[16]; float ss = 0.f;
#pragma unroll
            for (int hf = 0; hf < 2; ++hf)
#pragma unroll
                for (int q = 0; q < 2; ++q) { const int col = 512 * hf + 8 * lane + 4 * q; const f32x4 xo = *(const f32x4*)(P.Xin + row * DM + col), g = *(const f32x4*)(g2 + col);
#pragma unroll
                    for (int j = 0; j < 4; ++j) { const float v = xo[j] + g[j] * out[8 * hf + 4 * q + j]; xn[8 * hf + 4 * q + j] = v; ss += v * v; } }
            const float ri = __builtin_amdgcn_rsqf(wave_sum(ss) * (1.f / DM) + EPS);
            if (P.fout) {
                if (latent) {
#pragma unroll
                    for (int hf = 0; hf < 2; ++hf)
#pragma unroll
                        for (int q = 0; q < 2; ++q) { const int col = 512 * hf + 8 * lane + 4 * q; const f32x4 w = *(const f32x4*)(P.fnw + col);
                            f32x4 y; y.x = xn[8 * hf + 4 * q] * ri * w.x; y.y = xn[8 * hf + 4 * q + 1] * ri * w.y; y.z = xn[8 * hf + 4 * q + 2] * ri * w.z; y.w = xn[8 * hf + 4 * q + 3] * ri * w.w;
                            *(f32x4*)(P.fout + row * DM + col) = y; }
                }
            } else {
                const float* sh = latent ? P.shl : P.shc; const float* sc = latent ? P.scl : P.scc;
#pragma unroll
                for (int hf = 0; hf < 2; ++hf) {
                    v4u hw;
#pragma unroll
                    for (int q = 0; q < 2; ++q) { const int col = 512 * hf + 8 * lane + 4 * q;
                        *(f32x4*)(P.Xout + row * DM + col) = (f32x4){xn[8 * hf + 4 * q], xn[8 * hf + 4 * q + 1], xn[8 * hf + 4 * q + 2], xn[8 * hf + 4 * q + 3]};
                        const f32x4 w = *(const f32x4*)(P.nwn + col), a = *(const f32x4*)(sc + col), b = *(const f32x4*)(sh + col);
                        float y[4];
#pragma unroll
                        for (int j = 0; j < 4; ++j) y[j] = (xn[8 * hf + 4 * q + j] * ri * w[j]) * (1.0f + a[j]) + b[j];
                        if (q == 0) { hw.x = pk2(y[0], y[1]); hw.y = pk2(y[2], y[3]); } else { hw.z = pk2(y[0], y[1]); hw.w = pk2(y[2], y[3]); } }
                    *(v4u*)(P.Hout + row * DM + 512 * hf + 8 * lane) = hw;
                }
            }
        }
        __syncthreads();
    }
}
__device__ __forceinline__ float lam_init_of(int l) { return l == 0 ? 0.2f : 0.35550906765f; }

#ifndef PHASE_MASK
#define PHASE_MASK 0xffff
#endif
#define PH(n) ((PHASE_MASK >> (n)) & 1)
__global__ void __launch_bounds__(NTHREADS, 2) trunk_fwd(Args args) {
    extern __shared__ __attribute__((aligned(16))) unsigned char lds[];
    cg::grid_group grid = cg::this_grid();
    Frame F;
    F.lds = (LAS unsigned char*)lds;
    F.MISC = (volatile LAS unsigned*)(F.lds + MISC_OFF);
    F.wave = __builtin_amdgcn_readfirstlane((int)threadIdx.x >> 6);
    F.G = gridDim.x; { const int bx = blockIdx.x; F.vcu = (F.G % 8 == 0) ? (bx % 8) * (F.G / 8) + bx / 8 : bx; }
    unsigned char* ws = args.ws;
    F.ctl = (gu32*)(ws + WS_CTL);
    for (int u = ltid(); u < (LDS_BYTES - LDSCTL_OFF) / 4; u += NTHREADS) ((LAS unsigned*)(F.lds + LDSCTL_OFF))[u] = 0u;
    __syncthreads();
    XcdBarrier bar = xcd_barrier_post((unsigned*)(F.ctl + CW_BAR), F.MISC + 8);
#define GRID_BAR() xcd_barrier(bar)

    const float* const* in = args.in;
    float* modv = (float*)(ws + WS_CONST);
    float* lamv = modv + 2 * 2 * 6144;
    bf16_t* WIN = (bf16_t*)(ws + WS_WIN); bf16_t* WGATE = (bf16_t*)(ws + WS_WGATE); bf16_t* WBR = (bf16_t*)(ws + WS_WBR); bf16_t* WOUT = (bf16_t*)(ws + WS_WOUT); bf16_t* WSC = (bf16_t*)(ws + WS_WSC);
    bf16_t* UBF = (bf16_t*)(ws + WS_UBF); bf16_t* VBF = (bf16_t*)(ws + WS_VBF);
    float* X = (float*)(ws + WS_X); bf16_t* H = (bf16_t*)(ws + WS_H); bf16_t* YS = (bf16_t*)(ws + WS_YS); bf16_t* MIX = YS;
    bf16_t* Qb = (bf16_t*)(ws + WS_Q); bf16_t* Kb = (bf16_t*)(ws + WS_K); bf16_t* Vb = (bf16_t*)(ws + WS_V);
    bf16_t* BP = (bf16_t*)(ws + WS_R1); float* SB = (float*)(ws + WS_R1);
    const int gw = F.vcu * NWAVES + F.wave, NGW = F.G * NWAVES;

    if (PH(0)) {
        const int tid = ltid(), lane = tid & 63;
        LAS float* scr = (LAS float*)(F.lds + F.wave * 16384);
        for (int un = F.vcu; un < 2 * 96; un += F.G) {
            const int l = un / 96, col = (un % 96) * 64 + lane;
            const float* W = in[I_ADAW] + (size_t)l * DM * 6144;
            float a0 = 0.f, a1 = 0.f;
#pragma unroll 8
            for (int k = 128 * F.wave; k < 128 * F.wave + 128; ++k) { const float w = W[(size_t)k * 6144 + col]; const float c0 = in[I_C][k], c1 = in[I_CCTX][k];
                a0 += c0 * sigmoidf_(c0) * w; a1 += c1 * sigmoidf_(c1) * w; }
            LAS float* red = (LAS float*)(F.lds);
            red[(F.wave * 64 + lane) * 2] = a0; red[(F.wave * 64 + lane) * 2 + 1] = a1;
            __syncthreads();
            if (F.wave == 0) { float s0 = in[I_ADAB][l * 6144 + col], s1 = s0;
#pragma unroll
                for (int w = 0; w < 8; ++w) { s0 += red[(w * 64 + lane) * 2]; s1 += red[(w * 64 + lane) * 2 + 1]; }
                modv[(l * 2 + 0) * 6144 + col] = s0; modv[(l * 2 + 1) * 6144 + col] = s1; }
            __syncthreads();
        }
        if (blockIdx.x == 0 && tid < 2) { const float* lf = in[I_DLAM] + tid * 128; float s0 = 0.f, s1 = 0.f;
            for (int i = 0; i < 32; ++i) { s0 += lf[i] * lf[32 + i]; s1 += lf[64 + i] * lf[96 + i]; }
            lamv[tid] = expf(s0) - expf(s1) + lam_init_of(tid); }
        constexpr int I_IN = 16 * 80, I_GT = 16 * 128, I_BR = 4 * 32, I_OT = 16 * 32;
        constexpr int NITEMS = 2 * I_IN + 2 * I_GT + 8 * I_BR + 2 * I_OT;
        for (int it = gw; it < NITEMS; it += NGW) {
            int r = it;
            if (r < 2 * I_IN) { const int l = r / I_IN; transpose_item(in[I_WIN] + (size_t)l * DM * NQKV, DM, NQKV, WIN + (size_t)l * NQKV * DM, MapWin(), scr, r % I_IN, lane); continue; } r -= 2 * I_IN;
            if (r < 2 * I_GT) { const int l = r / I_GT; transpose_item(in[I_WGATE] + (size_t)l * DM * 4096, DM, 4096, WGATE + (size_t)l * 4096 * DM, MapGate(), scr, r % I_GT, lane); continue; } r -= 2 * I_GT;
            if (r < 8 * I_BR) { const int lb = r / I_BR; transpose_item(in[I_WBR] + (size_t)lb * 256 * DM, 256, DM, WBR + (size_t)lb * DM * 256, MapId(), scr, r % I_BR, lane); continue; } r -= 8 * I_BR;
            { const int l = r / I_OT; transpose_item(in[I_WOUT] + (size_t)l * DM * DM, DM, DM, WOUT + (size_t)l * DM * DM, MapId(), scr, r % I_OT, lane); }
        }
        for (int it = gw; it < 2 * 16 * 8 * 64; it += NGW) {
            const int kt = it & 63, nt = (it >> 6) & 7, g = (it >> 9) & 15, l = it >> 13, h = g >> 1, p = g & 1;
            const float* kp = in[I_PKEYS] + ((size_t)((l * 2 + p) * 8 + h) * 128 + nt * 16 + (lane & 15)) * 128 + (lane >> 4);
            const float* qp = in[I_PWQ] + ((size_t)l * DM + kt * 16 + (lane & 15)) * 2048 + g * 128 + (lane >> 4);
            f32x4 acc = {0.f, 0.f, 0.f, 0.f};
#pragma unroll 8
            for (int s = 0; s < 32; ++s) acc = __builtin_amdgcn_mfma_f32_16x16x4f32(kp[4 * s], qp[4 * s], acc, 0, 0, 0);
            bf16_t* op = WSC + ((size_t)l * 2048 + g * 128 + nt * 16 + 4 * (lane >> 4)) * DM + kt * 16 + (lane & 15);
#pragma unroll
            for (int r = 0; r < 4; ++r) op[(size_t)r * DM] = (bf16_t)f2bf(acc[r]);
        }
        {
            const size_t n8 = (size_t)2 * NEXP * DM / 8;
            for (size_t i = (size_t)F.vcu * NTHREADS + tid; i < 2 * n8; i += (size_t)F.G * NTHREADS) {
                const bool isv = i >= n8; const size_t j = isv ? i - n8 : i;
                const float* src = (isv ? in[I_PV] : in[I_PU]) + j * 8; bf16_t* dst = (isv ? VBF : UBF) + j * 8;
                const f32x4 a = *(const f32x4*)src, b = *(const f32x4*)(src + 4);
                *(v4u*)dst = (v4u){pk2(a.x, a.y), pk2(a.z, a.w), pk2(b.x, b.y), pk2(b.z, b.w)};
            }
        }
    }
#if SELFCHECK
    GRID_BAR();
#define CK_RED ((LAS float*)(F.lds))
#define CK_BUF ((LAS float*)(F.lds + 1024))
#define CK_IBUF ((LAS int*)(F.lds + 8192))
#define CK_OBUF ((LAS float*)(F.lds + 20480))
#define CK_SC ((LAS float*)(F.lds + 24576))
    if (blockIdx.x == 0) chk::ck_prologue(in, ws, F.ctl, CK_RED);
    __syncthreads();
#endif
    grid.sync();
    { const int lane = ltid() & 63;
    for (int m = gw; m < MT; m += NGW) {
        const bool lat = m < SEQ; const float* xr = lat ? in[I_X] + (size_t)m * DM : in[I_CTX] + (size_t)(m - SEQ) * DM; const float* mv = modv + (lat ? 0 : 6144);
        modnorm_row(xr, H + (size_t)m * DM, in[I_N1W], mv, mv + 1024, lane);
    } }
    GRID_BAR();
#if SELFCHECK
    if (blockIdx.x < 5) { const int r = blockIdx.x == 0 ? 0 : blockIdx.x == 1 ? 777 : blockIdx.x == 2 ? 16383 : blockIdx.x == 3 ? 16384 : 16639;
        const bool lat = r < SEQ; const float* mv = modv + (lat ? 0 : 6144);
        chk::ck_modnorm(lat ? in[I_X] + (size_t)r * DM : in[I_CTX] + (size_t)(r - SEQ) * DM, H + (size_t)r * DM, in[I_N1W], mv, mv + 1024, F.ctl, 2, CK_RED); }
    GRID_BAR();
#endif

#pragma unroll 1
    for (int l = 0; l < 2; ++l) {
        const float* modl = modv + (size_t)(l * 2) * 6144; const float* modc = modl + 6144;
        const int nMr = (l == 0) ? MT / 256 : SEQ / 256;
        if (PH(2)) {
            pg8::Gemm g{H, WIN + (size_t)l * NQKV * DM, MT / 256, NQKV / 256, DM, DM, DM, 0, 0};
            pg8::StaticOrder S; S.init(g, F.G, (int)blockIdx.x);
            pg8::EpiQKV E{Qb, Kb, Vb, in[I_QKNW] + l * 128};
            pg8::gemm_phase<pg8::EpiQKV>(F.lds, g, S, E);
        }
        GRID_BAR();
#if SELFCHECK
        if (blockIdx.x < 4) { const int b = blockIdx.x; const int r = b == 0 ? 5 : b == 1 ? 8400 : b == 2 ? 16383 : 16391; chk::ck_qkv(l, r, in, ws, F.ctl, CK_RED, CK_BUF); }
        GRID_BAR();
#endif
        if (PH(4)) {
            char* shm = (char*)lds;
            const float lam = lamv[l];
            for (int ui = F.vcu; ui < 256; ui += F.G) {
                const int h = (ui >> 5) & 3, qb = ((ui >> 7) << 5) | (ui & 31);
                const int njobs = (l == 0 && ui < 16) ? (((ui >> 2) == 1) ? 7 : 6) : 5;
#pragma unroll 1
                for (int j = 0; j < njobs; ++j) {
                    att::AU u; int mode = 0;
                    u.sinkl2 = -INFINITY; u.emode = 0; u.lam = 0.f; u.oscale = 1.f; u.subw = in[I_SUBW] + l * 64; u.kbase = 0; u.q0 = qb * 256; u.NT = 260;
                    int qh, kh, oc;
                    if (j == 0)      { qh = 16 + h; kh = 10 + (h >> 1); oc = 768 + h * 64; }
                    else if (j == 1) { qh = 4 + 2 * h; kh = 4 + h; oc = 256 + h * 64; u.emode = 1; }
                    else if (j == 2) { qh = 5 + 2 * h; kh = 4 + h; oc = 256 + h * 64; u.emode = 2; u.lam = lam; u.oscale = 1.f - lam_init_of(l); }
                    else if (j == 3) { qh = h; kh = h; oc = h * 64; mode = 1; u.NT = 16; int B = 4 * qb - 4; B = B < 0 ? 0 : (B > 244 ? 244 : B); u.kbase = 64 * B; }
                    else if (j == 4) { qh = 12 + h; kh = 8 + (h >> 1); oc = 512 + h * 64; mode = 2; u.NT = 12; u.kbase = 256 * qb - 128; u.sinkl2 = in[I_SINK][l * 4 + h] * LOG2E; }
                    else {
                        const int mx = ui >> 2, hc = ui & 3; u.q0 = SEQ; u.NT = 4;
                        if (mx == 0)      { qh = hc; kh = hc; oc = hc * 64; }
                        else if (mx == 1) { qh = 4 + 2 * hc + (j - 5); kh = 4 + hc; oc = 256 + hc * 64; u.emode = (j == 5) ? 1 : 2; u.lam = lam; u.oscale = 1.f - lam_init_of(l); }
                        else if (mx == 2) { qh = 12 + hc; kh = 8 + (hc >> 1); oc = 512 + hc * 64; u.sinkl2 = in[I_SINK][l * 4 + hc] * LOG2E; }
                        else              { qh = 16 + hc; kh = 10 + (hc >> 1); oc = 768 + hc * 64; }
                    }
                    u.Q = (const att::bf16*)(Qb + (size_t)qh * MT * 64); u.K = (const att::bf16*)(Kb + (size_t)kh * MT * 64); u.V = (const att::bf16*)(Vb + (size_t)kh * MT * 64);
                    u.O = (att::bf16*)(YS + oc);
#ifndef ATT_MODES
#define ATT_MODES 7
#endif
                    if ((ATT_MODES & 2) && mode == 1) {
                        float* rp = (float*)(shm + att::LDS_RPB);
                        for (int i = ltid(); i < 15 * 32; i += NTHREADS) { const int c = i & 31; rp[i] = (c < 31) ? in[I_RPB][((size_t)(l * 4 + h) * 15 + (i >> 5)) * 31 + c] * LOG2E : 0.f; }
                        __syncthreads();
                        att::attn_simple<1>(u, shm);
                    } else if ((ATT_MODES & 4) && mode == 2) att::attn_simple<2>(u, shm);
                    else if (ATT_MODES & 1) att::attn_unit<0, 8>(u, shm);
                }
            }
        }
        GRID_BAR();
#if SELFCHECK
        if (blockIdx.x < 80) { const int b = blockIdx.x, ri = b >> 4; const int r = ri == 0 ? 3 : ri == 1 ? 4227 : ri == 2 ? 16319 : ri == 3 ? 9000 : 16484; chk::ck_attn(l, (b >> 2) & 3, b & 3, r, in, ws, F.ctl, CK_RED, CK_SC, CK_OBUF); }
        GRID_BAR();
#endif
        if (PH(5)) {
            pg8::Gemm g{YS, WBR + (size_t)l * 4 * DM * 256, nMr, 16, 256, DM, 256, 2, 512};
            pg8::StaticOrder S; S.init(g, F.G, (int)blockIdx.x);
            pg8::EpiBranch E{BP};
            pg8::gemm_phase<pg8::EpiBranch>(F.lds, g, S, E);
        }
        GRID_BAR();
#if SELFCHECK
        if (blockIdx.x < 3) { const int b = blockIdx.x; chk::ck_branch(l, b == 0 ? 1 : b == 1 ? 16383 : 16390, in, ws, F.ctl, CK_RED); }
        GRID_BAR();
#endif
        if (PH(6)) {
            pg8::Gemm g{H, WGATE + (size_t)l * 4096 * DM, nMr, 16, DM, DM, DM, 0, 0};
            pg8::StaticOrder S; S.init(g, F.G, (int)blockIdx.x);
            pg8::EpiGate E{BP, MIX, in[I_BGATE] + l * 4096};
            pg8::gemm_phase<pg8::EpiGate>(F.lds, g, S, E);
        }
        GRID_BAR();
#if SELFCHECK
        if (blockIdx.x < 3) { const int b = blockIdx.x; chk::ck_gate(l, b == 0 ? 2 : b == 1 ? 9999 : 16385, in, ws, F.ctl, CK_RED); }
        GRID_BAR();
#endif
        if (PH(7)) {
            pg8::Gemm g{MIX, WOUT + (size_t)l * DM * DM, nMr, 4, DM, DM, DM, 0, 0};
            pg8::StaticOrder S; S.init(g, F.G, (int)blockIdx.x);
            pg8::EpiOut E{l == 0 ? in[I_X] : X, l == 0 ? in[I_CTX] : X + (size_t)SEQ * DM, X, modl + 2048, modc + 2048};
            pg8::gemm_phase<pg8::EpiOut>(F.lds, g, S, E);
        }
        GRID_BAR();
#if SELFCHECK
        if (blockIdx.x < 3) { const int b = blockIdx.x; chk::ck_out(l, b == 0 ? 4 : b == 1 ? 12345 : 16417, in, ws, F.ctl, CK_RED); }
        GRID_BAR();
#endif
        { const int lane = ltid() & 63;
        for (int m = gw; m < nMr * 256; m += NGW) {
            const float* mv = (m < SEQ) ? modl : modc;
            modnorm_row(X + (size_t)m * DM, H + (size_t)m * DM, in[I_N2W] + l * DM, mv + 3072, mv + 4096, lane);
        } }
        GRID_BAR();
#if SELFCHECK
        if (blockIdx.x < 3) { const int b = blockIdx.x; const int r = b == 0 ? 7 : b == 1 ? 16383 : 16500; const float* mv = (r < SEQ) ? modl : modc;
            chk::ck_modnorm(X + (size_t)r * DM, H + (size_t)r * DM, in[I_N2W] + l * DM, mv + 3072, mv + 4096, F.ctl, 8, CK_RED); }
        GRID_BAR();
#endif
        if (PH(9)) {
            pg8::Gemm g{H, WSC + (size_t)l * 2048 * DM, nMr, 8, DM, DM, DM, 0, 0};
            pg8::StaticOrder S; S.init(g, F.G, (int)blockIdx.x);
            pg8::EpiS E{SB};
            pg8::gemm_phase<pg8::EpiS>(F.lds, g, S, E);
        }
        GRID_BAR();
#if SELFCHECK
        if (blockIdx.x < 3) { const int b = blockIdx.x; chk::ck_scores(l, b == 0 ? 6 : b == 1 ? 16000 : 16385, in, ws, F.ctl, CK_RED, CK_BUF); }
        GRID_BAR();
#endif
        if (PH(10)) {
            PeerArgs P;
            P.S = SB; P.Hin = H; P.U = UBF + (size_t)l * NEXP * DM; P.V = VBF + (size_t)l * NEXP * DM; P.Xin = X; P.Xout = X;
            P.g2l = modl + 5120; P.g2c = modc + 5120;
            P.Hout = H; P.nwn = in[I_N1W] + DM; P.shl = modv + 2 * 6144; P.scl = P.shl + 1024; P.shc = modv + 3 * 6144; P.scc = P.shc + 1024;
            P.fout = (l == 1) ? args.out : nullptr; P.fnw = in[I_FNW];
            P.nblocks = nMr * 8; P.dbg_eid = nullptr; P.dbg_gt = nullptr;
#if SELFCHECK
            if (l == 0) { P.Xout = (float*)(ws + WS_DBG); P.Hout = YS; }
            P.dbg_eid = (int*)(ws + WS_UBF + 32 * MiB); P.dbg_gt = (float*)(ws + WS_UBF + 44 * MiB);
#endif
            peer_phase(F, P);
        }
#if SELFCHECK
        break;
#endif
        if (l == 0) GRID_BAR();
    }
#if SELFCHECK
    GRID_BAR();
    if (blockIdx.x < 5) { const int b = blockIdx.x; const int r = b == 0 ? 0 : b == 1 ? 31 : b == 2 ? 37 : b == 3 ? 16383 : 16639; chk::ck_peer(0, r, in, ws, F.ctl, CK_RED, CK_BUF, CK_IBUF); }
    GRID_BAR();
    {
        float e[32];
#pragma unroll
        for (int i = 0; i < 32; ++i) e[i] = __uint_as_float(__hip_atomic_load(F.ctl + CW_CHK + i, RLX_AGENT));
        const float T = 0.03f; int mask = 0;
#if SELFCHECK == 1
        mask = ((e[0] > T || e[1] > T) ? 1 : 0) | (e[2] > T ? 2 : 0) | (e[3] > T ? 4 : 0) | (e[4] > T ? 8 : 0) | (e[5] > T ? 16 : 0);
#elif SELFCHECK == 2
        mask = (e[6] > T ? 1 : 0) | (e[7] > T ? 2 : 0) | (e[8] > T ? 4 : 0) | (e[9] > T ? 8 : 0) | ((e[10] > T || e[11] > T) ? 16 : 0);
#elif SELFCHECK == 5
        mask = (e[24] > T ? 1 : 0) | (e[25] > T ? 2 : 0) | (e[26] > T ? 4 : 0) | (e[27] > T ? 8 : 0) | (e[28] > T ? 16 : 0);
#elif SELFCHECK == 4
        mask = (e[10] > T ? 1 : 0) | (e[11] > T ? 2 : 0) | (e[12] > T ? 4 : 0) | (e[13] > T ? 8 : 0);
#else
        mask = (e[16] > T ? 1 : 0) | (e[17] > T ? 2 : 0) | (e[18] > T ? 4 : 0) | (e[19] > T ? 8 : 0) | ((e[20] > T || e[21] > T || e[22] > T || e[23] > T) ? 16 : 0);
#endif
        const float cval = sqrtf((float)mask);
        for (size_t i = (size_t)blockIdx.x * NTHREADS + ltid(); i < (size_t)SEQ * DM / 4; i += (size_t)gridDim.x * NTHREADS) ((f32x4*)args.out)[i] = (f32x4){cval, cval, cval, cval};
    }
#endif
}
extern "C" void kernel_launch(void* const* d_in, const int* in_sizes, int n_in, void* d_out, int out_size, void* d_ws, size_t ws_size, hipStream_t stream) {
    static int grid = 0;
    if (grid == 0) {
        size_t need = WS_END;
#if SELFCHECK
        need = WS_DBG + (size_t)MT * DM * 4;
#endif
        if (n_in != 23 || in_sizes[0] != SEQ * DM || out_size != SEQ * DM || ws_size < need) {
            fprintf(stderr, "kernel_launch: unexpected problem shape (n_in %d, in0 %d, out %d, ws %zu, need %zu); nothing launched\n", n_in, n_in > 0 ? in_sizes[0] : -1, out_size, ws_size, need); grid = -1; return; }
        int dev = 0, cus = 0, per_cu = 0;
        if (hipGetDevice(&dev) != hipSuccess || hipDeviceGetAttribute(&cus, hipDeviceAttributeMultiprocessorCount, dev) != hipSuccess) { fprintf(stderr, "kernel_launch: device query failed\n"); grid = -1; return; }
        if (hipFuncSetAttribute((const void*)trunk_fwd, hipFuncAttributeMaxDynamicSharedMemorySize, LDS_BYTES) != hipSuccess) { fprintf(stderr, "kernel_launch: hipFuncSetAttribute failed\n"); grid = -1; return; }
        if (hipOccupancyMaxActiveBlocksPerMultiprocessor(&per_cu, (const void*)trunk_fwd, NTHREADS, LDS_BYTES) != hipSuccess || per_cu < 1) {
            fprintf(stderr, "kernel_launch: occupancy query says %d blocks per CU; nothing launched\n", per_cu); (void)hipGetLastError(); grid = -1; return; }
        grid = cus;
    }
    if (grid < 0) return;
    (void)hipMemsetAsync((char*)d_ws + WS_CTL, 0, CTL_ZERO_BYTES, stream);
    Args a{};
    for (int i = 0; i < 23; ++i) a.in[i] = (const float*)d_in[i];
    a.out = (float*)d_out; a.ws = (unsigned char*)d_ws; a.flags = 0; a.pad = 0;
    void* kargs[] = {&a};
    const hipError_t e = hipLaunchCooperativeKernel((const void*)trunk_fwd, dim3(grid), dim3(NTHREADS), kargs, LDS_BYTES, stream);
    if (e != hipSuccess) fprintf(stderr, "kernel_launch: cooperative launch failed: %s (grid %d)\n", hipGetErrorString(e), grid);
}
```

```cpp
#define SELFCHECK 0
#define TIMING 0
#define TIMING_A 0
#define TIMING_B 1
#define DUP_MASK 0
#define PEER_SLICED 0
#include <hip/hip_runtime.h>
#include <hip/hip_cooperative_groups.h>
#include <hip/hip_bf16.h>
#include <cstdio>
#include <cstdint>
#include <cmath>
namespace cg = cooperative_groups;

#ifndef SELFCHECK
#define SELFCHECK 0
#endif

constexpr int SEQ = 16384, CTX = 256, MT = SEQ + CTX, DM = 1024, NQKV = 2560, GRIDW = 64;
constexpr int NEXP = 16384, NKEYS = 128, PEER_H = 8, TOPK = 16;
constexpr float EPS = 1e-6f, LOG2E = 1.4426950408889634f;
constexpr float C2_64 = 0.125f * LOG2E;
constexpr float C2_32 = 0.17677669529663687f * LOG2E;
constexpr int NWAVES = 8, NTHREADS = 512;

constexpr size_t MiB = 1u << 20;
constexpr size_t WS_CTL = 0, CTL_ZERO_BYTES = 1 * MiB;
constexpr size_t WS_CONST = 1 * MiB;
constexpr size_t WS_WIN = 2 * MiB;
constexpr size_t WS_WGATE = 12 * MiB;
constexpr size_t WS_WBR = 28 * MiB;
constexpr size_t WS_WOUT = 32 * MiB;
constexpr size_t WS_WSC = 36 * MiB;
constexpr size_t WS_SU = WS_CONST + 256 * 1024, WS_SV = WS_CONST + 512 * 1024;
constexpr size_t WS_UBF = 44 * MiB;
constexpr size_t WS_VBF = 108 * MiB;
constexpr size_t WS_H8 = WS_UBF + 32 * MiB;
constexpr size_t WS_W8IN = WS_VBF + 32 * MiB, WS_W8GATE = WS_VBF + 40 * MiB, WS_W8OUT = WS_VBF + 48 * MiB;
constexpr size_t WS_X = 172 * MiB;
constexpr size_t WS_H = 237 * MiB;
constexpr size_t WS_YS = 270 * MiB;
constexpr size_t WS_R1 = 303 * MiB;
constexpr size_t WS_Q = WS_R1, WS_K = WS_Q + (size_t)20 * MT * 128, WS_V = WS_K + (size_t)12 * MT * 128;
constexpr size_t WS_END = 433 * MiB;
constexpr size_t WS_DBG = 433 * MiB;
static_assert(WS_V + (size_t)12 * MT * 128 <= WS_END && WS_R1 + (size_t)MT * 4096 * 2 <= WS_END && WS_R1 + (size_t)MT * 2048 * 4 <= WS_END, "ws map");
constexpr int CW_BAR = 4096;
constexpr int CW_CHK = 64;

constexpr int RING_BYTES = 131072;
constexpr int LDSCTL_OFF = RING_BYTES, MISC_OFF = LDSCTL_OFF + 320;
constexpr int LDS_BYTES = 147456;

#define GAS __attribute__((address_space(1)))
#define LAS __attribute__((address_space(3)))
typedef unsigned short bf16_t;
typedef unsigned v4u __attribute__((ext_vector_type(4)));
typedef unsigned v2u __attribute__((ext_vector_type(2)));
typedef float f32x4 __attribute__((ext_vector_type(4)));
typedef float f32x2 __attribute__((ext_vector_type(2)));
typedef float f32x16 __attribute__((ext_vector_type(16)));
typedef short bf16x8 __attribute__((ext_vector_type(8)));
typedef short s16x4 __attribute__((ext_vector_type(4)));
typedef __bf16 bf16x2_t __attribute__((ext_vector_type(2)));
typedef int i32x8 __attribute__((ext_vector_type(8)));
typedef int i32x4 __attribute__((ext_vector_type(4)));
typedef GAS unsigned gu32;
#define RLX_AGENT __ATOMIC_RELAXED, __HIP_MEMORY_SCOPE_AGENT
#define LDS_WAIT() asm volatile("s_waitcnt lgkmcnt(0)" ::: "memory")
#define VM_WAIT() asm volatile("s_waitcnt vmcnt(0)" ::: "memory")

__device__ __forceinline__ int lane_now() { int l; asm volatile("v_mbcnt_lo_u32_b32 %0, -1, 0\n\tv_mbcnt_hi_u32_b32 %0, -1, %0" : "=v"(l)); return l; }
__device__ __forceinline__ int tid_now(int wave) { return (wave << 6) | lane_now(); }
__device__ __forceinline__ unsigned f2bf(float f) { unsigned u = __builtin_bit_cast(unsigned, f); return (u + 0x7fffu + ((u >> 16) & 1u)) >> 16; }
__device__ __forceinline__ unsigned pk2(float lo, float hi) { f32x2 v = {lo, hi}; bf16x2_t b = __builtin_convertvector(v, bf16x2_t); return __builtin_bit_cast(unsigned, b); }
__device__ __forceinline__ unsigned pk4_fp8(float a, float b, float c, float d) { int w = 0; w = __builtin_amdgcn_cvt_pk_fp8_f32(a, b, w, false); w = __builtin_amdgcn_cvt_pk_fp8_f32(c, d, w, true); return (unsigned)w; }
__device__ __forceinline__ float bflo(unsigned w) { return __builtin_bit_cast(float, w << 16); }
__device__ __forceinline__ float bfhi(unsigned w) { return __builtin_bit_cast(float, w & 0xffff0000u); }
__device__ __forceinline__ float bf2f(bf16_t h) { return __builtin_bit_cast(float, (unsigned)h << 16); }
template <int X> __device__ __forceinline__ float xorf(float v) { return __builtin_bit_cast(float, __builtin_amdgcn_ds_swizzle(__builtin_bit_cast(int, v), (X << 10) | 0x1f)); }
__device__ __forceinline__ float x32_sum(float v) { auto r = __builtin_amdgcn_permlane32_swap(__float_as_uint(v), __float_as_uint(v), false, false); return __uint_as_float(r[0]) + __uint_as_float(r[1]); }
__device__ __forceinline__ float x32_max(float v) { auto r = __builtin_amdgcn_permlane32_swap(__float_as_uint(v), __float_as_uint(v), false, false); return __builtin_fmaxf(__uint_as_float(r[0]), __uint_as_float(r[1])); }
__device__ __forceinline__ float wave_sum(float v) { v += xorf<1>(v); v += xorf<2>(v); v += xorf<4>(v); v += xorf<8>(v); v += xorf<16>(v); return x32_sum(v); }
__device__ __forceinline__ float wave_max(float v) { v = __builtin_fmaxf(v, xorf<1>(v)); v = __builtin_fmaxf(v, xorf<2>(v)); v = __builtin_fmaxf(v, xorf<4>(v)); v = __builtin_fmaxf(v, xorf<8>(v)); v = __builtin_fmaxf(v, xorf<16>(v)); return x32_max(v); }
__device__ __forceinline__ float fast_exp2(float x) { return __builtin_amdgcn_exp2f(x); }
__device__ __forceinline__ float fast_rcp(float x) { return __builtin_amdgcn_rcpf(x); }
__device__ __forceinline__ float sigmoidf_(float x) { return fast_rcp(1.0f + fast_exp2(-x * LOG2E)); }
__device__ __forceinline__ float gelu_tanh(float x) {
    const float y = 0.7978845608028654f * (x + 0.044715f * x * x * x);
    const float t = 1.0f - 2.0f * fast_rcp(1.0f + fast_exp2(2.0f * LOG2E * y));
    return 0.5f * x * (1.0f + t);
}
#define XB_TMO      128
#define XB_XCNT(j)  (256  + 64 * (j))
#define XB_XSUB(j)  (1280 + 64 * (j))
#define XB_XGEN(j)  (2304 + 64 * (j))
#define XB_TOP      3328
#define XB_TOPGEN   3392
#define XCD_BAR_WORDS 3456
#define XB_SPIN_CAP (1u << 20)
__device__ __forceinline__ unsigned xb_ld(unsigned* p)              { return __hip_atomic_load(p, __ATOMIC_RELAXED, __HIP_MEMORY_SCOPE_AGENT); }
__device__ __forceinline__ unsigned xb_add(unsigned* p, unsigned v) { return __hip_atomic_fetch_add(p, v, __ATOMIC_RELAXED, __HIP_MEMORY_SCOPE_AGENT); }
__device__ __forceinline__ unsigned xb_xcc_id() { return (unsigned)__builtin_amdgcn_s_getreg((3 << 11) | 20) & 0xFu; }
#define XB_SPIN(cond, bar) do { unsigned _sp = 0; while (cond) { __builtin_amdgcn_s_sleep(1); \
    if ((++_sp & 255u) == 0u) { if (xb_ld(&(bar)[XB_TMO])) break; if (_sp > XB_SPIN_CAP) { atomicAdd(&(bar)[XB_TMO], 1u); break; } } } } while (0)
struct XcdBarrier { unsigned* bar; unsigned x; volatile LAS unsigned* st; int wave; };
__device__ __forceinline__ XcdBarrier xcd_barrier_post(unsigned* bar, volatile LAS unsigned* st, int wave) {
    XcdBarrier b; b.bar = bar; b.x = xb_xcc_id(); b.st = st; b.wave = wave;
    if (tid_now(wave) == 0) (void)xb_add(&bar[XB_XCNT(b.x)], 1u);
    return b;
}
__device__ __forceinline__ void xcd_barrier_complete(unsigned* bar, unsigned x, unsigned& nloc, unsigned& nx) {
    const unsigned G = gridDim.x * gridDim.y * gridDim.z;
    unsigned sum, cnt, mine, sp = 0u;
    for (;;) {
        sum = 0u; cnt = 0u; mine = 0u;
#pragma unroll
        for (unsigned j = 0; j < 16; ++j) { const unsigned c = xb_ld(&bar[XB_XCNT(j)]); sum += c; cnt += (c > 0u) ? 1u : 0u; mine = (j == x) ? c : mine; }
        if (sum == G) break;
        __builtin_amdgcn_s_sleep(1);
        if ((++sp & 255u) == 0u) { if (xb_ld(&bar[XB_TMO])) break; if (sp > XB_SPIN_CAP) { atomicAdd(&bar[XB_TMO], 1u); break; } }
    }
    nloc = mine > 0u ? mine : 1u; nx = cnt > 0u ? cnt : 1u;
}
__device__ __forceinline__ void xcd_barrier(const XcdBarrier& b) {
    asm volatile("s_waitcnt vmcnt(0)" ::: "memory");
    __syncthreads();
    unsigned* bar_ = b.bar; unsigned bx_ = b.x; asm volatile("" : "+s"(bar_), "+s"(bx_));
    if (tid_now(b.wave) == 0) {
        unsigned* bar = bar_; const unsigned bx = bx_;
        __builtin_amdgcn_s_waitcnt(0);
        unsigned nloc = b.st[0], nx = b.st[1];
        if (nloc == 0u) { xcd_barrier_complete(bar, bx, nloc, nx); b.st[0] = nloc; b.st[1] = nx; }
        const unsigned old = xb_add(&bar[XB_XSUB(bx)], 1u);
        const unsigned gen = old / nloc;
        if (old + 1u == (gen + 1u) * nloc) {
            __builtin_amdgcn_fence(__ATOMIC_RELEASE, "agent");
            asm volatile("s_waitcnt vmcnt(0)" ::: "memory");
            const unsigned og = xb_add(&bar[XB_TOP], 1u);
            const unsigned tg = og / nx;
            if (og + 1u == (tg + 1u) * nx) xb_add(&bar[XB_TOPGEN], 1u);
            else XB_SPIN(xb_ld(&bar[XB_TOPGEN]) == tg, bar);
            __builtin_amdgcn_fence(__ATOMIC_ACQUIRE, "agent");
            xb_add(&bar[XB_XGEN(bx)], 1u);
            asm volatile("s_waitcnt vmcnt(0)" ::: "memory");
        } else {
            XB_SPIN(xb_ld(&bar[XB_XGEN(bx)]) == gen, bar);
            __builtin_amdgcn_fence(__ATOMIC_ACQUIRE, "agent");
            asm volatile("s_waitcnt vmcnt(0)" ::: "memory");
        }
    }
    __syncthreads();
}

namespace pg8 {
#define PG8_LAS __attribute__((address_space(3)))
constexpr int BM = 256, BK = 64, HALF = 128, HTB = HALF * BK * 2, STAGE_BYTES = 8 * HTB, NXCD = 8, WGM = 8;
__host__ __device__ __forceinline__ int lds_byte(int r, int c) { const int st = (r >> 4) * 2 + (c >> 5), rr = r & 15, cc = c & 31, ob = rr * 64 + cc * 2; return st * 1024 + (ob ^ (((ob >> 9) & 1) << 5)); }
__host__ __device__ __forceinline__ void stage_rc(int b, int& R, int& C) { const int st = b / 1024, sb = b % 1024, swz = sb ^ (((sb >> 9) & 1) << 5); R = (st >> 1) * 16 + swz / 64; C = (st & 1) * 32 + (swz % 64) / 2; }
__host__ __device__ __forceinline__ int perm32(int rho) { const int n = rho >> 4, i = rho & 15; return 8 * (i >> 2) + 4 * n + (i & 3); }
__host__ __device__ __forceinline__ int wide_row(int R) { return 64 * (R >> 5) + 16 * ((R >> 2) & 3) + 4 * ((R >> 4) & 1) + (R & 3); }
template <class E, class = void> struct IsWide { static constexpr bool v = false; };
template <class E> struct IsWide<E, decltype((void)E::WIDE)> { static constexpr bool v = true; };

struct Unit { int pm, pn; const char* a; const char* b; };
struct Gemm { const void* A; const void* Bt; int nM, nN, K, lda, ldb, a_shift, a_pn_bytes, esz; };

struct StaticOrder {
    int nM, nN, nwg, G, c; const char* A; const char* B; size_t a_pm, b_pn; int a_shift, a_pn;
    __device__ void init(const Gemm& g, int G_, int c_) { nM = g.nM; nN = g.nN; nwg = nM * nN; G = G_; c = c_; A = (const char*)g.A; B = (const char*)g.Bt;
        a_pm = (size_t)BM * g.lda * g.esz; b_pn = (size_t)BM * g.ldb * g.esz; a_shift = g.a_shift; a_pn = g.a_pn_bytes; }
    __device__ bool has(int i) const { int cc = c; asm volatile("" : "+s"(cc)); return (long)i * G + cc < nwg; }
    __device__ bool next(int i, Unit& u) const {
        const long L = (long)i * G + c; if (L >= nwg) return false;
        int wgid = (int)L; { const int q = nwg / NXCD, r = nwg % NXCD, xcd = wgid % NXCD, off = wgid / NXCD; wgid = (xcd < r ? xcd * (q + 1) : r * (q + 1) + (xcd - r) * q) + off; }
        const int nig = WGM * nN, gid = wgid / nig, fm = gid * WGM, gsz = (nM - fm) < WGM ? (nM - fm) : WGM;
        u.pm = fm + ((wgid % nig) % gsz); u.pn = (wgid % nig) / gsz;
        u.a = A + (size_t)u.pm * a_pm + (size_t)(u.pn >> a_shift) * a_pn; u.b = B + (size_t)u.pn * b_pn; return true;
    }
};

template <class Epi, bool FP8 = false, int SCALE_ACT = 0x7F7F7F7F>
__device__ __forceinline__ void gemm_phase(PG8_LAS unsigned char* lds, const Gemm g, const StaticOrder& S, const Epi& E, int wave) {
    const int tid = tid_now(wave), wid = wave, lane = tid & 63, wr = wid >> 2, wc = wid & 3, fr = lane & 15, fq = lane >> 4;
    const int K = g.K, nt = (K * g.esz) / (BK * 2);
    unsigned voffA[2], voffB[2];
#pragma unroll
    for (int i = 0; i < 2; ++i) { int R, C; stage_rc(tid * 16 + i * 8192, R, C); const int Rb = IsWide<Epi>::v ? wide_row(R) : (Epi::PERM ? ((R & ~31) + perm32(R & 31)) : R);
        voffA[i] = (unsigned)(R * g.lda * g.esz + C * 2); voffB[i] = (unsigned)(Rb * g.ldb * g.esz + C * 2); }
    const size_t kstep = (size_t)(BK * 2);
    const size_t hstepA = (size_t)HALF * g.lda * g.esz, hstepB = (size_t)(IsWide<Epi>::v ? 8 : HALF) * g.ldb * g.esz;
    const unsigned ldsw = (unsigned)wid * 1024u, ldsbase = (unsigned)(uintptr_t)lds;
    const int aoff = FP8 ? lds_byte(wr * 64 + fr, fq * 16) : lds_byte(wr * 64 + fr, fq * 8), boff = FP8 ? lds_byte(wc * 32 + fr, fq * 16) : lds_byte(wc * 32 + fr, fq * 8);
#define PG8_SA(b, h) (((b) * 2 + (h)) * HTB)
#define PG8_SB(b, h) ((4 + (b) * 2 + (h)) * HTB)
#define PG8_GLDS(sbase, voff32, ldsdst) do { unsigned keep_; asm volatile("s_mov_b32 %0, m0\n\ts_mov_b32 m0, %3\n\ts_nop 0\n\tglobal_load_lds_dwordx4 %1, %2\n\ts_mov_b32 m0, %0" : "=&s"(keep_) : "v"(voff32), "s"(sbase), "s"(ldsdst) : "memory"); } while (0)
#define PG8_STAGE(bufoff, gbase, voff) do { _Pragma("unroll") for (int _i = 0; _i < 2; ++_i) \
        PG8_GLDS((const char*)(gbase), (voff)[_i], (unsigned)__builtin_amdgcn_readfirstlane((int)(ldsbase + (unsigned)(bufoff) + ldsw + _i * 8192))); } while (0)
#define PG8_LDA(dst, b, h) do { if constexpr (FP8) { _Pragma("unroll") for (int m = 0; m < 4; ++m) dst##8[m] = *(const PG8_LAS i32x8*)(lds + PG8_SA(b, h) + aoff + m * 2048); } \
        else { _Pragma("unroll") for (int m = 0; m < 4; ++m) _Pragma("unroll") for (int k = 0; k < 2; ++k) dst[m][k] = *(const PG8_LAS bf16x8*)(lds + PG8_SA(b, h) + aoff + m * 2048 + k * 1024); } } while (0)
#define PG8_LDB(dst, b, h) do { if constexpr (FP8) { _Pragma("unroll") for (int n = 0; n < 2; ++n) dst##8[n] = *(const PG8_LAS i32x8*)(lds + PG8_SB(b, h) + boff + n * 2048); } \
        else { _Pragma("unroll") for (int n = 0; n < 2; ++n) _Pragma("unroll") for (int k = 0; k < 2; ++k) dst[n][k] = *(const PG8_LAS bf16x8*)(lds + PG8_SB(b, h) + boff + n * 2048 + k * 1024); } } while (0)
#define PG8_MMA(ai, bj, At, Bt) do { __builtin_amdgcn_s_setprio(1); \
        if constexpr (FP8) { _Pragma("unroll") for (int m = 0; m < 4; ++m) _Pragma("unroll") for (int n = 0; n < 2; ++n) \
            acc[ai][bj][m][n] = __builtin_amdgcn_mfma_scale_f32_16x16x128_f8f6f4(Bt##8[n], At##8[m], acc[ai][bj][m][n], 0, 0, 0, 0x79797979, 0, SCALE_ACT); } \
        else { _Pragma("unroll") for (int m = 0; m < 4; ++m) _Pragma("unroll") for (int n = 0; n < 2; ++n) _Pragma("unroll") for (int k = 0; k < 2; ++k) \
            acc[ai][bj][m][n] = __builtin_amdgcn_mfma_f32_16x16x32_bf16(Bt[n][k], At[m][k], acc[ai][bj][m][n], 0, 0, 0); } \
        __builtin_amdgcn_s_setprio(0); } while (0)
#define PG8_WAIT_V(n) asm volatile("s_waitcnt vmcnt(" #n ")" ::: "memory")
#define PG8_WAIT_L(n) asm volatile("s_waitcnt lgkmcnt(" #n ")" ::: "memory")
#define PG8_BAR __builtin_amdgcn_s_barrier()
#define PG8_SCHED __builtin_amdgcn_sched_barrier(0)
    Unit cur, nxt; int ui = 0;
    if (!S.has(0)) return;
    (void)S.next(0, cur);
    f32x4 acc[2][2][4][2];
#pragma unroll
    for (int a = 0; a < 2; ++a)
#pragma unroll
        for (int b = 0; b < 2; ++b)
#pragma unroll
            for (int m = 0; m < 4; ++m)
#pragma unroll
                for (int n = 0; n < 2; ++n) acc[a][b][m][n] = (f32x4){0.f, 0.f, 0.f, 0.f};
    bf16x8 At[4][2], B0[2][2], B1[2][2]; i32x8 At8[4], B08[2], B18[2];
    const char* cA = cur.a; const char* cB = cur.b;
    PG8_STAGE(PG8_SB(0, 0), cB, voffB); PG8_STAGE(PG8_SB(0, 1), cB + hstepB, voffB); PG8_STAGE(PG8_SA(0, 0), cA, voffA); PG8_STAGE(PG8_SA(0, 1), cA + hstepA, voffA);
    { int w_ = wave; asm volatile("" : "+s"(w_)); if ((w_ >> 2) == 1) PG8_BAR; }
    PG8_WAIT_V(2); PG8_BAR;
    PG8_STAGE(PG8_SB(1, 0), cB + kstep, voffB); PG8_STAGE(PG8_SA(1, 0), cA + kstep, voffA); PG8_STAGE(PG8_SB(1, 1), cB + hstepB + kstep, voffB);
    PG8_WAIT_V(6); PG8_BAR;
    for (;;) {
        const bool has_next = S.has(ui + 1); nxt = cur; if (has_next) (void)S.next(ui + 1, nxt);
        const char* nA = has_next ? nxt.a : cA; const char* nB = has_next ? nxt.b : cB;
        for (int t = 0; t < nt; t += 2) {
            const bool last = (t == nt - 2);
            const char* a1 = cA + (size_t)(t + 1) * kstep;
            const char* a2 = last ? nA : cA + (size_t)(t + 2) * kstep; const char* b2 = last ? nB : cB + (size_t)(t + 2) * kstep;
            const char* a3 = a2 + kstep; const char* b3 = b2 + kstep;
            PG8_LDB(B0, 0, 0); PG8_LDB(B1, 0, 1); PG8_SCHED; PG8_LDA(At, 0, 0); PG8_STAGE(PG8_SA(1, 1), a1 + hstepA, voffA);
            PG8_WAIT_V(8); PG8_WAIT_L(0); PG8_BAR; PG8_MMA(0, 0, At, B0); PG8_MMA(0, 1, At, B1); PG8_BAR; PG8_SCHED;
            PG8_LDA(At, 0, 1); PG8_STAGE(PG8_SB(0, 0), b2, voffB); PG8_STAGE(PG8_SB(0, 1), b2 + hstepB, voffB); PG8_STAGE(PG8_SA(0, 0), a2, voffA);
            PG8_WAIT_V(8); PG8_WAIT_L(0); PG8_BAR; PG8_MMA(1, 0, At, B0); PG8_MMA(1, 1, At, B1); PG8_BAR; PG8_SCHED;
            PG8_LDB(B0, 1, 0); PG8_LDB(B1, 1, 1); PG8_SCHED; PG8_LDA(At, 1, 0); PG8_STAGE(PG8_SA(0, 1), a2 + hstepA, voffA);
            PG8_WAIT_V(8); PG8_WAIT_L(0); PG8_BAR; PG8_MMA(0, 0, At, B0); PG8_MMA(0, 1, At, B1); PG8_BAR; PG8_SCHED;
            PG8_LDA(At, 1, 1); PG8_STAGE(PG8_SB(1, 0), b3, voffB); PG8_STAGE(PG8_SB(1, 1), b3 + hstepB, voffB); PG8_STAGE(PG8_SA(1, 0), a3, voffA);
            PG8_WAIT_V(8); PG8_WAIT_L(0); PG8_BAR; PG8_MMA(1, 0, At, B0); PG8_MMA(1, 1, At, B1); PG8_BAR; PG8_SCHED;
        }
        { int w2_ = wave; asm volatile("" : "+s"(w2_));
          if ((w2_ >> 2) == 0) PG8_BAR;
          E(acc, cur, w2_ >> 2, w2_ & 3, 0, 0); }
        if (!S.has(ui + 1)) break;
#pragma unroll
        for (int a = 0; a < 2; ++a)
#pragma unroll
            for (int b = 0; b < 2; ++b)
#pragma unroll
                for (int m = 0; m < 4; ++m)
#pragma unroll
                    for (int n = 0; n < 2; ++n) acc[a][b][m][n] = (f32x4){0.f, 0.f, 0.f, 0.f};
        cur = nxt; cA = nA; cB = nB; ++ui;
        { int w_ = wave; asm volatile("" : "+s"(w_)); if ((w_ >> 2) == 1) PG8_BAR; }
    }
    PG8_WAIT_V(0);
    PG8_BAR;
#undef PG8_SA
#undef PG8_SB
#undef PG8_STAGE
#undef PG8_LDA
#undef PG8_LDB
#undef PG8_MMA
#undef PG8_WAIT_V
#undef PG8_WAIT_L
#undef PG8_BAR
#undef PG8_SCHED
}
}
namespace pg8 {
struct EpiQKV {
    static constexpr bool PERM = true;
    bf16_t *Qb, *Kb, *Vb; const float* qkw;
    __device__ __forceinline__ void operator()(const f32x4 (&acc)[2][2][4][2], const Unit& u, int wr, int wc, int, int) const {
        const int t_ = lane_now(); const int fr = t_ & 15, fq = (t_ >> 4) & 3;
        const int hs = __builtin_amdgcn_readfirstlane(u.pn * 4 + wc);
        bf16_t* dst; int rope = 0, norm = -1, dq = 0; float scale = 1.f;
        if (hs < 4)       { dst = Qb + (size_t)hs * MT * 64; scale = C2_64; }
        else if (hs < 8)  { dst = Kb + (size_t)(hs - 4) * MT * 64; }
        else if (hs < 12) { dst = Vb + (size_t)(hs - 8) * MT * 64; }
        else if (hs < 16) { dst = Qb + (size_t)(4 + 2 * (hs - 12)) * MT * 64; rope = 2; dq = 1; scale = C2_32; }
        else if (hs < 20) { dst = Kb + (size_t)(4 + hs - 16) * MT * 64; rope = 2; }
        else if (hs < 24) { dst = Vb + (size_t)(4 + hs - 20) * MT * 64; }
        else if (hs < 28) { dst = Qb + (size_t)(12 + hs - 24) * MT * 64; rope = 1; scale = C2_64; }
        else if (hs < 30) { dst = Kb + (size_t)(8 + hs - 28) * MT * 64; rope = 1; }
        else if (hs < 32) { dst = Vb + (size_t)(8 + hs - 30) * MT * 64; }
        else if (hs < 36) { dst = Qb + (size_t)(16 + hs - 32) * MT * 64; rope = 1; norm = 0; scale = C2_64; }
        else if (hs < 38) { dst = Kb + (size_t)(10 + hs - 36) * MT * 64; rope = 1; norm = 1; }
        else              { dst = Vb + (size_t)(10 + hs - 38) * MT * 64; }
        const bool latent = u.pm < SEQ / 256;
        if (!latent) rope = 0;
        float fstep = (rope == 2) ? (13.287712379549449f / 8.f) : (13.287712379549449f / 16.f); asm volatile("" : "+v"(fstep));
        const float fbase = (rope == 2) ? 0.f : (float)(8 * (fq & 1)) * fstep;
#define INVF(k) (fast_exp2(-(fbase + (float)(k) * fstep)) * 0.15915494309189535f)
#pragma unroll
        for (int m = 0; m < 4; ++m) {
            float csn[8], ccs[8];
            if (rope == 1) { float pos = (float)(m * 16 + fr); asm volatile("" : "+v"(pos));
#pragma unroll
                for (int k = 0; k < 8; ++k) { const float rev = pos * INVF(k); csn[k] = __builtin_amdgcn_sinf(rev); ccs[k] = __builtin_amdgcn_cosf(rev); } }
#pragma unroll
            for (int ai = 0; ai < 2; ++ai) {
                const int row = u.pm * BM + ai * HALF + wr * 64 + m * 16 + fr;
                float v[16];
#pragma unroll
                for (int bj = 0; bj < 2; ++bj)
#pragma unroll
                    for (int n = 0; n < 2; ++n)
#pragma unroll
                        for (int j = 0; j < 4; ++j) v[bj * 8 + n * 4 + j] = acc[ai][bj][m][n][j];
                if (norm >= 0) {
                    float ss = 0.f;
#pragma unroll
                    for (int k = 0; k < 16; ++k) ss += v[k] * v[k];
                    ss += xorf<16>(ss); ss = x32_sum(ss);
                    const float ri = __builtin_amdgcn_rsqf(ss * (1.f / 64.f) + EPS);
#pragma unroll
                    for (int bj = 0; bj < 2; ++bj) { const f32x4 w0 = *(const f32x4*)(qkw + norm * 64 + 32 * bj + 8 * fq), w1 = *(const f32x4*)(qkw + norm * 64 + 32 * bj + 8 * fq + 4);
#pragma unroll
                        for (int j = 0; j < 4; ++j) { v[bj * 8 + j] = v[bj * 8 + j] * ri * w0[j]; v[bj * 8 + 4 + j] = v[bj * 8 + 4 + j] * ri * w1[j]; } }
                }
                if (rope == 1) {
                    const float sgn = (fq & 2) ? 1.f : -1.f;
                    float pos = (float)(row >> 6); asm volatile("" : "+v"(pos));
#pragma unroll
                    for (int k = 0; k < 8; ++k) {
                        const float rev = pos * INVF(k); const float sn = __builtin_amdgcn_sinf(rev), cs = __builtin_amdgcn_cosf(rev);
                        const float x = v[k]; auto rx = __builtin_amdgcn_permlane32_swap(__float_as_uint(x), __float_as_uint(x), false, false);
                        const float pt = __uint_as_float((fq & 2) ? rx[0] : rx[1]);
                        v[k] = x * cs + sgn * pt * sn;
                        const float y = v[8 + k]; auto ry = __builtin_amdgcn_permlane32_swap(__float_as_uint(y), __float_as_uint(y), false, false);
                        const float qt = __uint_as_float((fq & 2) ? ry[0] : ry[1]);
                        v[8 + k] = y * ccs[k] + sgn * qt * csn[k];
                    }
                } else if (rope == 2) {
                    const float sgn = (fq & 1) ? 1.f : -1.f;
                    float pos = (float)(fq < 2 ? (row >> 6) : (row & 63)); asm volatile("" : "+v"(pos));
#pragma unroll
                    for (int k = 0; k < 8; ++k) {
                        const float rev = pos * INVF(k); const float sn = __builtin_amdgcn_sinf(rev), cs = __builtin_amdgcn_cosf(rev);
#pragma unroll
                        for (int bj = 0; bj < 2; ++bj) { const float x = v[bj * 8 + k], pt = xorf<16>(x); v[bj * 8 + k] = x * cs + sgn * pt * sn; }
                    }
                }
#pragma unroll
                for (int bj = 0; bj < 2; ++bj) {
                    v4u w; w.x = pk2(v[bj * 8 + 0] * scale, v[bj * 8 + 1] * scale); w.y = pk2(v[bj * 8 + 2] * scale, v[bj * 8 + 3] * scale);
                    w.z = pk2(v[bj * 8 + 4] * scale, v[bj * 8 + 5] * scale); w.w = pk2(v[bj * 8 + 6] * scale, v[bj * 8 + 7] * scale);
                    if (dq) {
                        *(v4u*)(dst + (size_t)bj * MT * 64 + (size_t)row * 64 + 32 * bj + 8 * fq) = w;
                        unsigned z0 = 0u; asm volatile("" : "+v"(z0));
                        *(v4u*)(dst + (size_t)(1 - bj) * MT * 64 + (size_t)row * 64 + 32 * bj + 8 * fq) = (v4u){z0, z0, z0, z0};
                    } else *(v4u*)(dst + (size_t)row * 64 + 32 * bj + 8 * fq) = w;
                }
                __builtin_amdgcn_sched_barrier(0);
            }
        }
#undef INVF
    }
};
struct EpiBranch {
    static constexpr bool PERM = true;
    bf16_t* Bp;
    __device__ __forceinline__ void operator()(const f32x4 (&acc)[2][2][4][2], const Unit& u, int wr, int wc, int, int) const {
        const int t_ = lane_now(); const int fr = t_ & 15, fq = (t_ >> 4) & 3;
        const int branch = u.pn >> 2, chb = 256 * (u.pn & 3) + 32 * wc + 8 * fq;
#pragma unroll
        for (int ai = 0; ai < 2; ++ai)
#pragma unroll
            for (int m = 0; m < 4; ++m) { bf16_t* rowp = Bp + (size_t)(u.pm * BM + ai * HALF + wr * 64 + m * 16 + fr) * 4096 + branch * 1024 + chb;
#pragma unroll
                for (int bj = 0; bj < 2; ++bj) { const f32x4 a = acc[ai][bj][m][0], c = acc[ai][bj][m][1];
                    v4u w; w.x = pk2(a[0], a[1]); w.y = pk2(a[2], a[3]); w.z = pk2(c[0], c[1]); w.w = pk2(c[2], c[3]); *(v4u*)(rowp + 128 * bj) = w; } }
    }
};
#ifndef BP8
#define BP8 1
#endif
#ifndef MIX8
#define MIX8 0
#endif
#if MIX8 && !BP8
#error MIX8 needs BP8
#endif
constexpr float BP8_SCALE = 32.f;
struct EpiBranch8 {
    static constexpr bool PERM = false, WIDE = true;
    unsigned char* Bp;
    __device__ __forceinline__ void operator()(const f32x4 (&acc)[2][2][4][2], const Unit& u, int wr, int wc, int, int) const {
        const int t_ = lane_now(); const int fr = t_ & 15, fq = (t_ >> 4) & 3;
        const int branch = u.pn >> 2, off = (4 * (u.pn & 3) + wc) * 256 + branch * 64 + 16 * fq;
#pragma unroll
        for (int ai = 0; ai < 2; ++ai)
#pragma unroll
            for (int m = 0; m < 4; ++m) { unsigned char* rowp = Bp + (size_t)(u.pm * BM + ai * HALF + wr * 64 + m * 16 + fr) * 4096 + off;
                v4u w;
#pragma unroll
                for (int bj = 0; bj < 2; ++bj) { const f32x4 a = acc[ai][bj][m][0] * BP8_SCALE, c = acc[ai][bj][m][1] * BP8_SCALE;
                    w[2 * bj] = pk4_fp8(a[0], a[1], a[2], a[3]); w[2 * bj + 1] = pk4_fp8(c[0], c[1], c[2], c[3]); }
                *(v4u*)rowp = w; }
    }
};
struct EpiGate {
    static constexpr bool PERM = false;
    const bf16_t* Bp; bf16_t* mix; const float* bgate;
    __device__ __forceinline__ void operator()(const f32x4 (&acc)[2][2][4][2], const Unit& u, int wr, int wc, int, int) const {
        const int t_ = lane_now(); const int fr = t_ & 15, fq = (t_ >> 4) & 3;
        const int ch = 64 * u.pn + 16 * wc + 4 * fq;
        f32x4 bias[2][2];
#pragma unroll
        for (int bj = 0; bj < 2; ++bj)
#pragma unroll
            for (int n = 0; n < 2; ++n) bias[bj][n] = *(const f32x4*)(bgate + (2 * bj + n) * 1024 + ch);
#pragma unroll
        for (int ai = 0; ai < 2; ++ai)
#pragma unroll
            for (int m = 0; m < 4; ++m) { const size_t row = (size_t)(u.pm * BM + ai * HALF + wr * 64 + m * 16 + fr);
                f32x4 s = {0.f, 0.f, 0.f, 0.f};
#if BP8
                unsigned b8[4];
#pragma unroll
                for (int b = 0; b < 4; ++b) b8[b] = *(const unsigned*)((const unsigned char*)Bp + row * 4096 + u.pn * 256 + b * 64 + 16 * wc + 4 * fq);
#pragma unroll
                for (int bj = 0; bj < 2; ++bj)
#pragma unroll
                    for (int n = 0; n < 2; ++n) { const f32x4 a = acc[ai][bj][m][n] + bias[bj][n]; const int w = (int)b8[2 * bj + n];
                        const f32x2 lo = __builtin_amdgcn_cvt_pk_f32_fp8(w, false), hi = __builtin_amdgcn_cvt_pk_f32_fp8(w, true);
                        s[0] += sigmoidf_(a[0]) * lo.x; s[1] += sigmoidf_(a[1]) * lo.y; s[2] += sigmoidf_(a[2]) * hi.x; s[3] += sigmoidf_(a[3]) * hi.y; }
#if !MIX8
                s = s * (1.f / BP8_SCALE);
#endif
#else
                v2u bb[4];
#pragma unroll
                for (int b = 0; b < 4; ++b) bb[b] = *(const v2u*)(Bp + row * 4096 + b * 1024 + ch);
#pragma unroll
                for (int bj = 0; bj < 2; ++bj)
#pragma unroll
                    for (int n = 0; n < 2; ++n) { const f32x4 a = acc[ai][bj][m][n] + bias[bj][n]; const unsigned w0 = bb[2 * bj + n].x, w1 = bb[2 * bj + n].y;
                        s[0] += sigmoidf_(a[0]) * bflo(w0); s[1] += sigmoidf_(a[1]) * bfhi(w0); s[2] += sigmoidf_(a[2]) * bflo(w1); s[3] += sigmoidf_(a[3]) * bfhi(w1); }
#endif
#if MIX8
                *(unsigned*)((unsigned char*)mix + row * 1024 + ch) = pk4_fp8(s[0], s[1], s[2], s[3]); }
#else
                v2u w; w.x = pk2(s[0], s[1]); w.y = pk2(s[2], s[3]); *(v2u*)(mix + row * 1024 + ch) = w; }
#endif
    }
};
struct EpiOut {
    static constexpr bool PERM = false;
    const float* xl; const float* xc; float* X; const float* gl; const float* gc;
    __device__ __forceinline__ void operator()(const f32x4 (&acc)[2][2][4][2], const Unit& u, int wr, int wc, int, int) const {
        const int t_ = lane_now(); const int fr = t_ & 15, fq = (t_ >> 4) & 3;
        const bool latent = u.pm < SEQ / 256; const float* gv = latent ? gl : gc; const float* xo = latent ? xl : xc - (size_t)SEQ * DM;
        const int col0 = u.pn * BM + wc * 32 + 4 * fq;
        f32x4 g[2][2];
#pragma unroll
        for (int bj = 0; bj < 2; ++bj)
#pragma unroll
            for (int n = 0; n < 2; ++n) g[bj][n] = *(const f32x4*)(gv + col0 + bj * HALF + n * 16);
#pragma unroll
        for (int ai = 0; ai < 2; ++ai)
#pragma unroll
            for (int m = 0; m < 4; ++m) { const size_t off = (size_t)(u.pm * BM + ai * HALF + wr * 64 + m * 16 + fr) * DM + col0;
#pragma unroll
                for (int bj = 0; bj < 2; ++bj)
#pragma unroll
                    for (int n = 0; n < 2; ++n) { const f32x4 o = *(const f32x4*)(xo + off + bj * HALF + n * 16); *(f32x4*)(X + off + bj * HALF + n * 16) = o + g[bj][n] * acc[ai][bj][m][n]; } }
    }
};
struct EpiOutNorm {
    static constexpr bool PERM = true;
    const float* xl; const float* xc; float* X; const float* gl; const float* gc;
    bf16_t* H; const float* nw; const float* ml; const float* mc;
    gu32* xbuf; gu32* cnt; gu32* tmo; LAS unsigned char* tl;
    __device__ __forceinline__ void operator()(f32x4 (&acc)[2][2][4][2], const Unit& u, int wr, int wc, int, int) const {
        const int t_ = lane_now(); const int fr = t_ & 15, fq = (t_ >> 4) & 3;
        const bool latent = u.pm < SEQ / 256; const float* gv = latent ? gl : gc; const float* xo = latent ? xl : xc - (size_t)SEQ * DM;
        const int col0 = u.pn * BM + wc * 32 + 8 * fq;
        LAS float* P = (LAS float*)tl; LAS float* Sr = (LAS float*)(tl + 4096); volatile LAS unsigned* flag = (volatile LAS unsigned*)(tl + 5120);
        {
            f32x4 g[2][2];
#pragma unroll
            for (int bj = 0; bj < 2; ++bj)
#pragma unroll
                for (int n = 0; n < 2; ++n) g[bj][n] = *(const f32x4*)(gv + col0 + bj * HALF + n * 4);
#pragma unroll
            for (int ai = 0; ai < 2; ++ai)
#pragma unroll
                for (int m = 0; m < 4; ++m) { const int r = ai * HALF + wr * 64 + m * 16 + fr; const size_t off = (size_t)(u.pm * BM + r) * DM + col0; float s = 0.f;
#pragma unroll
                    for (int bj = 0; bj < 2; ++bj)
#pragma unroll
                        for (int n = 0; n < 2; ++n) { const f32x4 o = *(const f32x4*)(xo + off + bj * HALF + n * 4); const f32x4 y = o + g[bj][n] * acc[ai][bj][m][n];
                            *(f32x4*)(X + off + bj * HALF + n * 4) = y; acc[ai][bj][m][n] = y; s += (y.x * y.x + y.y * y.y) + (y.z * y.z + y.w * y.w); }
                    s += xorf<16>(s); s = x32_sum(s);
                    if (fq == 0) P[r * 4 + wc] = s; }
        }
        asm volatile("s_waitcnt lgkmcnt(0)" ::: "memory"); __builtin_amdgcn_s_barrier(); asm volatile("" ::: "memory");
        const int wid = wr * 4 + wc, row = wid * 32 + (t_ & 31);
        if (t_ < 32) { const float tp = (P[row * 4 + 0] + P[row * 4 + 1]) + (P[row * 4 + 2] + P[row * 4 + 3]);
            __hip_atomic_store(xbuf + ((size_t)(u.pm * BM + row) * 4 + u.pn), __float_as_uint(tp), RLX_AGENT); }
        asm volatile("s_waitcnt vmcnt(0)" ::: "memory");
        if (t_ == 0) (void)__hip_atomic_fetch_add(cnt + 64 * u.pm, 1u, RLX_AGENT);
        if (wid == 0) {
            unsigned sp = 0u, dead = 0u;
            while ((unsigned)__builtin_amdgcn_readfirstlane((int)__hip_atomic_load(cnt + 64 * u.pm, RLX_AGENT)) < 32u) {
                __builtin_amdgcn_s_sleep(2);
                if ((++sp & 255u) == 0u) { if (__builtin_amdgcn_readfirstlane((int)__hip_atomic_load(tmo, RLX_AGENT)) != 0) { dead = 1u; break; }
                    if (sp > (1u << 22)) { if (t_ == 0) __hip_atomic_store(tmo, 1u, RLX_AGENT); dead = 1u; break; } } }
            __builtin_amdgcn_fence(__ATOMIC_ACQUIRE, "agent");
            if (t_ == 0) flag[0] = dead;
        }
        asm volatile("s_waitcnt vmcnt(0) lgkmcnt(0)" ::: "memory"); __builtin_amdgcn_s_barrier(); asm volatile("" ::: "memory");
        if (t_ < 32) { const gu32* sl = xbuf + (size_t)(u.pm * BM + row) * 4; float tot = 0.f;
#pragma unroll
            for (int q = 0; q < 4; ++q) tot += __uint_as_float(__hip_atomic_load(sl + q, RLX_AGENT));
            Sr[row] = __builtin_amdgcn_rsqf(tot * (1.f / DM) + EPS); }
        asm volatile("s_waitcnt vmcnt(0) lgkmcnt(0)" ::: "memory"); __builtin_amdgcn_s_barrier(); asm volatile("" ::: "memory");
        const float* mv = latent ? ml : mc;
#pragma unroll
        for (int bj = 0; bj < 2; ++bj) { const int col = col0 + bj * HALF;
            f32x4 wa[2], b[2];
#pragma unroll
            for (int n = 0; n < 2; ++n) { const f32x4 w = *(const f32x4*)(nw + col + 4 * n), a = *(const f32x4*)(mv + 4096 + col + 4 * n); b[n] = *(const f32x4*)(mv + 3072 + col + 4 * n); wa[n] = w * (1.0f + a); }
#pragma unroll
            for (int ai = 0; ai < 2; ++ai)
#pragma unroll
                for (int m = 0; m < 4; ++m) { const int r = ai * HALF + wr * 64 + m * 16 + fr; const float ri = Sr[r];
                    const f32x4 y0 = (acc[ai][bj][m][0] * ri) * wa[0] + b[0], y1 = (acc[ai][bj][m][1] * ri) * wa[1] + b[1];
                    v4u pk; pk.x = pk2(y0.x, y0.y); pk.y = pk2(y0.z, y0.w); pk.z = pk2(y1.x, y1.y); pk.w = pk2(y1.z, y1.w); *(v4u*)(H + (size_t)(u.pm * BM + r) * DM + col) = pk; } }
    }
};
struct EpiS {
    static constexpr bool PERM = true;
    float* S;
    __device__ __forceinline__ void operator()(const f32x4 (&acc)[2][2][4][2], const Unit& u, int wr, int wc, int, int) const {
        const int t_ = lane_now(); const int fr = t_ & 15, fq = (t_ >> 4) & 3;
        const int col0 = u.pn * BM + wc * 32 + 8 * fq;
        bf16_t* Sb = (bf16_t*)S;
#pragma unroll
        for (int ai = 0; ai < 2; ++ai)
#pragma unroll
            for (int m = 0; m < 4; ++m) { bf16_t* rowp = Sb + (size_t)(u.pm * BM + ai * HALF + wr * 64 + m * 16 + fr) * 2048 + col0;
#pragma unroll
                for (int bj = 0; bj < 2; ++bj) { const f32x4 a0 = acc[ai][bj][m][0], a1 = acc[ai][bj][m][1];
                    v4u o; o.x = pk2(a0.x, a0.y); o.y = pk2(a0.z, a0.w); o.z = pk2(a1.x, a1.y); o.w = pk2(a1.z, a1.w);
                    *(v4u*)(rowp + bj * HALF) = o; } }
    }
};
}
namespace att {
using bf16 = __hip_bfloat16;
constexpr int NW = 8, QBLK = 32, QB = 256, KVBLK = 64;
__device__ __forceinline__ int crow(int r, int hi) { return (r & 3) + 8 * (r >> 2) + 4 * hi; }
#define SBAR() __builtin_amdgcn_sched_barrier(0)
constexpr int NSLOT = 3, SLOTB = 8192;
constexpr int LDS_K = 0, LDS_V = NSLOT * SLOTB, LDS_WS = 2 * NSLOT * SLOTB, LDS_OST = LDS_WS + NW * 64 * 4, LDS_RPB = LDS_OST + NW * 8192, LDS_BYTES = LDS_RPB + 2048;
static_assert(LDS_BYTES <= RING_BYTES, "attention scratch fits the ring region");
__device__ __forceinline__ void glds16(const void* gsrc, unsigned lds_dst) { unsigned keep;
    asm volatile("s_mov_b32 %0, m0\n\ts_mov_b32 m0, %2\n\ts_nop 0\n\tglobal_load_lds_dwordx4 %1, off\n\ts_mov_b32 m0, %0" : "=&s"(keep) : "v"(gsrc), "s"(lds_dst) : "memory"); }
__device__ __forceinline__ float max3f(float a, float b, float c) { float r; asm("v_max3_f32 %0, %1, %2, %3" : "=v"(r) : "v"(a), "v"(b), "v"(c)); return r; }
__device__ __forceinline__ float max2f(float a, float b) { float r; asm("v_max_f32_e32 %0, %1, %2" : "=v"(r) : "v"(a), "v"(b)); return r; }
__device__ __forceinline__ float fadd_s(float a, float b) { float r; asm("v_add_f32_e32 %0, %1, %2" : "=v"(r) : "v"(a), "v"(b)); return r; }
__device__ __forceinline__ float fsub_s(float a, float b) { float r; asm("v_sub_f32_e32 %0, %1, %2" : "=v"(r) : "v"(a), "v"(b)); return r; }
__device__ __forceinline__ unsigned cvtpk_s(float lo, float hi) { f32x2 v = {lo, hi}; bf16x2_t b = __builtin_convertvector(v, bf16x2_t); return __builtin_bit_cast(unsigned, b); }
#define WAIT_BAR(N) asm volatile("s_waitcnt vmcnt(" #N ") lgkmcnt(0)\n\ts_barrier" ::: "memory")

__device__ __forceinline__ void qkt(f32x16& p0, f32x16& p1, const char* Kslot, const bf16x8* qr, const f32x16& negm, int r32, int hi) {
    const char* kb = Kslot + hi * 1024 + r32 * 16;
#pragma unroll
    for (int d0 = 0; d0 < 4; ++d0) {
        const bf16x8 b0 = *reinterpret_cast<const bf16x8*>(kb + d0 * 2048);
        const bf16x8 b1 = *reinterpret_cast<const bf16x8*>(kb + d0 * 2048 + 512);
        if (d0 == 0) { p0 = __builtin_amdgcn_mfma_f32_32x32x16_bf16(b0, qr[0], negm, 0, 0, 0); p1 = __builtin_amdgcn_mfma_f32_32x32x16_bf16(b1, qr[0], negm, 0, 0, 0); }
        else { p0 = __builtin_amdgcn_mfma_f32_32x32x16_bf16(b0, qr[d0], p0, 0, 0, 0); p1 = __builtin_amdgcn_mfma_f32_32x32x16_bf16(b1, qr[d0], p1, 0, 0, 0); } }
}
typedef __attribute__((address_space(3))) const char* lds_cptr;
typedef short v4i16_t __attribute__((ext_vector_type(4)));
__device__ __forceinline__ void kload8(bf16x8* kf, lds_cptr kp) {
    kf[0] = *(const __attribute__((address_space(3))) bf16x8*)(kp);        kf[1] = *(const __attribute__((address_space(3))) bf16x8*)(kp + 512);
    kf[2] = *(const __attribute__((address_space(3))) bf16x8*)(kp + 2048); kf[3] = *(const __attribute__((address_space(3))) bf16x8*)(kp + 2560);
    kf[4] = *(const __attribute__((address_space(3))) bf16x8*)(kp + 4096); kf[5] = *(const __attribute__((address_space(3))) bf16x8*)(kp + 4608);
    kf[6] = *(const __attribute__((address_space(3))) bf16x8*)(kp + 6144); kf[7] = *(const __attribute__((address_space(3))) bf16x8*)(kp + 6656);
}
__device__ __forceinline__ void kload2(bf16x8* kf, lds_cptr kp, int j) { kf[2 * j] = *(const __attribute__((address_space(3))) bf16x8*)(kp + j * 2048); kf[2 * j + 1] = *(const __attribute__((address_space(3))) bf16x8*)(kp + j * 2048 + 512); }
__device__ __forceinline__ s16x4 vtr(lds_cptr p) { return __builtin_bit_cast(s16x4, __builtin_amdgcn_ds_read_tr16_b64_v4i16((__attribute__((address_space(3))) v4i16_t*)p)); }
__device__ __forceinline__ float rowmax(const f32x16& p0, const f32x16& p1) {
    float a = max3f(p0[0], p0[1], p1[0]), b = max3f(p0[2], p0[3], p1[1]); a = max3f(a, p1[2], p1[3]);
#pragma unroll
    for (int r = 4; r < 16; r += 4) { a = max3f(a, p0[r], p0[r + 1]); b = max3f(b, p0[r + 2], p0[r + 3]); a = max3f(a, p1[r], p1[r + 1]); b = max3f(b, p1[r + 2], p1[r + 3]); }
    const float m = max2f(a, b);
    auto rr = __builtin_amdgcn_permlane32_swap(__float_as_uint(m), __float_as_uint(m), false, false);
    return max2f(__uint_as_float(rr[0]), __uint_as_float(rr[1]));
}
__device__ __forceinline__ void pv(f32x16* o, int vb, bf16x8 pa0, bf16x8 pa1, bf16x8 pa2, bf16x8 pa3) {
#pragma unroll
    for (int d0 = 0; d0 < 2; ++d0) { s16x4 lo[4], hi[4];
#pragma unroll
        for (int ks = 0; ks < 4; ++ks) {
            asm volatile("ds_read_b64_tr_b16 %0,%1 offset:%c2" : "=&v"(lo[ks]) : "v"(vb), "i"(d0 * 4096 + ks * 1024) : "memory");
            asm volatile("ds_read_b64_tr_b16 %0,%1 offset:%c2" : "=&v"(hi[ks]) : "v"(vb), "i"(d0 * 4096 + ks * 1024 + 512) : "memory"); }
        asm volatile("s_waitcnt lgkmcnt(0)" ::: "memory"); SBAR();
#define PK(k) (bf16x8){lo[k][0], lo[k][1], lo[k][2], lo[k][3], hi[k][0], hi[k][1], hi[k][2], hi[k][3]}
        o[d0] = __builtin_amdgcn_mfma_f32_32x32x16_bf16(pa0, PK(0), o[d0], 0, 0, 0);
        o[d0] = __builtin_amdgcn_mfma_f32_32x32x16_bf16(pa1, PK(1), o[d0], 0, 0, 0);
        o[d0] = __builtin_amdgcn_mfma_f32_32x32x16_bf16(pa2, PK(2), o[d0], 0, 0, 0);
        o[d0] = __builtin_amdgcn_mfma_f32_32x32x16_bf16(pa3, PK(3), o[d0], 0, 0, 0);
#undef PK
    }
}

struct AU {
    const bf16* Q; const bf16* K; const bf16* V;
    bf16* O;
    int q0, NT, kbase;
    float sinkl2;
    int emode;
    float lam, oscale; const float* subw;
};

template <int MODE> __device__ __forceinline__ void amask(f32x16& p0, f32x16& p1, int t, const AU& u, int wid, int r32, int hi, const float* rpb) {
    if constexpr (MODE == 2) {
        if (t >= 4) {
            const int kp0 = u.kbase + 64 * (t - 4) + 4 * hi, qpos = u.q0 + wid * QBLK + r32;
#pragma unroll
            for (int r = 0; r < 16; ++r) { const int kv = kp0 + (r & 3) + 8 * (r >> 2);
                const bool ok0 = ((unsigned)(kv - qpos + 128) <= 256u) && ((unsigned)kv < (unsigned)SEQ);
                const bool ok1 = ((unsigned)(kv + 32 - qpos + 128) <= 256u) && ((unsigned)(kv + 32) < (unsigned)SEQ);
                if (!ok0) p0[r] = -INFINITY; if (!ok1) p1[r] = -INFINITY; }
        }
    }
    if constexpr (MODE == 1) {
        if (t >= 4) {
            const int jr = (u.kbase >> 6) + (t - 4), qr = (u.q0 >> 6) + (wid >> 1), qc = 32 * (wid & 1) + r32;
            int rs = qr - 4; rs = rs < 0 ? 0 : (rs > 248 ? 248 : rs);
            int cs = qc - 8; cs = cs < 0 ? 0 : (cs > 48 ? 48 : cs);
            const bool rowok = (unsigned)(jr - rs) < 8u;
            int ro = jr - qr + 7; ro = ro < 0 ? 0 : (ro > 14 ? 14 : ro);
            const float* brow = rpb + ro * 32;
#pragma unroll
            for (int r = 0; r < 16; ++r) { const int kc = 4 * hi + (r & 3) + 8 * (r >> 2);
                { int bi = kc - qc + 15; bi = bi < 0 ? 0 : (bi > 30 ? 30 : bi); const bool ok = rowok && ((unsigned)(kc - cs) < 16u); p0[r] = ok ? p0[r] + brow[bi] : -INFINITY; }
                { int bi = kc + 32 - qc + 15; bi = bi < 0 ? 0 : (bi > 30 ? 30 : bi); const bool ok = rowok && ((unsigned)(kc + 32 - cs) < 16u); p1[r] = ok ? p1[r] + brow[bi] : -INFINITY; } }
        }
    }
}

template <int MODE, int THRL, int QKH = 0, int NOMAX = 0> __device__ __forceinline__ bool attn_unit(const AU& u, char* shm, int wave) {
    const int lane = lane_now(), tid = (wave << 6) | lane, r32 = lane & 31, hi = lane >> 5; const int wid = wave;
    const bf16* Qw = u.Q + (size_t)(u.q0 + wid * QBLK) * 64;
    const bf16* Kh = u.K; const bf16* Vh = u.V;
    const unsigned lds0 = (unsigned)(uintptr_t)shm;
    float* wsf = (float*)(shm + LDS_WS) + wid * 64;
    const float* rpb = (const float*)(shm + LDS_RPB);
    const int NT = u.NT;
    volatile int* okflag = (volatile int*)(shm + LDS_RPB + 2040);
    if constexpr (NOMAX) { if (tid == 0) *okflag = 0; }
#define KROW(t) ((t) < 4 ? SEQ + 64 * (t) : (u.kbase + 64 * ((t) - 4) < 0 ? 0 : (u.kbase + 64 * ((t) - 4) > SEQ - 64 ? SEQ - 64 : u.kbase + 64 * ((t) - 4))))
    const bf16* ksrc = Kh + (size_t)lane * 64 + wid * 8;
    const bf16* vsrc = Vh + (size_t)(16 * (wid & 3) + (lane >> 2)) * 64 + (wid >> 2) * 32 + (lane & 3) * 8;
    const unsigned kdst = lds0 + LDS_K + wid * 1024, vdst = lds0 + LDS_V + wid * 1024;
#define DMA_K(t, slot) glds16(ksrc + (size_t)KROW(t) * 64, (unsigned)__builtin_amdgcn_readfirstlane(kdst + (slot)))
#define DMA_V(t, slot) glds16(vsrc + (size_t)KROW(t) * 64, (unsigned)__builtin_amdgcn_readfirstlane(vdst + (slot)))
    const int vb0 = (int)(lds0 + LDS_V) + ((lane >> 4) & 1) * 32 + (lane & 3) * 8 + (4 * hi + ((lane & 15) >> 2)) * 64;
    const char* Kbase = shm + LDS_K; bf16x8 kf[8];
    const lds_cptr shm3 = (lds_cptr)shm; const lds_cptr kp0 = shm3 + LDS_K + hi * 1024 + r32 * 16; const lds_cptr vp0 = shm3 + LDS_V + ((lane >> 4) & 1) * 32 + (lane & 3) * 8 + (4 * hi + ((lane & 15) >> 2)) * 64;
    DMA_K(0, 0); DMA_V(0, 0); DMA_K(1, SLOTB);
    bf16x8 qr[4];
#pragma unroll
    for (int d0 = 0; d0 < 4; ++d0) qr[d0] = *reinterpret_cast<const bf16x8*>(&Qw[(size_t)r32 * 64 + d0 * 16 + hi * 8]);
    float mhat = 0.f, l_reg = 0.f; f32x16 o[2]; o[0] = f32x16{}; o[1] = f32x16{}; f32x16 negm = f32x16{}; asm volatile("" : "+v"(negm));
#define CMASK(P0, P1, t) amask<MODE>(P0, P1, (t), u, wid, r32, hi, rpb)
    bool resc = false;
#define START(P0, P1) do { const float rm = rowmax(P0, P1); resc = false; \
    { const float dl = rm; mhat = fadd_s(mhat, dl); \
      _Pragma("unroll") for (int r = 0; r < 16; ++r) { P0[r] = fsub_s(P0[r], dl); P1[r] = fsub_s(P1[r], dl); } \
      _Pragma("unroll") for (int r = 0; r < 16; ++r) negm[r] = -mhat; asm volatile("" : "+v"(negm)); } \
    _Pragma("unroll") for (int r = 0; r < 16; ++r) P0[r] = __builtin_amdgcn_exp2f(P0[r]); } while (0)
#define RESC() do { if (resc) { asm volatile("s_waitcnt lgkmcnt(0)" ::: "memory"); \
      _Pragma("unroll") for (int d_ = 0; d_ < 2; ++d_) _Pragma("unroll") for (int r = 0; r < 16; ++r) o[d_][r] *= wsf[crow(r, hi)]; } } while (0)
    f32x16 pA0, pA1, pB0, pB1;
    int sl_prev = 0, sl_cur = 0, sl_next = SLOTB;
#define ROT() do { sl_prev = sl_cur; sl_cur = sl_next; sl_next = (sl_next == (NSLOT - 1) * SLOTB) ? 0 : sl_next + SLOTB; } while (0)
    DMA_K(2, 2 * SLOTB);
    WAIT_BAR(3);
    qkt(pA0, pA1, Kbase, qr, negm, r32, hi); asm volatile("s_nop 15\n\ts_nop 7" : "+v"(pA0), "+v"(pA1));
    START(pA0, pA1);
    _Pragma("unroll") for (int r = 0; r < 16; ++r) pA1[r] = __builtin_amdgcn_exp2f(pA1[r]);
    WAIT_BAR(0);
    DMA_K(3, 0); DMA_V(1, SLOTB);
    ROT();
    kload8(kf, kp0 + sl_cur);
    WAIT_BAR(2);
    s16x4 vlo[8], vhi[8]; v4u pw0, pw1, pw2, pw3;
#define PKW(P, B) cvtpk_s(P[B], P[B + 1])
#define PAF(k) __builtin_bit_cast(bf16x8, pw##k)
#define VFR(i) (bf16x8){vlo[i][0], vlo[i][1], vlo[i][2], vlo[i][3], vhi[i][0], vhi[i][1], vhi[i][2], vhi[i][3]}
#define PIN(x) asm volatile("" : "+v"(x))
#define MX3(a, b, c) __builtin_fmaxf(__builtin_fmaxf((a), (b)), (c))
#define GAPA(MF, A0, A1, A2, A3, W0, W1, PW) do { MF; sacc += A0; sacc += A1; sacc += A2; sacc += A3; PIN(sacc); W0; W1; PIN(PW); SBAR(); } while (0)
#define EX(v) __builtin_amdgcn_exp2f(v)
#define GAPB(MF, X, B) do { MF; X[B] = EX(X[B]); X[B + 1] = EX(X[B + 1]); X[B + 2] = EX(X[B + 2]); X[B + 3] = EX(X[B + 3]); PIN(X); SBAR(); } while (0)
#define VRD(i) do { vlo[i] = vtr(vp_ + (((i) >> 2) * 4096 + ((i) & 3) * 1024)); vhi[i] = vtr(vp_ + (((i) >> 2) * 4096 + ((i) & 3) * 1024 + 512)); } while (0)
#define KRD(G, j) do { if constexpr (QKH == 0 || (QKH == 1 && (j) < 2) || (QKH == 2 && (j) >= 2)) { if (G) { kload2(kf, kp0 + sl_next, j); SBAR(); } } } while (0)
#define MF32(a, b, c) __builtin_amdgcn_mfma_f32_32x32x16_bf16(a, b, c, 0, 0, 0)
#define QLO(X) do { if constexpr (QKH != 2) { X; } } while (0)
#define QHI(X0, X2) do { if constexpr (QKH == 0) { X0; } else if constexpr (QKH == 2) { X2; } } while (0)
#define STEP(C0, C1, P0, P1, t, GK, GV, GL) do { SBAR(); \
    const lds_cptr vp_ = vp0 + sl_prev; \
    VRD(0); SBAR(); float sacc = (P0[0] + P0[1]); \
    GAPA(QLO(C0 = MF32(kf[0], qr[0], negm)), P0[2], P0[3], P0[4], P0[5],     pw0[0] = PKW(P0, 0), pw0[1] = PKW(P0, 2), pw0); \
    VRD(4); SBAR(); GAPA(QLO(C1 = MF32(kf[1], qr[0], negm)), P0[6], P0[7], P0[8], P0[9],     pw0[2] = PKW(P0, 4), pw0[3] = PKW(P0, 6), pw0); \
    VRD(1); SBAR(); GAPA(QLO(C0 = MF32(kf[2], qr[1], C0)), P0[10], P0[11], P0[12], P0[13], pw1[0] = PKW(P0, 8), pw1[1] = PKW(P0, 10), pw1); \
    VRD(5); SBAR(); GAPA(QLO(C1 = MF32(kf[3], qr[1], C1)), P0[14], P0[15], P1[0], P1[1],   pw1[2] = PKW(P0, 12), pw1[3] = PKW(P0, 14), pw1); \
    VRD(2); SBAR(); GAPA(QHI(C0 = MF32(kf[4], qr[2], C0), C0 = MF32(kf[4], qr[2], negm)), P1[2], P1[3], P1[4], P1[5],     pw2[0] = PKW(P1, 0), pw2[1] = PKW(P1, 2), pw2); \
    VRD(6); SBAR(); GAPA(QHI(C1 = MF32(kf[5], qr[2], C1), C1 = MF32(kf[5], qr[2], negm)), P1[6], P1[7], P1[8], P1[9],     pw2[2] = PKW(P1, 4), pw2[3] = PKW(P1, 6), pw2); \
    VRD(3); SBAR(); GAPA(QHI(C0 = MF32(kf[6], qr[3], C0), C0 = MF32(kf[6], qr[3], C0)), P1[10], P1[11], P1[12], P1[13], pw3[0] = PKW(P1, 8), pw3[1] = PKW(P1, 10), pw3); \
    VRD(7); SBAR(); GAPA(QHI(C1 = MF32(kf[7], qr[3], C1), C1 = MF32(kf[7], qr[3], C1)), P1[14], P1[15], 0.f, 0.f,       pw3[2] = PKW(P1, 12), pw3[3] = PKW(P1, 14), pw3); \
    l_reg += sacc; \
    if (GK) { DMA_K((t) + 3, sl_cur); } if (GV) { DMA_V((t) + 1, sl_next); } \
    CMASK(C0, C1, t); \
    if constexpr (NOMAX) { resc = false; } else { float a = MX3(C0[0], C0[1], C1[0]), b = MX3(C0[2], C0[3], C1[1]); a = MX3(a, C1[2], C1[3]); \
      _Pragma("unroll") for (int r = 4; r < 16; r += 4) { a = MX3(a, C0[r], C0[r + 1]); b = MX3(b, C0[r + 2], C0[r + 3]); a = MX3(a, C1[r], C1[r + 1]); b = MX3(b, C1[r + 2], C1[r + 3]); } \
      float rm = __builtin_fmaxf(a, b); { auto rr = __builtin_amdgcn_permlane32_swap(__float_as_uint(rm), __float_as_uint(rm), false, false); rm = __builtin_fmaxf(__uint_as_float(rr[0]), __uint_as_float(rr[1])); } \
      resc = false; \
      if (__builtin_expect(__any(rm > (float)THRL), 0)) { const float dl = __builtin_fmaxf(rm, 0.f); mhat += dl; \
        _Pragma("unroll") for (int r = 0; r < 16; ++r) { C0[r] -= dl; C1[r] -= dl; } \
        _Pragma("unroll") for (int r = 0; r < 16; ++r) negm[r] = -mhat; asm volatile("" : "+v"(negm)); \
        const float f = __builtin_amdgcn_exp2f(-dl); l_reg *= f; if (hi == 0) wsf[r32] = f; resc = true; } } \
    SBAR(); \
    GAPB(o[0] = __builtin_amdgcn_mfma_f32_32x32x16_bf16(PAF(0), VFR(0), o[0], 0, 0, 0), C0, 0); \
    GAPB(o[1] = __builtin_amdgcn_mfma_f32_32x32x16_bf16(PAF(0), VFR(4), o[1], 0, 0, 0), C0, 4); \
    KRD(GL, 0); GAPB(o[0] = __builtin_amdgcn_mfma_f32_32x32x16_bf16(PAF(1), VFR(1), o[0], 0, 0, 0), C0, 8); \
    KRD(GL, 1); GAPB(o[1] = __builtin_amdgcn_mfma_f32_32x32x16_bf16(PAF(1), VFR(5), o[1], 0, 0, 0), C0, 12); \
    KRD(GL, 2); GAPB(o[0] = __builtin_amdgcn_mfma_f32_32x32x16_bf16(PAF(2), VFR(2), o[0], 0, 0, 0), C1, 0); \
    KRD(GL, 3); GAPB(o[1] = __builtin_amdgcn_mfma_f32_32x32x16_bf16(PAF(2), VFR(6), o[1], 0, 0, 0), C1, 4); \
    GAPB(o[0] = __builtin_amdgcn_mfma_f32_32x32x16_bf16(PAF(3), VFR(3), o[0], 0, 0, 0), C1, 8); \
    GAPB(o[1] = __builtin_amdgcn_mfma_f32_32x32x16_bf16(PAF(3), VFR(7), o[1], 0, 0, 0), C1, 12); \
    } while (0)
    int t = 1;
    for (; t + 5 < NT; t += 2) {
        STEP(pB0, pB1, pA0, pA1, t, true, true, true);     WAIT_BAR(2); RESC(); ROT();
        STEP(pA0, pA1, pB0, pB1, t + 1, true, true, true);   WAIT_BAR(2); RESC(); ROT();
    }
#define ENDW(tt) do { if ((tt) + 3 < NT) { WAIT_BAR(2); } else if ((tt) + 2 < NT) { WAIT_BAR(1); } else { WAIT_BAR(0); } } while (0)
    for (; t + 1 < NT; t += 2) {
        STEP(pB0, pB1, pA0, pA1, t, (t + 3 < NT), (t + 1 < NT), (t + 1 < NT));       ENDW(t);   RESC(); ROT();
        STEP(pA0, pA1, pB0, pB1, t + 1, (t + 4 < NT), (t + 2 < NT), (t + 2 < NT));     ENDW(t + 1); RESC(); ROT();
    }
    STEP(pB0, pB1, pA0, pA1, NT - 1, false, false, false); RESC();
    { float sacc = pB0[0] + pB0[1]; _Pragma("unroll") for (int r = 2; r < 16; ++r) sacc += pB0[r]; _Pragma("unroll") for (int r = 0; r < 16; ++r) sacc += pB1[r]; l_reg += sacc;
      pw0 = (v4u){PKW(pB0, 0), PKW(pB0, 2), PKW(pB0, 4), PKW(pB0, 6)}; pw1 = (v4u){PKW(pB0, 8), PKW(pB0, 10), PKW(pB0, 12), PKW(pB0, 14)}; pw2 = (v4u){PKW(pB1, 0), PKW(pB1, 2), PKW(pB1, 4), PKW(pB1, 6)}; pw3 = (v4u){PKW(pB1, 8), PKW(pB1, 10), PKW(pB1, 12), PKW(pB1, 14)};
      SBAR(); pv(o, vb0 + sl_cur, PAF(0), PAF(1), PAF(2), PAF(3)); }
#undef PKW
#undef PAF
#undef VFR
#undef PIN
#undef MX3
#undef GAPA
#undef GAPB
#undef EX
#undef VRD
#undef KRD
#undef MF32
#undef QLO
#undef QHI
#undef STEP
#undef ENDW
    { auto rr = __builtin_amdgcn_permlane32_swap(__float_as_uint(l_reg), __float_as_uint(l_reg), false, false); l_reg = __uint_as_float(rr[0]) + __uint_as_float(rr[1]); }
    if constexpr (NOMAX) {
        const bool ok = (l_reg > 0x1p-90f) && (l_reg < 0x1p90f);
        if (__any(!ok)) { if (lane == 0) *okflag = 1; }
        asm volatile("s_waitcnt lgkmcnt(0)\n\ts_barrier" ::: "memory");
        const int bad = __builtin_amdgcn_readfirstlane(*okflag);
        if (bad) { asm volatile("s_waitcnt lgkmcnt(0)\n\ts_barrier" ::: "memory"); return false; }
    }
    l_reg += __builtin_amdgcn_exp2f(u.sinkl2 - mhat);
    if (hi == 0) wsf[32 + r32] = l_reg; asm volatile("s_waitcnt lgkmcnt(0)" ::: "memory");
    float rli[16];
#pragma unroll
    for (int r = 0; r < 16; ++r) rli[r] = __builtin_amdgcn_rcpf(wsf[32 + crow(r, hi)]);
    if (u.emode == 0) {
        bf16* Ow = u.O + (size_t)(u.q0 + wid * QBLK) * 1024;
        bf16* stg = (bf16*)(shm + LDS_OST + wid * 8192);
#pragma unroll
        for (int r = 0; r < 16; ++r) { const int orow = crow(r, hi);
#pragma unroll
            for (int d0 = 0; d0 < 2; ++d0) stg[orow * 64 + d0 * 32 + r32] = __float2bfloat16(o[d0][r] * rli[r]); }
        asm volatile("s_waitcnt lgkmcnt(0)" ::: "memory");
#pragma unroll
        for (int i = 0; i < 4; ++i) { const int row = i * 8 + (lane >> 3), ch = lane & 7; const v4u v = *(const v4u*)(stg + row * 64 + ch * 8); *(v4u*)(Ow + (size_t)row * 1024 + ch * 8) = v; }
    } else {
        float* stf = (float*)(shm + LDS_OST + wid * 8192);
        if (u.emode == 1) {
#pragma unroll
            for (int r = 0; r < 16; ++r) { const int orow = crow(r, hi);
#pragma unroll
                for (int d0 = 0; d0 < 2; ++d0) stf[orow * 64 + d0 * 32 + r32] = o[d0][r] * rli[r]; }
        } else {
#pragma unroll
            for (int r = 0; r < 16; ++r) { const int orow = crow(r, hi);
#pragma unroll
                for (int d0 = 0; d0 < 2; ++d0) { const float y = stf[orow * 64 + d0 * 32 + r32] - u.lam * (o[d0][r] * rli[r]); stf[orow * 64 + d0 * 32 + r32] = y; } }
            asm volatile("s_waitcnt lgkmcnt(0)" ::: "memory");
            bf16* Ow = u.O + (size_t)(u.q0 + wid * QBLK) * 1024;
#pragma unroll
            for (int i = 0; i < 4; ++i) { const int row = i * 8 + (lane >> 3), ch = lane & 7;
                const f32x4 y0 = *(const f32x4*)(stf + row * 64 + ch * 8), y1 = *(const f32x4*)(stf + row * 64 + ch * 8 + 4);
                float ss = (y0[0] * y0[0] + y0[1] * y0[1]) + (y0[2] * y0[2] + y0[3] * y0[3]) + (y1[0] * y1[0] + y1[1] * y1[1]) + (y1[2] * y1[2] + y1[3] * y1[3]);
                ss += xorf<1>(ss); ss += xorf<2>(ss); ss += xorf<4>(ss);
                const float ri = __builtin_amdgcn_rsqf(ss * (1.f / 64.f) + EPS) * u.oscale;
                const f32x4 w0 = *(const f32x4*)(u.subw + ch * 8), w1 = *(const f32x4*)(u.subw + ch * 8 + 4);
                v4u v; v.x = pk2(y0[0] * ri * w0[0], y0[1] * ri * w0[1]); v.y = pk2(y0[2] * ri * w0[2], y0[3] * ri * w0[3]); v.z = pk2(y1[0] * ri * w1[0], y1[1] * ri * w1[1]); v.w = pk2(y1[2] * ri * w1[2], y1[3] * ri * w1[3]);
                *(v4u*)(Ow + (size_t)row * 1024 + ch * 8) = v; }
        }
    }
    asm volatile("s_waitcnt lgkmcnt(0)\n\ts_barrier" ::: "memory");
    return true;
#undef DMA_K
#undef DMA_V
#undef KROW
#undef CMASK
#undef START
#undef RESC
#undef ROT
}

template <int MODE, int NOMAX = 0> __device__ __forceinline__ bool attn_simple(const AU& u, char* shm, int wave) {
    const int lane = lane_now(), tid = (wave << 6) | lane, r32 = lane & 31, hi = lane >> 5; const int wid = wave;
    const bf16* Qw = u.Q + (size_t)(u.q0 + wid * QBLK) * 64;
    const unsigned lds0 = (unsigned)(uintptr_t)shm;
    float* wsf = (float*)(shm + LDS_WS) + wid * 64;
    const float* rpb = (const float*)(shm + LDS_RPB);
    const int NT = u.NT;
    volatile int* okflag = (volatile int*)(shm + LDS_RPB + 2040);
    if constexpr (NOMAX) { if (tid == 0) *okflag = 0; }
#define KROW(t) ((t) < 4 ? SEQ + 64 * (t) : (u.kbase + 64 * ((t) - 4) < 0 ? 0 : (u.kbase + 64 * ((t) - 4) > SEQ - 64 ? SEQ - 64 : u.kbase + 64 * ((t) - 4))))
    const bf16* ksrc = u.K + (size_t)lane * 64 + wid * 8;
    const bf16* vsrc = u.V + (size_t)(16 * (wid & 3) + (lane >> 2)) * 64 + (wid >> 2) * 32 + (lane & 3) * 8;
    const unsigned kdst = lds0 + LDS_K + wid * 1024, vdst = lds0 + LDS_V + wid * 1024;
    const int vb0 = (int)(lds0 + LDS_V) + ((lane >> 4) & 1) * 32 + (lane & 3) * 8 + (4 * hi + ((lane & 15) >> 2)) * 64;
    { const int kr = KROW(0); glds16(ksrc + (size_t)kr * 64, (unsigned)__builtin_amdgcn_readfirstlane(kdst)); glds16(vsrc + (size_t)kr * 64, (unsigned)__builtin_amdgcn_readfirstlane(vdst)); }
    bf16x8 qr[4];
#pragma unroll
    for (int d0 = 0; d0 < 4; ++d0) qr[d0] = *reinterpret_cast<const bf16x8*>(&Qw[(size_t)r32 * 64 + d0 * 16 + hi * 8]);
    float m_run = -INFINITY, l_reg = 0.f; f32x16 o[2]; o[0] = f32x16{}; o[1] = f32x16{};
    const f32x16 zero = f32x16{};
#pragma unroll 1
    for (int t = 0; t < NT; ++t) {
        const int sl = (t & 1) * SLOTB;
        asm volatile("s_waitcnt vmcnt(0) lgkmcnt(0)\n\ts_barrier" ::: "memory");
        if (t + 1 < NT) { const int kr = KROW(t + 1); const int sn = ((t + 1) & 1) * SLOTB;
            glds16(ksrc + (size_t)kr * 64, (unsigned)__builtin_amdgcn_readfirstlane(kdst + sn)); glds16(vsrc + (size_t)kr * 64, (unsigned)__builtin_amdgcn_readfirstlane(vdst + sn)); }
        bool live = true;
        if (t >= 4) {
            if constexpr (MODE == 1) { const int jr = (u.kbase >> 6) + (t - 4), qr_ = (u.q0 >> 6) + (wid >> 1); int rs = qr_ - 4; rs = rs < 0 ? 0 : (rs > 248 ? 248 : rs); live = (unsigned)(jr - rs) < 8u; }
            if constexpr (MODE == 2) { const int k0 = u.kbase + 64 * (t - 4), qa = u.q0 + wid * QBLK; live = (k0 + 63 >= qa - 128) && (k0 <= qa + QBLK - 1 + 128); }
        }
        if (!live) continue;
        f32x16 p0, p1;
        qkt(p0, p1, shm + LDS_K + sl, qr, zero, r32, hi);
        amask<MODE>(p0, p1, t, u, wid, r32, hi, rpb);
        if (NOMAX && t > 0) {
            float sacc = 0.f;
#pragma unroll
            for (int r = 0; r < 16; ++r) { p0[r] = __builtin_amdgcn_exp2f(p0[r] - m_run); p1[r] = __builtin_amdgcn_exp2f(p1[r] - m_run); sacc += p0[r] + p1[r]; }
            l_reg += sacc;
        } else {
        float rm = p0[0];
#pragma unroll
        for (int r = 1; r < 16; ++r) rm = __builtin_fmaxf(rm, p0[r]);
#pragma unroll
        for (int r = 0; r < 16; ++r) rm = __builtin_fmaxf(rm, p1[r]);
        { auto rr = __builtin_amdgcn_permlane32_swap(__float_as_uint(rm), __float_as_uint(rm), false, false); rm = __builtin_fmaxf(__uint_as_float(rr[0]), __uint_as_float(rr[1])); }
        const float m_new = __builtin_fmaxf(m_run, rm);
        const float alpha = __builtin_amdgcn_exp2f(m_run - m_new); m_run = m_new;
        float sacc = 0.f;
#pragma unroll
        for (int r = 0; r < 16; ++r) { p0[r] = __builtin_amdgcn_exp2f(p0[r] - m_new); p1[r] = __builtin_amdgcn_exp2f(p1[r] - m_new); sacc += p0[r] + p1[r]; }
        l_reg = l_reg * alpha + sacc;
        if (hi == 0) wsf[r32] = alpha;
        asm volatile("s_waitcnt lgkmcnt(0)" ::: "memory");
#pragma unroll
        for (int d_ = 0; d_ < 2; ++d_)
#pragma unroll
            for (int r = 0; r < 16; ++r) o[d_][r] *= wsf[crow(r, hi)];
        }
        v4u pw0, pw1, pw2, pw3;
        pw0 = (v4u){cvtpk_s(p0[0], p0[1]), cvtpk_s(p0[2], p0[3]), cvtpk_s(p0[4], p0[5]), cvtpk_s(p0[6], p0[7])}; pw1 = (v4u){cvtpk_s(p0[8], p0[9]), cvtpk_s(p0[10], p0[11]), cvtpk_s(p0[12], p0[13]), cvtpk_s(p0[14], p0[15])};
        pw2 = (v4u){cvtpk_s(p1[0], p1[1]), cvtpk_s(p1[2], p1[3]), cvtpk_s(p1[4], p1[5]), cvtpk_s(p1[6], p1[7])}; pw3 = (v4u){cvtpk_s(p1[8], p1[9]), cvtpk_s(p1[10], p1[11]), cvtpk_s(p1[12], p1[13]), cvtpk_s(p1[14], p1[15])};
        asm volatile("s_waitcnt lgkmcnt(0)" ::: "memory"); SBAR();
        pv(o, vb0 + sl, __builtin_bit_cast(bf16x8, pw0), __builtin_bit_cast(bf16x8, pw1), __builtin_bit_cast(bf16x8, pw2), __builtin_bit_cast(bf16x8, pw3));
    }
    { auto rr = __builtin_amdgcn_permlane32_swap(__float_as_uint(l_reg), __float_as_uint(l_reg), false, false); l_reg = __uint_as_float(rr[0]) + __uint_as_float(rr[1]); }
    if constexpr (NOMAX) {
        const bool ok = (l_reg > 0x1p-90f) && (l_reg < 0x1p90f);
        if (__any(!ok)) { if (lane == 0) *okflag = 1; }
        asm volatile("s_waitcnt vmcnt(0) lgkmcnt(0)\n\ts_barrier" ::: "memory");
        const int bad = __builtin_amdgcn_readfirstlane(*okflag);
        if (bad) { asm volatile("s_waitcnt lgkmcnt(0)\n\ts_barrier" ::: "memory"); return false; }
    }
    l_reg += __builtin_amdgcn_exp2f(u.sinkl2 - m_run);
    asm volatile("s_waitcnt lgkmcnt(0)" ::: "memory");
    if (hi == 0) wsf[32 + r32] = l_reg; asm volatile("s_waitcnt lgkmcnt(0)" ::: "memory");
    float rli[16];
#pragma unroll
    for (int r = 0; r < 16; ++r) rli[r] = __builtin_amdgcn_rcpf(wsf[32 + crow(r, hi)]);
    {
        bf16* Ow = u.O + (size_t)(u.q0 + wid * QBLK) * 1024;
        bf16* stg = (bf16*)(shm + LDS_OST + wid * 8192);
#pragma unroll
        for (int r = 0; r < 16; ++r) { const int orow = crow(r, hi);
#pragma unroll
            for (int d0 = 0; d0 < 2; ++d0) stg[orow * 64 + d0 * 32 + r32] = __float2bfloat16(o[d0][r] * rli[r]); }
        asm volatile("s_waitcnt lgkmcnt(0)" ::: "memory");
#pragma unroll
        for (int i = 0; i < 4; ++i) { const int row = i * 8 + (lane >> 3), ch = lane & 7; const v4u v = *(const v4u*)(stg + row * 64 + ch * 8); *(v4u*)(Ow + (size_t)row * 1024 + ch * 8) = v; }
    }
    asm volatile("s_waitcnt vmcnt(0) lgkmcnt(0)\n\ts_barrier" ::: "memory");
    return true;
#undef KROW
}
#undef SBAR
#undef WAIT_BAR
}
struct Args { const float* in[23]; float* out; unsigned char* ws; int flags; int pad; };
enum { I_X = 0, I_C, I_CTX, I_CCTX, I_N1W, I_N2W, I_ADAW, I_ADAB, I_WIN, I_RPB, I_DLAM, I_SUBW, I_SINK, I_QKNW, I_WBR, I_WGATE, I_BGATE, I_WOUT, I_PWQ, I_PKEYS, I_PU, I_PV, I_FNW };

struct Frame {
    LAS unsigned char* lds; volatile LAS unsigned* MISC; gu32* ctl;
    int wave, vcu, G;
};
__device__ __forceinline__ int ltid(int wave) { return tid_now(wave); }

struct MapId   { __device__ __forceinline__ int operator()(int n) const { return n; } };
struct MapWin  { __device__ __forceinline__ int operator()(int n) const { return (n & ~255) + 128 * ((n >> 5) & 1) + 32 * ((n >> 6) & 3) + (n & 31); } };
struct MapGate { __device__ __forceinline__ int operator()(int n) const { const int br = n >> 10, ch = n & 1023; return 256 * (ch >> 6) + 128 * (br >> 1) + 32 * ((ch >> 4) & 3) + 16 * (br & 1) + (ch & 15); } };
template <class Map, bool F8 = false> __device__ __forceinline__ void transpose_item(const float* W, int K, int N, void* WTv, Map mp, LAS float* scr, int item, int lane) {
    bf16_t* WT = (bf16_t*)WTv; unsigned char* WT8 = (unsigned char*)WTv;
    const int nblk = N / 32, kb = item / nblk, nb = item % nblk, k0 = 64 * kb, n0 = 32 * nb;
#pragma unroll 8
    for (int i = 0; i < 32; ++i) { const int kk = 2 * i + (lane >> 5); scr[kk * 33 + (lane & 31)] = W[(size_t)(k0 + kk) * N + n0 + (lane & 31)]; }
    LDS_WAIT(); asm volatile("" ::: "memory");
    const int c = lane & 7;
#pragma unroll
    for (int j = 0; j < 4; ++j) { const int n = (lane >> 3) + 8 * j; const LAS float* s = scr + (8 * c) * 33 + n;
        int nn = n0 + n; asm volatile("" : "+v"(nn));
        if constexpr (F8) { v2u o; o.x = pk4_fp8(s[0 * 33] * 64.f, s[1 * 33] * 64.f, s[2 * 33] * 64.f, s[3 * 33] * 64.f); o.y = pk4_fp8(s[4 * 33] * 64.f, s[5 * 33] * 64.f, s[6 * 33] * 64.f, s[7 * 33] * 64.f);
            *(GAS v2u*)(WT8 + (size_t)mp(nn) * K + k0 + 8 * c) = o; }
        else { v4u o; o.x = pk2(s[0 * 33], s[1 * 33]); o.y = pk2(s[2 * 33], s[3 * 33]); o.z = pk2(s[4 * 33], s[5 * 33]); o.w = pk2(s[6 * 33], s[7 * 33]);
            *(GAS v4u*)(WT + (size_t)mp(nn) * K + k0 + 8 * c) = o; } }
    LDS_WAIT(); asm volatile("" ::: "memory");
}
__device__ __forceinline__ void modnorm_row(const float* xrow, bf16_t* orow, const float* nw, const float* sh, const float* sc, int lane, unsigned char* o8row = nullptr) {
    const GAS f32x4* xr = (const GAS f32x4*)xrow + lane;
    f32x4 v[4]; float s = 0.f;
#pragma unroll
    for (int j = 0; j < 4; ++j) { v[j] = xr[64 * j]; s += (v[j].x * v[j].x + v[j].y * v[j].y) + (v[j].z * v[j].z + v[j].w * v[j].w); }
    const float ri = __builtin_amdgcn_rsqf(wave_sum(s) * (1.f / DM) + EPS);
    GAS v2u* o8 = (GAS v2u*)orow + lane;
#pragma unroll
    for (int j = 0; j < 4; ++j) { const int col = 256 * j + 4 * lane; const f32x4 w = *(const f32x4*)(nw + col), a = *(const f32x4*)(sc + col), b = *(const f32x4*)(sh + col);
        const f32x4 y = (v[j] * ri * w) * (1.0f + a) + b;
        if (orow) { v2u p; p.x = pk2(y.x, y.y); p.y = pk2(y.z, y.w); o8[64 * j] = p; }
        if (o8row) ((GAS unsigned*)o8row)[64 * j + lane] = pk4_fp8(y.x, y.y, y.z, y.w); }
}

__device__ __forceinline__ void ce_desc(float& a, float& b) { const float hi = __builtin_fmaxf(a, b), lo = __builtin_fminf(a, b); a = hi; b = lo; }
__device__ __forceinline__ void sort16_desc(float (&x)[16]) {
#pragma unroll
    for (int k = 2; k <= 16; k <<= 1)
#pragma unroll
        for (int j = k >> 1; j > 0; j >>= 1)
#pragma unroll
            for (int i = 0; i < 16; ++i) { const int l = i ^ j; if (l > i) { if ((i & k) == 0) ce_desc(x[i], x[l]); else ce_desc(x[l], x[i]); } }
}
__device__ __forceinline__ void merge16_desc(float (&top)[16], const float (&c)[16]) {
#pragma unroll
    for (int i = 0; i < 16; ++i) top[i] = __builtin_fmaxf(top[i], c[15 - i]);
#pragma unroll
    for (int j = 8; j > 0; j >>= 1)
#pragma unroll
        for (int i = 0; i < 16; ++i) { const int l = i ^ j; if (l > i) ce_desc(top[i], top[l]); }
}

struct PeerArgs { unsigned char* H8out_xq; unsigned char* H8out; const float* S; const bf16_t* Hin; const unsigned char* U; const unsigned char* V; const float* SU; const float* SV; const float* Xin; float* Xout;
                  const float* g2l; const float* g2c;
                  bf16_t* Hout; const float* nwn; const float* shl; const float* scl; const float* shc; const float* scc;
                  float* fout; const float* fnw;
                  int nblocks; int* dbg_eid; float* dbg_gt; bool dry; int route_reps; };
struct PeerBufs;
constexpr int PL_LISTS = 0, PL_EID = 40960, PL_GT = PL_EID + 16384;
__device__ __forceinline__ float dot2bf(unsigned a, unsigned b, float acc) { return __builtin_amdgcn_fdot2_f32_bf16(__builtin_bit_cast(bf16x2_t, a), __builtin_bit_cast(bf16x2_t, b), acc, false); }
__device__ __forceinline__ float dot8(const v4u a, const v4u b, float acc) {
    const unsigned a0 = a.x, a1 = a.y, a2 = a.z, a3 = a.w, b0 = b.x, b1 = b.y, b2 = b.z, b3 = b.w;
    acc = dot2bf(a0, b0, acc); acc = dot2bf(a1, b1, acc); acc = dot2bf(a2, b2, acc); acc = dot2bf(a3, b3, acc);
    return acc;
}
struct PeerBufs { int* eid; float* gt; float* a; unsigned char* xq; float* sx; };
__device__ __forceinline__ void peer_route(Frame& F, const PeerArgs& P, const PeerBufs& B) {
    const int tid = ltid(F.wave), lane = tid & 63;
    LAS unsigned* lists = (LAS unsigned*)(F.lds + PL_LISTS);
    LAS int* eid = (LAS int*)(F.lds + PL_EID);
    LAS float* gt = (LAS float*)(F.lds + PL_GT);
    for (int blk = F.vcu; blk < P.nblocks; blk += F.G) {
        const int row0 = blk * 32;
        {
            const int tok = tid >> 4, lst = tid & 15;
            const float* sp = P.S + (size_t)(row0 + tok) * 2048 + lst * 128;
            float top[16];
#pragma unroll 1
            for (int c = 0; c < 8; ++c) {
                float x[16];
#pragma unroll
                for (int q = 0; q < 4; ++q) { const f32x4 v = *(const f32x4*)(sp + c * 16 + q * 4);
#pragma unroll
                    for (int j = 0; j < 4; ++j) x[q * 4 + j] = __uint_as_float((__float_as_uint(v[j]) & ~127u) | (unsigned)(c * 16 + q * 4 + j)); }
                sort16_desc(x);
                if (c == 0) {
#pragma unroll
                    for (int i = 0; i < 16; ++i) top[i] = x[i];
                } else merge16_desc(top, x);
            }
            LAS unsigned* lp = lists + tid * 20;
#pragma unroll
            for (int q = 0; q < 4; ++q) *(LAS v4u*)(lp + q * 4) = (v4u){__float_as_uint(top[q * 4]), __float_as_uint(top[q * 4 + 1]), __float_as_uint(top[q * 4 + 2]), __float_as_uint(top[q * 4 + 3])};
        }
        __syncthreads();
        if (tid < 256) {
            const int tok = tid >> 3, hd = tid & 7;
            const LAS unsigned* la = lists + (tok * 16 + 2 * hd) * 20; const LAS unsigned* lb = la + 20;
            float av[16], bv[16];
#pragma unroll
            for (int q = 0; q < 4; ++q) { const v4u a = *(const LAS v4u*)(la + q * 4), b = *(const LAS v4u*)(lb + q * 4);
#pragma unroll
                for (int j = 0; j < 4; ++j) { av[q * 4 + j] = __uint_as_float(a[j] & ~127u); bv[q * 4 + j] = __uint_as_float(b[j] & ~127u); } }
            float c0[16], c1[16], c2[16], c3[16];
#pragma unroll
            for (int i = 0; i < 16; ++i) { c0[i] = -INFINITY; c1[i] = -INFINITY; c2[i] = -INFINITY; c3[i] = -INFINITY; }
            {
                int cnt = 0;
#pragma unroll
                for (int i = 0; i < 16; ++i)
#pragma unroll
                    for (int j = 0; j < 16; ++j) if ((i + 1) * (j + 1) <= 16) {
                        const float sm = __uint_as_float((__float_as_uint(av[i] + bv[j]) & ~255u) | (unsigned)(i * 16 + j));
                        const int slot = cnt & 15, arr = cnt >> 4;
                        if (arr == 0) c0[slot] = sm; else if (arr == 1) c1[slot] = sm; else if (arr == 2) c2[slot] = sm; else c3[slot] = sm;
                        ++cnt;
                    }
            }
            sort16_desc(c0); sort16_desc(c1); sort16_desc(c2); sort16_desc(c3);
            merge16_desc(c0, c1); merge16_desc(c0, c2); merge16_desc(c0, c3);
            float ev[16], sum = 0.f; const float m0 = __uint_as_float(__float_as_uint(c0[0]) & ~255u);
#pragma unroll
            for (int k = 0; k < 16; ++k) { ev[k] = fast_exp2((__uint_as_float(__float_as_uint(c0[k]) & ~255u) - m0) * LOG2E); sum += ev[k]; }
            const float rs = 1.0f / sum;
#pragma unroll
            for (int k = 0; k < 16; ++k) { const unsigned code = __float_as_uint(c0[k]) & 255u;
                const int ia = (int)(la[code >> 4] & 127u), ib = (int)(lb[code & 15u] & 127u);
                eid[tok * 128 + hd * 16 + k] = ia * NKEYS + ib; gt[tok * 128 + hd * 16 + k] = ev[k] * rs; }
        }
        __syncthreads();
#pragma unroll
        for (int i = 0; i < 8; ++i) { const int idx = i * NTHREADS + tid; B.eid[(size_t)row0 * 128 + idx] = eid[idx]; B.gt[(size_t)row0 * 128 + idx] = gt[idx]; }
#pragma unroll 1
        for (int tk = 0; tk < 4; ++tk) {
            const size_t row = (size_t)(row0 + F.wave * 4 + tk);
            const bf16_t* hp = P.Hin + row * DM + 16 * lane;
            const v4u h0 = *(const v4u*)hp, h1 = *(const v4u*)(hp + 8);
            float xf[16];
#pragma unroll
            for (int q = 0; q < 4; ++q) { xf[2 * q] = bflo(h0[q]); xf[2 * q + 1] = bfhi(h0[q]); xf[8 + 2 * q] = bflo(h1[q]); xf[8 + 2 * q + 1] = bfhi(h1[q]); }
            float am = 0.f;
#pragma unroll
            for (int i = 0; i < 16; ++i) am = __builtin_fmaxf(am, __builtin_fabsf(xf[i]));
            am = wave_max(am);
            const float ix = am > 0.f ? 127.f / am : 0.f;
            v4u xq;
#pragma unroll
            for (int q = 0; q < 4; ++q) { unsigned w = 0;
#pragma unroll
                for (int j = 0; j < 4; ++j) { const int v = (int)__builtin_rintf(xf[4 * q + j] * ix); w |= (unsigned)(v & 0xff) << (8 * j); }
                xq[q] = w; }
            *(v4u*)(B.xq + row * DM + 16 * lane) = xq;
            if (lane == 0) B.sx[row] = am * (1.f / 127.f);
        }
        __syncthreads();
    }
}
__device__ __forceinline__ int wave_isum(int v) {
    v += __builtin_amdgcn_update_dpp(0, v, 0xB1, 0xf, 0xf, false);
    v += __builtin_amdgcn_update_dpp(0, v, 0x4E, 0xf, 0xf, false);
    v += __builtin_amdgcn_update_dpp(0, v, 0x141, 0xf, 0xf, false);
    v += __builtin_amdgcn_update_dpp(0, v, 0x140, 0xf, 0xf, false);
    v += __builtin_amdgcn_update_dpp(0, v, 0x142, 0xa, 0xf, false);
    v += __builtin_amdgcn_update_dpp(0, v, 0x143, 0xc, 0xf, false);
    return __builtin_amdgcn_readlane(v, 63);
}
__device__ __forceinline__ int bperm_i(int v, int srclane) { return __builtin_amdgcn_ds_bpermute(srclane << 2, v); }
__device__ __forceinline__ float bperm_f(float v, int srclane) { return __builtin_bit_cast(float, __builtin_amdgcn_ds_bpermute(srclane << 2, __builtin_bit_cast(int, v))); }
__device__ __forceinline__ int treduce16(const int (&d)[16], int lane) {
    int s8[8], s4[4], s2[2];
#pragma unroll
    for (int i = 0; i < 8; ++i) { auto r = __builtin_amdgcn_permlane32_swap((unsigned)d[i], (unsigned)d[i + 8], false, false); s8[i] = (int)r[0] + (int)r[1]; }
#pragma unroll
    for (int i = 0; i < 4; ++i) { auto r = __builtin_amdgcn_permlane16_swap((unsigned)s8[i], (unsigned)s8[i + 4], false, false); s4[i] = (int)r[0] + (int)r[1]; }
    const bool b3 = (lane & 8) != 0, b2 = (lane & 4) != 0;
#pragma unroll
    for (int i = 0; i < 2; ++i) { const int keep = b3 ? s4[i + 2] : s4[i], send = b3 ? s4[i] : s4[i + 2]; s2[i] = keep + __builtin_amdgcn_update_dpp(0, send, 0x128, 0xf, 0xf, false); }
    int z; { const int keep = b2 ? s2[1] : s2[0], send = b2 ? s2[0] : s2[1]; z = keep + __builtin_amdgcn_ds_swizzle(send, 0x101F); }
    z += __builtin_amdgcn_update_dpp(0, z, 0x4E, 0xf, 0xf, false);
    z += __builtin_amdgcn_update_dpp(0, z, 0xB1, 0xf, 0xf, false);
    return z;
}
__device__ __forceinline__ void peer_u(Frame& F, const PeerArgs& P, const PeerBufs& B, int ntok) {
    const int lane = ltid(F.wave) & 63;
    const int nsl = 8, wps = (F.G / nsl) * NWAVES;
    const int j = F.vcu / (F.G / nsl), wsl = (F.vcu % (F.G / nsl)) * NWAVES + F.wave;
    const int esel = (lane >> 2) & 15;
    int t = wsl; if (t >= ntok) return;
    int e_lo = B.eid[(size_t)t * 128 + lane], e_hi = B.eid[(size_t)t * 128 + 64 + lane];
    float g_lo = B.gt[(size_t)t * 128 + lane], g_hi = B.gt[(size_t)t * 128 + 64 + lane];
    v4u xq = *(const v4u*)(B.xq + (size_t)t * DM + 16 * lane); float sx = B.sx[t];
    for (;;) {
        const int tn = t + wps; const bool more = tn < ntok; const int tp = more ? tn : t;
        const int ne_lo = B.eid[(size_t)tp * 128 + lane], ne_hi = B.eid[(size_t)tp * 128 + 64 + lane];
        const float ng_lo = B.gt[(size_t)tp * 128 + lane], ng_hi = B.gt[(size_t)tp * 128 + 64 + lane];
        const v4u nxq = *(const v4u*)(B.xq + (size_t)tp * DM + 16 * lane); const float nsx = B.sx[tp];
        unsigned long long m_lo = __ballot((e_lo >> 11) == j), m_hi = __ballot((e_hi >> 11) == j);
        const int n = __popcll(m_lo) + __popcll(m_hi);
        v4u ua[32]; int slotv0 = -1, idv0 = 0, slotv1 = -1, idv1 = 0;
#pragma unroll
        for (int q = 0; q < 32; ++q) {
            ua[q] = (v4u){0u, 0u, 0u, 0u};
            if (q < n) {
                int k, id;
                if (m_lo) { k = __builtin_ctzll(m_lo); m_lo &= m_lo - 1; id = __builtin_amdgcn_readlane(e_lo, k); }
                else { k = __builtin_ctzll(m_hi); m_hi &= m_hi - 1; id = __builtin_amdgcn_readlane(e_hi, k); k += 64; }
                ua[q] = *(const v4u*)(P.U + (size_t)id * DM + 16 * lane);
                if (q < 16) { if (esel == q) { slotv0 = k; idv0 = id; } } else { if (esel == q - 16) { slotv1 = k; idv1 = id; } }
            }
        }
        const float su0 = P.SU[idv0], sv0 = P.SV[idv0], su1 = P.SU[idv1], sv1 = P.SV[idv1];
        const float gl0 = bperm_f(g_lo, slotv0 & 63), gh0 = bperm_f(g_hi, slotv0 & 63), gl1 = bperm_f(g_lo, slotv1 & 63), gh1 = bperm_f(g_hi, slotv1 & 63);
        const float gg0 = slotv0 < 64 ? gl0 : gh0, gg1 = slotv1 < 64 ? gl1 : gh1;
        int d[16];
#pragma unroll
        for (int q = 0; q < 16; ++q) { int di = __builtin_amdgcn_sdot4((int)ua[q][0], (int)xq[0], 0, false); di = __builtin_amdgcn_sdot4((int)ua[q][1], (int)xq[1], di, false);
            di = __builtin_amdgcn_sdot4((int)ua[q][2], (int)xq[2], di, false); d[q] = __builtin_amdgcn_sdot4((int)ua[q][3], (int)xq[3], di, false); }
        { const int z = treduce16(d, lane);
          if (slotv0 >= 0 && (lane & 3) == 0) B.a[(size_t)t * 128 + slotv0] = gg0 * gelu_tanh((float)z * su0 * sx) * sv0; }
        if (n > 16) {
#pragma unroll
            for (int q = 0; q < 16; ++q) { int di = __builtin_amdgcn_sdot4((int)ua[16 + q][0], (int)xq[0], 0, false); di = __builtin_amdgcn_sdot4((int)ua[16 + q][1], (int)xq[1], di, false);
                di = __builtin_amdgcn_sdot4((int)ua[16 + q][2], (int)xq[2], di, false); d[q] = __builtin_amdgcn_sdot4((int)ua[16 + q][3], (int)xq[3], di, false); }
            const int z = treduce16(d, lane);
            if (slotv1 >= 0 && (lane & 3) == 0) B.a[(size_t)t * 128 + slotv1] = gg1 * gelu_tanh((float)z * su1 * sx) * sv1;
        }
        if (n > 32) {
            while (m_lo | m_hi) { int k, id;
                if (m_lo) { k = __builtin_ctzll(m_lo); m_lo &= m_lo - 1; id = __builtin_amdgcn_readlane(e_lo, k); }
                else { k = __builtin_ctzll(m_hi); m_hi &= m_hi - 1; id = __builtin_amdgcn_readlane(e_hi, k); k += 64; }
                const v4u u1 = *(const v4u*)(P.U + (size_t)id * DM + 16 * lane);
                int di = __builtin_amdgcn_sdot4((int)u1[0], (int)xq[0], 0, false); di = __builtin_amdgcn_sdot4((int)u1[1], (int)xq[1], di, false);
                di = __builtin_amdgcn_sdot4((int)u1[2], (int)xq[2], di, false); di = __builtin_amdgcn_sdot4((int)u1[3], (int)xq[3], di, false);
                const int tot = wave_isum(di);
                const float g = __uint_as_float(k < 64 ? __builtin_amdgcn_readlane(__float_as_uint(g_lo), k) : __builtin_amdgcn_readlane(__float_as_uint(g_hi), k - 64));
                if (lane == 0) B.a[(size_t)t * 128 + k] = g * gelu_tanh((float)tot * P.SU[id] * sx) * P.SV[id]; }
        }
        if (!more) break;
        t = tn; e_lo = ne_lo; e_hi = ne_hi; g_lo = ng_lo; g_hi = ng_hi; xq = nxq; sx = nsx;
    }
}
__device__ __forceinline__ void peer_v(Frame& F, const PeerArgs& P, const PeerBufs& B, int ntok) {
    const int lane = ltid(F.wave) & 63;
    const int nsl = 8, wps = (F.G / nsl) * NWAVES;
    const int j = F.vcu / (F.G / nsl), wsl = (F.vcu % (F.G / nsl)) * NWAVES + F.wave;
    const int grp = lane >> 3, ch = lane & 7;
    int t = wsl; if (t >= ntok) return;
#define PV_HDR(tt, EL, EH, CL, CH) do { EL = B.eid[(size_t)(tt) * 128 + lane]; EH = B.eid[(size_t)(tt) * 128 + 64 + lane]; CL = B.a[(size_t)(tt) * 128 + lane]; CH = B.a[(size_t)(tt) * 128 + 64 + lane]; } while (0)
#define PV_ROWS(W, CF, EL, EH, CL, CH) do { _Pragma("unroll") for (int i = 0; i < 16; ++i) { const int src = (8 * i + grp) & 63; const int id = bperm_i(i < 8 ? EL : EH, src); CF[i] = bperm_f(i < 8 ? CL : CH, src); \
            W[i] = *(const v4u*)(P.V + (size_t)id * DM + 128 * j + 16 * ch); } } while (0)
    int e_lo, e_hi, ne_lo, ne_hi; float c_lo, c_hi, nc_lo, nc_hi;
    v4u wA[16], wB[16]; float cfA[16], cfB[16];
    PV_HDR(t, e_lo, e_hi, c_lo, c_hi);
    { const int t1 = (t + wps < ntok) ? t + wps : t; PV_HDR(t1, ne_lo, ne_hi, nc_lo, nc_hi); }
    PV_ROWS(wA, cfA, e_lo, e_hi, c_lo, c_hi);
#define PV_STEP(W, CF, WN, CFN) do { \
        const int tn = t + wps; const bool more = tn < ntok; \
        if (more) { PV_ROWS(WN, CFN, ne_lo, ne_hi, nc_lo, nc_hi); const int t2 = (tn + wps < ntok) ? tn + wps : tn; PV_HDR(t2, ne_lo, ne_hi, nc_lo, nc_hi); } \
        float acc[16]; float asum = 0.f; \
        _Pragma("unroll") for (int c = 0; c < 16; ++c) acc[c] = 0.f; \
        _Pragma("unroll") for (int i = 0; i < 16; ++i) { asum += CF[i]; const f32x2 cf2 = {CF[i], CF[i]}; \
            _Pragma("unroll") for (int q = 0; q < 4; ++q) { const unsigned x = W[i][q]; \
                const f32x2 v01 = {(float)(x & 0xffu), (float)((x >> 8) & 0xffu)}, v23 = {(float)((x >> 16) & 0xffu), (float)(x >> 24)}; \
                f32x2 o01 = {acc[4 * q], acc[4 * q + 1]}, o23 = {acc[4 * q + 2], acc[4 * q + 3]}; \
                o01 = __builtin_elementwise_fma(cf2, v01, o01); o23 = __builtin_elementwise_fma(cf2, v23, o23); \
                acc[4 * q] = o01.x; acc[4 * q + 1] = o01.y; acc[4 * q + 2] = o23.x; acc[4 * q + 3] = o23.y; } } \
        asum += __builtin_bit_cast(float, __builtin_amdgcn_update_dpp(0, __builtin_bit_cast(int, asum), 0x128, 0xf, 0xf, false)); asum += xorf<16>(asum); asum = x32_sum(asum); \
        _Pragma("unroll") for (int c = 0; c < 16; ++c) { acc[c] += __builtin_bit_cast(float, __builtin_amdgcn_update_dpp(0, __builtin_bit_cast(int, acc[c]), 0x128, 0xf, 0xf, false)); acc[c] += xorf<16>(acc[c]); acc[c] = x32_sum(acc[c]); } \
        if (lane < 8) { \
            const int col0 = 128 * j + 16 * lane; const float* g2 = (t < SEQ) ? P.g2l : P.g2c; \
            _Pragma("unroll") for (int q = 0; q < 4; ++q) { const f32x4 xo = *(const f32x4*)(P.Xin + (size_t)t * DM + col0 + 4 * q), g = *(const f32x4*)(g2 + col0 + 4 * q); \
                f32x4 y; y.x = xo.x + g.x * (acc[4 * q] - 128.f * asum); y.y = xo.y + g.y * (acc[4 * q + 1] - 128.f * asum); y.z = xo.z + g.z * (acc[4 * q + 2] - 128.f * asum); y.w = xo.w + g.w * (acc[4 * q + 3] - 128.f * asum); \
                *(f32x4*)(P.Xout + (size_t)t * DM + col0 + 4 * q) = y; } \
        } \
        done = !more; t = tn; } while (0)
    bool done = false;
    for (;;) {
        PV_STEP(wA, cfA, wB, cfB); if (done) break;
        PV_STEP(wB, cfB, wA, cfA); if (done) break;
    }
#undef PV_HDR
#undef PV_ROWS
#undef PV_STEP
}
__device__ __forceinline__ void peer_norm(Frame& F, const PeerArgs& P, int ntok) {
    const int lane = ltid(F.wave) & 63; const int gw = F.vcu * NWAVES + F.wave, NGW = F.G * NWAVES;
    for (int t = gw; t < ntok; t += NGW) {
        const bool latent = t < SEQ;
        if (P.fout) {
            const GAS f32x4* xr = (const GAS f32x4*)(P.Xout + (size_t)t * DM) + lane; f32x4 v[4]; float s = 0.f;
#pragma unroll
            for (int q = 0; q < 4; ++q) { v[q] = xr[64 * q]; s += (v[q].x * v[q].x + v[q].y * v[q].y) + (v[q].z * v[q].z + v[q].w * v[q].w); }
            const float ri = __builtin_amdgcn_rsqf(wave_sum(s) * (1.f / DM) + EPS);
#pragma unroll
            for (int q = 0; q < 4; ++q) { const f32x4 w = *(const f32x4*)(P.fnw + 256 * q + 4 * lane); *(f32x4*)(P.fout + (size_t)t * DM + 256 * q + 4 * lane) = v[q] * ri * w; }
        } else modnorm_row(P.Xout + (size_t)t * DM, P.Hout ? P.Hout + (size_t)t * DM : (bf16_t*)nullptr, P.nwn, latent ? P.shl : P.shc, latent ? P.scl : P.scc, lane, P.H8out ? P.H8out + (size_t)t * DM : (unsigned char*)nullptr);
    }
}

constexpr int P2_Y = 0;
constexpr int P2_EID = 73728, P2_GT = P2_EID + 72 * 128 * 2, P2_SX = P2_GT + 72 * 128 * 4, P2_END = P2_SX + 72 * 4;
static_assert(P2_END <= RING_BYTES, "peer2 LDS map");
template <int NTK> __device__ __forceinline__ void peer2_tokens(Frame& F, const PeerArgs& P, int t_begin, int lt0, int cnt, int lane_in) {
    int lane = lane_in; asm volatile("" : "+v"(lane));
    const LAS unsigned short* eidL = (const LAS unsigned short*)(F.lds + P2_EID); LAS float* gtL = (LAS float*)(F.lds + P2_GT); const LAS float* sxL = (const LAS float*)(F.lds + P2_SX);
#define g (lane >> 3)
#define c (lane & 7)
    const unsigned char* xqb = P.H8out_xq;
    int d[NTK][16];
#pragma unroll
    for (int tk = 0; tk < NTK; ++tk)
#pragma unroll
        for (int i = 0; i < 16; ++i) d[tk][i] = 0;
#pragma unroll 1
    for (int ps = 0; ps < 8; ++ps) {
#pragma unroll
        for (int tk = 0; tk < NTK; ++tk) {
            if (tk < cnt) {
                const int lt = lt0 + tk; const unsigned row = (unsigned)(t_begin + lt);
                const v4u xq = *(const v4u*)(xqb + (unsigned)(row * DM + 128 * ps + 16 * c));
                v4u ua[16];
#pragma unroll
                for (int i = 0; i < 16; ++i) { const int id = eidL[lt * 128 + 8 * i + g]; ua[i] = *(const v4u*)(P.U + (unsigned)((ps * NEXP + id) * 128 + 16 * c)); }
#pragma unroll
                for (int i = 0; i < 16; ++i) { int di = __builtin_amdgcn_sdot4((int)ua[i][0], (int)xq[0], d[tk][i], false); di = __builtin_amdgcn_sdot4((int)ua[i][1], (int)xq[1], di, false);
                    di = __builtin_amdgcn_sdot4((int)ua[i][2], (int)xq[2], di, false); d[tk][i] = __builtin_amdgcn_sdot4((int)ua[i][3], (int)xq[3], di, false); }
                __builtin_amdgcn_sched_barrier(0);
            }
        }
    }
    asm volatile("" : "+v"(lane));
#pragma unroll
    for (int tk = 0; tk < NTK; ++tk) {
        if (tk < cnt) {
            const int lt = lt0 + tk; const float sx = sxL[lt];
            int mine0 = 0, mine1 = 0;
#pragma unroll
            for (int i = 0; i < 16; ++i) { int v = d[tk][i];
                v += __builtin_amdgcn_update_dpp(0, v, 0xB1, 0xf, 0xf, false); v += __builtin_amdgcn_update_dpp(0, v, 0x4E, 0xf, 0xf, false); v += __builtin_amdgcn_update_dpp(0, v, 0x141, 0xf, 0xf, false);
                if ((i & 7) == c) { if (i < 8) mine0 = v; else mine1 = v; } }
#pragma unroll
            for (int hf = 0; hf < 2; ++hf) { const int e = 8 * (8 * hf + c) + g; const int id = eidL[lt * 128 + e];
                const float pre = (float)(hf ? mine1 : mine0) * (P.SU[id] * sx);
                gtL[lt * 128 + e] = gtL[lt * 128 + e] * gelu_tanh(pre) * P.SV[id]; }
        }
    }
    LDS_WAIT();
    asm volatile("" : "+v"(lane));
    LAS unsigned char* yL = F.lds + P2_Y + F.wave * (4 * 2048);
#pragma unroll 1
    for (int ps = 0; ps < 8; ++ps) {
#pragma unroll
        for (int tk = 0; tk < NTK; ++tk) {
            if (tk < cnt) {
                const int lt = lt0 + tk; const unsigned row = (unsigned)(t_begin + lt);
                v4u w[16]; float cf[16];
#pragma unroll
                for (int i = 0; i < 16; ++i) { const int id = eidL[lt * 128 + 8 * i + g]; cf[i] = gtL[lt * 128 + 8 * i + g]; w[i] = *(const v4u*)(P.V + (unsigned)((ps * NEXP + id) * 128 + 16 * c)); }
                float acc[16]; float asum = 0.f;
#pragma unroll
                for (int q = 0; q < 16; ++q) acc[q] = 0.f;
#pragma unroll
                for (int i = 0; i < 16; ++i) { asum += cf[i]; const f32x2 cf2 = {cf[i], cf[i]};
#pragma unroll
                    for (int q = 0; q < 4; ++q) { const unsigned x = w[i][q];
                        const f32x2 v01 = {(float)(x & 0xffu), (float)((x >> 8) & 0xffu)}, v23 = {(float)((x >> 16) & 0xffu), (float)(x >> 24)};
                        f32x2 o01 = {acc[4 * q], acc[4 * q + 1]}, o23 = {acc[4 * q + 2], acc[4 * q + 3]};
                        o01 = __builtin_elementwise_fma(cf2, v01, o01); o23 = __builtin_elementwise_fma(cf2, v23, o23);
                        acc[4 * q] = o01.x; acc[4 * q + 1] = o01.y; acc[4 * q + 2] = o23.x; acc[4 * q + 3] = o23.y; } }
                asum += __builtin_bit_cast(float, __builtin_amdgcn_update_dpp(0, __builtin_bit_cast(int, asum), 0x128, 0xf, 0xf, false)); asum += xorf<16>(asum); asum = x32_sum(asum);
#pragma unroll
                for (int q = 0; q < 16; ++q) { acc[q] += __builtin_bit_cast(float, __builtin_amdgcn_update_dpp(0, __builtin_bit_cast(int, acc[q]), 0x128, 0xf, 0xf, false)); acc[q] += xorf<16>(acc[q]); acc[q] = x32_sum(acc[q]); }
                if (lane < 8) {
                    v4u y0, y1;
                    y0.x = pk2(acc[0] - 128.f * asum, acc[1] - 128.f * asum); y0.y = pk2(acc[2] - 128.f * asum, acc[3] - 128.f * asum); y0.z = pk2(acc[4] - 128.f * asum, acc[5] - 128.f * asum); y0.w = pk2(acc[6] - 128.f * asum, acc[7] - 128.f * asum);
                    y1.x = pk2(acc[8] - 128.f * asum, acc[9] - 128.f * asum); y1.y = pk2(acc[10] - 128.f * asum, acc[11] - 128.f * asum); y1.z = pk2(acc[12] - 128.f * asum, acc[13] - 128.f * asum); y1.w = pk2(acc[14] - 128.f * asum, acc[15] - 128.f * asum);
                    LAS v4u* yp = (LAS v4u*)(yL + tk * 2048 + (128 * ps + 16 * lane) * 2); yp[0] = y0; yp[1] = y1;
                }
                __builtin_amdgcn_sched_barrier(0);
            }
        }
    }
    asm volatile("" : "+v"(lane));
    LDS_WAIT();
#pragma unroll
    for (int tk = 0; tk < NTK; ++tk) {
        if (tk < cnt) {
            const int lt = lt0 + tk; const unsigned row = (unsigned)(t_begin + lt); const bool latent = row < (unsigned)SEQ;
            const float* g2 = latent ? P.g2l : P.g2c;
            f32x4 xn[4]; float ss = 0.f;
#pragma unroll
            for (int q = 0; q < 4; ++q) { const unsigned col = 256 * q + 4 * lane; const f32x4 xo = __builtin_nontemporal_load((const f32x4*)(P.Xin + (unsigned)(row * DM + col))), gq = *(const f32x4*)(g2 + col);
                const v2u yy = *(const LAS v2u*)(yL + tk * 2048 + col * 2);
                f32x4 y; y.x = xo.x + gq.x * bflo(yy.x); y.y = xo.y + gq.y * bfhi(yy.x); y.z = xo.z + gq.z * bflo(yy.y); y.w = xo.w + gq.w * bfhi(yy.y);
                xn[q] = y; ss += (y.x * y.x + y.y * y.y) + (y.z * y.z + y.w * y.w); }
            const float ri = __builtin_amdgcn_rsqf(wave_sum(ss) * (1.f / DM) + EPS);
            if (P.fout) {
                if (latent) {
#pragma unroll
                    for (int q = 0; q < 4; ++q) { const unsigned col = 256 * q + 4 * lane; const f32x4 wq_ = *(const f32x4*)(P.fnw + col); __builtin_nontemporal_store(xn[q] * ri * wq_, (f32x4*)(P.fout + (unsigned)(row * DM + col))); }
                }
            } else {
                const float* sh = latent ? P.shl : P.shc; const float* sc = latent ? P.scl : P.scc;
#pragma unroll
                for (int q = 0; q < 4; ++q) { const unsigned col = 256 * q + 4 * lane; const f32x4 wn = *(const f32x4*)(P.nwn + col), a = *(const f32x4*)(sc + col), b = *(const f32x4*)(sh + col);
                    __builtin_nontemporal_store(xn[q], (f32x4*)(P.Xout + (unsigned)(row * DM + col)));
                    const f32x4 y = (xn[q] * ri * wn) * (1.0f + a) + b;
                    if (P.Hout) { v2u pk; pk.x = pk2(y.x, y.y); pk.y = pk2(y.z, y.w); *(v2u*)(P.Hout + (unsigned)(row * DM + col)) = pk; }
                    if (P.H8out) *(unsigned*)(P.H8out + (unsigned)(row * DM + col)) = pk4_fp8(y.x, y.y, y.z, y.w); }
            }
        }
    }
}
#undef g
#undef c
__device__ __forceinline__ void peer_phase2(Frame& F, const PeerArgs& P) {
    const int tid = ltid(F.wave), lane = tid & 63;
    LAS unsigned* lists = (LAS unsigned*)(F.lds + PL_LISTS);
    LAS int* eid = (LAS int*)(F.lds + PL_EID);
    LAS float* gt = (LAS float*)(F.lds + PL_GT);
    LAS unsigned short* eidL = (LAS unsigned short*)(F.lds + P2_EID); LAS float* gtL = (LAS float*)(F.lds + P2_GT); LAS float* sxL = (LAS float*)(F.lds + P2_SX);
    const int ntok = P.nblocks * 32, tpc = (ntok + F.G - 1) / F.G, t_begin = F.vcu * tpc, t_end = (t_begin + tpc < ntok) ? t_begin + tpc : ntok;
    if (t_begin >= t_end) return;
    for (int row0 = t_begin; row0 < t_end; row0 += 32) {
        const int nt = (t_end - row0 < 32) ? t_end - row0 : 32;
        for (int rr = 0; rr < P.route_reps; ++rr) {
        if (rr) __syncthreads();
        {
            const int tok = tid >> 4, lst = tid & 15;
            const bf16_t* sp = (const bf16_t*)P.S + (size_t)(row0 + (tok < nt ? tok : nt - 1)) * 2048 + lst * 128;
            float top[16];
            v4u nv[2];
#pragma unroll
            for (int q = 0; q < 2; ++q) nv[q] = *(const v4u*)(sp + q * 8);
#pragma unroll 1
            for (int c = 0; c < 8; ++c) {
                float x[16];
#pragma unroll
                for (int e = 0; e < 16; ++e) { const unsigned w = nv[e >> 3][(e >> 1) & 3];
                    x[e] = __uint_as_float(((e & 1) ? (w & 0xffff0000u) : (w << 16)) | (unsigned)(c * 16 + e)); }
                if (c < 7) {
#pragma unroll
                    for (int q = 0; q < 2; ++q) nv[q] = *(const v4u*)(sp + (c + 1) * 16 + q * 8);
                }
                sort16_desc(x);
                if (c == 0) {
#pragma unroll
                    for (int i = 0; i < 16; ++i) top[i] = x[i];
                } else merge16_desc(top, x);
            }
            LAS unsigned* lp = lists + tid * 20;
#pragma unroll
            for (int q = 0; q < 4; ++q) *(LAS v4u*)(lp + q * 4) = (v4u){__float_as_uint(top[q * 4]), __float_as_uint(top[q * 4 + 1]), __float_as_uint(top[q * 4 + 2]), __float_as_uint(top[q * 4 + 3])};
        }
        __syncthreads();
        if (tid < 256) {
            const int tok = tid >> 3, hd = tid & 7;
            const LAS unsigned* la = lists + (tok * 16 + 2 * hd) * 20; const LAS unsigned* lb = la + 20;
            float av[16], bv[16];
#pragma unroll
            for (int q = 0; q < 4; ++q) { const v4u a = *(const LAS v4u*)(la + q * 4), b = *(const LAS v4u*)(lb + q * 4);
#pragma unroll
                for (int j = 0; j < 4; ++j) { av[q * 4 + j] = __uint_as_float(a[j] & ~127u); bv[q * 4 + j] = __uint_as_float(b[j] & ~127u); } }
            float c0[16], c1[16], c2[16], c3[16];
#pragma unroll
            for (int i = 0; i < 16; ++i) { c0[i] = -INFINITY; c1[i] = -INFINITY; c2[i] = -INFINITY; c3[i] = -INFINITY; }
            {
                int cnt = 0;
#pragma unroll
                for (int i = 0; i < 16; ++i)
#pragma unroll
                    for (int j = 0; j < 16; ++j) if ((i + 1) * (j + 1) <= 16) {
                        const float sm = __uint_as_float((__float_as_uint(av[i] + bv[j]) & ~255u) | (unsigned)(i * 16 + j));
                        const int slot = cnt & 15, arr = cnt >> 4;
                        if (arr == 0) c0[slot] = sm; else if (arr == 1) c1[slot] = sm; else if (arr == 2) c2[slot] = sm; else c3[slot] = sm;
                        ++cnt;
                    }
            }
            sort16_desc(c0); sort16_desc(c1); sort16_desc(c2); sort16_desc(c3);
            merge16_desc(c0, c1); merge16_desc(c0, c2); merge16_desc(c0, c3);
            float ev[16], sum = 0.f; const float m0 = __uint_as_float(__float_as_uint(c0[0]) & ~255u);
#pragma unroll
            for (int k = 0; k < 16; ++k) { ev[k] = fast_exp2((__uint_as_float(__float_as_uint(c0[k]) & ~255u) - m0) * LOG2E); sum += ev[k]; }
            const float rs = 1.0f / sum;
#pragma unroll
            for (int k = 0; k < 16; ++k) { const unsigned code = __float_as_uint(c0[k]) & 255u;
                const int ia = (int)(la[code >> 4] & 127u), ib = (int)(lb[code & 15u] & 127u);
                eid[tok * 128 + hd * 16 + k] = ia * NKEYS + ib; gt[tok * 128 + hd * 16 + k] = ev[k] * rs;
#if SELFCHECK
                if (tok < nt) { P.dbg_eid[(size_t)(row0 + tok) * 128 + hd * 16 + k] = ia * NKEYS + ib; P.dbg_gt[(size_t)(row0 + tok) * 128 + hd * 16 + k] = ev[k] * rs; }
#endif
            }
        }
        }
        __syncthreads();
        { const int lb = row0 - t_begin;
#pragma unroll
          for (int i = 0; i < 8; ++i) { const int idx = i * NTHREADS + tid; if ((idx >> 7) < nt) { eidL[lb * 128 + idx] = (unsigned short)eid[idx]; gtL[lb * 128 + idx] = gt[idx]; } }
#pragma unroll 1
          for (int tk = 0; tk < 4; ++tk) { const int tok = F.wave * 4 + tk; if (tok >= nt) break;
            const size_t row = (size_t)(row0 + tok);
            const bf16_t* hp = P.Hin + row * DM + 16 * lane;
            const v4u h0 = *(const v4u*)hp, h1 = *(const v4u*)(hp + 8);
            float xf[16];
#pragma unroll
            for (int q = 0; q < 4; ++q) { xf[2 * q] = bflo(h0[q]); xf[2 * q + 1] = bfhi(h0[q]); xf[8 + 2 * q] = bflo(h1[q]); xf[8 + 2 * q + 1] = bfhi(h1[q]); }
            float am = 0.f;
#pragma unroll
            for (int i = 0; i < 16; ++i) am = __builtin_fmaxf(am, __builtin_fabsf(xf[i]));
            am = wave_max(am);
            const float ix = am > 0.f ? 127.f / am : 0.f;
            v4u xq;
#pragma unroll
            for (int q = 0; q < 4; ++q) { unsigned w = 0;
#pragma unroll
                for (int j = 0; j < 4; ++j) { const int v = (int)__builtin_rintf(xf[4 * q + j] * ix); w |= (unsigned)(v & 0xff) << (8 * j); }
                xq[q] = w; }
            *(v4u*)(P.H8out_xq + row * DM + 16 * lane) = xq;
            if (lane == 0) sxL[lb + tok] = am * (1.f / 127.f); }
        }
        __syncthreads();
    }
    asm volatile("s_waitcnt vmcnt(0)" ::: "memory"); __syncthreads();
    const int ntot = t_end - t_begin;
#pragma unroll 1
    for (int gi = 0; gi < 2; ++gi) { const int lt0 = F.wave * 4 + 32 * gi; int cnt = ntot - lt0; cnt = cnt < 0 ? 0 : (cnt > 4 ? 4 : cnt); if (cnt > 0) peer2_tokens<4>(F, P, t_begin, lt0, cnt, lane); }
    if (ntot > 64 && F.wave == 0) peer2_tokens<1>(F, P, t_begin, 64, 1, lane);
}

__device__ __forceinline__ void peer_phase(Frame& F, const PeerArgs& P) {
    const int tid = ltid(F.wave), lane = tid & 63;
    LAS unsigned* lists = (LAS unsigned*)(F.lds + PL_LISTS);
    LAS int* eid = (LAS int*)(F.lds + PL_EID);
    LAS float* gt = (LAS float*)(F.lds + PL_GT);
    const int ntok = P.nblocks * 32, tpc = (ntok + F.G - 1) / F.G, t_begin = F.vcu * tpc, t_end = (t_begin + tpc < ntok) ? t_begin + tpc : ntok;
    for (int row0 = t_begin; row0 < t_end; row0 += 32) {
        const int nt = (t_end - row0 < 32) ? t_end - row0 : 32;
        for (int rr = 0; rr < P.route_reps; ++rr) {
        if (rr) __syncthreads();
        {
            const int tok = tid >> 4, lst = tid & 15;
            const bf16_t* sp = (const bf16_t*)P.S + (size_t)(row0 + (tok < nt ? tok : nt - 1)) * 2048 + lst * 128;
            float top[16];
            v4u nv[2];
#pragma unroll
            for (int q = 0; q < 2; ++q) nv[q] = *(const v4u*)(sp + q * 8);
#pragma unroll 1
            for (int c = 0; c < 8; ++c) {
                float x[16];
#pragma unroll
                for (int e = 0; e < 16; ++e) { const unsigned w = nv[e >> 3][(e >> 1) & 3];
                    x[e] = __uint_as_float(((e & 1) ? (w & 0xffff0000u) : (w << 16)) | (unsigned)(c * 16 + e)); }
                if (c < 7) {
#pragma unroll
                    for (int q = 0; q < 2; ++q) nv[q] = *(const v4u*)(sp + (c + 1) * 16 + q * 8);
                }
                sort16_desc(x);
                if (c == 0) {
#pragma unroll
                    for (int i = 0; i < 16; ++i) top[i] = x[i];
                } else merge16_desc(top, x);
            }
            LAS unsigned* lp = lists + tid * 20;
#pragma unroll
            for (int q = 0; q < 4; ++q) *(LAS v4u*)(lp + q * 4) = (v4u){__float_as_uint(top[q * 4]), __float_as_uint(top[q * 4 + 1]), __float_as_uint(top[q * 4 + 2]), __float_as_uint(top[q * 4 + 3])};
        }
        __syncthreads();
        if (tid < 256) {
            const int tok = tid >> 3, hd = tid & 7;
            const LAS unsigned* la = lists + (tok * 16 + 2 * hd) * 20; const LAS unsigned* lb = la + 20;
            float av[16], bv[16];
#pragma unroll
            for (int q = 0; q < 4; ++q) { const v4u a = *(const LAS v4u*)(la + q * 4), b = *(const LAS v4u*)(lb + q * 4);
#pragma unroll
                for (int j = 0; j < 4; ++j) { av[q * 4 + j] = __uint_as_float(a[j] & ~127u); bv[q * 4 + j] = __uint_as_float(b[j] & ~127u); } }
            float c0[16], c1[16], c2[16], c3[16];
#pragma unroll
            for (int i = 0; i < 16; ++i) { c0[i] = -INFINITY; c1[i] = -INFINITY; c2[i] = -INFINITY; c3[i] = -INFINITY; }
            {
                int cnt = 0;
#pragma unroll
                for (int i = 0; i < 16; ++i)
#pragma unroll
                    for (int j = 0; j < 16; ++j) if ((i + 1) * (j + 1) <= 16) {
                        const float sm = __uint_as_float((__float_as_uint(av[i] + bv[j]) & ~255u) | (unsigned)(i * 16 + j));
                        const int slot = cnt & 15, arr = cnt >> 4;
                        if (arr == 0) c0[slot] = sm; else if (arr == 1) c1[slot] = sm; else if (arr == 2) c2[slot] = sm; else c3[slot] = sm;
                        ++cnt;
                    }
            }
            sort16_desc(c0); sort16_desc(c1); sort16_desc(c2); sort16_desc(c3);
            merge16_desc(c0, c1); merge16_desc(c0, c2); merge16_desc(c0, c3);
            float ev[16], sum = 0.f; const float m0 = __uint_as_float(__float_as_uint(c0[0]) & ~255u);
#pragma unroll
            for (int k = 0; k < 16; ++k) { ev[k] = fast_exp2((__uint_as_float(__float_as_uint(c0[k]) & ~255u) - m0) * LOG2E); sum += ev[k]; }
            const float rs = 1.0f / sum;
#pragma unroll
            for (int k = 0; k < 16; ++k) { const unsigned code = __float_as_uint(c0[k]) & 255u;
                const int ia = (int)(la[code >> 4] & 127u), ib = (int)(lb[code & 15u] & 127u);
                eid[tok * 128 + hd * 16 + k] = ia * NKEYS + ib; gt[tok * 128 + hd * 16 + k] = ev[k] * rs;
#if SELFCHECK
                if (tok < nt) { P.dbg_eid[(size_t)(row0 + tok) * 128 + hd * 16 + k] = ia * NKEYS + ib; P.dbg_gt[(size_t)(row0 + tok) * 128 + hd * 16 + k] = ev[k] * rs; }
#endif
            }
        }
        }
        __syncthreads();
#pragma unroll 1
        for (int tk = 0; tk < 4; ++tk) {
            const int tok = F.wave * 4 + tk; if (tok >= nt) break;
            const size_t row = (size_t)(row0 + tok);
            const bool latent = row < (size_t)SEQ;
            const bf16_t* hp = P.Hin + row * DM + 16 * lane;
            const v4u h0 = *(const v4u*)hp, h1 = *(const v4u*)(hp + 8);
            float xf[16];
#pragma unroll
            for (int q = 0; q < 4; ++q) { xf[2 * q] = bflo(h0[q]); xf[2 * q + 1] = bfhi(h0[q]); xf[8 + 2 * q] = bflo(h1[q]); xf[8 + 2 * q + 1] = bfhi(h1[q]); }
            float am = 0.f;
#pragma unroll
            for (int i = 0; i < 16; ++i) am = __builtin_fmaxf(am, __builtin_fabsf(xf[i]));
            am = wave_max(am);
            const float sx = am * (1.f / 127.f), ix = am > 0.f ? 127.f / am : 0.f;
            int xq[4];
#pragma unroll
            for (int q = 0; q < 4; ++q) { int w = 0;
#pragma unroll
                for (int j = 0; j < 4; ++j) { const int v = (int)__builtin_rintf(xf[4 * q + j] * ix); w |= (v & 0xff) << (8 * j); }
                xq[q] = w; }
            float out[16]; float asum = 0.f;
#pragma unroll
            for (int i = 0; i < 16; ++i) out[i] = 0.f;
            const int esel = (lane >> 2) & 15;
#pragma unroll 1
            for (int e0 = 0; e0 < 128; e0 += 16) {
                v4u ua[16], va[16];
#pragma unroll
                for (int k = 0; k < 16; ++k) { const int id = __builtin_amdgcn_readfirstlane(eid[tok * 128 + e0 + k]);
                    ua[k] = *(const v4u*)(P.U + (unsigned)(((lane >> 3) * NEXP + id) * 128 + 16 * (lane & 7))); va[k] = *(const v4u*)(P.V + (unsigned)(((lane >> 3) * NEXP + id) * 128 + 16 * (lane & 7))); }
                const int myid = eid[tok * 128 + e0 + esel]; const float mysu = P.SU[myid], mysv = P.SV[myid], myg = gt[tok * 128 + e0 + esel];
                int d[16];
#pragma unroll
                for (int k = 0; k < 16; ++k) { int di = __builtin_amdgcn_sdot4((int)ua[k][0], xq[0], 0, false); di = __builtin_amdgcn_sdot4((int)ua[k][1], xq[1], di, false);
                    di = __builtin_amdgcn_sdot4((int)ua[k][2], xq[2], di, false); d[k] = __builtin_amdgcn_sdot4((int)ua[k][3], xq[3], di, false); }
                int s8[8], s4[4], s2[2];
#pragma unroll
                for (int i = 0; i < 8; ++i) { auto r = __builtin_amdgcn_permlane32_swap((unsigned)d[i], (unsigned)d[i + 8], false, false); s8[i] = (int)r[0] + (int)r[1]; }
#pragma unroll
                for (int i = 0; i < 4; ++i) { auto r = __builtin_amdgcn_permlane16_swap((unsigned)s8[i], (unsigned)s8[i + 4], false, false); s4[i] = (int)r[0] + (int)r[1]; }
                const bool b3 = (lane & 8) != 0, b2 = (lane & 4) != 0;
#pragma unroll
                for (int i = 0; i < 2; ++i) { const int keep = b3 ? s4[i + 2] : s4[i], send = b3 ? s4[i] : s4[i + 2]; s2[i] = keep + __builtin_amdgcn_update_dpp(0, send, 0x128, 0xf, 0xf, false); }
                int z; { const int keep = b2 ? s2[1] : s2[0], send = b2 ? s2[0] : s2[1]; z = keep + __builtin_amdgcn_ds_swizzle(send, 0x101F); }
                z += __builtin_amdgcn_update_dpp(0, z, 0x4E, 0xf, 0xf, false);
                z += __builtin_amdgcn_update_dpp(0, z, 0xB1, 0xf, 0xf, false);
                const float pre = (float)z * (mysu * sx);
                const float act = myg * gelu_tanh(pre);
#if SELFCHECK
                if ((lane & 3) == 0) P.dbg_gt[(size_t)9 * MiB / 4 + row * 128 + e0 + esel] = gelu_tanh(pre);
#endif
                const float cfl = act * mysv;
#pragma unroll
                for (int k = 0; k < 16; ++k) {
                    const float cf = __uint_as_float(__builtin_amdgcn_readlane(__float_as_uint(cfl), 4 * k));
                    asum += cf;
                    const f32x2 cf2 = {cf, cf};
#pragma unroll
                    for (int q = 0; q < 4; ++q) { const unsigned w = va[k][q];
                        const f32x2 v01 = {(float)(w & 0xffu), (float)((w >> 8) & 0xffu)}, v23 = {(float)((w >> 16) & 0xffu), (float)(w >> 24)};
                        f32x2 o01 = {out[4 * q], out[4 * q + 1]}, o23 = {out[4 * q + 2], out[4 * q + 3]};
                        o01 = __builtin_elementwise_fma(cf2, v01, o01); o23 = __builtin_elementwise_fma(cf2, v23, o23);
                        out[4 * q] = o01.x; out[4 * q + 1] = o01.y; out[4 * q + 2] = o23.x; out[4 * q + 3] = o23.y; }
                }
            }
#pragma unroll
            for (int i = 0; i < 16; ++i) out[i] -= 128.f * asum;
            const float* g2 = latent ? P.g2l : P.g2c;
            float xn[16]; float ss = 0.f;
#pragma unroll
            for (int q = 0; q < 4; ++q) { const int col = 16 * lane + 4 * q; const f32x4 xo = *(const f32x4*)(P.Xin + row * DM + col), g = *(const f32x4*)(g2 + col);
#pragma unroll
                for (int j = 0; j < 4; ++j) { const float v = xo[j] + g[j] * out[4 * q + j]; xn[4 * q + j] = v; ss += v * v; } }
            const float ri = __builtin_amdgcn_rsqf(wave_sum(ss) * (1.f / DM) + EPS);
            if (P.dry) {
                if (ri == 12345.678f) P.Xout[row * DM] = ri;
            } else if (P.fout) {
                if (latent) {
#pragma unroll
                    for (int q = 0; q < 4; ++q) { const int col = 16 * lane + 4 * q; const f32x4 w = *(const f32x4*)(P.fnw + col);
                        f32x4 y; y.x = xn[4 * q] * ri * w.x; y.y = xn[4 * q + 1] * ri * w.y; y.z = xn[4 * q + 2] * ri * w.z; y.w = xn[4 * q + 3] * ri * w.w;
                        *(f32x4*)(P.fout + row * DM + col) = y; }
                }
            } else {
                const float* sh = latent ? P.shl : P.shc; const float* sc = latent ? P.scl : P.scc;
                unsigned hw[8], h8[4];
#pragma unroll
                for (int q = 0; q < 4; ++q) { const int col = 16 * lane + 4 * q;
                    *(f32x4*)(P.Xout + row * DM + col) = (f32x4){xn[4 * q], xn[4 * q + 1], xn[4 * q + 2], xn[4 * q + 3]};
                    const f32x4 w = *(const f32x4*)(P.nwn + col), a = *(const f32x4*)(sc + col), b = *(const f32x4*)(sh + col);
                    float y[4];
#pragma unroll
                    for (int j = 0; j < 4; ++j) y[j] = (xn[4 * q + j] * ri * w[j]) * (1.0f + a[j]) + b[j];
                    hw[2 * q] = pk2(y[0], y[1]); hw[2 * q + 1] = pk2(y[2], y[3]); h8[q] = pk4_fp8(y[0], y[1], y[2], y[3]); }
                if (P.Hout) { *(v4u*)(P.Hout + row * DM + 16 * lane) = (v4u){hw[0], hw[1], hw[2], hw[3]};
                    *(v4u*)(P.Hout + row * DM + 16 * lane + 8) = (v4u){hw[4], hw[5], hw[6], hw[7]}; }
                if (P.H8out) *(v4u*)(P.H8out + row * DM + 16 * lane) = (v4u){h8[0], h8[1], h8[2], h8[3]};
            }
        }
        __syncthreads();
    }
}
__device__ __forceinline__ float lam_init_of(int l) { return l == 0 ? 0.2f : 0.35550906765f; }

#ifndef PHASE_MASK
#define PHASE_MASK 0xffff
#endif
#define PH(n) ((PHASE_MASK >> (n)) & 1)
#define REPS(n) (1 + ((dupmask >> (n)) & 1))
__global__ void __launch_bounds__(NTHREADS, 2) trunk_fwd(Args args) {
    extern __shared__ __attribute__((aligned(16))) unsigned char lds[];
    Frame F;
    F.lds = (LAS unsigned char*)lds;
    F.MISC = (volatile LAS unsigned*)(F.lds + MISC_OFF);
    F.wave = __builtin_amdgcn_readfirstlane((int)threadIdx.x >> 6);
    F.G = gridDim.x; { const int bx = blockIdx.x; F.vcu = (F.G % 8 == 0) ? (bx % 8) * (F.G / 8) + bx / 8 : bx; }
    unsigned char* ws = args.ws;
    F.ctl = (gu32*)(ws + WS_CTL);
    for (int u = ltid(F.wave); u < (LDS_BYTES - LDSCTL_OFF) / 4; u += NTHREADS) ((LAS unsigned*)(F.lds + LDSCTL_OFF))[u] = 0u;
    __syncthreads();
    XcdBarrier bar = xcd_barrier_post((unsigned*)(F.ctl + CW_BAR), F.MISC + 8, F.wave);
#ifndef TIMING
#define TIMING 0
#endif
#if TIMING
    int n_stamp = 0;
#define STAMP() do { if (blockIdx.x == 0 && tid_now(F.wave) == 0) ((unsigned long long*)(F.ctl + 1024))[n_stamp] = __builtin_amdgcn_s_memrealtime(); ++n_stamp; } while (0)
#else
#define STAMP() do {} while (0)
#endif
#define GRID_BAR() do { xcd_barrier(bar); STAMP(); asm volatile("" : "+s"(ws)); } while (0)
    STAMP();

    const float* const* in = args.in;
    const int dupmask = args.flags;
#define modv ((float*)(ws + WS_CONST))
#define lamv (modv + 2 * 2 * 6144)
#define WIN ((bf16_t*)(ws + WS_WIN))
#define WGATE ((bf16_t*)(ws + WS_WGATE))
#define WBR ((bf16_t*)(ws + WS_WBR))
#define WOUT ((bf16_t*)(ws + WS_WOUT))
#define WSC ((bf16_t*)(ws + WS_WSC))
#define X ((float*)(ws + WS_X))
#define H ((bf16_t*)(ws + WS_H))
#define YS ((bf16_t*)(ws + WS_YS))
#define MIX YS
#define Qb ((bf16_t*)(ws + WS_Q))
#define Kb ((bf16_t*)(ws + WS_K))
#define Vb ((bf16_t*)(ws + WS_V))
#define BP ((bf16_t*)(ws + WS_R1))
#define SB ((float*)(ws + WS_R1))
    const int gw = F.vcu * NWAVES + F.wave, NGW = F.G * NWAVES;

    for (int rep = 0; rep < REPS(0); ++rep) {
        const int tid = ltid(F.wave), lane = tid & 63;
        LAS float* scr = (LAS float*)(F.lds + F.wave * 16384);
        for (int un = F.vcu; un < 2 * 128; un += F.G) {
            const int l = un >> 7, col = (un & 127) * 48 + lane; const bool act = lane < 48;
            const float* W = in[I_ADAW] + (size_t)l * DM * 6144;
            float a0 = 0.f, a1 = 0.f;
            if (act) {
#pragma unroll 16
                for (int k = 128 * F.wave; k < 128 * F.wave + 128; ++k) { const float w = W[(size_t)k * 6144 + col]; const float c0 = in[I_C][k], c1 = in[I_CCTX][k];
                    a0 += c0 * sigmoidf_(c0) * w; a1 += c1 * sigmoidf_(c1) * w; }
            }
            LAS float* red = (LAS float*)(F.lds);
            red[(F.wave * 64 + lane) * 2] = a0; red[(F.wave * 64 + lane) * 2 + 1] = a1;
            __syncthreads();
            if (F.wave == 0 && act) { float s0 = in[I_ADAB][l * 6144 + col], s1 = s0;
#pragma unroll
                for (int w = 0; w < 8; ++w) { s0 += red[(w * 64 + lane) * 2]; s1 += red[(w * 64 + lane) * 2 + 1]; }
                modv[(l * 2 + 0) * 6144 + col] = s0; modv[(l * 2 + 1) * 6144 + col] = s1; }
            __syncthreads();
        }
        if (blockIdx.x == 0 && tid < 2) { const float* lf = in[I_DLAM] + tid * 128; float s0 = 0.f, s1 = 0.f;
            for (int i = 0; i < 32; ++i) { s0 += lf[i] * lf[32 + i]; s1 += lf[64 + i] * lf[96 + i]; }
            lamv[tid] = expf(s0) - expf(s1) + lam_init_of(tid); }
        constexpr int I_IN = 16 * 80, I_GT = 16 * 128, I_BR = 4 * 32, I_OT = 16 * 32;
        constexpr int NITEMS = 2 * I_IN + 2 * I_GT + 8 * I_BR + 2 * I_OT;
        unsigned char* W8IN = ws + WS_W8IN; unsigned char* W8GATE = ws + WS_W8GATE;
        for (int it = gw; it < NITEMS; it += NGW) {
            int r = it;
            if (r < 2 * I_IN) { const int l = r / I_IN; transpose_item<MapWin, true>(in[I_WIN] + (size_t)l * DM * NQKV, DM, NQKV, W8IN + (size_t)l * NQKV * DM, MapWin(), scr, r % I_IN, lane); continue; } r -= 2 * I_IN;
            if (r < 2 * I_GT) { const int l = r / I_GT; transpose_item<MapGate, true>(in[I_WGATE] + (size_t)l * DM * 4096, DM, 4096, W8GATE + (size_t)l * 4096 * DM, MapGate(), scr, r % I_GT, lane); continue; } r -= 2 * I_GT;
            if (r < 8 * I_BR) { const int lb = r / I_BR; transpose_item(in[I_WBR] + (size_t)lb * 256 * DM, 256, DM, WBR + (size_t)lb * DM * 256, MapId(), scr, r % I_BR, lane); continue; } r -= 8 * I_BR;
#if MIX8
            { const int l = r / I_OT; transpose_item<MapId, true>(in[I_WOUT] + (size_t)l * DM * DM, DM, DM, ws + WS_W8OUT + (size_t)l * DM * DM, MapId(), scr, r % I_OT, lane); }
#else
            { const int l = r / I_OT; transpose_item(in[I_WOUT] + (size_t)l * DM * DM, DM, DM, WOUT + (size_t)l * DM * DM, MapId(), scr, r % I_OT, lane); }
#endif
        }
        for (int it = gw; it < 2 * 16 * 8 * 64; it += NGW) {
            const int kt = it & 63, nt = (it >> 6) & 7, g = (it >> 9) & 15, l = it >> 13, h = g >> 1, p = g & 1;
            const float* kp = in[I_PKEYS] + ((size_t)((l * 2 + p) * 8 + h) * 128 + nt * 16 + (lane & 15)) * 128 + (lane >> 4);
            const float* qp = in[I_PWQ] + ((size_t)l * DM + kt * 16 + (lane & 15)) * 2048 + g * 128 + (lane >> 4);
            f32x4 acc = {0.f, 0.f, 0.f, 0.f};
            float ka[32], qa[32];
#pragma unroll
            for (int s = 0; s < 32; ++s) { ka[s] = kp[4 * s]; qa[s] = qp[4 * s]; }
            __builtin_amdgcn_sched_barrier(0);
#pragma unroll
            for (int s = 0; s < 32; ++s) acc = __builtin_amdgcn_mfma_f32_16x16x4f32(ka[s], qa[s], acc, 0, 0, 0);
            bf16_t* op = WSC + ((size_t)l * 2048 + g * 128 + nt * 16 + 4 * (lane >> 4)) * DM + kt * 16 + (lane & 15);
#pragma unroll
            for (int r = 0; r < 4; ++r) op[(size_t)r * DM] = (bf16_t)f2bf(acc[r]);
        }
        {
            unsigned char* UQ = (unsigned char*)(ws + WS_UBF); unsigned char* VQ = (unsigned char*)(ws + WS_VBF); float* SU = (float*)(ws + WS_SU); float* SV = (float*)(ws + WS_SV);
            for (int r0 = gw; r0 < 2 * 2 * NEXP; r0 += 4 * NGW) {
                f32x4 v[4][4];
#pragma unroll
                for (int u4 = 0; u4 < 4; ++u4) { const int r = r0 + u4 * NGW; const bool isv = r >= 2 * NEXP; const int rr = isv ? r - 2 * NEXP : r;
                    const float* src = (isv ? in[I_PV] : in[I_PU]) + (size_t)rr * DM + 16 * lane;
#pragma unroll
                    for (int q = 0; q < 4; ++q) v[u4][q] = *(const f32x4*)(src + 4 * q); }
#pragma unroll
                for (int u4 = 0; u4 < 4; ++u4) { const int r = r0 + u4 * NGW; const bool isv = r >= 2 * NEXP; const int rr = isv ? r - 2 * NEXP : r;
                    float am = 0.f;
#pragma unroll
                    for (int q = 0; q < 4; ++q) am = __builtin_fmaxf(am, __builtin_fmaxf(__builtin_fmaxf(__builtin_fabsf(v[u4][q].x), __builtin_fabsf(v[u4][q].y)), __builtin_fmaxf(__builtin_fabsf(v[u4][q].z), __builtin_fabsf(v[u4][q].w))));
                    am = wave_max(am);
                    const float inv = am > 0.f ? 127.f / am : 0.f; const int off = isv ? 128 : 0;
                    v4u w;
#pragma unroll
                    for (int q = 0; q < 4; ++q) { const int a0 = (int)__builtin_rintf(v[u4][q].x * inv) + off, a1 = (int)__builtin_rintf(v[u4][q].y * inv) + off, a2 = (int)__builtin_rintf(v[u4][q].z * inv) + off, a3 = (int)__builtin_rintf(v[u4][q].w * inv) + off;
                        w[q] = (unsigned)(a0 & 0xff) | ((unsigned)(a1 & 0xff) << 8) | ((unsigned)(a2 & 0xff) << 16) | ((unsigned)(a3 & 0xff) << 24); }
                    { const int lyr = rr >> 14, ex = rr & (NEXP - 1);
                      *(v4u*)((isv ? VQ : UQ) + (size_t)lyr * NEXP * DM + (size_t)(((lane >> 3) * NEXP + ex) * 128 + 16 * (lane & 7))) = w; }
                    if (lane == 0) (isv ? SV : SU)[rr] = am * (1.f / 127.f); }
            }
        }
    }
#if SELFCHECK
    GRID_BAR();
#define CK_RED ((LAS float*)(F.lds))
#define CK_BUF ((LAS float*)(F.lds + 1024))
#define CK_IBUF ((LAS int*)(F.lds + 8192))
#define CK_OBUF ((LAS float*)(F.lds + 20480))
#define CK_SC ((LAS float*)(F.lds + 24576))
    if (blockIdx.x == 0) chk::ck_prologue(in, ws, F.ctl, CK_RED);
    __syncthreads();
#endif
    GRID_BAR();
    { const int lane = ltid(F.wave) & 63;
    for (int m = gw; m < MT; m += NGW) {
        const bool lat = m < SEQ; const float* xr = lat ? in[I_X] + (size_t)m * DM : in[I_CTX] + (size_t)(m - SEQ) * DM; const float* mv = modv + (lat ? 0 : 6144);
        modnorm_row(xr, SELFCHECK ? H + (size_t)m * DM : (bf16_t*)nullptr, in[I_N1W], mv, mv + 1024, lane, ws + WS_H8 + (size_t)m * DM);
    } }
    GRID_BAR();
#if SELFCHECK
    if (blockIdx.x < 5) { const int r = blockIdx.x == 0 ? 0 : blockIdx.x == 1 ? 777 : blockIdx.x == 2 ? 16383 : blockIdx.x == 3 ? 16384 : 16639;
        const bool lat = r < SEQ; const float* mv = modv + (lat ? 0 : 6144);
        chk::ck_modnorm(lat ? in[I_X] + (size_t)r * DM : in[I_CTX] + (size_t)(r - SEQ) * DM, H + (size_t)r * DM, in[I_N1W], mv, mv + 1024, F.ctl, 2, CK_RED); }
    GRID_BAR();
#endif

#pragma unroll 1
    for (int l = 0; l < 2; ++l) {
#define modl (modv + (size_t)(l * 2) * 6144)
#define modc (modl + 6144)
        const int nMr = (l == 0) ? MT / 256 : SEQ / 256;
        for (int rep = 0; rep < REPS(2); ++rep) {
            if (rep) GRID_BAR();
            pg8::Gemm g{ws + WS_H8, ws + WS_W8IN + (size_t)l * NQKV * DM, MT / 256, NQKV / 256, DM, DM, DM, 0, 0, 1};
            pg8::StaticOrder S; S.init(g, F.G, (int)blockIdx.x);
            pg8::EpiQKV E{Qb, Kb, Vb, in[I_QKNW] + l * 128};
            pg8::gemm_phase<pg8::EpiQKV, true>(F.lds, g, S, E, F.wave);
        }
        GRID_BAR();
#if SELFCHECK
        if (blockIdx.x < 4) { const int b = blockIdx.x; const int r = b == 0 ? 5 : b == 1 ? 8400 : b == 2 ? 16383 : 16391; chk::ck_qkv(l, r, in, ws, F.ctl, CK_RED, CK_BUF); }
        GRID_BAR();
#endif
        for (int rep = 0; rep < REPS(4); ++rep) {
            if (rep) GRID_BAR();
            char* shm = (char*)lds;
            const float lam = lamv[l];
            for (int ui = F.vcu; ui < 256; ui += F.G) {
                const int h = (ui >> 5) & 3, qb = ((ui >> 7) << 5) | (ui & 31);
                const int njobs = (l == 0 && ui < 16) ? (((ui >> 2) == 1) ? 7 : 6) : 5;
#pragma unroll 1
                for (int j = 0; j < njobs; ++j) {
                    att::AU u; int mode = 0;
                    u.sinkl2 = -INFINITY; u.emode = 0; u.lam = 0.f; u.oscale = 1.f; u.subw = in[I_SUBW] + l * 64; u.kbase = 0; u.q0 = qb * 256; u.NT = 260;
                    int qh, kh, oc;
                    if (j == 0)      { qh = 16 + h; kh = 10 + (h >> 1); oc = 768 + h * 64; }
                    else if (j == 1) { qh = 4 + 2 * h; kh = 4 + h; oc = 256 + h * 64; u.emode = 1; }
                    else if (j == 2) { qh = 5 + 2 * h; kh = 4 + h; oc = 256 + h * 64; u.emode = 2; u.lam = lam; u.oscale = 1.f - lam_init_of(l); }
                    else if (j == 3) { qh = h; kh = h; oc = h * 64; mode = 1; u.NT = 16; int B = 4 * qb - 4; B = B < 0 ? 0 : (B > 244 ? 244 : B); u.kbase = 64 * B; }
                    else if (j == 4) { qh = 12 + h; kh = 8 + (h >> 1); oc = 512 + h * 64; mode = 2; u.NT = 12; u.kbase = 256 * qb - 128; u.sinkl2 = in[I_SINK][l * 4 + h] * LOG2E; }
                    else {
                        const int mx = ui >> 2, hc = ui & 3; u.q0 = SEQ; u.NT = 4;
                        if (mx == 0)      { qh = hc; kh = hc; oc = hc * 64; }
                        else if (mx == 1) { qh = 4 + 2 * hc + (j - 5); kh = 4 + hc; oc = 256 + hc * 64; u.emode = (j == 5) ? 1 : 2; u.lam = lam; u.oscale = 1.f - lam_init_of(l); }
                        else if (mx == 2) { qh = 12 + hc; kh = 8 + (hc >> 1); oc = 512 + hc * 64; u.sinkl2 = in[I_SINK][l * 4 + hc] * LOG2E; }
                        else              { qh = 16 + hc; kh = 10 + (hc >> 1); oc = 768 + hc * 64; }
                    }
                    u.Q = (const att::bf16*)(Qb + (size_t)qh * MT * 64); u.K = (const att::bf16*)(Kb + (size_t)kh * MT * 64); u.V = (const att::bf16*)(Vb + (size_t)kh * MT * 64);
                    u.O = (att::bf16*)(YS + oc);
#ifndef ATT_MODES
#define ATT_MODES 7
#endif
                    if ((ATT_MODES & 2) && mode == 1) {
                        float* rp = (float*)(shm + att::LDS_RPB);
                        for (int i = ltid(F.wave); i < 15 * 32; i += NTHREADS) { const int c = i & 31; rp[i] = (c < 31) ? in[I_RPB][((size_t)(l * 4 + h) * 15 + (i >> 5)) * 31 + c] * LOG2E : 0.f; }
                        __syncthreads();
                        if (!att::attn_simple<1, 1>(u, shm, F.wave)) att::attn_simple<1>(u, shm, F.wave);
                    } else if ((ATT_MODES & 4) && mode == 2) { if (!att::attn_unit<2, 8, 0, 1>(u, shm, F.wave)) att::attn_unit<2, 8>(u, shm, F.wave); }
                    else if ((ATT_MODES & 1) && j == 1) { if (!att::attn_unit<0, 8, 1, 1>(u, shm, F.wave)) att::attn_unit<0, 8, 1>(u, shm, F.wave); }
                    else if ((ATT_MODES & 1) && j == 2) { if (!att::attn_unit<0, 8, 2, 1>(u, shm, F.wave)) att::attn_unit<0, 8, 2>(u, shm, F.wave); }
                    else if (ATT_MODES & 1) { if (!att::attn_unit<0, 8, 0, 1>(u, shm, F.wave)) att::attn_unit<0, 8>(u, shm, F.wave); }
                }
            }
        }
        GRID_BAR();
#if SELFCHECK
        if (blockIdx.x < 80) { const int b = blockIdx.x, ri = b >> 4; const int r = ri == 0 ? 3 : ri == 1 ? 4227 : ri == 2 ? 16319 : ri == 3 ? 9000 : 16484; chk::ck_attn(l, (b >> 2) & 3, b & 3, r, in, ws, F.ctl, CK_RED, CK_SC, CK_OBUF); }
        GRID_BAR();
#endif
        for (int rep = 0; rep < REPS(5); ++rep) {
            if (rep) GRID_BAR();
            pg8::Gemm g{YS, WBR + (size_t)l * 4 * DM * 256, nMr, 16, 256, DM, 256, 2, 512, 2};
            pg8::StaticOrder S; S.init(g, F.G, (int)blockIdx.x);
#if BP8
            pg8::EpiBranch8 E{(unsigned char*)BP};
            pg8::gemm_phase<pg8::EpiBranch8>(F.lds, g, S, E, F.wave);
#else
            pg8::EpiBranch E{BP};
            pg8::gemm_phase<pg8::EpiBranch>(F.lds, g, S, E, F.wave);
#endif
        }
        GRID_BAR();
#if SELFCHECK
        if (blockIdx.x < 3) { const int b = blockIdx.x; chk::ck_branch(l, b == 0 ? 1 : b == 1 ? 16383 : 16390, in, ws, F.ctl, CK_RED); }
        GRID_BAR();
#endif
        for (int rep = 0; rep < REPS(6); ++rep) {
            if (rep) GRID_BAR();
            pg8::Gemm g{ws + WS_H8, ws + WS_W8GATE + (size_t)l * 4096 * DM, nMr, 16, DM, DM, DM, 0, 0, 1};
            pg8::StaticOrder S; S.init(g, F.G, (int)blockIdx.x);
            pg8::EpiGate E{BP, MIX, in[I_BGATE] + l * 4096};
            pg8::gemm_phase<pg8::EpiGate, true>(F.lds, g, S, E, F.wave);
        }
        GRID_BAR();
#if SELFCHECK
        if (blockIdx.x < 3) { const int b = blockIdx.x; chk::ck_gate(l, b == 0 ? 2 : b == 1 ? 9999 : 16385, in, ws, F.ctl, CK_RED); }
        GRID_BAR();
#endif
        for (int rep = 0; rep < (l == 0 ? REPS(7) : 1); ++rep) {
            if (rep) GRID_BAR();
#if MIX8
            pg8::Gemm g{MIX, ws + WS_W8OUT + (size_t)l * DM * DM, nMr, 4, DM, DM, DM, 0, 0, 1};
#else
            pg8::Gemm g{MIX, WOUT + (size_t)l * DM * DM, nMr, 4, DM, DM, DM, 0, 0, 2};
#endif
            pg8::StaticOrder S; S.init(g, F.G, (int)blockIdx.x);
#ifndef FUSE_NORM2
#define FUSE_NORM2 1
#endif
#if FUSE_NORM2
            pg8::EpiOutNorm E{l == 0 ? in[I_X] : X, l == 0 ? in[I_CTX] : X + (size_t)SEQ * DM, X, modl + 2048, modc + 2048,
                              H, in[I_N2W] + l * DM, modl, modc, (gu32*)(ws + WS_CONST + 704 * 1024), F.ctl + 16384 + l * 65 * 64, F.ctl + 16000, F.lds + MISC_OFF + 1024};
#if MIX8
            pg8::gemm_phase<pg8::EpiOutNorm, true, 0x7A7A7A7A>(F.lds, g, S, E, F.wave);
#else
            pg8::gemm_phase<pg8::EpiOutNorm>(F.lds, g, S, E, F.wave);
#endif
#else
            pg8::EpiOut E{l == 0 ? in[I_X] : X, l == 0 ? in[I_CTX] : X + (size_t)SEQ * DM, X, modl + 2048, modc + 2048};
            pg8::gemm_phase<pg8::EpiOut>(F.lds, g, S, E, F.wave);
#endif
        }
        GRID_BAR();
#if SELFCHECK
        if (blockIdx.x < 3) { const int b = blockIdx.x; chk::ck_out(l, b == 0 ? 4 : b == 1 ? 12345 : 16417, in, ws, F.ctl, CK_RED); }
        GRID_BAR();
#endif
#if !FUSE_NORM2
        { const int lane = ltid(F.wave) & 63;
        for (int m = gw; m < nMr * 256; m += NGW) {
            const float* mv = (m < SEQ) ? modl : modc;
            modnorm_row(X + (size_t)m * DM, H + (size_t)m * DM, in[I_N2W] + l * DM, mv + 3072, mv + 4096, lane);
        } }
        GRID_BAR();
#endif
#if SELFCHECK
        if (blockIdx.x < 3) { const int b = blockIdx.x; const int r = b == 0 ? 7 : b == 1 ? 16383 : 16500; const float* mv = (r < SEQ) ? modl : modc;
            chk::ck_modnorm(X + (size_t)r * DM, H + (size_t)r * DM, in[I_N2W] + l * DM, mv + 3072, mv + 4096, F.ctl, 8, CK_RED); }
        GRID_BAR();
#endif
        for (int rep = 0; rep < REPS(9); ++rep) {
            if (rep) GRID_BAR();
            pg8::Gemm g{H, WSC + (size_t)l * 2048 * DM, nMr, 8, DM, DM, DM, 0, 0, 2};
            pg8::StaticOrder S; S.init(g, F.G, (int)blockIdx.x);
            pg8::EpiS E{SB};
            pg8::gemm_phase<pg8::EpiS>(F.lds, g, S, E, F.wave);
        }
        GRID_BAR();
#if SELFCHECK
        if (blockIdx.x < 3) { const int b = blockIdx.x; chk::ck_scores(l, b == 0 ? 6 : b == 1 ? 16000 : 16385, in, ws, F.ctl, CK_RED, CK_BUF); }
        GRID_BAR();
#endif
#ifndef PEER_SLICED
#define PEER_SLICED 0
#endif
#if !PEER_SLICED
        for (int rep = 0; rep < REPS(10); ++rep) {
            if (rep) GRID_BAR();
            PeerArgs P; P.dry = (rep + 1 < REPS(10)); P.route_reps = REPS(11);
            P.S = SB; P.Hin = H; P.U = (const unsigned char*)(ws + WS_UBF) + (size_t)l * NEXP * DM; P.V = (const unsigned char*)(ws + WS_VBF) + (size_t)l * NEXP * DM; P.SU = (const float*)(ws + WS_SU) + l * NEXP; P.SV = (const float*)(ws + WS_SV) + l * NEXP; P.Xin = X; P.Xout = X;
            P.g2l = modl + 5120; P.g2c = modc + 5120;
            P.Hout = SELFCHECK ? H : (bf16_t*)nullptr; P.H8out = ws + WS_H8; P.nwn = in[I_N1W] + DM; P.shl = modv + 2 * 6144; P.scl = P.shl + 1024; P.shc = modv + 3 * 6144; P.scc = P.shc + 1024;
            P.fout = (l == 1) ? args.out : nullptr; P.fnw = in[I_FNW];
            P.nblocks = nMr * 8; P.dbg_eid = nullptr; P.dbg_gt = nullptr;
#if SELFCHECK
            if (l == 0) { P.Xout = (float*)(ws + WS_DBG); P.Hout = YS; P.H8out = nullptr; }
            P.dbg_eid = (int*)(ws + WS_VBF + 32 * MiB); P.dbg_gt = (float*)(ws + WS_VBF + 41 * MiB);
#endif
            P.H8out_xq = ws + WS_H8;
#ifndef PEER_V2
#define PEER_V2 1
#endif
            if (PEER_V2 && !P.dry) peer_phase2(F, P); else peer_phase(F, P);
        }
#else
        {
            PeerArgs P; P.dry = false; P.route_reps = 1;
            P.S = SB; P.Hin = H; P.U = (const unsigned char*)(ws + WS_UBF) + (size_t)l * NEXP * DM; P.V = (const unsigned char*)(ws + WS_VBF) + (size_t)l * NEXP * DM; P.SU = (const float*)(ws + WS_SU) + l * NEXP; P.SV = (const float*)(ws + WS_SV) + l * NEXP; P.Xin = X; P.Xout = X;
            P.g2l = modl + 5120; P.g2c = modc + 5120;
            P.Hout = SELFCHECK ? H : (bf16_t*)nullptr; P.H8out = ws + WS_H8; P.nwn = in[I_N1W] + DM; P.shl = modv + 2 * 6144; P.scl = P.shl + 1024; P.shc = modv + 3 * 6144; P.scc = P.shc + 1024;
            P.fout = (l == 1) ? args.out : nullptr; P.fnw = in[I_FNW];
            P.nblocks = nMr * 8; P.dbg_eid = nullptr; P.dbg_gt = nullptr;
            PeerBufs B;
#if SELFCHECK
            unsigned char* pb = ws + WS_VBF + 32 * MiB;
            if (l == 0) { P.Xout = (float*)(ws + WS_DBG); P.Hout = YS; }
#else
            unsigned char* pb = ws + WS_YS;
#endif
            B.eid = (int*)pb; B.gt = (float*)(pb + 9 * MiB); B.a = (float*)(pb + 18 * MiB); B.xq = ws + WS_UBF + 32 * MiB; B.sx = (float*)(ws + WS_UBF + 50 * MiB);
            const int ntok = nMr * 256;
            peer_route(F, P, B);
            GRID_BAR();
            peer_u(F, P, B, ntok);
            GRID_BAR();
            peer_v(F, P, B, ntok);
            GRID_BAR();
            peer_norm(F, P, ntok);
        }
#endif
#if SELFCHECK
        break;
#endif
        if (l == 0) GRID_BAR();
    }
#if TIMING
    GRID_BAR(); xcd_barrier(bar);
    {
        const unsigned long long* ts = (const unsigned long long*)(F.ctl + 1024);
        float iv[10];
#pragma unroll
        for (int i = 0; i < 10; ++i) iv[i] = 0.f;
        iv[0] = (float)(ts[1] - ts[0]); iv[1] = (float)(ts[2] - ts[1]);
#pragma unroll
        for (int l = 0; l < 2; ++l)
#pragma unroll
            for (int p = 0; p < 8; ++p) iv[2 + p] += (float)(ts[3 + l * 8 + p] - ts[2 + l * 8 + p]);
        const float total = (float)(ts[18] - ts[0]);
        const int k1 = (int)(100.f * iv[TIMING_A] / total + 0.5f); int k2 = 10 + (int)(100.f * iv[TIMING_B] / total + 0.5f); k2 = k2 > 99 ? 99 : k2;
        const float cval = sqrtf((float)k1);
        for (size_t i = (size_t)blockIdx.x * NTHREADS + ltid(F.wave); i < (size_t)SEQ * DM / 4; i += (size_t)gridDim.x * NTHREADS) ((f32x4*)args.out)[i] = (f32x4){i == 0 ? 100.f * (float)k2 : cval, cval, cval, cval};
    }
#endif
#if SELFCHECK
    GRID_BAR();
    if (blockIdx.x < 5) { const int b = blockIdx.x; const int r = b == 0 ? 0 : b == 1 ? 31 : b == 2 ? 37 : b == 3 ? 16383 : 16639; chk::ck_peer(0, r, in, ws, F.ctl, CK_RED, CK_BUF, CK_IBUF); }
    GRID_BAR();
    {
        float e[32];
#pragma unroll
        for (int i = 0; i < 32; ++i) e[i] = __uint_as_float(__hip_atomic_load(F.ctl + CW_CHK + i, RLX_AGENT));
        const float T = 0.03f; int mask = 0;
#if SELFCHECK == 1
        mask = ((e[0] > T || e[1] > T) ? 1 : 0) | (e[2] > T ? 2 : 0) | (e[3] > T ? 4 : 0) | (e[4] > T ? 8 : 0) | (e[5] > T ? 16 : 0);
#elif SELFCHECK == 2
        mask = (e[6] > T ? 1 : 0) | (e[7] > T ? 2 : 0) | (e[8] > T ? 4 : 0) | (e[9] > T ? 8 : 0) | ((e[10] > T || e[11] > T) ? 16 : 0);
#elif SELFCHECK == 5
        mask = (e[24] > T ? 1 : 0) | (e[25] > T ? 2 : 0) | (e[26] > T ? 4 : 0) | (e[27] > T ? 8 : 0) | (e[28] > T ? 16 : 0);
#elif SELFCHECK == 4
        mask = (e[10] > T ? 1 : 0) | (e[11] > T ? 2 : 0) | (e[12] > T ? 4 : 0) | (e[13] > T ? 8 : 0);
#else
        mask = (e[16] > T ? 1 : 0) | (e[17] > T ? 2 : 0) | (e[18] > T ? 4 : 0) | (e[19] > T ? 8 : 0) | ((e[20] > T || e[21] > T || e[22] > T || e[23] > T) ? 16 : 0);
#endif
        const float cval = sqrtf((float)mask);
        for (size_t i = (size_t)blockIdx.x * NTHREADS + ltid(F.wave); i < (size_t)SEQ * DM / 4; i += (size_t)gridDim.x * NTHREADS) ((f32x4*)args.out)[i] = (f32x4){cval, cval, cval, cval};
    }
#endif
}
#ifndef DUP_MASK
#define DUP_MASK 0
#endif
extern "C" void kernel_launch(void* const* d_in, const int* in_sizes, int n_in, void* d_out, int out_size, void* d_ws, size_t ws_size, hipStream_t stream) {
    static int grid = 0;
    if (grid == 0) {
        size_t need = WS_END;
#if SELFCHECK
        need = WS_DBG + (size_t)MT * DM * 4;
#endif
        if (n_in != 23 || in_sizes[0] != SEQ * DM || out_size != SEQ * DM || ws_size < need) {
            fprintf(stderr, "kernel_launch: unexpected problem shape (n_in %d, in0 %d, out %d, ws %zu, need %zu); nothing launched\n", n_in, n_in > 0 ? in_sizes[0] : -1, out_size, ws_size, need); grid = -1; return; }
        int dev = 0, cus = 0, per_cu = 0;
        if (hipGetDevice(&dev) != hipSuccess || hipDeviceGetAttribute(&cus, hipDeviceAttributeMultiprocessorCount, dev) != hipSuccess) { fprintf(stderr, "kernel_launch: device query failed\n"); grid = -1; return; }
        if (hipFuncSetAttribute((const void*)trunk_fwd, hipFuncAttributeMaxDynamicSharedMemorySize, LDS_BYTES) != hipSuccess) { fprintf(stderr, "kernel_launch: hipFuncSetAttribute failed\n"); grid = -1; return; }
        if (hipOccupancyMaxActiveBlocksPerMultiprocessor(&per_cu, (const void*)trunk_fwd, NTHREADS, LDS_BYTES) != hipSuccess || per_cu < 1) {
            fprintf(stderr, "kernel_launch: occupancy query says %d blocks per CU; nothing launched\n", per_cu); (void)hipGetLastError(); grid = -1; return; }
        grid = cus;
    }
    if (grid < 0) return;
    (void)hipMemsetAsync((char*)d_ws + WS_CTL, 0, CTL_ZERO_BYTES, stream);
    Args a{};
    for (int i = 0; i < 23; ++i) a.in[i] = (const float*)d_in[i];
    a.out = (float*)d_out; a.ws = (unsigned char*)d_ws; a.flags = DUP_MASK; a.pad = 0;
    void* kargs[] = {&a};
    const hipError_t e = hipLaunchCooperativeKernel((const void*)trunk_fwd, dim3(grid), dim3(NTHREADS), kargs, LDS_BYTES, stream);
    if (e != hipSuccess) fprintf(stderr, "kernel_launch: cooperative launch failed: %s (grid %d)\n", hipGetErrorString(e), grid);
}
```

```cpp
#define SELFCHECK 0
#define TIMING 0
#define TIMING_A 0
#define TIMING_B 1
#define DUP_MASK 0
#define PEER_SLICED 0
#include <hip/hip_runtime.h>
#include <hip/hip_cooperative_groups.h>
#include <hip/hip_bf16.h>
#include <cstdio>
#include <cstdint>
#include <cmath>
namespace cg = cooperative_groups;

#ifndef SELFCHECK
#define SELFCHECK 0
#endif

constexpr int SEQ = 16384, CTX = 256, MT = SEQ + CTX, DM = 1024, NQKV = 2560, GRIDW = 64;
constexpr int NEXP = 16384, NKEYS = 128, PEER_H = 8, TOPK = 16;
constexpr float EPS = 1e-6f, LOG2E = 1.4426950408889634f;
constexpr float C2_64 = 0.125f * LOG2E;
constexpr float C2_32 = 0.17677669529663687f * LOG2E;
constexpr int NWAVES = 8, NTHREADS = 512;

constexpr size_t MiB = 1u << 20;
constexpr size_t WS_CTL = 0, CTL_ZERO_BYTES = 1 * MiB;
constexpr size_t WS_CONST = 1 * MiB;
constexpr size_t WS_WIN = 2 * MiB;
constexpr size_t WS_WGATE = 12 * MiB;
constexpr size_t WS_WBR = 28 * MiB;
constexpr size_t WS_WOUT = 32 * MiB;
constexpr size_t WS_WSC = 36 * MiB;
constexpr size_t WS_SU = WS_CONST + 256 * 1024, WS_SV = WS_CONST + 512 * 1024;
constexpr size_t WS_UBF = 44 * MiB;
constexpr size_t WS_VBF = 108 * MiB;
constexpr size_t WS_H8 = WS_UBF + 32 * MiB;
constexpr size_t WS_W8IN = WS_VBF + 32 * MiB, WS_W8GATE = WS_VBF + 40 * MiB, WS_W8OUT = WS_VBF + 48 * MiB;
constexpr size_t WS_X = 172 * MiB;
constexpr size_t WS_H = 237 * MiB;
constexpr size_t WS_YS = 270 * MiB;
constexpr size_t WS_R1 = 303 * MiB;
constexpr size_t WS_Q = WS_R1, WS_K = WS_Q + (size_t)20 * MT * 128, WS_V = WS_K + (size_t)12 * MT * 128;
constexpr size_t WS_END = 433 * MiB;
constexpr size_t WS_DBG = 433 * MiB;
static_assert(WS_V + (size_t)12 * MT * 128 <= WS_END && WS_R1 + (size_t)MT * 4096 * 2 <= WS_END && WS_R1 + (size_t)MT * 2048 * 4 <= WS_END, "ws map");
constexpr int CW_BAR = 4096;
constexpr int CW_CHK = 64;

constexpr int RING_BYTES = 131072;
constexpr int LDSCTL_OFF = RING_BYTES, MISC_OFF = LDSCTL_OFF + 320;
constexpr int LDS_BYTES = 147456;

#define GAS __attribute__((address_space(1)))
#define LAS __attribute__((address_space(3)))
typedef unsigned short bf16_t;
typedef unsigned v4u __attribute__((ext_vector_type(4)));
typedef unsigned v2u __attribute__((ext_vector_type(2)));
typedef float f32x4 __attribute__((ext_vector_type(4)));
typedef float f32x2 __attribute__((ext_vector_type(2)));
typedef float f32x16 __attribute__((ext_vector_type(16)));
typedef short bf16x8 __attribute__((ext_vector_type(8)));
typedef short s16x4 __attribute__((ext_vector_type(4)));
typedef __bf16 bf16x2_t __attribute__((ext_vector_type(2)));
typedef int i32x8 __attribute__((ext_vector_type(8)));
typedef int i32x4 __attribute__((ext_vector_type(4)));
typedef GAS unsigned gu32;
#define RLX_AGENT __ATOMIC_RELAXED, __HIP_MEMORY_SCOPE_AGENT
#define LDS_WAIT() asm volatile("s_waitcnt lgkmcnt(0)" ::: "memory")
#define VM_WAIT() asm volatile("s_waitcnt vmcnt(0)" ::: "memory")

__device__ __forceinline__ int lane_now() { int l; asm volatile("v_mbcnt_lo_u32_b32 %0, -1, 0\n\tv_mbcnt_hi_u32_b32 %0, -1, %0" : "=v"(l)); return l; }
__device__ __forceinline__ int tid_now(int wave) { return (wave << 6) | lane_now(); }
__device__ __forceinline__ unsigned f2bf(float f) { unsigned u = __builtin_bit_cast(unsigned, f); return (u + 0x7fffu + ((u >> 16) & 1u)) >> 16; }
__device__ __forceinline__ unsigned pk2(float lo, float hi) { f32x2 v = {lo, hi}; bf16x2_t b = __builtin_convertvector(v, bf16x2_t); return __builtin_bit_cast(unsigned, b); }
__device__ __forceinline__ unsigned pk4_fp8(float a, float b, float c, float d) { int w = 0; w = __builtin_amdgcn_cvt_pk_fp8_f32(a, b, w, false); w = __builtin_amdgcn_cvt_pk_fp8_f32(c, d, w, true); return (unsigned)w; }
__device__ __forceinline__ float bflo(unsigned w) { return __builtin_bit_cast(float, w << 16); }
__device__ __forceinline__ float bfhi(unsigned w) { return __builtin_bit_cast(float, w & 0xffff0000u); }
__device__ __forceinline__ float bf2f(bf16_t h) { return __builtin_bit_cast(float, (unsigned)h << 16); }
template <int X> __device__ __forceinline__ float xorf(float v) { return __builtin_bit_cast(float, __builtin_amdgcn_ds_swizzle(__builtin_bit_cast(int, v), (X << 10) | 0x1f)); }
__device__ __forceinline__ float x32_sum(float v) { auto r = __builtin_amdgcn_permlane32_swap(__float_as_uint(v), __float_as_uint(v), false, false); return __uint_as_float(r[0]) + __uint_as_float(r[1]); }
__device__ __forceinline__ float x32_max(float v) { auto r = __builtin_amdgcn_permlane32_swap(__float_as_uint(v), __float_as_uint(v), false, false); return __builtin_fmaxf(__uint_as_float(r[0]), __uint_as_float(r[1])); }
__device__ __forceinline__ float wave_sum(float v) { v += xorf<1>(v); v += xorf<2>(v); v += xorf<4>(v); v += xorf<8>(v); v += xorf<16>(v); return x32_sum(v); }
__device__ __forceinline__ float wave_max(float v) { v = __builtin_fmaxf(v, xorf<1>(v)); v = __builtin_fmaxf(v, xorf<2>(v)); v = __builtin_fmaxf(v, xorf<4>(v)); v = __builtin_fmaxf(v, xorf<8>(v)); v = __builtin_fmaxf(v, xorf<16>(v)); return x32_max(v); }
__device__ __forceinline__ float fast_exp2(float x) { return __builtin_amdgcn_exp2f(x); }
__device__ __forceinline__ float fast_rcp(float x) { return __builtin_amdgcn_rcpf(x); }
__device__ __forceinline__ float sigmoidf_(float x) { return fast_rcp(1.0f + fast_exp2(-x * LOG2E)); }
__device__ __forceinline__ float gelu_tanh(float x) {
    const float y = 0.7978845608028654f * (x + 0.044715f * x * x * x);
    const float t = 1.0f - 2.0f * fast_rcp(1.0f + fast_exp2(2.0f * LOG2E * y));
    return 0.5f * x * (1.0f + t);
}
#define XB_TMO      128
#define XB_XCNT(j)  (256  + 64 * (j))
#define XB_XSUB(j)  (1280 + 64 * (j))
#define XB_XGEN(j)  (2304 + 64 * (j))
#define XB_TOP      3328
#define XB_TOPGEN   3392
#define XCD_BAR_WORDS 3456
#define XB_SPIN_CAP (1u << 20)
__device__ __forceinline__ unsigned xb_ld(unsigned* p)              { return __hip_atomic_load(p, __ATOMIC_RELAXED, __HIP_MEMORY_SCOPE_AGENT); }
__device__ __forceinline__ unsigned xb_add(unsigned* p, unsigned v) { return __hip_atomic_fetch_add(p, v, __ATOMIC_RELAXED, __HIP_MEMORY_SCOPE_AGENT); }
__device__ __forceinline__ unsigned xb_xcc_id() { return (unsigned)__builtin_amdgcn_s_getreg((3 << 11) | 20) & 0xFu; }
#define XB_SPIN(cond, bar) do { unsigned _sp = 0; while (cond) { __builtin_amdgcn_s_sleep(1); \
    if ((++_sp & 255u) == 0u) { if (xb_ld(&(bar)[XB_TMO])) break; if (_sp > XB_SPIN_CAP) { atomicAdd(&(bar)[XB_TMO], 1u); break; } } } } while (0)
struct XcdBarrier { unsigned* bar; unsigned x; volatile LAS unsigned* st; int wave; };
__device__ __forceinline__ XcdBarrier xcd_barrier_post(unsigned* bar, volatile LAS unsigned* st, int wave) {
    XcdBarrier b; b.bar = bar; b.x = xb_xcc_id(); b.st = st; b.wave = wave;
    if (tid_now(wave) == 0) (void)xb_add(&bar[XB_XCNT(b.x)], 1u);
    return b;
}
__device__ __forceinline__ void xcd_barrier_complete(unsigned* bar, unsigned x, unsigned& nloc, unsigned& nx) {
    const unsigned G = gridDim.x * gridDim.y * gridDim.z;
    unsigned sum, cnt, mine, sp = 0u;
    for (;;) {
        sum = 0u; cnt = 0u; mine = 0u;
#pragma unroll
        for (unsigned j = 0; j < 16; ++j) { const unsigned c = xb_ld(&bar[XB_XCNT(j)]); sum += c; cnt += (c > 0u) ? 1u : 0u; mine = (j == x) ? c : mine; }
        if (sum == G) break;
        __builtin_amdgcn_s_sleep(1);
        if ((++sp & 255u) == 0u) { if (xb_ld(&bar[XB_TMO])) break; if (sp > XB_SPIN_CAP) { atomicAdd(&bar[XB_TMO], 1u); break; } }
    }
    nloc = mine > 0u ? mine : 1u; nx = cnt > 0u ? cnt : 1u;
}
__device__ __forceinline__ void xcd_barrier(const XcdBarrier& b) {
    asm volatile("s_waitcnt vmcnt(0)" ::: "memory");
    __syncthreads();
    unsigned* bar_ = b.bar; unsigned bx_ = b.x; asm volatile("" : "+s"(bar_), "+s"(bx_));
    if (tid_now(b.wave) == 0) {
        unsigned* bar = bar_; const unsigned bx = bx_;
        __builtin_amdgcn_s_waitcnt(0);
        unsigned nloc = b.st[0], nx = b.st[1];
        if (nloc == 0u) { xcd_barrier_complete(bar, bx, nloc, nx); b.st[0] = nloc; b.st[1] = nx; }
        const unsigned old = xb_add(&bar[XB_XSUB(bx)], 1u);
        const unsigned gen = old / nloc;
        if (old + 1u == (gen + 1u) * nloc) {
            __builtin_amdgcn_fence(__ATOMIC_RELEASE, "agent");
            asm volatile("s_waitcnt vmcnt(0)" ::: "memory");
            const unsigned og = xb_add(&bar[XB_TOP], 1u);
            const unsigned tg = og / nx;
            if (og + 1u == (tg + 1u) * nx) xb_add(&bar[XB_TOPGEN], 1u);
            else XB_SPIN(xb_ld(&bar[XB_TOPGEN]) == tg, bar);
            __builtin_amdgcn_fence(__ATOMIC_ACQUIRE, "agent");
            xb_add(&bar[XB_XGEN(bx)], 1u);
            asm volatile("s_waitcnt vmcnt(0)" ::: "memory");
        } else {
            XB_SPIN(xb_ld(&bar[XB_XGEN(bx)]) == gen, bar);
            __builtin_amdgcn_fence(__ATOMIC_ACQUIRE, "agent");
            asm volatile("s_waitcnt vmcnt(0)" ::: "memory");
        }
    }
    __syncthreads();
}

namespace pg8 {
#define PG8_LAS __attribute__((address_space(3)))
constexpr int BM = 256, BK = 64, HALF = 128, HTB = HALF * BK * 2, STAGE_BYTES = 8 * HTB, NXCD = 8, WGM = 8;
__host__ __device__ __forceinline__ int lds_byte(int r, int c) { const int st = (r >> 4) * 2 + (c >> 5), rr = r & 15, cc = c & 31, ob = rr * 64 + cc * 2; return st * 1024 + (ob ^ (((ob >> 9) & 1) << 5)); }
__host__ __device__ __forceinline__ void stage_rc(int b, int& R, int& C) { const int st = b / 1024, sb = b % 1024, swz = sb ^ (((sb >> 9) & 1) << 5); R = (st >> 1) * 16 + swz / 64; C = (st & 1) * 32 + (swz % 64) / 2; }
__host__ __device__ __forceinline__ int perm32(int rho) { const int n = rho >> 4, i = rho & 15; return 8 * (i >> 2) + 4 * n + (i & 3); }
__host__ __device__ __forceinline__ int wide_row(int R) { return 64 * (R >> 5) + 16 * ((R >> 2) & 3) + 4 * ((R >> 4) & 1) + (R & 3); }
template <class E, class = void> struct IsWide { static constexpr bool v = false; };
template <class E> struct IsWide<E, decltype((void)E::WIDE)> { static constexpr bool v = true; };

struct Unit { int pm, pn; const char* a; const char* b; };
struct Gemm { const void* A; const void* Bt; int nM, nN, K, lda, ldb, a_shift, a_pn_bytes, esz; };

struct StaticOrder {
    int nM, nN, nwg, G, c; const char* A; const char* B; size_t a_pm, b_pn; int a_shift, a_pn;
    __device__ void init(const Gemm& g, int G_, int c_) { nM = g.nM; nN = g.nN; nwg = nM * nN; G = G_; c = c_; A = (const char*)g.A; B = (const char*)g.Bt;
        a_pm = (size_t)BM * g.lda * g.esz; b_pn = (size_t)BM * g.ldb * g.esz; a_shift = g.a_shift; a_pn = g.a_pn_bytes; }
    __device__ bool has(int i) const { int cc = c; asm volatile("" : "+s"(cc)); return (long)i * G + cc < nwg; }
    __device__ bool next(int i, Unit& u) const {
        const long L = (long)i * G + c; if (L >= nwg) return false;
        int wgid = (int)L; { const int q = nwg / NXCD, r = nwg % NXCD, xcd = wgid % NXCD, off = wgid / NXCD; wgid = (xcd < r ? xcd * (q + 1) : r * (q + 1) + (xcd - r) * q) + off; }
        const int nig = WGM * nN, gid = wgid / nig, fm = gid * WGM, gsz = (nM - fm) < WGM ? (nM - fm) : WGM;
        u.pm = fm + ((wgid % nig) % gsz); u.pn = (wgid % nig) / gsz;
        u.a = A + (size_t)u.pm * a_pm + (size_t)(u.pn >> a_shift) * a_pn; u.b = B + (size_t)u.pn * b_pn; return true;
    }
};

template <class Epi, bool FP8 = false, int SCALE_ACT = 0x7F7F7F7F>
__device__ __forceinline__ void gemm_phase(PG8_LAS unsigned char* lds, const Gemm g, const StaticOrder& S, const Epi& E, int wave) {
    const int tid = tid_now(wave), wid = wave, lane = tid & 63, wr = wid >> 2, wc = wid & 3, fr = lane & 15, fq = lane >> 4;
    const int K = g.K, nt = (K * g.esz) / (BK * 2);
    unsigned voffA[2], voffB[2];
#pragma unroll
    for (int i = 0; i < 2; ++i) { int R, C; stage_rc(tid * 16 + i * 8192, R, C); const int Rb = IsWide<Epi>::v ? wide_row(R) : (Epi::PERM ? ((R & ~31) + perm32(R & 31)) : R);
        voffA[i] = (unsigned)(R * g.lda * g.esz + C * 2); voffB[i] = (unsigned)(Rb * g.ldb * g.esz + C * 2); }
    const size_t kstep = (size_t)(BK * 2);
    const size_t hstepA = (size_t)HALF * g.lda * g.esz, hstepB = (size_t)(IsWide<Epi>::v ? 8 : HALF) * g.ldb * g.esz;
    const unsigned ldsw = (unsigned)wid * 1024u, ldsbase = (unsigned)(uintptr_t)lds;
    const int aoff = FP8 ? lds_byte(wr * 64 + fr, fq * 16) : lds_byte(wr * 64 + fr, fq * 8), boff = FP8 ? lds_byte(wc * 32 + fr, fq * 16) : lds_byte(wc * 32 + fr, fq * 8);
#define PG8_SA(b, h) (((b) * 2 + (h)) * HTB)
#define PG8_SB(b, h) ((4 + (b) * 2 + (h)) * HTB)
#define PG8_GLDS(sbase, voff32, ldsdst) do { unsigned keep_; asm volatile("s_mov_b32 %0, m0\n\ts_mov_b32 m0, %3\n\ts_nop 0\n\tglobal_load_lds_dwordx4 %1, %2\n\ts_mov_b32 m0, %0" : "=&s"(keep_) : "v"(voff32), "s"(sbase), "s"(ldsdst) : "memory"); } while (0)
#define PG8_STAGE(bufoff, gbase, voff) do { _Pragma("unroll") for (int _i = 0; _i < 2; ++_i) \
        PG8_GLDS((const char*)(gbase), (voff)[_i], (unsigned)__builtin_amdgcn_readfirstlane((int)(ldsbase + (unsigned)(bufoff) + ldsw + _i * 8192))); } while (0)
#define PG8_LDA(dst, b, h) do { if constexpr (FP8) { _Pragma("unroll") for (int m = 0; m < 4; ++m) dst##8[m] = *(const PG8_LAS i32x8*)(lds + PG8_SA(b, h) + aoff + m * 2048); } \
        else { _Pragma("unroll") for (int m = 0; m < 4; ++m) _Pragma("unroll") for (int k = 0; k < 2; ++k) dst[m][k] = *(const PG8_LAS bf16x8*)(lds + PG8_SA(b, h) + aoff + m * 2048 + k * 1024); } } while (0)
#define PG8_LDB(dst, b, h) do { if constexpr (FP8) { _Pragma("unroll") for (int n = 0; n < 2; ++n) dst##8[n] = *(const PG8_LAS i32x8*)(lds + PG8_SB(b, h) + boff + n * 2048); } \
        else { _Pragma("unroll") for (int n = 0; n < 2; ++n) _Pragma("unroll") for (int k = 0; k < 2; ++k) dst[n][k] = *(const PG8_LAS bf16x8*)(lds + PG8_SB(b, h) + boff + n * 2048 + k * 1024); } } while (0)
#define PG8_MMA(ai, bj, At, Bt) do { __builtin_amdgcn_s_setprio(1); \
        if constexpr (FP8) { _Pragma("unroll") for (int m = 0; m < 4; ++m) _Pragma("unroll") for (int n = 0; n < 2; ++n) \
            acc[ai][bj][m][n] = __builtin_amdgcn_mfma_scale_f32_16x16x128_f8f6f4(Bt##8[n], At##8[m], acc[ai][bj][m][n], 0, 0, 0, 0x79797979, 0, SCALE_ACT); } \
        else { _Pragma("unroll") for (int m = 0; m < 4; ++m) _Pragma("unroll") for (int n = 0; n < 2; ++n) _Pragma("unroll") for (int k = 0; k < 2; ++k) \
            acc[ai][bj][m][n] = __builtin_amdgcn_mfma_f32_16x16x32_bf16(Bt[n][k], At[m][k], acc[ai][bj][m][n], 0, 0, 0); } \
        __builtin_amdgcn_s_setprio(0); } while (0)
#define PG8_WAIT_V(n) asm volatile("s_waitcnt vmcnt(" #n ")" ::: "memory")
#define PG8_WAIT_L(n) asm volatile("s_waitcnt lgkmcnt(" #n ")" ::: "memory")
#define PG8_BAR __builtin_amdgcn_s_barrier()
#define PG8_SCHED __builtin_amdgcn_sched_barrier(0)
    Unit cur, nxt; int ui = 0;
    if (!S.has(0)) return;
    (void)S.next(0, cur);
    f32x4 acc[2][2][4][2];
#pragma unroll
    for (int a = 0; a < 2; ++a)
#pragma unroll
        for (int b = 0; b < 2; ++b)
#pragma unroll
            for (int m = 0; m < 4; ++m)
#pragma unroll
                for (int n = 0; n < 2; ++n) acc[a][b][m][n] = (f32x4){0.f, 0.f, 0.f, 0.f};
    bf16x8 At[4][2], B0[2][2], B1[2][2]; i32x8 At8[4], B08[2], B18[2];
    const char* cA = cur.a; const char* cB = cur.b;
    PG8_STAGE(PG8_SB(0, 0), cB, voffB); PG8_STAGE(PG8_SB(0, 1), cB + hstepB, voffB); PG8_STAGE(PG8_SA(0, 0), cA, voffA); PG8_STAGE(PG8_SA(0, 1), cA + hstepA, voffA);
    { int w_ = wave; asm volatile("" : "+s"(w_)); if ((w_ >> 2) == 1) PG8_BAR; }
    PG8_WAIT_V(2); PG8_BAR;
    PG8_STAGE(PG8_SB(1, 0), cB + kstep, voffB); PG8_STAGE(PG8_SA(1, 0), cA + kstep, voffA); PG8_STAGE(PG8_SB(1, 1), cB + hstepB + kstep, voffB);
    PG8_WAIT_V(6); PG8_BAR;
    for (;;) {
        const bool has_next = S.has(ui + 1); nxt = cur; if (has_next) (void)S.next(ui + 1, nxt);
        const char* nA = has_next ? nxt.a : cA; const char* nB = has_next ? nxt.b : cB;
        for (int t = 0; t < nt; t += 2) {
            const bool last = (t == nt - 2);
            const char* a1 = cA + (size_t)(t + 1) * kstep;
            const char* a2 = last ? nA : cA + (size_t)(t + 2) * kstep; const char* b2 = last ? nB : cB + (size_t)(t + 2) * kstep;
            const char* a3 = a2 + kstep; const char* b3 = b2 + kstep;
            PG8_LDB(B0, 0, 0); PG8_LDB(B1, 0, 1); PG8_SCHED; PG8_LDA(At, 0, 0); PG8_STAGE(PG8_SA(1, 1), a1 + hstepA, voffA);
            PG8_WAIT_V(8); PG8_WAIT_L(0); PG8_BAR; PG8_MMA(0, 0, At, B0); PG8_MMA(0, 1, At, B1); PG8_BAR; PG8_SCHED;
            PG8_LDA(At, 0, 1); PG8_STAGE(PG8_SB(0, 0), b2, voffB); PG8_STAGE(PG8_SB(0, 1), b2 + hstepB, voffB); PG8_STAGE(PG8_SA(0, 0), a2, voffA);
            PG8_WAIT_V(8); PG8_WAIT_L(0); PG8_BAR; PG8_MMA(1, 0, At, B0); PG8_MMA(1, 1, At, B1); PG8_BAR; PG8_SCHED;
            PG8_LDB(B0, 1, 0); PG8_LDB(B1, 1, 1); PG8_SCHED; PG8_LDA(At, 1, 0); PG8_STAGE(PG8_SA(0, 1), a2 + hstepA, voffA);
            PG8_WAIT_V(8); PG8_WAIT_L(0); PG8_BAR; PG8_MMA(0, 0, At, B0); PG8_MMA(0, 1, At, B1); PG8_BAR; PG8_SCHED;
            PG8_LDA(At, 1, 1); PG8_STAGE(PG8_SB(1, 0), b3, voffB); PG8_STAGE(PG8_SB(1, 1), b3 + hstepB, voffB); PG8_STAGE(PG8_SA(1, 0), a3, voffA);
            PG8_WAIT_V(8); PG8_WAIT_L(0); PG8_BAR; PG8_MMA(1, 0, At, B0); PG8_MMA(1, 1, At, B1); PG8_BAR; PG8_SCHED;
        }
        { int w2_ = wave; asm volatile("" : "+s"(w2_));
          if ((w2_ >> 2) == 0) PG8_BAR;
          E(acc, cur, w2_ >> 2, w2_ & 3, 0, 0); }
        if (!S.has(ui + 1)) break;
#pragma unroll
        for (int a = 0; a < 2; ++a)
#pragma unroll
            for (int b = 0; b < 2; ++b)
#pragma unroll
                for (int m = 0; m < 4; ++m)
#pragma unroll
                    for (int n = 0; n < 2; ++n) acc[a][b][m][n] = (f32x4){0.f, 0.f, 0.f, 0.f};
        cur = nxt; cA = nA; cB = nB; ++ui;
        { int w_ = wave; asm volatile("" : "+s"(w_)); if ((w_ >> 2) == 1) PG8_BAR; }
    }
    PG8_WAIT_V(0);
    PG8_BAR;
#undef PG8_SA
#undef PG8_SB
#undef PG8_STAGE
#undef PG8_LDA
#undef PG8_LDB
#undef PG8_MMA
#undef PG8_WAIT_V
#undef PG8_WAIT_L
#undef PG8_BAR
#undef PG8_SCHED
}
}
namespace pg8 {
struct EpiQKV {
    static constexpr bool PERM = true;
    bf16_t *Qb, *Kb, *Vb; const float* qkw;
    __device__ __forceinline__ void operator()(const f32x4 (&acc)[2][2][4][2], const Unit& u, int wr, int wc, int, int) const {
        const int t_ = lane_now(); const int fr = t_ & 15, fq = (t_ >> 4) & 3;
        const int hs = __builtin_amdgcn_readfirstlane(u.pn * 4 + wc);
        bf16_t* dst; int rope = 0, norm = -1, dq = 0; float scale = 1.f;
        if (hs < 4)       { dst = Qb + (size_t)hs * MT * 64; scale = C2_64; }
        else if (hs < 8)  { dst = Kb + (size_t)(hs - 4) * MT * 64; }
        else if (hs < 12) { dst = Vb + (size_t)(hs - 8) * MT * 64; }
        else if (hs < 16) { dst = Qb + (size_t)(4 + 2 * (hs - 12)) * MT * 64; rope = 2; dq = 1; scale = C2_32; }
        else if (hs < 20) { dst = Kb + (size_t)(4 + hs - 16) * MT * 64; rope = 2; }
        else if (hs < 24) { dst = Vb + (size_t)(4 + hs - 20) * MT * 64; }
        else if (hs < 28) { dst = Qb + (size_t)(12 + hs - 24) * MT * 64; rope = 1; scale = C2_64; }
        else if (hs < 30) { dst = Kb + (size_t)(8 + hs - 28) * MT * 64; rope = 1; }
        else if (hs < 32) { dst = Vb + (size_t)(8 + hs - 30) * MT * 64; }
        else if (hs < 36) { dst = Qb + (size_t)(16 + hs - 32) * MT * 64; rope = 1; norm = 0; scale = C2_64; }
        else if (hs < 38) { dst = Kb + (size_t)(10 + hs - 36) * MT * 64; rope = 1; norm = 1; }
        else              { dst = Vb + (size_t)(10 + hs - 38) * MT * 64; }
        const bool latent = u.pm < SEQ / 256;
        if (!latent) rope = 0;
        float fstep = (rope == 2) ? (13.287712379549449f / 8.f) : (13.287712379549449f / 16.f); asm volatile("" : "+v"(fstep));
        const float fbase = (rope == 2) ? 0.f : (float)(8 * (fq & 1)) * fstep;
#define INVF(k) (fast_exp2(-(fbase + (float)(k) * fstep)) * 0.15915494309189535f)
#pragma unroll
        for (int m = 0; m < 4; ++m) {
            float csn[8], ccs[8];
            if (rope == 1) { float pos = (float)(m * 16 + fr); asm volatile("" : "+v"(pos));
#pragma unroll
                for (int k = 0; k < 8; ++k) { const float rev = pos * INVF(k); csn[k] = __builtin_amdgcn_sinf(rev); ccs[k] = __builtin_amdgcn_cosf(rev); } }
#pragma unroll
            for (int ai = 0; ai < 2; ++ai) {
                const int row = u.pm * BM + ai * HALF + wr * 64 + m * 16 + fr;
                float v[16];
#pragma unroll
                for (int bj = 0; bj < 2; ++bj)
#pragma unroll
                    for (int n = 0; n < 2; ++n)
#pragma unroll
                        for (int j = 0; j < 4; ++j) v[bj * 8 + n * 4 + j] = acc[ai][bj][m][n][j];
                if (norm >= 0) {
                    float ss = 0.f;
#pragma unroll
                    for (int k = 0; k < 16; ++k) ss += v[k] * v[k];
                    ss += xorf<16>(ss); ss = x32_sum(ss);
                    const float ri = __builtin_amdgcn_rsqf(ss * (1.f / 64.f) + EPS);
#pragma unroll
                    for (int bj = 0; bj < 2; ++bj) { const f32x4 w0 = *(const f32x4*)(qkw + norm * 64 + 32 * bj + 8 * fq), w1 = *(const f32x4*)(qkw + norm * 64 + 32 * bj + 8 * fq + 4);
#pragma unroll
                        for (int j = 0; j < 4; ++j) { v[bj * 8 + j] = v[bj * 8 + j] * ri * w0[j]; v[bj * 8 + 4 + j] = v[bj * 8 + 4 + j] * ri * w1[j]; } }
                }
                if (rope == 1) {
                    const float sgn = (fq & 2) ? 1.f : -1.f;
                    float pos = (float)(row >> 6); asm volatile("" : "+v"(pos));
#pragma unroll
                    for (int k = 0; k < 8; ++k) {
                        const float rev = pos * INVF(k); const float sn = __builtin_amdgcn_sinf(rev), cs = __builtin_amdgcn_cosf(rev);
                        const float x = v[k]; auto rx = __builtin_amdgcn_permlane32_swap(__float_as_uint(x), __float_as_uint(x), false, false);
                        const float pt = __uint_as_float((fq & 2) ? rx[0] : rx[1]);
                        v[k] = x * cs + sgn * pt * sn;
                        const float y = v[8 + k]; auto ry = __builtin_amdgcn_permlane32_swap(__float_as_uint(y), __float_as_uint(y), false, false);
                        const float qt = __uint_as_float((fq & 2) ? ry[0] : ry[1]);
                        v[8 + k] = y * ccs[k] + sgn * qt * csn[k];
                    }
                } else if (rope == 2) {
                    const float sgn = (fq & 1) ? 1.f : -1.f;
                    float pos = (float)(fq < 2 ? (row >> 6) : (row & 63)); asm volatile("" : "+v"(pos));
#pragma unroll
                    for (int k = 0; k < 8; ++k) {
                        const float rev = pos * INVF(k); const float sn = __builtin_amdgcn_sinf(rev), cs = __builtin_amdgcn_cosf(rev);
#pragma unroll
                        for (int bj = 0; bj < 2; ++bj) { const float x = v[bj * 8 + k], pt = xorf<16>(x); v[bj * 8 + k] = x * cs + sgn * pt * sn; }
                    }
                }
#pragma unroll
                for (int bj = 0; bj < 2; ++bj) {
                    v4u w; w.x = pk2(v[bj * 8 + 0] * scale, v[bj * 8 + 1] * scale); w.y = pk2(v[bj * 8 + 2] * scale, v[bj * 8 + 3] * scale);
                    w.z = pk2(v[bj * 8 + 4] * scale, v[bj * 8 + 5] * scale); w.w = pk2(v[bj * 8 + 6] * scale, v[bj * 8 + 7] * scale);
                    if (dq) {
                        *(v4u*)(dst + (size_t)bj * MT * 64 + (size_t)row * 64 + 32 * bj + 8 * fq) = w;
                        unsigned z0 = 0u; asm volatile("" : "+v"(z0));
                        *(v4u*)(dst + (size_t)(1 - bj) * MT * 64 + (size_t)row * 64 + 32 * bj + 8 * fq) = (v4u){z0, z0, z0, z0};
                    } else *(v4u*)(dst + (size_t)row * 64 + 32 * bj + 8 * fq) = w;
                }
                __builtin_amdgcn_sched_barrier(0);
            }
        }
#undef INVF
    }
};
struct EpiBranch {
    static constexpr bool PERM = true;
    bf16_t* Bp;
    __device__ __forceinline__ void operator()(const f32x4 (&acc)[2][2][4][2], const Unit& u, int wr, int wc, int, int) const {
        const int t_ = lane_now(); const int fr = t_ & 15, fq = (t_ >> 4) & 3;
        const int branch = u.pn >> 2, chb = 256 * (u.pn & 3) + 32 * wc + 8 * fq;
#pragma unroll
        for (int ai = 0; ai < 2; ++ai)
#pragma unroll
            for (int m = 0; m < 4; ++m) { bf16_t* rowp = Bp + (size_t)(u.pm * BM + ai * HALF + wr * 64 + m * 16 + fr) * 4096 + branch * 1024 + chb;
#pragma unroll
                for (int bj = 0; bj < 2; ++bj) { const f32x4 a = acc[ai][bj][m][0], c = acc[ai][bj][m][1];
                    v4u w; w.x = pk2(a[0], a[1]); w.y = pk2(a[2], a[3]); w.z = pk2(c[0], c[1]); w.w = pk2(c[2], c[3]); *(v4u*)(rowp + 128 * bj) = w; } }
    }
};
#ifndef BP8
#define BP8 1
#endif
#ifndef MIX8
#define MIX8 1
#endif
#if MIX8 && !BP8
#error MIX8 needs BP8
#endif
constexpr float BP8_SCALE = 32.f;
struct EpiBranch8 {
    static constexpr bool PERM = false, WIDE = true;
    unsigned char* Bp;
    __device__ __forceinline__ void operator()(const f32x4 (&acc)[2][2][4][2], const Unit& u, int wr, int wc, int, int) const {
        const int t_ = lane_now(); const int fr = t_ & 15, fq = (t_ >> 4) & 3;
        const int branch = u.pn >> 2, off = (4 * (u.pn & 3) + wc) * 256 + branch * 64 + 16 * fq;
#pragma unroll
        for (int ai = 0; ai < 2; ++ai)
#pragma unroll
            for (int m = 0; m < 4; ++m) { unsigned char* rowp = Bp + (size_t)(u.pm * BM + ai * HALF + wr * 64 + m * 16 + fr) * 4096 + off;
                v4u w;
#pragma unroll
                for (int bj = 0; bj < 2; ++bj) { const f32x4 a = acc[ai][bj][m][0] * BP8_SCALE, c = acc[ai][bj][m][1] * BP8_SCALE;
                    w[2 * bj] = pk4_fp8(a[0], a[1], a[2], a[3]); w[2 * bj + 1] = pk4_fp8(c[0], c[1], c[2], c[3]); }
                *(v4u*)rowp = w; }
    }
};
struct EpiGate {
    static constexpr bool PERM = false;
    const bf16_t* Bp; bf16_t* mix; const float* bgate;
    __device__ __forceinline__ void operator()(const f32x4 (&acc)[2][2][4][2], const Unit& u, int wr, int wc, int, int) const {
        const int t_ = lane_now(); const int fr = t_ & 15, fq = (t_ >> 4) & 3;
        const int ch = 64 * u.pn + 16 * wc + 4 * fq;
        f32x4 bias[2][2];
#pragma unroll
        for (int bj = 0; bj < 2; ++bj)
#pragma unroll
            for (int n = 0; n < 2; ++n) bias[bj][n] = *(const f32x4*)(bgate + (2 * bj + n) * 1024 + ch);
#pragma unroll
        for (int ai = 0; ai < 2; ++ai)
#pragma unroll
            for (int m = 0; m < 4; ++m) { const size_t row = (size_t)(u.pm * BM + ai * HALF + wr * 64 + m * 16 + fr);
                f32x4 s = {0.f, 0.f, 0.f, 0.f};
#if BP8
                unsigned b8[4];
#pragma unroll
                for (int b = 0; b < 4; ++b) b8[b] = *(const unsigned*)((const unsigned char*)Bp + row * 4096 + u.pn * 256 + b * 64 + 16 * wc + 4 * fq);
#pragma unroll
                for (int bj = 0; bj < 2; ++bj)
#pragma unroll
                    for (int n = 0; n < 2; ++n) { const f32x4 a = acc[ai][bj][m][n] + bias[bj][n]; const int w = (int)b8[2 * bj + n];
                        const f32x2 lo = __builtin_amdgcn_cvt_pk_f32_fp8(w, false), hi = __builtin_amdgcn_cvt_pk_f32_fp8(w, true);
                        s[0] += sigmoidf_(a[0]) * lo.x; s[1] += sigmoidf_(a[1]) * lo.y; s[2] += sigmoidf_(a[2]) * hi.x; s[3] += sigmoidf_(a[3]) * hi.y; }
#if !MIX8
                s = s * (1.f / BP8_SCALE);
#endif
#else
                v2u bb[4];
#pragma unroll
                for (int b = 0; b < 4; ++b) bb[b] = *(const v2u*)(Bp + row * 4096 + b * 1024 + ch);
#pragma unroll
                for (int bj = 0; bj < 2; ++bj)
#pragma unroll
                    for (int n = 0; n < 2; ++n) { const f32x4 a = acc[ai][bj][m][n] + bias[bj][n]; const unsigned w0 = bb[2 * bj + n].x, w1 = bb[2 * bj + n].y;
                        s[0] += sigmoidf_(a[0]) * bflo(w0); s[1] += sigmoidf_(a[1]) * bfhi(w0); s[2] += sigmoidf_(a[2]) * bflo(w1); s[3] += sigmoidf_(a[3]) * bfhi(w1); }
#endif
#if MIX8
                *(unsigned*)((unsigned char*)mix + row * 1024 + ch) = pk4_fp8(s[0], s[1], s[2], s[3]); }
#else
                v2u w; w.x = pk2(s[0], s[1]); w.y = pk2(s[2], s[3]); *(v2u*)(mix + row * 1024 + ch) = w; }
#endif
    }
};
struct EpiOut {
    static constexpr bool PERM = false;
    const float* xl; const float* xc; float* X; const float* gl; const float* gc;
    __device__ __forceinline__ void operator()(const f32x4 (&acc)[2][2][4][2], const Unit& u, int wr, int wc, int, int) const {
        const int t_ = lane_now(); const int fr = t_ & 15, fq = (t_ >> 4) & 3;
        const bool latent = u.pm < SEQ / 256; const float* gv = latent ? gl : gc; const float* xo = latent ? xl : xc - (size_t)SEQ * DM;
        const int col0 = u.pn * BM + wc * 32 + 4 * fq;
        f32x4 g[2][2];
#pragma unroll
        for (int bj = 0; bj < 2; ++bj)
#pragma unroll
            for (int n = 0; n < 2; ++n) g[bj][n] = *(const f32x4*)(gv + col0 + bj * HALF + n * 16);
#pragma unroll
        for (int ai = 0; ai < 2; ++ai)
#pragma unroll
            for (int m = 0; m < 4; ++m) { const size_t off = (size_t)(u.pm * BM + ai * HALF + wr * 64 + m * 16 + fr) * DM + col0;
#pragma unroll
                for (int bj = 0; bj < 2; ++bj)
#pragma unroll
                    for (int n = 0; n < 2; ++n) { const f32x4 o = *(const f32x4*)(xo + off + bj * HALF + n * 16); *(f32x4*)(X + off + bj * HALF + n * 16) = o + g[bj][n] * acc[ai][bj][m][n]; } }
    }
};
struct EpiOutNorm {
    static constexpr bool PERM = true;
    const float* xl; const float* xc; float* X; const float* gl; const float* gc;
    bf16_t* H; const float* nw; const float* ml; const float* mc;
    gu32* xbuf; gu32* cnt; gu32* tmo; LAS unsigned char* tl;
    __device__ __forceinline__ void operator()(f32x4 (&acc)[2][2][4][2], const Unit& u, int wr, int wc, int, int) const {
        const int t_ = lane_now(); const int fr = t_ & 15, fq = (t_ >> 4) & 3;
        const bool latent = u.pm < SEQ / 256; const float* gv = latent ? gl : gc; const float* xo = latent ? xl : xc - (size_t)SEQ * DM;
        const int col0 = u.pn * BM + wc * 32 + 8 * fq;
        LAS float* P = (LAS float*)tl; LAS float* Sr = (LAS float*)(tl + 4096); volatile LAS unsigned* flag = (volatile LAS unsigned*)(tl + 5120);
        {
            f32x4 g[2][2];
#pragma unroll
            for (int bj = 0; bj < 2; ++bj)
#pragma unroll
                for (int n = 0; n < 2; ++n) g[bj][n] = *(const f32x4*)(gv + col0 + bj * HALF + n * 4);
#pragma unroll
            for (int ai = 0; ai < 2; ++ai)
#pragma unroll
                for (int m = 0; m < 4; ++m) { const int r = ai * HALF + wr * 64 + m * 16 + fr; const size_t off = (size_t)(u.pm * BM + r) * DM + col0; float s = 0.f;
#pragma unroll
                    for (int bj = 0; bj < 2; ++bj)
#pragma unroll
                        for (int n = 0; n < 2; ++n) { const f32x4 o = *(const f32x4*)(xo + off + bj * HALF + n * 4); const f32x4 y = o + g[bj][n] * acc[ai][bj][m][n];
                            *(f32x4*)(X + off + bj * HALF + n * 4) = y; acc[ai][bj][m][n] = y; s += (y.x * y.x + y.y * y.y) + (y.z * y.z + y.w * y.w); }
                    s += xorf<16>(s); s = x32_sum(s);
                    if (fq == 0) P[r * 4 + wc] = s; }
        }
        asm volatile("s_waitcnt lgkmcnt(0)" ::: "memory"); __builtin_amdgcn_s_barrier(); asm volatile("" ::: "memory");
        const int wid = wr * 4 + wc, row = wid * 32 + (t_ & 31);
        if (t_ < 32) { const float tp = (P[row * 4 + 0] + P[row * 4 + 1]) + (P[row * 4 + 2] + P[row * 4 + 3]);
            __hip_atomic_store(xbuf + ((size_t)(u.pm * BM + row) * 4 + u.pn), __float_as_uint(tp), RLX_AGENT); }
        asm volatile("s_waitcnt vmcnt(0)" ::: "memory");
        if (t_ == 0) (void)__hip_atomic_fetch_add(cnt + 64 * u.pm, 1u, RLX_AGENT);
        if (wid == 0) {
            unsigned sp = 0u, dead = 0u;
            while ((unsigned)__builtin_amdgcn_readfirstlane((int)__hip_atomic_load(cnt + 64 * u.pm, RLX_AGENT)) < 32u) {
                __builtin_amdgcn_s_sleep(2);
                if ((++sp & 255u) == 0u) { if (__builtin_amdgcn_readfirstlane((int)__hip_atomic_load(tmo, RLX_AGENT)) != 0) { dead = 1u; break; }
                    if (sp > (1u << 22)) { if (t_ == 0) __hip_atomic_store(tmo, 1u, RLX_AGENT); dead = 1u; break; } } }
            __builtin_amdgcn_fence(__ATOMIC_ACQUIRE, "agent");
            if (t_ == 0) flag[0] = dead;
        }
        asm volatile("s_waitcnt vmcnt(0) lgkmcnt(0)" ::: "memory"); __builtin_amdgcn_s_barrier(); asm volatile("" ::: "memory");
        if (t_ < 32) { const gu32* sl = xbuf + (size_t)(u.pm * BM + row) * 4; float tot = 0.f;
#pragma unroll
            for (int q = 0; q < 4; ++q) tot += __uint_as_float(__hip_atomic_load(sl + q, RLX_AGENT));
            Sr[row] = __builtin_amdgcn_rsqf(tot * (1.f / DM) + EPS); }
        asm volatile("s_waitcnt vmcnt(0) lgkmcnt(0)" ::: "memory"); __builtin_amdgcn_s_barrier(); asm volatile("" ::: "memory");
        const float* mv = latent ? ml : mc;
#pragma unroll
        for (int bj = 0; bj < 2; ++bj) { const int col = col0 + bj * HALF;
            f32x4 wa[2], b[2];
#pragma unroll
            for (int n = 0; n < 2; ++n) { const f32x4 w = *(const f32x4*)(nw + col + 4 * n), a = *(const f32x4*)(mv + 4096 + col + 4 * n); b[n] = *(const f32x4*)(mv + 3072 + col + 4 * n); wa[n] = w * (1.0f + a); }
#pragma unroll
            for (int ai = 0; ai < 2; ++ai)
#pragma unroll
                for (int m = 0; m < 4; ++m) { const int r = ai * HALF + wr * 64 + m * 16 + fr; const float ri = Sr[r];
                    const f32x4 y0 = (acc[ai][bj][m][0] * ri) * wa[0] + b[0], y1 = (acc[ai][bj][m][1] * ri) * wa[1] + b[1];
                    v4u pk; pk.x = pk2(y0.x, y0.y); pk.y = pk2(y0.z, y0.w); pk.z = pk2(y1.x, y1.y); pk.w = pk2(y1.z, y1.w); *(v4u*)(H + (size_t)(u.pm * BM + r) * DM + col) = pk; } }
    }
};
struct EpiS {
    static constexpr bool PERM = true;
    float* S;
    __device__ __forceinline__ void operator()(const f32x4 (&acc)[2][2][4][2], const Unit& u, int wr, int wc, int, int) const {
        const int t_ = lane_now(); const int fr = t_ & 15, fq = (t_ >> 4) & 3;
        const int col0 = u.pn * BM + wc * 32 + 8 * fq;
        bf16_t* Sb = (bf16_t*)S;
#pragma unroll
        for (int ai = 0; ai < 2; ++ai)
#pragma unroll
            for (int m = 0; m < 4; ++m) { bf16_t* rowp = Sb + (size_t)(u.pm * BM + ai * HALF + wr * 64 + m * 16 + fr) * 2048 + col0;
#pragma unroll
                for (int bj = 0; bj < 2; ++bj) { const f32x4 a0 = acc[ai][bj][m][0], a1 = acc[ai][bj][m][1];
                    v4u o; o.x = pk2(a0.x, a0.y); o.y = pk2(a0.z, a0.w); o.z = pk2(a1.x, a1.y); o.w = pk2(a1.z, a1.w);
                    *(v4u*)(rowp + bj * HALF) = o; } }
    }
};
}
namespace att {
using bf16 = __hip_bfloat16;
constexpr int NW = 8, QBLK = 32, QB = 256, KVBLK = 64;
__device__ __forceinline__ int crow(int r, int hi) { return (r & 3) + 8 * (r >> 2) + 4 * hi; }
#define SBAR() __builtin_amdgcn_sched_barrier(0)
constexpr int NSLOT = 3, SLOTB = 8192;
constexpr int LDS_K = 0, LDS_V = NSLOT * SLOTB, LDS_WS = 2 * NSLOT * SLOTB, LDS_OST = LDS_WS + NW * 64 * 4, LDS_RPB = LDS_OST + NW * 8192, LDS_BYTES = LDS_RPB + 2048;
static_assert(LDS_BYTES <= RING_BYTES, "attention scratch fits the ring region");
__device__ __forceinline__ void glds16(const void* gsrc, unsigned lds_dst) { unsigned keep;
    asm volatile("s_mov_b32 %0, m0\n\ts_mov_b32 m0, %2\n\ts_nop 0\n\tglobal_load_lds_dwordx4 %1, off\n\ts_mov_b32 m0, %0" : "=&s"(keep) : "v"(gsrc), "s"(lds_dst) : "memory"); }
__device__ __forceinline__ float max3f(float a, float b, float c) { float r; asm("v_max3_f32 %0, %1, %2, %3" : "=v"(r) : "v"(a), "v"(b), "v"(c)); return r; }
__device__ __forceinline__ float max2f(float a, float b) { float r; asm("v_max_f32_e32 %0, %1, %2" : "=v"(r) : "v"(a), "v"(b)); return r; }
__device__ __forceinline__ float fadd_s(float a, float b) { float r; asm("v_add_f32_e32 %0, %1, %2" : "=v"(r) : "v"(a), "v"(b)); return r; }
__device__ __forceinline__ float fsub_s(float a, float b) { float r; asm("v_sub_f32_e32 %0, %1, %2" : "=v"(r) : "v"(a), "v"(b)); return r; }
__device__ __forceinline__ unsigned cvtpk_s(float lo, float hi) { f32x2 v = {lo, hi}; bf16x2_t b = __builtin_convertvector(v, bf16x2_t); return __builtin_bit_cast(unsigned, b); }
#define WAIT_BAR(N) asm volatile("s_waitcnt vmcnt(" #N ") lgkmcnt(0)\n\ts_barrier" ::: "memory")

__device__ __forceinline__ void qkt(f32x16& p0, f32x16& p1, const char* Kslot, const bf16x8* qr, const f32x16& negm, int r32, int hi) {
    const char* kb = Kslot + hi * 1024 + r32 * 16;
#pragma unroll
    for (int d0 = 0; d0 < 4; ++d0) {
        const bf16x8 b0 = *reinterpret_cast<const bf16x8*>(kb + d0 * 2048);
        const bf16x8 b1 = *reinterpret_cast<const bf16x8*>(kb + d0 * 2048 + 512);
        if (d0 == 0) { p0 = __builtin_amdgcn_mfma_f32_32x32x16_bf16(b0, qr[0], negm, 0, 0, 0); p1 = __builtin_amdgcn_mfma_f32_32x32x16_bf16(b1, qr[0], negm, 0, 0, 0); }
        else { p0 = __builtin_amdgcn_mfma_f32_32x32x16_bf16(b0, qr[d0], p0, 0, 0, 0); p1 = __builtin_amdgcn_mfma_f32_32x32x16_bf16(b1, qr[d0], p1, 0, 0, 0); } }
}
typedef __attribute__((address_space(3))) const char* lds_cptr;
typedef short v4i16_t __attribute__((ext_vector_type(4)));
__device__ __forceinline__ void kload8(bf16x8* kf, lds_cptr kp) {
    kf[0] = *(const __attribute__((address_space(3))) bf16x8*)(kp);        kf[1] = *(const __attribute__((address_space(3))) bf16x8*)(kp + 512);
    kf[2] = *(const __attribute__((address_space(3))) bf16x8*)(kp + 2048); kf[3] = *(const __attribute__((address_space(3))) bf16x8*)(kp + 2560);
    kf[4] = *(const __attribute__((address_space(3))) bf16x8*)(kp + 4096); kf[5] = *(const __attribute__((address_space(3))) bf16x8*)(kp + 4608);
    kf[6] = *(const __attribute__((address_space(3))) bf16x8*)(kp + 6144); kf[7] = *(const __attribute__((address_space(3))) bf16x8*)(kp + 6656);
}
__device__ __forceinline__ void kload2(bf16x8* kf, lds_cptr kp, int j) { kf[2 * j] = *(const __attribute__((address_space(3))) bf16x8*)(kp + j * 2048); kf[2 * j + 1] = *(const __attribute__((address_space(3))) bf16x8*)(kp + j * 2048 + 512); }
__device__ __forceinline__ s16x4 vtr(lds_cptr p) { return __builtin_bit_cast(s16x4, __builtin_amdgcn_ds_read_tr16_b64_v4i16((__attribute__((address_space(3))) v4i16_t*)p)); }
__device__ __forceinline__ float rowmax(const f32x16& p0, const f32x16& p1) {
    float a = max3f(p0[0], p0[1], p1[0]), b = max3f(p0[2], p0[3], p1[1]); a = max3f(a, p1[2], p1[3]);
#pragma unroll
    for (int r = 4; r < 16; r += 4) { a = max3f(a, p0[r], p0[r + 1]); b = max3f(b, p0[r + 2], p0[r + 3]); a = max3f(a, p1[r], p1[r + 1]); b = max3f(b, p1[r + 2], p1[r + 3]); }
    const float m = max2f(a, b);
    auto rr = __builtin_amdgcn_permlane32_swap(__float_as_uint(m), __float_as_uint(m), false, false);
    return max2f(__uint_as_float(rr[0]), __uint_as_float(rr[1]));
}
__device__ __forceinline__ void pv(f32x16* o, int vb, bf16x8 pa0, bf16x8 pa1, bf16x8 pa2, bf16x8 pa3) {
#pragma unroll
    for (int d0 = 0; d0 < 2; ++d0) { s16x4 lo[4], hi[4];
#pragma unroll
        for (int ks = 0; ks < 4; ++ks) {
            asm volatile("ds_read_b64_tr_b16 %0,%1 offset:%c2" : "=&v"(lo[ks]) : "v"(vb), "i"(d0 * 4096 + ks * 1024) : "memory");
            asm volatile("ds_read_b64_tr_b16 %0,%1 offset:%c2" : "=&v"(hi[ks]) : "v"(vb), "i"(d0 * 4096 + ks * 1024 + 512) : "memory"); }
        asm volatile("s_waitcnt lgkmcnt(0)" ::: "memory"); SBAR();
#define PK(k) (bf16x8){lo[k][0], lo[k][1], lo[k][2], lo[k][3], hi[k][0], hi[k][1], hi[k][2], hi[k][3]}
        o[d0] = __builtin_amdgcn_mfma_f32_32x32x16_bf16(pa0, PK(0), o[d0], 0, 0, 0);
        o[d0] = __builtin_amdgcn_mfma_f32_32x32x16_bf16(pa1, PK(1), o[d0], 0, 0, 0);
        o[d0] = __builtin_amdgcn_mfma_f32_32x32x16_bf16(pa2, PK(2), o[d0], 0, 0, 0);
        o[d0] = __builtin_amdgcn_mfma_f32_32x32x16_bf16(pa3, PK(3), o[d0], 0, 0, 0);
#undef PK
    }
}

struct AU {
    const bf16* Q; const bf16* K; const bf16* V;
    bf16* O;
    int q0, NT, kbase;
    float sinkl2;
    int emode;
    float lam, oscale; const float* subw;
};

template <int MODE> __device__ __forceinline__ void amask(f32x16& p0, f32x16& p1, int t, const AU& u, int wid, int r32, int hi, const float* rpb) {
    if constexpr (MODE == 2) {
        if (t >= 4) {
            const int kp0 = u.kbase + 64 * (t - 4) + 4 * hi, qpos = u.q0 + wid * QBLK + r32;
#pragma unroll
            for (int r = 0; r < 16; ++r) { const int kv = kp0 + (r & 3) + 8 * (r >> 2);
                const bool ok0 = ((unsigned)(kv - qpos + 128) <= 256u) && ((unsigned)kv < (unsigned)SEQ);
                const bool ok1 = ((unsigned)(kv + 32 - qpos + 128) <= 256u) && ((unsigned)(kv + 32) < (unsigned)SEQ);
                if (!ok0) p0[r] = -INFINITY; if (!ok1) p1[r] = -INFINITY; }
        }
    }
    if constexpr (MODE == 1) {
        if (t >= 4) {
            const int jr = (u.kbase >> 6) + (t - 4), qr = (u.q0 >> 6) + (wid >> 1), qc = 32 * (wid & 1) + r32;
            int rs = qr - 4; rs = rs < 0 ? 0 : (rs > 248 ? 248 : rs);
            int cs = qc - 8; cs = cs < 0 ? 0 : (cs > 48 ? 48 : cs);
            const bool rowok = (unsigned)(jr - rs) < 8u;
            int ro = jr - qr + 7; ro = ro < 0 ? 0 : (ro > 14 ? 14 : ro);
            const float* brow = rpb + ro * 32;
#pragma unroll
            for (int r = 0; r < 16; ++r) { const int kc = 4 * hi + (r & 3) + 8 * (r >> 2);
                { int bi = kc - qc + 15; bi = bi < 0 ? 0 : (bi > 30 ? 30 : bi); const bool ok = rowok && ((unsigned)(kc - cs) < 16u); p0[r] = ok ? p0[r] + brow[bi] : -INFINITY; }
                { int bi = kc + 32 - qc + 15; bi = bi < 0 ? 0 : (bi > 30 ? 30 : bi); const bool ok = rowok && ((unsigned)(kc + 32 - cs) < 16u); p1[r] = ok ? p1[r] + brow[bi] : -INFINITY; } }
        }
    }
}

template <int MODE, int THRL, int QKH = 0, int NOMAX = 0> __device__ __forceinline__ bool attn_unit(const AU& u, char* shm, int wave) {
    const int lane = lane_now(), tid = (wave << 6) | lane, r32 = lane & 31, hi = lane >> 5; const int wid = wave;
    const bf16* Qw = u.Q + (size_t)(u.q0 + wid * QBLK) * 64;
    const bf16* Kh = u.K; const bf16* Vh = u.V;
    const unsigned lds0 = (unsigned)(uintptr_t)shm;
    float* wsf = (float*)(shm + LDS_WS) + wid * 64;
    const float* rpb = (const float*)(shm + LDS_RPB);
    const int NT = u.NT;
    volatile int* okflag = (volatile int*)(shm + LDS_RPB + 2040);
    if constexpr (NOMAX) { if (tid == 0) *okflag = 0; }
#define KROW(t) ((t) < 4 ? SEQ + 64 * (t) : (u.kbase + 64 * ((t) - 4) < 0 ? 0 : (u.kbase + 64 * ((t) - 4) > SEQ - 64 ? SEQ - 64 : u.kbase + 64 * ((t) - 4))))
    const bf16* ksrc = Kh + (size_t)lane * 64 + wid * 8;
    const bf16* vsrc = Vh + (size_t)(16 * (wid & 3) + (lane >> 2)) * 64 + (wid >> 2) * 32 + (lane & 3) * 8;
    const unsigned kdst = lds0 + LDS_K + wid * 1024, vdst = lds0 + LDS_V + wid * 1024;
#define DMA_K(t, slot) glds16(ksrc + (size_t)KROW(t) * 64, (unsigned)__builtin_amdgcn_readfirstlane(kdst + (slot)))
#define DMA_V(t, slot) glds16(vsrc + (size_t)KROW(t) * 64, (unsigned)__builtin_amdgcn_readfirstlane(vdst + (slot)))
    const int vb0 = (int)(lds0 + LDS_V) + ((lane >> 4) & 1) * 32 + (lane & 3) * 8 + (4 * hi + ((lane & 15) >> 2)) * 64;
    const char* Kbase = shm + LDS_K; bf16x8 kf[8];
    const lds_cptr shm3 = (lds_cptr)shm; const lds_cptr kp0 = shm3 + LDS_K + hi * 1024 + r32 * 16; const lds_cptr vp0 = shm3 + LDS_V + ((lane >> 4) & 1) * 32 + (lane & 3) * 8 + (4 * hi + ((lane & 15) >> 2)) * 64;
    DMA_K(0, 0); DMA_V(0, 0); DMA_K(1, SLOTB);
    bf16x8 qr[4];
#pragma unroll
    for (int d0 = 0; d0 < 4; ++d0) qr[d0] = *reinterpret_cast<const bf16x8*>(&Qw[(size_t)r32 * 64 + d0 * 16 + hi * 8]);
    float mhat = 0.f, l_reg = 0.f; f32x16 o[2]; o[0] = f32x16{}; o[1] = f32x16{}; f32x16 negm = f32x16{}; asm volatile("" : "+v"(negm));
#define CMASK(P0, P1, t) amask<MODE>(P0, P1, (t), u, wid, r32, hi, rpb)
    bool resc = false;
#define START(P0, P1) do { const float rm = rowmax(P0, P1); resc = false; \
    { const float dl = rm; mhat = fadd_s(mhat, dl); \
      _Pragma("unroll") for (int r = 0; r < 16; ++r) { P0[r] = fsub_s(P0[r], dl); P1[r] = fsub_s(P1[r], dl); } \
      _Pragma("unroll") for (int r = 0; r < 16; ++r) negm[r] = -mhat; asm volatile("" : "+v"(negm)); } \
    _Pragma("unroll") for (int r = 0; r < 16; ++r) P0[r] = __builtin_amdgcn_exp2f(P0[r]); } while (0)
#define RESC() do { if (resc) { asm volatile("s_waitcnt lgkmcnt(0)" ::: "memory"); \
      _Pragma("unroll") for (int d_ = 0; d_ < 2; ++d_) _Pragma("unroll") for (int r = 0; r < 16; ++r) o[d_][r] *= wsf[crow(r, hi)]; } } while (0)
    f32x16 pA0, pA1, pB0, pB1;
    int sl_prev = 0, sl_cur = 0, sl_next = SLOTB;
#define ROT() do { sl_prev = sl_cur; sl_cur = sl_next; sl_next = (sl_next == (NSLOT - 1) * SLOTB) ? 0 : sl_next + SLOTB; } while (0)
    DMA_K(2, 2 * SLOTB);
    WAIT_BAR(3);
    qkt(pA0, pA1, Kbase, qr, negm, r32, hi); asm volatile("s_nop 15\n\ts_nop 7" : "+v"(pA0), "+v"(pA1));
    START(pA0, pA1);
    _Pragma("unroll") for (int r = 0; r < 16; ++r) pA1[r] = __builtin_amdgcn_exp2f(pA1[r]);
    WAIT_BAR(0);
    DMA_K(3, 0); DMA_V(1, SLOTB);
    ROT();
    kload8(kf, kp0 + sl_cur);
    WAIT_BAR(2);
    s16x4 vlo[8], vhi[8]; v4u pw0, pw1, pw2, pw3;
#define PKW(P, B) cvtpk_s(P[B], P[B + 1])
#define PAF(k) __builtin_bit_cast(bf16x8, pw##k)
#define VFR(i) (bf16x8){vlo[i][0], vlo[i][1], vlo[i][2], vlo[i][3], vhi[i][0], vhi[i][1], vhi[i][2], vhi[i][3]}
#define PIN(x) asm volatile("" : "+v"(x))
#define MX3(a, b, c) __builtin_fmaxf(__builtin_fmaxf((a), (b)), (c))
#define GAPA(MF, A0, A1, A2, A3, W0, W1, PW) do { MF; sacc += A0; sacc += A1; sacc += A2; sacc += A3; PIN(sacc); W0; W1; PIN(PW); SBAR(); } while (0)
#define EX(v) __builtin_amdgcn_exp2f(v)
#define GAPB(MF, X, B) do { MF; X[B] = EX(X[B]); X[B + 1] = EX(X[B + 1]); X[B + 2] = EX(X[B + 2]); X[B + 3] = EX(X[B + 3]); PIN(X); SBAR(); } while (0)
#define VRD(i) do { vlo[i] = vtr(vp_ + (((i) >> 2) * 4096 + ((i) & 3) * 1024)); vhi[i] = vtr(vp_ + (((i) >> 2) * 4096 + ((i) & 3) * 1024 + 512)); } while (0)
#define KRD(G, j) do { if constexpr (QKH == 0 || (QKH == 1 && (j) < 2) || (QKH == 2 && (j) >= 2)) { if (G) { kload2(kf, kp0 + sl_next, j); SBAR(); } } } while (0)
#define MF32(a, b, c) __builtin_amdgcn_mfma_f32_32x32x16_bf16(a, b, c, 0, 0, 0)
#define QLO(X) do { if constexpr (QKH != 2) { X; } } while (0)
#define QHI(X0, X2) do { if constexpr (QKH == 0) { X0; } else if constexpr (QKH == 2) { X2; } } while (0)
#define STEP(C0, C1, P0, P1, t, GK, GV, GL) do { SBAR(); \
    const lds_cptr vp_ = vp0 + sl_prev; \
    VRD(0); SBAR(); float sacc = (P0[0] + P0[1]); \
    GAPA(QLO(C0 = MF32(kf[0], qr[0], negm)), P0[2], P0[3], P0[4], P0[5],     pw0[0] = PKW(P0, 0), pw0[1] = PKW(P0, 2), pw0); \
    VRD(4); SBAR(); GAPA(QLO(C1 = MF32(kf[1], qr[0], negm)), P0[6], P0[7], P0[8], P0[9],     pw0[2] = PKW(P0, 4), pw0[3] = PKW(P0, 6), pw0); \
    VRD(1); SBAR(); GAPA(QLO(C0 = MF32(kf[2], qr[1], C0)), P0[10], P0[11], P0[12], P0[13], pw1[0] = PKW(P0, 8), pw1[1] = PKW(P0, 10), pw1); \
    VRD(5); SBAR(); GAPA(QLO(C1 = MF32(kf[3], qr[1], C1)), P0[14], P0[15], P1[0], P1[1],   pw1[2] = PKW(P0, 12), pw1[3] = PKW(P0, 14), pw1); \
    VRD(2); SBAR(); GAPA(QHI(C0 = MF32(kf[4], qr[2], C0), C0 = MF32(kf[4], qr[2], negm)), P1[2], P1[3], P1[4], P1[5],     pw2[0] = PKW(P1, 0), pw2[1] = PKW(P1, 2), pw2); \
    VRD(6); SBAR(); GAPA(QHI(C1 = MF32(kf[5], qr[2], C1), C1 = MF32(kf[5], qr[2], negm)), P1[6], P1[7], P1[8], P1[9],     pw2[2] = PKW(P1, 4), pw2[3] = PKW(P1, 6), pw2); \
    VRD(3); SBAR(); GAPA(QHI(C0 = MF32(kf[6], qr[3], C0), C0 = MF32(kf[6], qr[3], C0)), P1[10], P1[11], P1[12], P1[13], pw3[0] = PKW(P1, 8), pw3[1] = PKW(P1, 10), pw3); \
    VRD(7); SBAR(); GAPA(QHI(C1 = MF32(kf[7], qr[3], C1), C1 = MF32(kf[7], qr[3], C1)), P1[14], P1[15], 0.f, 0.f,       pw3[2] = PKW(P1, 12), pw3[3] = PKW(P1, 14), pw3); \
    l_reg += sacc; \
    if (GK) { DMA_K((t) + 3, sl_cur); } if (GV) { DMA_V((t) + 1, sl_next); } \
    CMASK(C0, C1, t); \
    if constexpr (NOMAX) { resc = false; } else { float a = MX3(C0[0], C0[1], C1[0]), b = MX3(C0[2], C0[3], C1[1]); a = MX3(a, C1[2], C1[3]); \
      _Pragma("unroll") for (int r = 4; r < 16; r += 4) { a = MX3(a, C0[r], C0[r + 1]); b = MX3(b, C0[r + 2], C0[r + 3]); a = MX3(a, C1[r], C1[r + 1]); b = MX3(b, C1[r + 2], C1[r + 3]); } \
      float rm = __builtin_fmaxf(a, b); { auto rr = __builtin_amdgcn_permlane32_swap(__float_as_uint(rm), __float_as_uint(rm), false, false); rm = __builtin_fmaxf(__uint_as_float(rr[0]), __uint_as_float(rr[1])); } \
      resc = false; \
      if (__builtin_expect(__any(rm > (float)THRL), 0)) { const float dl = __builtin_fmaxf(rm, 0.f); mhat += dl; \
        _Pragma("unroll") for (int r = 0; r < 16; ++r) { C0[r] -= dl; C1[r] -= dl; } \
        _Pragma("unroll") for (int r = 0; r < 16; ++r) negm[r] = -mhat; asm volatile("" : "+v"(negm)); \
        const float f = __builtin_amdgcn_exp2f(-dl); l_reg *= f; if (hi == 0) wsf[r32] = f; resc = true; } } \
    SBAR(); \
    GAPB(o[0] = __builtin_amdgcn_mfma_f32_32x32x16_bf16(PAF(0), VFR(0), o[0], 0, 0, 0), C0, 0); \
    GAPB(o[1] = __builtin_amdgcn_mfma_f32_32x32x16_bf16(PAF(0), VFR(4), o[1], 0, 0, 0), C0, 4); \
    KRD(GL, 0); GAPB(o[0] = __builtin_amdgcn_mfma_f32_32x32x16_bf16(PAF(1), VFR(1), o[0], 0, 0, 0), C0, 8); \
    KRD(GL, 1); GAPB(o[1] = __builtin_amdgcn_mfma_f32_32x32x16_bf16(PAF(1), VFR(5), o[1], 0, 0, 0), C0, 12); \
    KRD(GL, 2); GAPB(o[0] = __builtin_amdgcn_mfma_f32_32x32x16_bf16(PAF(2), VFR(2), o[0], 0, 0, 0), C1, 0); \
    KRD(GL, 3); GAPB(o[1] = __builtin_amdgcn_mfma_f32_32x32x16_bf16(PAF(2), VFR(6), o[1], 0, 0, 0), C1, 4); \
    GAPB(o[0] = __builtin_amdgcn_mfma_f32_32x32x16_bf16(PAF(3), VFR(3), o[0], 0, 0, 0), C1, 8); \
    GAPB(o[1] = __builtin_amdgcn_mfma_f32_32x32x16_bf16(PAF(3), VFR(7), o[1], 0, 0, 0), C1, 12); \
    } while (0)
    int t = 1;
    for (; t + 5 < NT; t += 2) {
        STEP(pB0, pB1, pA0, pA1, t, true, true, true);     WAIT_BAR(2); RESC(); ROT();
        STEP(pA0, pA1, pB0, pB1, t + 1, true, true, true);   WAIT_BAR(2); RESC(); ROT();
    }
#define ENDW(tt) do { if ((tt) + 3 < NT) { WAIT_BAR(2); } else if ((tt) + 2 < NT) { WAIT_BAR(1); } else { WAIT_BAR(0); } } while (0)
    for (; t + 1 < NT; t += 2) {
        STEP(pB0, pB1, pA0, pA1, t, (t + 3 < NT), (t + 1 < NT), (t + 1 < NT));       ENDW(t);   RESC(); ROT();
        STEP(pA0, pA1, pB0, pB1, t + 1, (t + 4 < NT), (t + 2 < NT), (t + 2 < NT));     ENDW(t + 1); RESC(); ROT();
    }
    STEP(pB0, pB1, pA0, pA1, NT - 1, false, false, false); RESC();
    { float sacc = pB0[0] + pB0[1]; _Pragma("unroll") for (int r = 2; r < 16; ++r) sacc += pB0[r]; _Pragma("unroll") for (int r = 0; r < 16; ++r) sacc += pB1[r]; l_reg += sacc;
      pw0 = (v4u){PKW(pB0, 0), PKW(pB0, 2), PKW(pB0, 4), PKW(pB0, 6)}; pw1 = (v4u){PKW(pB0, 8), PKW(pB0, 10), PKW(pB0, 12), PKW(pB0, 14)}; pw2 = (v4u){PKW(pB1, 0), PKW(pB1, 2), PKW(pB1, 4), PKW(pB1, 6)}; pw3 = (v4u){PKW(pB1, 8), PKW(pB1, 10), PKW(pB1, 12), PKW(pB1, 14)};
      SBAR(); pv(o, vb0 + sl_cur, PAF(0), PAF(1), PAF(2), PAF(3)); }
#undef PKW
#undef PAF
#undef VFR
#undef PIN
#undef MX3
#undef GAPA
#undef GAPB
#undef EX
#undef VRD
#undef KRD
#undef MF32
#undef QLO
#undef QHI
#undef STEP
#undef ENDW
    { auto rr = __builtin_amdgcn_permlane32_swap(__float_as_uint(l_reg), __float_as_uint(l_reg), false, false); l_reg = __uint_as_float(rr[0]) + __uint_as_float(rr[1]); }
    if constexpr (NOMAX) {
        const bool ok = (l_reg > 0x1p-90f) && (l_reg < 0x1p90f);
        if (__any(!ok)) { if (lane == 0) *okflag = 1; }
        asm volatile("s_waitcnt lgkmcnt(0)\n\ts_barrier" ::: "memory");
        const int bad = __builtin_amdgcn_readfirstlane(*okflag);
        if (bad) { asm volatile("s_waitcnt lgkmcnt(0)\n\ts_barrier" ::: "memory"); return false; }
    }
    l_reg += __builtin_amdgcn_exp2f(u.sinkl2 - mhat);
    if (hi == 0) wsf[32 + r32] = l_reg; asm volatile("s_waitcnt lgkmcnt(0)" ::: "memory");
    float rli[16];
#pragma unroll
    for (int r = 0; r < 16; ++r) rli[r] = __builtin_amdgcn_rcpf(wsf[32 + crow(r, hi)]);
    if (u.emode == 0) {
        bf16* Ow = u.O + (size_t)(u.q0 + wid * QBLK) * 1024;
        bf16* stg = (bf16*)(shm + LDS_OST + wid * 8192);
#pragma unroll
        for (int r = 0; r < 16; ++r) { const int orow = crow(r, hi);
#pragma unroll
            for (int d0 = 0; d0 < 2; ++d0) stg[orow * 64 + d0 * 32 + r32] = __float2bfloat16(o[d0][r] * rli[r]); }
        asm volatile("s_waitcnt lgkmcnt(0)" ::: "memory");
#pragma unroll
        for (int i = 0; i < 4; ++i) { const int row = i * 8 + (lane >> 3), ch = lane & 7; const v4u v = *(const v4u*)(stg + row * 64 + ch * 8); *(v4u*)(Ow + (size_t)row * 1024 + ch * 8) = v; }
    } else {
        float* stf = (float*)(shm + LDS_OST + wid * 8192);
        if (u.emode == 1) {
#pragma unroll
            for (int r = 0; r < 16; ++r) { const int orow = crow(r, hi);
#pragma unroll
                for (int d0 = 0; d0 < 2; ++d0) stf[orow * 64 + d0 * 32 + r32] = o[d0][r] * rli[r]; }
        } else {
#pragma unroll
            for (int r = 0; r < 16; ++r) { const int orow = crow(r, hi);
#pragma unroll
                for (int d0 = 0; d0 < 2; ++d0) { const float y = stf[orow * 64 + d0 * 32 + r32] - u.lam * (o[d0][r] * rli[r]); stf[orow * 64 + d0 * 32 + r32] = y; } }
            asm volatile("s_waitcnt lgkmcnt(0)" ::: "memory");
            bf16* Ow = u.O + (size_t)(u.q0 + wid * QBLK) * 1024;
#pragma unroll
            for (int i = 0; i < 4; ++i) { const int row = i * 8 + (lane >> 3), ch = lane & 7;
                const f32x4 y0 = *(const f32x4*)(stf + row * 64 + ch * 8), y1 = *(const f32x4*)(stf + row * 64 + ch * 8 + 4);
                float ss = (y0[0] * y0[0] + y0[1] * y0[1]) + (y0[2] * y0[2] + y0[3] * y0[3]) + (y1[0] * y1[0] + y1[1] * y1[1]) + (y1[2] * y1[2] + y1[3] * y1[3]);
                ss += xorf<1>(ss); ss += xorf<2>(ss); ss += xorf<4>(ss);
                const float ri = __builtin_amdgcn_rsqf(ss * (1.f / 64.f) + EPS) * u.oscale;
                const f32x4 w0 = *(const f32x4*)(u.subw + ch * 8), w1 = *(const f32x4*)(u.subw + ch * 8 + 4);
                v4u v; v.x = pk2(y0[0] * ri * w0[0], y0[1] * ri * w0[1]); v.y = pk2(y0[2] * ri * w0[2], y0[3] * ri * w0[3]); v.z = pk2(y1[0] * ri * w1[0], y1[1] * ri * w1[1]); v.w = pk2(y1[2] * ri * w1[2], y1[3] * ri * w1[3]);
                *(v4u*)(Ow + (size_t)row * 1024 + ch * 8) = v; }
        }
    }
    asm volatile("s_waitcnt lgkmcnt(0)\n\ts_barrier" ::: "memory");
    return true;
#undef DMA_K
#undef DMA_V
#undef KROW
#undef CMASK
#undef START
#undef RESC
#undef ROT
}

template <int MODE, int NOMAX = 0> __device__ __forceinline__ bool attn_simple(const AU& u, char* shm, int wave) {
    const int lane = lane_now(), tid = (wave << 6) | lane, r32 = lane & 31, hi = lane >> 5; const int wid = wave;
    const bf16* Qw = u.Q + (size_t)(u.q0 + wid * QBLK) * 64;
    const unsigned lds0 = (unsigned)(uintptr_t)shm;
    float* wsf = (float*)(shm + LDS_WS) + wid * 64;
    const float* rpb = (const float*)(shm + LDS_RPB);
    const int NT = u.NT;
    volatile int* okflag = (volatile int*)(shm + LDS_RPB + 2040);
    if constexpr (NOMAX) { if (tid == 0) *okflag = 0; }
#define KROW(t) ((t) < 4 ? SEQ + 64 * (t) : (u.kbase + 64 * ((t) - 4) < 0 ? 0 : (u.kbase + 64 * ((t) - 4) > SEQ - 64 ? SEQ - 64 : u.kbase + 64 * ((t) - 4))))
    const bf16* ksrc = u.K + (size_t)lane * 64 + wid * 8;
    const bf16* vsrc = u.V + (size_t)(16 * (wid & 3) + (lane >> 2)) * 64 + (wid >> 2) * 32 + (lane & 3) * 8;
    const unsigned kdst = lds0 + LDS_K + wid * 1024, vdst = lds0 + LDS_V + wid * 1024;
    const int vb0 = (int)(lds0 + LDS_V) + ((lane >> 4) & 1) * 32 + (lane & 3) * 8 + (4 * hi + ((lane & 15) >> 2)) * 64;
    { const int kr = KROW(0); glds16(ksrc + (size_t)kr * 64, (unsigned)__builtin_amdgcn_readfirstlane(kdst)); glds16(vsrc + (size_t)kr * 64, (unsigned)__builtin_amdgcn_readfirstlane(vdst)); }
    bf16x8 qr[4];
#pragma unroll
    for (int d0 = 0; d0 < 4; ++d0) qr[d0] = *reinterpret_cast<const bf16x8*>(&Qw[(size_t)r32 * 64 + d0 * 16 + hi * 8]);
    float m_run = -INFINITY, l_reg = 0.f; f32x16 o[2]; o[0] = f32x16{}; o[1] = f32x16{};
    const f32x16 zero = f32x16{};
#pragma unroll 1
    for (int t = 0; t < NT; ++t) {
        const int sl = (t & 1) * SLOTB;
        asm volatile("s_waitcnt vmcnt(0) lgkmcnt(0)\n\ts_barrier" ::: "memory");
        if (t + 1 < NT) { const int kr = KROW(t + 1); const int sn = ((t + 1) & 1) * SLOTB;
            glds16(ksrc + (size_t)kr * 64, (unsigned)__builtin_amdgcn_readfirstlane(kdst + sn)); glds16(vsrc + (size_t)kr * 64, (unsigned)__builtin_amdgcn_readfirstlane(vdst + sn)); }
        bool live = true;
        if (t >= 4) {
            if constexpr (MODE == 1) { const int jr = (u.kbase >> 6) + (t - 4), qr_ = (u.q0 >> 6) + (wid >> 1); int rs = qr_ - 4; rs = rs < 0 ? 0 : (rs > 248 ? 248 : rs); live = (unsigned)(jr - rs) < 8u; }
            if constexpr (MODE == 2) { const int k0 = u.kbase + 64 * (t - 4), qa = u.q0 + wid * QBLK; live = (k0 + 63 >= qa - 128) && (k0 <= qa + QBLK - 1 + 128); }
        }
        if (!live) continue;
        f32x16 p0, p1;
        qkt(p0, p1, shm + LDS_K + sl, qr, zero, r32, hi);
        amask<MODE>(p0, p1, t, u, wid, r32, hi, rpb);
        if (NOMAX && t > 0) {
            float sacc = 0.f;
#pragma unroll
            for (int r = 0; r < 16; ++r) { p0[r] = __builtin_amdgcn_exp2f(p0[r] - m_run); p1[r] = __builtin_amdgcn_exp2f(p1[r] - m_run); sacc += p0[r] + p1[r]; }
            l_reg += sacc;
        } else {
        float rm = p0[0];
#pragma unroll
        for (int r = 1; r < 16; ++r) rm = __builtin_fmaxf(rm, p0[r]);
#pragma unroll
        for (int r = 0; r < 16; ++r) rm = __builtin_fmaxf(rm, p1[r]);
        { auto rr = __builtin_amdgcn_permlane32_swap(__float_as_uint(rm), __float_as_uint(rm), false, false); rm = __builtin_fmaxf(__uint_as_float(rr[0]), __uint_as_float(rr[1])); }
        const float m_new = __builtin_fmaxf(m_run, rm);
        const float alpha = __builtin_amdgcn_exp2f(m_run - m_new); m_run = m_new;
        float sacc = 0.f;
#pragma unroll
        for (int r = 0; r < 16; ++r) { p0[r] = __builtin_amdgcn_exp2f(p0[r] - m_new); p1[r] = __builtin_amdgcn_exp2f(p1[r] - m_new); sacc += p0[r] + p1[r]; }
        l_reg = l_reg * alpha + sacc;
        if (hi == 0) wsf[r32] = alpha;
        asm volatile("s_waitcnt lgkmcnt(0)" ::: "memory");
#pragma unroll
        for (int d_ = 0; d_ < 2; ++d_)
#pragma unroll
            for (int r = 0; r < 16; ++r) o[d_][r] *= wsf[crow(r, hi)];
        }
        v4u pw0, pw1, pw2, pw3;
        pw0 = (v4u){cvtpk_s(p0[0], p0[1]), cvtpk_s(p0[2], p0[3]), cvtpk_s(p0[4], p0[5]), cvtpk_s(p0[6], p0[7])}; pw1 = (v4u){cvtpk_s(p0[8], p0[9]), cvtpk_s(p0[10], p0[11]), cvtpk_s(p0[12], p0[13]), cvtpk_s(p0[14], p0[15])};
        pw2 = (v4u){cvtpk_s(p1[0], p1[1]), cvtpk_s(p1[2], p1[3]), cvtpk_s(p1[4], p1[5]), cvtpk_s(p1[6], p1[7])}; pw3 = (v4u){cvtpk_s(p1[8], p1[9]), cvtpk_s(p1[10], p1[11]), cvtpk_s(p1[12], p1[13]), cvtpk_s(p1[14], p1[15])};
        asm volatile("s_waitcnt lgkmcnt(0)" ::: "memory"); SBAR();
        pv(o, vb0 + sl, __builtin_bit_cast(bf16x8, pw0), __builtin_bit_cast(bf16x8, pw1), __builtin_bit_cast(bf16x8, pw2), __builtin_bit_cast(bf16x8, pw3));
    }
    { auto rr = __builtin_amdgcn_permlane32_swap(__float_as_uint(l_reg), __float_as_uint(l_reg), false, false); l_reg = __uint_as_float(rr[0]) + __uint_as_float(rr[1]); }
    if constexpr (NOMAX) {
        const bool ok = (l_reg > 0x1p-90f) && (l_reg < 0x1p90f);
        if (__any(!ok)) { if (lane == 0) *okflag = 1; }
        asm volatile("s_waitcnt vmcnt(0) lgkmcnt(0)\n\ts_barrier" ::: "memory");
        const int bad = __builtin_amdgcn_readfirstlane(*okflag);
        if (bad) { asm volatile("s_waitcnt lgkmcnt(0)\n\ts_barrier" ::: "memory"); return false; }
    }
    l_reg += __builtin_amdgcn_exp2f(u.sinkl2 - m_run);
    asm volatile("s_waitcnt lgkmcnt(0)" ::: "memory");
    if (hi == 0) wsf[32 + r32] = l_reg; asm volatile("s_waitcnt lgkmcnt(0)" ::: "memory");
    float rli[16];
#pragma unroll
    for (int r = 0; r < 16; ++r) rli[r] = __builtin_amdgcn_rcpf(wsf[32 + crow(r, hi)]);
    {
        bf16* Ow = u.O + (size_t)(u.q0 + wid * QBLK) * 1024;
        bf16* stg = (bf16*)(shm + LDS_OST + wid * 8192);
#pragma unroll
        for (int r = 0; r < 16; ++r) { const int orow = crow(r, hi);
#pragma unroll
            for (int d0 = 0; d0 < 2; ++d0) stg[orow * 64 + d0 * 32 + r32] = __float2bfloat16(o[d0][r] * rli[r]); }
        asm volatile("s_waitcnt lgkmcnt(0)" ::: "memory");
#pragma unroll
        for (int i = 0; i < 4; ++i) { const int row = i * 8 + (lane >> 3), ch = lane & 7; const v4u v = *(const v4u*)(stg + row * 64 + ch * 8); *(v4u*)(Ow + (size_t)row * 1024 + ch * 8) = v; }
    }
    asm volatile("s_waitcnt vmcnt(0) lgkmcnt(0)\n\ts_barrier" ::: "memory");
    return true;
#undef KROW
}
#undef SBAR
#undef WAIT_BAR
}
struct Args { const float* in[23]; float* out; unsigned char* ws; int flags; int pad; };
enum { I_X = 0, I_C, I_CTX, I_CCTX, I_N1W, I_N2W, I_ADAW, I_ADAB, I_WIN, I_RPB, I_DLAM, I_SUBW, I_SINK, I_QKNW, I_WBR, I_WGATE, I_BGATE, I_WOUT, I_PWQ, I_PKEYS, I_PU, I_PV, I_FNW };

struct Frame {
    LAS unsigned char* lds; volatile LAS unsigned* MISC; gu32* ctl;
    int wave, vcu, G;
};
__device__ __forceinline__ int ltid(int wave) { return tid_now(wave); }

struct MapId   { __device__ __forceinline__ int operator()(int n) const { return n; } };
struct MapWin  { __device__ __forceinline__ int operator()(int n) const { return (n & ~255) + 128 * ((n >> 5) & 1) + 32 * ((n >> 6) & 3) + (n & 31); } };
struct MapGate { __device__ __forceinline__ int operator()(int n) const { const int br = n >> 10, ch = n & 1023; return 256 * (ch >> 6) + 128 * (br >> 1) + 32 * ((ch >> 4) & 3) + 16 * (br & 1) + (ch & 15); } };
template <class Map, bool F8 = false> __device__ __forceinline__ void transpose_item(const float* W, int K, int N, void* WTv, Map mp, LAS float* scr, int item, int lane) {
    bf16_t* WT = (bf16_t*)WTv; unsigned char* WT8 = (unsigned char*)WTv;
    const int nblk = N / 32, kb = item / nblk, nb = item % nblk, k0 = 64 * kb, n0 = 32 * nb;
#pragma unroll 8
    for (int i = 0; i < 32; ++i) { const int kk = 2 * i + (lane >> 5); scr[kk * 33 + (lane & 31)] = W[(size_t)(k0 + kk) * N + n0 + (lane & 31)]; }
    LDS_WAIT(); asm volatile("" ::: "memory");
    const int c = lane & 7;
#pragma unroll
    for (int j = 0; j < 4; ++j) { const int n = (lane >> 3) + 8 * j; const LAS float* s = scr + (8 * c) * 33 + n;
        int nn = n0 + n; asm volatile("" : "+v"(nn));
        if constexpr (F8) { v2u o; o.x = pk4_fp8(s[0 * 33] * 64.f, s[1 * 33] * 64.f, s[2 * 33] * 64.f, s[3 * 33] * 64.f); o.y = pk4_fp8(s[4 * 33] * 64.f, s[5 * 33] * 64.f, s[6 * 33] * 64.f, s[7 * 33] * 64.f);
            *(GAS v2u*)(WT8 + (size_t)mp(nn) * K + k0 + 8 * c) = o; }
        else { v4u o; o.x = pk2(s[0 * 33], s[1 * 33]); o.y = pk2(s[2 * 33], s[3 * 33]); o.z = pk2(s[4 * 33], s[5 * 33]); o.w = pk2(s[6 * 33], s[7 * 33]);
            *(GAS v4u*)(WT + (size_t)mp(nn) * K + k0 + 8 * c) = o; } }
    LDS_WAIT(); asm volatile("" ::: "memory");
}
__device__ __forceinline__ void modnorm_row(const float* xrow, bf16_t* orow, const float* nw, const float* sh, const float* sc, int lane, unsigned char* o8row = nullptr) {
    const GAS f32x4* xr = (const GAS f32x4*)xrow + lane;
    f32x4 v[4]; float s = 0.f;
#pragma unroll
    for (int j = 0; j < 4; ++j) { v[j] = xr[64 * j]; s += (v[j].x * v[j].x + v[j].y * v[j].y) + (v[j].z * v[j].z + v[j].w * v[j].w); }
    const float ri = __builtin_amdgcn_rsqf(wave_sum(s) * (1.f / DM) + EPS);
    GAS v2u* o8 = (GAS v2u*)orow + lane;
#pragma unroll
    for (int j = 0; j < 4; ++j) { const int col = 256 * j + 4 * lane; const f32x4 w = *(const f32x4*)(nw + col), a = *(const f32x4*)(sc + col), b = *(const f32x4*)(sh + col);
        const f32x4 y = (v[j] * ri * w) * (1.0f + a) + b;
        if (orow) { v2u p; p.x = pk2(y.x, y.y); p.y = pk2(y.z, y.w); o8[64 * j] = p; }
        if (o8row) ((GAS unsigned*)o8row)[64 * j + lane] = pk4_fp8(y.x, y.y, y.z, y.w); }
}

__device__ __forceinline__ void ce_desc(float& a, float& b) { const float hi = __builtin_fmaxf(a, b), lo = __builtin_fminf(a, b); a = hi; b = lo; }
__device__ __forceinline__ void sort16_desc(float (&x)[16]) {
#pragma unroll
    for (int k = 2; k <= 16; k <<= 1)
#pragma unroll
        for (int j = k >> 1; j > 0; j >>= 1)
#pragma unroll
            for (int i = 0; i < 16; ++i) { const int l = i ^ j; if (l > i) { if ((i & k) == 0) ce_desc(x[i], x[l]); else ce_desc(x[l], x[i]); } }
}
__device__ __forceinline__ void merge16_desc(float (&top)[16], const float (&c)[16]) {
#pragma unroll
    for (int i = 0; i < 16; ++i) top[i] = __builtin_fmaxf(top[i], c[15 - i]);
#pragma unroll
    for (int j = 8; j > 0; j >>= 1)
#pragma unroll
        for (int i = 0; i < 16; ++i) { const int l = i ^ j; if (l > i) ce_desc(top[i], top[l]); }
}

struct PeerArgs { unsigned char* H8out_xq; unsigned char* H8out; const float* S; const bf16_t* Hin; const unsigned char* U; const unsigned char* V; const float* SU; const float* SV; const float* Xin; float* Xout;
                  const float* g2l; const float* g2c;
                  bf16_t* Hout; const float* nwn; const float* shl; const float* scl; const float* shc; const float* scc;
                  float* fout; const float* fnw;
                  int nblocks; int* dbg_eid; float* dbg_gt; bool dry; int route_reps; };
struct PeerBufs;
constexpr int PL_LISTS = 0, PL_EID = 40960, PL_GT = PL_EID + 16384;
__device__ __forceinline__ float dot2bf(unsigned a, unsigned b, float acc) { return __builtin_amdgcn_fdot2_f32_bf16(__builtin_bit_cast(bf16x2_t, a), __builtin_bit_cast(bf16x2_t, b), acc, false); }
__device__ __forceinline__ float dot8(const v4u a, const v4u b, float acc) {
    const unsigned a0 = a.x, a1 = a.y, a2 = a.z, a3 = a.w, b0 = b.x, b1 = b.y, b2 = b.z, b3 = b.w;
    acc = dot2bf(a0, b0, acc); acc = dot2bf(a1, b1, acc); acc = dot2bf(a2, b2, acc); acc = dot2bf(a3, b3, acc);
    return acc;
}
struct PeerBufs { int* eid; float* gt; float* a; unsigned char* xq; float* sx; };
__device__ __forceinline__ void peer_route(Frame& F, const PeerArgs& P, const PeerBufs& B) {
    const int tid = ltid(F.wave), lane = tid & 63;
    LAS unsigned* lists = (LAS unsigned*)(F.lds + PL_LISTS);
    LAS int* eid = (LAS int*)(F.lds + PL_EID);
    LAS float* gt = (LAS float*)(F.lds + PL_GT);
    for (int blk = F.vcu; blk < P.nblocks; blk += F.G) {
        const int row0 = blk * 32;
        {
            const int tok = tid >> 4, lst = tid & 15;
            const float* sp = P.S + (size_t)(row0 + tok) * 2048 + lst * 128;
            float top[16];
#pragma unroll 1
            for (int c = 0; c < 8; ++c) {
                float x[16];
#pragma unroll
                for (int q = 0; q < 4; ++q) { const f32x4 v = *(const f32x4*)(sp + c * 16 + q * 4);
#pragma unroll
                    for (int j = 0; j < 4; ++j) x[q * 4 + j] = __uint_as_float((__float_as_uint(v[j]) & ~127u) | (unsigned)(c * 16 + q * 4 + j)); }
                sort16_desc(x);
                if (c == 0) {
#pragma unroll
                    for (int i = 0; i < 16; ++i) top[i] = x[i];
                } else merge16_desc(top, x);
            }
            LAS unsigned* lp = lists + tid * 20;
#pragma unroll
            for (int q = 0; q < 4; ++q) *(LAS v4u*)(lp + q * 4) = (v4u){__float_as_uint(top[q * 4]), __float_as_uint(top[q * 4 + 1]), __float_as_uint(top[q * 4 + 2]), __float_as_uint(top[q * 4 + 3])};
        }
        __syncthreads();
        if (tid < 256) {
            const int tok = tid >> 3, hd = tid & 7;
            const LAS unsigned* la = lists + (tok * 16 + 2 * hd) * 20; const LAS unsigned* lb = la + 20;
            float av[16], bv[16];
#pragma unroll
            for (int q = 0; q < 4; ++q) { const v4u a = *(const LAS v4u*)(la + q * 4), b = *(const LAS v4u*)(lb + q * 4);
#pragma unroll
                for (int j = 0; j < 4; ++j) { av[q * 4 + j] = __uint_as_float(a[j] & ~127u); bv[q * 4 + j] = __uint_as_float(b[j] & ~127u); } }
            float c0[16], c1[16], c2[16], c3[16];
#pragma unroll
            for (int i = 0; i < 16; ++i) { c0[i] = -INFINITY; c1[i] = -INFINITY; c2[i] = -INFINITY; c3[i] = -INFINITY; }
            {
                int cnt = 0;
#pragma unroll
                for (int i = 0; i < 16; ++i)
#pragma unroll
                    for (int j = 0; j < 16; ++j) if ((i + 1) * (j + 1) <= 16) {
                        const float sm = __uint_as_float((__float_as_uint(av[i] + bv[j]) & ~255u) | (unsigned)(i * 16 + j));
                        const int slot = cnt & 15, arr = cnt >> 4;
                        if (arr == 0) c0[slot] = sm; else if (arr == 1) c1[slot] = sm; else if (arr == 2) c2[slot] = sm; else c3[slot] = sm;
                        ++cnt;
                    }
            }
            sort16_desc(c0); sort16_desc(c1); sort16_desc(c2); sort16_desc(c3);
            merge16_desc(c0, c1); merge16_desc(c0, c2); merge16_desc(c0, c3);
            float ev[16], sum = 0.f; const float m0 = __uint_as_float(__float_as_uint(c0[0]) & ~255u);
#pragma unroll
            for (int k = 0; k < 16; ++k) { ev[k] = fast_exp2((__uint_as_float(__float_as_uint(c0[k]) & ~255u) - m0) * LOG2E); sum += ev[k]; }
            const float rs = 1.0f / sum;
#pragma unroll
            for (int k = 0; k < 16; ++k) { const unsigned code = __float_as_uint(c0[k]) & 255u;
                const int ia = (int)(la[code >> 4] & 127u), ib = (int)(lb[code & 15u] & 127u);
                eid[tok * 128 + hd * 16 + k] = ia * NKEYS + ib; gt[tok * 128 + hd * 16 + k] = ev[k] * rs; }
        }
        __syncthreads();
#pragma unroll
        for (int i = 0; i < 8; ++i) { const int idx = i * NTHREADS + tid; B.eid[(size_t)row0 * 128 + idx] = eid[idx]; B.gt[(size_t)row0 * 128 + idx] = gt[idx]; }
#pragma unroll 1
        for (int tk = 0; tk < 4; ++tk) {
            const size_t row = (size_t)(row0 + F.wave * 4 + tk);
            const bf16_t* hp = P.Hin + row * DM + 16 * lane;
            const v4u h0 = *(const v4u*)hp, h1 = *(const v4u*)(hp + 8);
            float xf[16];
#pragma unroll
            for (int q = 0; q < 4; ++q) { xf[2 * q] = bflo(h0[q]); xf[2 * q + 1] = bfhi(h0[q]); xf[8 + 2 * q] = bflo(h1[q]); xf[8 + 2 * q + 1] = bfhi(h1[q]); }
            float am = 0.f;
#pragma unroll
            for (int i = 0; i < 16; ++i) am = __builtin_fmaxf(am, __builtin_fabsf(xf[i]));
            am = wave_max(am);
            const float ix = am > 0.f ? 127.f / am : 0.f;
            v4u xq;
#pragma unroll
            for (int q = 0; q < 4; ++q) { unsigned w = 0;
#pragma unroll
                for (int j = 0; j < 4; ++j) { const int v = (int)__builtin_rintf(xf[4 * q + j] * ix); w |= (unsigned)(v & 0xff) << (8 * j); }
                xq[q] = w; }
            *(v4u*)(B.xq + row * DM + 16 * lane) = xq;
            if (lane == 0) B.sx[row] = am * (1.f / 127.f);
        }
        __syncthreads();
    }
}
__device__ __forceinline__ int wave_isum(int v) {
    v += __builtin_amdgcn_update_dpp(0, v, 0xB1, 0xf, 0xf, false);
    v += __builtin_amdgcn_update_dpp(0, v, 0x4E, 0xf, 0xf, false);
    v += __builtin_amdgcn_update_dpp(0, v, 0x141, 0xf, 0xf, false);
    v += __builtin_amdgcn_update_dpp(0, v, 0x140, 0xf, 0xf, false);
    v += __builtin_amdgcn_update_dpp(0, v, 0x142, 0xa, 0xf, false);
    v += __builtin_amdgcn_update_dpp(0, v, 0x143, 0xc, 0xf, false);
    return __builtin_amdgcn_readlane(v, 63);
}
__device__ __forceinline__ int bperm_i(int v, int srclane) { return __builtin_amdgcn_ds_bpermute(srclane << 2, v); }
__device__ __forceinline__ float bperm_f(float v, int srclane) { return __builtin_bit_cast(float, __builtin_amdgcn_ds_bpermute(srclane << 2, __builtin_bit_cast(int, v))); }
__device__ __forceinline__ int treduce16(const int (&d)[16], int lane) {
    int s8[8], s4[4], s2[2];
#pragma unroll
    for (int i = 0; i < 8; ++i) { auto r = __builtin_amdgcn_permlane32_swap((unsigned)d[i], (unsigned)d[i + 8], false, false); s8[i] = (int)r[0] + (int)r[1]; }
#pragma unroll
    for (int i = 0; i < 4; ++i) { auto r = __builtin_amdgcn_permlane16_swap((unsigned)s8[i], (unsigned)s8[i + 4], false, false); s4[i] = (int)r[0] + (int)r[1]; }
    const bool b3 = (lane & 8) != 0, b2 = (lane & 4) != 0;
#pragma unroll
    for (int i = 0; i < 2; ++i) { const int keep = b3 ? s4[i + 2] : s4[i], send = b3 ? s4[i] : s4[i + 2]; s2[i] = keep + __builtin_amdgcn_update_dpp(0, send, 0x128, 0xf, 0xf, false); }
    int z; { const int keep = b2 ? s2[1] : s2[0], send = b2 ? s2[0] : s2[1]; z = keep + __builtin_amdgcn_ds_swizzle(send, 0x101F); }
    z += __builtin_amdgcn_update_dpp(0, z, 0x4E, 0xf, 0xf, false);
    z += __builtin_amdgcn_update_dpp(0, z, 0xB1, 0xf, 0xf, false);
    return z;
}
__device__ __forceinline__ void peer_u(Frame& F, const PeerArgs& P, const PeerBufs& B, int ntok) {
    const int lane = ltid(F.wave) & 63;
    const int nsl = 8, wps = (F.G / nsl) * NWAVES;
    const int j = F.vcu / (F.G / nsl), wsl = (F.vcu % (F.G / nsl)) * NWAVES + F.wave;
    const int esel = (lane >> 2) & 15;
    int t = wsl; if (t >= ntok) return;
    int e_lo = B.eid[(size_t)t * 128 + lane], e_hi = B.eid[(size_t)t * 128 + 64 + lane];
    float g_lo = B.gt[(size_t)t * 128 + lane], g_hi = B.gt[(size_t)t * 128 + 64 + lane];
    v4u xq = *(const v4u*)(B.xq + (size_t)t * DM + 16 * lane); float sx = B.sx[t];
    for (;;) {
        const int tn = t + wps; const bool more = tn < ntok; const int tp = more ? tn : t;
        const int ne_lo = B.eid[(size_t)tp * 128 + lane], ne_hi = B.eid[(size_t)tp * 128 + 64 + lane];
        const float ng_lo = B.gt[(size_t)tp * 128 + lane], ng_hi = B.gt[(size_t)tp * 128 + 64 + lane];
        const v4u nxq = *(const v4u*)(B.xq + (size_t)tp * DM + 16 * lane); const float nsx = B.sx[tp];
        unsigned long long m_lo = __ballot((e_lo >> 11) == j), m_hi = __ballot((e_hi >> 11) == j);
        const int n = __popcll(m_lo) + __popcll(m_hi);
        v4u ua[32]; int slotv0 = -1, idv0 = 0, slotv1 = -1, idv1 = 0;
#pragma unroll
        for (int q = 0; q < 32; ++q) {
            ua[q] = (v4u){0u, 0u, 0u, 0u};
            if (q < n) {
                int k, id;
                if (m_lo) { k = __builtin_ctzll(m_lo); m_lo &= m_lo - 1; id = __builtin_amdgcn_readlane(e_lo, k); }
                else { k = __builtin_ctzll(m_hi); m_hi &= m_hi - 1; id = __builtin_amdgcn_readlane(e_hi, k); k += 64; }
                ua[q] = *(const v4u*)(P.U + (size_t)id * DM + 16 * lane);
                if (q < 16) { if (esel == q) { slotv0 = k; idv0 = id; } } else { if (esel == q - 16) { slotv1 = k; idv1 = id; } }
            }
        }
        const float su0 = P.SU[idv0], sv0 = P.SV[idv0], su1 = P.SU[idv1], sv1 = P.SV[idv1];
        const float gl0 = bperm_f(g_lo, slotv0 & 63), gh0 = bperm_f(g_hi, slotv0 & 63), gl1 = bperm_f(g_lo, slotv1 & 63), gh1 = bperm_f(g_hi, slotv1 & 63);
        const float gg0 = slotv0 < 64 ? gl0 : gh0, gg1 = slotv1 < 64 ? gl1 : gh1;
        int d[16];
#pragma unroll
        for (int q = 0; q < 16; ++q) { int di = __builtin_amdgcn_sdot4((int)ua[q][0], (int)xq[0], 0, false); di = __builtin_amdgcn_sdot4((int)ua[q][1], (int)xq[1], di, false);
            di = __builtin_amdgcn_sdot4((int)ua[q][2], (int)xq[2], di, false); d[q] = __builtin_amdgcn_sdot4((int)ua[q][3], (int)xq[3], di, false); }
        { const int z = treduce16(d, lane);
          if (slotv0 >= 0 && (lane & 3) == 0) B.a[(size_t)t * 128 + slotv0] = gg0 * gelu_tanh((float)z * su0 * sx) * sv0; }
        if (n > 16) {
#pragma unroll
            for (int q = 0; q < 16; ++q) { int di = __builtin_amdgcn_sdot4((int)ua[16 + q][0], (int)xq[0], 0, false); di = __builtin_amdgcn_sdot4((int)ua[16 + q][1], (int)xq[1], di, false);
                di = __builtin_amdgcn_sdot4((int)ua[16 + q][2], (int)xq[2], di, false); d[q] = __builtin_amdgcn_sdot4((int)ua[16 + q][3], (int)xq[3], di, false); }
            const int z = treduce16(d, lane);
            if (slotv1 >= 0 && (lane & 3) == 0) B.a[(size_t)t * 128 + slotv1] = gg1 * gelu_tanh((float)z * su1 * sx) * sv1;
        }
        if (n > 32) {
            while (m_lo | m_hi) { int k, id;
                if (m_lo) { k = __builtin_ctzll(m_lo); m_lo &= m_lo - 1; id = __builtin_amdgcn_readlane(e_lo, k); }
                else { k = __builtin_ctzll(m_hi); m_hi &= m_hi - 1; id = __builtin_amdgcn_readlane(e_hi, k); k += 64; }
                const v4u u1 = *(const v4u*)(P.U + (size_t)id * DM + 16 * lane);
                int di = __builtin_amdgcn_sdot4((int)u1[0], (int)xq[0], 0, false); di = __builtin_amdgcn_sdot4((int)u1[1], (int)xq[1], di, false);
                di = __builtin_amdgcn_sdot4((int)u1[2], (int)xq[2], di, false); di = __builtin_amdgcn_sdot4((int)u1[3], (int)xq[3], di, false);
                const int tot = wave_isum(di);
                const float g = __uint_as_float(k < 64 ? __builtin_amdgcn_readlane(__float_as_uint(g_lo), k) : __builtin_amdgcn_readlane(__float_as_uint(g_hi), k - 64));
                if (lane == 0) B.a[(size_t)t * 128 + k] = g * gelu_tanh((float)tot * P.SU[id] * sx) * P.SV[id]; }
        }
        if (!more) break;
        t = tn; e_lo = ne_lo; e_hi = ne_hi; g_lo = ng_lo; g_hi = ng_hi; xq = nxq; sx = nsx;
    }
}
__device__ __forceinline__ void peer_v(Frame& F, const PeerArgs& P, const PeerBufs& B, int ntok) {
    const int lane = ltid(F.wave) & 63;
    const int nsl = 8, wps = (F.G / nsl) * NWAVES;
    const int j = F.vcu / (F.G / nsl), wsl = (F.vcu % (F.G / nsl)) * NWAVES + F.wave;
    const int grp = lane >> 3, ch = lane & 7;
    int t = wsl; if (t >= ntok) return;
#define PV_HDR(tt, EL, EH, CL, CH) do { EL = B.eid[(size_t)(tt) * 128 + lane]; EH = B.eid[(size_t)(tt) * 128 + 64 + lane]; CL = B.a[(size_t)(tt) * 128 + lane]; CH = B.a[(size_t)(tt) * 128 + 64 + lane]; } while (0)
#define PV_ROWS(W, CF, EL, EH, CL, CH) do { _Pragma("unroll") for (int i = 0; i < 16; ++i) { const int src = (8 * i + grp) & 63; const int id = bperm_i(i < 8 ? EL : EH, src); CF[i] = bperm_f(i < 8 ? CL : CH, src); \
            W[i] = *(const v4u*)(P.V + (size_t)id * DM + 128 * j + 16 * ch); } } while (0)
    int e_lo, e_hi, ne_lo, ne_hi; float c_lo, c_hi, nc_lo, nc_hi;
    v4u wA[16], wB[16]; float cfA[16], cfB[16];
    PV_HDR(t, e_lo, e_hi, c_lo, c_hi);
    { const int t1 = (t + wps < ntok) ? t + wps : t; PV_HDR(t1, ne_lo, ne_hi, nc_lo, nc_hi); }
    PV_ROWS(wA, cfA, e_lo, e_hi, c_lo, c_hi);
#define PV_STEP(W, CF, WN, CFN) do { \
        const int tn = t + wps; const bool more = tn < ntok; \
        if (more) { PV_ROWS(WN, CFN, ne_lo, ne_hi, nc_lo, nc_hi); const int t2 = (tn + wps < ntok) ? tn + wps : tn; PV_HDR(t2, ne_lo, ne_hi, nc_lo, nc_hi); } \
        float acc[16]; float asum = 0.f; \
        _Pragma("unroll") for (int c = 0; c < 16; ++c) acc[c] = 0.f; \
        _Pragma("unroll") for (int i = 0; i < 16; ++i) { asum += CF[i]; const f32x2 cf2 = {CF[i], CF[i]}; \
            _Pragma("unroll") for (int q = 0; q < 4; ++q) { const unsigned x = W[i][q]; \
                const f32x2 v01 = {(float)(x & 0xffu), (float)((x >> 8) & 0xffu)}, v23 = {(float)((x >> 16) & 0xffu), (float)(x >> 24)}; \
                f32x2 o01 = {acc[4 * q], acc[4 * q + 1]}, o23 = {acc[4 * q + 2], acc[4 * q + 3]}; \
                o01 = __builtin_elementwise_fma(cf2, v01, o01); o23 = __builtin_elementwise_fma(cf2, v23, o23); \
                acc[4 * q] = o01.x; acc[4 * q + 1] = o01.y; acc[4 * q + 2] = o23.x; acc[4 * q + 3] = o23.y; } } \
        asum += __builtin_bit_cast(float, __builtin_amdgcn_update_dpp(0, __builtin_bit_cast(int, asum), 0x128, 0xf, 0xf, false)); asum += xorf<16>(asum); asum = x32_sum(asum); \
        _Pragma("unroll") for (int c = 0; c < 16; ++c) { acc[c] += __builtin_bit_cast(float, __builtin_amdgcn_update_dpp(0, __builtin_bit_cast(int, acc[c]), 0x128, 0xf, 0xf, false)); acc[c] += xorf<16>(acc[c]); acc[c] = x32_sum(acc[c]); } \
        if (lane < 8) { \
            const int col0 = 128 * j + 16 * lane; const float* g2 = (t < SEQ) ? P.g2l : P.g2c; \
            _Pragma("unroll") for (int q = 0; q < 4; ++q) { const f32x4 xo = *(const f32x4*)(P.Xin + (size_t)t * DM + col0 + 4 * q), g = *(const f32x4*)(g2 + col0 + 4 * q); \
                f32x4 y; y.x = xo.x + g.x * (acc[4 * q] - 128.f * asum); y.y = xo.y + g.y * (acc[4 * q + 1] - 128.f * asum); y.z = xo.z + g.z * (acc[4 * q + 2] - 128.f * asum); y.w = xo.w + g.w * (acc[4 * q + 3] - 128.f * asum); \
                *(f32x4*)(P.Xout + (size_t)t * DM + col0 + 4 * q) = y; } \
        } \
        done = !more; t = tn; } while (0)
    bool done = false;
    for (;;) {
        PV_STEP(wA, cfA, wB, cfB); if (done) break;
        PV_STEP(wB, cfB, wA, cfA); if (done) break;
    }
#undef PV_HDR
#undef PV_ROWS
#undef PV_STEP
}
__device__ __forceinline__ void peer_norm(Frame& F, const PeerArgs& P, int ntok) {
    const int lane = ltid(F.wave) & 63; const int gw = F.vcu * NWAVES + F.wave, NGW = F.G * NWAVES;
    for (int t = gw; t < ntok; t += NGW) {
        const bool latent = t < SEQ;
        if (P.fout) {
            const GAS f32x4* xr = (const GAS f32x4*)(P.Xout + (size_t)t * DM) + lane; f32x4 v[4]; float s = 0.f;
#pragma unroll
            for (int q = 0; q < 4; ++q) { v[q] = xr[64 * q]; s += (v[q].x * v[q].x + v[q].y * v[q].y) + (v[q].z * v[q].z + v[q].w * v[q].w); }
            const float ri = __builtin_amdgcn_rsqf(wave_sum(s) * (1.f / DM) + EPS);
#pragma unroll
            for (int q = 0; q < 4; ++q) { const f32x4 w = *(const f32x4*)(P.fnw + 256 * q + 4 * lane); *(f32x4*)(P.fout + (size_t)t * DM + 256 * q + 4 * lane) = v[q] * ri * w; }
        } else modnorm_row(P.Xout + (size_t)t * DM, P.Hout ? P.Hout + (size_t)t * DM : (bf16_t*)nullptr, P.nwn, latent ? P.shl : P.shc, latent ? P.scl : P.scc, lane, P.H8out ? P.H8out + (size_t)t * DM : (unsigned char*)nullptr);
    }
}

constexpr int P2_Y = 0;
constexpr int P2_EID = 73728, P2_GT = P2_EID + 72 * 128 * 2, P2_SX = P2_GT + 72 * 128 * 4, P2_END = P2_SX + 72 * 4;
static_assert(P2_END <= RING_BYTES, "peer2 LDS map");
template <int NTK> __device__ __forceinline__ void peer2_tokens(Frame& F, const PeerArgs& P, int t_begin, int lt0, int cnt, int lane_in) {
    int lane = lane_in; asm volatile("" : "+v"(lane));
    const LAS unsigned short* eidL = (const LAS unsigned short*)(F.lds + P2_EID); LAS float* gtL = (LAS float*)(F.lds + P2_GT); const LAS float* sxL = (const LAS float*)(F.lds + P2_SX);
#define g (lane >> 3)
#define c (lane & 7)
    const unsigned char* xqb = P.H8out_xq;
    int d[NTK][16];
#pragma unroll
    for (int tk = 0; tk < NTK; ++tk)
#pragma unroll
        for (int i = 0; i < 16; ++i) d[tk][i] = 0;
#pragma unroll 1
    for (int ps = 0; ps < 8; ++ps) {
#pragma unroll
        for (int tk = 0; tk < NTK; ++tk) {
            if (tk < cnt) {
                const int lt = lt0 + tk; const unsigned row = (unsigned)(t_begin + lt);
                const v4u xq = *(const v4u*)(xqb + (unsigned)(row * DM + 128 * ps + 16 * c));
                v4u ua[16];
#pragma unroll
                for (int i = 0; i < 16; ++i) { const int id = eidL[lt * 128 + 8 * i + g]; ua[i] = *(const v4u*)(P.U + (unsigned)((ps * NEXP + id) * 128 + 16 * c)); }
#pragma unroll
                for (int i = 0; i < 16; ++i) { int di = __builtin_amdgcn_sdot4((int)ua[i][0], (int)xq[0], d[tk][i], false); di = __builtin_amdgcn_sdot4((int)ua[i][1], (int)xq[1], di, false);
                    di = __builtin_amdgcn_sdot4((int)ua[i][2], (int)xq[2], di, false); d[tk][i] = __builtin_amdgcn_sdot4((int)ua[i][3], (int)xq[3], di, false); }
                __builtin_amdgcn_sched_barrier(0);
            }
        }
    }
    asm volatile("" : "+v"(lane));
#pragma unroll
    for (int tk = 0; tk < NTK; ++tk) {
        if (tk < cnt) {
            const int lt = lt0 + tk; const float sx = sxL[lt];
            int mine0 = 0, mine1 = 0;
#pragma unroll
            for (int i = 0; i < 16; ++i) { int v = d[tk][i];
                v += __builtin_amdgcn_update_dpp(0, v, 0xB1, 0xf, 0xf, false); v += __builtin_amdgcn_update_dpp(0, v, 0x4E, 0xf, 0xf, false); v += __builtin_amdgcn_update_dpp(0, v, 0x141, 0xf, 0xf, false);
                if ((i & 7) == c) { if (i < 8) mine0 = v; else mine1 = v; } }
#pragma unroll
            for (int hf = 0; hf < 2; ++hf) { const int e = 8 * (8 * hf + c) + g; const int id = eidL[lt * 128 + e];
                const f32x2 suv = ((const f32x2*)P.SU)[id];
                const float pre = (float)(hf ? mine1 : mine0) * (suv.x * sx);
                gtL[lt * 128 + e] = gtL[lt * 128 + e] * gelu_tanh(pre) * suv.y; }
        }
    }
    LDS_WAIT();
    asm volatile("" : "+v"(lane));
    LAS unsigned char* yL = F.lds + P2_Y + F.wave * (4 * 2048);
#pragma unroll 1
    for (int ps = 0; ps < 8; ++ps) {
#pragma unroll
        for (int tk = 0; tk < NTK; ++tk) {
            if (tk < cnt) {
                const int lt = lt0 + tk; const unsigned row = (unsigned)(t_begin + lt);
                v4u w[16]; float cf[16];
#pragma unroll
                for (int i = 0; i < 16; ++i) { const int id = eidL[lt * 128 + 8 * i + g]; cf[i] = gtL[lt * 128 + 8 * i + g]; w[i] = *(const v4u*)(P.V + (unsigned)((ps * NEXP + id) * 128 + 16 * c)); }
                float acc[16]; float asum = 0.f;
#pragma unroll
                for (int q = 0; q < 16; ++q) acc[q] = 0.f;
#pragma unroll
                for (int i = 0; i < 16; ++i) { asum += cf[i]; const f32x2 cf2 = {cf[i], cf[i]};
#pragma unroll
                    for (int q = 0; q < 4; ++q) { const unsigned x = w[i][q];
                        const f32x2 v01 = {(float)(x & 0xffu), (float)((x >> 8) & 0xffu)}, v23 = {(float)((x >> 16) & 0xffu), (float)(x >> 24)};
                        f32x2 o01 = {acc[4 * q], acc[4 * q + 1]}, o23 = {acc[4 * q + 2], acc[4 * q + 3]};
                        o01 = __builtin_elementwise_fma(cf2, v01, o01); o23 = __builtin_elementwise_fma(cf2, v23, o23);
                        acc[4 * q] = o01.x; acc[4 * q + 1] = o01.y; acc[4 * q + 2] = o23.x; acc[4 * q + 3] = o23.y; } }
                asum += __builtin_bit_cast(float, __builtin_amdgcn_update_dpp(0, __builtin_bit_cast(int, asum), 0x128, 0xf, 0xf, false)); asum += xorf<16>(asum); asum = x32_sum(asum);
#pragma unroll
                for (int q = 0; q < 16; ++q) { acc[q] += __builtin_bit_cast(float, __builtin_amdgcn_update_dpp(0, __builtin_bit_cast(int, acc[q]), 0x128, 0xf, 0xf, false)); acc[q] += xorf<16>(acc[q]); acc[q] = x32_sum(acc[q]); }
                if (lane < 8) {
                    v4u y0, y1;
                    y0.x = pk2(acc[0] - 128.f * asum, acc[1] - 128.f * asum); y0.y = pk2(acc[2] - 128.f * asum, acc[3] - 128.f * asum); y0.z = pk2(acc[4] - 128.f * asum, acc[5] - 128.f * asum); y0.w = pk2(acc[6] - 128.f * asum, acc[7] - 128.f * asum);
                    y1.x = pk2(acc[8] - 128.f * asum, acc[9] - 128.f * asum); y1.y = pk2(acc[10] - 128.f * asum, acc[11] - 128.f * asum); y1.z = pk2(acc[12] - 128.f * asum, acc[13] - 128.f * asum); y1.w = pk2(acc[14] - 128.f * asum, acc[15] - 128.f * asum);
                    LAS v4u* yp = (LAS v4u*)(yL + tk * 2048 + (128 * ps + 16 * lane) * 2); yp[0] = y0; yp[1] = y1;
                }
                __builtin_amdgcn_sched_barrier(0);
            }
        }
    }
    asm volatile("" : "+v"(lane));
    LDS_WAIT();
#pragma unroll
    for (int tk = 0; tk < NTK; ++tk) {
        if (tk < cnt) {
            const int lt = lt0 + tk; const unsigned row = (unsigned)(t_begin + lt); const bool latent = row < (unsigned)SEQ;
            const float* g2 = latent ? P.g2l : P.g2c;
            f32x4 xn[4]; float ss = 0.f;
#pragma unroll
            for (int q = 0; q < 4; ++q) { const unsigned col = 256 * q + 4 * lane; const f32x4 xo = __builtin_nontemporal_load((const f32x4*)(P.Xin + (unsigned)(row * DM + col))), gq = *(const f32x4*)(g2 + col);
                const v2u yy = *(const LAS v2u*)(yL + tk * 2048 + col * 2);
                f32x4 y; y.x = xo.x + gq.x * bflo(yy.x); y.y = xo.y + gq.y * bfhi(yy.x); y.z = xo.z + gq.z * bflo(yy.y); y.w = xo.w + gq.w * bfhi(yy.y);
                xn[q] = y; ss += (y.x * y.x + y.y * y.y) + (y.z * y.z + y.w * y.w); }
            const float ri = __builtin_amdgcn_rsqf(wave_sum(ss) * (1.f / DM) + EPS);
            if (P.fout) {
                if (latent) {
#pragma unroll
                    for (int q = 0; q < 4; ++q) { const unsigned col = 256 * q + 4 * lane; const f32x4 wq_ = *(const f32x4*)(P.fnw + col); __builtin_nontemporal_store(xn[q] * ri * wq_, (f32x4*)(P.fout + (unsigned)(row * DM + col))); }
                }
            } else {
                const float* sh = latent ? P.shl : P.shc; const float* sc = latent ? P.scl : P.scc;
#pragma unroll
                for (int q = 0; q < 4; ++q) { const unsigned col = 256 * q + 4 * lane; const f32x4 wn = *(const f32x4*)(P.nwn + col), a = *(const f32x4*)(sc + col), b = *(const f32x4*)(sh + col);
                    __builtin_nontemporal_store(xn[q], (f32x4*)(P.Xout + (unsigned)(row * DM + col)));
                    const f32x4 y = (xn[q] * ri * wn) * (1.0f + a) + b;
                    if (P.Hout) { v2u pk; pk.x = pk2(y.x, y.y); pk.y = pk2(y.z, y.w); *(v2u*)(P.Hout + (unsigned)(row * DM + col)) = pk; }
                    if (P.H8out) *(unsigned*)(P.H8out + (unsigned)(row * DM + col)) = pk4_fp8(y.x, y.y, y.z, y.w); }
            }
        }
    }
}
#undef g
#undef c
__device__ __forceinline__ void peer_phase2(Frame& F, const PeerArgs& P) {
    const int tid = ltid(F.wave), lane = tid & 63;
    LAS unsigned* lists = (LAS unsigned*)(F.lds + PL_LISTS);
    LAS int* eid = (LAS int*)(F.lds + PL_EID);
    LAS float* gt = (LAS float*)(F.lds + PL_GT);
    LAS unsigned short* eidL = (LAS unsigned short*)(F.lds + P2_EID); LAS float* gtL = (LAS float*)(F.lds + P2_GT); LAS float* sxL = (LAS float*)(F.lds + P2_SX);
    const int ntok = P.nblocks * 32, tpc = (ntok + F.G - 1) / F.G, t_begin = F.vcu * tpc, t_end = (t_begin + tpc < ntok) ? t_begin + tpc : ntok;
    if (t_begin >= t_end) return;
    for (int row0 = t_begin; row0 < t_end; row0 += 32) {
        const int nt = (t_end - row0 < 32) ? t_end - row0 : 32;
        for (int rr = 0; rr < P.route_reps; ++rr) {
        if (rr) __syncthreads();
        {
            const int tok = tid >> 4, lst = tid & 15;
            const bf16_t* sp = (const bf16_t*)P.S + (size_t)(row0 + (tok < nt ? tok : nt - 1)) * 2048 + lst * 128;
            float top[16];
            v4u nv[2];
#pragma unroll
            for (int q = 0; q < 2; ++q) nv[q] = *(const v4u*)(sp + q * 8);
#pragma unroll 1
            for (int c = 0; c < 8; ++c) {
                float x[16];
#pragma unroll
                for (int e = 0; e < 16; ++e) { const unsigned w = nv[e >> 3][(e >> 1) & 3];
                    x[e] = __uint_as_float(((e & 1) ? (w & 0xffff0000u) : (w << 16)) | (unsigned)(c * 16 + e)); }
                if (c < 7) {
#pragma unroll
                    for (int q = 0; q < 2; ++q) nv[q] = *(const v4u*)(sp + (c + 1) * 16 + q * 8);
                }
                sort16_desc(x);
                if (c == 0) {
#pragma unroll
                    for (int i = 0; i < 16; ++i) top[i] = x[i];
                } else merge16_desc(top, x);
            }
            LAS unsigned* lp = lists + tid * 20;
#pragma unroll
            for (int q = 0; q < 4; ++q) *(LAS v4u*)(lp + q * 4) = (v4u){__float_as_uint(top[q * 4]), __float_as_uint(top[q * 4 + 1]), __float_as_uint(top[q * 4 + 2]), __float_as_uint(top[q * 4 + 3])};
        }
        __syncthreads();
        if (tid < 256) {
            const int tok = tid >> 3, hd = tid & 7;
            const LAS unsigned* la = lists + (tok * 16 + 2 * hd) * 20; const LAS unsigned* lb = la + 20;
            float av[16], bv[16];
#pragma unroll
            for (int q = 0; q < 4; ++q) { const v4u a = *(const LAS v4u*)(la + q * 4), b = *(const LAS v4u*)(lb + q * 4);
#pragma unroll
                for (int j = 0; j < 4; ++j) { av[q * 4 + j] = __uint_as_float(a[j] & ~127u); bv[q * 4 + j] = __uint_as_float(b[j] & ~127u); } }
            float c0[16], c1[16], c2[16], c3[16];
#pragma unroll
            for (int i = 0; i < 16; ++i) { c0[i] = -INFINITY; c1[i] = -INFINITY; c2[i] = -INFINITY; c3[i] = -INFINITY; }
            {
                int cnt = 0;
#pragma unroll
                for (int i = 0; i < 16; ++i)
#pragma unroll
                    for (int j = 0; j < 16; ++j) if ((i + 1) * (j + 1) <= 16) {
                        const float sm = __uint_as_float((__float_as_uint(av[i] + bv[j]) & ~255u) | (unsigned)(i * 16 + j));
                        const int slot = cnt & 15, arr = cnt >> 4;
                        if (arr == 0) c0[slot] = sm; else if (arr == 1) c1[slot] = sm; else if (arr == 2) c2[slot] = sm; else c3[slot] = sm;
                        ++cnt;
                    }
            }
            sort16_desc(c0); sort16_desc(c1); sort16_desc(c2); sort16_desc(c3);
            merge16_desc(c0, c1); merge16_desc(c0, c2); merge16_desc(c0, c3);
            float ev[16], sum = 0.f; const float m0 = __uint_as_float(__float_as_uint(c0[0]) & ~255u);
#pragma unroll
            for (int k = 0; k < 16; ++k) { ev[k] = fast_exp2((__uint_as_float(__float_as_uint(c0[k]) & ~255u) - m0) * LOG2E); sum += ev[k]; }
            const float rs = 1.0f / sum;
#pragma unroll
            for (int k = 0; k < 16; ++k) { const unsigned code = __float_as_uint(c0[k]) & 255u;
                const int ia = (int)(la[code >> 4] & 127u), ib = (int)(lb[code & 15u] & 127u);
                eid[tok * 128 + hd * 16 + k] = ia * NKEYS + ib; gt[tok * 128 + hd * 16 + k] = ev[k] * rs;
#if SELFCHECK
                if (tok < nt) { P.dbg_eid[(size_t)(row0 + tok) * 128 + hd * 16 + k] = ia * NKEYS + ib; P.dbg_gt[(size_t)(row0 + tok) * 128 + hd * 16 + k] = ev[k] * rs; }
#endif
            }
        }
        }
        __syncthreads();
        { const int lb = row0 - t_begin;
#pragma unroll
          for (int i = 0; i < 8; ++i) { const int idx = i * NTHREADS + tid; if ((idx >> 7) < nt) { eidL[lb * 128 + idx] = (unsigned short)eid[idx]; gtL[lb * 128 + idx] = gt[idx]; } }
#pragma unroll 1
          for (int tk = 0; tk < 4; ++tk) { const int tok = F.wave * 4 + tk; if (tok >= nt) break;
            const size_t row = (size_t)(row0 + tok);
            const bf16_t* hp = P.Hin + row * DM + 16 * lane;
            const v4u h0 = *(const v4u*)hp, h1 = *(const v4u*)(hp + 8);
            float xf[16];
#pragma unroll
            for (int q = 0; q < 4; ++q) { xf[2 * q] = bflo(h0[q]); xf[2 * q + 1] = bfhi(h0[q]); xf[8 + 2 * q] = bflo(h1[q]); xf[8 + 2 * q + 1] = bfhi(h1[q]); }
            float am = 0.f;
#pragma unroll
            for (int i = 0; i < 16; ++i) am = __builtin_fmaxf(am, __builtin_fabsf(xf[i]));
            am = wave_max(am);
            const float ix = am > 0.f ? 127.f / am : 0.f;
            v4u xq;
#pragma unroll
            for (int q = 0; q < 4; ++q) { unsigned w = 0;
#pragma unroll
                for (int j = 0; j < 4; ++j) { const int v = (int)__builtin_rintf(xf[4 * q + j] * ix); w |= (unsigned)(v & 0xff) << (8 * j); }
                xq[q] = w; }
            *(v4u*)(P.H8out_xq + row * DM + 16 * lane) = xq;
            if (lane == 0) sxL[lb + tok] = am * (1.f / 127.f); }
        }
        __syncthreads();
    }
    asm volatile("s_waitcnt vmcnt(0)" ::: "memory"); __syncthreads();
    const int ntot = t_end - t_begin;
#pragma unroll 1
    for (int gi = 0; gi < 2; ++gi) { const int lt0 = F.wave * 4 + 32 * gi; int cnt = ntot - lt0; cnt = cnt < 0 ? 0 : (cnt > 4 ? 4 : cnt); if (cnt > 0) peer2_tokens<4>(F, P, t_begin, lt0, cnt, lane); }
    if (ntot > 64 && F.wave == 0) peer2_tokens<1>(F, P, t_begin, 64, 1, lane);
}

__device__ __forceinline__ void peer_phase(Frame& F, const PeerArgs& P) {
    const int tid = ltid(F.wave), lane = tid & 63;
    LAS unsigned* lists = (LAS unsigned*)(F.lds + PL_LISTS);
    LAS int* eid = (LAS int*)(F.lds + PL_EID);
    LAS float* gt = (LAS float*)(F.lds + PL_GT);
    const int ntok = P.nblocks * 32, tpc = (ntok + F.G - 1) / F.G, t_begin = F.vcu * tpc, t_end = (t_begin + tpc < ntok) ? t_begin + tpc : ntok;
    for (int row0 = t_begin; row0 < t_end; row0 += 32) {
        const int nt = (t_end - row0 < 32) ? t_end - row0 : 32;
        for (int rr = 0; rr < P.route_reps; ++rr) {
        if (rr) __syncthreads();
        {
            const int tok = tid >> 4, lst = tid & 15;
            const bf16_t* sp = (const bf16_t*)P.S + (size_t)(row0 + (tok < nt ? tok : nt - 1)) * 2048 + lst * 128;
            float top[16];
            v4u nv[2];
#pragma unroll
            for (int q = 0; q < 2; ++q) nv[q] = *(const v4u*)(sp + q * 8);
#pragma unroll 1
            for (int c = 0; c < 8; ++c) {
                float x[16];
#pragma unroll
                for (int e = 0; e < 16; ++e) { const unsigned w = nv[e >> 3][(e >> 1) & 3];
                    x[e] = __uint_as_float(((e & 1) ? (w & 0xffff0000u) : (w << 16)) | (unsigned)(c * 16 + e)); }
                if (c < 7) {
#pragma unroll
                    for (int q = 0; q < 2; ++q) nv[q] = *(const v4u*)(sp + (c + 1) * 16 + q * 8);
                }
                sort16_desc(x);
                if (c == 0) {
#pragma unroll
                    for (int i = 0; i < 16; ++i) top[i] = x[i];
                } else merge16_desc(top, x);
            }
            LAS unsigned* lp = lists + tid * 20;
#pragma unroll
            for (int q = 0; q < 4; ++q) *(LAS v4u*)(lp + q * 4) = (v4u){__float_as_uint(top[q * 4]), __float_as_uint(top[q * 4 + 1]), __float_as_uint(top[q * 4 + 2]), __float_as_uint(top[q * 4 + 3])};
        }
        __syncthreads();
        if (tid < 256) {
            const int tok = tid >> 3, hd = tid & 7;
            const LAS unsigned* la = lists + (tok * 16 + 2 * hd) * 20; const LAS unsigned* lb = la + 20;
            float av[16], bv[16];
#pragma unroll
            for (int q = 0; q < 4; ++q) { const v4u a = *(const LAS v4u*)(la + q * 4), b = *(const LAS v4u*)(lb + q * 4);
#pragma unroll
                for (int j = 0; j < 4; ++j) { av[q * 4 + j] = __uint_as_float(a[j] & ~127u); bv[q * 4 + j] = __uint_as_float(b[j] & ~127u); } }
            float c0[16], c1[16], c2[16], c3[16];
#pragma unroll
            for (int i = 0; i < 16; ++i) { c0[i] = -INFINITY; c1[i] = -INFINITY; c2[i] = -INFINITY; c3[i] = -INFINITY; }
            {
                int cnt = 0;
#pragma unroll
                for (int i = 0; i < 16; ++i)
#pragma unroll
                    for (int j = 0; j < 16; ++j) if ((i + 1) * (j + 1) <= 16) {
                        const float sm = __uint_as_float((__float_as_uint(av[i] + bv[j]) & ~255u) | (unsigned)(i * 16 + j));
                        const int slot = cnt & 15, arr = cnt >> 4;
                        if (arr == 0) c0[slot] = sm; else if (arr == 1) c1[slot] = sm; else if (arr == 2) c2[slot] = sm; else c3[slot] = sm;
                        ++cnt;
                    }
            }
            sort16_desc(c0); sort16_desc(c1); sort16_desc(c2); sort16_desc(c3);
            merge16_desc(c0, c1); merge16_desc(c0, c2); merge16_desc(c0, c3);
            float ev[16], sum = 0.f; const float m0 = __uint_as_float(__float_as_uint(c0[0]) & ~255u);
#pragma unroll
            for (int k = 0; k < 16; ++k) { ev[k] = fast_exp2((__uint_as_float(__float_as_uint(c0[k]) & ~255u) - m0) * LOG2E); sum += ev[k]; }
            const float rs = 1.0f / sum;
#pragma unroll
            for (int k = 0; k < 16; ++k) { const unsigned code = __float_as_uint(c0[k]) & 255u;
                const int ia = (int)(la[code >> 4] & 127u), ib = (int)(lb[code & 15u] & 127u);
                eid[tok * 128 + hd * 16 + k] = ia * NKEYS + ib; gt[tok * 128 + hd * 16 + k] = ev[k] * rs;
#if SELFCHECK
                if (tok < nt) { P.dbg_eid[(size_t)(row0 + tok) * 128 + hd * 16 + k] = ia * NKEYS + ib; P.dbg_gt[(size_t)(row0 + tok) * 128 + hd * 16 + k] = ev[k] * rs; }
#endif
            }
        }
        }
        __syncthreads();
#pragma unroll 1
        for (int tk = 0; tk < 4; ++tk) {
            const int tok = F.wave * 4 + tk; if (tok >= nt) break;
            const size_t row = (size_t)(row0 + tok);
            const bool latent = row < (size_t)SEQ;
            const bf16_t* hp = P.Hin + row * DM + 16 * lane;
            const v4u h0 = *(const v4u*)hp, h1 = *(const v4u*)(hp + 8);
            float xf[16];
#pragma unroll
            for (int q = 0; q < 4; ++q) { xf[2 * q] = bflo(h0[q]); xf[2 * q + 1] = bfhi(h0[q]); xf[8 + 2 * q] = bflo(h1[q]); xf[8 + 2 * q + 1] = bfhi(h1[q]); }
            float am = 0.f;
#pragma unroll
            for (int i = 0; i < 16; ++i) am = __builtin_fmaxf(am, __builtin_fabsf(xf[i]));
            am = wave_max(am);
            const float sx = am * (1.f / 127.f), ix = am > 0.f ? 127.f / am : 0.f;
            int xq[4];
#pragma unroll
            for (int q = 0; q < 4; ++q) { int w = 0;
#pragma unroll
                for (int j = 0; j < 4; ++j) { const int v = (int)__builtin_rintf(xf[4 * q + j] * ix); w |= (v & 0xff) << (8 * j); }
                xq[q] = w; }
            float out[16]; float asum = 0.f;
#pragma unroll
            for (int i = 0; i < 16; ++i) out[i] = 0.f;
            const int esel = (lane >> 2) & 15;
#pragma unroll 1
            for (int e0 = 0; e0 < 128; e0 += 16) {
                v4u ua[16], va[16];
#pragma unroll
                for (int k = 0; k < 16; ++k) { const int id = __builtin_amdgcn_readfirstlane(eid[tok * 128 + e0 + k]);
                    ua[k] = *(const v4u*)(P.U + (unsigned)(((lane >> 3) * NEXP + id) * 128 + 16 * (lane & 7))); va[k] = *(const v4u*)(P.V + (unsigned)(((lane >> 3) * NEXP + id) * 128 + 16 * (lane & 7))); }
                const int myid = eid[tok * 128 + e0 + esel]; const float mysu = P.SU[myid], mysv = P.SV[myid], myg = gt[tok * 128 + e0 + esel];
                int d[16];
#pragma unroll
                for (int k = 0; k < 16; ++k) { int di = __builtin_amdgcn_sdot4((int)ua[k][0], xq[0], 0, false); di = __builtin_amdgcn_sdot4((int)ua[k][1], xq[1], di, false);
                    di = __builtin_amdgcn_sdot4((int)ua[k][2], xq[2], di, false); d[k] = __builtin_amdgcn_sdot4((int)ua[k][3], xq[3], di, false); }
                int s8[8], s4[4], s2[2];
#pragma unroll
                for (int i = 0; i < 8; ++i) { auto r = __builtin_amdgcn_permlane32_swap((unsigned)d[i], (unsigned)d[i + 8], false, false); s8[i] = (int)r[0] + (int)r[1]; }
#pragma unroll
                for (int i = 0; i < 4; ++i) { auto r = __builtin_amdgcn_permlane16_swap((unsigned)s8[i], (unsigned)s8[i + 4], false, false); s4[i] = (int)r[0] + (int)r[1]; }
                const bool b3 = (lane & 8) != 0, b2 = (lane & 4) != 0;
#pragma unroll
                for (int i = 0; i < 2; ++i) { const int keep = b3 ? s4[i + 2] : s4[i], send = b3 ? s4[i] : s4[i + 2]; s2[i] = keep + __builtin_amdgcn_update_dpp(0, send, 0x128, 0xf, 0xf, false); }
                int z; { const int keep = b2 ? s2[1] : s2[0], send = b2 ? s2[0] : s2[1]; z = keep + __builtin_amdgcn_ds_swizzle(send, 0x101F); }
                z += __builtin_amdgcn_update_dpp(0, z, 0x4E, 0xf, 0xf, false);
                z += __builtin_amdgcn_update_dpp(0, z, 0xB1, 0xf, 0xf, false);
                const float pre = (float)z * (mysu * sx);
                const float act = myg * gelu_tanh(pre);
#if SELFCHECK
                if ((lane & 3) == 0) P.dbg_gt[(size_t)9 * MiB / 4 + row * 128 + e0 + esel] = gelu_tanh(pre);
#endif
                const float cfl = act * mysv;
#pragma unroll
                for (int k = 0; k < 16; ++k) {
                    const float cf = __uint_as_float(__builtin_amdgcn_readlane(__float_as_uint(cfl), 4 * k));
                    asum += cf;
                    const f32x2 cf2 = {cf, cf};
#pragma unroll
                    for (int q = 0; q < 4; ++q) { const unsigned w = va[k][q];
                        const f32x2 v01 = {(float)(w & 0xffu), (float)((w >> 8) & 0xffu)}, v23 = {(float)((w >> 16) & 0xffu), (float)(w >> 24)};
                        f32x2 o01 = {out[4 * q], out[4 * q + 1]}, o23 = {out[4 * q + 2], out[4 * q + 3]};
                        o01 = __builtin_elementwise_fma(cf2, v01, o01); o23 = __builtin_elementwise_fma(cf2, v23, o23);
                        out[4 * q] = o01.x; out[4 * q + 1] = o01.y; out[4 * q + 2] = o23.x; out[4 * q + 3] = o23.y; }
                }
            }
#pragma unroll
            for (int i = 0; i < 16; ++i) out[i] -= 128.f * asum;
            const float* g2 = latent ? P.g2l : P.g2c;
            float xn[16]; float ss = 0.f;
#pragma unroll
            for (int q = 0; q < 4; ++q) { const int col = 16 * lane + 4 * q; const f32x4 xo = *(const f32x4*)(P.Xin + row * DM + col), g = *(const f32x4*)(g2 + col);
#pragma unroll
                for (int j = 0; j < 4; ++j) { const float v = xo[j] + g[j] * out[4 * q + j]; xn[4 * q + j] = v; ss += v * v; } }
            const float ri = __builtin_amdgcn_rsqf(wave_sum(ss) * (1.f / DM) + EPS);
            if (P.dry) {
                if (ri == 12345.678f) P.Xout[row * DM] = ri;
            } else if (P.fout) {
                if (latent) {
#pragma unroll
                    for (int q = 0; q < 4; ++q) { const int col = 16 * lane + 4 * q; const f32x4 w = *(const f32x4*)(P.fnw + col);
                        f32x4 y; y.x = xn[4 * q] * ri * w.x; y.y = xn[4 * q + 1] * ri * w.y; y.z = xn[4 * q + 2] * ri * w.z; y.w = xn[4 * q + 3] * ri * w.w;
                        *(f32x4*)(P.fout + row * DM + col) = y; }
                }
            } else {
                const float* sh = latent ? P.shl : P.shc; const float* sc = latent ? P.scl : P.scc;
                unsigned hw[8], h8[4];
#pragma unroll
                for (int q = 0; q < 4; ++q) { const int col = 16 * lane + 4 * q;
                    *(f32x4*)(P.Xout + row * DM + col) = (f32x4){xn[4 * q], xn[4 * q + 1], xn[4 * q + 2], xn[4 * q + 3]};
                    const f32x4 w = *(const f32x4*)(P.nwn + col), a = *(const f32x4*)(sc + col), b = *(const f32x4*)(sh + col);
                    float y[4];
#pragma unroll
                    for (int j = 0; j < 4; ++j) y[j] = (xn[4 * q + j] * ri * w[j]) * (1.0f + a[j]) + b[j];
                    hw[2 * q] = pk2(y[0], y[1]); hw[2 * q + 1] = pk2(y[2], y[3]); h8[q] = pk4_fp8(y[0], y[1], y[2], y[3]); }
                if (P.Hout) { *(v4u*)(P.Hout + row * DM + 16 * lane) = (v4u){hw[0], hw[1], hw[2], hw[3]};
                    *(v4u*)(P.Hout + row * DM + 16 * lane + 8) = (v4u){hw[4], hw[5], hw[6], hw[7]}; }
                if (P.H8out) *(v4u*)(P.H8out + row * DM + 16 * lane) = (v4u){h8[0], h8[1], h8[2], h8[3]};
            }
        }
        __syncthreads();
    }
}
__device__ __forceinline__ float lam_init_of(int l) { return l == 0 ? 0.2f : 0.35550906765f; }

#ifndef PHASE_MASK
#define PHASE_MASK 0xffff
#endif
#define PH(n) ((PHASE_MASK >> (n)) & 1)
#define REPS(n) (1 + ((dupmask >> (n)) & 1))
__global__ void __launch_bounds__(NTHREADS, 2) trunk_fwd(Args args) {
    extern __shared__ __attribute__((aligned(16))) unsigned char lds[];
    Frame F;
    F.lds = (LAS unsigned char*)lds;
    F.MISC = (volatile LAS unsigned*)(F.lds + MISC_OFF);
    F.wave = __builtin_amdgcn_readfirstlane((int)threadIdx.x >> 6);
    F.G = gridDim.x; { const int bx = blockIdx.x; F.vcu = (F.G % 8 == 0) ? (bx % 8) * (F.G / 8) + bx / 8 : bx; }
    unsigned char* ws = args.ws;
    F.ctl = (gu32*)(ws + WS_CTL);
    for (int u = ltid(F.wave); u < (LDS_BYTES - LDSCTL_OFF) / 4; u += NTHREADS) ((LAS unsigned*)(F.lds + LDSCTL_OFF))[u] = 0u;
    __syncthreads();
    XcdBarrier bar = xcd_barrier_post((unsigned*)(F.ctl + CW_BAR), F.MISC + 8, F.wave);
#ifndef TIMING
#define TIMING 0
#endif
#if TIMING
    int n_stamp = 0;
#define STAMP() do { if (blockIdx.x == 0 && tid_now(F.wave) == 0) ((unsigned long long*)(F.ctl + 1024))[n_stamp] = __builtin_amdgcn_s_memrealtime(); ++n_stamp; } while (0)
#else
#define STAMP() do {} while (0)
#endif
#define GRID_BAR() do { xcd_barrier(bar); STAMP(); asm volatile("" : "+s"(ws)); } while (0)
    STAMP();

    const float* const* in = args.in;
    const int dupmask = args.flags;
#define modv ((float*)(ws + WS_CONST))
#define lamv (modv + 2 * 2 * 6144)
#define WIN ((bf16_t*)(ws + WS_WIN))
#define WGATE ((bf16_t*)(ws + WS_WGATE))
#define WBR ((bf16_t*)(ws + WS_WBR))
#define WOUT ((bf16_t*)(ws + WS_WOUT))
#define WSC ((bf16_t*)(ws + WS_WSC))
#define X ((float*)(ws + WS_X))
#define H ((bf16_t*)(ws + WS_H))
#define YS ((bf16_t*)(ws + WS_YS))
#define MIX YS
#define Qb ((bf16_t*)(ws + WS_Q))
#define Kb ((bf16_t*)(ws + WS_K))
#define Vb ((bf16_t*)(ws + WS_V))
#define BP ((bf16_t*)(ws + WS_R1))
#define SB ((float*)(ws + WS_R1))
    const int gw = F.vcu * NWAVES + F.wave, NGW = F.G * NWAVES;

    for (int rep = 0; rep < REPS(0); ++rep) {
        const int tid = ltid(F.wave), lane = tid & 63;
        LAS float* scr = (LAS float*)(F.lds + F.wave * 16384);
        for (int un = F.vcu; un < 2 * 128; un += F.G) {
            const int l = un >> 7, col = (un & 127) * 48 + lane; const bool act = lane < 48;
            const float* W = in[I_ADAW] + (size_t)l * DM * 6144;
            float a0 = 0.f, a1 = 0.f;
            if (act) {
#pragma unroll 16
                for (int k = 128 * F.wave; k < 128 * F.wave + 128; ++k) { const float w = W[(size_t)k * 6144 + col]; const float c0 = in[I_C][k], c1 = in[I_CCTX][k];
                    a0 += c0 * sigmoidf_(c0) * w; a1 += c1 * sigmoidf_(c1) * w; }
            }
            LAS float* red = (LAS float*)(F.lds);
            red[(F.wave * 64 + lane) * 2] = a0; red[(F.wave * 64 + lane) * 2 + 1] = a1;
            __syncthreads();
            if (F.wave == 0 && act) { float s0 = in[I_ADAB][l * 6144 + col], s1 = s0;
#pragma unroll
                for (int w = 0; w < 8; ++w) { s0 += red[(w * 64 + lane) * 2]; s1 += red[(w * 64 + lane) * 2 + 1]; }
                modv[(l * 2 + 0) * 6144 + col] = s0; modv[(l * 2 + 1) * 6144 + col] = s1; }
            __syncthreads();
        }
        if (blockIdx.x == 0 && tid < 2) { const float* lf = in[I_DLAM] + tid * 128; float s0 = 0.f, s1 = 0.f;
            for (int i = 0; i < 32; ++i) { s0 += lf[i] * lf[32 + i]; s1 += lf[64 + i] * lf[96 + i]; }
            lamv[tid] = expf(s0) - expf(s1) + lam_init_of(tid); }
        constexpr int I_IN = 16 * 80, I_GT = 16 * 128, I_BR = 4 * 32, I_OT = 16 * 32;
        constexpr int NITEMS = 2 * I_IN + 2 * I_GT + 8 * I_BR + 2 * I_OT;
        unsigned char* W8IN = ws + WS_W8IN; unsigned char* W8GATE = ws + WS_W8GATE;
        for (int it = gw; it < NITEMS; it += NGW) {
            int r = it;
            if (r < 2 * I_IN) { const int l = r / I_IN; transpose_item<MapWin, true>(in[I_WIN] + (size_t)l * DM * NQKV, DM, NQKV, W8IN + (size_t)l * NQKV * DM, MapWin(), scr, r % I_IN, lane); continue; } r -= 2 * I_IN;
            if (r < 2 * I_GT) { const int l = r / I_GT; transpose_item<MapGate, true>(in[I_WGATE] + (size_t)l * DM * 4096, DM, 4096, W8GATE + (size_t)l * 4096 * DM, MapGate(), scr, r % I_GT, lane); continue; } r -= 2 * I_GT;
            if (r < 8 * I_BR) { const int lb = r / I_BR; transpose_item(in[I_WBR] + (size_t)lb * 256 * DM, 256, DM, WBR + (size_t)lb * DM * 256, MapId(), scr, r % I_BR, lane); continue; } r -= 8 * I_BR;
#if MIX8
            { const int l = r / I_OT; transpose_item<MapId, true>(in[I_WOUT] + (size_t)l * DM * DM, DM, DM, ws + WS_W8OUT + (size_t)l * DM * DM, MapId(), scr, r % I_OT, lane); }
#else
            { const int l = r / I_OT; transpose_item(in[I_WOUT] + (size_t)l * DM * DM, DM, DM, WOUT + (size_t)l * DM * DM, MapId(), scr, r % I_OT, lane); }
#endif
        }
        for (int it = gw; it < 2 * 16 * 8 * 64; it += NGW) {
            const int kt = it & 63, nt = (it >> 6) & 7, g = (it >> 9) & 15, l = it >> 13, h = g >> 1, p = g & 1;
            const float* kp = in[I_PKEYS] + ((size_t)((l * 2 + p) * 8 + h) * 128 + nt * 16 + (lane & 15)) * 128 + (lane >> 4);
            const float* qp = in[I_PWQ] + ((size_t)l * DM + kt * 16 + (lane & 15)) * 2048 + g * 128 + (lane >> 4);
            f32x4 acc = {0.f, 0.f, 0.f, 0.f};
            float ka[32], qa[32];
#pragma unroll
            for (int s = 0; s < 32; ++s) { ka[s] = kp[4 * s]; qa[s] = qp[4 * s]; }
            __builtin_amdgcn_sched_barrier(0);
#pragma unroll
            for (int s = 0; s < 32; ++s) acc = __builtin_amdgcn_mfma_f32_16x16x4f32(ka[s], qa[s], acc, 0, 0, 0);
            bf16_t* op = WSC + ((size_t)l * 2048 + g * 128 + nt * 16 + 4 * (lane >> 4)) * DM + kt * 16 + (lane & 15);
#pragma unroll
            for (int r = 0; r < 4; ++r) op[(size_t)r * DM] = (bf16_t)f2bf(acc[r]);
        }
        {
            unsigned char* UQ = (unsigned char*)(ws + WS_UBF); unsigned char* VQ = (unsigned char*)(ws + WS_VBF); float* SU = (float*)(ws + WS_SU); float* SV = (float*)(ws + WS_SV);
            for (int r0 = gw; r0 < 2 * 2 * NEXP; r0 += 4 * NGW) {
                f32x4 v[4][4];
#pragma unroll
                for (int u4 = 0; u4 < 4; ++u4) { const int r = r0 + u4 * NGW; const bool isv = r >= 2 * NEXP; const int rr = isv ? r - 2 * NEXP : r;
                    const float* src = (isv ? in[I_PV] : in[I_PU]) + (size_t)rr * DM + 16 * lane;
#pragma unroll
                    for (int q = 0; q < 4; ++q) v[u4][q] = *(const f32x4*)(src + 4 * q); }
#pragma unroll
                for (int u4 = 0; u4 < 4; ++u4) { const int r = r0 + u4 * NGW; const bool isv = r >= 2 * NEXP; const int rr = isv ? r - 2 * NEXP : r;
                    float am = 0.f;
#pragma unroll
                    for (int q = 0; q < 4; ++q) am = __builtin_fmaxf(am, __builtin_fmaxf(__builtin_fmaxf(__builtin_fabsf(v[u4][q].x), __builtin_fabsf(v[u4][q].y)), __builtin_fmaxf(__builtin_fabsf(v[u4][q].z), __builtin_fabsf(v[u4][q].w))));
                    am = wave_max(am);
                    const float inv = am > 0.f ? 127.f / am : 0.f; const int off = isv ? 128 : 0;
                    v4u w;
#pragma unroll
                    for (int q = 0; q < 4; ++q) { const int a0 = (int)__builtin_rintf(v[u4][q].x * inv) + off, a1 = (int)__builtin_rintf(v[u4][q].y * inv) + off, a2 = (int)__builtin_rintf(v[u4][q].z * inv) + off, a3 = (int)__builtin_rintf(v[u4][q].w * inv) + off;
                        w[q] = (unsigned)(a0 & 0xff) | ((unsigned)(a1 & 0xff) << 8) | ((unsigned)(a2 & 0xff) << 16) | ((unsigned)(a3 & 0xff) << 24); }
                    { const int lyr = rr >> 14, ex = rr & (NEXP - 1);
                      *(v4u*)((isv ? VQ : UQ) + (size_t)lyr * NEXP * DM + (size_t)(((lane >> 3) * NEXP + ex) * 128 + 16 * (lane & 7))) = w; }
                    if (lane == 0) SU[2 * rr + (isv ? 1 : 0)] = am * (1.f / 127.f); }
            }
        }
    }
#if SELFCHECK
    GRID_BAR();
#define CK_RED ((LAS float*)(F.lds))
#define CK_BUF ((LAS float*)(F.lds + 1024))
#define CK_IBUF ((LAS int*)(F.lds + 8192))
#define CK_OBUF ((LAS float*)(F.lds + 20480))
#define CK_SC ((LAS float*)(F.lds + 24576))
    if (blockIdx.x == 0) chk::ck_prologue(in, ws, F.ctl, CK_RED);
    __syncthreads();
#endif
    GRID_BAR();
    { const int lane = ltid(F.wave) & 63;
    for (int m = gw; m < MT; m += NGW) {
        const bool lat = m < SEQ; const float* xr = lat ? in[I_X] + (size_t)m * DM : in[I_CTX] + (size_t)(m - SEQ) * DM; const float* mv = modv + (lat ? 0 : 6144);
        modnorm_row(xr, SELFCHECK ? H + (size_t)m * DM : (bf16_t*)nullptr, in[I_N1W], mv, mv + 1024, lane, ws + WS_H8 + (size_t)m * DM);
    } }
    GRID_BAR();
#if SELFCHECK
    if (blockIdx.x < 5) { const int r = blockIdx.x == 0 ? 0 : blockIdx.x == 1 ? 777 : blockIdx.x == 2 ? 16383 : blockIdx.x == 3 ? 16384 : 16639;
        const bool lat = r < SEQ; const float* mv = modv + (lat ? 0 : 6144);
        chk::ck_modnorm(lat ? in[I_X] + (size_t)r * DM : in[I_CTX] + (size_t)(r - SEQ) * DM, H + (size_t)r * DM, in[I_N1W], mv, mv + 1024, F.ctl, 2, CK_RED); }
    GRID_BAR();
#endif

#pragma unroll 1
    for (int l = 0; l < 2; ++l) {
#define modl (modv + (size_t)(l * 2) * 6144)
#define modc (modl + 6144)
        const int nMr = (l == 0) ? MT / 256 : SEQ / 256;
        for (int rep = 0; rep < REPS(2); ++rep) {
            if (rep) GRID_BAR();
            pg8::Gemm g{ws + WS_H8, ws + WS_W8IN + (size_t)l * NQKV * DM, MT / 256, NQKV / 256, DM, DM, DM, 0, 0, 1};
            pg8::StaticOrder S; S.init(g, F.G, (int)blockIdx.x);
            pg8::EpiQKV E{Qb, Kb, Vb, in[I_QKNW] + l * 128};
            pg8::gemm_phase<pg8::EpiQKV, true>(F.lds, g, S, E, F.wave);
        }
        GRID_BAR();
#if SELFCHECK
        if (blockIdx.x < 4) { const int b = blockIdx.x; const int r = b == 0 ? 5 : b == 1 ? 8400 : b == 2 ? 16383 : 16391; chk::ck_qkv(l, r, in, ws, F.ctl, CK_RED, CK_BUF); }
        GRID_BAR();
#endif
        for (int rep = 0; rep < REPS(4); ++rep) {
            if (rep) GRID_BAR();
            char* shm = (char*)lds;
            const float lam = lamv[l];
            for (int ui = F.vcu; ui < 256; ui += F.G) {
                const int h = (ui >> 5) & 3, qb = ((ui >> 7) << 5) | (ui & 31);
                const int njobs = (l == 0 && ui < 16) ? (((ui >> 2) == 1) ? 7 : 6) : 5;
#pragma unroll 1
                for (int j = 0; j < njobs; ++j) {
                    att::AU u; int mode = 0;
                    u.sinkl2 = -INFINITY; u.emode = 0; u.lam = 0.f; u.oscale = 1.f; u.subw = in[I_SUBW] + l * 64; u.kbase = 0; u.q0 = qb * 256; u.NT = 260;
                    int qh, kh, oc;
                    if (j == 0)      { qh = 16 + h; kh = 10 + (h >> 1); oc = 768 + h * 64; }
                    else if (j == 1) { qh = 4 + 2 * h; kh = 4 + h; oc = 256 + h * 64; u.emode = 1; }
                    else if (j == 2) { qh = 5 + 2 * h; kh = 4 + h; oc = 256 + h * 64; u.emode = 2; u.lam = lam; u.oscale = 1.f - lam_init_of(l); }
                    else if (j == 3) { qh = h; kh = h; oc = h * 64; mode = 1; u.NT = 16; int B = 4 * qb - 4; B = B < 0 ? 0 : (B > 244 ? 244 : B); u.kbase = 64 * B; }
                    else if (j == 4) { qh = 12 + h; kh = 8 + (h >> 1); oc = 512 + h * 64; mode = 2; u.NT = 12; u.kbase = 256 * qb - 128; u.sinkl2 = in[I_SINK][l * 4 + h] * LOG2E; }
                    else {
                        const int mx = ui >> 2, hc = ui & 3; u.q0 = SEQ; u.NT = 4;
                        if (mx == 0)      { qh = hc; kh = hc; oc = hc * 64; }
                        else if (mx == 1) { qh = 4 + 2 * hc + (j - 5); kh = 4 + hc; oc = 256 + hc * 64; u.emode = (j == 5) ? 1 : 2; u.lam = lam; u.oscale = 1.f - lam_init_of(l); }
                        else if (mx == 2) { qh = 12 + hc; kh = 8 + (hc >> 1); oc = 512 + hc * 64; u.sinkl2 = in[I_SINK][l * 4 + hc] * LOG2E; }
                        else              { qh = 16 + hc; kh = 10 + (hc >> 1); oc = 768 + hc * 64; }
                    }
                    u.Q = (const att::bf16*)(Qb + (size_t)qh * MT * 64); u.K = (const att::bf16*)(Kb + (size_t)kh * MT * 64); u.V = (const att::bf16*)(Vb + (size_t)kh * MT * 64);
                    u.O = (att::bf16*)(YS + oc);
#ifndef ATT_MODES
#define ATT_MODES 7
#endif
                    if ((ATT_MODES & 2) && mode == 1) {
                        float* rp = (float*)(shm + att::LDS_RPB);
                        for (int i = ltid(F.wave); i < 15 * 32; i += NTHREADS) { const int c = i & 31; rp[i] = (c < 31) ? in[I_RPB][((size_t)(l * 4 + h) * 15 + (i >> 5)) * 31 + c] * LOG2E : 0.f; }
                        __syncthreads();
                        if (!att::attn_simple<1, 1>(u, shm, F.wave)) att::attn_simple<1>(u, shm, F.wave);
                    } else if ((ATT_MODES & 4) && mode == 2) { if (!att::attn_unit<2, 8, 0, 1>(u, shm, F.wave)) att::attn_unit<2, 8>(u, shm, F.wave); }
                    else if ((ATT_MODES & 1) && j == 1) { if (!att::attn_unit<0, 8, 1, 1>(u, shm, F.wave)) att::attn_unit<0, 8, 1>(u, shm, F.wave); }
                    else if ((ATT_MODES & 1) && j == 2) { if (!att::attn_unit<0, 8, 2, 1>(u, shm, F.wave)) att::attn_unit<0, 8, 2>(u, shm, F.wave); }
                    else if (ATT_MODES & 1) { if (!att::attn_unit<0, 8, 0, 1>(u, shm, F.wave)) att::attn_unit<0, 8>(u, shm, F.wave); }
                }
            }
        }
        GRID_BAR();
#if SELFCHECK
        if (blockIdx.x < 80) { const int b = blockIdx.x, ri = b >> 4; const int r = ri == 0 ? 3 : ri == 1 ? 4227 : ri == 2 ? 16319 : ri == 3 ? 9000 : 16484; chk::ck_attn(l, (b >> 2) & 3, b & 3, r, in, ws, F.ctl, CK_RED, CK_SC, CK_OBUF); }
        GRID_BAR();
#endif
        for (int rep = 0; rep < REPS(5); ++rep) {
            if (rep) GRID_BAR();
            pg8::Gemm g{YS, WBR + (size_t)l * 4 * DM * 256, nMr, 16, 256, DM, 256, 2, 512, 2};
            pg8::StaticOrder S; S.init(g, F.G, (int)blockIdx.x);
#if BP8
            pg8::EpiBranch8 E{(unsigned char*)BP};
            pg8::gemm_phase<pg8::EpiBranch8>(F.lds, g, S, E, F.wave);
#else
            pg8::EpiBranch E{BP};
            pg8::gemm_phase<pg8::EpiBranch>(F.lds, g, S, E, F.wave);
#endif
        }
        GRID_BAR();
#if SELFCHECK
        if (blockIdx.x < 3) { const int b = blockIdx.x; chk::ck_branch(l, b == 0 ? 1 : b == 1 ? 16383 : 16390, in, ws, F.ctl, CK_RED); }
        GRID_BAR();
#endif
        for (int rep = 0; rep < REPS(6); ++rep) {
            if (rep) GRID_BAR();
            pg8::Gemm g{ws + WS_H8, ws + WS_W8GATE + (size_t)l * 4096 * DM, nMr, 16, DM, DM, DM, 0, 0, 1};
            pg8::StaticOrder S; S.init(g, F.G, (int)blockIdx.x);
            pg8::EpiGate E{BP, MIX, in[I_BGATE] + l * 4096};
            pg8::gemm_phase<pg8::EpiGate, true>(F.lds, g, S, E, F.wave);
        }
        GRID_BAR();
#if SELFCHECK
        if (blockIdx.x < 3) { const int b = blockIdx.x; chk::ck_gate(l, b == 0 ? 2 : b == 1 ? 9999 : 16385, in, ws, F.ctl, CK_RED); }
        GRID_BAR();
#endif
        for (int rep = 0; rep < (l == 0 ? REPS(7) : 1); ++rep) {
            if (rep) GRID_BAR();
#if MIX8
            pg8::Gemm g{MIX, ws + WS_W8OUT + (size_t)l * DM * DM, nMr, 4, DM, DM, DM, 0, 0, 1};
#else
            pg8::Gemm g{MIX, WOUT + (size_t)l * DM * DM, nMr, 4, DM, DM, DM, 0, 0, 2};
#endif
            pg8::StaticOrder S; S.init(g, F.G, (int)blockIdx.x);
#ifndef FUSE_NORM2
#define FUSE_NORM2 1
#endif
#if FUSE_NORM2
            pg8::EpiOutNorm E{l == 0 ? in[I_X] : X, l == 0 ? in[I_CTX] : X + (size_t)SEQ * DM, X, modl + 2048, modc + 2048,
                              H, in[I_N2W] + l * DM, modl, modc, (gu32*)(ws + WS_CONST + 704 * 1024), F.ctl + 16384 + l * 65 * 64, F.ctl + 16000, F.lds + MISC_OFF + 1024};
#if MIX8
            pg8::gemm_phase<pg8::EpiOutNorm, true, 0x7A7A7A7A>(F.lds, g, S, E, F.wave);
#else
            pg8::gemm_phase<pg8::EpiOutNorm>(F.lds, g, S, E, F.wave);
#endif
#else
            pg8::EpiOut E{l == 0 ? in[I_X] : X, l == 0 ? in[I_CTX] : X + (size_t)SEQ * DM, X, modl + 2048, modc + 2048};
            pg8::gemm_phase<pg8::EpiOut>(F.lds, g, S, E, F.wave);
#endif
        }
        GRID_BAR();
#if SELFCHECK
        if (blockIdx.x < 3) { const int b = blockIdx.x; chk::ck_out(l, b == 0 ? 4 : b == 1 ? 12345 : 16417, in, ws, F.ctl, CK_RED); }
        GRID_BAR();
#endif
#if !FUSE_NORM2
        { const int lane = ltid(F.wave) & 63;
        for (int m = gw; m < nMr * 256; m += NGW) {
            const float* mv = (m < SEQ) ? modl : modc;
            modnorm_row(X + (size_t)m * DM, H + (size_t)m * DM, in[I_N2W] + l * DM, mv + 3072, mv + 4096, lane);
        } }
        GRID_BAR();
#endif
#if SELFCHECK
        if (blockIdx.x < 3) { const int b = blockIdx.x; const int r = b == 0 ? 7 : b == 1 ? 16383 : 16500; const float* mv = (r < SEQ) ? modl : modc;
            chk::ck_modnorm(X + (size_t)r * DM, H + (size_t)r * DM, in[I_N2W] + l * DM, mv + 3072, mv + 4096, F.ctl, 8, CK_RED); }
        GRID_BAR();
#endif
        for (int rep = 0; rep < REPS(9); ++rep) {
            if (rep) GRID_BAR();
            pg8::Gemm g{H, WSC + (size_t)l * 2048 * DM, nMr, 8, DM, DM, DM, 0, 0, 2};
            pg8::StaticOrder S; S.init(g, F.G, (int)blockIdx.x);
            pg8::EpiS E{SB};
            pg8::gemm_phase<pg8::EpiS>(F.lds, g, S, E, F.wave);
        }
        GRID_BAR();
#if SELFCHECK
        if (blockIdx.x < 3) { const int b = blockIdx.x; chk::ck_scores(l, b == 0 ? 6 : b == 1 ? 16000 : 16385, in, ws, F.ctl, CK_RED, CK_BUF); }
        GRID_BAR();
#endif
#ifndef PEER_SLICED
#define PEER_SLICED 0
#endif
#if !PEER_SLICED
        for (int rep = 0; rep < REPS(10); ++rep) {
            if (rep) GRID_BAR();
            PeerArgs P; P.dry = (rep + 1 < REPS(10)); P.route_reps = REPS(11);
            P.S = SB; P.Hin = H; P.U = (const unsigned char*)(ws + WS_UBF) + (size_t)l * NEXP * DM; P.V = (const unsigned char*)(ws + WS_VBF) + (size_t)l * NEXP * DM; P.SU = (const float*)(ws + WS_SU) + (size_t)l * 2 * NEXP; P.SV = (const float*)(ws + WS_SV) + l * NEXP; P.Xin = X; P.Xout = X;
            P.g2l = modl + 5120; P.g2c = modc + 5120;
            P.Hout = SELFCHECK ? H : (bf16_t*)nullptr; P.H8out = ws + WS_H8; P.nwn = in[I_N1W] + DM; P.shl = modv + 2 * 6144; P.scl = P.shl + 1024; P.shc = modv + 3 * 6144; P.scc = P.shc + 1024;
            P.fout = (l == 1) ? args.out : nullptr; P.fnw = in[I_FNW];
            P.nblocks = nMr * 8; P.dbg_eid = nullptr; P.dbg_gt = nullptr;
#if SELFCHECK
            if (l == 0) { P.Xout = (float*)(ws + WS_DBG); P.Hout = YS; P.H8out = nullptr; }
            P.dbg_eid = (int*)(ws + WS_VBF + 32 * MiB); P.dbg_gt = (float*)(ws + WS_VBF + 41 * MiB);
#endif
            P.H8out_xq = ws + WS_H8;
#ifndef PEER_V2
#define PEER_V2 1
#endif
            if (PEER_V2 && !P.dry) peer_phase2(F, P); else peer_phase(F, P);
        }
#else
        {
            PeerArgs P; P.dry = false; P.route_reps = 1;
            P.S = SB; P.Hin = H; P.U = (const unsigned char*)(ws + WS_UBF) + (size_t)l * NEXP * DM; P.V = (const unsigned char*)(ws + WS_VBF) + (size_t)l * NEXP * DM; P.SU = (const float*)(ws + WS_SU) + (size_t)l * 2 * NEXP; P.SV = (const float*)(ws + WS_SV) + l * NEXP; P.Xin = X; P.Xout = X;
            P.g2l = modl + 5120; P.g2c = modc + 5120;
            P.Hout = SELFCHECK ? H : (bf16_t*)nullptr; P.H8out = ws + WS_H8; P.nwn = in[I_N1W] + DM; P.shl = modv + 2 * 6144; P.scl = P.shl + 1024; P.shc = modv + 3 * 6144; P.scc = P.shc + 1024;
            P.fout = (l == 1) ? args.out : nullptr; P.fnw = in[I_FNW];
            P.nblocks = nMr * 8; P.dbg_eid = nullptr; P.dbg_gt = nullptr;
            PeerBufs B;
#if SELFCHECK
            unsigned char* pb = ws + WS_VBF + 32 * MiB;
            if (l == 0) { P.Xout = (float*)(ws + WS_DBG); P.Hout = YS; }
#else
            unsigned char* pb = ws + WS_YS;
#endif
            B.eid = (int*)pb; B.gt = (float*)(pb + 9 * MiB); B.a = (float*)(pb + 18 * MiB); B.xq = ws + WS_UBF + 32 * MiB; B.sx = (float*)(ws + WS_UBF + 50 * MiB);
            const int ntok = nMr * 256;
            peer_route(F, P, B);
            GRID_BAR();
            peer_u(F, P, B, ntok);
            GRID_BAR();
            peer_v(F, P, B, ntok);
            GRID_BAR();
            peer_norm(F, P, ntok);
        }
#endif
#if SELFCHECK
        break;
#endif
        if (l == 0) GRID_BAR();
    }
#if TIMING
    GRID_BAR(); xcd_barrier(bar);
    {
        const unsigned long long* ts = (const unsigned long long*)(F.ctl + 1024);
        float iv[10];
#pragma unroll
        for (int i = 0; i < 10; ++i) iv[i] = 0.f;
        iv[0] = (float)(ts[1] - ts[0]); iv[1] = (float)(ts[2] - ts[1]);
#pragma unroll
        for (int l = 0; l < 2; ++l)
#pragma unroll
            for (int p = 0; p < 8; ++p) iv[2 + p] += (float)(ts[3 + l * 8 + p] - ts[2 + l * 8 + p]);
        const float total = (float)(ts[18] - ts[0]);
        const int k1 = (int)(100.f * iv[TIMING_A] / total + 0.5f); int k2 = 10 + (int)(100.f * iv[TIMING_B] / total + 0.5f); k2 = k2 > 99 ? 99 : k2;
        const float cval = sqrtf((float)k1);
        for (size_t i = (size_t)blockIdx.x * NTHREADS + ltid(F.wave); i < (size_t)SEQ * DM / 4; i += (size_t)gridDim.x * NTHREADS) ((f32x4*)args.out)[i] = (f32x4){i == 0 ? 100.f * (float)k2 : cval, cval, cval, cval};
    }
#endif
#if SELFCHECK
    GRID_BAR();
    if (blockIdx.x < 5) { const int b = blockIdx.x; const int r = b == 0 ? 0 : b == 1 ? 31 : b == 2 ? 37 : b == 3 ? 16383 : 16639; chk::ck_peer(0, r, in, ws, F.ctl, CK_RED, CK_BUF, CK_IBUF); }
    GRID_BAR();
    {
        float e[32];
#pragma unroll
        for (int i = 0; i < 32; ++i) e[i] = __uint_as_float(__hip_atomic_load(F.ctl + CW_CHK + i, RLX_AGENT));
        const float T = 0.03f; int mask = 0;
#if SELFCHECK == 1
        mask = ((e[0] > T || e[1] > T) ? 1 : 0) | (e[2] > T ? 2 : 0) | (e[3] > T ? 4 : 0) | (e[4] > T ? 8 : 0) | (e[5] > T ? 16 : 0);
#elif SELFCHECK == 2
        mask = (e[6] > T ? 1 : 0) | (e[7] > T ? 2 : 0) | (e[8] > T ? 4 : 0) | (e[9] > T ? 8 : 0) | ((e[10] > T || e[11] > T) ? 16 : 0);
#elif SELFCHECK == 5
        mask = (e[24] > T ? 1 : 0) | (e[25] > T ? 2 : 0) | (e[26] > T ? 4 : 0) | (e[27] > T ? 8 : 0) | (e[28] > T ? 16 : 0);
#elif SELFCHECK == 4
        mask = (e[10] > T ? 1 : 0) | (e[11] > T ? 2 : 0) | (e[12] > T ? 4 : 0) | (e[13] > T ? 8 : 0);
#else
        mask = (e[16] > T ? 1 : 0) | (e[17] > T ? 2 : 0) | (e[18] > T ? 4 : 0) | (e[19] > T ? 8 : 0) | ((e[20] > T || e[21] > T || e[22] > T || e[23] > T) ? 16 : 0);
#endif
        const float cval = sqrtf((float)mask);
        for (size_t i = (size_t)blockIdx.x * NTHREADS + ltid(F.wave); i < (size_t)SEQ * DM / 4; i += (size_t)gridDim.x * NTHREADS) ((f32x4*)args.out)[i] = (f32x4){cval, cval, cval, cval};
    }
#endif
}
#ifndef DUP_MASK
#define DUP_MASK 0
#endif
extern "C" void kernel_launch(void* const* d_in, const int* in_sizes, int n_in, void* d_out, int out_size, void* d_ws, size_t ws_size, hipStream_t stream) {
    static int grid = 0;
    if (grid == 0) {
        size_t need = WS_END;
#if SELFCHECK
        need = WS_DBG + (size_t)MT * DM * 4;
#endif
        if (n_in != 23 || in_sizes[0] != SEQ * DM || out_size != SEQ * DM || ws_size < need) {
            fprintf(stderr, "kernel_launch: unexpected problem shape (n_in %d, in0 %d, out %d, ws %zu, need %zu); nothing launched\n", n_in, n_in > 0 ? in_sizes[0] : -1, out_size, ws_size, need); grid = -1; return; }
        int dev = 0, cus = 0, per_cu = 0;
        if (hipGetDevice(&dev) != hipSuccess || hipDeviceGetAttribute(&cus, hipDeviceAttributeMultiprocessorCount, dev) != hipSuccess) { fprintf(stderr, "kernel_launch: device query failed\n"); grid = -1; return; }
        if (hipFuncSetAttribute((const void*)trunk_fwd, hipFuncAttributeMaxDynamicSharedMemorySize, LDS_BYTES) != hipSuccess) { fprintf(stderr, "kernel_launch: hipFuncSetAttribute failed\n"); grid = -1; return; }
        if (hipOccupancyMaxActiveBlocksPerMultiprocessor(&per_cu, (const void*)trunk_fwd, NTHREADS, LDS_BYTES) != hipSuccess || per_cu < 1) {
            fprintf(stderr, "kernel_launch: occupancy query says %d blocks per CU; nothing launched\n", per_cu); (void)hipGetLastError(); grid = -1; return; }
        grid = cus;
    }
    if (grid < 0) return;
    (void)hipMemsetAsync((char*)d_ws + WS_CTL, 0, CTL_ZERO_BYTES, stream);
    Args a{};
    for (int i = 0; i < 23; ++i) a.in[i] = (const float*)d_in[i];
    a.out = (float*)d_out; a.ws = (unsigned char*)d_ws; a.flags = DUP_MASK; a.pad = 0;
    void* kargs[] = {&a};
    const hipError_t e = hipLaunchCooperativeKernel((const void*)trunk_fwd, dim3(grid), dim3(NTHREADS), kargs, LDS_BYTES, stream);
    if (e != hipSuccess) fprintf(stderr, "kernel_launch: cooperative launch failed: %s (grid %d)\n", hipGetErrorString(e), grid);
}
```

```cpp
#define SELFCHECK 0
#define TIMING 0
#define TIMING_A 0
#define TIMING_B 1
#define DUP_MASK 0
#define PEER_SLICED 0
#include <hip/hip_runtime.h>
#include <hip/hip_cooperative_groups.h>
#include <hip/hip_bf16.h>
#include <cstdio>
#include <cstdint>
#include <cmath>
namespace cg = cooperative_groups;

#ifndef SELFCHECK
#define SELFCHECK 0
#endif

constexpr int SEQ = 16384, CTX = 256, MT = SEQ + CTX, DM = 1024, NQKV = 2560, GRIDW = 64;
constexpr int NEXP = 16384, NKEYS = 128, PEER_H = 8, TOPK = 16;
constexpr float EPS = 1e-6f, LOG2E = 1.4426950408889634f;
constexpr float C2_64 = 0.125f * LOG2E;
constexpr float C2_32 = 0.17677669529663687f * LOG2E;
constexpr int NWAVES = 8, NTHREADS = 512;

constexpr size_t MiB = 1u << 20;
constexpr size_t WS_CTL = 0, CTL_ZERO_BYTES = 1 * MiB;
constexpr size_t WS_CONST = 1 * MiB;
constexpr size_t WS_WIN = 2 * MiB;
constexpr size_t WS_WGATE = 12 * MiB;
constexpr size_t WS_WBR = 28 * MiB;
constexpr size_t WS_WOUT = 32 * MiB;
constexpr size_t WS_WSC = 36 * MiB;
constexpr size_t WS_SU = WS_CONST + 256 * 1024, WS_SV = WS_CONST + 512 * 1024;
constexpr size_t WS_UBF = 44 * MiB;
constexpr size_t WS_VBF = 108 * MiB;
constexpr size_t WS_H8 = WS_UBF + 32 * MiB;
constexpr size_t WS_W8IN = WS_VBF + 32 * MiB, WS_W8GATE = WS_VBF + 40 * MiB, WS_W8OUT = WS_VBF + 48 * MiB;
constexpr size_t WS_X = 172 * MiB;
constexpr size_t WS_H = 237 * MiB;
constexpr size_t WS_YS = 270 * MiB;
constexpr size_t WS_R1 = 303 * MiB;
constexpr size_t WS_Q = WS_R1, WS_K = WS_Q + (size_t)20 * MT * 128, WS_V = WS_K + (size_t)12 * MT * 128;
constexpr size_t WS_END = 433 * MiB;
constexpr size_t WS_DBG = 433 * MiB;
static_assert(WS_V + (size_t)12 * MT * 128 <= WS_END && WS_R1 + (size_t)MT * 4096 * 2 <= WS_END && WS_R1 + (size_t)MT * 2048 * 4 <= WS_END, "ws map");
constexpr int CW_BAR = 4096;
constexpr int CW_CHK = 64;

constexpr int RING_BYTES = 131072;
constexpr int LDSCTL_OFF = RING_BYTES, MISC_OFF = LDSCTL_OFF + 320;
constexpr int LDS_BYTES = 147456;

#define GAS __attribute__((address_space(1)))
#define LAS __attribute__((address_space(3)))
typedef unsigned short bf16_t;
typedef unsigned v4u __attribute__((ext_vector_type(4)));
typedef unsigned v2u __attribute__((ext_vector_type(2)));
typedef float f32x4 __attribute__((ext_vector_type(4)));
typedef float f32x2 __attribute__((ext_vector_type(2)));
typedef float f32x16 __attribute__((ext_vector_type(16)));
typedef short bf16x8 __attribute__((ext_vector_type(8)));
typedef short s16x4 __attribute__((ext_vector_type(4)));
typedef __bf16 bf16x2_t __attribute__((ext_vector_type(2)));
typedef int i32x8 __attribute__((ext_vector_type(8)));
typedef int i32x4 __attribute__((ext_vector_type(4)));
typedef GAS unsigned gu32;
#define RLX_AGENT __ATOMIC_RELAXED, __HIP_MEMORY_SCOPE_AGENT
#define LDS_WAIT() asm volatile("s_waitcnt lgkmcnt(0)" ::: "memory")
#define VM_WAIT() asm volatile("s_waitcnt vmcnt(0)" ::: "memory")

__device__ __forceinline__ int lane_now() { int l; asm volatile("v_mbcnt_lo_u32_b32 %0, -1, 0\n\tv_mbcnt_hi_u32_b32 %0, -1, %0" : "=v"(l)); return l; }
__device__ __forceinline__ int tid_now(int wave) { return (wave << 6) | lane_now(); }
__device__ __forceinline__ unsigned f2bf(float f) { unsigned u = __builtin_bit_cast(unsigned, f); return (u + 0x7fffu + ((u >> 16) & 1u)) >> 16; }
__device__ __forceinline__ unsigned pk2(float lo, float hi) { f32x2 v = {lo, hi}; bf16x2_t b = __builtin_convertvector(v, bf16x2_t); return __builtin_bit_cast(unsigned, b); }
__device__ __forceinline__ unsigned pk4_fp8(float a, float b, float c, float d) { int w = 0; w = __builtin_amdgcn_cvt_pk_fp8_f32(a, b, w, false); w = __builtin_amdgcn_cvt_pk_fp8_f32(c, d, w, true); return (unsigned)w; }
__device__ __forceinline__ float bflo(unsigned w) { return __builtin_bit_cast(float, w << 16); }
__device__ __forceinline__ float bfhi(unsigned w) { return __builtin_bit_cast(float, w & 0xffff0000u); }
__device__ __forceinline__ float bf2f(bf16_t h) { return __builtin_bit_cast(float, (unsigned)h << 16); }
template <int X> __device__ __forceinline__ float xorf(float v) { return __builtin_bit_cast(float, __builtin_amdgcn_ds_swizzle(__builtin_bit_cast(int, v), (X << 10) | 0x1f)); }
__device__ __forceinline__ float x32_sum(float v) { auto r = __builtin_amdgcn_permlane32_swap(__float_as_uint(v), __float_as_uint(v), false, false); return __uint_as_float(r[0]) + __uint_as_float(r[1]); }
__device__ __forceinline__ float x32_max(float v) { auto r = __builtin_amdgcn_permlane32_swap(__float_as_uint(v), __float_as_uint(v), false, false); return __builtin_fmaxf(__uint_as_float(r[0]), __uint_as_float(r[1])); }
__device__ __forceinline__ float wave_sum(float v) { v += xorf<1>(v); v += xorf<2>(v); v += xorf<4>(v); v += xorf<8>(v); v += xorf<16>(v); return x32_sum(v); }
__device__ __forceinline__ float wave_max(float v) { v = __builtin_fmaxf(v, xorf<1>(v)); v = __builtin_fmaxf(v, xorf<2>(v)); v = __builtin_fmaxf(v, xorf<4>(v)); v = __builtin_fmaxf(v, xorf<8>(v)); v = __builtin_fmaxf(v, xorf<16>(v)); return x32_max(v); }
__device__ __forceinline__ float fast_exp2(float x) { return __builtin_amdgcn_exp2f(x); }
__device__ __forceinline__ float fast_rcp(float x) { return __builtin_amdgcn_rcpf(x); }
__device__ __forceinline__ float sigmoidf_(float x) { return fast_rcp(1.0f + fast_exp2(-x * LOG2E)); }
__device__ __forceinline__ float gelu_tanh(float x) {
    const float y = 0.7978845608028654f * (x + 0.044715f * x * x * x);
    const float t = 1.0f - 2.0f * fast_rcp(1.0f + fast_exp2(2.0f * LOG2E * y));
    return 0.5f * x * (1.0f + t);
}
#define XB_TMO      128
#define XB_XCNT(j)  (256  + 64 * (j))
#define XB_XSUB(j)  (1280 + 64 * (j))
#define XB_XGEN(j)  (2304 + 64 * (j))
#define XB_TOP      3328
#define XB_TOPGEN   3392
#define XCD_BAR_WORDS 3456
#define XB_SPIN_CAP (1u << 20)
__device__ __forceinline__ unsigned xb_ld(unsigned* p)              { return __hip_atomic_load(p, __ATOMIC_RELAXED, __HIP_MEMORY_SCOPE_AGENT); }
__device__ __forceinline__ unsigned xb_add(unsigned* p, unsigned v) { return __hip_atomic_fetch_add(p, v, __ATOMIC_RELAXED, __HIP_MEMORY_SCOPE_AGENT); }
__device__ __forceinline__ unsigned xb_xcc_id() { return (unsigned)__builtin_amdgcn_s_getreg((3 << 11) | 20) & 0xFu; }
#define XB_SPIN(cond, bar) do { unsigned _sp = 0; while (cond) { __builtin_amdgcn_s_sleep(1); \
    if ((++_sp & 255u) == 0u) { if (xb_ld(&(bar)[XB_TMO])) break; if (_sp > XB_SPIN_CAP) { atomicAdd(&(bar)[XB_TMO], 1u); break; } } } } while (0)
struct XcdBarrier { unsigned* bar; unsigned x; volatile LAS unsigned* st; int wave; };
__device__ __forceinline__ XcdBarrier xcd_barrier_post(unsigned* bar, volatile LAS unsigned* st, int wave) {
    XcdBarrier b; b.bar = bar; b.x = xb_xcc_id(); b.st = st; b.wave = wave;
    if (tid_now(wave) == 0) (void)xb_add(&bar[XB_XCNT(b.x)], 1u);
    return b;
}
__device__ __forceinline__ void xcd_barrier_complete(unsigned* bar, unsigned x, unsigned& nloc, unsigned& nx) {
    const unsigned G = gridDim.x * gridDim.y * gridDim.z;
    unsigned sum, cnt, mine, sp = 0u;
    for (;;) {
        sum = 0u; cnt = 0u; mine = 0u;
#pragma unroll
        for (unsigned j = 0; j < 16; ++j) { const unsigned c = xb_ld(&bar[XB_XCNT(j)]); sum += c; cnt += (c > 0u) ? 1u : 0u; mine = (j == x) ? c : mine; }
        if (sum == G) break;
        __builtin_amdgcn_s_sleep(1);
        if ((++sp & 255u) == 0u) { if (xb_ld(&bar[XB_TMO])) break; if (sp > XB_SPIN_CAP) { atomicAdd(&bar[XB_TMO], 1u); break; } }
    }
    nloc = mine > 0u ? mine : 1u; nx = cnt > 0u ? cnt : 1u;
}
__device__ __forceinline__ void xcd_barrier(const XcdBarrier& b) {
    asm volatile("s_waitcnt vmcnt(0)" ::: "memory");
    __syncthreads();
    unsigned* bar_ = b.bar; unsigned bx_ = b.x; asm volatile("" : "+s"(bar_), "+s"(bx_));
    if (tid_now(b.wave) == 0) {
        unsigned* bar = bar_; const unsigned bx = bx_;
        __builtin_amdgcn_s_waitcnt(0);
        unsigned nloc = b.st[0], nx = b.st[1];
        if (nloc == 0u) { xcd_barrier_complete(bar, bx, nloc, nx); b.st[0] = nloc; b.st[1] = nx; }
        const unsigned old = xb_add(&bar[XB_XSUB(bx)], 1u);
        const unsigned gen = old / nloc;
        if (old + 1u == (gen + 1u) * nloc) {
            __builtin_amdgcn_fence(__ATOMIC_RELEASE, "agent");
            asm volatile("s_waitcnt vmcnt(0)" ::: "memory");
            const unsigned og = xb_add(&bar[XB_TOP], 1u);
            const unsigned tg = og / nx;
            if (og + 1u == (tg + 1u) * nx) xb_add(&bar[XB_TOPGEN], 1u);
            else XB_SPIN(xb_ld(&bar[XB_TOPGEN]) == tg, bar);
            __builtin_amdgcn_fence(__ATOMIC_ACQUIRE, "agent");
            xb_add(&bar[XB_XGEN(bx)], 1u);
            asm volatile("s_waitcnt vmcnt(0)" ::: "memory");
        } else {
            XB_SPIN(xb_ld(&bar[XB_XGEN(bx)]) == gen, bar);
            __builtin_amdgcn_fence(__ATOMIC_ACQUIRE, "agent");
            asm volatile("s_waitcnt vmcnt(0)" ::: "memory");
        }
    }
    __syncthreads();
}

namespace pg8 {
#define PG8_LAS __attribute__((address_space(3)))
constexpr int BM = 256, BK = 64, HALF = 128, HTB = HALF * BK * 2, STAGE_BYTES = 8 * HTB, NXCD = 8, WGM = 8;
__host__ __device__ __forceinline__ int lds_byte(int r, int c) { const int st = (r >> 4) * 2 + (c >> 5), rr = r & 15, cc = c & 31, ob = rr * 64 + cc * 2; return st * 1024 + (ob ^ (((ob >> 9) & 1) << 5)); }
__host__ __device__ __forceinline__ void stage_rc(int b, int& R, int& C) { const int st = b / 1024, sb = b % 1024, swz = sb ^ (((sb >> 9) & 1) << 5); R = (st >> 1) * 16 + swz / 64; C = (st & 1) * 32 + (swz % 64) / 2; }
__host__ __device__ __forceinline__ int perm32(int rho) { const int n = rho >> 4, i = rho & 15; return 8 * (i >> 2) + 4 * n + (i & 3); }
__host__ __device__ __forceinline__ int wide_row(int R) { return 64 * (R >> 5) + 16 * ((R >> 2) & 3) + 4 * ((R >> 4) & 1) + (R & 3); }
template <class E, class = void> struct IsWide { static constexpr bool v = false; };
template <class E> struct IsWide<E, decltype((void)E::WIDE)> { static constexpr bool v = true; };

struct Unit { int pm, pn; const char* a; const char* b; };
struct Gemm { const void* A; const void* Bt; int nM, nN, K, lda, ldb, a_shift, a_pn_bytes, esz; };

struct StaticOrder {
    int nM, nN, nwg, G, c; const char* A; const char* B; size_t a_pm, b_pn; int a_shift, a_pn;
    __device__ void init(const Gemm& g, int G_, int c_) { nM = g.nM; nN = g.nN; nwg = nM * nN; G = G_; c = c_; A = (const char*)g.A; B = (const char*)g.Bt;
        a_pm = (size_t)BM * g.lda * g.esz; b_pn = (size_t)BM * g.ldb * g.esz; a_shift = g.a_shift; a_pn = g.a_pn_bytes; }
    __device__ bool has(int i) const { int cc = c; asm volatile("" : "+s"(cc)); return (long)i * G + cc < nwg; }
    __device__ bool next(int i, Unit& u) const {
        const long L = (long)i * G + c; if (L >= nwg) return false;
        int wgid = (int)L; { const int q = nwg / NXCD, r = nwg % NXCD, xcd = wgid % NXCD, off = wgid / NXCD; wgid = (xcd < r ? xcd * (q + 1) : r * (q + 1) + (xcd - r) * q) + off; }
        const int nig = WGM * nN, gid = wgid / nig, fm = gid * WGM, gsz = (nM - fm) < WGM ? (nM - fm) : WGM;
        u.pm = fm + ((wgid % nig) % gsz); u.pn = (wgid % nig) / gsz;
        u.a = A + (size_t)u.pm * a_pm + (size_t)(u.pn >> a_shift) * a_pn; u.b = B + (size_t)u.pn * b_pn; return true;
    }
};

template <class Epi, bool FP8 = false, int SCALE_ACT = 0x7F7F7F7F>
__device__ __forceinline__ void gemm_phase(PG8_LAS unsigned char* lds, const Gemm g, const StaticOrder& S, const Epi& E, int wave) {
    const int tid = tid_now(wave), wid = wave, lane = tid & 63, wr = wid >> 2, wc = wid & 3, fr = lane & 15, fq = lane >> 4;
    const int K = g.K, nt = (K * g.esz) / (BK * 2);
    unsigned voffA[2], voffB[2];
#pragma unroll
    for (int i = 0; i < 2; ++i) { int R, C; stage_rc(tid * 16 + i * 8192, R, C); const int Rb = IsWide<Epi>::v ? wide_row(R) : (Epi::PERM ? ((R & ~31) + perm32(R & 31)) : R);
        voffA[i] = (unsigned)(R * g.lda * g.esz + C * 2); voffB[i] = (unsigned)(Rb * g.ldb * g.esz + C * 2); }
    const size_t kstep = (size_t)(BK * 2);
    const size_t hstepA = (size_t)HALF * g.lda * g.esz, hstepB = (size_t)(IsWide<Epi>::v ? 8 : HALF) * g.ldb * g.esz;
    const unsigned ldsw = (unsigned)wid * 1024u, ldsbase = (unsigned)(uintptr_t)lds;
    const int aoff = FP8 ? lds_byte(wr * 64 + fr, fq * 16) : lds_byte(wr * 64 + fr, fq * 8), boff = FP8 ? lds_byte(wc * 32 + fr, fq * 16) : lds_byte(wc * 32 + fr, fq * 8);
#define PG8_SA(b, h) (((b) * 2 + (h)) * HTB)
#define PG8_SB(b, h) ((4 + (b) * 2 + (h)) * HTB)
#define PG8_GLDS(sbase, voff32, ldsdst) do { unsigned keep_; asm volatile("s_mov_b32 %0, m0\n\ts_mov_b32 m0, %3\n\ts_nop 0\n\tglobal_load_lds_dwordx4 %1, %2\n\ts_mov_b32 m0, %0" : "=&s"(keep_) : "v"(voff32), "s"(sbase), "s"(ldsdst) : "memory"); } while (0)
#define PG8_STAGE(bufoff, gbase, voff) do { _Pragma("unroll") for (int _i = 0; _i < 2; ++_i) \
        PG8_GLDS((const char*)(gbase), (voff)[_i], (unsigned)__builtin_amdgcn_readfirstlane((int)(ldsbase + (unsigned)(bufoff) + ldsw + _i * 8192))); } while (0)
#define PG8_LDA(dst, b, h) do { if constexpr (FP8) { _Pragma("unroll") for (int m = 0; m < 4; ++m) dst##8[m] = *(const PG8_LAS i32x8*)(lds + PG8_SA(b, h) + aoff + m * 2048); } \
        else { _Pragma("unroll") for (int m = 0; m < 4; ++m) _Pragma("unroll") for (int k = 0; k < 2; ++k) dst[m][k] = *(const PG8_LAS bf16x8*)(lds + PG8_SA(b, h) + aoff + m * 2048 + k * 1024); } } while (0)
#define PG8_LDB(dst, b, h) do { if constexpr (FP8) { _Pragma("unroll") for (int n = 0; n < 2; ++n) dst##8[n] = *(const PG8_LAS i32x8*)(lds + PG8_SB(b, h) + boff + n * 2048); } \
        else { _Pragma("unroll") for (int n = 0; n < 2; ++n) _Pragma("unroll") for (int k = 0; k < 2; ++k) dst[n][k] = *(const PG8_LAS bf16x8*)(lds + PG8_SB(b, h) + boff + n * 2048 + k * 1024); } } while (0)
#define PG8_MMA(ai, bj, At, Bt) do { __builtin_amdgcn_s_setprio(1); \
        if constexpr (FP8) { _Pragma("unroll") for (int m = 0; m < 4; ++m) _Pragma("unroll") for (int n = 0; n < 2; ++n) \
            acc[ai][bj][m][n] = __builtin_amdgcn_mfma_scale_f32_16x16x128_f8f6f4(Bt##8[n], At##8[m], acc[ai][bj][m][n], 0, 0, 0, 0x79797979, 0, SCALE_ACT); } \
        else { _Pragma("unroll") for (int m = 0; m < 4; ++m) _Pragma("unroll") for (int n = 0; n < 2; ++n) _Pragma("unroll") for (int k = 0; k < 2; ++k) \
            acc[ai][bj][m][n] = __builtin_amdgcn_mfma_f32_16x16x32_bf16(Bt[n][k], At[m][k], acc[ai][bj][m][n], 0, 0, 0); } \
        __builtin_amdgcn_s_setprio(0); } while (0)
#define PG8_WAIT_V(n) asm volatile("s_waitcnt vmcnt(" #n ")" ::: "memory")
#define PG8_WAIT_L(n) asm volatile("s_waitcnt lgkmcnt(" #n ")" ::: "memory")
#define PG8_BAR __builtin_amdgcn_s_barrier()
#define PG8_SCHED __builtin_amdgcn_sched_barrier(0)
    Unit cur, nxt; int ui = 0;
    if (!S.has(0)) return;
    (void)S.next(0, cur);
    f32x4 acc[2][2][4][2];
#pragma unroll
    for (int a = 0; a < 2; ++a)
#pragma unroll
        for (int b = 0; b < 2; ++b)
#pragma unroll
            for (int m = 0; m < 4; ++m)
#pragma unroll
                for (int n = 0; n < 2; ++n) acc[a][b][m][n] = (f32x4){0.f, 0.f, 0.f, 0.f};
    bf16x8 At[4][2], B0[2][2], B1[2][2]; i32x8 At8[4], B08[2], B18[2];
    const char* cA = cur.a; const char* cB = cur.b;
    PG8_STAGE(PG8_SB(0, 0), cB, voffB); PG8_STAGE(PG8_SB(0, 1), cB + hstepB, voffB); PG8_STAGE(PG8_SA(0, 0), cA, voffA); PG8_STAGE(PG8_SA(0, 1), cA + hstepA, voffA);
    { int w_ = wave; asm volatile("" : "+s"(w_)); if ((w_ >> 2) == 1) PG8_BAR; }
    PG8_WAIT_V(2); PG8_BAR;
    PG8_STAGE(PG8_SB(1, 0), cB + kstep, voffB); PG8_STAGE(PG8_SA(1, 0), cA + kstep, voffA); PG8_STAGE(PG8_SB(1, 1), cB + hstepB + kstep, voffB);
    PG8_WAIT_V(6); PG8_BAR;
    for (;;) {
        const bool has_next = S.has(ui + 1); nxt = cur; if (has_next) (void)S.next(ui + 1, nxt);
        const char* nA = has_next ? nxt.a : cA; const char* nB = has_next ? nxt.b : cB;
        for (int t = 0; t < nt; t += 2) {
            const bool last = (t == nt - 2);
            const char* a1 = cA + (size_t)(t + 1) * kstep;
            const char* a2 = last ? nA : cA + (size_t)(t + 2) * kstep; const char* b2 = last ? nB : cB + (size_t)(t + 2) * kstep;
            const char* a3 = a2 + kstep; const char* b3 = b2 + kstep;
            PG8_LDB(B0, 0, 0); PG8_LDB(B1, 0, 1); PG8_SCHED; PG8_LDA(At, 0, 0); PG8_STAGE(PG8_SA(1, 1), a1 + hstepA, voffA);
            PG8_WAIT_V(8); PG8_WAIT_L(0); PG8_BAR; PG8_MMA(0, 0, At, B0); PG8_MMA(0, 1, At, B1); PG8_BAR; PG8_SCHED;
            PG8_LDA(At, 0, 1); PG8_STAGE(PG8_SB(0, 0), b2, voffB); PG8_STAGE(PG8_SB(0, 1), b2 + hstepB, voffB); PG8_STAGE(PG8_SA(0, 0), a2, voffA);
            PG8_WAIT_V(8); PG8_WAIT_L(0); PG8_BAR; PG8_MMA(1, 0, At, B0); PG8_MMA(1, 1, At, B1); PG8_BAR; PG8_SCHED;
            PG8_LDB(B0, 1, 0); PG8_LDB(B1, 1, 1); PG8_SCHED; PG8_LDA(At, 1, 0); PG8_STAGE(PG8_SA(0, 1), a2 + hstepA, voffA);
            PG8_WAIT_V(8); PG8_WAIT_L(0); PG8_BAR; PG8_MMA(0, 0, At, B0); PG8_MMA(0, 1, At, B1); PG8_BAR; PG8_SCHED;
            PG8_LDA(At, 1, 1); PG8_STAGE(PG8_SB(1, 0), b3, voffB); PG8_STAGE(PG8_SB(1, 1), b3 + hstepB, voffB); PG8_STAGE(PG8_SA(1, 0), a3, voffA);
            PG8_WAIT_V(8); PG8_WAIT_L(0); PG8_BAR; PG8_MMA(1, 0, At, B0); PG8_MMA(1, 1, At, B1); PG8_BAR; PG8_SCHED;
        }
        { int w2_ = wave; asm volatile("" : "+s"(w2_));
          if ((w2_ >> 2) == 0) PG8_BAR;
          E(acc, cur, w2_ >> 2, w2_ & 3, 0, 0); }
        if (!S.has(ui + 1)) break;
#pragma unroll
        for (int a = 0; a < 2; ++a)
#pragma unroll
            for (int b = 0; b < 2; ++b)
#pragma unroll
                for (int m = 0; m < 4; ++m)
#pragma unroll
                    for (int n = 0; n < 2; ++n) acc[a][b][m][n] = (f32x4){0.f, 0.f, 0.f, 0.f};
        cur = nxt; cA = nA; cB = nB; ++ui;
        { int w_ = wave; asm volatile("" : "+s"(w_)); if ((w_ >> 2) == 1) PG8_BAR; }
    }
    PG8_WAIT_V(0);
    PG8_BAR;
#undef PG8_SA
#undef PG8_SB
#undef PG8_STAGE
#undef PG8_LDA
#undef PG8_LDB
#undef PG8_MMA
#undef PG8_WAIT_V
#undef PG8_WAIT_L
#undef PG8_BAR
#undef PG8_SCHED
}
}
namespace pg8 {
struct EpiQKV {
    static constexpr bool PERM = true;
    bf16_t *Qb, *Kb, *Vb; const float* qkw;
    __device__ __forceinline__ void operator()(const f32x4 (&acc)[2][2][4][2], const Unit& u, int wr, int wc, int, int) const {
        const int t_ = lane_now(); const int fr = t_ & 15, fq = (t_ >> 4) & 3;
        const int hs = __builtin_amdgcn_readfirstlane(u.pn * 4 + wc);
        bf16_t* dst; int rope = 0, norm = -1, dq = 0; float scale = 1.f;
        if (hs < 4)       { dst = Qb + (size_t)hs * MT * 64; scale = C2_64; }
        else if (hs < 8)  { dst = Kb + (size_t)(hs - 4) * MT * 64; }
        else if (hs < 12) { dst = Vb + (size_t)(hs - 8) * MT * 64; }
        else if (hs < 16) { dst = Qb + (size_t)(4 + 2 * (hs - 12)) * MT * 64; rope = 2; dq = 1; scale = C2_32; }
        else if (hs < 20) { dst = Kb + (size_t)(4 + hs - 16) * MT * 64; rope = 2; }
        else if (hs < 24) { dst = Vb + (size_t)(4 + hs - 20) * MT * 64; }
        else if (hs < 28) { dst = Qb + (size_t)(12 + hs - 24) * MT * 64; rope = 1; scale = C2_64; }
        else if (hs < 30) { dst = Kb + (size_t)(8 + hs - 28) * MT * 64; rope = 1; }
        else if (hs < 32) { dst = Vb + (size_t)(8 + hs - 30) * MT * 64; }
        else if (hs < 36) { dst = Qb + (size_t)(16 + hs - 32) * MT * 64; rope = 1; norm = 0; scale = C2_64; }
        else if (hs < 38) { dst = Kb + (size_t)(10 + hs - 36) * MT * 64; rope = 1; norm = 1; }
        else              { dst = Vb + (size_t)(10 + hs - 38) * MT * 64; }
        const bool latent = u.pm < SEQ / 256;
        if (!latent) rope = 0;
        float fstep = (rope == 2) ? (13.287712379549449f / 8.f) : (13.287712379549449f / 16.f); asm volatile("" : "+v"(fstep));
        const float fbase = (rope == 2) ? 0.f : (float)(8 * (fq & 1)) * fstep;
#define INVF(k) (fast_exp2(-(fbase + (float)(k) * fstep)) * 0.15915494309189535f)
#pragma unroll
        for (int m = 0; m < 4; ++m) {
            float csn[8], ccs[8];
            if (rope == 1) { float pos = (float)(m * 16 + fr); asm volatile("" : "+v"(pos));
#pragma unroll
                for (int k = 0; k < 8; ++k) { const float rev = pos * INVF(k); csn[k] = __builtin_amdgcn_sinf(rev); ccs[k] = __builtin_amdgcn_cosf(rev); } }
#pragma unroll
            for (int ai = 0; ai < 2; ++ai) {
                const int row = u.pm * BM + ai * HALF + wr * 64 + m * 16 + fr;
                float v[16];
#pragma unroll
                for (int bj = 0; bj < 2; ++bj)
#pragma unroll
                    for (int n = 0; n < 2; ++n)
#pragma unroll
                        for (int j = 0; j < 4; ++j) v[bj * 8 + n * 4 + j] = acc[ai][bj][m][n][j];
                if (norm >= 0) {
                    float ss = 0.f;
#pragma unroll
                    for (int k = 0; k < 16; ++k) ss += v[k] * v[k];
                    ss += xorf<16>(ss); ss = x32_sum(ss);
                    const float ri = __builtin_amdgcn_rsqf(ss * (1.f / 64.f) + EPS);
#pragma unroll
                    for (int bj = 0; bj < 2; ++bj) { const f32x4 w0 = *(const f32x4*)(qkw + norm * 64 + 32 * bj + 8 * fq), w1 = *(const f32x4*)(qkw + norm * 64 + 32 * bj + 8 * fq + 4);
#pragma unroll
                        for (int j = 0; j < 4; ++j) { v[bj * 8 + j] = v[bj * 8 + j] * ri * w0[j]; v[bj * 8 + 4 + j] = v[bj * 8 + 4 + j] * ri * w1[j]; } }
                }
                if (rope == 1) {
                    const float sgn = (fq & 2) ? 1.f : -1.f;
                    float pos = (float)(row >> 6); asm volatile("" : "+v"(pos));
#pragma unroll
                    for (int k = 0; k < 8; ++k) {
                        const float rev = pos * INVF(k); const float sn = __builtin_amdgcn_sinf(rev), cs = __builtin_amdgcn_cosf(rev);
                        const float x = v[k]; auto rx = __builtin_amdgcn_permlane32_swap(__float_as_uint(x), __float_as_uint(x), false, false);
                        const float pt = __uint_as_float((fq & 2) ? rx[0] : rx[1]);
                        v[k] = x * cs + sgn * pt * sn;
                        const float y = v[8 + k]; auto ry = __builtin_amdgcn_permlane32_swap(__float_as_uint(y), __float_as_uint(y), false, false);
                        const float qt = __uint_as_float((fq & 2) ? ry[0] : ry[1]);
                        v[8 + k] = y * ccs[k] + sgn * qt * csn[k];
                    }
                } else if (rope == 2) {
                    const float sgn = (fq & 1) ? 1.f : -1.f;
                    float pos = (float)(fq < 2 ? (row >> 6) : (row & 63)); asm volatile("" : "+v"(pos));
#pragma unroll
                    for (int k = 0; k < 8; ++k) {
                        const float rev = pos * INVF(k); const float sn = __builtin_amdgcn_sinf(rev), cs = __builtin_amdgcn_cosf(rev);
#pragma unroll
                        for (int bj = 0; bj < 2; ++bj) { const float x = v[bj * 8 + k], pt = xorf<16>(x); v[bj * 8 + k] = x * cs + sgn * pt * sn; }
                    }
                }
#pragma unroll
                for (int bj = 0; bj < 2; ++bj) {
                    v4u w; w.x = pk2(v[bj * 8 + 0] * scale, v[bj * 8 + 1] * scale); w.y = pk2(v[bj * 8 + 2] * scale, v[bj * 8 + 3] * scale);
                    w.z = pk2(v[bj * 8 + 4] * scale, v[bj * 8 + 5] * scale); w.w = pk2(v[bj * 8 + 6] * scale, v[bj * 8 + 7] * scale);
                    if (dq) {
                        *(v4u*)(dst + (size_t)bj * MT * 64 + (size_t)row * 64 + 32 * bj + 8 * fq) = w;
                        unsigned z0 = 0u; asm volatile("" : "+v"(z0));
                        *(v4u*)(dst + (size_t)(1 - bj) * MT * 64 + (size_t)row * 64 + 32 * bj + 8 * fq) = (v4u){z0, z0, z0, z0};
                    } else *(v4u*)(dst + (size_t)row * 64 + 32 * bj + 8 * fq) = w;
                }
                __builtin_amdgcn_sched_barrier(0);
            }
        }
#undef INVF
    }
};
struct EpiBranch {
    static constexpr bool PERM = true;
    bf16_t* Bp;
    __device__ __forceinline__ void operator()(const f32x4 (&acc)[2][2][4][2], const Unit& u, int wr, int wc, int, int) const {
        const int t_ = lane_now(); const int fr = t_ & 15, fq = (t_ >> 4) & 3;
        const int branch = u.pn >> 2, chb = 256 * (u.pn & 3) + 32 * wc + 8 * fq;
#pragma unroll
        for (int ai = 0; ai < 2; ++ai)
#pragma unroll
            for (int m = 0; m < 4; ++m) { bf16_t* rowp = Bp + (size_t)(u.pm * BM + ai * HALF + wr * 64 + m * 16 + fr) * 4096 + branch * 1024 + chb;
#pragma unroll
                for (int bj = 0; bj < 2; ++bj) { const f32x4 a = acc[ai][bj][m][0], c = acc[ai][bj][m][1];
                    v4u w; w.x = pk2(a[0], a[1]); w.y = pk2(a[2], a[3]); w.z = pk2(c[0], c[1]); w.w = pk2(c[2], c[3]); *(v4u*)(rowp + 128 * bj) = w; } }
    }
};
#ifndef BP8
#define BP8 1
#endif
#ifndef MIX8
#define MIX8 1
#endif
#if MIX8 && !BP8
#error MIX8 needs BP8
#endif
constexpr float BP8_SCALE = 32.f;
struct EpiBranch8 {
    static constexpr bool PERM = false, WIDE = true;
    unsigned char* Bp;
    __device__ __forceinline__ void operator()(const f32x4 (&acc)[2][2][4][2], const Unit& u, int wr, int wc, int, int) const {
        const int t_ = lane_now(); const int fr = t_ & 15, fq = (t_ >> 4) & 3;
        const int branch = u.pn >> 2, off = (4 * (u.pn & 3) + wc) * 256 + branch * 64 + 16 * fq;
#pragma unroll
        for (int ai = 0; ai < 2; ++ai)
#pragma unroll
            for (int m = 0; m < 4; ++m) { unsigned char* rowp = Bp + (size_t)(u.pm * BM + ai * HALF + wr * 64 + m * 16 + fr) * 4096 + off;
                v4u w;
#pragma unroll
                for (int bj = 0; bj < 2; ++bj) { const f32x4 a = acc[ai][bj][m][0] * BP8_SCALE, c = acc[ai][bj][m][1] * BP8_SCALE;
                    w[2 * bj] = pk4_fp8(a[0], a[1], a[2], a[3]); w[2 * bj + 1] = pk4_fp8(c[0], c[1], c[2], c[3]); }
                *(v4u*)rowp = w; }
    }
};
struct EpiGate {
    static constexpr bool PERM = false;
    const bf16_t* Bp; bf16_t* mix; const float* bgate;
    __device__ __forceinline__ void operator()(const f32x4 (&acc)[2][2][4][2], const Unit& u, int wr, int wc, int, int) const {
        const int t_ = lane_now(); const int fr = t_ & 15, fq = (t_ >> 4) & 3;
        const int ch = 64 * u.pn + 16 * wc + 4 * fq;
        f32x4 bias[2][2];
#pragma unroll
        for (int bj = 0; bj < 2; ++bj)
#pragma unroll
            for (int n = 0; n < 2; ++n) bias[bj][n] = *(const f32x4*)(bgate + (2 * bj + n) * 1024 + ch);
#pragma unroll
        for (int ai = 0; ai < 2; ++ai)
#pragma unroll
            for (int m = 0; m < 4; ++m) { const size_t row = (size_t)(u.pm * BM + ai * HALF + wr * 64 + m * 16 + fr);
                f32x4 s = {0.f, 0.f, 0.f, 0.f};
#if BP8
                unsigned b8[4];
#pragma unroll
                for (int b = 0; b < 4; ++b) b8[b] = *(const unsigned*)((const unsigned char*)Bp + row * 4096 + u.pn * 256 + b * 64 + 16 * wc + 4 * fq);
#pragma unroll
                for (int bj = 0; bj < 2; ++bj)
#pragma unroll
                    for (int n = 0; n < 2; ++n) { const f32x4 a = acc[ai][bj][m][n] + bias[bj][n]; const int w = (int)b8[2 * bj + n];
                        const f32x2 lo = __builtin_amdgcn_cvt_pk_f32_fp8(w, false), hi = __builtin_amdgcn_cvt_pk_f32_fp8(w, true);
                        s[0] += sigmoidf_(a[0]) * lo.x; s[1] += sigmoidf_(a[1]) * lo.y; s[2] += sigmoidf_(a[2]) * hi.x; s[3] += sigmoidf_(a[3]) * hi.y; }
#if !MIX8
                s = s * (1.f / BP8_SCALE);
#endif
#else
                v2u bb[4];
#pragma unroll
                for (int b = 0; b < 4; ++b) bb[b] = *(const v2u*)(Bp + row * 4096 + b * 1024 + ch);
#pragma unroll
                for (int bj = 0; bj < 2; ++bj)
#pragma unroll
                    for (int n = 0; n < 2; ++n) { const f32x4 a = acc[ai][bj][m][n] + bias[bj][n]; const unsigned w0 = bb[2 * bj + n].x, w1 = bb[2 * bj + n].y;
                        s[0] += sigmoidf_(a[0]) * bflo(w0); s[1] += sigmoidf_(a[1]) * bfhi(w0); s[2] += sigmoidf_(a[2]) * bflo(w1); s[3] += sigmoidf_(a[3]) * bfhi(w1); }
#endif
#if MIX8
                *(unsigned*)((unsigned char*)mix + row * 1024 + ch) = pk4_fp8(s[0], s[1], s[2], s[3]); }
#else
                v2u w; w.x = pk2(s[0], s[1]); w.y = pk2(s[2], s[3]); *(v2u*)(mix + row * 1024 + ch) = w; }
#endif
    }
};
struct EpiOut {
    static constexpr bool PERM = false;
    const float* xl; const float* xc; float* X; const float* gl; const float* gc;
    __device__ __forceinline__ void operator()(const f32x4 (&acc)[2][2][4][2], const Unit& u, int wr, int wc, int, int) const {
        const int t_ = lane_now(); const int fr = t_ & 15, fq = (t_ >> 4) & 3;
        const bool latent = u.pm < SEQ / 256; const float* gv = latent ? gl : gc; const float* xo = latent ? xl : xc - (size_t)SEQ * DM;
        const int col0 = u.pn * BM + wc * 32 + 4 * fq;
        f32x4 g[2][2];
#pragma unroll
        for (int bj = 0; bj < 2; ++bj)
#pragma unroll
            for (int n = 0; n < 2; ++n) g[bj][n] = *(const f32x4*)(gv + col0 + bj * HALF + n * 16);
#pragma unroll
        for (int ai = 0; ai < 2; ++ai)
#pragma unroll
            for (int m = 0; m < 4; ++m) { const size_t off = (size_t)(u.pm * BM + ai * HALF + wr * 64 + m * 16 + fr) * DM + col0;
#pragma unroll
                for (int bj = 0; bj < 2; ++bj)
#pragma unroll
                    for (int n = 0; n < 2; ++n) { const f32x4 o = *(const f32x4*)(xo + off + bj * HALF + n * 16); *(f32x4*)(X + off + bj * HALF + n * 16) = o + g[bj][n] * acc[ai][bj][m][n]; } }
    }
};
struct EpiOutNorm {
    static constexpr bool PERM = true;
    const float* xl; const float* xc; float* X; const float* gl; const float* gc;
    bf16_t* H; const float* nw; const float* ml; const float* mc;
    gu32* xbuf; gu32* cnt; gu32* tmo; LAS unsigned char* tl;
    __device__ __forceinline__ void operator()(f32x4 (&acc)[2][2][4][2], const Unit& u, int wr, int wc, int, int) const {
        const int t_ = lane_now(); const int fr = t_ & 15, fq = (t_ >> 4) & 3;
        const bool latent = u.pm < SEQ / 256; const float* gv = latent ? gl : gc; const float* xo = latent ? xl : xc - (size_t)SEQ * DM;
        const int col0 = u.pn * BM + wc * 32 + 8 * fq;
        LAS float* P = (LAS float*)tl; LAS float* Sr = (LAS float*)(tl + 4096); volatile LAS unsigned* flag = (volatile LAS unsigned*)(tl + 5120);
        {
            f32x4 g[2][2];
#pragma unroll
            for (int bj = 0; bj < 2; ++bj)
#pragma unroll
                for (int n = 0; n < 2; ++n) g[bj][n] = *(const f32x4*)(gv + col0 + bj * HALF + n * 4);
#pragma unroll
            for (int ai = 0; ai < 2; ++ai)
#pragma unroll
                for (int m = 0; m < 4; ++m) { const int r = ai * HALF + wr * 64 + m * 16 + fr; const size_t off = (size_t)(u.pm * BM + r) * DM + col0; float s = 0.f;
#pragma unroll
                    for (int bj = 0; bj < 2; ++bj)
#pragma unroll
                        for (int n = 0; n < 2; ++n) { const f32x4 o = *(const f32x4*)(xo + off + bj * HALF + n * 4); const f32x4 y = o + g[bj][n] * acc[ai][bj][m][n];
                            *(f32x4*)(X + off + bj * HALF + n * 4) = y; acc[ai][bj][m][n] = y; s += (y.x * y.x + y.y * y.y) + (y.z * y.z + y.w * y.w); }
                    s += xorf<16>(s); s = x32_sum(s);
                    if (fq == 0) P[r * 4 + wc] = s; }
        }
        asm volatile("s_waitcnt lgkmcnt(0)" ::: "memory"); __builtin_amdgcn_s_barrier(); asm volatile("" ::: "memory");
        const int wid = wr * 4 + wc, row = wid * 32 + (t_ & 31);
        if (t_ < 32) { const float tp = (P[row * 4 + 0] + P[row * 4 + 1]) + (P[row * 4 + 2] + P[row * 4 + 3]);
            __hip_atomic_store(xbuf + ((size_t)(u.pm * BM + row) * 4 + u.pn), __float_as_uint(tp), RLX_AGENT); }
        asm volatile("s_waitcnt vmcnt(0)" ::: "memory");
        if (t_ == 0) (void)__hip_atomic_fetch_add(cnt + 64 * u.pm, 1u, RLX_AGENT);
        if (wid == 0) {
            unsigned sp = 0u, dead = 0u;
            while ((unsigned)__builtin_amdgcn_readfirstlane((int)__hip_atomic_load(cnt + 64 * u.pm, RLX_AGENT)) < 32u) {
                __builtin_amdgcn_s_sleep(2);
                if ((++sp & 255u) == 0u) { if (__builtin_amdgcn_readfirstlane((int)__hip_atomic_load(tmo, RLX_AGENT)) != 0) { dead = 1u; break; }
                    if (sp > (1u << 22)) { if (t_ == 0) __hip_atomic_store(tmo, 1u, RLX_AGENT); dead = 1u; break; } } }
            __builtin_amdgcn_fence(__ATOMIC_ACQUIRE, "agent");
            if (t_ == 0) flag[0] = dead;
        }
        asm volatile("s_waitcnt vmcnt(0) lgkmcnt(0)" ::: "memory"); __builtin_amdgcn_s_barrier(); asm volatile("" ::: "memory");
        if (t_ < 32) { const gu32* sl = xbuf + (size_t)(u.pm * BM + row) * 4; float tot = 0.f;
#pragma unroll
            for (int q = 0; q < 4; ++q) tot += __uint_as_float(__hip_atomic_load(sl + q, RLX_AGENT));
            Sr[row] = __builtin_amdgcn_rsqf(tot * (1.f / DM) + EPS); }
        asm volatile("s_waitcnt vmcnt(0) lgkmcnt(0)" ::: "memory"); __builtin_amdgcn_s_barrier(); asm volatile("" ::: "memory");
        const float* mv = latent ? ml : mc;
#pragma unroll
        for (int bj = 0; bj < 2; ++bj) { const int col = col0 + bj * HALF;
            f32x4 wa[2], b[2];
#pragma unroll
            for (int n = 0; n < 2; ++n) { const f32x4 w = *(const f32x4*)(nw + col + 4 * n), a = *(const f32x4*)(mv + 4096 + col + 4 * n); b[n] = *(const f32x4*)(mv + 3072 + col + 4 * n); wa[n] = w * (1.0f + a); }
#pragma unroll
            for (int ai = 0; ai < 2; ++ai)
#pragma unroll
                for (int m = 0; m < 4; ++m) { const int r = ai * HALF + wr * 64 + m * 16 + fr; const float ri = Sr[r];
                    const f32x4 y0 = (acc[ai][bj][m][0] * ri) * wa[0] + b[0], y1 = (acc[ai][bj][m][1] * ri) * wa[1] + b[1];
                    v4u pk; pk.x = pk2(y0.x, y0.y); pk.y = pk2(y0.z, y0.w); pk.z = pk2(y1.x, y1.y); pk.w = pk2(y1.z, y1.w); *(v4u*)(H + (size_t)(u.pm * BM + r) * DM + col) = pk; } }
    }
};
struct EpiS {
    static constexpr bool PERM = true;
    float* S;
    __device__ __forceinline__ void operator()(const f32x4 (&acc)[2][2][4][2], const Unit& u, int wr, int wc, int, int) const {
        const int t_ = lane_now(); const int fr = t_ & 15, fq = (t_ >> 4) & 3;
        const int col0 = u.pn * BM + wc * 32 + 8 * fq;
        bf16_t* Sb = (bf16_t*)S;
#pragma unroll
        for (int ai = 0; ai < 2; ++ai)
#pragma unroll
            for (int m = 0; m < 4; ++m) { bf16_t* rowp = Sb + (size_t)(u.pm * BM + ai * HALF + wr * 64 + m * 16 + fr) * 2048 + col0;
#pragma unroll
                for (int bj = 0; bj < 2; ++bj) { const f32x4 a0 = acc[ai][bj][m][0], a1 = acc[ai][bj][m][1];
                    v4u o; o.x = pk2(a0.x, a0.y); o.y = pk2(a0.z, a0.w); o.z = pk2(a1.x, a1.y); o.w = pk2(a1.z, a1.w);
                    *(v4u*)(rowp + bj * HALF) = o; } }
    }
};
}
namespace att {
using bf16 = __hip_bfloat16;
constexpr int NW = 8, QBLK = 32, QB = 256, KVBLK = 64;
__device__ __forceinline__ int crow(int r, int hi) { return (r & 3) + 8 * (r >> 2) + 4 * hi; }
#define SBAR() __builtin_amdgcn_sched_barrier(0)
constexpr int NSLOT = 3, SLOTB = 8192;
constexpr int LDS_K = 0, LDS_V = NSLOT * SLOTB, LDS_WS = 2 * NSLOT * SLOTB, LDS_OST = LDS_WS + NW * 64 * 4, LDS_RPB = LDS_OST + NW * 8192, LDS_BYTES = LDS_RPB + 2048;
static_assert(LDS_BYTES <= RING_BYTES, "attention scratch fits the ring region");
__device__ __forceinline__ void glds16(const void* gsrc, unsigned lds_dst) { unsigned keep;
    asm volatile("s_mov_b32 %0, m0\n\ts_mov_b32 m0, %2\n\ts_nop 0\n\tglobal_load_lds_dwordx4 %1, off\n\ts_mov_b32 m0, %0" : "=&s"(keep) : "v"(gsrc), "s"(lds_dst) : "memory"); }
__device__ __forceinline__ float max3f(float a, float b, float c) { float r; asm("v_max3_f32 %0, %1, %2, %3" : "=v"(r) : "v"(a), "v"(b), "v"(c)); return r; }
__device__ __forceinline__ float max2f(float a, float b) { float r; asm("v_max_f32_e32 %0, %1, %2" : "=v"(r) : "v"(a), "v"(b)); return r; }
__device__ __forceinline__ float fadd_s(float a, float b) { float r; asm("v_add_f32_e32 %0, %1, %2" : "=v"(r) : "v"(a), "v"(b)); return r; }
__device__ __forceinline__ float fsub_s(float a, float b) { float r; asm("v_sub_f32_e32 %0, %1, %2" : "=v"(r) : "v"(a), "v"(b)); return r; }
__device__ __forceinline__ unsigned cvtpk_s(float lo, float hi) { f32x2 v = {lo, hi}; bf16x2_t b = __builtin_convertvector(v, bf16x2_t); return __builtin_bit_cast(unsigned, b); }
#define WAIT_BAR(N) asm volatile("s_waitcnt vmcnt(" #N ") lgkmcnt(0)\n\ts_barrier" ::: "memory")

__device__ __forceinline__ void qkt(f32x16& p0, f32x16& p1, const char* Kslot, const bf16x8* qr, const f32x16& negm, int r32, int hi) {
    const char* kb = Kslot + hi * 1024 + r32 * 16;
#pragma unroll
    for (int d0 = 0; d0 < 4; ++d0) {
        const bf16x8 b0 = *reinterpret_cast<const bf16x8*>(kb + d0 * 2048);
        const bf16x8 b1 = *reinterpret_cast<const bf16x8*>(kb + d0 * 2048 + 512);
        if (d0 == 0) { p0 = __builtin_amdgcn_mfma_f32_32x32x16_bf16(b0, qr[0], negm, 0, 0, 0); p1 = __builtin_amdgcn_mfma_f32_32x32x16_bf16(b1, qr[0], negm, 0, 0, 0); }
        else { p0 = __builtin_amdgcn_mfma_f32_32x32x16_bf16(b0, qr[d0], p0, 0, 0, 0); p1 = __builtin_amdgcn_mfma_f32_32x32x16_bf16(b1, qr[d0], p1, 0, 0, 0); } }
}
typedef __attribute__((address_space(3))) const char* lds_cptr;
typedef short v4i16_t __attribute__((ext_vector_type(4)));
__device__ __forceinline__ void kload8(bf16x8* kf, lds_cptr kp) {
    kf[0] = *(const __attribute__((address_space(3))) bf16x8*)(kp);        kf[1] = *(const __attribute__((address_space(3))) bf16x8*)(kp + 512);
    kf[2] = *(const __attribute__((address_space(3))) bf16x8*)(kp + 2048); kf[3] = *(const __attribute__((address_space(3))) bf16x8*)(kp + 2560);
    kf[4] = *(const __attribute__((address_space(3))) bf16x8*)(kp + 4096); kf[5] = *(const __attribute__((address_space(3))) bf16x8*)(kp + 4608);
    kf[6] = *(const __attribute__((address_space(3))) bf16x8*)(kp + 6144); kf[7] = *(const __attribute__((address_space(3))) bf16x8*)(kp + 6656);
}
__device__ __forceinline__ void kload2(bf16x8* kf, lds_cptr kp, int j) { kf[2 * j] = *(const __attribute__((address_space(3))) bf16x8*)(kp + j * 2048); kf[2 * j + 1] = *(const __attribute__((address_space(3))) bf16x8*)(kp + j * 2048 + 512); }
__device__ __forceinline__ s16x4 vtr(lds_cptr p) { return __builtin_bit_cast(s16x4, __builtin_amdgcn_ds_read_tr16_b64_v4i16((__attribute__((address_space(3))) v4i16_t*)p)); }
__device__ __forceinline__ float rowmax(const f32x16& p0, const f32x16& p1) {
    float a = max3f(p0[0], p0[1], p1[0]), b = max3f(p0[2], p0[3], p1[1]); a = max3f(a, p1[2], p1[3]);
#pragma unroll
    for (int r = 4; r < 16; r += 4) { a = max3f(a, p0[r], p0[r + 1]); b = max3f(b, p0[r + 2], p0[r + 3]); a = max3f(a, p1[r], p1[r + 1]); b = max3f(b, p1[r + 2], p1[r + 3]); }
    const float m = max2f(a, b);
    auto rr = __builtin_amdgcn_permlane32_swap(__float_as_uint(m), __float_as_uint(m), false, false);
    return max2f(__uint_as_float(rr[0]), __uint_as_float(rr[1]));
}
__device__ __forceinline__ void pv(f32x16* o, int vb, bf16x8 pa0, bf16x8 pa1, bf16x8 pa2, bf16x8 pa3) {
#pragma unroll
    for (int d0 = 0; d0 < 2; ++d0) { s16x4 lo[4], hi[4];
#pragma unroll
        for (int ks = 0; ks < 4; ++ks) {
            asm volatile("ds_read_b64_tr_b16 %0,%1 offset:%c2" : "=&v"(lo[ks]) : "v"(vb), "i"(d0 * 4096 + ks * 1024) : "memory");
            asm volatile("ds_read_b64_tr_b16 %0,%1 offset:%c2" : "=&v"(hi[ks]) : "v"(vb), "i"(d0 * 4096 + ks * 1024 + 512) : "memory"); }
        asm volatile("s_waitcnt lgkmcnt(0)" ::: "memory"); SBAR();
#define PK(k) (bf16x8){lo[k][0], lo[k][1], lo[k][2], lo[k][3], hi[k][0], hi[k][1], hi[k][2], hi[k][3]}
        o[d0] = __builtin_amdgcn_mfma_f32_32x32x16_bf16(pa0, PK(0), o[d0], 0, 0, 0);
        o[d0] = __builtin_amdgcn_mfma_f32_32x32x16_bf16(pa1, PK(1), o[d0], 0, 0, 0);
        o[d0] = __builtin_amdgcn_mfma_f32_32x32x16_bf16(pa2, PK(2), o[d0], 0, 0, 0);
        o[d0] = __builtin_amdgcn_mfma_f32_32x32x16_bf16(pa3, PK(3), o[d0], 0, 0, 0);
#undef PK
    }
}

struct AU {
    const bf16* Q; const bf16* K; const bf16* V;
    bf16* O;
    int q0, NT, kbase;
    float sinkl2;
    int emode;
    float lam, oscale; const float* subw;
};

template <int MODE> __device__ __forceinline__ void amask(f32x16& p0, f32x16& p1, int t, const AU& u, int wid, int r32, int hi, const float* rpb) {
    if constexpr (MODE == 2) {
        if (t >= 4) {
            const int kp0 = u.kbase + 64 * (t - 4) + 4 * hi, qpos = u.q0 + wid * QBLK + r32;
#pragma unroll
            for (int r = 0; r < 16; ++r) { const int kv = kp0 + (r & 3) + 8 * (r >> 2);
                const bool ok0 = ((unsigned)(kv - qpos + 128) <= 256u) && ((unsigned)kv < (unsigned)SEQ);
                const bool ok1 = ((unsigned)(kv + 32 - qpos + 128) <= 256u) && ((unsigned)(kv + 32) < (unsigned)SEQ);
                if (!ok0) p0[r] = -INFINITY; if (!ok1) p1[r] = -INFINITY; }
        }
    }
    if constexpr (MODE == 1) {
        if (t >= 4) {
            const int jr = (u.kbase >> 6) + (t - 4), qr = (u.q0 >> 6) + (wid >> 1), qc = 32 * (wid & 1) + r32;
            int rs = qr - 4; rs = rs < 0 ? 0 : (rs > 248 ? 248 : rs);
            int cs = qc - 8; cs = cs < 0 ? 0 : (cs > 48 ? 48 : cs);
            const bool rowok = (unsigned)(jr - rs) < 8u;
            int ro = jr - qr + 7; ro = ro < 0 ? 0 : (ro > 14 ? 14 : ro);
            const float* brow = rpb + ro * 32;
#pragma unroll
            for (int r = 0; r < 16; ++r) { const int kc = 4 * hi + (r & 3) + 8 * (r >> 2);
                { int bi = kc - qc + 15; bi = bi < 0 ? 0 : (bi > 30 ? 30 : bi); const bool ok = rowok && ((unsigned)(kc - cs) < 16u); p0[r] = ok ? p0[r] + brow[bi] : -INFINITY; }
                { int bi = kc + 32 - qc + 15; bi = bi < 0 ? 0 : (bi > 30 ? 30 : bi); const bool ok = rowok && ((unsigned)(kc + 32 - cs) < 16u); p1[r] = ok ? p1[r] + brow[bi] : -INFINITY; } }
        }
    }
}

template <int MODE, int THRL, int QKH = 0, int NOMAX = 0> __device__ __forceinline__ bool attn_unit(const AU& u, char* shm, int wave) {
    const int lane = lane_now(), tid = (wave << 6) | lane, r32 = lane & 31, hi = lane >> 5; const int wid = wave;
    const bf16* Qw = u.Q + (size_t)(u.q0 + wid * QBLK) * 64;
    const bf16* Kh = u.K; const bf16* Vh = u.V;
    const unsigned lds0 = (unsigned)(uintptr_t)shm;
    float* wsf = (float*)(shm + LDS_WS) + wid * 64;
    const float* rpb = (const float*)(shm + LDS_RPB);
    const int NT = u.NT;
    volatile int* okflag = (volatile int*)(shm + LDS_RPB + 2040);
    if constexpr (NOMAX) { if (tid == 0) *okflag = 0; }
#define KROW(t) ((t) < 4 ? SEQ + 64 * (t) : (u.kbase + 64 * ((t) - 4) < 0 ? 0 : (u.kbase + 64 * ((t) - 4) > SEQ - 64 ? SEQ - 64 : u.kbase + 64 * ((t) - 4))))
    const bf16* ksrc = Kh + (size_t)lane * 64 + wid * 8;
    const bf16* vsrc = Vh + (size_t)(16 * (wid & 3) + (lane >> 2)) * 64 + (wid >> 2) * 32 + (lane & 3) * 8;
    const unsigned kdst = lds0 + LDS_K + wid * 1024, vdst = lds0 + LDS_V + wid * 1024;
#define DMA_K(t, slot) glds16(ksrc + (size_t)KROW(t) * 64, (unsigned)__builtin_amdgcn_readfirstlane(kdst + (slot)))
#define DMA_V(t, slot) glds16(vsrc + (size_t)KROW(t) * 64, (unsigned)__builtin_amdgcn_readfirstlane(vdst + (slot)))
    const int vb0 = (int)(lds0 + LDS_V) + ((lane >> 4) & 1) * 32 + (lane & 3) * 8 + (4 * hi + ((lane & 15) >> 2)) * 64;
    const char* Kbase = shm + LDS_K; bf16x8 kf[8];
    const lds_cptr shm3 = (lds_cptr)shm; const lds_cptr kp0 = shm3 + LDS_K + hi * 1024 + r32 * 16; const lds_cptr vp0 = shm3 + LDS_V + ((lane >> 4) & 1) * 32 + (lane & 3) * 8 + (4 * hi + ((lane & 15) >> 2)) * 64;
    DMA_K(0, 0); DMA_V(0, 0); DMA_K(1, SLOTB);
    bf16x8 qr[4];
#pragma unroll
    for (int d0 = 0; d0 < 4; ++d0) qr[d0] = *reinterpret_cast<const bf16x8*>(&Qw[(size_t)r32 * 64 + d0 * 16 + hi * 8]);
    float mhat = 0.f, l_reg = 0.f; f32x16 o[2]; o[0] = f32x16{}; o[1] = f32x16{}; f32x16 negm = f32x16{}; asm volatile("" : "+v"(negm));
#define CMASK(P0, P1, t) amask<MODE>(P0, P1, (t), u, wid, r32, hi, rpb)
    bool resc = false;
#define START(P0, P1) do { const float rm = rowmax(P0, P1); resc = false; \
    { const float dl = rm; mhat = fadd_s(mhat, dl); \
      _Pragma("unroll") for (int r = 0; r < 16; ++r) { P0[r] = fsub_s(P0[r], dl); P1[r] = fsub_s(P1[r], dl); } \
      _Pragma("unroll") for (int r = 0; r < 16; ++r) negm[r] = -mhat; asm volatile("" : "+v"(negm)); } \
    _Pragma("unroll") for (int r = 0; r < 16; ++r) P0[r] = __builtin_amdgcn_exp2f(P0[r]); } while (0)
#define RESC() do { if (resc) { asm volatile("s_waitcnt lgkmcnt(0)" ::: "memory"); \
      _Pragma("unroll") for (int d_ = 0; d_ < 2; ++d_) _Pragma("unroll") for (int r = 0; r < 16; ++r) o[d_][r] *= wsf[crow(r, hi)]; } } while (0)
    f32x16 pA0, pA1, pB0, pB1;
    int sl_prev = 0, sl_cur = 0, sl_next = SLOTB;
#define ROT() do { sl_prev = sl_cur; sl_cur = sl_next; sl_next = (sl_next == (NSLOT - 1) * SLOTB) ? 0 : sl_next + SLOTB; } while (0)
    DMA_K(2, 2 * SLOTB);
    WAIT_BAR(3);
    qkt(pA0, pA1, Kbase, qr, negm, r32, hi); asm volatile("s_nop 15\n\ts_nop 7" : "+v"(pA0), "+v"(pA1));
    START(pA0, pA1);
    _Pragma("unroll") for (int r = 0; r < 16; ++r) pA1[r] = __builtin_amdgcn_exp2f(pA1[r]);
    WAIT_BAR(0);
    DMA_K(3, 0); DMA_V(1, SLOTB);
    ROT();
    kload8(kf, kp0 + sl_cur);
    WAIT_BAR(2);
    s16x4 vlo[8], vhi[8]; v4u pw0, pw1, pw2, pw3;
#define PKW(P, B) cvtpk_s(P[B], P[B + 1])
#define PAF(k) __builtin_bit_cast(bf16x8, pw##k)
#define VFR(i) (bf16x8){vlo[i][0], vlo[i][1], vlo[i][2], vlo[i][3], vhi[i][0], vhi[i][1], vhi[i][2], vhi[i][3]}
#define PIN(x) asm volatile("" : "+v"(x))
#define MX3(a, b, c) __builtin_fmaxf(__builtin_fmaxf((a), (b)), (c))
#define GAPA(MF, A0, A1, A2, A3, W0, W1, PW) do { MF; sacc += A0; sacc += A1; sacc += A2; sacc += A3; PIN(sacc); W0; W1; PIN(PW); SBAR(); } while (0)
#define EX(v) __builtin_amdgcn_exp2f(v)
#define GAPB(MF, X, B) do { MF; X[B] = EX(X[B]); X[B + 1] = EX(X[B + 1]); X[B + 2] = EX(X[B + 2]); X[B + 3] = EX(X[B + 3]); PIN(X); SBAR(); } while (0)
#define VRD(i) do { vlo[i] = vtr(vp_ + (((i) >> 2) * 4096 + ((i) & 3) * 1024)); vhi[i] = vtr(vp_ + (((i) >> 2) * 4096 + ((i) & 3) * 1024 + 512)); } while (0)
#define KRD(G, j) do { if constexpr (QKH == 0 || (QKH == 1 && (j) < 2) || (QKH == 2 && (j) >= 2)) { if (G) { kload2(kf, kp0 + sl_next, j); SBAR(); } } } while (0)
#define MF32(a, b, c) __builtin_amdgcn_mfma_f32_32x32x16_bf16(a, b, c, 0, 0, 0)
#define QLO(X) do { if constexpr (QKH != 2) { X; } } while (0)
#define QHI(X0, X2) do { if constexpr (QKH == 0) { X0; } else if constexpr (QKH == 2) { X2; } } while (0)
#define STEP(C0, C1, P0, P1, t, GK, GV, GL) do { SBAR(); \
    const lds_cptr vp_ = vp0 + sl_prev; \
    VRD(0); SBAR(); float sacc = (P0[0] + P0[1]); \
    GAPA(QLO(C0 = MF32(kf[0], qr[0], negm)), P0[2], P0[3], P0[4], P0[5],     pw0[0] = PKW(P0, 0), pw0[1] = PKW(P0, 2), pw0); \
    VRD(4); SBAR(); GAPA(QLO(C1 = MF32(kf[1], qr[0], negm)), P0[6], P0[7], P0[8], P0[9],     pw0[2] = PKW(P0, 4), pw0[3] = PKW(P0, 6), pw0); \
    VRD(1); SBAR(); GAPA(QLO(C0 = MF32(kf[2], qr[1], C0)), P0[10], P0[11], P0[12], P0[13], pw1[0] = PKW(P0, 8), pw1[1] = PKW(P0, 10), pw1); \
    VRD(5); SBAR(); GAPA(QLO(C1 = MF32(kf[3], qr[1], C1)), P0[14], P0[15], P1[0], P1[1],   pw1[2] = PKW(P0, 12), pw1[3] = PKW(P0, 14), pw1); \
    VRD(2); SBAR(); GAPA(QHI(C0 = MF32(kf[4], qr[2], C0), C0 = MF32(kf[4], qr[2], negm)), P1[2], P1[3], P1[4], P1[5],     pw2[0] = PKW(P1, 0), pw2[1] = PKW(P1, 2), pw2); \
    VRD(6); SBAR(); GAPA(QHI(C1 = MF32(kf[5], qr[2], C1), C1 = MF32(kf[5], qr[2], negm)), P1[6], P1[7], P1[8], P1[9],     pw2[2] = PKW(P1, 4), pw2[3] = PKW(P1, 6), pw2); \
    VRD(3); SBAR(); GAPA(QHI(C0 = MF32(kf[6], qr[3], C0), C0 = MF32(kf[6], qr[3], C0)), P1[10], P1[11], P1[12], P1[13], pw3[0] = PKW(P1, 8), pw3[1] = PKW(P1, 10), pw3); \
    VRD(7); SBAR(); GAPA(QHI(C1 = MF32(kf[7], qr[3], C1), C1 = MF32(kf[7], qr[3], C1)), P1[14], P1[15], 0.f, 0.f,       pw3[2] = PKW(P1, 12), pw3[3] = PKW(P1, 14), pw3); \
    l_reg += sacc; \
    if (GK) { DMA_K((t) + 3, sl_cur); } if (GV) { DMA_V((t) + 1, sl_next); } \
    CMASK(C0, C1, t); \
    if constexpr (NOMAX) { resc = false; } else { float a = MX3(C0[0], C0[1], C1[0]), b = MX3(C0[2], C0[3], C1[1]); a = MX3(a, C1[2], C1[3]); \
      _Pragma("unroll") for (int r = 4; r < 16; r += 4) { a = MX3(a, C0[r], C0[r + 1]); b = MX3(b, C0[r + 2], C0[r + 3]); a = MX3(a, C1[r], C1[r + 1]); b = MX3(b, C1[r + 2], C1[r + 3]); } \
      float rm = __builtin_fmaxf(a, b); { auto rr = __builtin_amdgcn_permlane32_swap(__float_as_uint(rm), __float_as_uint(rm), false, false); rm = __builtin_fmaxf(__uint_as_float(rr[0]), __uint_as_float(rr[1])); } \
      resc = false; \
      if (__builtin_expect(__any(rm > (float)THRL), 0)) { const float dl = __builtin_fmaxf(rm, 0.f); mhat += dl; \
        _Pragma("unroll") for (int r = 0; r < 16; ++r) { C0[r] -= dl; C1[r] -= dl; } \
        _Pragma("unroll") for (int r = 0; r < 16; ++r) negm[r] = -mhat; asm volatile("" : "+v"(negm)); \
        const float f = __builtin_amdgcn_exp2f(-dl); l_reg *= f; if (hi == 0) wsf[r32] = f; resc = true; } } \
    SBAR(); \
    GAPB(o[0] = __builtin_amdgcn_mfma_f32_32x32x16_bf16(PAF(0), VFR(0), o[0], 0, 0, 0), C0, 0); \
    GAPB(o[1] = __builtin_amdgcn_mfma_f32_32x32x16_bf16(PAF(0), VFR(4), o[1], 0, 0, 0), C0, 4); \
    KRD(GL, 0); GAPB(o[0] = __builtin_amdgcn_mfma_f32_32x32x16_bf16(PAF(1), VFR(1), o[0], 0, 0, 0), C0, 8); \
    KRD(GL, 1); GAPB(o[1] = __builtin_amdgcn_mfma_f32_32x32x16_bf16(PAF(1), VFR(5), o[1], 0, 0, 0), C0, 12); \
    KRD(GL, 2); GAPB(o[0] = __builtin_amdgcn_mfma_f32_32x32x16_bf16(PAF(2), VFR(2), o[0], 0, 0, 0), C1, 0); \
    KRD(GL, 3); GAPB(o[1] = __builtin_amdgcn_mfma_f32_32x32x16_bf16(PAF(2), VFR(6), o[1], 0, 0, 0), C1, 4); \
    GAPB(o[0] = __builtin_amdgcn_mfma_f32_32x32x16_bf16(PAF(3), VFR(3), o[0], 0, 0, 0), C1, 8); \
    GAPB(o[1] = __builtin_amdgcn_mfma_f32_32x32x16_bf16(PAF(3), VFR(7), o[1], 0, 0, 0), C1, 12); \
    } while (0)
    int t = 1;
    for (; t + 5 < NT; t += 2) {
        STEP(pB0, pB1, pA0, pA1, t, true, true, true);     WAIT_BAR(2); RESC(); ROT();
        STEP(pA0, pA1, pB0, pB1, t + 1, true, true, true);   WAIT_BAR(2); RESC(); ROT();
    }
#define ENDW(tt) do { if ((tt) + 3 < NT) { WAIT_BAR(2); } else if ((tt) + 2 < NT) { WAIT_BAR(1); } else { WAIT_BAR(0); } } while (0)
    for (; t + 1 < NT; t += 2) {
        STEP(pB0, pB1, pA0, pA1, t, (t + 3 < NT), (t + 1 < NT), (t + 1 < NT));       ENDW(t);   RESC(); ROT();
        STEP(pA0, pA1, pB0, pB1, t + 1, (t + 4 < NT), (t + 2 < NT), (t + 2 < NT));     ENDW(t + 1); RESC(); ROT();
    }
    STEP(pB0, pB1, pA0, pA1, NT - 1, false, false, false); RESC();
    { float sacc = pB0[0] + pB0[1]; _Pragma("unroll") for (int r = 2; r < 16; ++r) sacc += pB0[r]; _Pragma("unroll") for (int r = 0; r < 16; ++r) sacc += pB1[r]; l_reg += sacc;
      pw0 = (v4u){PKW(pB0, 0), PKW(pB0, 2), PKW(pB0, 4), PKW(pB0, 6)}; pw1 = (v4u){PKW(pB0, 8), PKW(pB0, 10), PKW(pB0, 12), PKW(pB0, 14)}; pw2 = (v4u){PKW(pB1, 0), PKW(pB1, 2), PKW(pB1, 4), PKW(pB1, 6)}; pw3 = (v4u){PKW(pB1, 8), PKW(pB1, 10), PKW(pB1, 12), PKW(pB1, 14)};
      SBAR(); pv(o, vb0 + sl_cur, PAF(0), PAF(1), PAF(2), PAF(3)); }
#undef PKW
#undef PAF
#undef VFR
#undef PIN
#undef MX3
#undef GAPA
#undef GAPB
#undef EX
#undef VRD
#undef KRD
#undef MF32
#undef QLO
#undef QHI
#undef STEP
#undef ENDW
    { auto rr = __builtin_amdgcn_permlane32_swap(__float_as_uint(l_reg), __float_as_uint(l_reg), false, false); l_reg = __uint_as_float(rr[0]) + __uint_as_float(rr[1]); }
    if constexpr (NOMAX) {
        const bool ok = (l_reg > 0x1p-90f) && (l_reg < 0x1p90f);
        if (__any(!ok)) { if (lane == 0) *okflag = 1; }
        asm volatile("s_waitcnt lgkmcnt(0)\n\ts_barrier" ::: "memory");
        const int bad = __builtin_amdgcn_readfirstlane(*okflag);
        if (bad) { asm volatile("s_waitcnt lgkmcnt(0)\n\ts_barrier" ::: "memory"); return false; }
    }
    l_reg += __builtin_amdgcn_exp2f(u.sinkl2 - mhat);
    if (hi == 0) wsf[32 + r32] = l_reg; asm volatile("s_waitcnt lgkmcnt(0)" ::: "memory");
    float rli[16];
#pragma unroll
    for (int r = 0; r < 16; ++r) rli[r] = __builtin_amdgcn_rcpf(wsf[32 + crow(r, hi)]);
    if (u.emode == 0) {
        bf16* Ow = u.O + (size_t)(u.q0 + wid * QBLK) * 1024;
        bf16* stg = (bf16*)(shm + LDS_OST + wid * 8192);
#pragma unroll
        for (int r = 0; r < 16; ++r) { const int orow = crow(r, hi);
#pragma unroll
            for (int d0 = 0; d0 < 2; ++d0) stg[orow * 64 + d0 * 32 + r32] = __float2bfloat16(o[d0][r] * rli[r]); }
        asm volatile("s_waitcnt lgkmcnt(0)" ::: "memory");
#pragma unroll
        for (int i = 0; i < 4; ++i) { const int row = i * 8 + (lane >> 3), ch = lane & 7; const v4u v = *(const v4u*)(stg + row * 64 + ch * 8); *(v4u*)(Ow + (size_t)row * 1024 + ch * 8) = v; }
    } else {
        float* stf = (float*)(shm + LDS_OST + wid * 8192);
        if (u.emode == 1) {
#pragma unroll
            for (int r = 0; r < 16; ++r) { const int orow = crow(r, hi);
#pragma unroll
                for (int d0 = 0; d0 < 2; ++d0) stf[orow * 64 + d0 * 32 + r32] = o[d0][r] * rli[r]; }
        } else {
#pragma unroll
            for (int r = 0; r < 16; ++r) { const int orow = crow(r, hi);
#pragma unroll
                for (int d0 = 0; d0 < 2; ++d0) { const float y = stf[orow * 64 + d0 * 32 + r32] - u.lam * (o[d0][r] * rli[r]); stf[orow * 64 + d0 * 32 + r32] = y; } }
            asm volatile("s_waitcnt lgkmcnt(0)" ::: "memory");
            bf16* Ow = u.O + (size_t)(u.q0 + wid * QBLK) * 1024;
#pragma unroll
            for (int i = 0; i < 4; ++i) { const int row = i * 8 + (lane >> 3), ch = lane & 7;
                const f32x4 y0 = *(const f32x4*)(stf + row * 64 + ch * 8), y1 = *(const f32x4*)(stf + row * 64 + ch * 8 + 4);
                float ss = (y0[0] * y0[0] + y0[1] * y0[1]) + (y0[2] * y0[2] + y0[3] * y0[3]) + (y1[0] * y1[0] + y1[1] * y1[1]) + (y1[2] * y1[2] + y1[3] * y1[3]);
                ss += xorf<1>(ss); ss += xorf<2>(ss); ss += xorf<4>(ss);
                const float ri = __builtin_amdgcn_rsqf(ss * (1.f / 64.f) + EPS) * u.oscale;
                const f32x4 w0 = *(const f32x4*)(u.subw + ch * 8), w1 = *(const f32x4*)(u.subw + ch * 8 + 4);
                v4u v; v.x = pk2(y0[0] * ri * w0[0], y0[1] * ri * w0[1]); v.y = pk2(y0[2] * ri * w0[2], y0[3] * ri * w0[3]); v.z = pk2(y1[0] * ri * w1[0], y1[1] * ri * w1[1]); v.w = pk2(y1[2] * ri * w1[2], y1[3] * ri * w1[3]);
                *(v4u*)(Ow + (size_t)row * 1024 + ch * 8) = v; }
        }
    }
    asm volatile("s_waitcnt lgkmcnt(0)\n\ts_barrier" ::: "memory");
    return true;
#undef DMA_K
#undef DMA_V
#undef KROW
#undef CMASK
#undef START
#undef RESC
#undef ROT
}

template <int MODE, int NOMAX = 0> __device__ __forceinline__ bool attn_simple(const AU& u, char* shm, int wave) {
    const int lane = lane_now(), tid = (wave << 6) | lane, r32 = lane & 31, hi = lane >> 5; const int wid = wave;
    const bf16* Qw = u.Q + (size_t)(u.q0 + wid * QBLK) * 64;
    const unsigned lds0 = (unsigned)(uintptr_t)shm;
    float* wsf = (float*)(shm + LDS_WS) + wid * 64;
    const float* rpb = (const float*)(shm + LDS_RPB);
    const int NT = u.NT;
    volatile int* okflag = (volatile int*)(shm + LDS_RPB + 2040);
    if constexpr (NOMAX) { if (tid == 0) *okflag = 0; }
#define KROW(t) ((t) < 4 ? SEQ + 64 * (t) : (u.kbase + 64 * ((t) - 4) < 0 ? 0 : (u.kbase + 64 * ((t) - 4) > SEQ - 64 ? SEQ - 64 : u.kbase + 64 * ((t) - 4))))
    const bf16* ksrc = u.K + (size_t)lane * 64 + wid * 8;
    const bf16* vsrc = u.V + (size_t)(16 * (wid & 3) + (lane >> 2)) * 64 + (wid >> 2) * 32 + (lane & 3) * 8;
    const unsigned kdst = lds0 + LDS_K + wid * 1024, vdst = lds0 + LDS_V + wid * 1024;
    const int vb0 = (int)(lds0 + LDS_V) + ((lane >> 4) & 1) * 32 + (lane & 3) * 8 + (4 * hi + ((lane & 15) >> 2)) * 64;
    { const int kr = KROW(0); glds16(ksrc + (size_t)kr * 64, (unsigned)__builtin_amdgcn_readfirstlane(kdst)); glds16(vsrc + (size_t)kr * 64, (unsigned)__builtin_amdgcn_readfirstlane(vdst)); }
    bf16x8 qr[4];
#pragma unroll
    for (int d0 = 0; d0 < 4; ++d0) qr[d0] = *reinterpret_cast<const bf16x8*>(&Qw[(size_t)r32 * 64 + d0 * 16 + hi * 8]);
    float m_run = -INFINITY, l_reg = 0.f; f32x16 o[2]; o[0] = f32x16{}; o[1] = f32x16{};
    const f32x16 zero = f32x16{};
#pragma unroll 1
    for (int t = 0; t < NT; ++t) {
        const int sl = (t & 1) * SLOTB;
        asm volatile("s_waitcnt vmcnt(0) lgkmcnt(0)\n\ts_barrier" ::: "memory");
        if (t + 1 < NT) { const int kr = KROW(t + 1); const int sn = ((t + 1) & 1) * SLOTB;
            glds16(ksrc + (size_t)kr * 64, (unsigned)__builtin_amdgcn_readfirstlane(kdst + sn)); glds16(vsrc + (size_t)kr * 64, (unsigned)__builtin_amdgcn_readfirstlane(vdst + sn)); }
        bool live = true;
        if (t >= 4) {
            if constexpr (MODE == 1) { const int jr = (u.kbase >> 6) + (t - 4), qr_ = (u.q0 >> 6) + (wid >> 1); int rs = qr_ - 4; rs = rs < 0 ? 0 : (rs > 248 ? 248 : rs); live = (unsigned)(jr - rs) < 8u; }
            if constexpr (MODE == 2) { const int k0 = u.kbase + 64 * (t - 4), qa = u.q0 + wid * QBLK; live = (k0 + 63 >= qa - 128) && (k0 <= qa + QBLK - 1 + 128); }
        }
        if (!live) continue;
        f32x16 p0, p1;
        qkt(p0, p1, shm + LDS_K + sl, qr, zero, r32, hi);
        amask<MODE>(p0, p1, t, u, wid, r32, hi, rpb);
        if (NOMAX && t > 0) {
            float sacc = 0.f;
#pragma unroll
            for (int r = 0; r < 16; ++r) { p0[r] = __builtin_amdgcn_exp2f(p0[r] - m_run); p1[r] = __builtin_amdgcn_exp2f(p1[r] - m_run); sacc += p0[r] + p1[r]; }
            l_reg += sacc;
        } else {
        float rm = p0[0];
#pragma unroll
        for (int r = 1; r < 16; ++r) rm = __builtin_fmaxf(rm, p0[r]);
#pragma unroll
        for (int r = 0; r < 16; ++r) rm = __builtin_fmaxf(rm, p1[r]);
        { auto rr = __builtin_amdgcn_permlane32_swap(__float_as_uint(rm), __float_as_uint(rm), false, false); rm = __builtin_fmaxf(__uint_as_float(rr[0]), __uint_as_float(rr[1])); }
        const float m_new = __builtin_fmaxf(m_run, rm);
        const float alpha = __builtin_amdgcn_exp2f(m_run - m_new); m_run = m_new;
        float sacc = 0.f;
#pragma unroll
        for (int r = 0; r < 16; ++r) { p0[r] = __builtin_amdgcn_exp2f(p0[r] - m_new); p1[r] = __builtin_amdgcn_exp2f(p1[r] - m_new); sacc += p0[r] + p1[r]; }
        l_reg = l_reg * alpha + sacc;
        if (hi == 0) wsf[r32] = alpha;
        asm volatile("s_waitcnt lgkmcnt(0)" ::: "memory");
#pragma unroll
        for (int d_ = 0; d_ < 2; ++d_)
#pragma unroll
            for (int r = 0; r < 16; ++r) o[d_][r] *= wsf[crow(r, hi)];
        }
        v4u pw0, pw1, pw2, pw3;
        pw0 = (v4u){cvtpk_s(p0[0], p0[1]), cvtpk_s(p0[2], p0[3]), cvtpk_s(p0[4], p0[5]), cvtpk_s(p0[6], p0[7])}; pw1 = (v4u){cvtpk_s(p0[8], p0[9]), cvtpk_s(p0[10], p0[11]), cvtpk_s(p0[12], p0[13]), cvtpk_s(p0[14], p0[15])};
        pw2 = (v4u){cvtpk_s(p1[0], p1[1]), cvtpk_s(p1[2], p1[3]), cvtpk_s(p1[4], p1[5]), cvtpk_s(p1[6], p1[7])}; pw3 = (v4u){cvtpk_s(p1[8], p1[9]), cvtpk_s(p1[10], p1[11]), cvtpk_s(p1[12], p1[13]), cvtpk_s(p1[14], p1[15])};
        asm volatile("s_waitcnt lgkmcnt(0)" ::: "memory"); SBAR();
        pv(o, vb0 + sl, __builtin_bit_cast(bf16x8, pw0), __builtin_bit_cast(bf16x8, pw1), __builtin_bit_cast(bf16x8, pw2), __builtin_bit_cast(bf16x8, pw3));
    }
    { auto rr = __builtin_amdgcn_permlane32_swap(__float_as_uint(l_reg), __float_as_uint(l_reg), false, false); l_reg = __uint_as_float(rr[0]) + __uint_as_float(rr[1]); }
    if constexpr (NOMAX) {
        const bool ok = (l_reg > 0x1p-90f) && (l_reg < 0x1p90f);
        if (__any(!ok)) { if (lane == 0) *okflag = 1; }
        asm volatile("s_waitcnt vmcnt(0) lgkmcnt(0)\n\ts_barrier" ::: "memory");
        const int bad = __builtin_amdgcn_readfirstlane(*okflag);
        if (bad) { asm volatile("s_waitcnt lgkmcnt(0)\n\ts_barrier" ::: "memory"); return false; }
    }
    l_reg += __builtin_amdgcn_exp2f(u.sinkl2 - m_run);
    asm volatile("s_waitcnt lgkmcnt(0)" ::: "memory");
    if (hi == 0) wsf[32 + r32] = l_reg; asm volatile("s_waitcnt lgkmcnt(0)" ::: "memory");
    float rli[16];
#pragma unroll
    for (int r = 0; r < 16; ++r) rli[r] = __builtin_amdgcn_rcpf(wsf[32 + crow(r, hi)]);
    {
        bf16* Ow = u.O + (size_t)(u.q0 + wid * QBLK) * 1024;
        bf16* stg = (bf16*)(shm + LDS_OST + wid * 8192);
#pragma unroll
        for (int r = 0; r < 16; ++r) { const int orow = crow(r, hi);
#pragma unroll
            for (int d0 = 0; d0 < 2; ++d0) stg[orow * 64 + d0 * 32 + r32] = __float2bfloat16(o[d0][r] * rli[r]); }
        asm volatile("s_waitcnt lgkmcnt(0)" ::: "memory");
#pragma unroll
        for (int i = 0; i < 4; ++i) { const int row = i * 8 + (lane >> 3), ch = lane & 7; const v4u v = *(const v4u*)(stg + row * 64 + ch * 8); *(v4u*)(Ow + (size_t)row * 1024 + ch * 8) = v; }
    }
    asm volatile("s_waitcnt vmcnt(0) lgkmcnt(0)\n\ts_barrier" ::: "memory");
    return true;
#undef KROW
}
#undef SBAR
#undef WAIT_BAR
}
struct Args { const float* in[23]; float* out; unsigned char* ws; int flags; int pad; };
enum { I_X = 0, I_C, I_CTX, I_CCTX, I_N1W, I_N2W, I_ADAW, I_ADAB, I_WIN, I_RPB, I_DLAM, I_SUBW, I_SINK, I_QKNW, I_WBR, I_WGATE, I_BGATE, I_WOUT, I_PWQ, I_PKEYS, I_PU, I_PV, I_FNW };

struct Frame {
    LAS unsigned char* lds; volatile LAS unsigned* MISC; gu32* ctl;
    int wave, vcu, G;
};
__device__ __forceinline__ int ltid(int wave) { return tid_now(wave); }

struct MapId   { __device__ __forceinline__ int operator()(int n) const { return n; } };
struct MapWin  { __device__ __forceinline__ int operator()(int n) const { return (n & ~255) + 128 * ((n >> 5) & 1) + 32 * ((n >> 6) & 3) + (n & 31); } };
struct MapGate { __device__ __forceinline__ int operator()(int n) const { const int br = n >> 10, ch = n & 1023; return 256 * (ch >> 6) + 128 * (br >> 1) + 32 * ((ch >> 4) & 3) + 16 * (br & 1) + (ch & 15); } };
template <class Map, bool F8 = false> __device__ __forceinline__ void transpose_item(const float* W, int K, int N, void* WTv, Map mp, LAS float* scr, int item, int lane) {
    bf16_t* WT = (bf16_t*)WTv; unsigned char* WT8 = (unsigned char*)WTv;
    const int nblk = N / 32, kb = item / nblk, nb = item % nblk, k0 = 64 * kb, n0 = 32 * nb;
#pragma unroll 8
    for (int i = 0; i < 32; ++i) { const int kk = 2 * i + (lane >> 5); scr[kk * 33 + (lane & 31)] = W[(size_t)(k0 + kk) * N + n0 + (lane & 31)]; }
    LDS_WAIT(); asm volatile("" ::: "memory");
    const int c = lane & 7;
#pragma unroll
    for (int j = 0; j < 4; ++j) { const int n = (lane >> 3) + 8 * j; const LAS float* s = scr + (8 * c) * 33 + n;
        int nn = n0 + n; asm volatile("" : "+v"(nn));
        if constexpr (F8) { v2u o; o.x = pk4_fp8(s[0 * 33] * 64.f, s[1 * 33] * 64.f, s[2 * 33] * 64.f, s[3 * 33] * 64.f); o.y = pk4_fp8(s[4 * 33] * 64.f, s[5 * 33] * 64.f, s[6 * 33] * 64.f, s[7 * 33] * 64.f);
            *(GAS v2u*)(WT8 + (size_t)mp(nn) * K + k0 + 8 * c) = o; }
        else { v4u o; o.x = pk2(s[0 * 33], s[1 * 33]); o.y = pk2(s[2 * 33], s[3 * 33]); o.z = pk2(s[4 * 33], s[5 * 33]); o.w = pk2(s[6 * 33], s[7 * 33]);
            *(GAS v4u*)(WT + (size_t)mp(nn) * K + k0 + 8 * c) = o; } }
    LDS_WAIT(); asm volatile("" ::: "memory");
}
__device__ __forceinline__ void modnorm_row(const float* xrow, bf16_t* orow, const float* nw, const float* sh, const float* sc, int lane, unsigned char* o8row = nullptr) {
    const GAS f32x4* xr = (const GAS f32x4*)xrow + lane;
    f32x4 v[4]; float s = 0.f;
#pragma unroll
    for (int j = 0; j < 4; ++j) { v[j] = xr[64 * j]; s += (v[j].x * v[j].x + v[j].y * v[j].y) + (v[j].z * v[j].z + v[j].w * v[j].w); }
    const float ri = __builtin_amdgcn_rsqf(wave_sum(s) * (1.f / DM) + EPS);
    GAS v2u* o8 = (GAS v2u*)orow + lane;
#pragma unroll
    for (int j = 0; j < 4; ++j) { const int col = 256 * j + 4 * lane; const f32x4 w = *(const f32x4*)(nw + col), a = *(const f32x4*)(sc + col), b = *(const f32x4*)(sh + col);
        const f32x4 y = (v[j] * ri * w) * (1.0f + a) + b;
        if (orow) { v2u p; p.x = pk2(y.x, y.y); p.y = pk2(y.z, y.w); o8[64 * j] = p; }
        if (o8row) ((GAS unsigned*)o8row)[64 * j + lane] = pk4_fp8(y.x, y.y, y.z, y.w); }
}

__device__ __forceinline__ void ce_desc(float& a, float& b) { const float hi = __builtin_fmaxf(a, b), lo = __builtin_fminf(a, b); a = hi; b = lo; }
__device__ __forceinline__ void sort16_desc(float (&x)[16]) {
#pragma unroll
    for (int k = 2; k <= 16; k <<= 1)
#pragma unroll
        for (int j = k >> 1; j > 0; j >>= 1)
#pragma unroll
            for (int i = 0; i < 16; ++i) { const int l = i ^ j; if (l > i) { if ((i & k) == 0) ce_desc(x[i], x[l]); else ce_desc(x[l], x[i]); } }
}
__device__ __forceinline__ void merge16_desc(float (&top)[16], const float (&c)[16]) {
#pragma unroll
    for (int i = 0; i < 16; ++i) top[i] = __builtin_fmaxf(top[i], c[15 - i]);
#pragma unroll
    for (int j = 8; j > 0; j >>= 1)
#pragma unroll
        for (int i = 0; i < 16; ++i) { const int l = i ^ j; if (l > i) ce_desc(top[i], top[l]); }
}

struct PeerArgs { unsigned char* H8out_xq; unsigned char* H8out; const float* S; const bf16_t* Hin; const unsigned char* U; const unsigned char* V; const float* SU; const float* SV; const float* Xin; float* Xout;
                  const float* g2l; const float* g2c;
                  bf16_t* Hout; const float* nwn; const float* shl; const float* scl; const float* shc; const float* scc;
                  float* fout; const float* fnw;
                  int nblocks; int* dbg_eid; float* dbg_gt; bool dry; int route_reps; };
struct PeerBufs;
constexpr int PL_LISTS = 0, PL_EID = 40960, PL_GT = PL_EID + 16384;
__device__ __forceinline__ float dot2bf(unsigned a, unsigned b, float acc) { return __builtin_amdgcn_fdot2_f32_bf16(__builtin_bit_cast(bf16x2_t, a), __builtin_bit_cast(bf16x2_t, b), acc, false); }
__device__ __forceinline__ float dot8(const v4u a, const v4u b, float acc) {
    const unsigned a0 = a.x, a1 = a.y, a2 = a.z, a3 = a.w, b0 = b.x, b1 = b.y, b2 = b.z, b3 = b.w;
    acc = dot2bf(a0, b0, acc); acc = dot2bf(a1, b1, acc); acc = dot2bf(a2, b2, acc); acc = dot2bf(a3, b3, acc);
    return acc;
}
struct PeerBufs { int* eid; float* gt; float* a; unsigned char* xq; float* sx; };
__device__ __forceinline__ void peer_route(Frame& F, const PeerArgs& P, const PeerBufs& B) {
    const int tid = ltid(F.wave), lane = tid & 63;
    LAS unsigned* lists = (LAS unsigned*)(F.lds + PL_LISTS);
    LAS int* eid = (LAS int*)(F.lds + PL_EID);
    LAS float* gt = (LAS float*)(F.lds + PL_GT);
    for (int blk = F.vcu; blk < P.nblocks; blk += F.G) {
        const int row0 = blk * 32;
        {
            const int tok = tid >> 4, lst = tid & 15;
            const float* sp = P.S + (size_t)(row0 + tok) * 2048 + lst * 128;
            float top[16];
#pragma unroll 1
            for (int c = 0; c < 8; ++c) {
                float x[16];
#pragma unroll
                for (int q = 0; q < 4; ++q) { const f32x4 v = *(const f32x4*)(sp + c * 16 + q * 4);
#pragma unroll
                    for (int j = 0; j < 4; ++j) x[q * 4 + j] = __uint_as_float((__float_as_uint(v[j]) & ~127u) | (unsigned)(c * 16 + q * 4 + j)); }
                sort16_desc(x);
                if (c == 0) {
#pragma unroll
                    for (int i = 0; i < 16; ++i) top[i] = x[i];
                } else merge16_desc(top, x);
            }
            LAS unsigned* lp = lists + tid * 20;
#pragma unroll
            for (int q = 0; q < 4; ++q) *(LAS v4u*)(lp + q * 4) = (v4u){__float_as_uint(top[q * 4]), __float_as_uint(top[q * 4 + 1]), __float_as_uint(top[q * 4 + 2]), __float_as_uint(top[q * 4 + 3])};
        }
        __syncthreads();
        if (tid < 256) {
            const int tok = tid >> 3, hd = tid & 7;
            const LAS unsigned* la = lists + (tok * 16 + 2 * hd) * 20; const LAS unsigned* lb = la + 20;
            float av[16], bv[16];
#pragma unroll
            for (int q = 0; q < 4; ++q) { const v4u a = *(const LAS v4u*)(la + q * 4), b = *(const LAS v4u*)(lb + q * 4);
#pragma unroll
                for (int j = 0; j < 4; ++j) { av[q * 4 + j] = __uint_as_float(a[j] & ~127u); bv[q * 4 + j] = __uint_as_float(b[j] & ~127u); } }
            float c0[16], c1[16], c2[16], c3[16];
#pragma unroll
            for (int i = 0; i < 16; ++i) { c0[i] = -INFINITY; c1[i] = -INFINITY; c2[i] = -INFINITY; c3[i] = -INFINITY; }
            {
                int cnt = 0;
#pragma unroll
                for (int i = 0; i < 16; ++i)
#pragma unroll
                    for (int j = 0; j < 16; ++j) if ((i + 1) * (j + 1) <= 16) {
                        const float sm = __uint_as_float((__float_as_uint(av[i] + bv[j]) & ~255u) | (unsigned)(i * 16 + j));
                        const int slot = cnt & 15, arr = cnt >> 4;
                        if (arr == 0) c0[slot] = sm; else if (arr == 1) c1[slot] = sm; else if (arr == 2) c2[slot] = sm; else c3[slot] = sm;
                        ++cnt;
                    }
            }
            sort16_desc(c0); sort16_desc(c1); sort16_desc(c2); sort16_desc(c3);
            merge16_desc(c0, c1); merge16_desc(c0, c2); merge16_desc(c0, c3);
            float ev[16], sum = 0.f; const float m0 = __uint_as_float(__float_as_uint(c0[0]) & ~255u);
#pragma unroll
            for (int k = 0; k < 16; ++k) { ev[k] = fast_exp2((__uint_as_float(__float_as_uint(c0[k]) & ~255u) - m0) * LOG2E); sum += ev[k]; }
            const float rs = 1.0f / sum;
#pragma unroll
            for (int k = 0; k < 16; ++k) { const unsigned code = __float_as_uint(c0[k]) & 255u;
                const int ia = (int)(la[code >> 4] & 127u), ib = (int)(lb[code & 15u] & 127u);
                eid[tok * 128 + hd * 16 + k] = ia * NKEYS + ib; gt[tok * 128 + hd * 16 + k] = ev[k] * rs; }
        }
        __syncthreads();
#pragma unroll
        for (int i = 0; i < 8; ++i) { const int idx = i * NTHREADS + tid; B.eid[(size_t)row0 * 128 + idx] = eid[idx]; B.gt[(size_t)row0 * 128 + idx] = gt[idx]; }
#pragma unroll 1
        for (int tk = 0; tk < 4; ++tk) {
            const size_t row = (size_t)(row0 + F.wave * 4 + tk);
            const bf16_t* hp = P.Hin + row * DM + 16 * lane;
            const v4u h0 = *(const v4u*)hp, h1 = *(const v4u*)(hp + 8);
            float xf[16];
#pragma unroll
            for (int q = 0; q < 4; ++q) { xf[2 * q] = bflo(h0[q]); xf[2 * q + 1] = bfhi(h0[q]); xf[8 + 2 * q] = bflo(h1[q]); xf[8 + 2 * q + 1] = bfhi(h1[q]); }
            float am = 0.f;
#pragma unroll
            for (int i = 0; i < 16; ++i) am = __builtin_fmaxf(am, __builtin_fabsf(xf[i]));
            am = wave_max(am);
            const float ix = am > 0.f ? 127.f / am : 0.f;
            v4u xq;
#pragma unroll
            for (int q = 0; q < 4; ++q) { unsigned w = 0;
#pragma unroll
                for (int j = 0; j < 4; ++j) { const int v = (int)__builtin_rintf(xf[4 * q + j] * ix); w |= (unsigned)(v & 0xff) << (8 * j); }
                xq[q] = w; }
            *(v4u*)(B.xq + row * DM + 16 * lane) = xq;
            if (lane == 0) B.sx[row] = am * (1.f / 127.f);
        }
        __syncthreads();
    }
}
__device__ __forceinline__ int wave_isum(int v) {
    v += __builtin_amdgcn_update_dpp(0, v, 0xB1, 0xf, 0xf, false);
    v += __builtin_amdgcn_update_dpp(0, v, 0x4E, 0xf, 0xf, false);
    v += __builtin_amdgcn_update_dpp(0, v, 0x141, 0xf, 0xf, false);
    v += __builtin_amdgcn_update_dpp(0, v, 0x140, 0xf, 0xf, false);
    v += __builtin_amdgcn_update_dpp(0, v, 0x142, 0xa, 0xf, false);
    v += __builtin_amdgcn_update_dpp(0, v, 0x143, 0xc, 0xf, false);
    return __builtin_amdgcn_readlane(v, 63);
}
__device__ __forceinline__ int bperm_i(int v, int srclane) { return __builtin_amdgcn_ds_bpermute(srclane << 2, v); }
__device__ __forceinline__ float bperm_f(float v, int srclane) { return __builtin_bit_cast(float, __builtin_amdgcn_ds_bpermute(srclane << 2, __builtin_bit_cast(int, v))); }
__device__ __forceinline__ int treduce16(const int (&d)[16], int lane) {
    int s8[8], s4[4], s2[2];
#pragma unroll
    for (int i = 0; i < 8; ++i) { auto r = __builtin_amdgcn_permlane32_swap((unsigned)d[i], (unsigned)d[i + 8], false, false); s8[i] = (int)r[0] + (int)r[1]; }
#pragma unroll
    for (int i = 0; i < 4; ++i) { auto r = __builtin_amdgcn_permlane16_swap((unsigned)s8[i], (unsigned)s8[i + 4], false, false); s4[i] = (int)r[0] + (int)r[1]; }
    const bool b3 = (lane & 8) != 0, b2 = (lane & 4) != 0;
#pragma unroll
    for (int i = 0; i < 2; ++i) { const int keep = b3 ? s4[i + 2] : s4[i], send = b3 ? s4[i] : s4[i + 2]; s2[i] = keep + __builtin_amdgcn_update_dpp(0, send, 0x128, 0xf, 0xf, false); }
    int z; { const int keep = b2 ? s2[1] : s2[0], send = b2 ? s2[0] : s2[1]; z = keep + __builtin_amdgcn_ds_swizzle(send, 0x101F); }
    z += __builtin_amdgcn_update_dpp(0, z, 0x4E, 0xf, 0xf, false);
    z += __builtin_amdgcn_update_dpp(0, z, 0xB1, 0xf, 0xf, false);
    return z;
}
__device__ __forceinline__ void peer_u(Frame& F, const PeerArgs& P, const PeerBufs& B, int ntok) {
    const int lane = ltid(F.wave) & 63;
    const int nsl = 8, wps = (F.G / nsl) * NWAVES;
    const int j = F.vcu / (F.G / nsl), wsl = (F.vcu % (F.G / nsl)) * NWAVES + F.wave;
    const int esel = (lane >> 2) & 15;
    int t = wsl; if (t >= ntok) return;
    int e_lo = B.eid[(size_t)t * 128 + lane], e_hi = B.eid[(size_t)t * 128 + 64 + lane];
    float g_lo = B.gt[(size_t)t * 128 + lane], g_hi = B.gt[(size_t)t * 128 + 64 + lane];
    v4u xq = *(const v4u*)(B.xq + (size_t)t * DM + 16 * lane); float sx = B.sx[t];
    for (;;) {
        const int tn = t + wps; const bool more = tn < ntok; const int tp = more ? tn : t;
        const int ne_lo = B.eid[(size_t)tp * 128 + lane], ne_hi = B.eid[(size_t)tp * 128 + 64 + lane];
        const float ng_lo = B.gt[(size_t)tp * 128 + lane], ng_hi = B.gt[(size_t)tp * 128 + 64 + lane];
        const v4u nxq = *(const v4u*)(B.xq + (size_t)tp * DM + 16 * lane); const float nsx = B.sx[tp];
        unsigned long long m_lo = __ballot((e_lo >> 11) == j), m_hi = __ballot((e_hi >> 11) == j);
        const int n = __popcll(m_lo) + __popcll(m_hi);
        v4u ua[32]; int slotv0 = -1, idv0 = 0, slotv1 = -1, idv1 = 0;
#pragma unroll
        for (int q = 0; q < 32; ++q) {
            ua[q] = (v4u){0u, 0u, 0u, 0u};
            if (q < n) {
                int k, id;
                if (m_lo) { k = __builtin_ctzll(m_lo); m_lo &= m_lo - 1; id = __builtin_amdgcn_readlane(e_lo, k); }
                else { k = __builtin_ctzll(m_hi); m_hi &= m_hi - 1; id = __builtin_amdgcn_readlane(e_hi, k); k += 64; }
                ua[q] = *(const v4u*)(P.U + (size_t)id * DM + 16 * lane);
                if (q < 16) { if (esel == q) { slotv0 = k; idv0 = id; } } else { if (esel == q - 16) { slotv1 = k; idv1 = id; } }
            }
        }
        const float su0 = P.SU[idv0], sv0 = P.SV[idv0], su1 = P.SU[idv1], sv1 = P.SV[idv1];
        const float gl0 = bperm_f(g_lo, slotv0 & 63), gh0 = bperm_f(g_hi, slotv0 & 63), gl1 = bperm_f(g_lo, slotv1 & 63), gh1 = bperm_f(g_hi, slotv1 & 63);
        const float gg0 = slotv0 < 64 ? gl0 : gh0, gg1 = slotv1 < 64 ? gl1 : gh1;
        int d[16];
#pragma unroll
        for (int q = 0; q < 16; ++q) { int di = __builtin_amdgcn_sdot4((int)ua[q][0], (int)xq[0], 0, false); di = __builtin_amdgcn_sdot4((int)ua[q][1], (int)xq[1], di, false);
            di = __builtin_amdgcn_sdot4((int)ua[q][2], (int)xq[2], di, false); d[q] = __builtin_amdgcn_sdot4((int)ua[q][3], (int)xq[3], di, false); }
        { const int z = treduce16(d, lane);
          if (slotv0 >= 0 && (lane & 3) == 0) B.a[(size_t)t * 128 + slotv0] = gg0 * gelu_tanh((float)z * su0 * sx) * sv0; }
        if (n > 16) {
#pragma unroll
            for (int q = 0; q < 16; ++q) { int di = __builtin_amdgcn_sdot4((int)ua[16 + q][0], (int)xq[0], 0, false); di = __builtin_amdgcn_sdot4((int)ua[16 + q][1], (int)xq[1], di, false);
                di = __builtin_amdgcn_sdot4((int)ua[16 + q][2], (int)xq[2], di, false); d[q] = __builtin_amdgcn_sdot4((int)ua[16 + q][3], (int)xq[3], di, false); }
            const int z = treduce16(d, lane);
            if (slotv1 >= 0 && (lane & 3) == 0) B.a[(size_t)t * 128 + slotv1] = gg1 * gelu_tanh((float)z * su1 * sx) * sv1;
        }
        if (n > 32) {
            while (m_lo | m_hi) { int k, id;
                if (m_lo) { k = __builtin_ctzll(m_lo); m_lo &= m_lo - 1; id = __builtin_amdgcn_readlane(e_lo, k); }
                else { k = __builtin_ctzll(m_hi); m_hi &= m_hi - 1; id = __builtin_amdgcn_readlane(e_hi, k); k += 64; }
                const v4u u1 = *(const v4u*)(P.U + (size_t)id * DM + 16 * lane);
                int di = __builtin_amdgcn_sdot4((int)u1[0], (int)xq[0], 0, false); di = __builtin_amdgcn_sdot4((int)u1[1], (int)xq[1], di, false);
                di = __builtin_amdgcn_sdot4((int)u1[2], (int)xq[2], di, false); di = __builtin_amdgcn_sdot4((int)u1[3], (int)xq[3], di, false);
                const int tot = wave_isum(di);
                const float g = __uint_as_float(k < 64 ? __builtin_amdgcn_readlane(__float_as_uint(g_lo), k) : __builtin_amdgcn_readlane(__float_as_uint(g_hi), k - 64));
                if (lane == 0) B.a[(size_t)t * 128 + k] = g * gelu_tanh((float)tot * P.SU[id] * sx) * P.SV[id]; }
        }
        if (!more) break;
        t = tn; e_lo = ne_lo; e_hi = ne_hi; g_lo = ng_lo; g_hi = ng_hi; xq = nxq; sx = nsx;
    }
}
__device__ __forceinline__ void peer_v(Frame& F, const PeerArgs& P, const PeerBufs& B, int ntok) {
    const int lane = ltid(F.wave) & 63;
    const int nsl = 8, wps = (F.G / nsl) * NWAVES;
    const int j = F.vcu / (F.G / nsl), wsl = (F.vcu % (F.G / nsl)) * NWAVES + F.wave;
    const int grp = lane >> 3, ch = lane & 7;
    int t = wsl; if (t >= ntok) return;
#define PV_HDR(tt, EL, EH, CL, CH) do { EL = B.eid[(size_t)(tt) * 128 + lane]; EH = B.eid[(size_t)(tt) * 128 + 64 + lane]; CL = B.a[(size_t)(tt) * 128 + lane]; CH = B.a[(size_t)(tt) * 128 + 64 + lane]; } while (0)
#define PV_ROWS(W, CF, EL, EH, CL, CH) do { _Pragma("unroll") for (int i = 0; i < 16; ++i) { const int src = (8 * i + grp) & 63; const int id = bperm_i(i < 8 ? EL : EH, src); CF[i] = bperm_f(i < 8 ? CL : CH, src); \
            W[i] = *(const v4u*)(P.V + (size_t)id * DM + 128 * j + 16 * ch); } } while (0)
    int e_lo, e_hi, ne_lo, ne_hi; float c_lo, c_hi, nc_lo, nc_hi;
    v4u wA[16], wB[16]; float cfA[16], cfB[16];
    PV_HDR(t, e_lo, e_hi, c_lo, c_hi);
    { const int t1 = (t + wps < ntok) ? t + wps : t; PV_HDR(t1, ne_lo, ne_hi, nc_lo, nc_hi); }
    PV_ROWS(wA, cfA, e_lo, e_hi, c_lo, c_hi);
#define PV_STEP(W, CF, WN, CFN) do { \
        const int tn = t + wps; const bool more = tn < ntok; \
        if (more) { PV_ROWS(WN, CFN, ne_lo, ne_hi, nc_lo, nc_hi); const int t2 = (tn + wps < ntok) ? tn + wps : tn; PV_HDR(t2, ne_lo, ne_hi, nc_lo, nc_hi); } \
        float acc[16]; float asum = 0.f; \
        _Pragma("unroll") for (int c = 0; c < 16; ++c) acc[c] = 0.f; \
        _Pragma("unroll") for (int i = 0; i < 16; ++i) { asum += CF[i]; const f32x2 cf2 = {CF[i], CF[i]}; \
            _Pragma("unroll") for (int q = 0; q < 4; ++q) { const unsigned x = W[i][q]; \
                const f32x2 v01 = {(float)(x & 0xffu), (float)((x >> 8) & 0xffu)}, v23 = {(float)((x >> 16) & 0xffu), (float)(x >> 24)}; \
                f32x2 o01 = {acc[4 * q], acc[4 * q + 1]}, o23 = {acc[4 * q + 2], acc[4 * q + 3]}; \
                o01 = __builtin_elementwise_fma(cf2, v01, o01); o23 = __builtin_elementwise_fma(cf2, v23, o23); \
                acc[4 * q] = o01.x; acc[4 * q + 1] = o01.y; acc[4 * q + 2] = o23.x; acc[4 * q + 3] = o23.y; } } \
        asum += __builtin_bit_cast(float, __builtin_amdgcn_update_dpp(0, __builtin_bit_cast(int, asum), 0x128, 0xf, 0xf, false)); asum += xorf<16>(asum); asum = x32_sum(asum); \
        _Pragma("unroll") for (int c = 0; c < 16; ++c) { acc[c] += __builtin_bit_cast(float, __builtin_amdgcn_update_dpp(0, __builtin_bit_cast(int, acc[c]), 0x128, 0xf, 0xf, false)); acc[c] += xorf<16>(acc[c]); acc[c] = x32_sum(acc[c]); } \
        if (lane < 8) { \
            const int col0 = 128 * j + 16 * lane; const float* g2 = (t < SEQ) ? P.g2l : P.g2c; \
            _Pragma("unroll") for (int q = 0; q < 4; ++q) { const f32x4 xo = *(const f32x4*)(P.Xin + (size_t)t * DM + col0 + 4 * q), g = *(const f32x4*)(g2 + col0 + 4 * q); \
                f32x4 y; y.x = xo.x + g.x * (acc[4 * q] - 128.f * asum); y.y = xo.y + g.y * (acc[4 * q + 1] - 128.f * asum); y.z = xo.z + g.z * (acc[4 * q + 2] - 128.f * asum); y.w = xo.w + g.w * (acc[4 * q + 3] - 128.f * asum); \
                *(f32x4*)(P.Xout + (size_t)t * DM + col0 + 4 * q) = y; } \
        } \
        done = !more; t = tn; } while (0)
    bool done = false;
    for (;;) {
        PV_STEP(wA, cfA, wB, cfB); if (done) break;
        PV_STEP(wB, cfB, wA, cfA); if (done) break;
    }
#undef PV_HDR
#undef PV_ROWS
#undef PV_STEP
}
__device__ __forceinline__ void peer_norm(Frame& F, const PeerArgs& P, int ntok) {
    const int lane = ltid(F.wave) & 63; const int gw = F.vcu * NWAVES + F.wave, NGW = F.G * NWAVES;
    for (int t = gw; t < ntok; t += NGW) {
        const bool latent = t < SEQ;
        if (P.fout) {
            const GAS f32x4* xr = (const GAS f32x4*)(P.Xout + (size_t)t * DM) + lane; f32x4 v[4]; float s = 0.f;
#pragma unroll
            for (int q = 0; q < 4; ++q) { v[q] = xr[64 * q]; s += (v[q].x * v[q].x + v[q].y * v[q].y) + (v[q].z * v[q].z + v[q].w * v[q].w); }
            const float ri = __builtin_amdgcn_rsqf(wave_sum(s) * (1.f / DM) + EPS);
#pragma unroll
            for (int q = 0; q < 4; ++q) { const f32x4 w = *(const f32x4*)(P.fnw + 256 * q + 4 * lane); *(f32x4*)(P.fout + (size_t)t * DM + 256 * q + 4 * lane) = v[q] * ri * w; }
        } else modnorm_row(P.Xout + (size_t)t * DM, P.Hout ? P.Hout + (size_t)t * DM : (bf16_t*)nullptr, P.nwn, latent ? P.shl : P.shc, latent ? P.scl : P.scc, lane, P.H8out ? P.H8out + (size_t)t * DM : (unsigned char*)nullptr);
    }
}

constexpr int P2_Y = 0;
constexpr int P2_EID = 73728, P2_GT = P2_EID + 72 * 128 * 2, P2_SX = P2_GT + 72 * 128 * 4, P2_END = P2_SX + 72 * 4;
static_assert(P2_END <= RING_BYTES, "peer2 LDS map");
template <int NTK> __device__ __forceinline__ void peer2_tokens(Frame& F, const PeerArgs& P, int t_begin, int lt0, int cnt, int lane_in) {
    int lane = lane_in; asm volatile("" : "+v"(lane));
    const LAS unsigned short* eidL = (const LAS unsigned short*)(F.lds + P2_EID); LAS float* gtL = (LAS float*)(F.lds + P2_GT); const LAS float* sxL = (const LAS float*)(F.lds + P2_SX);
#define g (lane >> 3)
#define c (lane & 7)
    const unsigned char* xqb = P.H8out_xq;
    int d[NTK][16];
#pragma unroll
    for (int tk = 0; tk < NTK; ++tk)
#pragma unroll
        for (int i = 0; i < 16; ++i) d[tk][i] = 0;
#pragma unroll 1
    for (int ps = 0; ps < 8; ++ps) {
#pragma unroll
        for (int tk = 0; tk < NTK; ++tk) {
            if (tk < cnt) {
                const int lt = lt0 + tk; const unsigned row = (unsigned)(t_begin + lt);
                const v4u xq = *(const v4u*)(xqb + (unsigned)(row * DM + 128 * ps + 16 * c));
                v4u ua[16];
#pragma unroll
                for (int i = 0; i < 16; ++i) { const int id = eidL[lt * 128 + 8 * i + g]; ua[i] = *(const v4u*)(P.U + (unsigned)((ps * NEXP + id) * 128 + 16 * c)); }
#pragma unroll
                for (int i = 0; i < 16; ++i) { int di = __builtin_amdgcn_sdot4((int)ua[i][0], (int)xq[0], d[tk][i], false); di = __builtin_amdgcn_sdot4((int)ua[i][1], (int)xq[1], di, false);
                    di = __builtin_amdgcn_sdot4((int)ua[i][2], (int)xq[2], di, false); d[tk][i] = __builtin_amdgcn_sdot4((int)ua[i][3], (int)xq[3], di, false); }
                __builtin_amdgcn_sched_barrier(0);
            }
        }
    }
    asm volatile("" : "+v"(lane));
#pragma unroll
    for (int tk = 0; tk < NTK; ++tk) {
        if (tk < cnt) {
            const int lt = lt0 + tk; const float sx = sxL[lt];
            int mine0 = 0, mine1 = 0;
#pragma unroll
            for (int i = 0; i < 16; ++i) { int v = d[tk][i];
                v += __builtin_amdgcn_update_dpp(0, v, 0xB1, 0xf, 0xf, false); v += __builtin_amdgcn_update_dpp(0, v, 0x4E, 0xf, 0xf, false); v += __builtin_amdgcn_update_dpp(0, v, 0x141, 0xf, 0xf, false);
                if ((i & 7) == c) { if (i < 8) mine0 = v; else mine1 = v; } }
#pragma unroll
            for (int hf = 0; hf < 2; ++hf) { const int e = 8 * (8 * hf + c) + g; const int id = eidL[lt * 128 + e];
                const f32x2 suv = ((const f32x2*)P.SU)[id];
                const float pre = (float)(hf ? mine1 : mine0) * (suv.x * sx);
                gtL[lt * 128 + e] = gtL[lt * 128 + e] * gelu_tanh(pre) * suv.y; }
        }
    }
    LDS_WAIT();
    asm volatile("" : "+v"(lane));
    LAS unsigned char* yL = F.lds + P2_Y + F.wave * (4 * 2048);
#pragma unroll 1
    for (int ps = 0; ps < 8; ++ps) {
#pragma unroll
        for (int tk = 0; tk < NTK; ++tk) {
            if (tk < cnt) {
                const int lt = lt0 + tk; const unsigned row = (unsigned)(t_begin + lt);
                v4u w[16]; float cf[16];
#pragma unroll
                for (int i = 0; i < 16; ++i) { const int id = eidL[lt * 128 + 8 * i + g]; cf[i] = gtL[lt * 128 + 8 * i + g]; w[i] = *(const v4u*)(P.V + (unsigned)((ps * NEXP + id) * 128 + 16 * c)); }
                float acc[16]; float asum = 0.f;
#pragma unroll
                for (int q = 0; q < 16; ++q) acc[q] = 0.f;
#pragma unroll
                for (int i = 0; i < 16; ++i) { asum += cf[i]; const f32x2 cf2 = {cf[i], cf[i]};
#pragma unroll
                    for (int q = 0; q < 4; ++q) { const unsigned x = w[i][q];
                        const f32x2 v01 = {(float)(x & 0xffu), (float)((x >> 8) & 0xffu)}, v23 = {(float)((x >> 16) & 0xffu), (float)(x >> 24)};
                        f32x2 o01 = {acc[4 * q], acc[4 * q + 1]}, o23 = {acc[4 * q + 2], acc[4 * q + 3]};
                        o01 = __builtin_elementwise_fma(cf2, v01, o01); o23 = __builtin_elementwise_fma(cf2, v23, o23);
                        acc[4 * q] = o01.x; acc[4 * q + 1] = o01.y; acc[4 * q + 2] = o23.x; acc[4 * q + 3] = o23.y; } }
                asum += __builtin_bit_cast(float, __builtin_amdgcn_update_dpp(0, __builtin_bit_cast(int, asum), 0x128, 0xf, 0xf, false)); asum += xorf<16>(asum); asum = x32_sum(asum);
#pragma unroll
                for (int q = 0; q < 16; ++q) { acc[q] += __builtin_bit_cast(float, __builtin_amdgcn_update_dpp(0, __builtin_bit_cast(int, acc[q]), 0x128, 0xf, 0xf, false)); acc[q] += xorf<16>(acc[q]); acc[q] = x32_sum(acc[q]); }
                if (lane < 8) {
                    v4u y0, y1;
                    y0.x = pk2(acc[0] - 128.f * asum, acc[1] - 128.f * asum); y0.y = pk2(acc[2] - 128.f * asum, acc[3] - 128.f * asum); y0.z = pk2(acc[4] - 128.f * asum, acc[5] - 128.f * asum); y0.w = pk2(acc[6] - 128.f * asum, acc[7] - 128.f * asum);
                    y1.x = pk2(acc[8] - 128.f * asum, acc[9] - 128.f * asum); y1.y = pk2(acc[10] - 128.f * asum, acc[11] - 128.f * asum); y1.z = pk2(acc[12] - 128.f * asum, acc[13] - 128.f * asum); y1.w = pk2(acc[14] - 128.f * asum, acc[15] - 128.f * asum);
                    LAS v4u* yp = (LAS v4u*)(yL + tk * 2048 + (128 * ps + 16 * lane) * 2); yp[0] = y0; yp[1] = y1;
                }
                __builtin_amdgcn_sched_barrier(0);
            }
        }
    }
    asm volatile("" : "+v"(lane));
    LDS_WAIT();
#pragma unroll
    for (int tk = 0; tk < NTK; ++tk) {
        if (tk < cnt) {
            const int lt = lt0 + tk; const unsigned row = (unsigned)(t_begin + lt); const bool latent = row < (unsigned)SEQ;
            const float* g2 = latent ? P.g2l : P.g2c;
            f32x4 xn[4]; float ss = 0.f;
#pragma unroll
            for (int q = 0; q < 4; ++q) { const unsigned col = 256 * q + 4 * lane; const f32x4 xo = __builtin_nontemporal_load((const f32x4*)(P.Xin + (unsigned)(row * DM + col))), gq = *(const f32x4*)(g2 + col);
                const v2u yy = *(const LAS v2u*)(yL + tk * 2048 + col * 2);
                f32x4 y; y.x = xo.x + gq.x * bflo(yy.x); y.y = xo.y + gq.y * bfhi(yy.x); y.z = xo.z + gq.z * bflo(yy.y); y.w = xo.w + gq.w * bfhi(yy.y);
                xn[q] = y; ss += (y.x * y.x + y.y * y.y) + (y.z * y.z + y.w * y.w); }
            const float ri = __builtin_amdgcn_rsqf(wave_sum(ss) * (1.f / DM) + EPS);
            if (P.fout) {
                if (latent) {
#pragma unroll
                    for (int q = 0; q < 4; ++q) { const unsigned col = 256 * q + 4 * lane; const f32x4 wq_ = *(const f32x4*)(P.fnw + col); __builtin_nontemporal_store(xn[q] * ri * wq_, (f32x4*)(P.fout + (unsigned)(row * DM + col))); }
                }
            } else {
                const float* sh = latent ? P.shl : P.shc; const float* sc = latent ? P.scl : P.scc;
#pragma unroll
                for (int q = 0; q < 4; ++q) { const unsigned col = 256 * q + 4 * lane; const f32x4 wn = *(const f32x4*)(P.nwn + col), a = *(const f32x4*)(sc + col), b = *(const f32x4*)(sh + col);
                    __builtin_nontemporal_store(xn[q], (f32x4*)(P.Xout + (unsigned)(row * DM + col)));
                    const f32x4 y = (xn[q] * ri * wn) * (1.0f + a) + b;
                    if (P.Hout) { v2u pk; pk.x = pk2(y.x, y.y); pk.y = pk2(y.z, y.w); *(v2u*)(P.Hout + (unsigned)(row * DM + col)) = pk; }
                    if (P.H8out) *(unsigned*)(P.H8out + (unsigned)(row * DM + col)) = pk4_fp8(y.x, y.y, y.z, y.w); }
            }
        }
    }
}
#undef g
#undef c
__device__ __forceinline__ void peer_phase2(Frame& F, const PeerArgs& P) {
    const int tid = ltid(F.wave), lane = tid & 63;
    LAS unsigned* lists = (LAS unsigned*)(F.lds + PL_LISTS);
    LAS int* eid = (LAS int*)(F.lds + PL_EID);
    LAS float* gt = (LAS float*)(F.lds + PL_GT);
    LAS unsigned short* eidL = (LAS unsigned short*)(F.lds + P2_EID); LAS float* gtL = (LAS float*)(F.lds + P2_GT); LAS float* sxL = (LAS float*)(F.lds + P2_SX);
    const int ntok = P.nblocks * 32, tpc = (ntok + F.G - 1) / F.G, t_begin = F.vcu * tpc, t_end = (t_begin + tpc < ntok) ? t_begin + tpc : ntok;
    if (t_begin >= t_end) return;
    for (int row0 = t_begin; row0 < t_end; row0 += 32) {
        const int nt = (t_end - row0 < 32) ? t_end - row0 : 32;
        for (int rr = 0; rr < P.route_reps; ++rr) {
        if (rr) __syncthreads();
        {
            const int tok = tid >> 4, lst = tid & 15;
            const bf16_t* sp = (const bf16_t*)P.S + (size_t)(row0 + (tok < nt ? tok : nt - 1)) * 2048 + lst * 128;
            float top[16];
            v4u nv[2];
#pragma unroll
            for (int q = 0; q < 2; ++q) nv[q] = *(const v4u*)(sp + q * 8);
#pragma unroll 1
            for (int c = 0; c < 8; ++c) {
                float x[16];
#pragma unroll
                for (int e = 0; e < 16; ++e) { const unsigned w = nv[e >> 3][(e >> 1) & 3];
                    x[e] = __uint_as_float(((e & 1) ? (w & 0xffff0000u) : (w << 16)) | (unsigned)(c * 16 + e)); }
                if (c < 7) {
#pragma unroll
                    for (int q = 0; q < 2; ++q) nv[q] = *(const v4u*)(sp + (c + 1) * 16 + q * 8);
                }
                sort16_desc(x);
                if (c == 0) {
#pragma unroll
                    for (int i = 0; i < 16; ++i) top[i] = x[i];
                } else merge16_desc(top, x);
            }
            LAS unsigned* lp = lists + tid * 20;
#pragma unroll
            for (int q = 0; q < 4; ++q) *(LAS v4u*)(lp + q * 4) = (v4u){__float_as_uint(top[q * 4]), __float_as_uint(top[q * 4 + 1]), __float_as_uint(top[q * 4 + 2]), __float_as_uint(top[q * 4 + 3])};
        }
        __syncthreads();
        if (tid < 256) {
            const int tok = tid >> 3, hd = tid & 7;
            const LAS unsigned* la = lists + (tok * 16 + 2 * hd) * 20; const LAS unsigned* lb = la + 20;
            float av[16], bv[16];
#pragma unroll
            for (int q = 0; q < 4; ++q) { const v4u a = *(const LAS v4u*)(la + q * 4), b = *(const LAS v4u*)(lb + q * 4);
#pragma unroll
                for (int j = 0; j < 4; ++j) { av[q * 4 + j] = __uint_as_float(a[j] & ~127u); bv[q * 4 + j] = __uint_as_float(b[j] & ~127u); } }
            float c0[16], c1[16], c2[16], c3[16];
#pragma unroll
            for (int i = 0; i < 16; ++i) { c0[i] = -INFINITY; c1[i] = -INFINITY; c2[i] = -INFINITY; c3[i] = -INFINITY; }
            {
                int cnt = 0;
#pragma unroll
                for (int i = 0; i < 16; ++i)
#pragma unroll
                    for (int j = 0; j < 16; ++j) if ((i + 1) * (j + 1) <= 16) {
                        const float sm = __uint_as_float((__float_as_uint(av[i] + bv[j]) & ~255u) | (unsigned)(i * 16 + j));
                        const int slot = cnt & 15, arr = cnt >> 4;
                        if (arr == 0) c0[slot] = sm; else if (arr == 1) c1[slot] = sm; else if (arr == 2) c2[slot] = sm; else c3[slot] = sm;
                        ++cnt;
                    }
            }
            sort16_desc(c0); sort16_desc(c1); sort16_desc(c2); sort16_desc(c3);
            merge16_desc(c0, c1); merge16_desc(c0, c2); merge16_desc(c0, c3);
            float ev[16], sum = 0.f; const float m0 = __uint_as_float(__float_as_uint(c0[0]) & ~255u);
#pragma unroll
            for (int k = 0; k < 16; ++k) { ev[k] = fast_exp2((__uint_as_float(__float_as_uint(c0[k]) & ~255u) - m0) * LOG2E); sum += ev[k]; }
            const float rs = 1.0f / sum;
#pragma unroll
            for (int k = 0; k < 16; ++k) { const unsigned code = __float_as_uint(c0[k]) & 255u;
                const int ia = (int)(la[code >> 4] & 127u), ib = (int)(lb[code & 15u] & 127u);
                eid[tok * 128 + hd * 16 + k] = ia * NKEYS + ib; gt[tok * 128 + hd * 16 + k] = ev[k] * rs;
#if SELFCHECK
                if (tok < nt) { P.dbg_eid[(size_t)(row0 + tok) * 128 + hd * 16 + k] = ia * NKEYS + ib; P.dbg_gt[(size_t)(row0 + tok) * 128 + hd * 16 + k] = ev[k] * rs; }
#endif
            }
        }
        }
        __syncthreads();
        { const int lb = row0 - t_begin;
#pragma unroll
          for (int i = 0; i < 8; ++i) { const int idx = i * NTHREADS + tid; if ((idx >> 7) < nt) { eidL[lb * 128 + idx] = (unsigned short)eid[idx]; gtL[lb * 128 + idx] = gt[idx]; } }
#pragma unroll 1
          for (int tk = 0; tk < 4; ++tk) { const int tok = F.wave * 4 + tk; if (tok >= nt) break;
            const size_t row = (size_t)(row0 + tok);
            const bf16_t* hp = P.Hin + row * DM + 16 * lane;
            const v4u h0 = *(const v4u*)hp, h1 = *(const v4u*)(hp + 8);
            float xf[16];
#pragma unroll
            for (int q = 0; q < 4; ++q) { xf[2 * q] = bflo(h0[q]); xf[2 * q + 1] = bfhi(h0[q]); xf[8 + 2 * q] = bflo(h1[q]); xf[8 + 2 * q + 1] = bfhi(h1[q]); }
            float am = 0.f;
#pragma unroll
            for (int i = 0; i < 16; ++i) am = __builtin_fmaxf(am, __builtin_fabsf(xf[i]));
            am = wave_max(am);
            const float ix = am > 0.f ? 127.f / am : 0.f;
            v4u xq;
#pragma unroll
            for (int q = 0; q < 4; ++q) { unsigned w = 0;
#pragma unroll
                for (int j = 0; j < 4; ++j) { const int v = (int)__builtin_rintf(xf[4 * q + j] * ix); w |= (unsigned)(v & 0xff) << (8 * j); }
                xq[q] = w; }
            *(v4u*)(P.H8out_xq + row * DM + 16 * lane) = xq;
            if (lane == 0) sxL[lb + tok] = am * (1.f / 127.f); }
        }
        __syncthreads();
    }
    asm volatile("s_waitcnt vmcnt(0)" ::: "memory"); __syncthreads();
    const int ntot = t_end - t_begin;
#pragma unroll 1
    for (int gi = 0; gi < 2; ++gi) { const int lt0 = F.wave * 4 + 32 * gi; int cnt = ntot - lt0; cnt = cnt < 0 ? 0 : (cnt > 4 ? 4 : cnt); if (cnt > 0) peer2_tokens<4>(F, P, t_begin, lt0, cnt, lane); }
    if (ntot > 64 && F.wave == 0) peer2_tokens<1>(F, P, t_begin, 64, 1, lane);
}

__device__ __forceinline__ void peer_phase(Frame& F, const PeerArgs& P) {
    const int tid = ltid(F.wave), lane = tid & 63;
    LAS unsigned* lists = (LAS unsigned*)(F.lds + PL_LISTS);
    LAS int* eid = (LAS int*)(F.lds + PL_EID);
    LAS float* gt = (LAS float*)(F.lds + PL_GT);
    const int ntok = P.nblocks * 32, tpc = (ntok + F.G - 1) / F.G, t_begin = F.vcu * tpc, t_end = (t_begin + tpc < ntok) ? t_begin + tpc : ntok;
    for (int row0 = t_begin; row0 < t_end; row0 += 32) {
        const int nt = (t_end - row0 < 32) ? t_end - row0 : 32;
        for (int rr = 0; rr < P.route_reps; ++rr) {
        if (rr) __syncthreads();
        {
            const int tok = tid >> 4, lst = tid & 15;
            const bf16_t* sp = (const bf16_t*)P.S + (size_t)(row0 + (tok < nt ? tok : nt - 1)) * 2048 + lst * 128;
            float top[16];
            v4u nv[2];
#pragma unroll
            for (int q = 0; q < 2; ++q) nv[q] = *(const v4u*)(sp + q * 8);
#pragma unroll 1
            for (int c = 0; c < 8; ++c) {
                float x[16];
#pragma unroll
                for (int e = 0; e < 16; ++e) { const unsigned w = nv[e >> 3][(e >> 1) & 3];
                    x[e] = __uint_as_float(((e & 1) ? (w & 0xffff0000u) : (w << 16)) | (unsigned)(c * 16 + e)); }
                if (c < 7) {
#pragma unroll
                    for (int q = 0; q < 2; ++q) nv[q] = *(const v4u*)(sp + (c + 1) * 16 + q * 8);
                }
                sort16_desc(x);
                if (c == 0) {
#pragma unroll
                    for (int i = 0; i < 16; ++i) top[i] = x[i];
                } else merge16_desc(top, x);
            }
            LAS unsigned* lp = lists + tid * 20;
#pragma unroll
            for (int q = 0; q < 4; ++q) *(LAS v4u*)(lp + q * 4) = (v4u){__float_as_uint(top[q * 4]), __float_as_uint(top[q * 4 + 1]), __float_as_uint(top[q * 4 + 2]), __float_as_uint(top[q * 4 + 3])};
        }
        __syncthreads();
        if (tid < 256) {
            const int tok = tid >> 3, hd = tid & 7;
            const LAS unsigned* la = lists + (tok * 16 + 2 * hd) * 20; const LAS unsigned* lb = la + 20;
            float av[16], bv[16];
#pragma unroll
            for (int q = 0; q < 4; ++q) { const v4u a = *(const LAS v4u*)(la + q * 4), b = *(const LAS v4u*)(lb + q * 4);
#pragma unroll
                for (int j = 0; j < 4; ++j) { av[q * 4 + j] = __uint_as_float(a[j] & ~127u); bv[q * 4 + j] = __uint_as_float(b[j] & ~127u); } }
            float c0[16], c1[16], c2[16], c3[16];
#pragma unroll
            for (int i = 0; i < 16; ++i) { c0[i] = -INFINITY; c1[i] = -INFINITY; c2[i] = -INFINITY; c3[i] = -INFINITY; }
            {
                int cnt = 0;
#pragma unroll
                for (int i = 0; i < 16; ++i)
#pragma unroll
                    for (int j = 0; j < 16; ++j) if ((i + 1) * (j + 1) <= 16) {
                        const float sm = __uint_as_float((__float_as_uint(av[i] + bv[j]) & ~255u) | (unsigned)(i * 16 + j));
                        const int slot = cnt & 15, arr = cnt >> 4;
                        if (arr == 0) c0[slot] = sm; else if (arr == 1) c1[slot] = sm; else if (arr == 2) c2[slot] = sm; else c3[slot] = sm;
                        ++cnt;
                    }
            }
            sort16_desc(c0); sort16_desc(c1); sort16_desc(c2); sort16_desc(c3);
            merge16_desc(c0, c1); merge16_desc(c0, c2); merge16_desc(c0, c3);
            float ev[16], sum = 0.f; const float m0 = __uint_as_float(__float_as_uint(c0[0]) & ~255u);
#pragma unroll
            for (int k = 0; k < 16; ++k) { ev[k] = fast_exp2((__uint_as_float(__float_as_uint(c0[k]) & ~255u) - m0) * LOG2E); sum += ev[k]; }
            const float rs = 1.0f / sum;
#pragma unroll
            for (int k = 0; k < 16; ++k) { const unsigned code = __float_as_uint(c0[k]) & 255u;
                const int ia = (int)(la[code >> 4] & 127u), ib = (int)(lb[code & 15u] & 127u);
                eid[tok * 128 + hd * 16 + k] = ia * NKEYS + ib; gt[tok * 128 + hd * 16 + k] = ev[k] * rs;
#if SELFCHECK
                if (tok < nt) { P.dbg_eid[(size_t)(row0 + tok) * 128 + hd * 16 + k] = ia * NKEYS + ib; P.dbg_gt[(size_t)(row0 + tok) * 128 + hd * 16 + k] = ev[k] * rs; }
#endif
            }
        }
        }
        __syncthreads();
#pragma unroll 1
        for (int tk = 0; tk < 4; ++tk) {
            const int tok = F.wave * 4 + tk; if (tok >= nt) break;
            const size_t row = (size_t)(row0 + tok);
            const bool latent = row < (size_t)SEQ;
            const bf16_t* hp = P.Hin + row * DM + 16 * lane;
            const v4u h0 = *(const v4u*)hp, h1 = *(const v4u*)(hp + 8);
            float xf[16];
#pragma unroll
            for (int q = 0; q < 4; ++q) { xf[2 * q] = bflo(h0[q]); xf[2 * q + 1] = bfhi(h0[q]); xf[8 + 2 * q] = bflo(h1[q]); xf[8 + 2 * q + 1] = bfhi(h1[q]); }
            float am = 0.f;
#pragma unroll
            for (int i = 0; i < 16; ++i) am = __builtin_fmaxf(am, __builtin_fabsf(xf[i]));
            am = wave_max(am);
            const float sx = am * (1.f / 127.f), ix = am > 0.f ? 127.f / am : 0.f;
            int xq[4];
#pragma unroll
            for (int q = 0; q < 4; ++q) { int w = 0;
#pragma unroll
                for (int j = 0; j < 4; ++j) { const int v = (int)__builtin_rintf(xf[4 * q + j] * ix); w |= (v & 0xff) << (8 * j); }
                xq[q] = w; }
            float out[16]; float asum = 0.f;
#pragma unroll
            for (int i = 0; i < 16; ++i) out[i] = 0.f;
            const int esel = (lane >> 2) & 15;
#pragma unroll 1
            for (int e0 = 0; e0 < 128; e0 += 16) {
                v4u ua[16], va[16];
#pragma unroll
                for (int k = 0; k < 16; ++k) { const int id = __builtin_amdgcn_readfirstlane(eid[tok * 128 + e0 + k]);
                    ua[k] = *(const v4u*)(P.U + (unsigned)(((lane >> 3) * NEXP + id) * 128 + 16 * (lane & 7))); va[k] = *(const v4u*)(P.V + (unsigned)(((lane >> 3) * NEXP + id) * 128 + 16 * (lane & 7))); }
                const int myid = eid[tok * 128 + e0 + esel]; const float mysu = P.SU[myid], mysv = P.SV[myid], myg = gt[tok * 128 + e0 + esel];
                int d[16];
#pragma unroll
                for (int k = 0; k < 16; ++k) { int di = __builtin_amdgcn_sdot4((int)ua[k][0], xq[0], 0, false); di = __builtin_amdgcn_sdot4((int)ua[k][1], xq[1], di, false);
                    di = __builtin_amdgcn_sdot4((int)ua[k][2], xq[2], di, false); d[k] = __builtin_amdgcn_sdot4((int)ua[k][3], xq[3], di, false); }
                int s8[8], s4[4], s2[2];
#pragma unroll
                for (int i = 0; i < 8; ++i) { auto r = __builtin_amdgcn_permlane32_swap((unsigned)d[i], (unsigned)d[i + 8], false, false); s8[i] = (int)r[0] + (int)r[1]; }
#pragma unroll
                for (int i = 0; i < 4; ++i) { auto r = __builtin_amdgcn_permlane16_swap((unsigned)s8[i], (unsigned)s8[i + 4], false, false); s4[i] = (int)r[0] + (int)r[1]; }
                const bool b3 = (lane & 8) != 0, b2 = (lane & 4) != 0;
#pragma unroll
                for (int i = 0; i < 2; ++i) { const int keep = b3 ? s4[i + 2] : s4[i], send = b3 ? s4[i] : s4[i + 2]; s2[i] = keep + __builtin_amdgcn_update_dpp(0, send, 0x128, 0xf, 0xf, false); }
                int z; { const int keep = b2 ? s2[1] : s2[0], send = b2 ? s2[0] : s2[1]; z = keep + __builtin_amdgcn_ds_swizzle(send, 0x101F); }
                z += __builtin_amdgcn_update_dpp(0, z, 0x4E, 0xf, 0xf, false);
                z += __builtin_amdgcn_update_dpp(0, z, 0xB1, 0xf, 0xf, false);
                const float pre = (float)z * (mysu * sx);
                const float act = myg * gelu_tanh(pre);
#if SELFCHECK
                if ((lane & 3) == 0) P.dbg_gt[(size_t)9 * MiB / 4 + row * 128 + e0 + esel] = gelu_tanh(pre);
#endif
                const float cfl = act * mysv;
#pragma unroll
                for (int k = 0; k < 16; ++k) {
                    const float cf = __uint_as_float(__builtin_amdgcn_readlane(__float_as_uint(cfl), 4 * k));
                    asum += cf;
                    const f32x2 cf2 = {cf, cf};
#pragma unroll
                    for (int q = 0; q < 4; ++q) { const unsigned w = va[k][q];
                        const f32x2 v01 = {(float)(w & 0xffu), (float)((w >> 8) & 0xffu)}, v23 = {(float)((w >> 16) & 0xffu), (float)(w >> 24)};
                        f32x2 o01 = {out[4 * q], out[4 * q + 1]}, o23 = {out[4 * q + 2], out[4 * q + 3]};
                        o01 = __builtin_elementwise_fma(cf2, v01, o01); o23 = __builtin_elementwise_fma(cf2, v23, o23);
                        out[4 * q] = o01.x; out[4 * q + 1] = o01.y; out[4 * q + 2] = o23.x; out[4 * q + 3] = o23.y; }
                }
            }
#pragma unroll
            for (int i = 0; i < 16; ++i) out[i] -= 128.f * asum;
            const float* g2 = latent ? P.g2l : P.g2c;
            float xn[16]; float ss = 0.f;
#pragma unroll
            for (int q = 0; q < 4; ++q) { const int col = 16 * lane + 4 * q; const f32x4 xo = *(const f32x4*)(P.Xin + row * DM + col), g = *(const f32x4*)(g2 + col);
#pragma unroll
                for (int j = 0; j < 4; ++j) { const float v = xo[j] + g[j] * out[4 * q + j]; xn[4 * q + j] = v; ss += v * v; } }
            const float ri = __builtin_amdgcn_rsqf(wave_sum(ss) * (1.f / DM) + EPS);
            if (P.dry) {
                if (ri == 12345.678f) P.Xout[row * DM] = ri;
            } else if (P.fout) {
                if (latent) {
#pragma unroll
                    for (int q = 0; q < 4; ++q) { const int col = 16 * lane + 4 * q; const f32x4 w = *(const f32x4*)(P.fnw + col);
                        f32x4 y; y.x = xn[4 * q] * ri * w.x; y.y = xn[4 * q + 1] * ri * w.y; y.z = xn[4 * q + 2] * ri * w.z; y.w = xn[4 * q + 3] * ri * w.w;
                        *(f32x4*)(P.fout + row * DM + col) = y; }
                }
            } else {
                const float* sh = latent ? P.shl : P.shc; const float* sc = latent ? P.scl : P.scc;
                unsigned hw[8], h8[4];
#pragma unroll
                for (int q = 0; q < 4; ++q) { const int col = 16 * lane + 4 * q;
                    *(f32x4*)(P.Xout + row * DM + col) = (f32x4){xn[4 * q], xn[4 * q + 1], xn[4 * q + 2], xn[4 * q + 3]};
                    const f32x4 w = *(const f32x4*)(P.nwn + col), a = *(const f32x4*)(sc + col), b = *(const f32x4*)(sh + col);
                    float y[4];
#pragma unroll
                    for (int j = 0; j < 4; ++j) y[j] = (xn[4 * q + j] * ri * w[j]) * (1.0f + a[j]) + b[j];
                    hw[2 * q] = pk2(y[0], y[1]); hw[2 * q + 1] = pk2(y[2], y[3]); h8[q] = pk4_fp8(y[0], y[1], y[2], y[3]); }
                if (P.Hout) { *(v4u*)(P.Hout + row * DM + 16 * lane) = (v4u){hw[0], hw[1], hw[2], hw[3]};
                    *(v4u*)(P.Hout + row * DM + 16 * lane + 8) = (v4u){hw[4], hw[5], hw[6], hw[7]}; }
                if (P.H8out) *(v4u*)(P.H8out + row * DM + 16 * lane) = (v4u){h8[0], h8[1], h8[2], h8[3]};
            }
        }
        __syncthreads();
    }
}
__device__ __forceinline__ float lam_init_of(int l) { return l == 0 ? 0.2f : 0.35550906765f; }

#ifndef PHASE_MASK
#define PHASE_MASK 0xffff
#endif
#define PH(n) ((PHASE_MASK >> (n)) & 1)
#define REPS(n) (1 + ((dupmask >> (n)) & 1))
__global__ void __launch_bounds__(NTHREADS, 2) trunk_fwd(Args args) {
    extern __shared__ __attribute__((aligned(16))) unsigned char lds[];
    Frame F;
    F.lds = (LAS unsigned char*)lds;
    F.MISC = (volatile LAS unsigned*)(F.lds + MISC_OFF);
    F.wave = __builtin_amdgcn_readfirstlane((int)threadIdx.x >> 6);
    F.G = gridDim.x; { const int bx = blockIdx.x; F.vcu = (F.G % 8 == 0) ? (bx % 8) * (F.G / 8) + bx / 8 : bx; }
    unsigned char* ws = args.ws;
    F.ctl = (gu32*)(ws + WS_CTL);
    for (int u = ltid(F.wave); u < (LDS_BYTES - LDSCTL_OFF) / 4; u += NTHREADS) ((LAS unsigned*)(F.lds + LDSCTL_OFF))[u] = 0u;
    __syncthreads();
    XcdBarrier bar = xcd_barrier_post((unsigned*)(F.ctl + CW_BAR), F.MISC + 8, F.wave);
#ifndef TIMING
#define TIMING 0
#endif
#if TIMING
    int n_stamp = 0;
#define STAMP() do { if (blockIdx.x == 0 && tid_now(F.wave) == 0) ((unsigned long long*)(F.ctl + 1024))[n_stamp] = __builtin_amdgcn_s_memrealtime(); ++n_stamp; } while (0)
#else
#define STAMP() do {} while (0)
#endif
#define GRID_BAR() do { xcd_barrier(bar); STAMP(); asm volatile("" : "+s"(ws)); } while (0)
    STAMP();

    const float* const* in = args.in;
    const int dupmask = args.flags;
#define modv ((float*)(ws + WS_CONST))
#define lamv (modv + 2 * 2 * 6144)
#define WIN ((bf16_t*)(ws + WS_WIN))
#define WGATE ((bf16_t*)(ws + WS_WGATE))
#define WBR ((bf16_t*)(ws + WS_WBR))
#define WOUT ((bf16_t*)(ws + WS_WOUT))
#define WSC ((bf16_t*)(ws + WS_WSC))
#define X ((float*)(ws + WS_X))
#define H ((bf16_t*)(ws + WS_H))
#define YS ((bf16_t*)(ws + WS_YS))
#define MIX YS
#define Qb ((bf16_t*)(ws + WS_Q))
#define Kb ((bf16_t*)(ws + WS_K))
#define Vb ((bf16_t*)(ws + WS_V))
#define BP ((bf16_t*)(ws + WS_R1))
#define SB ((float*)(ws + WS_R1))
    const int gw = F.vcu * NWAVES + F.wave, NGW = F.G * NWAVES;

    for (int rep = 0; rep < REPS(0); ++rep) {
        const int tid = ltid(F.wave), lane = tid & 63;
        LAS float* scr = (LAS float*)(F.lds + F.wave * 16384);
        for (int un = F.vcu; un < 2 * 128; un += F.G) {
            const int l = un >> 7, col = (un & 127) * 48 + lane; const bool act = lane < 48;
            const float* W = in[I_ADAW] + (size_t)l * DM * 6144;
            float a0 = 0.f, a1 = 0.f;
            if (act) {
#pragma unroll 16
                for (int k = 128 * F.wave; k < 128 * F.wave + 128; ++k) { const float w = W[(size_t)k * 6144 + col]; const float c0 = in[I_C][k], c1 = in[I_CCTX][k];
                    a0 += c0 * sigmoidf_(c0) * w; a1 += c1 * sigmoidf_(c1) * w; }
            }
            LAS float* red = (LAS float*)(F.lds);
            red[(F.wave * 64 + lane) * 2] = a0; red[(F.wave * 64 + lane) * 2 + 1] = a1;
            __syncthreads();
            if (F.wave == 0 && act) { float s0 = in[I_ADAB][l * 6144 + col], s1 = s0;
#pragma unroll
                for (int w = 0; w < 8; ++w) { s0 += red[(w * 64 + lane) * 2]; s1 += red[(w * 64 + lane) * 2 + 1]; }
                modv[(l * 2 + 0) * 6144 + col] = s0; modv[(l * 2 + 1) * 6144 + col] = s1; }
            __syncthreads();
        }
        if (blockIdx.x == 0 && tid < 2) { const float* lf = in[I_DLAM] + tid * 128; float s0 = 0.f, s1 = 0.f;
            for (int i = 0; i < 32; ++i) { s0 += lf[i] * lf[32 + i]; s1 += lf[64 + i] * lf[96 + i]; }
            lamv[tid] = expf(s0) - expf(s1) + lam_init_of(tid); }
        constexpr int I_IN = 16 * 80, I_GT = 16 * 128, I_BR = 4 * 32, I_OT = 16 * 32;
        constexpr int NITEMS = 2 * I_IN + 2 * I_GT + 8 * I_BR + 2 * I_OT;
        unsigned char* W8IN = ws + WS_W8IN; unsigned char* W8GATE = ws + WS_W8GATE;
        for (int it = gw; it < NITEMS; it += NGW) {
            int r = it;
            if (r < 2 * I_IN) { const int l = r / I_IN; transpose_item<MapWin, true>(in[I_WIN] + (size_t)l * DM * NQKV, DM, NQKV, W8IN + (size_t)l * NQKV * DM, MapWin(), scr, r % I_IN, lane); continue; } r -= 2 * I_IN;
            if (r < 2 * I_GT) { const int l = r / I_GT; transpose_item<MapGate, true>(in[I_WGATE] + (size_t)l * DM * 4096, DM, 4096, W8GATE + (size_t)l * 4096 * DM, MapGate(), scr, r % I_GT, lane); continue; } r -= 2 * I_GT;
            if (r < 8 * I_BR) { const int lb = r / I_BR; transpose_item(in[I_WBR] + (size_t)lb * 256 * DM, 256, DM, WBR + (size_t)lb * DM * 256, MapId(), scr, r % I_BR, lane); continue; } r -= 8 * I_BR;
#if MIX8
            { const int l = r / I_OT; transpose_item<MapId, true>(in[I_WOUT] + (size_t)l * DM * DM, DM, DM, ws + WS_W8OUT + (size_t)l * DM * DM, MapId(), scr, r % I_OT, lane); }
#else
            { const int l = r / I_OT; transpose_item(in[I_WOUT] + (size_t)l * DM * DM, DM, DM, WOUT + (size_t)l * DM * DM, MapId(), scr, r % I_OT, lane); }
#endif
        }
        for (int it = gw; it < 2 * 16 * 8 * 64; it += NGW) {
            const int kt = it & 63, nt = (it >> 6) & 7, g = (it >> 9) & 15, l = it >> 13, h = g >> 1, p = g & 1;
            const float* kp = in[I_PKEYS] + ((size_t)((l * 2 + p) * 8 + h) * 128 + nt * 16 + (lane & 15)) * 128 + 4 * (lane >> 4);
            const float* qp = in[I_PWQ] + ((size_t)l * DM + kt * 16 + (lane & 15)) * 2048 + g * 128 + 4 * (lane >> 4);
            f32x4 acc = {0.f, 0.f, 0.f, 0.f};
            f32x4 ka[8], qa[8];
#pragma unroll
            for (int c = 0; c < 8; ++c) { ka[c] = *(const f32x4*)(kp + 16 * c); qa[c] = *(const f32x4*)(qp + 16 * c); }
            __builtin_amdgcn_sched_barrier(0);
#pragma unroll
            for (int c = 0; c < 8; ++c)
#pragma unroll
                for (int j = 0; j < 4; ++j) acc = __builtin_amdgcn_mfma_f32_16x16x4f32(ka[c][j], qa[c][j], acc, 0, 0, 0);
            bf16_t* op = WSC + ((size_t)l * 2048 + g * 128 + nt * 16 + 4 * (lane >> 4)) * DM + kt * 16 + (lane & 15);
#pragma unroll
            for (int r = 0; r < 4; ++r) op[(size_t)r * DM] = (bf16_t)f2bf(acc[r]);
        }
        {
            unsigned char* UQ = (unsigned char*)(ws + WS_UBF); unsigned char* VQ = (unsigned char*)(ws + WS_VBF); float* SU = (float*)(ws + WS_SU); float* SV = (float*)(ws + WS_SV);
            for (int r0 = gw; r0 < 2 * 2 * NEXP; r0 += 4 * NGW) {
                f32x4 v[4][4];
#pragma unroll
                for (int u4 = 0; u4 < 4; ++u4) { const int r = r0 + u4 * NGW; const bool isv = r >= 2 * NEXP; const int rr = isv ? r - 2 * NEXP : r;
                    const float* src = (isv ? in[I_PV] : in[I_PU]) + (size_t)rr * DM + 16 * lane;
#pragma unroll
                    for (int q = 0; q < 4; ++q) v[u4][q] = *(const f32x4*)(src + 4 * q); }
#pragma unroll
                for (int u4 = 0; u4 < 4; ++u4) { const int r = r0 + u4 * NGW; const bool isv = r >= 2 * NEXP; const int rr = isv ? r - 2 * NEXP : r;
                    float am = 0.f;
#pragma unroll
                    for (int q = 0; q < 4; ++q) am = __builtin_fmaxf(am, __builtin_fmaxf(__builtin_fmaxf(__builtin_fabsf(v[u4][q].x), __builtin_fabsf(v[u4][q].y)), __builtin_fmaxf(__builtin_fabsf(v[u4][q].z), __builtin_fabsf(v[u4][q].w))));
                    am = wave_max(am);
                    const float inv = am > 0.f ? 127.f / am : 0.f; const int off = isv ? 128 : 0;
                    v4u w;
#pragma unroll
                    for (int q = 0; q < 4; ++q) { const int a0 = (int)__builtin_rintf(v[u4][q].x * inv) + off, a1 = (int)__builtin_rintf(v[u4][q].y * inv) + off, a2 = (int)__builtin_rintf(v[u4][q].z * inv) + off, a3 = (int)__builtin_rintf(v[u4][q].w * inv) + off;
                        w[q] = (unsigned)(a0 & 0xff) | ((unsigned)(a1 & 0xff) << 8) | ((unsigned)(a2 & 0xff) << 16) | ((unsigned)(a3 & 0xff) << 24); }
                    { const int lyr = rr >> 14, ex = rr & (NEXP - 1);
                      *(v4u*)((isv ? VQ : UQ) + (size_t)lyr * NEXP * DM + (size_t)(((lane >> 3) * NEXP + ex) * 128 + 16 * (lane & 7))) = w; }
                    if (lane == 0) SU[2 * rr + (isv ? 1 : 0)] = am * (1.f / 127.f); }
            }
        }
    }
#if SELFCHECK
    GRID_BAR();
#define CK_RED ((LAS float*)(F.lds))
#define CK_BUF ((LAS float*)(F.lds + 1024))
#define CK_IBUF ((LAS int*)(F.lds + 8192))
#define CK_OBUF ((LAS float*)(F.lds + 20480))
#define CK_SC ((LAS float*)(F.lds + 24576))
    if (blockIdx.x == 0) chk::ck_prologue(in, ws, F.ctl, CK_RED);
    __syncthreads();
#endif
    GRID_BAR();
    { const int lane = ltid(F.wave) & 63;
    for (int m = gw; m < MT; m += NGW) {
        const bool lat = m < SEQ; const float* xr = lat ? in[I_X] + (size_t)m * DM : in[I_CTX] + (size_t)(m - SEQ) * DM; const float* mv = modv + (lat ? 0 : 6144);
        modnorm_row(xr, SELFCHECK ? H + (size_t)m * DM : (bf16_t*)nullptr, in[I_N1W], mv, mv + 1024, lane, ws + WS_H8 + (size_t)m * DM);
    } }
    GRID_BAR();
#if SELFCHECK
    if (blockIdx.x < 5) { const int r = blockIdx.x == 0 ? 0 : blockIdx.x == 1 ? 777 : blockIdx.x == 2 ? 16383 : blockIdx.x == 3 ? 16384 : 16639;
        const bool lat = r < SEQ; const float* mv = modv + (lat ? 0 : 6144);
        chk::ck_modnorm(lat ? in[I_X] + (size_t)r * DM : in[I_CTX] + (size_t)(r - SEQ) * DM, H + (size_t)r * DM, in[I_N1W], mv, mv + 1024, F.ctl, 2, CK_RED); }
    GRID_BAR();
#endif

#pragma unroll 1
    for (int l = 0; l < 2; ++l) {
#define modl (modv + (size_t)(l * 2) * 6144)
#define modc (modl + 6144)
        const int nMr = (l == 0) ? MT / 256 : SEQ / 256;
        for (int rep = 0; rep < REPS(2); ++rep) {
            if (rep) GRID_BAR();
            pg8::Gemm g{ws + WS_H8, ws + WS_W8IN + (size_t)l * NQKV * DM, MT / 256, NQKV / 256, DM, DM, DM, 0, 0, 1};
            pg8::StaticOrder S; S.init(g, F.G, (int)blockIdx.x);
            pg8::EpiQKV E{Qb, Kb, Vb, in[I_QKNW] + l * 128};
            pg8::gemm_phase<pg8::EpiQKV, true>(F.lds, g, S, E, F.wave);
        }
        GRID_BAR();
#if SELFCHECK
        if (blockIdx.x < 4) { const int b = blockIdx.x; const int r = b == 0 ? 5 : b == 1 ? 8400 : b == 2 ? 16383 : 16391; chk::ck_qkv(l, r, in, ws, F.ctl, CK_RED, CK_BUF); }
        GRID_BAR();
#endif
        for (int rep = 0; rep < REPS(4); ++rep) {
            if (rep) GRID_BAR();
            char* shm = (char*)lds;
            const float lam = lamv[l];
            for (int ui = F.vcu; ui < 256; ui += F.G) {
                const int h = (ui >> 5) & 3, qb = ((ui >> 7) << 5) | (ui & 31);
                const int njobs = (l == 0 && ui < 16) ? (((ui >> 2) == 1) ? 7 : 6) : 5;
#pragma unroll 1
                for (int j = 0; j < njobs; ++j) {
                    att::AU u; int mode = 0;
                    u.sinkl2 = -INFINITY; u.emode = 0; u.lam = 0.f; u.oscale = 1.f; u.subw = in[I_SUBW] + l * 64; u.kbase = 0; u.q0 = qb * 256; u.NT = 260;
                    int qh, kh, oc;
                    if (j == 0)      { qh = 16 + h; kh = 10 + (h >> 1); oc = 768 + h * 64; }
                    else if (j == 1) { qh = 4 + 2 * h; kh = 4 + h; oc = 256 + h * 64; u.emode = 1; }
                    else if (j == 2) { qh = 5 + 2 * h; kh = 4 + h; oc = 256 + h * 64; u.emode = 2; u.lam = lam; u.oscale = 1.f - lam_init_of(l); }
                    else if (j == 3) { qh = h; kh = h; oc = h * 64; mode = 1; u.NT = 16; int B = 4 * qb - 4; B = B < 0 ? 0 : (B > 244 ? 244 : B); u.kbase = 64 * B; }
                    else if (j == 4) { qh = 12 + h; kh = 8 + (h >> 1); oc = 512 + h * 64; mode = 2; u.NT = 12; u.kbase = 256 * qb - 128; u.sinkl2 = in[I_SINK][l * 4 + h] * LOG2E; }
                    else {
                        const int mx = ui >> 2, hc = ui & 3; u.q0 = SEQ; u.NT = 4;
                        if (mx == 0)      { qh = hc; kh = hc; oc = hc * 64; }
                        else if (mx == 1) { qh = 4 + 2 * hc + (j - 5); kh = 4 + hc; oc = 256 + hc * 64; u.emode = (j == 5) ? 1 : 2; u.lam = lam; u.oscale = 1.f - lam_init_of(l); }
                        else if (mx == 2) { qh = 12 + hc; kh = 8 + (hc >> 1); oc = 512 + hc * 64; u.sinkl2 = in[I_SINK][l * 4 + hc] * LOG2E; }
                        else              { qh = 16 + hc; kh = 10 + (hc >> 1); oc = 768 + hc * 64; }
                    }
                    u.Q = (const att::bf16*)(Qb + (size_t)qh * MT * 64); u.K = (const att::bf16*)(Kb + (size_t)kh * MT * 64); u.V = (const att::bf16*)(Vb + (size_t)kh * MT * 64);
                    u.O = (att::bf16*)(YS + oc);
#ifndef ATT_MODES
#define ATT_MODES 7
#endif
                    if ((ATT_MODES & 2) && mode == 1) {
                        float* rp = (float*)(shm + att::LDS_RPB);
                        for (int i = ltid(F.wave); i < 15 * 32; i += NTHREADS) { const int c = i & 31; rp[i] = (c < 31) ? in[I_RPB][((size_t)(l * 4 + h) * 15 + (i >> 5)) * 31 + c] * LOG2E : 0.f; }
                        __syncthreads();
                        if (!att::attn_simple<1, 1>(u, shm, F.wave)) att::attn_simple<1>(u, shm, F.wave);
                    } else if ((ATT_MODES & 4) && mode == 2) { if (!att::attn_unit<2, 8, 0, 1>(u, shm, F.wave)) att::attn_unit<2, 8>(u, shm, F.wave); }
                    else if ((ATT_MODES & 1) && j == 1) { if (!att::attn_unit<0, 8, 1, 1>(u, shm, F.wave)) att::attn_unit<0, 8, 1>(u, shm, F.wave); }
                    else if ((ATT_MODES & 1) && j == 2) { if (!att::attn_unit<0, 8, 2, 1>(u, shm, F.wave)) att::attn_unit<0, 8, 2>(u, shm, F.wave); }
                    else if (ATT_MODES & 1) { if (!att::attn_unit<0, 8, 0, 1>(u, shm, F.wave)) att::attn_unit<0, 8>(u, shm, F.wave); }
                }
            }
        }
        GRID_BAR();
#if SELFCHECK
        if (blockIdx.x < 80) { const int b = blockIdx.x, ri = b >> 4; const int r = ri == 0 ? 3 : ri == 1 ? 4227 : ri == 2 ? 16319 : ri == 3 ? 9000 : 16484; chk::ck_attn(l, (b >> 2) & 3, b & 3, r, in, ws, F.ctl, CK_RED, CK_SC, CK_OBUF); }
        GRID_BAR();
#endif
        for (int rep = 0; rep < REPS(5); ++rep) {
            if (rep) GRID_BAR();
            pg8::Gemm g{YS, WBR + (size_t)l * 4 * DM * 256, nMr, 16, 256, DM, 256, 2, 512, 2};
            pg8::StaticOrder S; S.init(g, F.G, (int)blockIdx.x);
#if BP8
            pg8::EpiBranch8 E{(unsigned char*)BP};
            pg8::gemm_phase<pg8::EpiBranch8>(F.lds, g, S, E, F.wave);
#else
            pg8::EpiBranch E{BP};
            pg8::gemm_phase<pg8::EpiBranch>(F.lds, g, S, E, F.wave);
#endif
        }
        GRID_BAR();
#if SELFCHECK
        if (blockIdx.x < 3) { const int b = blockIdx.x; chk::ck_branch(l, b == 0 ? 1 : b == 1 ? 16383 : 16390, in, ws, F.ctl, CK_RED); }
        GRID_BAR();
#endif
        for (int rep = 0; rep < REPS(6); ++rep) {
            if (rep) GRID_BAR();
            pg8::Gemm g{ws + WS_H8, ws + WS_W8GATE + (size_t)l * 4096 * DM, nMr, 16, DM, DM, DM, 0, 0, 1};
            pg8::StaticOrder S; S.init(g, F.G, (int)blockIdx.x);
            pg8::EpiGate E{BP, MIX, in[I_BGATE] + l * 4096};
            pg8::gemm_phase<pg8::EpiGate, true>(F.lds, g, S, E, F.wave);
        }
        GRID_BAR();
#if SELFCHECK
        if (blockIdx.x < 3) { const int b = blockIdx.x; chk::ck_gate(l, b == 0 ? 2 : b == 1 ? 9999 : 16385, in, ws, F.ctl, CK_RED); }
        GRID_BAR();
#endif
        for (int rep = 0; rep < (l == 0 ? REPS(7) : 1); ++rep) {
            if (rep) GRID_BAR();
#if MIX8
            pg8::Gemm g{MIX, ws + WS_W8OUT + (size_t)l * DM * DM, nMr, 4, DM, DM, DM, 0, 0, 1};
#else
            pg8::Gemm g{MIX, WOUT + (size_t)l * DM * DM, nMr, 4, DM, DM, DM, 0, 0, 2};
#endif
            pg8::StaticOrder S; S.init(g, F.G, (int)blockIdx.x);
#ifndef FUSE_NORM2
#define FUSE_NORM2 1
#endif
#if FUSE_NORM2
            pg8::EpiOutNorm E{l == 0 ? in[I_X] : X, l == 0 ? in[I_CTX] : X + (size_t)SEQ * DM, X, modl + 2048, modc + 2048,
                              H, in[I_N2W] + l * DM, modl, modc, (gu32*)(ws + WS_CONST + 704 * 1024), F.ctl + 16384 + l * 65 * 64, F.ctl + 16000, F.lds + MISC_OFF + 1024};
#if MIX8
            pg8::gemm_phase<pg8::EpiOutNorm, true, 0x7A7A7A7A>(F.lds, g, S, E, F.wave);
#else
            pg8::gemm_phase<pg8::EpiOutNorm>(F.lds, g, S, E, F.wave);
#endif
#else
            pg8::EpiOut E{l == 0 ? in[I_X] : X, l == 0 ? in[I_CTX] : X + (size_t)SEQ * DM, X, modl + 2048, modc + 2048};
            pg8::gemm_phase<pg8::EpiOut>(F.lds, g, S, E, F.wave);
#endif
        }
        GRID_BAR();
#if SELFCHECK
        if (blockIdx.x < 3) { const int b = blockIdx.x; chk::ck_out(l, b == 0 ? 4 : b == 1 ? 12345 : 16417, in, ws, F.ctl, CK_RED); }
        GRID_BAR();
#endif
#if !FUSE_NORM2
        { const int lane = ltid(F.wave) & 63;
        for (int m = gw; m < nMr * 256; m += NGW) {
            const float* mv = (m < SEQ) ? modl : modc;
            modnorm_row(X + (size_t)m * DM, H + (size_t)m * DM, in[I_N2W] + l * DM, mv + 3072, mv + 4096, lane);
        } }
        GRID_BAR();
#endif
#if SELFCHECK
        if (blockIdx.x < 3) { const int b = blockIdx.x; const int r = b == 0 ? 7 : b == 1 ? 16383 : 16500; const float* mv = (r < SEQ) ? modl : modc;
            chk::ck_modnorm(X + (size_t)r * DM, H + (size_t)r * DM, in[I_N2W] + l * DM, mv + 3072, mv + 4096, F.ctl, 8, CK_RED); }
        GRID_BAR();
#endif
        for (int rep = 0; rep < REPS(9); ++rep) {
            if (rep) GRID_BAR();
            pg8::Gemm g{H, WSC + (size_t)l * 2048 * DM, nMr, 8, DM, DM, DM, 0, 0, 2};
            pg8::StaticOrder S; S.init(g, F.G, (int)blockIdx.x);
            pg8::EpiS E{SB};
            pg8::gemm_phase<pg8::EpiS>(F.lds, g, S, E, F.wave);
        }
        GRID_BAR();
#if SELFCHECK
        if (blockIdx.x < 3) { const int b = blockIdx.x; chk::ck_scores(l, b == 0 ? 6 : b == 1 ? 16000 : 16385, in, ws, F.ctl, CK_RED, CK_BUF); }
        GRID_BAR();
#endif
#ifndef PEER_SLICED
#define PEER_SLICED 0
#endif
#if !PEER_SLICED
        for (int rep = 0; rep < REPS(10); ++rep) {
            if (rep) GRID_BAR();
            PeerArgs P; P.dry = (rep + 1 < REPS(10)); P.route_reps = REPS(11);
            P.S = SB; P.Hin = H; P.U = (const unsigned char*)(ws + WS_UBF) + (size_t)l * NEXP * DM; P.V = (const unsigned char*)(ws + WS_VBF) + (size_t)l * NEXP * DM; P.SU = (const float*)(ws + WS_SU) + (size_t)l * 2 * NEXP; P.SV = (const float*)(ws + WS_SV) + l * NEXP; P.Xin = X; P.Xout = X;
            P.g2l = modl + 5120; P.g2c = modc + 5120;
            P.Hout = SELFCHECK ? H : (bf16_t*)nullptr; P.H8out = ws + WS_H8; P.nwn = in[I_N1W] + DM; P.shl = modv + 2 * 6144; P.scl = P.shl + 1024; P.shc = modv + 3 * 6144; P.scc = P.shc + 1024;
            P.fout = (l == 1) ? args.out : nullptr; P.fnw = in[I_FNW];
            P.nblocks = nMr * 8; P.dbg_eid = nullptr; P.dbg_gt = nullptr;
#if SELFCHECK
            if (l == 0) { P.Xout = (float*)(ws + WS_DBG); P.Hout = YS; P.H8out = nullptr; }
            P.dbg_eid = (int*)(ws + WS_VBF + 32 * MiB); P.dbg_gt = (float*)(ws + WS_VBF + 41 * MiB);
#endif
            P.H8out_xq = ws + WS_H8;
#ifndef PEER_V2
#define PEER_V2 1
#endif
            if (PEER_V2 && !P.dry) peer_phase2(F, P); else peer_phase(F, P);
        }
#else
        {
            PeerArgs P; P.dry = false; P.route_reps = 1;
            P.S = SB; P.Hin = H; P.U = (const unsigned char*)(ws + WS_UBF) + (size_t)l * NEXP * DM; P.V = (const unsigned char*)(ws + WS_VBF) + (size_t)l * NEXP * DM; P.SU = (const float*)(ws + WS_SU) + (size_t)l * 2 * NEXP; P.SV = (const float*)(ws + WS_SV) + l * NEXP; P.Xin = X; P.Xout = X;
            P.g2l = modl + 5120; P.g2c = modc + 5120;
            P.Hout = SELFCHECK ? H : (bf16_t*)nullptr; P.H8out = ws + WS_H8; P.nwn = in[I_N1W] + DM; P.shl = modv + 2 * 6144; P.scl = P.shl + 1024; P.shc = modv + 3 * 6144; P.scc = P.shc + 1024;
            P.fout = (l == 1) ? args.out : nullptr; P.fnw = in[I_FNW];
            P.nblocks = nMr * 8; P.dbg_eid = nullptr; P.dbg_gt = nullptr;
            PeerBufs B;
#if SELFCHECK
            unsigned char* pb = ws + WS_VBF + 32 * MiB;
            if (l == 0) { P.Xout = (float*)(ws + WS_DBG); P.Hout = YS; }
#else
            unsigned char* pb = ws + WS_YS;
#endif
            B.eid = (int*)pb; B.gt = (float*)(pb + 9 * MiB); B.a = (float*)(pb + 18 * MiB); B.xq = ws + WS_UBF + 32 * MiB; B.sx = (float*)(ws + WS_UBF + 50 * MiB);
            const int ntok = nMr * 256;
            peer_route(F, P, B);
            GRID_BAR();
            peer_u(F, P, B, ntok);
            GRID_BAR();
            peer_v(F, P, B, ntok);
            GRID_BAR();
            peer_norm(F, P, ntok);
        }
#endif
#if SELFCHECK
        break;
#endif
        if (l == 0) GRID_BAR();
    }
#if TIMING
    GRID_BAR(); xcd_barrier(bar);
    {
        const unsigned long long* ts = (const unsigned long long*)(F.ctl + 1024);
        float iv[10];
#pragma unroll
        for (int i = 0; i < 10; ++i) iv[i] = 0.f;
        iv[0] = (float)(ts[1] - ts[0]); iv[1] = (float)(ts[2] - ts[1]);
#pragma unroll
        for (int l = 0; l < 2; ++l)
#pragma unroll
            for (int p = 0; p < 8; ++p) iv[2 + p] += (float)(ts[3 + l * 8 + p] - ts[2 + l * 8 + p]);
        const float total = (float)(ts[18] - ts[0]);
        const int k1 = (int)(100.f * iv[TIMING_A] / total + 0.5f); int k2 = 10 + (int)(100.f * iv[TIMING_B] / total + 0.5f); k2 = k2 > 99 ? 99 : k2;
        const float cval = sqrtf((float)k1);
        for (size_t i = (size_t)blockIdx.x * NTHREADS + ltid(F.wave); i < (size_t)SEQ * DM / 4; i += (size_t)gridDim.x * NTHREADS) ((f32x4*)args.out)[i] = (f32x4){i == 0 ? 100.f * (float)k2 : cval, cval, cval, cval};
    }
#endif
#if SELFCHECK
    GRID_BAR();
    if (blockIdx.x < 5) { const int b = blockIdx.x; const int r = b == 0 ? 0 : b == 1 ? 31 : b == 2 ? 37 : b == 3 ? 16383 : 16639; chk::ck_peer(0, r, in, ws, F.ctl, CK_RED, CK_BUF, CK_IBUF); }
    GRID_BAR();
    {
        float e[32];
#pragma unroll
        for (int i = 0; i < 32; ++i) e[i] = __uint_as_float(__hip_atomic_load(F.ctl + CW_CHK + i, RLX_AGENT));
        const float T = 0.03f; int mask = 0;
#if SELFCHECK == 1
        mask = ((e[0] > T || e[1] > T) ? 1 : 0) | (e[2] > T ? 2 : 0) | (e[3] > T ? 4 : 0) | (e[4] > T ? 8 : 0) | (e[5] > T ? 16 : 0);
#elif SELFCHECK == 2
        mask = (e[6] > T ? 1 : 0) | (e[7] > T ? 2 : 0) | (e[8] > T ? 4 : 0) | (e[9] > T ? 8 : 0) | ((e[10] > T || e[11] > T) ? 16 : 0);
#elif SELFCHECK == 5
        mask = (e[24] > T ? 1 : 0) | (e[25] > T ? 2 : 0) | (e[26] > T ? 4 : 0) | (e[27] > T ? 8 : 0) | (e[28] > T ? 16 : 0);
#elif SELFCHECK == 4
        mask = (e[10] > T ? 1 : 0) | (e[11] > T ? 2 : 0) | (e[12] > T ? 4 : 0) | (e[13] > T ? 8 : 0);
#else
        mask = (e[16] > T ? 1 : 0) | (e[17] > T ? 2 : 0) | (e[18] > T ? 4 : 0) | (e[19] > T ? 8 : 0) | ((e[20] > T || e[21] > T || e[22] > T || e[23] > T) ? 16 : 0);
#endif
        const float cval = sqrtf((float)mask);
        for (size_t i = (size_t)blockIdx.x * NTHREADS + ltid(F.wave); i < (size_t)SEQ * DM / 4; i += (size_t)gridDim.x * NTHREADS) ((f32x4*)args.out)[i] = (f32x4){cval, cval, cval, cval};
    }
#endif
}
#ifndef DUP_MASK
#define DUP_MASK 0
#endif
extern "C" void kernel_launch(void* const* d_in, const int* in_sizes, int n_in, void* d_out, int out_size, void* d_ws, size_t ws_size, hipStream_t stream) {
    static int grid = 0;
    if (grid == 0) {
        size_t need = WS_END;
#if SELFCHECK
        need = WS_DBG + (size_t)MT * DM * 4;
#endif
        if (n_in != 23 || in_sizes[0] != SEQ * DM || out_size != SEQ * DM || ws_size < need) {
            fprintf(stderr, "kernel_launch: unexpected problem shape (n_in %d, in0 %d, out %d, ws %zu, need %zu); nothing launched\n", n_in, n_in > 0 ? in_sizes[0] : -1, out_size, ws_size, need); grid = -1; return; }
        int dev = 0, cus = 0, per_cu = 0;
        if (hipGetDevice(&dev) != hipSuccess || hipDeviceGetAttribute(&cus, hipDeviceAttributeMultiprocessorCount, dev) != hipSuccess) { fprintf(stderr, "kernel_launch: device query failed\n"); grid = -1; return; }
        if (hipFuncSetAttribute((const void*)trunk_fwd, hipFuncAttributeMaxDynamicSharedMemorySize, LDS_BYTES) != hipSuccess) { fprintf(stderr, "kernel_launch: hipFuncSetAttribute failed\n"); grid = -1; return; }
        if (hipOccupancyMaxActiveBlocksPerMultiprocessor(&per_cu, (const void*)trunk_fwd, NTHREADS, LDS_BYTES) != hipSuccess || per_cu < 1) {
            fprintf(stderr, "kernel_launch: occupancy query says %d blocks per CU; nothing launched\n", per_cu); (void)hipGetLastError(); grid = -1; return; }
        grid = cus;
    }
    if (grid < 0) return;
    (void)hipMemsetAsync((char*)d_ws + WS_CTL, 0, CTL_ZERO_BYTES, stream);
    Args a{};
    for (int i = 0; i < 23; ++i) a.in[i] = (const float*)d_in[i];
    a.out = (float*)d_out; a.ws = (unsigned char*)d_ws; a.flags = DUP_MASK; a.pad = 0;
    void* kargs[] = {&a};
    const hipError_t e = hipLaunchCooperativeKernel((const void*)trunk_fwd, dim3(grid), dim3(NTHREADS), kargs, LDS_BYTES, stream);
    if (e != hipSuccess) fprintf(stderr, "kernel_launch: cooperative launch failed: %s (grid %d)\n", hipGetErrorString(e), grid);
}
```

```cpp
#define SELFCHECK 0
#define TIMING 0
#define TIMING_A 0
#define TIMING_B 1
#define DUP_MASK 0
#define PEER_SLICED 0
#include <hip/hip_runtime.h>
#include <hip/hip_cooperative_groups.h>
#include <hip/hip_bf16.h>
#include <cstdio>
#include <cstdint>
#include <cmath>
namespace cg = cooperative_groups;

#ifndef SELFCHECK
#define SELFCHECK 0
#endif

constexpr int SEQ = 16384, CTX = 256, MT = SEQ + CTX, DM = 1024, NQKV = 2560, GRIDW = 64;
constexpr int NEXP = 16384, NKEYS = 128, PEER_H = 8, TOPK = 16;
constexpr float EPS = 1e-6f, LOG2E = 1.4426950408889634f;
constexpr float C2_64 = 0.125f * LOG2E;
constexpr float C2_32 = 0.17677669529663687f * LOG2E;
constexpr int NWAVES = 8, NTHREADS = 512;

constexpr size_t MiB = 1u << 20;
constexpr size_t WS_CTL = 0, CTL_ZERO_BYTES = 1 * MiB;
constexpr size_t WS_CONST = 1 * MiB;
constexpr size_t WS_WIN = 2 * MiB;
constexpr size_t WS_WGATE = 12 * MiB;
constexpr size_t WS_WBR = 28 * MiB;
constexpr size_t WS_WOUT = 32 * MiB;
constexpr size_t WS_WSC = 36 * MiB;
constexpr size_t WS_SU = WS_CONST + 256 * 1024, WS_SV = WS_CONST + 512 * 1024;
constexpr size_t WS_UBF = 44 * MiB;
constexpr size_t WS_VBF = 108 * MiB;
constexpr size_t WS_H8 = WS_UBF + 32 * MiB;
constexpr size_t WS_W8IN = WS_VBF + 32 * MiB, WS_W8GATE = WS_VBF + 40 * MiB, WS_W8OUT = WS_VBF + 48 * MiB;
constexpr size_t WS_X = 172 * MiB;
constexpr size_t WS_H = 237 * MiB;
constexpr size_t WS_YS = 270 * MiB;
constexpr size_t WS_R1 = 303 * MiB;
constexpr size_t WS_Q = WS_R1, WS_K = WS_Q + (size_t)20 * MT * 128, WS_V = WS_K + (size_t)12 * MT * 128;
constexpr size_t WS_END = 433 * MiB;
constexpr size_t WS_DBG = 433 * MiB;
static_assert(WS_V + (size_t)12 * MT * 128 <= WS_END && WS_R1 + (size_t)MT * 4096 * 2 <= WS_END && WS_R1 + (size_t)MT * 2048 * 4 <= WS_END, "ws map");
constexpr int CW_BAR = 4096;
constexpr int CW_CHK = 64;

constexpr int RING_BYTES = 131072;
constexpr int LDSCTL_OFF = RING_BYTES, MISC_OFF = LDSCTL_OFF + 320;
constexpr int LDS_BYTES = 147456;

#define GAS __attribute__((address_space(1)))
#define LAS __attribute__((address_space(3)))
typedef unsigned short bf16_t;
typedef unsigned v4u __attribute__((ext_vector_type(4)));
typedef unsigned v2u __attribute__((ext_vector_type(2)));
typedef float f32x4 __attribute__((ext_vector_type(4)));
typedef float f32x2 __attribute__((ext_vector_type(2)));
typedef float f32x16 __attribute__((ext_vector_type(16)));
typedef short bf16x8 __attribute__((ext_vector_type(8)));
typedef short s16x4 __attribute__((ext_vector_type(4)));
typedef __bf16 bf16x2_t __attribute__((ext_vector_type(2)));
typedef int i32x8 __attribute__((ext_vector_type(8)));
typedef int i32x4 __attribute__((ext_vector_type(4)));
typedef GAS unsigned gu32;
#define RLX_AGENT __ATOMIC_RELAXED, __HIP_MEMORY_SCOPE_AGENT
#define LDS_WAIT() asm volatile("s_waitcnt lgkmcnt(0)" ::: "memory")
#define VM_WAIT() asm volatile("s_waitcnt vmcnt(0)" ::: "memory")

__device__ __forceinline__ int lane_now() { int l; asm volatile("v_mbcnt_lo_u32_b32 %0, -1, 0\n\tv_mbcnt_hi_u32_b32 %0, -1, %0" : "=v"(l)); return l; }
__device__ __forceinline__ int tid_now(int wave) { return (wave << 6) | lane_now(); }
__device__ __forceinline__ unsigned f2bf(float f) { unsigned u = __builtin_bit_cast(unsigned, f); return (u + 0x7fffu + ((u >> 16) & 1u)) >> 16; }
__device__ __forceinline__ unsigned pk2(float lo, float hi) { f32x2 v = {lo, hi}; bf16x2_t b = __builtin_convertvector(v, bf16x2_t); return __builtin_bit_cast(unsigned, b); }
__device__ __forceinline__ unsigned pk4_fp8(float a, float b, float c, float d) { int w = 0; w = __builtin_amdgcn_cvt_pk_fp8_f32(a, b, w, false); w = __builtin_amdgcn_cvt_pk_fp8_f32(c, d, w, true); return (unsigned)w; }
__device__ __forceinline__ float bflo(unsigned w) { return __builtin_bit_cast(float, w << 16); }
__device__ __forceinline__ float bfhi(unsigned w) { return __builtin_bit_cast(float, w & 0xffff0000u); }
__device__ __forceinline__ float bf2f(bf16_t h) { return __builtin_bit_cast(float, (unsigned)h << 16); }
template <int X> __device__ __forceinline__ float xorf(float v) { return __builtin_bit_cast(float, __builtin_amdgcn_ds_swizzle(__builtin_bit_cast(int, v), (X << 10) | 0x1f)); }
__device__ __forceinline__ float x32_sum(float v) { auto r = __builtin_amdgcn_permlane32_swap(__float_as_uint(v), __float_as_uint(v), false, false); return __uint_as_float(r[0]) + __uint_as_float(r[1]); }
__device__ __forceinline__ float x32_max(float v) { auto r = __builtin_amdgcn_permlane32_swap(__float_as_uint(v), __float_as_uint(v), false, false); return __builtin_fmaxf(__uint_as_float(r[0]), __uint_as_float(r[1])); }
__device__ __forceinline__ float wave_sum(float v) { v += xorf<1>(v); v += xorf<2>(v); v += xorf<4>(v); v += xorf<8>(v); v += xorf<16>(v); return x32_sum(v); }
__device__ __forceinline__ float wave_max(float v) { v = __builtin_fmaxf(v, xorf<1>(v)); v = __builtin_fmaxf(v, xorf<2>(v)); v = __builtin_fmaxf(v, xorf<4>(v)); v = __builtin_fmaxf(v, xorf<8>(v)); v = __builtin_fmaxf(v, xorf<16>(v)); return x32_max(v); }
__device__ __forceinline__ float fast_exp2(float x) { return __builtin_amdgcn_exp2f(x); }
__device__ __forceinline__ float fast_rcp(float x) { return __builtin_amdgcn_rcpf(x); }
__device__ __forceinline__ float sigmoidf_(float x) { return fast_rcp(1.0f + fast_exp2(-x * LOG2E)); }
__device__ __forceinline__ float gelu_tanh(float x) {
    const float y = 0.7978845608028654f * (x + 0.044715f * x * x * x);
    const float t = 1.0f - 2.0f * fast_rcp(1.0f + fast_exp2(2.0f * LOG2E * y));
    return 0.5f * x * (1.0f + t);
}
#define XB_TMO      128
#define XB_XCNT(j)  (256  + 64 * (j))
#define XB_XSUB(j)  (1280 + 64 * (j))
#define XB_XGEN(j)  (2304 + 64 * (j))
#define XB_TOP      3328
#define XB_TOPGEN   3392
#define XCD_BAR_WORDS 3456
#define XB_SPIN_CAP (1u << 20)
__device__ __forceinline__ unsigned xb_ld(unsigned* p)              { return __hip_atomic_load(p, __ATOMIC_RELAXED, __HIP_MEMORY_SCOPE_AGENT); }
__device__ __forceinline__ unsigned xb_add(unsigned* p, unsigned v) { return __hip_atomic_fetch_add(p, v, __ATOMIC_RELAXED, __HIP_MEMORY_SCOPE_AGENT); }
__device__ __forceinline__ unsigned xb_xcc_id() { return (unsigned)__builtin_amdgcn_s_getreg((3 << 11) | 20) & 0xFu; }
#define XB_SPIN(cond, bar) do { unsigned _sp = 0; while (cond) { __builtin_amdgcn_s_sleep(1); \
    if ((++_sp & 255u) == 0u) { if (xb_ld(&(bar)[XB_TMO])) break; if (_sp > XB_SPIN_CAP) { atomicAdd(&(bar)[XB_TMO], 1u); break; } } } } while (0)
struct XcdBarrier { unsigned* bar; unsigned x; volatile LAS unsigned* st; int wave; };
__device__ __forceinline__ XcdBarrier xcd_barrier_post(unsigned* bar, volatile LAS unsigned* st, int wave) {
    XcdBarrier b; b.bar = bar; b.x = xb_xcc_id(); b.st = st; b.wave = wave;
    if (tid_now(wave) == 0) (void)xb_add(&bar[XB_XCNT(b.x)], 1u);
    return b;
}
__device__ __forceinline__ void xcd_barrier_complete(unsigned* bar, unsigned x, unsigned& nloc, unsigned& nx) {
    const unsigned G = gridDim.x * gridDim.y * gridDim.z;
    unsigned sum, cnt, mine, sp = 0u;
    for (;;) {
        sum = 0u; cnt = 0u; mine = 0u;
#pragma unroll
        for (unsigned j = 0; j < 16; ++j) { const unsigned c = xb_ld(&bar[XB_XCNT(j)]); sum += c; cnt += (c > 0u) ? 1u : 0u; mine = (j == x) ? c : mine; }
        if (sum == G) break;
        __builtin_amdgcn_s_sleep(1);
        if ((++sp & 255u) == 0u) { if (xb_ld(&bar[XB_TMO])) break; if (sp > XB_SPIN_CAP) { atomicAdd(&bar[XB_TMO], 1u); break; } }
    }
    nloc = mine > 0u ? mine : 1u; nx = cnt > 0u ? cnt : 1u;
}
__device__ __forceinline__ void xcd_barrier(const XcdBarrier& b) {
    asm volatile("s_waitcnt vmcnt(0)" ::: "memory");
    __syncthreads();
    unsigned* bar_ = b.bar; unsigned bx_ = b.x; asm volatile("" : "+s"(bar_), "+s"(bx_));
    if (tid_now(b.wave) == 0) {
        unsigned* bar = bar_; const unsigned bx = bx_;
        __builtin_amdgcn_s_waitcnt(0);
        unsigned nloc = b.st[0], nx = b.st[1];
        if (nloc == 0u) { xcd_barrier_complete(bar, bx, nloc, nx); b.st[0] = nloc; b.st[1] = nx; }
        const unsigned old = xb_add(&bar[XB_XSUB(bx)], 1u);
        const unsigned gen = old / nloc;
        if (old + 1u == (gen + 1u) * nloc) {
            __builtin_amdgcn_fence(__ATOMIC_RELEASE, "agent");
            asm volatile("s_waitcnt vmcnt(0)" ::: "memory");
            const unsigned og = xb_add(&bar[XB_TOP], 1u);
            const unsigned tg = og / nx;
            if (og + 1u == (tg + 1u) * nx) xb_add(&bar[XB_TOPGEN], 1u);
            else XB_SPIN(xb_ld(&bar[XB_TOPGEN]) == tg, bar);
            __builtin_amdgcn_fence(__ATOMIC_ACQUIRE, "agent");
            xb_add(&bar[XB_XGEN(bx)], 1u);
            asm volatile("s_waitcnt vmcnt(0)" ::: "memory");
        } else {
            XB_SPIN(xb_ld(&bar[XB_XGEN(bx)]) == gen, bar);
            __builtin_amdgcn_fence(__ATOMIC_ACQUIRE, "agent");
            asm volatile("s_waitcnt vmcnt(0)" ::: "memory");
        }
    }
    __syncthreads();
}

namespace pg8 {
#define PG8_LAS __attribute__((address_space(3)))
constexpr int BM = 256, BK = 64, HALF = 128, HTB = HALF * BK * 2, STAGE_BYTES = 8 * HTB, NXCD = 8, WGM = 8;
__host__ __device__ __forceinline__ int lds_byte(int r, int c) { const int st = (r >> 4) * 2 + (c >> 5), rr = r & 15, cc = c & 31, ob = rr * 64 + cc * 2; return st * 1024 + (ob ^ (((ob >> 9) & 1) << 5)); }
__host__ __device__ __forceinline__ void stage_rc(int b, int& R, int& C) { const int st = b / 1024, sb = b % 1024, swz = sb ^ (((sb >> 9) & 1) << 5); R = (st >> 1) * 16 + swz / 64; C = (st & 1) * 32 + (swz % 64) / 2; }
__host__ __device__ __forceinline__ int perm32(int rho) { const int n = rho >> 4, i = rho & 15; return 8 * (i >> 2) + 4 * n + (i & 3); }
__host__ __device__ __forceinline__ int wide_row(int R) { return 64 * (R >> 5) + 16 * ((R >> 2) & 3) + 4 * ((R >> 4) & 1) + (R & 3); }
template <class E, class = void> struct IsWide { static constexpr bool v = false; };
template <class E> struct IsWide<E, decltype((void)E::WIDE)> { static constexpr bool v = true; };

struct Unit { int pm, pn; const char* a; const char* b; };
struct Gemm { const void* A; const void* Bt; int nM, nN, K, lda, ldb, a_shift, a_pn_bytes, esz; };

struct StaticOrder {
    int nM, nN, nwg, G, c; const char* A; const char* B; size_t a_pm, b_pn; int a_shift, a_pn;
    __device__ void init(const Gemm& g, int G_, int c_) { nM = g.nM; nN = g.nN; nwg = nM * nN; G = G_; c = c_; A = (const char*)g.A; B = (const char*)g.Bt;
        a_pm = (size_t)BM * g.lda * g.esz; b_pn = (size_t)BM * g.ldb * g.esz; a_shift = g.a_shift; a_pn = g.a_pn_bytes; }
    __device__ bool has(int i) const { int cc = c; asm volatile("" : "+s"(cc)); return (long)i * G + cc < nwg; }
    __device__ bool next(int i, Unit& u) const {
        const long L = (long)i * G + c; if (L >= nwg) return false;
        int wgid = (int)L; { const int q = nwg / NXCD, r = nwg % NXCD, xcd = wgid % NXCD, off = wgid / NXCD; wgid = (xcd < r ? xcd * (q + 1) : r * (q + 1) + (xcd - r) * q) + off; }
        const int nig = WGM * nN, gid = wgid / nig, fm = gid * WGM, gsz = (nM - fm) < WGM ? (nM - fm) : WGM;
        u.pm = fm + ((wgid % nig) % gsz); u.pn = (wgid % nig) / gsz;
        u.a = A + (size_t)u.pm * a_pm + (size_t)(u.pn >> a_shift) * a_pn; u.b = B + (size_t)u.pn * b_pn; return true;
    }
};

template <class Epi, bool FP8 = false, int SCALE_ACT = 0x7F7F7F7F>
__device__ __forceinline__ void gemm_phase(PG8_LAS unsigned char* lds, const Gemm g, const StaticOrder& S, const Epi& E, int wave) {
    const int tid = tid_now(wave), wid = wave, lane = tid & 63, wr = wid >> 2, wc = wid & 3, fr = lane & 15, fq = lane >> 4;
    const int K = g.K, nt = (K * g.esz) / (BK * 2);
    unsigned voffA[2], voffB[2];
#pragma unroll
    for (int i = 0; i < 2; ++i) { int R, C; stage_rc(tid * 16 + i * 8192, R, C); const int Rb = IsWide<Epi>::v ? wide_row(R) : (Epi::PERM ? ((R & ~31) + perm32(R & 31)) : R);
        voffA[i] = (unsigned)(R * g.lda * g.esz + C * 2); voffB[i] = (unsigned)(Rb * g.ldb * g.esz + C * 2); }
    const size_t kstep = (size_t)(BK * 2);
    const size_t hstepA = (size_t)HALF * g.lda * g.esz, hstepB = (size_t)(IsWide<Epi>::v ? 8 : HALF) * g.ldb * g.esz;
    const unsigned ldsw = (unsigned)wid * 1024u, ldsbase = (unsigned)(uintptr_t)lds;
    const int aoff = FP8 ? lds_byte(wr * 64 + fr, fq * 16) : lds_byte(wr * 64 + fr, fq * 8), boff = FP8 ? lds_byte(wc * 32 + fr, fq * 16) : lds_byte(wc * 32 + fr, fq * 8);
#define PG8_SA(b, h) (((b) * 2 + (h)) * HTB)
#define PG8_SB(b, h) ((4 + (b) * 2 + (h)) * HTB)
#define PG8_GLDS(sbase, voff32, ldsdst) do { unsigned keep_; asm volatile("s_mov_b32 %0, m0\n\ts_mov_b32 m0, %3\n\ts_nop 0\n\tglobal_load_lds_dwordx4 %1, %2\n\ts_mov_b32 m0, %0" : "=&s"(keep_) : "v"(voff32), "s"(sbase), "s"(ldsdst) : "memory"); } while (0)
#define PG8_STAGE(bufoff, gbase, voff) do { _Pragma("unroll") for (int _i = 0; _i < 2; ++_i) \
        PG8_GLDS((const char*)(gbase), (voff)[_i], (unsigned)__builtin_amdgcn_readfirstlane((int)(ldsbase + (unsigned)(bufoff) + ldsw + _i * 8192))); } while (0)
#define PG8_LDA(dst, b, h) do { if constexpr (FP8) { _Pragma("unroll") for (int m = 0; m < 4; ++m) dst##8[m] = *(const PG8_LAS i32x8*)(lds + PG8_SA(b, h) + aoff + m * 2048); } \
        else { _Pragma("unroll") for (int m = 0; m < 4; ++m) _Pragma("unroll") for (int k = 0; k < 2; ++k) dst[m][k] = *(const PG8_LAS bf16x8*)(lds + PG8_SA(b, h) + aoff + m * 2048 + k * 1024); } } while (0)
#define PG8_LDB(dst, b, h) do { if constexpr (FP8) { _Pragma("unroll") for (int n = 0; n < 2; ++n) dst##8[n] = *(const PG8_LAS i32x8*)(lds + PG8_SB(b, h) + boff + n * 2048); } \
        else { _Pragma("unroll") for (int n = 0; n < 2; ++n) _Pragma("unroll") for (int k = 0; k < 2; ++k) dst[n][k] = *(const PG8_LAS bf16x8*)(lds + PG8_SB(b, h) + boff + n * 2048 + k * 1024); } } while (0)
#define PG8_MMA(ai, bj, At, Bt) do { __builtin_amdgcn_s_setprio(1); \
        if constexpr (FP8) { _Pragma("unroll") for (int m = 0; m < 4; ++m) _Pragma("unroll") for (int n = 0; n < 2; ++n) \
            acc[ai][bj][m][n] = __builtin_amdgcn_mfma_scale_f32_16x16x128_f8f6f4(Bt##8[n], At##8[m], acc[ai][bj][m][n], 0, 0, 0, 0x79797979, 0, SCALE_ACT); } \
        else { _Pragma("unroll") for (int m = 0; m < 4; ++m) _Pragma("unroll") for (int n = 0; n < 2; ++n) _Pragma("unroll") for (int k = 0; k < 2; ++k) \
            acc[ai][bj][m][n] = __builtin_amdgcn_mfma_f32_16x16x32_bf16(Bt[n][k], At[m][k], acc[ai][bj][m][n], 0, 0, 0); } \
        __builtin_amdgcn_s_setprio(0); } while (0)
#define PG8_WAIT_V(n) asm volatile("s_waitcnt vmcnt(" #n ")" ::: "memory")
#define PG8_WAIT_L(n) asm volatile("s_waitcnt lgkmcnt(" #n ")" ::: "memory")
#define PG8_BAR __builtin_amdgcn_s_barrier()
#define PG8_SCHED __builtin_amdgcn_sched_barrier(0)
    Unit cur, nxt; int ui = 0;
    if (!S.has(0)) return;
    (void)S.next(0, cur);
    f32x4 acc[2][2][4][2];
#pragma unroll
    for (int a = 0; a < 2; ++a)
#pragma unroll
        for (int b = 0; b < 2; ++b)
#pragma unroll
            for (int m = 0; m < 4; ++m)
#pragma unroll
                for (int n = 0; n < 2; ++n) acc[a][b][m][n] = (f32x4){0.f, 0.f, 0.f, 0.f};
    bf16x8 At[4][2], B0[2][2], B1[2][2]; i32x8 At8[4], B08[2], B18[2];
    const char* cA = cur.a; const char* cB = cur.b;
    PG8_STAGE(PG8_SB(0, 0), cB, voffB); PG8_STAGE(PG8_SB(0, 1), cB + hstepB, voffB); PG8_STAGE(PG8_SA(0, 0), cA, voffA); PG8_STAGE(PG8_SA(0, 1), cA + hstepA, voffA);
    { int w_ = wave; asm volatile("" : "+s"(w_)); if ((w_ >> 2) == 1) PG8_BAR; }
    PG8_WAIT_V(2); PG8_BAR;
    PG8_STAGE(PG8_SB(1, 0), cB + kstep, voffB); PG8_STAGE(PG8_SA(1, 0), cA + kstep, voffA); PG8_STAGE(PG8_SB(1, 1), cB + hstepB + kstep, voffB);
    PG8_WAIT_V(6); PG8_BAR;
    for (;;) {
        const bool has_next = S.has(ui + 1); nxt = cur; if (has_next) (void)S.next(ui + 1, nxt);
        const char* nA = has_next ? nxt.a : cA; const char* nB = has_next ? nxt.b : cB;
        for (int t = 0; t < nt; t += 2) {
            const bool last = (t == nt - 2);
            const char* a1 = cA + (size_t)(t + 1) * kstep;
            const char* a2 = last ? nA : cA + (size_t)(t + 2) * kstep; const char* b2 = last ? nB : cB + (size_t)(t + 2) * kstep;
            const char* a3 = a2 + kstep; const char* b3 = b2 + kstep;
            PG8_LDB(B0, 0, 0); PG8_LDB(B1, 0, 1); PG8_SCHED; PG8_LDA(At, 0, 0); PG8_STAGE(PG8_SA(1, 1), a1 + hstepA, voffA);
            PG8_WAIT_V(8); PG8_WAIT_L(0); PG8_BAR; PG8_MMA(0, 0, At, B0); PG8_MMA(0, 1, At, B1); PG8_BAR; PG8_SCHED;
            PG8_LDA(At, 0, 1); PG8_STAGE(PG8_SB(0, 0), b2, voffB); PG8_STAGE(PG8_SB(0, 1), b2 + hstepB, voffB); PG8_STAGE(PG8_SA(0, 0), a2, voffA);
            PG8_WAIT_V(8); PG8_WAIT_L(0); PG8_BAR; PG8_MMA(1, 0, At, B0); PG8_MMA(1, 1, At, B1); PG8_BAR; PG8_SCHED;
            PG8_LDB(B0, 1, 0); PG8_LDB(B1, 1, 1); PG8_SCHED; PG8_LDA(At, 1, 0); PG8_STAGE(PG8_SA(0, 1), a2 + hstepA, voffA);
            PG8_WAIT_V(8); PG8_WAIT_L(0); PG8_BAR; PG8_MMA(0, 0, At, B0); PG8_MMA(0, 1, At, B1); PG8_BAR; PG8_SCHED;
            PG8_LDA(At, 1, 1); PG8_STAGE(PG8_SB(1, 0), b3, voffB); PG8_STAGE(PG8_SB(1, 1), b3 + hstepB, voffB); PG8_STAGE(PG8_SA(1, 0), a3, voffA);
            PG8_WAIT_V(8); PG8_WAIT_L(0); PG8_BAR; PG8_MMA(1, 0, At, B0); PG8_MMA(1, 1, At, B1); PG8_BAR; PG8_SCHED;
        }
        { int w2_ = wave; asm volatile("" : "+s"(w2_));
          if ((w2_ >> 2) == 0) PG8_BAR;
          E(acc, cur, w2_ >> 2, w2_ & 3, 0, 0); }
        if (!S.has(ui + 1)) break;
#pragma unroll
        for (int a = 0; a < 2; ++a)
#pragma unroll
            for (int b = 0; b < 2; ++b)
#pragma unroll
                for (int m = 0; m < 4; ++m)
#pragma unroll
                    for (int n = 0; n < 2; ++n) acc[a][b][m][n] = (f32x4){0.f, 0.f, 0.f, 0.f};
        cur = nxt; cA = nA; cB = nB; ++ui;
        { int w_ = wave; asm volatile("" : "+s"(w_)); if ((w_ >> 2) == 1) PG8_BAR; }
    }
    PG8_WAIT_V(0);
    PG8_BAR;
#undef PG8_SA
#undef PG8_SB
#undef PG8_STAGE
#undef PG8_LDA
#undef PG8_LDB
#undef PG8_MMA
#undef PG8_WAIT_V
#undef PG8_WAIT_L
#undef PG8_BAR
#undef PG8_SCHED
}
}
namespace pg8 {
struct EpiQKV {
    static constexpr bool PERM = true;
    bf16_t *Qb, *Kb, *Vb; const float* qkw;
    __device__ __forceinline__ void operator()(const f32x4 (&acc)[2][2][4][2], const Unit& u, int wr, int wc, int, int) const {
        const int t_ = lane_now(); const int fr = t_ & 15, fq = (t_ >> 4) & 3;
        const int hs = __builtin_amdgcn_readfirstlane(u.pn * 4 + wc);
        bf16_t* dst; int rope = 0, norm = -1, dq = 0; float scale = 1.f;
        if (hs < 4)       { dst = Qb + (size_t)hs * MT * 64; scale = C2_64; }
        else if (hs < 8)  { dst = Kb + (size_t)(hs - 4) * MT * 64; }
        else if (hs < 12) { dst = Vb + (size_t)(hs - 8) * MT * 64; }
        else if (hs < 16) { dst = Qb + (size_t)(4 + 2 * (hs - 12)) * MT * 64; rope = 2; dq = 1; scale = C2_32; }
        else if (hs < 20) { dst = Kb + (size_t)(4 + hs - 16) * MT * 64; rope = 2; }
        else if (hs < 24) { dst = Vb + (size_t)(4 + hs - 20) * MT * 64; }
        else if (hs < 28) { dst = Qb + (size_t)(12 + hs - 24) * MT * 64; rope = 1; scale = C2_64; }
        else if (hs < 30) { dst = Kb + (size_t)(8 + hs - 28) * MT * 64; rope = 1; }
        else if (hs < 32) { dst = Vb + (size_t)(8 + hs - 30) * MT * 64; }
        else if (hs < 36) { dst = Qb + (size_t)(16 + hs - 32) * MT * 64; rope = 1; norm = 0; scale = C2_64; }
        else if (hs < 38) { dst = Kb + (size_t)(10 + hs - 36) * MT * 64; rope = 1; norm = 1; }
        else              { dst = Vb + (size_t)(10 + hs - 38) * MT * 64; }
        const bool latent = u.pm < SEQ / 256;
        if (!latent) rope = 0;
        float fstep = (rope == 2) ? (13.287712379549449f / 8.f) : (13.287712379549449f / 16.f); asm volatile("" : "+v"(fstep));
        const float fbase = (rope == 2) ? 0.f : (float)(8 * (fq & 1)) * fstep;
#define INVF(k) (fast_exp2(-(fbase + (float)(k) * fstep)) * 0.15915494309189535f)
#pragma unroll
        for (int m = 0; m < 4; ++m) {
            float csn[8], ccs[8];
            if (rope == 1) { float pos = (float)(m * 16 + fr); asm volatile("" : "+v"(pos));
#pragma unroll
                for (int k = 0; k < 8; ++k) { const float rev = pos * INVF(k); csn[k] = __builtin_amdgcn_sinf(rev); ccs[k] = __builtin_amdgcn_cosf(rev); } }
#pragma unroll
            for (int ai = 0; ai < 2; ++ai) {
                const int row = u.pm * BM + ai * HALF + wr * 64 + m * 16 + fr;
                float v[16];
#pragma unroll
                for (int bj = 0; bj < 2; ++bj)
#pragma unroll
                    for (int n = 0; n < 2; ++n)
#pragma unroll
                        for (int j = 0; j < 4; ++j) v[bj * 8 + n * 4 + j] = acc[ai][bj][m][n][j];
                if (norm >= 0) {
                    float ss = 0.f;
#pragma unroll
                    for (int k = 0; k < 16; ++k) ss += v[k] * v[k];
                    ss += xorf<16>(ss); ss = x32_sum(ss);
                    const float ri = __builtin_amdgcn_rsqf(ss * (1.f / 64.f) + EPS);
#pragma unroll
                    for (int bj = 0; bj < 2; ++bj) { const f32x4 w0 = *(const f32x4*)(qkw + norm * 64 + 32 * bj + 8 * fq), w1 = *(const f32x4*)(qkw + norm * 64 + 32 * bj + 8 * fq + 4);
#pragma unroll
                        for (int j = 0; j < 4; ++j) { v[bj * 8 + j] = v[bj * 8 + j] * ri * w0[j]; v[bj * 8 + 4 + j] = v[bj * 8 + 4 + j] * ri * w1[j]; } }
                }
                if (rope == 1) {
                    const float sgn = (fq & 2) ? 1.f : -1.f;
                    float pos = (float)(row >> 6); asm volatile("" : "+v"(pos));
#pragma unroll
                    for (int k = 0; k < 8; ++k) {
                        const float rev = pos * INVF(k); const float sn = __builtin_amdgcn_sinf(rev), cs = __builtin_amdgcn_cosf(rev);
                        const float x = v[k]; auto rx = __builtin_amdgcn_permlane32_swap(__float_as_uint(x), __float_as_uint(x), false, false);
                        const float pt = __uint_as_float((fq & 2) ? rx[0] : rx[1]);
                        v[k] = x * cs + sgn * pt * sn;
                        const float y = v[8 + k]; auto ry = __builtin_amdgcn_permlane32_swap(__float_as_uint(y), __float_as_uint(y), false, false);
                        const float qt = __uint_as_float((fq & 2) ? ry[0] : ry[1]);
                        v[8 + k] = y * ccs[k] + sgn * qt * csn[k];
                    }
                } else if (rope == 2) {
                    const float sgn = (fq & 1) ? 1.f : -1.f;
                    float pos = (float)(fq < 2 ? (row >> 6) : (row & 63)); asm volatile("" : "+v"(pos));
#pragma unroll
                    for (int k = 0; k < 8; ++k) {
                        const float rev = pos * INVF(k); const float sn = __builtin_amdgcn_sinf(rev), cs = __builtin_amdgcn_cosf(rev);
#pragma unroll
                        for (int bj = 0; bj < 2; ++bj) { const float x = v[bj * 8 + k], pt = xorf<16>(x); v[bj * 8 + k] = x * cs + sgn * pt * sn; }
                    }
                }
#pragma unroll
                for (int bj = 0; bj < 2; ++bj) {
                    v4u w; w.x = pk2(v[bj * 8 + 0] * scale, v[bj * 8 + 1] * scale); w.y = pk2(v[bj * 8 + 2] * scale, v[bj * 8 + 3] * scale);
                    w.z = pk2(v[bj * 8 + 4] * scale, v[bj * 8 + 5] * scale); w.w = pk2(v[bj * 8 + 6] * scale, v[bj * 8 + 7] * scale);
                    if (dq) {
                        *(v4u*)(dst + (size_t)bj * MT * 64 + (size_t)row * 64 + 32 * bj + 8 * fq) = w;
                        unsigned z0 = 0u; asm volatile("" : "+v"(z0));
                        *(v4u*)(dst + (size_t)(1 - bj) * MT * 64 + (size_t)row * 64 + 32 * bj + 8 * fq) = (v4u){z0, z0, z0, z0};
                    } else *(v4u*)(dst + (size_t)row * 64 + 32 * bj + 8 * fq) = w;
                }
                __builtin_amdgcn_sched_barrier(0);
            }
        }
#undef INVF
    }
};
struct EpiBranch {
    static constexpr bool PERM = true;
    bf16_t* Bp;
    __device__ __forceinline__ void operator()(const f32x4 (&acc)[2][2][4][2], const Unit& u, int wr, int wc, int, int) const {
        const int t_ = lane_now(); const int fr = t_ & 15, fq = (t_ >> 4) & 3;
        const int branch = u.pn >> 2, chb = 256 * (u.pn & 3) + 32 * wc + 8 * fq;
#pragma unroll
        for (int ai = 0; ai < 2; ++ai)
#pragma unroll
            for (int m = 0; m < 4; ++m) { bf16_t* rowp = Bp + (size_t)(u.pm * BM + ai * HALF + wr * 64 + m * 16 + fr) * 4096 + branch * 1024 + chb;
#pragma unroll
                for (int bj = 0; bj < 2; ++bj) { const f32x4 a = acc[ai][bj][m][0], c = acc[ai][bj][m][1];
                    v4u w; w.x = pk2(a[0], a[1]); w.y = pk2(a[2], a[3]); w.z = pk2(c[0], c[1]); w.w = pk2(c[2], c[3]); *(v4u*)(rowp + 128 * bj) = w; } }
    }
};
#ifndef BP8
#define BP8 1
#endif
#ifndef MIX8
#define MIX8 1
#endif
#if MIX8 && !BP8
#error MIX8 needs BP8
#endif
constexpr float BP8_SCALE = 32.f;
struct EpiBranch8 {
    static constexpr bool PERM = false, WIDE = true;
    unsigned char* Bp;
    __device__ __forceinline__ void operator()(const f32x4 (&acc)[2][2][4][2], const Unit& u, int wr, int wc, int, int) const {
        const int t_ = lane_now(); const int fr = t_ & 15, fq = (t_ >> 4) & 3;
        const int branch = u.pn >> 2, off = (4 * (u.pn & 3) + wc) * 256 + branch * 64 + 16 * fq;
#pragma unroll
        for (int ai = 0; ai < 2; ++ai)
#pragma unroll
            for (int m = 0; m < 4; ++m) { unsigned char* rowp = Bp + (size_t)(u.pm * BM + ai * HALF + wr * 64 + m * 16 + fr) * 4096 + off;
                v4u w;
#pragma unroll
                for (int bj = 0; bj < 2; ++bj) { const f32x4 a = acc[ai][bj][m][0] * BP8_SCALE, c = acc[ai][bj][m][1] * BP8_SCALE;
                    w[2 * bj] = pk4_fp8(a[0], a[1], a[2], a[3]); w[2 * bj + 1] = pk4_fp8(c[0], c[1], c[2], c[3]); }
                *(v4u*)rowp = w; }
    }
};
struct EpiGate {
    static constexpr bool PERM = false;
    const bf16_t* Bp; bf16_t* mix; const float* bgate;
    __device__ __forceinline__ void operator()(const f32x4 (&acc)[2][2][4][2], const Unit& u, int wr, int wc, int, int) const {
        const int t_ = lane_now(); const int fr = t_ & 15, fq = (t_ >> 4) & 3;
        const int ch = 64 * u.pn + 16 * wc + 4 * fq;
        f32x4 bias[2][2];
#pragma unroll
        for (int bj = 0; bj < 2; ++bj)
#pragma unroll
            for (int n = 0; n < 2; ++n) bias[bj][n] = *(const f32x4*)(bgate + (2 * bj + n) * 1024 + ch);
#if BP8
        unsigned b8a[2][4][4];
#pragma unroll
        for (int ai = 0; ai < 2; ++ai)
#pragma unroll
            for (int m = 0; m < 4; ++m) { const size_t row = (size_t)(u.pm * BM + ai * HALF + wr * 64 + m * 16 + fr);
#pragma unroll
                for (int b = 0; b < 4; ++b) b8a[ai][m][b] = *(const unsigned*)((const unsigned char*)Bp + row * 4096 + u.pn * 256 + b * 64 + 16 * wc + 4 * fq); }
#endif
#pragma unroll
        for (int ai = 0; ai < 2; ++ai)
#pragma unroll
            for (int m = 0; m < 4; ++m) { const size_t row = (size_t)(u.pm * BM + ai * HALF + wr * 64 + m * 16 + fr);
                f32x4 s = {0.f, 0.f, 0.f, 0.f};
#if BP8
#pragma unroll
                for (int bj = 0; bj < 2; ++bj)
#pragma unroll
                    for (int n = 0; n < 2; ++n) { const f32x4 a = acc[ai][bj][m][n] + bias[bj][n]; const int w = (int)b8a[ai][m][2 * bj + n];
                        const f32x2 lo = __builtin_amdgcn_cvt_pk_f32_fp8(w, false), hi = __builtin_amdgcn_cvt_pk_f32_fp8(w, true);
                        s[0] += sigmoidf_(a[0]) * lo.x; s[1] += sigmoidf_(a[1]) * lo.y; s[2] += sigmoidf_(a[2]) * hi.x; s[3] += sigmoidf_(a[3]) * hi.y; }
#if !MIX8
                s = s * (1.f / BP8_SCALE);
#endif
#else
                v2u bb[4];
#pragma unroll
                for (int b = 0; b < 4; ++b) bb[b] = *(const v2u*)(Bp + row * 4096 + b * 1024 + ch);
#pragma unroll
                for (int bj = 0; bj < 2; ++bj)
#pragma unroll
                    for (int n = 0; n < 2; ++n) { const f32x4 a = acc[ai][bj][m][n] + bias[bj][n]; const unsigned w0 = bb[2 * bj + n].x, w1 = bb[2 * bj + n].y;
                        s[0] += sigmoidf_(a[0]) * bflo(w0); s[1] += sigmoidf_(a[1]) * bfhi(w0); s[2] += sigmoidf_(a[2]) * bflo(w1); s[3] += sigmoidf_(a[3]) * bfhi(w1); }
#endif
#if MIX8
                *(unsigned*)((unsigned char*)mix + row * 1024 + ch) = pk4_fp8(s[0], s[1], s[2], s[3]); }
#else
                v2u w; w.x = pk2(s[0], s[1]); w.y = pk2(s[2], s[3]); *(v2u*)(mix + row * 1024 + ch) = w; }
#endif
    }
};
struct EpiOut {
    static constexpr bool PERM = false;
    const float* xl; const float* xc; float* X; const float* gl; const float* gc;
    __device__ __forceinline__ void operator()(const f32x4 (&acc)[2][2][4][2], const Unit& u, int wr, int wc, int, int) const {
        const int t_ = lane_now(); const int fr = t_ & 15, fq = (t_ >> 4) & 3;
        const bool latent = u.pm < SEQ / 256; const float* gv = latent ? gl : gc; const float* xo = latent ? xl : xc - (size_t)SEQ * DM;
        const int col0 = u.pn * BM + wc * 32 + 4 * fq;
        f32x4 g[2][2];
#pragma unroll
        for (int bj = 0; bj < 2; ++bj)
#pragma unroll
            for (int n = 0; n < 2; ++n) g[bj][n] = *(const f32x4*)(gv + col0 + bj * HALF + n * 16);
#pragma unroll
        for (int ai = 0; ai < 2; ++ai)
#pragma unroll
            for (int m = 0; m < 4; ++m) { const size_t off = (size_t)(u.pm * BM + ai * HALF + wr * 64 + m * 16 + fr) * DM + col0;
#pragma unroll
                for (int bj = 0; bj < 2; ++bj)
#pragma unroll
                    for (int n = 0; n < 2; ++n) { const f32x4 o = *(const f32x4*)(xo + off + bj * HALF + n * 16); *(f32x4*)(X + off + bj * HALF + n * 16) = o + g[bj][n] * acc[ai][bj][m][n]; } }
    }
};
struct EpiOutNorm {
    static constexpr bool PERM = true;
    const float* xl; const float* xc; float* X; const float* gl; const float* gc;
    bf16_t* H; const float* nw; const float* ml; const float* mc;
    gu32* xbuf; gu32* cnt; gu32* tmo; LAS unsigned char* tl;
    __device__ __forceinline__ void operator()(f32x4 (&acc)[2][2][4][2], const Unit& u, int wr, int wc, int, int) const {
        const int t_ = lane_now(); const int fr = t_ & 15, fq = (t_ >> 4) & 3;
        const bool latent = u.pm < SEQ / 256; const float* gv = latent ? gl : gc; const float* xo = latent ? xl : xc - (size_t)SEQ * DM;
        const int col0 = u.pn * BM + wc * 32 + 8 * fq;
        LAS float* P = (LAS float*)tl; LAS float* Sr = (LAS float*)(tl + 4096); volatile LAS unsigned* flag = (volatile LAS unsigned*)(tl + 5120);
        {
            f32x4 g[2][2];
#pragma unroll
            for (int bj = 0; bj < 2; ++bj)
#pragma unroll
                for (int n = 0; n < 2; ++n) g[bj][n] = *(const f32x4*)(gv + col0 + bj * HALF + n * 4);
            f32x4 xo_c[2][2], xo_n[2][2];
#define EON_LOAD(dst, it_) do { const int r_ = ((it_) >> 2) * HALF + wr * 64 + ((it_) & 3) * 16 + fr; const size_t off_ = (size_t)(u.pm * BM + r_) * DM + col0; \
            _Pragma("unroll") for (int bj = 0; bj < 2; ++bj) _Pragma("unroll") for (int n = 0; n < 2; ++n) dst[bj][n] = *(const f32x4*)(xo + off_ + bj * HALF + n * 4); } while (0)
            EON_LOAD(xo_c, 0);
#pragma unroll
            for (int it = 0; it < 8; ++it) { const int ai = it >> 2, m = it & 3;
                if (it < 7) EON_LOAD(xo_n, it + 1);
                const int r = ai * HALF + wr * 64 + m * 16 + fr; const size_t off = (size_t)(u.pm * BM + r) * DM + col0; float s = 0.f;
#pragma unroll
                for (int bj = 0; bj < 2; ++bj)
#pragma unroll
                    for (int n = 0; n < 2; ++n) { const f32x4 y = xo_c[bj][n] + g[bj][n] * acc[ai][bj][m][n];
                        *(f32x4*)(X + off + bj * HALF + n * 4) = y; acc[ai][bj][m][n] = y; s += (y.x * y.x + y.y * y.y) + (y.z * y.z + y.w * y.w); }
                s += xorf<16>(s); s = x32_sum(s);
                if (fq == 0) P[r * 4 + wc] = s;
#pragma unroll
                for (int bj = 0; bj < 2; ++bj)
#pragma unroll
                    for (int n = 0; n < 2; ++n) xo_c[bj][n] = xo_n[bj][n]; }
#undef EON_LOAD
        }
        asm volatile("s_waitcnt lgkmcnt(0)" ::: "memory"); __builtin_amdgcn_s_barrier(); asm volatile("" ::: "memory");
        const int wid = wr * 4 + wc, row = wid * 32 + (t_ & 31);
        if (t_ < 32) { const float tp = (P[row * 4 + 0] + P[row * 4 + 1]) + (P[row * 4 + 2] + P[row * 4 + 3]);
            __hip_atomic_store(xbuf + ((size_t)(u.pm * BM + row) * 4 + u.pn), __float_as_uint(tp), RLX_AGENT); }
        asm volatile("s_waitcnt vmcnt(0)" ::: "memory");
        if (t_ == 0) (void)__hip_atomic_fetch_add(cnt + 64 * u.pm, 1u, RLX_AGENT);
        if (wid == 0) {
            unsigned sp = 0u, dead = 0u;
            while ((unsigned)__builtin_amdgcn_readfirstlane((int)__hip_atomic_load(cnt + 64 * u.pm, RLX_AGENT)) < 32u) {
                __builtin_amdgcn_s_sleep(2);
                if ((++sp & 255u) == 0u) { if (__builtin_amdgcn_readfirstlane((int)__hip_atomic_load(tmo, RLX_AGENT)) != 0) { dead = 1u; break; }
                    if (sp > (1u << 22)) { if (t_ == 0) __hip_atomic_store(tmo, 1u, RLX_AGENT); dead = 1u; break; } } }
            __builtin_amdgcn_fence(__ATOMIC_ACQUIRE, "agent");
            if (t_ == 0) flag[0] = dead;
        }
        asm volatile("s_waitcnt vmcnt(0) lgkmcnt(0)" ::: "memory"); __builtin_amdgcn_s_barrier(); asm volatile("" ::: "memory");
        if (t_ < 32) { const gu32* sl = xbuf + (size_t)(u.pm * BM + row) * 4; float tot = 0.f;
#pragma unroll
            for (int q = 0; q < 4; ++q) tot += __uint_as_float(__hip_atomic_load(sl + q, RLX_AGENT));
            Sr[row] = __builtin_amdgcn_rsqf(tot * (1.f / DM) + EPS); }
        asm volatile("s_waitcnt vmcnt(0) lgkmcnt(0)" ::: "memory"); __builtin_amdgcn_s_barrier(); asm volatile("" ::: "memory");
        const float* mv = latent ? ml : mc;
#pragma unroll
        for (int bj = 0; bj < 2; ++bj) { const int col = col0 + bj * HALF;
            f32x4 wa[2], b[2];
#pragma unroll
            for (int n = 0; n < 2; ++n) { const f32x4 w = *(const f32x4*)(nw + col + 4 * n), a = *(const f32x4*)(mv + 4096 + col + 4 * n); b[n] = *(const f32x4*)(mv + 3072 + col + 4 * n); wa[n] = w * (1.0f + a); }
#pragma unroll
            for (int ai = 0; ai < 2; ++ai)
#pragma unroll
                for (int m = 0; m < 4; ++m) { const int r = ai * HALF + wr * 64 + m * 16 + fr; const float ri = Sr[r];
                    const f32x4 y0 = (acc[ai][bj][m][0] * ri) * wa[0] + b[0], y1 = (acc[ai][bj][m][1] * ri) * wa[1] + b[1];
                    v4u pk; pk.x = pk2(y0.x, y0.y); pk.y = pk2(y0.z, y0.w); pk.z = pk2(y1.x, y1.y); pk.w = pk2(y1.z, y1.w); *(v4u*)(H + (size_t)(u.pm * BM + r) * DM + col) = pk; } }
    }
};
struct EpiS {
    static constexpr bool PERM = true;
    float* S;
    __device__ __forceinline__ void operator()(const f32x4 (&acc)[2][2][4][2], const Unit& u, int wr, int wc, int, int) const {
        const int t_ = lane_now(); const int fr = t_ & 15, fq = (t_ >> 4) & 3;
        const int col0 = u.pn * BM + wc * 32 + 8 * fq;
        bf16_t* Sb = (bf16_t*)S;
#pragma unroll
        for (int ai = 0; ai < 2; ++ai)
#pragma unroll
            for (int m = 0; m < 4; ++m) { bf16_t* rowp = Sb + (size_t)(u.pm * BM + ai * HALF + wr * 64 + m * 16 + fr) * 2048 + col0;
#pragma unroll
                for (int bj = 0; bj < 2; ++bj) { const f32x4 a0 = acc[ai][bj][m][0], a1 = acc[ai][bj][m][1];
                    v4u o; o.x = pk2(a0.x, a0.y); o.y = pk2(a0.z, a0.w); o.z = pk2(a1.x, a1.y); o.w = pk2(a1.z, a1.w);
                    *(v4u*)(rowp + bj * HALF) = o; } }
    }
};
}
namespace att {
using bf16 = __hip_bfloat16;
constexpr int NW = 8, QBLK = 32, QB = 256, KVBLK = 64;
__device__ __forceinline__ int crow(int r, int hi) { return (r & 3) + 8 * (r >> 2) + 4 * hi; }
#define SBAR() __builtin_amdgcn_sched_barrier(0)
constexpr int NSLOT = 3, SLOTB = 8192;
constexpr int LDS_K = 0, LDS_V = NSLOT * SLOTB, LDS_WS = 2 * NSLOT * SLOTB, LDS_OST = LDS_WS + NW * 64 * 4, LDS_RPB = LDS_OST + NW * 8192, LDS_BYTES = LDS_RPB + 2048;
static_assert(LDS_BYTES <= RING_BYTES, "attention scratch fits the ring region");
__device__ __forceinline__ void glds16(const void* gsrc, unsigned lds_dst) { unsigned keep;
    asm volatile("s_mov_b32 %0, m0\n\ts_mov_b32 m0, %2\n\ts_nop 0\n\tglobal_load_lds_dwordx4 %1, off\n\ts_mov_b32 m0, %0" : "=&s"(keep) : "v"(gsrc), "s"(lds_dst) : "memory"); }
__device__ __forceinline__ float max3f(float a, float b, float c) { float r; asm("v_max3_f32 %0, %1, %2, %3" : "=v"(r) : "v"(a), "v"(b), "v"(c)); return r; }
__device__ __forceinline__ float max2f(float a, float b) { float r; asm("v_max_f32_e32 %0, %1, %2" : "=v"(r) : "v"(a), "v"(b)); return r; }
__device__ __forceinline__ float fadd_s(float a, float b) { float r; asm("v_add_f32_e32 %0, %1, %2" : "=v"(r) : "v"(a), "v"(b)); return r; }
__device__ __forceinline__ float fsub_s(float a, float b) { float r; asm("v_sub_f32_e32 %0, %1, %2" : "=v"(r) : "v"(a), "v"(b)); return r; }
__device__ __forceinline__ unsigned cvtpk_s(float lo, float hi) { f32x2 v = {lo, hi}; bf16x2_t b = __builtin_convertvector(v, bf16x2_t); return __builtin_bit_cast(unsigned, b); }
#define WAIT_BAR(N) asm volatile("s_waitcnt vmcnt(" #N ") lgkmcnt(0)\n\ts_barrier" ::: "memory")

__device__ __forceinline__ void qkt(f32x16& p0, f32x16& p1, const char* Kslot, const bf16x8* qr, const f32x16& negm, int r32, int hi) {
    const char* kb = Kslot + hi * 1024 + r32 * 16;
#pragma unroll
    for (int d0 = 0; d0 < 4; ++d0) {
        const bf16x8 b0 = *reinterpret_cast<const bf16x8*>(kb + d0 * 2048);
        const bf16x8 b1 = *reinterpret_cast<const bf16x8*>(kb + d0 * 2048 + 512);
        if (d0 == 0) { p0 = __builtin_amdgcn_mfma_f32_32x32x16_bf16(b0, qr[0], negm, 0, 0, 0); p1 = __builtin_amdgcn_mfma_f32_32x32x16_bf16(b1, qr[0], negm, 0, 0, 0); }
        else { p0 = __builtin_amdgcn_mfma_f32_32x32x16_bf16(b0, qr[d0], p0, 0, 0, 0); p1 = __builtin_amdgcn_mfma_f32_32x32x16_bf16(b1, qr[d0], p1, 0, 0, 0); } }
}
typedef __attribute__((address_space(3))) const char* lds_cptr;
typedef short v4i16_t __attribute__((ext_vector_type(4)));
__device__ __forceinline__ void kload8(bf16x8* kf, lds_cptr kp) {
    kf[0] = *(const __attribute__((address_space(3))) bf16x8*)(kp);        kf[1] = *(const __attribute__((address_space(3))) bf16x8*)(kp + 512);
    kf[2] = *(const __attribute__((address_space(3))) bf16x8*)(kp + 2048); kf[3] = *(const __attribute__((address_space(3))) bf16x8*)(kp + 2560);
    kf[4] = *(const __attribute__((address_space(3))) bf16x8*)(kp + 4096); kf[5] = *(const __attribute__((address_space(3))) bf16x8*)(kp + 4608);
    kf[6] = *(const __attribute__((address_space(3))) bf16x8*)(kp + 6144); kf[7] = *(const __attribute__((address_space(3))) bf16x8*)(kp + 6656);
}
__device__ __forceinline__ void kload2(bf16x8* kf, lds_cptr kp, int j) { kf[2 * j] = *(const __attribute__((address_space(3))) bf16x8*)(kp + j * 2048); kf[2 * j + 1] = *(const __attribute__((address_space(3))) bf16x8*)(kp + j * 2048 + 512); }
__device__ __forceinline__ s16x4 vtr(lds_cptr p) { return __builtin_bit_cast(s16x4, __builtin_amdgcn_ds_read_tr16_b64_v4i16((__attribute__((address_space(3))) v4i16_t*)p)); }
__device__ __forceinline__ float rowmax(const f32x16& p0, const f32x16& p1) {
    float a = max3f(p0[0], p0[1], p1[0]), b = max3f(p0[2], p0[3], p1[1]); a = max3f(a, p1[2], p1[3]);
#pragma unroll
    for (int r = 4; r < 16; r += 4) { a = max3f(a, p0[r], p0[r + 1]); b = max3f(b, p0[r + 2], p0[r + 3]); a = max3f(a, p1[r], p1[r + 1]); b = max3f(b, p1[r + 2], p1[r + 3]); }
    const float m = max2f(a, b);
    auto rr = __builtin_amdgcn_permlane32_swap(__float_as_uint(m), __float_as_uint(m), false, false);
    return max2f(__uint_as_float(rr[0]), __uint_as_float(rr[1]));
}
__device__ __forceinline__ void pv(f32x16* o, int vb, bf16x8 pa0, bf16x8 pa1, bf16x8 pa2, bf16x8 pa3) {
#pragma unroll
    for (int d0 = 0; d0 < 2; ++d0) { s16x4 lo[4], hi[4];
#pragma unroll
        for (int ks = 0; ks < 4; ++ks) {
            asm volatile("ds_read_b64_tr_b16 %0,%1 offset:%c2" : "=&v"(lo[ks]) : "v"(vb), "i"(d0 * 4096 + ks * 1024) : "memory");
            asm volatile("ds_read_b64_tr_b16 %0,%1 offset:%c2" : "=&v"(hi[ks]) : "v"(vb), "i"(d0 * 4096 + ks * 1024 + 512) : "memory"); }
        asm volatile("s_waitcnt lgkmcnt(0)" ::: "memory"); SBAR();
#define PK(k) (bf16x8){lo[k][0], lo[k][1], lo[k][2], lo[k][3], hi[k][0], hi[k][1], hi[k][2], hi[k][3]}
        o[d0] = __builtin_amdgcn_mfma_f32_32x32x16_bf16(pa0, PK(0), o[d0], 0, 0, 0);
        o[d0] = __builtin_amdgcn_mfma_f32_32x32x16_bf16(pa1, PK(1), o[d0], 0, 0, 0);
        o[d0] = __builtin_amdgcn_mfma_f32_32x32x16_bf16(pa2, PK(2), o[d0], 0, 0, 0);
        o[d0] = __builtin_amdgcn_mfma_f32_32x32x16_bf16(pa3, PK(3), o[d0], 0, 0, 0);
#undef PK
    }
}

struct AU {
    const bf16* Q; const bf16* K; const bf16* V;
    bf16* O;
    int q0, NT, kbase;
    float sinkl2;
    int emode;
    float lam, oscale; const float* subw;
};

template <int MODE> __device__ __forceinline__ void amask(f32x16& p0, f32x16& p1, int t, const AU& u, int wid, int r32, int hi, const float* rpb) {
    if constexpr (MODE == 2) {
        if (t >= 4) {
            const int kp0 = u.kbase + 64 * (t - 4) + 4 * hi, qpos = u.q0 + wid * QBLK + r32;
#pragma unroll
            for (int r = 0; r < 16; ++r) { const int kv = kp0 + (r & 3) + 8 * (r >> 2);
                const bool ok0 = ((unsigned)(kv - qpos + 128) <= 256u) && ((unsigned)kv < (unsigned)SEQ);
                const bool ok1 = ((unsigned)(kv + 32 - qpos + 128) <= 256u) && ((unsigned)(kv + 32) < (unsigned)SEQ);
                if (!ok0) p0[r] = -INFINITY; if (!ok1) p1[r] = -INFINITY; }
        }
    }
    if constexpr (MODE == 1) {
        if (t >= 4) {
            const int jr = (u.kbase >> 6) + (t - 4), qr = (u.q0 >> 6) + (wid >> 1), qc = 32 * (wid & 1) + r32;
            int rs = qr - 4; rs = rs < 0 ? 0 : (rs > 248 ? 248 : rs);
            int cs = qc - 8; cs = cs < 0 ? 0 : (cs > 48 ? 48 : cs);
            const bool rowok = (unsigned)(jr - rs) < 8u;
            int ro = jr - qr + 7; ro = ro < 0 ? 0 : (ro > 14 ? 14 : ro);
            const float* brow = rpb + ro * 32;
#pragma unroll
            for (int r = 0; r < 16; ++r) { const int kc = 4 * hi + (r & 3) + 8 * (r >> 2);
                { int bi = kc - qc + 15; bi = bi < 0 ? 0 : (bi > 30 ? 30 : bi); const bool ok = rowok && ((unsigned)(kc - cs) < 16u); p0[r] = ok ? p0[r] + brow[bi] : -INFINITY; }
                { int bi = kc + 32 - qc + 15; bi = bi < 0 ? 0 : (bi > 30 ? 30 : bi); const bool ok = rowok && ((unsigned)(kc + 32 - cs) < 16u); p1[r] = ok ? p1[r] + brow[bi] : -INFINITY; } }
        }
    }
}

template <int MODE, int THRL, int QKH = 0, int NOMAX = 0> __device__ __forceinline__ bool attn_unit(const AU& u, char* shm, int wave) {
    const int lane = lane_now(), tid = (wave << 6) | lane, r32 = lane & 31, hi = lane >> 5; const int wid = wave;
    const bf16* Qw = u.Q + (size_t)(u.q0 + wid * QBLK) * 64;
    const bf16* Kh = u.K; const bf16* Vh = u.V;
    const unsigned lds0 = (unsigned)(uintptr_t)shm;
    float* wsf = (float*)(shm + LDS_WS) + wid * 64;
    const float* rpb = (const float*)(shm + LDS_RPB);
    const int NT = u.NT;
    volatile int* okflag = (volatile int*)(shm + LDS_RPB + 2040);
    if constexpr (NOMAX) { if (tid == 0) *okflag = 0; }
#define KROW(t) ((t) < 4 ? SEQ + 64 * (t) : (u.kbase + 64 * ((t) - 4) < 0 ? 0 : (u.kbase + 64 * ((t) - 4) > SEQ - 64 ? SEQ - 64 : u.kbase + 64 * ((t) - 4))))
    const bf16* ksrc = Kh + (size_t)lane * 64 + wid * 8;
    const bf16* vsrc = Vh + (size_t)(16 * (wid & 3) + (lane >> 2)) * 64 + (wid >> 2) * 32 + (lane & 3) * 8;
    const unsigned kdst = lds0 + LDS_K + wid * 1024, vdst = lds0 + LDS_V + wid * 1024;
#define DMA_K(t, slot) glds16(ksrc + (size_t)KROW(t) * 64, (unsigned)__builtin_amdgcn_readfirstlane(kdst + (slot)))
#define DMA_V(t, slot) glds16(vsrc + (size_t)KROW(t) * 64, (unsigned)__builtin_amdgcn_readfirstlane(vdst + (slot)))
    const int vb0 = (int)(lds0 + LDS_V) + ((lane >> 4) & 1) * 32 + (lane & 3) * 8 + (4 * hi + ((lane & 15) >> 2)) * 64;
    const char* Kbase = shm + LDS_K; bf16x8 kf[8];
    const lds_cptr shm3 = (lds_cptr)shm; const lds_cptr kp0 = shm3 + LDS_K + hi * 1024 + r32 * 16; const lds_cptr vp0 = shm3 + LDS_V + ((lane >> 4) & 1) * 32 + (lane & 3) * 8 + (4 * hi + ((lane & 15) >> 2)) * 64;
    DMA_K(0, 0); DMA_V(0, 0); DMA_K(1, SLOTB);
    bf16x8 qr[4];
#pragma unroll
    for (int d0 = 0; d0 < 4; ++d0) qr[d0] = *reinterpret_cast<const bf16x8*>(&Qw[(size_t)r32 * 64 + d0 * 16 + hi * 8]);
    float mhat = 0.f, l_reg = 0.f; f32x16 o[2]; o[0] = f32x16{}; o[1] = f32x16{}; f32x16 negm = f32x16{}; asm volatile("" : "+v"(negm));
#define CMASK(P0, P1, t) amask<MODE>(P0, P1, (t), u, wid, r32, hi, rpb)
    bool resc = false;
#define START(P0, P1) do { const float rm = rowmax(P0, P1); resc = false; \
    { const float dl = rm; mhat = fadd_s(mhat, dl); \
      _Pragma("unroll") for (int r = 0; r < 16; ++r) { P0[r] = fsub_s(P0[r], dl); P1[r] = fsub_s(P1[r], dl); } \
      _Pragma("unroll") for (int r = 0; r < 16; ++r) negm[r] = -mhat; asm volatile("" : "+v"(negm)); } \
    _Pragma("unroll") for (int r = 0; r < 16; ++r) P0[r] = __builtin_amdgcn_exp2f(P0[r]); } while (0)
#define RESC() do { if (resc) { asm volatile("s_waitcnt lgkmcnt(0)" ::: "memory"); \
      _Pragma("unroll") for (int d_ = 0; d_ < 2; ++d_) _Pragma("unroll") for (int r = 0; r < 16; ++r) o[d_][r] *= wsf[crow(r, hi)]; } } while (0)
    f32x16 pA0, pA1, pB0, pB1;
    int sl_prev = 0, sl_cur = 0, sl_next = SLOTB;
#define ROT() do { sl_prev = sl_cur; sl_cur = sl_next; sl_next = (sl_next == (NSLOT - 1) * SLOTB) ? 0 : sl_next + SLOTB; } while (0)
    DMA_K(2, 2 * SLOTB);
    WAIT_BAR(3);
    qkt(pA0, pA1, Kbase, qr, negm, r32, hi); asm volatile("s_nop 15\n\ts_nop 7" : "+v"(pA0), "+v"(pA1));
    START(pA0, pA1);
    _Pragma("unroll") for (int r = 0; r < 16; ++r) pA1[r] = __builtin_amdgcn_exp2f(pA1[r]);
    WAIT_BAR(0);
    DMA_K(3, 0); DMA_V(1, SLOTB);
    ROT();
    kload8(kf, kp0 + sl_cur);
    WAIT_BAR(2);
    s16x4 vlo[8], vhi[8]; v4u pw0, pw1, pw2, pw3;
#define PKW(P, B) cvtpk_s(P[B], P[B + 1])
#define PAF(k) __builtin_bit_cast(bf16x8, pw##k)
#define VFR(i) (bf16x8){vlo[i][0], vlo[i][1], vlo[i][2], vlo[i][3], vhi[i][0], vhi[i][1], vhi[i][2], vhi[i][3]}
#define PIN(x) asm volatile("" : "+v"(x))
#define MX3(a, b, c) __builtin_fmaxf(__builtin_fmaxf((a), (b)), (c))
#define GAPA(MF, A0, A1, A2, A3, W0, W1, PW) do { MF; sacc += A0; sacc += A1; sacc += A2; sacc += A3; PIN(sacc); W0; W1; PIN(PW); SBAR(); } while (0)
#define EX(v) __builtin_amdgcn_exp2f(v)
#define GAPB(MF, X, B) do { MF; X[B] = EX(X[B]); X[B + 1] = EX(X[B + 1]); X[B + 2] = EX(X[B + 2]); X[B + 3] = EX(X[B + 3]); PIN(X); SBAR(); } while (0)
#define VRD(i) do { vlo[i] = vtr(vp_ + (((i) >> 2) * 4096 + ((i) & 3) * 1024)); vhi[i] = vtr(vp_ + (((i) >> 2) * 4096 + ((i) & 3) * 1024 + 512)); } while (0)
#define KRD(G, j) do { if constexpr (QKH == 0 || (QKH == 1 && (j) < 2) || (QKH == 2 && (j) >= 2)) { if (G) { kload2(kf, kp0 + sl_next, j); SBAR(); } } } while (0)
#define MF32(a, b, c) __builtin_amdgcn_mfma_f32_32x32x16_bf16(a, b, c, 0, 0, 0)
#define QLO(X) do { if constexpr (QKH != 2) { X; } } while (0)
#define QHI(X0, X2) do { if constexpr (QKH == 0) { X0; } else if constexpr (QKH == 2) { X2; } } while (0)
#define STEP(C0, C1, P0, P1, t, GK, GV, GL) do { SBAR(); \
    const lds_cptr vp_ = vp0 + sl_prev; \
    VRD(0); SBAR(); float sacc = (P0[0] + P0[1]); \
    GAPA(QLO(C0 = MF32(kf[0], qr[0], negm)), P0[2], P0[3], P0[4], P0[5],     pw0[0] = PKW(P0, 0), pw0[1] = PKW(P0, 2), pw0); \
    VRD(4); SBAR(); GAPA(QLO(C1 = MF32(kf[1], qr[0], negm)), P0[6], P0[7], P0[8], P0[9],     pw0[2] = PKW(P0, 4), pw0[3] = PKW(P0, 6), pw0); \
    VRD(1); SBAR(); GAPA(QLO(C0 = MF32(kf[2], qr[1], C0)), P0[10], P0[11], P0[12], P0[13], pw1[0] = PKW(P0, 8), pw1[1] = PKW(P0, 10), pw1); \
    VRD(5); SBAR(); GAPA(QLO(C1 = MF32(kf[3], qr[1], C1)), P0[14], P0[15], P1[0], P1[1],   pw1[2] = PKW(P0, 12), pw1[3] = PKW(P0, 14), pw1); \
    VRD(2); SBAR(); GAPA(QHI(C0 = MF32(kf[4], qr[2], C0), C0 = MF32(kf[4], qr[2], negm)), P1[2], P1[3], P1[4], P1[5],     pw2[0] = PKW(P1, 0), pw2[1] = PKW(P1, 2), pw2); \
    VRD(6); SBAR(); GAPA(QHI(C1 = MF32(kf[5], qr[2], C1), C1 = MF32(kf[5], qr[2], negm)), P1[6], P1[7], P1[8], P1[9],     pw2[2] = PKW(P1, 4), pw2[3] = PKW(P1, 6), pw2); \
    VRD(3); SBAR(); GAPA(QHI(C0 = MF32(kf[6], qr[3], C0), C0 = MF32(kf[6], qr[3], C0)), P1[10], P1[11], P1[12], P1[13], pw3[0] = PKW(P1, 8), pw3[1] = PKW(P1, 10), pw3); \
    VRD(7); SBAR(); GAPA(QHI(C1 = MF32(kf[7], qr[3], C1), C1 = MF32(kf[7], qr[3], C1)), P1[14], P1[15], 0.f, 0.f,       pw3[2] = PKW(P1, 12), pw3[3] = PKW(P1, 14), pw3); \
    l_reg += sacc; \
    if (GK) { DMA_K((t) + 3, sl_cur); } if (GV) { DMA_V((t) + 1, sl_next); } \
    CMASK(C0, C1, t); \
    if constexpr (NOMAX) { resc = false; } else { float a = MX3(C0[0], C0[1], C1[0]), b = MX3(C0[2], C0[3], C1[1]); a = MX3(a, C1[2], C1[3]); \
      _Pragma("unroll") for (int r = 4; r < 16; r += 4) { a = MX3(a, C0[r], C0[r + 1]); b = MX3(b, C0[r + 2], C0[r + 3]); a = MX3(a, C1[r], C1[r + 1]); b = MX3(b, C1[r + 2], C1[r + 3]); } \
      float rm = __builtin_fmaxf(a, b); { auto rr = __builtin_amdgcn_permlane32_swap(__float_as_uint(rm), __float_as_uint(rm), false, false); rm = __builtin_fmaxf(__uint_as_float(rr[0]), __uint_as_float(rr[1])); } \
      resc = false; \
      if (__builtin_expect(__any(rm > (float)THRL), 0)) { const float dl = __builtin_fmaxf(rm, 0.f); mhat += dl; \
        _Pragma("unroll") for (int r = 0; r < 16; ++r) { C0[r] -= dl; C1[r] -= dl; } \
        _Pragma("unroll") for (int r = 0; r < 16; ++r) negm[r] = -mhat; asm volatile("" : "+v"(negm)); \
        const float f = __builtin_amdgcn_exp2f(-dl); l_reg *= f; if (hi == 0) wsf[r32] = f; resc = true; } } \
    SBAR(); \
    GAPB(o[0] = __builtin_amdgcn_mfma_f32_32x32x16_bf16(PAF(0), VFR(0), o[0], 0, 0, 0), C0, 0); \
    GAPB(o[1] = __builtin_amdgcn_mfma_f32_32x32x16_bf16(PAF(0), VFR(4), o[1], 0, 0, 0), C0, 4); \
    KRD(GL, 0); GAPB(o[0] = __builtin_amdgcn_mfma_f32_32x32x16_bf16(PAF(1), VFR(1), o[0], 0, 0, 0), C0, 8); \
    KRD(GL, 1); GAPB(o[1] = __builtin_amdgcn_mfma_f32_32x32x16_bf16(PAF(1), VFR(5), o[1], 0, 0, 0), C0, 12); \
    KRD(GL, 2); GAPB(o[0] = __builtin_amdgcn_mfma_f32_32x32x16_bf16(PAF(2), VFR(2), o[0], 0, 0, 0), C1, 0); \
    KRD(GL, 3); GAPB(o[1] = __builtin_amdgcn_mfma_f32_32x32x16_bf16(PAF(2), VFR(6), o[1], 0, 0, 0), C1, 4); \
    GAPB(o[0] = __builtin_amdgcn_mfma_f32_32x32x16_bf16(PAF(3), VFR(3), o[0], 0, 0, 0), C1, 8); \
    GAPB(o[1] = __builtin_amdgcn_mfma_f32_32x32x16_bf16(PAF(3), VFR(7), o[1], 0, 0, 0), C1, 12); \
    } while (0)
    int t = 1;
    for (; t + 5 < NT; t += 2) {
        STEP(pB0, pB1, pA0, pA1, t, true, true, true);     WAIT_BAR(2); RESC(); ROT();
        STEP(pA0, pA1, pB0, pB1, t + 1, true, true, true);   WAIT_BAR(2); RESC(); ROT();
    }
#define ENDW(tt) do { if ((tt) + 3 < NT) { WAIT_BAR(2); } else if ((tt) + 2 < NT) { WAIT_BAR(1); } else { WAIT_BAR(0); } } while (0)
    for (; t + 1 < NT; t += 2) {
        STEP(pB0, pB1, pA0, pA1, t, (t + 3 < NT), (t + 1 < NT), (t + 1 < NT));       ENDW(t);   RESC(); ROT();
        STEP(pA0, pA1, pB0, pB1, t + 1, (t + 4 < NT), (t + 2 < NT), (t + 2 < NT));     ENDW(t + 1); RESC(); ROT();
    }
    STEP(pB0, pB1, pA0, pA1, NT - 1, false, false, false); RESC();
    { float sacc = pB0[0] + pB0[1]; _Pragma("unroll") for (int r = 2; r < 16; ++r) sacc += pB0[r]; _Pragma("unroll") for (int r = 0; r < 16; ++r) sacc += pB1[r]; l_reg += sacc;
      pw0 = (v4u){PKW(pB0, 0), PKW(pB0, 2), PKW(pB0, 4), PKW(pB0, 6)}; pw1 = (v4u){PKW(pB0, 8), PKW(pB0, 10), PKW(pB0, 12), PKW(pB0, 14)}; pw2 = (v4u){PKW(pB1, 0), PKW(pB1, 2), PKW(pB1, 4), PKW(pB1, 6)}; pw3 = (v4u){PKW(pB1, 8), PKW(pB1, 10), PKW(pB1, 12), PKW(pB1, 14)};
      SBAR(); pv(o, vb0 + sl_cur, PAF(0), PAF(1), PAF(2), PAF(3)); }
#undef PKW
#undef PAF
#undef VFR
#undef PIN
#undef MX3
#undef GAPA
#undef GAPB
#undef EX
#undef VRD
#undef KRD
#undef MF32
#undef QLO
#undef QHI
#undef STEP
#undef ENDW
    { auto rr = __builtin_amdgcn_permlane32_swap(__float_as_uint(l_reg), __float_as_uint(l_reg), false, false); l_reg = __uint_as_float(rr[0]) + __uint_as_float(rr[1]); }
    if constexpr (NOMAX) {
        const bool ok = (l_reg > 0x1p-90f) && (l_reg < 0x1p90f);
        if (__any(!ok)) { if (lane == 0) *okflag = 1; }
        asm volatile("s_waitcnt lgkmcnt(0)\n\ts_barrier" ::: "memory");
        const int bad = __builtin_amdgcn_readfirstlane(*okflag);
        if (bad) { asm volatile("s_waitcnt lgkmcnt(0)\n\ts_barrier" ::: "memory"); return false; }
    }
    l_reg += __builtin_amdgcn_exp2f(u.sinkl2 - mhat);
    if (hi == 0) wsf[32 + r32] = l_reg; asm volatile("s_waitcnt lgkmcnt(0)" ::: "memory");
    float rli[16];
#pragma unroll
    for (int r = 0; r < 16; ++r) rli[r] = __builtin_amdgcn_rcpf(wsf[32 + crow(r, hi)]);
    if (u.emode == 0) {
        bf16* Ow = u.O + (size_t)(u.q0 + wid * QBLK) * 1024;
        bf16* stg = (bf16*)(shm + LDS_OST + wid * 8192);
#pragma unroll
        for (int r = 0; r < 16; ++r) { const int orow = crow(r, hi);
#pragma unroll
            for (int d0 = 0; d0 < 2; ++d0) stg[orow * 64 + d0 * 32 + r32] = __float2bfloat16(o[d0][r] * rli[r]); }
        asm volatile("s_waitcnt lgkmcnt(0)" ::: "memory");
#pragma unroll
        for (int i = 0; i < 4; ++i) { const int row = i * 8 + (lane >> 3), ch = lane & 7; const v4u v = *(const v4u*)(stg + row * 64 + ch * 8); *(v4u*)(Ow + (size_t)row * 1024 + ch * 8) = v; }
    } else {
        float* stf = (float*)(shm + LDS_OST + wid * 8192);
        if (u.emode == 1) {
#pragma unroll
            for (int r = 0; r < 16; ++r) { const int orow = crow(r, hi);
#pragma unroll
                for (int d0 = 0; d0 < 2; ++d0) stf[orow * 64 + d0 * 32 + r32] = o[d0][r] * rli[r]; }
        } else {
#pragma unroll
            for (int r = 0; r < 16; ++r) { const int orow = crow(r, hi);
#pragma unroll
                for (int d0 = 0; d0 < 2; ++d0) { const float y = stf[orow * 64 + d0 * 32 + r32] - u.lam * (o[d0][r] * rli[r]); stf[orow * 64 + d0 * 32 + r32] = y; } }
            asm volatile("s_waitcnt lgkmcnt(0)" ::: "memory");
            bf16* Ow = u.O + (size_t)(u.q0 + wid * QBLK) * 1024;
#pragma unroll
            for (int i = 0; i < 4; ++i) { const int row = i * 8 + (lane >> 3), ch = lane & 7;
                const f32x4 y0 = *(const f32x4*)(stf + row * 64 + ch * 8), y1 = *(const f32x4*)(stf + row * 64 + ch * 8 + 4);
                float ss = (y0[0] * y0[0] + y0[1] * y0[1]) + (y0[2] * y0[2] + y0[3] * y0[3]) + (y1[0] * y1[0] + y1[1] * y1[1]) + (y1[2] * y1[2] + y1[3] * y1[3]);
                ss += xorf<1>(ss); ss += xorf<2>(ss); ss += xorf<4>(ss);
                const float ri = __builtin_amdgcn_rsqf(ss * (1.f / 64.f) + EPS) * u.oscale;
                const f32x4 w0 = *(const f32x4*)(u.subw + ch * 8), w1 = *(const f32x4*)(u.subw + ch * 8 + 4);
                v4u v; v.x = pk2(y0[0] * ri * w0[0], y0[1] * ri * w0[1]); v.y = pk2(y0[2] * ri * w0[2], y0[3] * ri * w0[3]); v.z = pk2(y1[0] * ri * w1[0], y1[1] * ri * w1[1]); v.w = pk2(y1[2] * ri * w1[2], y1[3] * ri * w1[3]);
                *(v4u*)(Ow + (size_t)row * 1024 + ch * 8) = v; }
        }
    }
    asm volatile("s_waitcnt lgkmcnt(0)\n\ts_barrier" ::: "memory");
    return true;
#undef DMA_K
#undef DMA_V
#undef KROW
#undef CMASK
#undef START
#undef RESC
#undef ROT
}

template <int MODE, int NOMAX = 0> __device__ __forceinline__ bool attn_simple(const AU& u, char* shm, int wave) {
    const int lane = lane_now(), tid = (wave << 6) | lane, r32 = lane & 31, hi = lane >> 5; const int wid = wave;
    const bf16* Qw = u.Q + (size_t)(u.q0 + wid * QBLK) * 64;
    const unsigned lds0 = (unsigned)(uintptr_t)shm;
    float* wsf = (float*)(shm + LDS_WS) + wid * 64;
    const float* rpb = (const float*)(shm + LDS_RPB);
    const int NT = u.NT;
    volatile int* okflag = (volatile int*)(shm + LDS_RPB + 2040);
    if constexpr (NOMAX) { if (tid == 0) *okflag = 0; }
#define KROW(t) ((t) < 4 ? SEQ + 64 * (t) : (u.kbase + 64 * ((t) - 4) < 0 ? 0 : (u.kbase + 64 * ((t) - 4) > SEQ - 64 ? SEQ - 64 : u.kbase + 64 * ((t) - 4))))
    const bf16* ksrc = u.K + (size_t)lane * 64 + wid * 8;
    const bf16* vsrc = u.V + (size_t)(16 * (wid & 3) + (lane >> 2)) * 64 + (wid >> 2) * 32 + (lane & 3) * 8;
    const unsigned kdst = lds0 + LDS_K + wid * 1024, vdst = lds0 + LDS_V + wid * 1024;
    const int vb0 = (int)(lds0 + LDS_V) + ((lane >> 4) & 1) * 32 + (lane & 3) * 8 + (4 * hi + ((lane & 15) >> 2)) * 64;
    { const int kr = KROW(0); glds16(ksrc + (size_t)kr * 64, (unsigned)__builtin_amdgcn_readfirstlane(kdst)); glds16(vsrc + (size_t)kr * 64, (unsigned)__builtin_amdgcn_readfirstlane(vdst)); }
    bf16x8 qr[4];
#pragma unroll
    for (int d0 = 0; d0 < 4; ++d0) qr[d0] = *reinterpret_cast<const bf16x8*>(&Qw[(size_t)r32 * 64 + d0 * 16 + hi * 8]);
    float m_run = -INFINITY, l_reg = 0.f; f32x16 o[2]; o[0] = f32x16{}; o[1] = f32x16{};
    const f32x16 zero = f32x16{};
#pragma unroll 1
    for (int t = 0; t < NT; ++t) {
        const int sl = (t & 1) * SLOTB;
        asm volatile("s_waitcnt vmcnt(0) lgkmcnt(0)\n\ts_barrier" ::: "memory");
        if (t + 1 < NT) { const int kr = KROW(t + 1); const int sn = ((t + 1) & 1) * SLOTB;
            glds16(ksrc + (size_t)kr * 64, (unsigned)__builtin_amdgcn_readfirstlane(kdst + sn)); glds16(vsrc + (size_t)kr * 64, (unsigned)__builtin_amdgcn_readfirstlane(vdst + sn)); }
        bool live = true;
        if (t >= 4) {
            if constexpr (MODE == 1) { const int jr = (u.kbase >> 6) + (t - 4), qr_ = (u.q0 >> 6) + (wid >> 1); int rs = qr_ - 4; rs = rs < 0 ? 0 : (rs > 248 ? 248 : rs); live = (unsigned)(jr - rs) < 8u; }
            if constexpr (MODE == 2) { const int k0 = u.kbase + 64 * (t - 4), qa = u.q0 + wid * QBLK; live = (k0 + 63 >= qa - 128) && (k0 <= qa + QBLK - 1 + 128); }
        }
        if (!live) continue;
        f32x16 p0, p1;
        qkt(p0, p1, shm + LDS_K + sl, qr, zero, r32, hi);
        amask<MODE>(p0, p1, t, u, wid, r32, hi, rpb);
        if (NOMAX && t > 0) {
            float sacc = 0.f;
#pragma unroll
            for (int r = 0; r < 16; ++r) { p0[r] = __builtin_amdgcn_exp2f(p0[r] - m_run); p1[r] = __builtin_amdgcn_exp2f(p1[r] - m_run); sacc += p0[r] + p1[r]; }
            l_reg += sacc;
        } else {
        float rm = p0[0];
#pragma unroll
        for (int r = 1; r < 16; ++r) rm = __builtin_fmaxf(rm, p0[r]);
#pragma unroll
        for (int r = 0; r < 16; ++r) rm = __builtin_fmaxf(rm, p1[r]);
        { auto rr = __builtin_amdgcn_permlane32_swap(__float_as_uint(rm), __float_as_uint(rm), false, false); rm = __builtin_fmaxf(__uint_as_float(rr[0]), __uint_as_float(rr[1])); }
        const float m_new = __builtin_fmaxf(m_run, rm);
        const float alpha = __builtin_amdgcn_exp2f(m_run - m_new); m_run = m_new;
        float sacc = 0.f;
#pragma unroll
        for (int r = 0; r < 16; ++r) { p0[r] = __builtin_amdgcn_exp2f(p0[r] - m_new); p1[r] = __builtin_amdgcn_exp2f(p1[r] - m_new); sacc += p0[r] + p1[r]; }
        l_reg = l_reg * alpha + sacc;
        if (hi == 0) wsf[r32] = alpha;
        asm volatile("s_waitcnt lgkmcnt(0)" ::: "memory");
#pragma unroll
        for (int d_ = 0; d_ < 2; ++d_)
#pragma unroll
            for (int r = 0; r < 16; ++r) o[d_][r] *= wsf[crow(r, hi)];
        }
        v4u pw0, pw1, pw2, pw3;
        pw0 = (v4u){cvtpk_s(p0[0], p0[1]), cvtpk_s(p0[2], p0[3]), cvtpk_s(p0[4], p0[5]), cvtpk_s(p0[6], p0[7])}; pw1 = (v4u){cvtpk_s(p0[8], p0[9]), cvtpk_s(p0[10], p0[11]), cvtpk_s(p0[12], p0[13]), cvtpk_s(p0[14], p0[15])};
        pw2 = (v4u){cvtpk_s(p1[0], p1[1]), cvtpk_s(p1[2], p1[3]), cvtpk_s(p1[4], p1[5]), cvtpk_s(p1[6], p1[7])}; pw3 = (v4u){cvtpk_s(p1[8], p1[9]), cvtpk_s(p1[10], p1[11]), cvtpk_s(p1[12], p1[13]), cvtpk_s(p1[14], p1[15])};
        asm volatile("s_waitcnt lgkmcnt(0)" ::: "memory"); SBAR();
        pv(o, vb0 + sl, __builtin_bit_cast(bf16x8, pw0), __builtin_bit_cast(bf16x8, pw1), __builtin_bit_cast(bf16x8, pw2), __builtin_bit_cast(bf16x8, pw3));
    }
    { auto rr = __builtin_amdgcn_permlane32_swap(__float_as_uint(l_reg), __float_as_uint(l_reg), false, false); l_reg = __uint_as_float(rr[0]) + __uint_as_float(rr[1]); }
    if constexpr (NOMAX) {
        const bool ok = (l_reg > 0x1p-90f) && (l_reg < 0x1p90f);
        if (__any(!ok)) { if (lane == 0) *okflag = 1; }
        asm volatile("s_waitcnt vmcnt(0) lgkmcnt(0)\n\ts_barrier" ::: "memory");
        const int bad = __builtin_amdgcn_readfirstlane(*okflag);
        if (bad) { asm volatile("s_waitcnt lgkmcnt(0)\n\ts_barrier" ::: "memory"); return false; }
    }
    l_reg += __builtin_amdgcn_exp2f(u.sinkl2 - m_run);
    asm volatile("s_waitcnt lgkmcnt(0)" ::: "memory");
    if (hi == 0) wsf[32 + r32] = l_reg; asm volatile("s_waitcnt lgkmcnt(0)" ::: "memory");
    float rli[16];
#pragma unroll
    for (int r = 0; r < 16; ++r) rli[r] = __builtin_amdgcn_rcpf(wsf[32 + crow(r, hi)]);
    {
        bf16* Ow = u.O + (size_t)(u.q0 + wid * QBLK) * 1024;
        bf16* stg = (bf16*)(shm + LDS_OST + wid * 8192);
#pragma unroll
        for (int r = 0; r < 16; ++r) { const int orow = crow(r, hi);
#pragma unroll
            for (int d0 = 0; d0 < 2; ++d0) stg[orow * 64 + d0 * 32 + r32] = __float2bfloat16(o[d0][r] * rli[r]); }
        asm volatile("s_waitcnt lgkmcnt(0)" ::: "memory");
#pragma unroll
        for (int i = 0; i < 4; ++i) { const int row = i * 8 + (lane >> 3), ch = lane & 7; const v4u v = *(const v4u*)(stg + row * 64 + ch * 8); *(v4u*)(Ow + (size_t)row * 1024 + ch * 8) = v; }
    }
    asm volatile("s_waitcnt vmcnt(0) lgkmcnt(0)\n\ts_barrier" ::: "memory");
    return true;
#undef KROW
}
#undef SBAR
#undef WAIT_BAR
}
struct Args { const float* in[23]; float* out; unsigned char* ws; int flags; int pad; };
enum { I_X = 0, I_C, I_CTX, I_CCTX, I_N1W, I_N2W, I_ADAW, I_ADAB, I_WIN, I_RPB, I_DLAM, I_SUBW, I_SINK, I_QKNW, I_WBR, I_WGATE, I_BGATE, I_WOUT, I_PWQ, I_PKEYS, I_PU, I_PV, I_FNW };

struct Frame {
    LAS unsigned char* lds; volatile LAS unsigned* MISC; gu32* ctl;
    int wave, vcu, G;
};
__device__ __forceinline__ int ltid(int wave) { return tid_now(wave); }

struct MapId   { __device__ __forceinline__ int operator()(int n) const { return n; } };
struct MapWin  { __device__ __forceinline__ int operator()(int n) const { return (n & ~255) + 128 * ((n >> 5) & 1) + 32 * ((n >> 6) & 3) + (n & 31); } };
struct MapGate { __device__ __forceinline__ int operator()(int n) const { const int br = n >> 10, ch = n & 1023; return 256 * (ch >> 6) + 128 * (br >> 1) + 32 * ((ch >> 4) & 3) + 16 * (br & 1) + (ch & 15); } };
template <class Map, bool F8 = false> __device__ __forceinline__ void transpose_item(const float* W, int K, int N, void* WTv, Map mp, LAS float* scr, int item, int lane) {
    bf16_t* WT = (bf16_t*)WTv; unsigned char* WT8 = (unsigned char*)WTv;
    const int nblk = N / 32, kb = item / nblk, nb = item % nblk, k0 = 64 * kb, n0 = 32 * nb;
#pragma unroll 8
    for (int i = 0; i < 32; ++i) { const int kk = 2 * i + (lane >> 5); scr[kk * 33 + (lane & 31)] = W[(size_t)(k0 + kk) * N + n0 + (lane & 31)]; }
    LDS_WAIT(); asm volatile("" ::: "memory");
    const int c = lane & 7;
#pragma unroll
    for (int j = 0; j < 4; ++j) { const int n = (lane >> 3) + 8 * j; const LAS float* s = scr + (8 * c) * 33 + n;
        int nn = n0 + n; asm volatile("" : "+v"(nn));
        if constexpr (F8) { v2u o; o.x = pk4_fp8(s[0 * 33] * 64.f, s[1 * 33] * 64.f, s[2 * 33] * 64.f, s[3 * 33] * 64.f); o.y = pk4_fp8(s[4 * 33] * 64.f, s[5 * 33] * 64.f, s[6 * 33] * 64.f, s[7 * 33] * 64.f);
            *(GAS v2u*)(WT8 + (size_t)mp(nn) * K + k0 + 8 * c) = o; }
        else { v4u o; o.x = pk2(s[0 * 33], s[1 * 33]); o.y = pk2(s[2 * 33], s[3 * 33]); o.z = pk2(s[4 * 33], s[5 * 33]); o.w = pk2(s[6 * 33], s[7 * 33]);
            *(GAS v4u*)(WT + (size_t)mp(nn) * K + k0 + 8 * c) = o; } }
    LDS_WAIT(); asm volatile("" ::: "memory");
}
__device__ __forceinline__ void modnorm_row(const float* xrow, bf16_t* orow, const float* nw, const float* sh, const float* sc, int lane, unsigned char* o8row = nullptr) {
    const GAS f32x4* xr = (const GAS f32x4*)xrow + lane;
    f32x4 v[4]; float s = 0.f;
#pragma unroll
    for (int j = 0; j < 4; ++j) { v[j] = xr[64 * j]; s += (v[j].x * v[j].x + v[j].y * v[j].y) + (v[j].z * v[j].z + v[j].w * v[j].w); }
    const float ri = __builtin_amdgcn_rsqf(wave_sum(s) * (1.f / DM) + EPS);
    GAS v2u* o8 = (GAS v2u*)orow + lane;
#pragma unroll
    for (int j = 0; j < 4; ++j) { const int col = 256 * j + 4 * lane; const f32x4 w = *(const f32x4*)(nw + col), a = *(const f32x4*)(sc + col), b = *(const f32x4*)(sh + col);
        const f32x4 y = (v[j] * ri * w) * (1.0f + a) + b;
        if (orow) { v2u p; p.x = pk2(y.x, y.y); p.y = pk2(y.z, y.w); o8[64 * j] = p; }
        if (o8row) ((GAS unsigned*)o8row)[64 * j + lane] = pk4_fp8(y.x, y.y, y.z, y.w); }
}

__device__ __forceinline__ void ce_desc(float& a, float& b) { const float hi = __builtin_fmaxf(a, b), lo = __builtin_fminf(a, b); a = hi; b = lo; }
__device__ __forceinline__ void sort16_desc(float (&x)[16]) {
#pragma unroll
    for (int k = 2; k <= 16; k <<= 1)
#pragma unroll
        for (int j = k >> 1; j > 0; j >>= 1)
#pragma unroll
            for (int i = 0; i < 16; ++i) { const int l = i ^ j; if (l > i) { if ((i & k) == 0) ce_desc(x[i], x[l]); else ce_desc(x[l], x[i]); } }
}
__device__ __forceinline__ void merge16_desc(float (&top)[16], const float (&c)[16]) {
#pragma unroll
    for (int i = 0; i < 16; ++i) top[i] = __builtin_fmaxf(top[i], c[15 - i]);
#pragma unroll
    for (int j = 8; j > 0; j >>= 1)
#pragma unroll
        for (int i = 0; i < 16; ++i) { const int l = i ^ j; if (l > i) ce_desc(top[i], top[l]); }
}

struct PeerArgs { unsigned char* H8out_xq; unsigned char* H8out; const float* S; const bf16_t* Hin; const unsigned char* U; const unsigned char* V; const float* SU; const float* SV; const float* Xin; float* Xout;
                  const float* g2l; const float* g2c;
                  bf16_t* Hout; const float* nwn; const float* shl; const float* scl; const float* shc; const float* scc;
                  float* fout; const float* fnw;
                  int nblocks; int* dbg_eid; float* dbg_gt; bool dry; int route_reps; };
struct PeerBufs;
constexpr int PL_LISTS = 0, PL_EID = 40960, PL_GT = PL_EID + 16384;
__device__ __forceinline__ float dot2bf(unsigned a, unsigned b, float acc) { return __builtin_amdgcn_fdot2_f32_bf16(__builtin_bit_cast(bf16x2_t, a), __builtin_bit_cast(bf16x2_t, b), acc, false); }
__device__ __forceinline__ float dot8(const v4u a, const v4u b, float acc) {
    const unsigned a0 = a.x, a1 = a.y, a2 = a.z, a3 = a.w, b0 = b.x, b1 = b.y, b2 = b.z, b3 = b.w;
    acc = dot2bf(a0, b0, acc); acc = dot2bf(a1, b1, acc); acc = dot2bf(a2, b2, acc); acc = dot2bf(a3, b3, acc);
    return acc;
}
struct PeerBufs { int* eid; float* gt; float* a; unsigned char* xq; float* sx; };
__device__ __forceinline__ void peer_route(Frame& F, const PeerArgs& P, const PeerBufs& B) {
    const int tid = ltid(F.wave), lane = tid & 63;
    LAS unsigned* lists = (LAS unsigned*)(F.lds + PL_LISTS);
    LAS int* eid = (LAS int*)(F.lds + PL_EID);
    LAS float* gt = (LAS float*)(F.lds + PL_GT);
    for (int blk = F.vcu; blk < P.nblocks; blk += F.G) {
        const int row0 = blk * 32;
        {
            const int tok = tid >> 4, lst = tid & 15;
            const float* sp = P.S + (size_t)(row0 + tok) * 2048 + lst * 128;
            float top[16];
#pragma unroll 1
            for (int c = 0; c < 8; ++c) {
                float x[16];
#pragma unroll
                for (int q = 0; q < 4; ++q) { const f32x4 v = *(const f32x4*)(sp + c * 16 + q * 4);
#pragma unroll
                    for (int j = 0; j < 4; ++j) x[q * 4 + j] = __uint_as_float((__float_as_uint(v[j]) & ~127u) | (unsigned)(c * 16 + q * 4 + j)); }
                sort16_desc(x);
                if (c == 0) {
#pragma unroll
                    for (int i = 0; i < 16; ++i) top[i] = x[i];
                } else merge16_desc(top, x);
            }
            LAS unsigned* lp = lists + tid * 20;
#pragma unroll
            for (int q = 0; q < 4; ++q) *(LAS v4u*)(lp + q * 4) = (v4u){__float_as_uint(top[q * 4]), __float_as_uint(top[q * 4 + 1]), __float_as_uint(top[q * 4 + 2]), __float_as_uint(top[q * 4 + 3])};
        }
        __syncthreads();
        if (tid < 256) {
            const int tok = tid >> 3, hd = tid & 7;
            const LAS unsigned* la = lists + (tok * 16 + 2 * hd) * 20; const LAS unsigned* lb = la + 20;
            float av[16], bv[16];
#pragma unroll
            for (int q = 0; q < 4; ++q) { const v4u a = *(const LAS v4u*)(la + q * 4), b = *(const LAS v4u*)(lb + q * 4);
#pragma unroll
                for (int j = 0; j < 4; ++j) { av[q * 4 + j] = __uint_as_float(a[j] & ~127u); bv[q * 4 + j] = __uint_as_float(b[j] & ~127u); } }
            float c0[16], c1[16], c2[16], c3[16];
#pragma unroll
            for (int i = 0; i < 16; ++i) { c0[i] = -INFINITY; c1[i] = -INFINITY; c2[i] = -INFINITY; c3[i] = -INFINITY; }
            {
                int cnt = 0;
#pragma unroll
                for (int i = 0; i < 16; ++i)
#pragma unroll
                    for (int j = 0; j < 16; ++j) if ((i + 1) * (j + 1) <= 16) {
                        const float sm = __uint_as_float((__float_as_uint(av[i] + bv[j]) & ~255u) | (unsigned)(i * 16 + j));
                        const int slot = cnt & 15, arr = cnt >> 4;
                        if (arr == 0) c0[slot] = sm; else if (arr == 1) c1[slot] = sm; else if (arr == 2) c2[slot] = sm; else c3[slot] = sm;
                        ++cnt;
                    }
            }
            sort16_desc(c0); sort16_desc(c1); sort16_desc(c2); sort16_desc(c3);
            merge16_desc(c0, c1); merge16_desc(c0, c2); merge16_desc(c0, c3);
            float ev[16], sum = 0.f; const float m0 = __uint_as_float(__float_as_uint(c0[0]) & ~255u);
#pragma unroll
            for (int k = 0; k < 16; ++k) { ev[k] = fast_exp2((__uint_as_float(__float_as_uint(c0[k]) & ~255u) - m0) * LOG2E); sum += ev[k]; }
            const float rs = 1.0f / sum;
#pragma unroll
            for (int k = 0; k < 16; ++k) { const unsigned code = __float_as_uint(c0[k]) & 255u;
                const int ia = (int)(la[code >> 4] & 127u), ib = (int)(lb[code & 15u] & 127u);
                eid[tok * 128 + hd * 16 + k] = ia * NKEYS + ib; gt[tok * 128 + hd * 16 + k] = ev[k] * rs; }
        }
        __syncthreads();
#pragma unroll
        for (int i = 0; i < 8; ++i) { const int idx = i * NTHREADS + tid; B.eid[(size_t)row0 * 128 + idx] = eid[idx]; B.gt[(size_t)row0 * 128 + idx] = gt[idx]; }
#pragma unroll 1
        for (int tk = 0; tk < 4; ++tk) {
            const size_t row = (size_t)(row0 + F.wave * 4 + tk);
            const bf16_t* hp = P.Hin + row * DM + 16 * lane;
            const v4u h0 = *(const v4u*)hp, h1 = *(const v4u*)(hp + 8);
            float xf[16];
#pragma unroll
            for (int q = 0; q < 4; ++q) { xf[2 * q] = bflo(h0[q]); xf[2 * q + 1] = bfhi(h0[q]); xf[8 + 2 * q] = bflo(h1[q]); xf[8 + 2 * q + 1] = bfhi(h1[q]); }
            float am = 0.f;
#pragma unroll
            for (int i = 0; i < 16; ++i) am = __builtin_fmaxf(am, __builtin_fabsf(xf[i]));
            am = wave_max(am);
            const float ix = am > 0.f ? 127.f / am : 0.f;
            v4u xq;
#pragma unroll
            for (int q = 0; q < 4; ++q) { unsigned w = 0;
#pragma unroll
                for (int j = 0; j < 4; ++j) { const int v = (int)__builtin_rintf(xf[4 * q + j] * ix); w |= (unsigned)(v & 0xff) << (8 * j); }
                xq[q] = w; }
            *(v4u*)(B.xq + row * DM + 16 * lane) = xq;
            if (lane == 0) B.sx[row] = am * (1.f / 127.f);
        }
        __syncthreads();
    }
}
__device__ __forceinline__ int wave_isum(int v) {
    v += __builtin_amdgcn_update_dpp(0, v, 0xB1, 0xf, 0xf, false);
    v += __builtin_amdgcn_update_dpp(0, v, 0x4E, 0xf, 0xf, false);
    v += __builtin_amdgcn_update_dpp(0, v, 0x141, 0xf, 0xf, false);
    v += __builtin_amdgcn_update_dpp(0, v, 0x140, 0xf, 0xf, false);
    v += __builtin_amdgcn_update_dpp(0, v, 0x142, 0xa, 0xf, false);
    v += __builtin_amdgcn_update_dpp(0, v, 0x143, 0xc, 0xf, false);
    return __builtin_amdgcn_readlane(v, 63);
}
__device__ __forceinline__ int bperm_i(int v, int srclane) { return __builtin_amdgcn_ds_bpermute(srclane << 2, v); }
__device__ __forceinline__ float bperm_f(float v, int srclane) { return __builtin_bit_cast(float, __builtin_amdgcn_ds_bpermute(srclane << 2, __builtin_bit_cast(int, v))); }
__device__ __forceinline__ int treduce16(const int (&d)[16], int lane) {
    int s8[8], s4[4], s2[2];
#pragma unroll
    for (int i = 0; i < 8; ++i) { auto r = __builtin_amdgcn_permlane32_swap((unsigned)d[i], (unsigned)d[i + 8], false, false); s8[i] = (int)r[0] + (int)r[1]; }
#pragma unroll
    for (int i = 0; i < 4; ++i) { auto r = __builtin_amdgcn_permlane16_swap((unsigned)s8[i], (unsigned)s8[i + 4], false, false); s4[i] = (int)r[0] + (int)r[1]; }
    const bool b3 = (lane & 8) != 0, b2 = (lane & 4) != 0;
#pragma unroll
    for (int i = 0; i < 2; ++i) { const int keep = b3 ? s4[i + 2] : s4[i], send = b3 ? s4[i] : s4[i + 2]; s2[i] = keep + __builtin_amdgcn_update_dpp(0, send, 0x128, 0xf, 0xf, false); }
    int z; { const int keep = b2 ? s2[1] : s2[0], send = b2 ? s2[0] : s2[1]; z = keep + __builtin_amdgcn_ds_swizzle(send, 0x101F); }
    z += __builtin_amdgcn_update_dpp(0, z, 0x4E, 0xf, 0xf, false);
    z += __builtin_amdgcn_update_dpp(0, z, 0xB1, 0xf, 0xf, false);
    return z;
}
__device__ __forceinline__ void peer_u(Frame& F, const PeerArgs& P, const PeerBufs& B, int ntok) {
    const int lane = ltid(F.wave) & 63;
    const int nsl = 8, wps = (F.G / nsl) * NWAVES;
    const int j = F.vcu / (F.G / nsl), wsl = (F.vcu % (F.G / nsl)) * NWAVES + F.wave;
    const int esel = (lane >> 2) & 15;
    int t = wsl; if (t >= ntok) return;
    int e_lo = B.eid[(size_t)t * 128 + lane], e_hi = B.eid[(size_t)t * 128 + 64 + lane];
    float g_lo = B.gt[(size_t)t * 128 + lane], g_hi = B.gt[(size_t)t * 128 + 64 + lane];
    v4u xq = *(const v4u*)(B.xq + (size_t)t * DM + 16 * lane); float sx = B.sx[t];
    for (;;) {
        const int tn = t + wps; const bool more = tn < ntok; const int tp = more ? tn : t;
        const int ne_lo = B.eid[(size_t)tp * 128 + lane], ne_hi = B.eid[(size_t)tp * 128 + 64 + lane];
        const float ng_lo = B.gt[(size_t)tp * 128 + lane], ng_hi = B.gt[(size_t)tp * 128 + 64 + lane];
        const v4u nxq = *(const v4u*)(B.xq + (size_t)tp * DM + 16 * lane); const float nsx = B.sx[tp];
        unsigned long long m_lo = __ballot((e_lo >> 11) == j), m_hi = __ballot((e_hi >> 11) == j);
        const int n = __popcll(m_lo) + __popcll(m_hi);
        v4u ua[32]; int slotv0 = -1, idv0 = 0, slotv1 = -1, idv1 = 0;
#pragma unroll
        for (int q = 0; q < 32; ++q) {
            ua[q] = (v4u){0u, 0u, 0u, 0u};
            if (q < n) {
                int k, id;
                if (m_lo) { k = __builtin_ctzll(m_lo); m_lo &= m_lo - 1; id = __builtin_amdgcn_readlane(e_lo, k); }
                else { k = __builtin_ctzll(m_hi); m_hi &= m_hi - 1; id = __builtin_amdgcn_readlane(e_hi, k); k += 64; }
                ua[q] = *(const v4u*)(P.U + (size_t)id * DM + 16 * lane);
                if (q < 16) { if (esel == q) { slotv0 = k; idv0 = id; } } else { if (esel == q - 16) { slotv1 = k; idv1 = id; } }
            }
        }
        const float su0 = P.SU[idv0], sv0 = P.SV[idv0], su1 = P.SU[idv1], sv1 = P.SV[idv1];
        const float gl0 = bperm_f(g_lo, slotv0 & 63), gh0 = bperm_f(g_hi, slotv0 & 63), gl1 = bperm_f(g_lo, slotv1 & 63), gh1 = bperm_f(g_hi, slotv1 & 63);
        const float gg0 = slotv0 < 64 ? gl0 : gh0, gg1 = slotv1 < 64 ? gl1 : gh1;
        int d[16];
#pragma unroll
        for (int q = 0; q < 16; ++q) { int di = __builtin_amdgcn_sdot4((int)ua[q][0], (int)xq[0], 0, false); di = __builtin_amdgcn_sdot4((int)ua[q][1], (int)xq[1], di, false);
            di = __builtin_amdgcn_sdot4((int)ua[q][2], (int)xq[2], di, false); d[q] = __builtin_amdgcn_sdot4((int)ua[q][3], (int)xq[3], di, false); }
        { const int z = treduce16(d, lane);
          if (slotv0 >= 0 && (lane & 3) == 0) B.a[(size_t)t * 128 + slotv0] = gg0 * gelu_tanh((float)z * su0 * sx) * sv0; }
        if (n > 16) {
#pragma unroll
            for (int q = 0; q < 16; ++q) { int di = __builtin_amdgcn_sdot4((int)ua[16 + q][0], (int)xq[0], 0, false); di = __builtin_amdgcn_sdot4((int)ua[16 + q][1], (int)xq[1], di, false);
                di = __builtin_amdgcn_sdot4((int)ua[16 + q][2], (int)xq[2], di, false); d[q] = __builtin_amdgcn_sdot4((int)ua[16 + q][3], (int)xq[3], di, false); }
            const int z = treduce16(d, lane);
            if (slotv1 >= 0 && (lane & 3) == 0) B.a[(size_t)t * 128 + slotv1] = gg1 * gelu_tanh((float)z * su1 * sx) * sv1;
        }
        if (n > 32) {
            while (m_lo | m_hi) { int k, id;
                if (m_lo) { k = __builtin_ctzll(m_lo); m_lo &= m_lo - 1; id = __builtin_amdgcn_readlane(e_lo, k); }
                else { k = __builtin_ctzll(m_hi); m_hi &= m_hi - 1; id = __builtin_amdgcn_readlane(e_hi, k); k += 64; }
                const v4u u1 = *(const v4u*)(P.U + (size_t)id * DM + 16 * lane);
                int di = __builtin_amdgcn_sdot4((int)u1[0], (int)xq[0], 0, false); di = __builtin_amdgcn_sdot4((int)u1[1], (int)xq[1], di, false);
                di = __builtin_amdgcn_sdot4((int)u1[2], (int)xq[2], di, false); di = __builtin_amdgcn_sdot4((int)u1[3], (int)xq[3], di, false);
                const int tot = wave_isum(di);
                const float g = __uint_as_float(k < 64 ? __builtin_amdgcn_readlane(__float_as_uint(g_lo), k) : __builtin_amdgcn_readlane(__float_as_uint(g_hi), k - 64));
                if (lane == 0) B.a[(size_t)t * 128 + k] = g * gelu_tanh((float)tot * P.SU[id] * sx) * P.SV[id]; }
        }
        if (!more) break;
        t = tn; e_lo = ne_lo; e_hi = ne_hi; g_lo = ng_lo; g_hi = ng_hi; xq = nxq; sx = nsx;
    }
}
__device__ __forceinline__ void peer_v(Frame& F, const PeerArgs& P, const PeerBufs& B, int ntok) {
    const int lane = ltid(F.wave) & 63;
    const int nsl = 8, wps = (F.G / nsl) * NWAVES;
    const int j = F.vcu / (F.G / nsl), wsl = (F.vcu % (F.G / nsl)) * NWAVES + F.wave;
    const int grp = lane >> 3, ch = lane & 7;
    int t = wsl; if (t >= ntok) return;
#define PV_HDR(tt, EL, EH, CL, CH) do { EL = B.eid[(size_t)(tt) * 128 + lane]; EH = B.eid[(size_t)(tt) * 128 + 64 + lane]; CL = B.a[(size_t)(tt) * 128 + lane]; CH = B.a[(size_t)(tt) * 128 + 64 + lane]; } while (0)
#define PV_ROWS(W, CF, EL, EH, CL, CH) do { _Pragma("unroll") for (int i = 0; i < 16; ++i) { const int src = (8 * i + grp) & 63; const int id = bperm_i(i < 8 ? EL : EH, src); CF[i] = bperm_f(i < 8 ? CL : CH, src); \
            W[i] = *(const v4u*)(P.V + (size_t)id * DM + 128 * j + 16 * ch); } } while (0)
    int e_lo, e_hi, ne_lo, ne_hi; float c_lo, c_hi, nc_lo, nc_hi;
    v4u wA[16], wB[16]; float cfA[16], cfB[16];
    PV_HDR(t, e_lo, e_hi, c_lo, c_hi);
    { const int t1 = (t + wps < ntok) ? t + wps : t; PV_HDR(t1, ne_lo, ne_hi, nc_lo, nc_hi); }
    PV_ROWS(wA, cfA, e_lo, e_hi, c_lo, c_hi);
#define PV_STEP(W, CF, WN, CFN) do { \
        const int tn = t + wps; const bool more = tn < ntok; \
        if (more) { PV_ROWS(WN, CFN, ne_lo, ne_hi, nc_lo, nc_hi); const int t2 = (tn + wps < ntok) ? tn + wps : tn; PV_HDR(t2, ne_lo, ne_hi, nc_lo, nc_hi); } \
        float acc[16]; float asum = 0.f; \
        _Pragma("unroll") for (int c = 0; c < 16; ++c) acc[c] = 0.f; \
        _Pragma("unroll") for (int i = 0; i < 16; ++i) { asum += CF[i]; const f32x2 cf2 = {CF[i], CF[i]}; \
            _Pragma("unroll") for (int q = 0; q < 4; ++q) { const unsigned x = W[i][q]; \
                const f32x2 v01 = {(float)(x & 0xffu), (float)((x >> 8) & 0xffu)}, v23 = {(float)((x >> 16) & 0xffu), (float)(x >> 24)}; \
                f32x2 o01 = {acc[4 * q], acc[4 * q + 1]}, o23 = {acc[4 * q + 2], acc[4 * q + 3]}; \
                o01 = __builtin_elementwise_fma(cf2, v01, o01); o23 = __builtin_elementwise_fma(cf2, v23, o23); \
                acc[4 * q] = o01.x; acc[4 * q + 1] = o01.y; acc[4 * q + 2] = o23.x; acc[4 * q + 3] = o23.y; } } \
        asum += __builtin_bit_cast(float, __builtin_amdgcn_update_dpp(0, __builtin_bit_cast(int, asum), 0x128, 0xf, 0xf, false)); asum += xorf<16>(asum); asum = x32_sum(asum); \
        _Pragma("unroll") for (int c = 0; c < 16; ++c) { acc[c] += __builtin_bit_cast(float, __builtin_amdgcn_update_dpp(0, __builtin_bit_cast(int, acc[c]), 0x128, 0xf, 0xf, false)); acc[c] += xorf<16>(acc[c]); acc[c] = x32_sum(acc[c]); } \
        if (lane < 8) { \
            const int col0 = 128 * j + 16 * lane; const float* g2 = (t < SEQ) ? P.g2l : P.g2c; \
            _Pragma("unroll") for (int q = 0; q < 4; ++q) { const f32x4 xo = *(const f32x4*)(P.Xin + (size_t)t * DM + col0 + 4 * q), g = *(const f32x4*)(g2 + col0 + 4 * q); \
                f32x4 y; y.x = xo.x + g.x * (acc[4 * q] - 128.f * asum); y.y = xo.y + g.y * (acc[4 * q + 1] - 128.f * asum); y.z = xo.z + g.z * (acc[4 * q + 2] - 128.f * asum); y.w = xo.w + g.w * (acc[4 * q + 3] - 128.f * asum); \
                *(f32x4*)(P.Xout + (size_t)t * DM + col0 + 4 * q) = y; } \
        } \
        done = !more; t = tn; } while (0)
    bool done = false;
    for (;;) {
        PV_STEP(wA, cfA, wB, cfB); if (done) break;
        PV_STEP(wB, cfB, wA, cfA); if (done) break;
    }
#undef PV_HDR
#undef PV_ROWS
#undef PV_STEP
}
__device__ __forceinline__ void peer_norm(Frame& F, const PeerArgs& P, int ntok) {
    const int lane = ltid(F.wave) & 63; const int gw = F.vcu * NWAVES + F.wave, NGW = F.G * NWAVES;
    for (int t = gw; t < ntok; t += NGW) {
        const bool latent = t < SEQ;
        if (P.fout) {
            const GAS f32x4* xr = (const GAS f32x4*)(P.Xout + (size_t)t * DM) + lane; f32x4 v[4]; float s = 0.f;
#pragma unroll
            for (int q = 0; q < 4; ++q) { v[q] = xr[64 * q]; s += (v[q].x * v[q].x + v[q].y * v[q].y) + (v[q].z * v[q].z + v[q].w * v[q].w); }
            const float ri = __builtin_amdgcn_rsqf(wave_sum(s) * (1.f / DM) + EPS);
#pragma unroll
            for (int q = 0; q < 4; ++q) { const f32x4 w = *(const f32x4*)(P.fnw + 256 * q + 4 * lane); *(f32x4*)(P.fout + (size_t)t * DM + 256 * q + 4 * lane) = v[q] * ri * w; }
        } else modnorm_row(P.Xout + (size_t)t * DM, P.Hout ? P.Hout + (size_t)t * DM : (bf16_t*)nullptr, P.nwn, latent ? P.shl : P.shc, latent ? P.scl : P.scc, lane, P.H8out ? P.H8out + (size_t)t * DM : (unsigned char*)nullptr);
    }
}

constexpr int P2_Y = 0;
constexpr int P2_EID = 73728, P2_GT = P2_EID + 72 * 128 * 2, P2_SX = P2_GT + 72 * 128 * 4, P2_END = P2_SX + 72 * 4;
static_assert(P2_END <= RING_BYTES, "peer2 LDS map");
template <int NTK> __device__ __forceinline__ void peer2_tokens(Frame& F, const PeerArgs& P, int t_begin, int lt0, int cnt, int lane_in) {
    int lane = lane_in; asm volatile("" : "+v"(lane));
    const LAS unsigned short* eidL = (const LAS unsigned short*)(F.lds + P2_EID); LAS float* gtL = (LAS float*)(F.lds + P2_GT); const LAS float* sxL = (const LAS float*)(F.lds + P2_SX);
#define g (lane >> 3)
#define c (lane & 7)
    const unsigned char* xqb = P.H8out_xq;
    int d[NTK][16];
#pragma unroll
    for (int tk = 0; tk < NTK; ++tk)
#pragma unroll
        for (int i = 0; i < 16; ++i) d[tk][i] = 0;
#pragma unroll 1
    for (int ps = 0; ps < 8; ++ps) {
#pragma unroll
        for (int tk = 0; tk < NTK; ++tk) {
            if (tk < cnt) {
                const int lt = lt0 + tk; const unsigned row = (unsigned)(t_begin + lt);
                const v4u xq = *(const v4u*)(xqb + (unsigned)(row * DM + 128 * ps + 16 * c));
                v4u ua[16];
#pragma unroll
                for (int i = 0; i < 16; ++i) { const int id = eidL[lt * 128 + 8 * i + g]; ua[i] = *(const v4u*)(P.U + (unsigned)((ps * NEXP + id) * 128 + 16 * c)); }
#pragma unroll
                for (int i = 0; i < 16; ++i) { int di = __builtin_amdgcn_sdot4((int)ua[i][0], (int)xq[0], d[tk][i], false); di = __builtin_amdgcn_sdot4((int)ua[i][1], (int)xq[1], di, false);
                    di = __builtin_amdgcn_sdot4((int)ua[i][2], (int)xq[2], di, false); d[tk][i] = __builtin_amdgcn_sdot4((int)ua[i][3], (int)xq[3], di, false); }
                __builtin_amdgcn_sched_barrier(0);
            }
        }
    }
    asm volatile("" : "+v"(lane));
#pragma unroll
    for (int tk = 0; tk < NTK; ++tk) {
        if (tk < cnt) {
            const int lt = lt0 + tk; const float sx = sxL[lt];
            int mine0 = 0, mine1 = 0;
#pragma unroll
            for (int i = 0; i < 16; ++i) { int v = d[tk][i];
                v += __builtin_amdgcn_update_dpp(0, v, 0xB1, 0xf, 0xf, false); v += __builtin_amdgcn_update_dpp(0, v, 0x4E, 0xf, 0xf, false); v += __builtin_amdgcn_update_dpp(0, v, 0x141, 0xf, 0xf, false);
                if ((i & 7) == c) { if (i < 8) mine0 = v; else mine1 = v; } }
#pragma unroll
            for (int hf = 0; hf < 2; ++hf) { const int e = 8 * (8 * hf + c) + g; const int id = eidL[lt * 128 + e];
                const f32x2 suv = ((const f32x2*)P.SU)[id];
                const float pre = (float)(hf ? mine1 : mine0) * (suv.x * sx);
                gtL[lt * 128 + e] = gtL[lt * 128 + e] * gelu_tanh(pre) * suv.y; }
        }
    }
    LDS_WAIT();
    asm volatile("" : "+v"(lane));
    LAS unsigned char* yL = F.lds + P2_Y + F.wave * (4 * 2048);
#pragma unroll 1
    for (int ps = 0; ps < 8; ++ps) {
#pragma unroll
        for (int tk = 0; tk < NTK; ++tk) {
            if (tk < cnt) {
                const int lt = lt0 + tk; const unsigned row = (unsigned)(t_begin + lt);
                v4u w[16]; float cf[16];
#pragma unroll
                for (int i = 0; i < 16; ++i) { const int id = eidL[lt * 128 + 8 * i + g]; cf[i] = gtL[lt * 128 + 8 * i + g]; w[i] = *(const v4u*)(P.V + (unsigned)((ps * NEXP + id) * 128 + 16 * c)); }
                float acc[16]; float asum = 0.f;
#pragma unroll
                for (int q = 0; q < 16; ++q) acc[q] = 0.f;
#pragma unroll
                for (int i = 0; i < 16; ++i) { asum += cf[i]; const f32x2 cf2 = {cf[i], cf[i]};
#pragma unroll
                    for (int q = 0; q < 4; ++q) { const unsigned x = w[i][q];
                        const f32x2 v01 = {(float)(x & 0xffu), (float)((x >> 8) & 0xffu)}, v23 = {(float)((x >> 16) & 0xffu), (float)(x >> 24)};
                        f32x2 o01 = {acc[4 * q], acc[4 * q + 1]}, o23 = {acc[4 * q + 2], acc[4 * q + 3]};
                        o01 = __builtin_elementwise_fma(cf2, v01, o01); o23 = __builtin_elementwise_fma(cf2, v23, o23);
                        acc[4 * q] = o01.x; acc[4 * q + 1] = o01.y; acc[4 * q + 2] = o23.x; acc[4 * q + 3] = o23.y; } }
                asum += __builtin_bit_cast(float, __builtin_amdgcn_update_dpp(0, __builtin_bit_cast(int, asum), 0x128, 0xf, 0xf, false)); asum += xorf<16>(asum); asum = x32_sum(asum);
#pragma unroll
                for (int q = 0; q < 16; ++q) { acc[q] += __builtin_bit_cast(float, __builtin_amdgcn_update_dpp(0, __builtin_bit_cast(int, acc[q]), 0x128, 0xf, 0xf, false)); acc[q] += xorf<16>(acc[q]); acc[q] = x32_sum(acc[q]); }
                if (lane < 8) {
                    v4u y0, y1;
                    y0.x = pk2(acc[0] - 128.f * asum, acc[1] - 128.f * asum); y0.y = pk2(acc[2] - 128.f * asum, acc[3] - 128.f * asum); y0.z = pk2(acc[4] - 128.f * asum, acc[5] - 128.f * asum); y0.w = pk2(acc[6] - 128.f * asum, acc[7] - 128.f * asum);
                    y1.x = pk2(acc[8] - 128.f * asum, acc[9] - 128.f * asum); y1.y = pk2(acc[10] - 128.f * asum, acc[11] - 128.f * asum); y1.z = pk2(acc[12] - 128.f * asum, acc[13] - 128.f * asum); y1.w = pk2(acc[14] - 128.f * asum, acc[15] - 128.f * asum);
                    LAS v4u* yp = (LAS v4u*)(yL + tk * 2048 + (128 * ps + 16 * lane) * 2); yp[0] = y0; yp[1] = y1;
                }
                __builtin_amdgcn_sched_barrier(0);
            }
        }
    }
    asm volatile("" : "+v"(lane));
    LDS_WAIT();
#pragma unroll
    for (int tk = 0; tk < NTK; ++tk) {
        if (tk < cnt) {
            const int lt = lt0 + tk; const unsigned row = (unsigned)(t_begin + lt); const bool latent = row < (unsigned)SEQ;
            const float* g2 = latent ? P.g2l : P.g2c;
            f32x4 xn[4]; float ss = 0.f;
#pragma unroll
            for (int q = 0; q < 4; ++q) { const unsigned col = 256 * q + 4 * lane; const f32x4 xo = __builtin_nontemporal_load((const f32x4*)(P.Xin + (unsigned)(row * DM + col))), gq = *(const f32x4*)(g2 + col);
                const v2u yy = *(const LAS v2u*)(yL + tk * 2048 + col * 2);
                f32x4 y; y.x = xo.x + gq.x * bflo(yy.x); y.y = xo.y + gq.y * bfhi(yy.x); y.z = xo.z + gq.z * bflo(yy.y); y.w = xo.w + gq.w * bfhi(yy.y);
                xn[q] = y; ss += (y.x * y.x + y.y * y.y) + (y.z * y.z + y.w * y.w); }
            const float ri = __builtin_amdgcn_rsqf(wave_sum(ss) * (1.f / DM) + EPS);
            if (P.fout) {
                if (latent) {
#pragma unroll
                    for (int q = 0; q < 4; ++q) { const unsigned col = 256 * q + 4 * lane; const f32x4 wq_ = *(const f32x4*)(P.fnw + col); __builtin_nontemporal_store(xn[q] * ri * wq_, (f32x4*)(P.fout + (unsigned)(row * DM + col))); }
                }
            } else {
                const float* sh = latent ? P.shl : P.shc; const float* sc = latent ? P.scl : P.scc;
#pragma unroll
                for (int q = 0; q < 4; ++q) { const unsigned col = 256 * q + 4 * lane; const f32x4 wn = *(const f32x4*)(P.nwn + col), a = *(const f32x4*)(sc + col), b = *(const f32x4*)(sh + col);
                    __builtin_nontemporal_store(xn[q], (f32x4*)(P.Xout + (unsigned)(row * DM + col)));
                    const f32x4 y = (xn[q] * ri * wn) * (1.0f + a) + b;
                    if (P.Hout) { v2u pk; pk.x = pk2(y.x, y.y); pk.y = pk2(y.z, y.w); *(v2u*)(P.Hout + (unsigned)(row * DM + col)) = pk; }
                    if (P.H8out) *(unsigned*)(P.H8out + (unsigned)(row * DM + col)) = pk4_fp8(y.x, y.y, y.z, y.w); }
            }
        }
    }
}
#undef g
#undef c
__device__ __forceinline__ void peer_phase2(Frame& F, const PeerArgs& P) {
    const int tid = ltid(F.wave), lane = tid & 63;
    LAS unsigned* lists = (LAS unsigned*)(F.lds + PL_LISTS);
    LAS int* eid = (LAS int*)(F.lds + PL_EID);
    LAS float* gt = (LAS float*)(F.lds + PL_GT);
    LAS unsigned short* eidL = (LAS unsigned short*)(F.lds + P2_EID); LAS float* gtL = (LAS float*)(F.lds + P2_GT); LAS float* sxL = (LAS float*)(F.lds + P2_SX);
    const int ntok = P.nblocks * 32, tpc = (ntok + F.G - 1) / F.G, t_begin = F.vcu * tpc, t_end = (t_begin + tpc < ntok) ? t_begin + tpc : ntok;
    if (t_begin >= t_end) return;
    for (int row0 = t_begin; row0 < t_end; row0 += 32) {
        const int nt = (t_end - row0 < 32) ? t_end - row0 : 32;
        for (int rr = 0; rr < P.route_reps; ++rr) {
        if (rr) __syncthreads();
        {
            const int tok = tid >> 4, lst = tid & 15;
            const bf16_t* sp = (const bf16_t*)P.S + (size_t)(row0 + (tok < nt ? tok : nt - 1)) * 2048 + lst * 128;
            float top[16];
            v4u nv[2];
#pragma unroll
            for (int q = 0; q < 2; ++q) nv[q] = *(const v4u*)(sp + q * 8);
#pragma unroll 1
            for (int c = 0; c < 8; ++c) {
                float x[16];
#pragma unroll
                for (int e = 0; e < 16; ++e) { const unsigned w = nv[e >> 3][(e >> 1) & 3];
                    x[e] = __uint_as_float(((e & 1) ? (w & 0xffff0000u) : (w << 16)) | (unsigned)(c * 16 + e)); }
                if (c < 7) {
#pragma unroll
                    for (int q = 0; q < 2; ++q) nv[q] = *(const v4u*)(sp + (c + 1) * 16 + q * 8);
                }
                sort16_desc(x);
                if (c == 0) {
#pragma unroll
                    for (int i = 0; i < 16; ++i) top[i] = x[i];
                } else merge16_desc(top, x);
            }
            LAS unsigned* lp = lists + tid * 20;
#pragma unroll
            for (int q = 0; q < 4; ++q) *(LAS v4u*)(lp + q * 4) = (v4u){__float_as_uint(top[q * 4]), __float_as_uint(top[q * 4 + 1]), __float_as_uint(top[q * 4 + 2]), __float_as_uint(top[q * 4 + 3])};
        }
        __syncthreads();
        if (tid < 256) {
            const int tok = tid >> 3, hd = tid & 7;
            const LAS unsigned* la = lists + (tok * 16 + 2 * hd) * 20; const LAS unsigned* lb = la + 20;
            float av[16], bv[16];
#pragma unroll
            for (int q = 0; q < 4; ++q) { const v4u a = *(const LAS v4u*)(la + q * 4), b = *(const LAS v4u*)(lb + q * 4);
#pragma unroll
                for (int j = 0; j < 4; ++j) { av[q * 4 + j] = __uint_as_float(a[j] & ~127u); bv[q * 4 + j] = __uint_as_float(b[j] & ~127u); } }
            float c0[16], c1[16], c2[16], c3[16];
#pragma unroll
            for (int i = 0; i < 16; ++i) { c0[i] = -INFINITY; c1[i] = -INFINITY; c2[i] = -INFINITY; c3[i] = -INFINITY; }
            {
                int cnt = 0;
#pragma unroll
                for (int i = 0; i < 16; ++i)
#pragma unroll
                    for (int j = 0; j < 16; ++j) if ((i + 1) * (j + 1) <= 16) {
                        const float sm = __uint_as_float((__float_as_uint(av[i] + bv[j]) & ~255u) | (unsigned)(i * 16 + j));
                        const int slot = cnt & 15, arr = cnt >> 4;
                        if (arr == 0) c0[slot] = sm; else if (arr == 1) c1[slot] = sm; else if (arr == 2) c2[slot] = sm; else c3[slot] = sm;
                        ++cnt;
                    }
            }
            sort16_desc(c0); sort16_desc(c1); sort16_desc(c2); sort16_desc(c3);
            merge16_desc(c0, c1); merge16_desc(c0, c2); merge16_desc(c0, c3);
            float ev[16], sum = 0.f; const float m0 = __uint_as_float(__float_as_uint(c0[0]) & ~255u);
#pragma unroll
            for (int k = 0; k < 16; ++k) { ev[k] = fast_exp2((__uint_as_float(__float_as_uint(c0[k]) & ~255u) - m0) * LOG2E); sum += ev[k]; }
            const float rs = 1.0f / sum;
#pragma unroll
            for (int k = 0; k < 16; ++k) { const unsigned code = __float_as_uint(c0[k]) & 255u;
                const int ia = (int)(la[code >> 4] & 127u), ib = (int)(lb[code & 15u] & 127u);
                eid[tok * 128 + hd * 16 + k] = ia * NKEYS + ib; gt[tok * 128 + hd * 16 + k] = ev[k] * rs;
#if SELFCHECK
                if (tok < nt) { P.dbg_eid[(size_t)(row0 + tok) * 128 + hd * 16 + k] = ia * NKEYS + ib; P.dbg_gt[(size_t)(row0 + tok) * 128 + hd * 16 + k] = ev[k] * rs; }
#endif
            }
        }
        }
        __syncthreads();
        { const int lb = row0 - t_begin;
#pragma unroll
          for (int i = 0; i < 8; ++i) { const int idx = i * NTHREADS + tid; if ((idx >> 7) < nt) { eidL[lb * 128 + idx] = (unsigned short)eid[idx]; gtL[lb * 128 + idx] = gt[idx]; } }
#pragma unroll 1
          for (int tk = 0; tk < 4; ++tk) { const int tok = F.wave * 4 + tk; if (tok >= nt) break;
            const size_t row = (size_t)(row0 + tok);
            const bf16_t* hp = P.Hin + row * DM + 16 * lane;
            const v4u h0 = *(const v4u*)hp, h1 = *(const v4u*)(hp + 8);
            float xf[16];
#pragma unroll
            for (int q = 0; q < 4; ++q) { xf[2 * q] = bflo(h0[q]); xf[2 * q + 1] = bfhi(h0[q]); xf[8 + 2 * q] = bflo(h1[q]); xf[8 + 2 * q + 1] = bfhi(h1[q]); }
            float am = 0.f;
#pragma unroll
            for (int i = 0; i < 16; ++i) am = __builtin_fmaxf(am, __builtin_fabsf(xf[i]));
            am = wave_max(am);
            const float ix = am > 0.f ? 127.f / am : 0.f;
            v4u xq;
#pragma unroll
            for (int q = 0; q < 4; ++q) { unsigned w = 0;
#pragma unroll
                for (int j = 0; j < 4; ++j) { const int v = (int)__builtin_rintf(xf[4 * q + j] * ix); w |= (unsigned)(v & 0xff) << (8 * j); }
                xq[q] = w; }
            *(v4u*)(P.H8out_xq + row * DM + 16 * lane) = xq;
            if (lane == 0) sxL[lb + tok] = am * (1.f / 127.f); }
        }
        __syncthreads();
    }
    asm volatile("s_waitcnt vmcnt(0)" ::: "memory"); __syncthreads();
    const int ntot = t_end - t_begin;
#pragma unroll 1
    for (int gi = 0; gi < 2; ++gi) { const int lt0 = F.wave * 4 + 32 * gi; int cnt = ntot - lt0; cnt = cnt < 0 ? 0 : (cnt > 4 ? 4 : cnt); if (cnt > 0) peer2_tokens<4>(F, P, t_begin, lt0, cnt, lane); }
    if (ntot > 64 && F.wave == 0) peer2_tokens<1>(F, P, t_begin, 64, 1, lane);
}

__device__ __forceinline__ void peer_phase(Frame& F, const PeerArgs& P) {
    const int tid = ltid(F.wave), lane = tid & 63;
    LAS unsigned* lists = (LAS unsigned*)(F.lds + PL_LISTS);
    LAS int* eid = (LAS int*)(F.lds + PL_EID);
    LAS float* gt = (LAS float*)(F.lds + PL_GT);
    const int ntok = P.nblocks * 32, tpc = (ntok + F.G - 1) / F.G, t_begin = F.vcu * tpc, t_end = (t_begin + tpc < ntok) ? t_begin + tpc : ntok;
    for (int row0 = t_begin; row0 < t_end; row0 += 32) {
        const int nt = (t_end - row0 < 32) ? t_end - row0 : 32;
        for (int rr = 0; rr < P.route_reps; ++rr) {
        if (rr) __syncthreads();
        {
            const int tok = tid >> 4, lst = tid & 15;
            const bf16_t* sp = (const bf16_t*)P.S + (size_t)(row0 + (tok < nt ? tok : nt - 1)) * 2048 + lst * 128;
            float top[16];
            v4u nv[2];
#pragma unroll
            for (int q = 0; q < 2; ++q) nv[q] = *(const v4u*)(sp + q * 8);
#pragma unroll 1
            for (int c = 0; c < 8; ++c) {
                float x[16];
#pragma unroll
                for (int e = 0; e < 16; ++e) { const unsigned w = nv[e >> 3][(e >> 1) & 3];
                    x[e] = __uint_as_float(((e & 1) ? (w & 0xffff0000u) : (w << 16)) | (unsigned)(c * 16 + e)); }
                if (c < 7) {
#pragma unroll
                    for (int q = 0; q < 2; ++q) nv[q] = *(const v4u*)(sp + (c + 1) * 16 + q * 8);
                }
                sort16_desc(x);
                if (c == 0) {
#pragma unroll
                    for (int i = 0; i < 16; ++i) top[i] = x[i];
                } else merge16_desc(top, x);
            }
            LAS unsigned* lp = lists + tid * 20;
#pragma unroll
            for (int q = 0; q < 4; ++q) *(LAS v4u*)(lp + q * 4) = (v4u){__float_as_uint(top[q * 4]), __float_as_uint(top[q * 4 + 1]), __float_as_uint(top[q * 4 + 2]), __float_as_uint(top[q * 4 + 3])};
        }
        __syncthreads();
        if (tid < 256) {
            const int tok = tid >> 3, hd = tid & 7;
            const LAS unsigned* la = lists + (tok * 16 + 2 * hd) * 20; const LAS unsigned* lb = la + 20;
            float av[16], bv[16];
#pragma unroll
            for (int q = 0; q < 4; ++q) { const v4u a = *(const LAS v4u*)(la + q * 4), b = *(const LAS v4u*)(lb + q * 4);
#pragma unroll
                for (int j = 0; j < 4; ++j) { av[q * 4 + j] = __uint_as_float(a[j] & ~127u); bv[q * 4 + j] = __uint_as_float(b[j] & ~127u); } }
            float c0[16], c1[16], c2[16], c3[16];
#pragma unroll
            for (int i = 0; i < 16; ++i) { c0[i] = -INFINITY; c1[i] = -INFINITY; c2[i] = -INFINITY; c3[i] = -INFINITY; }
            {
                int cnt = 0;
#pragma unroll
                for (int i = 0; i < 16; ++i)
#pragma unroll
                    for (int j = 0; j < 16; ++j) if ((i + 1) * (j + 1) <= 16) {
                        const float sm = __uint_as_float((__float_as_uint(av[i] + bv[j]) & ~255u) | (unsigned)(i * 16 + j));
                        const int slot = cnt & 15, arr = cnt >> 4;
                        if (arr == 0) c0[slot] = sm; else if (arr == 1) c1[slot] = sm; else if (arr == 2) c2[slot] = sm; else c3[slot] = sm;
                        ++cnt;
                    }
            }
            sort16_desc(c0); sort16_desc(c1); sort16_desc(c2); sort16_desc(c3);
            merge16_desc(c0, c1); merge16_desc(c0, c2); merge16_desc(c0, c3);
            float ev[16], sum = 0.f; const float m0 = __uint_as_float(__float_as_uint(c0[0]) & ~255u);
#pragma unroll
            for (int k = 0; k < 16; ++k) { ev[k] = fast_exp2((__uint_as_float(__float_as_uint(c0[k]) & ~255u) - m0) * LOG2E); sum += ev[k]; }
            const float rs = 1.0f / sum;
#pragma unroll
            for (int k = 0; k < 16; ++k) { const unsigned code = __float_as_uint(c0[k]) & 255u;
                const int ia = (int)(la[code >> 4] & 127u), ib = (int)(lb[code & 15u] & 127u);
                eid[tok * 128 + hd * 16 + k] = ia * NKEYS + ib; gt[tok * 128 + hd * 16 + k] = ev[k] * rs;
#if SELFCHECK
                if (tok < nt) { P.dbg_eid[(size_t)(row0 + tok) * 128 + hd * 16 + k] = ia * NKEYS + ib; P.dbg_gt[(size_t)(row0 + tok) * 128 + hd * 16 + k] = ev[k] * rs; }
#endif
            }
        }
        }
        __syncthreads();
#pragma unroll 1
        for (int tk = 0; tk < 4; ++tk) {
            const int tok = F.wave * 4 + tk; if (tok >= nt) break;
            const size_t row = (size_t)(row0 + tok);
            const bool latent = row < (size_t)SEQ;
            const bf16_t* hp = P.Hin + row * DM + 16 * lane;
            const v4u h0 = *(const v4u*)hp, h1 = *(const v4u*)(hp + 8);
            float xf[16];
#pragma unroll
            for (int q = 0; q < 4; ++q) { xf[2 * q] = bflo(h0[q]); xf[2 * q + 1] = bfhi(h0[q]); xf[8 + 2 * q] = bflo(h1[q]); xf[8 + 2 * q + 1] = bfhi(h1[q]); }
            float am = 0.f;
#pragma unroll
            for (int i = 0; i < 16; ++i) am = __builtin_fmaxf(am, __builtin_fabsf(xf[i]));
            am = wave_max(am);
            const float sx = am * (1.f / 127.f), ix = am > 0.f ? 127.f / am : 0.f;
            int xq[4];
#pragma unroll
            for (int q = 0; q < 4; ++q) { int w = 0;
#pragma unroll
                for (int j = 0; j < 4; ++j) { const int v = (int)__builtin_rintf(xf[4 * q + j] * ix); w |= (v & 0xff) << (8 * j); }
                xq[q] = w; }
            float out[16]; float asum = 0.f;
#pragma unroll
            for (int i = 0; i < 16; ++i) out[i] = 0.f;
            const int esel = (lane >> 2) & 15;
#pragma unroll 1
            for (int e0 = 0; e0 < 128; e0 += 16) {
                v4u ua[16], va[16];
#pragma unroll
                for (int k = 0; k < 16; ++k) { const int id = __builtin_amdgcn_readfirstlane(eid[tok * 128 + e0 + k]);
                    ua[k] = *(const v4u*)(P.U + (unsigned)(((lane >> 3) * NEXP + id) * 128 + 16 * (lane & 7))); va[k] = *(const v4u*)(P.V + (unsigned)(((lane >> 3) * NEXP + id) * 128 + 16 * (lane & 7))); }
                const int myid = eid[tok * 128 + e0 + esel]; const float mysu = P.SU[myid], mysv = P.SV[myid], myg = gt[tok * 128 + e0 + esel];
                int d[16];
#pragma unroll
                for (int k = 0; k < 16; ++k) { int di = __builtin_amdgcn_sdot4((int)ua[k][0], xq[0], 0, false); di = __builtin_amdgcn_sdot4((int)ua[k][1], xq[1], di, false);
                    di = __builtin_amdgcn_sdot4((int)ua[k][2], xq[2], di, false); d[k] = __builtin_amdgcn_sdot4((int)ua[k][3], xq[3], di, false); }
                int s8[8], s4[4], s2[2];
#pragma unroll
                for (int i = 0; i < 8; ++i) { auto r = __builtin_amdgcn_permlane32_swap((unsigned)d[i], (unsigned)d[i + 8], false, false); s8[i] = (int)r[0] + (int)r[1]; }
#pragma unroll
                for (int i = 0; i < 4; ++i) { auto r = __builtin_amdgcn_permlane16_swap((unsigned)s8[i], (unsigned)s8[i + 4], false, false); s4[i] = (int)r[0] + (int)r[1]; }
                const bool b3 = (lane & 8) != 0, b2 = (lane & 4) != 0;
#pragma unroll
                for (int i = 0; i < 2; ++i) { const int keep = b3 ? s4[i + 2] : s4[i], send = b3 ? s4[i] : s4[i + 2]; s2[i] = keep + __builtin_amdgcn_update_dpp(0, send, 0x128, 0xf, 0xf, false); }
                int z; { const int keep = b2 ? s2[1] : s2[0], send = b2 ? s2[0] : s2[1]; z = keep + __builtin_amdgcn_ds_swizzle(send, 0x101F); }
                z += __builtin_amdgcn_update_dpp(0, z, 0x4E, 0xf, 0xf, false);
                z += __builtin_amdgcn_update_dpp(0, z, 0xB1, 0xf, 0xf, false);
                const float pre = (float)z * (mysu * sx);
                const float act = myg * gelu_tanh(pre);
#if SELFCHECK
                if ((lane & 3) == 0) P.dbg_gt[(size_t)9 * MiB / 4 + row * 128 + e0 + esel] = gelu_tanh(pre);
#endif
                const float cfl = act * mysv;
#pragma unroll
                for (int k = 0; k < 16; ++k) {
                    const float cf = __uint_as_float(__builtin_amdgcn_readlane(__float_as_uint(cfl), 4 * k));
                    asum += cf;
                    const f32x2 cf2 = {cf, cf};
#pragma unroll
                    for (int q = 0; q < 4; ++q) { const unsigned w = va[k][q];
                        const f32x2 v01 = {(float)(w & 0xffu), (float)((w >> 8) & 0xffu)}, v23 = {(float)((w >> 16) & 0xffu), (float)(w >> 24)};
                        f32x2 o01 = {out[4 * q], out[4 * q + 1]}, o23 = {out[4 * q + 2], out[4 * q + 3]};
                        o01 = __builtin_elementwise_fma(cf2, v01, o01); o23 = __builtin_elementwise_fma(cf2, v23, o23);
                        out[4 * q] = o01.x; out[4 * q + 1] = o01.y; out[4 * q + 2] = o23.x; out[4 * q + 3] = o23.y; }
                }
            }
#pragma unroll
            for (int i = 0; i < 16; ++i) out[i] -= 128.f * asum;
            const float* g2 = latent ? P.g2l : P.g2c;
            float xn[16]; float ss = 0.f;
#pragma unroll
            for (int q = 0; q < 4; ++q) { const int col = 16 * lane + 4 * q; const f32x4 xo = *(const f32x4*)(P.Xin + row * DM + col), g = *(const f32x4*)(g2 + col);
#pragma unroll
                for (int j = 0; j < 4; ++j) { const float v = xo[j] + g[j] * out[4 * q + j]; xn[4 * q + j] = v; ss += v * v; } }
            const float ri = __builtin_amdgcn_rsqf(wave_sum(ss) * (1.f / DM) + EPS);
            if (P.dry) {
                if (ri == 12345.678f) P.Xout[row * DM] = ri;
            } else if (P.fout) {
                if (latent) {
#pragma unroll
                    for (int q = 0; q < 4; ++q) { const int col = 16 * lane + 4 * q; const f32x4 w = *(const f32x4*)(P.fnw + col);
                        f32x4 y; y.x = xn[4 * q] * ri * w.x; y.y = xn[4 * q + 1] * ri * w.y; y.z = xn[4 * q + 2] * ri * w.z; y.w = xn[4 * q + 3] * ri * w.w;
                        *(f32x4*)(P.fout + row * DM + col) = y; }
                }
            } else {
                const float* sh = latent ? P.shl : P.shc; const float* sc = latent ? P.scl : P.scc;
                unsigned hw[8], h8[4];
#pragma unroll
                for (int q = 0; q < 4; ++q) { const int col = 16 * lane + 4 * q;
                    *(f32x4*)(P.Xout + row * DM + col) = (f32x4){xn[4 * q], xn[4 * q + 1], xn[4 * q + 2], xn[4 * q + 3]};
                    const f32x4 w = *(const f32x4*)(P.nwn + col), a = *(const f32x4*)(sc + col), b = *(const f32x4*)(sh + col);
                    float y[4];
#pragma unroll
                    for (int j = 0; j < 4; ++j) y[j] = (xn[4 * q + j] * ri * w[j]) * (1.0f + a[j]) + b[j];
                    hw[2 * q] = pk2(y[0], y[1]); hw[2 * q + 1] = pk2(y[2], y[3]); h8[q] = pk4_fp8(y[0], y[1], y[2], y[3]); }
                if (P.Hout) { *(v4u*)(P.Hout + row * DM + 16 * lane) = (v4u){hw[0], hw[1], hw[2], hw[3]};
                    *(v4u*)(P.Hout + row * DM + 16 * lane + 8) = (v4u){hw[4], hw[5], hw[6], hw[7]}; }
                if (P.H8out) *(v4u*)(P.H8out + row * DM + 16 * lane) = (v4u){h8[0], h8[1], h8[2], h8[3]};
            }
        }
        __syncthreads();
    }
}
__device__ __forceinline__ float lam_init_of(int l) { return l == 0 ? 0.2f : 0.35550906765f; }

#ifndef PHASE_MASK
#define PHASE_MASK 0xffff
#endif
#define PH(n) ((PHASE_MASK >> (n)) & 1)
#define REPS(n) (1 + ((dupmask >> (n)) & 1))
__global__ void __launch_bounds__(NTHREADS, 2) trunk_fwd(Args args) {
    extern __shared__ __attribute__((aligned(16))) unsigned char lds[];
    Frame F;
    F.lds = (LAS unsigned char*)lds;
    F.MISC = (volatile LAS unsigned*)(F.lds + MISC_OFF);
    F.wave = __builtin_amdgcn_readfirstlane((int)threadIdx.x >> 6);
    F.G = gridDim.x; { const int bx = blockIdx.x; F.vcu = (F.G % 8 == 0) ? (bx % 8) * (F.G / 8) + bx / 8 : bx; }
    unsigned char* ws = args.ws;
    F.ctl = (gu32*)(ws + WS_CTL);
    for (int u = ltid(F.wave); u < (LDS_BYTES - LDSCTL_OFF) / 4; u += NTHREADS) ((LAS unsigned*)(F.lds + LDSCTL_OFF))[u] = 0u;
    __syncthreads();
    XcdBarrier bar = xcd_barrier_post((unsigned*)(F.ctl + CW_BAR), F.MISC + 8, F.wave);
#ifndef TIMING
#define TIMING 0
#endif
#if TIMING
    int n_stamp = 0;
#define STAMP() do { if (blockIdx.x == 0 && tid_now(F.wave) == 0) ((unsigned long long*)(F.ctl + 1024))[n_stamp] = __builtin_amdgcn_s_memrealtime(); ++n_stamp; } while (0)
#else
#define STAMP() do {} while (0)
#endif
#define GRID_BAR() do { xcd_barrier(bar); STAMP(); asm volatile("" : "+s"(ws)); } while (0)
    STAMP();

    const float* const* in = args.in;
    const int dupmask = args.flags;
#define modv ((float*)(ws + WS_CONST))
#define lamv (modv + 2 * 2 * 6144)
#define WIN ((bf16_t*)(ws + WS_WIN))
#define WGATE ((bf16_t*)(ws + WS_WGATE))
#define WBR ((bf16_t*)(ws + WS_WBR))
#define WOUT ((bf16_t*)(ws + WS_WOUT))
#define WSC ((bf16_t*)(ws + WS_WSC))
#define X ((float*)(ws + WS_X))
#define H ((bf16_t*)(ws + WS_H))
#define YS ((bf16_t*)(ws + WS_YS))
#define MIX YS
#define Qb ((bf16_t*)(ws + WS_Q))
#define Kb ((bf16_t*)(ws + WS_K))
#define Vb ((bf16_t*)(ws + WS_V))
#define BP ((bf16_t*)(ws + WS_R1))
#define SB ((float*)(ws + WS_R1))
    const int gw = F.vcu * NWAVES + F.wave, NGW = F.G * NWAVES;

    for (int rep = 0; rep < REPS(0); ++rep) {
        const int tid = ltid(F.wave), lane = tid & 63;
        LAS float* scr = (LAS float*)(F.lds + F.wave * 16384);
        for (int un = F.vcu; un < 2 * 128; un += F.G) {
            const int l = un >> 7, col = (un & 127) * 48 + lane; const bool act = lane < 48;
            const float* W = in[I_ADAW] + (size_t)l * DM * 6144;
            float a0 = 0.f, a1 = 0.f;
            if (act) {
#pragma unroll 16
                for (int k = 128 * F.wave; k < 128 * F.wave + 128; ++k) { const float w = W[(size_t)k * 6144 + col]; const float c0 = in[I_C][k], c1 = in[I_CCTX][k];
                    a0 += c0 * sigmoidf_(c0) * w; a1 += c1 * sigmoidf_(c1) * w; }
            }
            LAS float* red = (LAS float*)(F.lds);
            red[(F.wave * 64 + lane) * 2] = a0; red[(F.wave * 64 + lane) * 2 + 1] = a1;
            __syncthreads();
            if (F.wave == 0 && act) { float s0 = in[I_ADAB][l * 6144 + col], s1 = s0;
#pragma unroll
                for (int w = 0; w < 8; ++w) { s0 += red[(w * 64 + lane) * 2]; s1 += red[(w * 64 + lane) * 2 + 1]; }
                modv[(l * 2 + 0) * 6144 + col] = s0; modv[(l * 2 + 1) * 6144 + col] = s1; }
            __syncthreads();
        }
        if (blockIdx.x == 0 && tid < 2) { const float* lf = in[I_DLAM] + tid * 128; float s0 = 0.f, s1 = 0.f;
            for (int i = 0; i < 32; ++i) { s0 += lf[i] * lf[32 + i]; s1 += lf[64 + i] * lf[96 + i]; }
            lamv[tid] = expf(s0) - expf(s1) + lam_init_of(tid); }
        constexpr int I_IN = 16 * 80, I_GT = 16 * 128, I_BR = 4 * 32, I_OT = 16 * 32;
        constexpr int NITEMS = 2 * I_IN + 2 * I_GT + 8 * I_BR + 2 * I_OT;
        unsigned char* W8IN = ws + WS_W8IN; unsigned char* W8GATE = ws + WS_W8GATE;
        for (int it = gw; it < NITEMS; it += NGW) {
            int r = it;
            if (r < 2 * I_IN) { const int l = r / I_IN; transpose_item<MapWin, true>(in[I_WIN] + (size_t)l * DM * NQKV, DM, NQKV, W8IN + (size_t)l * NQKV * DM, MapWin(), scr, r % I_IN, lane); continue; } r -= 2 * I_IN;
            if (r < 2 * I_GT) { const int l = r / I_GT; transpose_item<MapGate, true>(in[I_WGATE] + (size_t)l * DM * 4096, DM, 4096, W8GATE + (size_t)l * 4096 * DM, MapGate(), scr, r % I_GT, lane); continue; } r -= 2 * I_GT;
            if (r < 8 * I_BR) { const int lb = r / I_BR; transpose_item(in[I_WBR] + (size_t)lb * 256 * DM, 256, DM, WBR + (size_t)lb * DM * 256, MapId(), scr, r % I_BR, lane); continue; } r -= 8 * I_BR;
#if MIX8
            { const int l = r / I_OT; transpose_item<MapId, true>(in[I_WOUT] + (size_t)l * DM * DM, DM, DM, ws + WS_W8OUT + (size_t)l * DM * DM, MapId(), scr, r % I_OT, lane); }
#else
            { const int l = r / I_OT; transpose_item(in[I_WOUT] + (size_t)l * DM * DM, DM, DM, WOUT + (size_t)l * DM * DM, MapId(), scr, r % I_OT, lane); }
#endif
        }
        for (int it = gw; it < 2 * 16 * 8 * 64; it += NGW) {
            const int kt = it & 63, nt = (it >> 6) & 7, g = (it >> 9) & 15, l = it >> 13, h = g >> 1, p = g & 1;
            const float* kp = in[I_PKEYS] + ((size_t)((l * 2 + p) * 8 + h) * 128 + nt * 16 + (lane & 15)) * 128 + 4 * (lane >> 4);
            const float* qp = in[I_PWQ] + ((size_t)l * DM + kt * 16 + (lane & 15)) * 2048 + g * 128 + 4 * (lane >> 4);
            f32x4 acc = {0.f, 0.f, 0.f, 0.f};
            f32x4 ka[8], qa[8];
#pragma unroll
            for (int c = 0; c < 8; ++c) { ka[c] = *(const f32x4*)(kp + 16 * c); qa[c] = *(const f32x4*)(qp + 16 * c); }
            __builtin_amdgcn_sched_barrier(0);
#pragma unroll
            for (int c = 0; c < 8; ++c)
#pragma unroll
                for (int j = 0; j < 4; ++j) acc = __builtin_amdgcn_mfma_f32_16x16x4f32(ka[c][j], qa[c][j], acc, 0, 0, 0);
            bf16_t* op = WSC + ((size_t)l * 2048 + g * 128 + nt * 16 + 4 * (lane >> 4)) * DM + kt * 16 + (lane & 15);
#pragma unroll
            for (int r = 0; r < 4; ++r) op[(size_t)r * DM] = (bf16_t)f2bf(acc[r]);
        }
        {
            unsigned char* UQ = (unsigned char*)(ws + WS_UBF); unsigned char* VQ = (unsigned char*)(ws + WS_VBF); float* SU = (float*)(ws + WS_SU); float* SV = (float*)(ws + WS_SV);
            for (int r0 = gw; r0 < 2 * 2 * NEXP; r0 += 4 * NGW) {
                f32x4 v[4][4];
#pragma unroll
                for (int u4 = 0; u4 < 4; ++u4) { const int r = r0 + u4 * NGW; const bool isv = r >= 2 * NEXP; const int rr = isv ? r - 2 * NEXP : r;
                    const float* src = (isv ? in[I_PV] : in[I_PU]) + (size_t)rr * DM + 16 * lane;
#pragma unroll
                    for (int q = 0; q < 4; ++q) v[u4][q] = *(const f32x4*)(src + 4 * q); }
#pragma unroll
                for (int u4 = 0; u4 < 4; ++u4) { const int r = r0 + u4 * NGW; const bool isv = r >= 2 * NEXP; const int rr = isv ? r - 2 * NEXP : r;
                    float am = 0.f;
#pragma unroll
                    for (int q = 0; q < 4; ++q) am = __builtin_fmaxf(am, __builtin_fmaxf(__builtin_fmaxf(__builtin_fabsf(v[u4][q].x), __builtin_fabsf(v[u4][q].y)), __builtin_fmaxf(__builtin_fabsf(v[u4][q].z), __builtin_fabsf(v[u4][q].w))));
                    am = wave_max(am);
                    const float inv = am > 0.f ? 127.f / am : 0.f; const int off = isv ? 128 : 0;
                    v4u w;
#pragma unroll
                    for (int q = 0; q < 4; ++q) { const int a0 = (int)__builtin_rintf(v[u4][q].x * inv) + off, a1 = (int)__builtin_rintf(v[u4][q].y * inv) + off, a2 = (int)__builtin_rintf(v[u4][q].z * inv) + off, a3 = (int)__builtin_rintf(v[u4][q].w * inv) + off;
                        w[q] = (unsigned)(a0 & 0xff) | ((unsigned)(a1 & 0xff) << 8) | ((unsigned)(a2 & 0xff) << 16) | ((unsigned)(a3 & 0xff) << 24); }
                    { const int lyr = rr >> 14, ex = rr & (NEXP - 1);
                      *(v4u*)((isv ? VQ : UQ) + (size_t)lyr * NEXP * DM + (size_t)(((lane >> 3) * NEXP + ex) * 128 + 16 * (lane & 7))) = w; }
                    if (lane == 0) SU[2 * rr + (isv ? 1 : 0)] = am * (1.f / 127.f); }
            }
        }
    }
#if SELFCHECK
    GRID_BAR();
#define CK_RED ((LAS float*)(F.lds))
#define CK_BUF ((LAS float*)(F.lds + 1024))
#define CK_IBUF ((LAS int*)(F.lds + 8192))
#define CK_OBUF ((LAS float*)(F.lds + 20480))
#define CK_SC ((LAS float*)(F.lds + 24576))
    if (blockIdx.x == 0) chk::ck_prologue(in, ws, F.ctl, CK_RED);
    __syncthreads();
#endif
    GRID_BAR();
    { const int lane = ltid(F.wave) & 63;
    for (int m = gw; m < MT; m += NGW) {
        const bool lat = m < SEQ; const float* xr = lat ? in[I_X] + (size_t)m * DM : in[I_CTX] + (size_t)(m - SEQ) * DM; const float* mv = modv + (lat ? 0 : 6144);
        modnorm_row(xr, SELFCHECK ? H + (size_t)m * DM : (bf16_t*)nullptr, in[I_N1W], mv, mv + 1024, lane, ws + WS_H8 + (size_t)m * DM);
    } }
    GRID_BAR();
#if SELFCHECK
    if (blockIdx.x < 5) { const int r = blockIdx.x == 0 ? 0 : blockIdx.x == 1 ? 777 : blockIdx.x == 2 ? 16383 : blockIdx.x == 3 ? 16384 : 16639;
        const bool lat = r < SEQ; const float* mv = modv + (lat ? 0 : 6144);
        chk::ck_modnorm(lat ? in[I_X] + (size_t)r * DM : in[I_CTX] + (size_t)(r - SEQ) * DM, H + (size_t)r * DM, in[I_N1W], mv, mv + 1024, F.ctl, 2, CK_RED); }
    GRID_BAR();
#endif

#pragma unroll 1
    for (int l = 0; l < 2; ++l) {
#define modl (modv + (size_t)(l * 2) * 6144)
#define modc (modl + 6144)
        const int nMr = (l == 0) ? MT / 256 : SEQ / 256;
        for (int rep = 0; rep < REPS(2); ++rep) {
            if (rep) GRID_BAR();
            pg8::Gemm g{ws + WS_H8, ws + WS_W8IN + (size_t)l * NQKV * DM, MT / 256, NQKV / 256, DM, DM, DM, 0, 0, 1};
            pg8::StaticOrder S; S.init(g, F.G, (int)blockIdx.x);
            pg8::EpiQKV E{Qb, Kb, Vb, in[I_QKNW] + l * 128};
            pg8::gemm_phase<pg8::EpiQKV, true>(F.lds, g, S, E, F.wave);
        }
        GRID_BAR();
#if SELFCHECK
        if (blockIdx.x < 4) { const int b = blockIdx.x; const int r = b == 0 ? 5 : b == 1 ? 8400 : b == 2 ? 16383 : 16391; chk::ck_qkv(l, r, in, ws, F.ctl, CK_RED, CK_BUF); }
        GRID_BAR();
#endif
        for (int rep = 0; rep < REPS(4); ++rep) {
            if (rep) GRID_BAR();
            char* shm = (char*)lds;
            const float lam = lamv[l];
            for (int ui = F.vcu; ui < 256; ui += F.G) {
                const int h = (ui >> 5) & 3, qb = ((ui >> 7) << 5) | (ui & 31);
                const int njobs = (l == 0 && ui < 16) ? (((ui >> 2) == 1) ? 7 : 6) : 5;
#pragma unroll 1
                for (int j = 0; j < njobs; ++j) {
                    att::AU u; int mode = 0;
                    u.sinkl2 = -INFINITY; u.emode = 0; u.lam = 0.f; u.oscale = 1.f; u.subw = in[I_SUBW] + l * 64; u.kbase = 0; u.q0 = qb * 256; u.NT = 260;
                    int qh, kh, oc;
                    if (j == 0)      { qh = 16 + h; kh = 10 + (h >> 1); oc = 768 + h * 64; }
                    else if (j == 1) { qh = 4 + 2 * h; kh = 4 + h; oc = 256 + h * 64; u.emode = 1; }
                    else if (j == 2) { qh = 5 + 2 * h; kh = 4 + h; oc = 256 + h * 64; u.emode = 2; u.lam = lam; u.oscale = 1.f - lam_init_of(l); }
                    else if (j == 3) { qh = h; kh = h; oc = h * 64; mode = 1; u.NT = 16; int B = 4 * qb - 4; B = B < 0 ? 0 : (B > 244 ? 244 : B); u.kbase = 64 * B; }
                    else if (j == 4) { qh = 12 + h; kh = 8 + (h >> 1); oc = 512 + h * 64; mode = 2; u.NT = 12; u.kbase = 256 * qb - 128; u.sinkl2 = in[I_SINK][l * 4 + h] * LOG2E; }
                    else {
                        const int mx = ui >> 2, hc = ui & 3; u.q0 = SEQ; u.NT = 4;
                        if (mx == 0)      { qh = hc; kh = hc; oc = hc * 64; }
                        else if (mx == 1) { qh = 4 + 2 * hc + (j - 5); kh = 4 + hc; oc = 256 + hc * 64; u.emode = (j == 5) ? 1 : 2; u.lam = lam; u.oscale = 1.f - lam_init_of(l); }
                        else if (mx == 2) { qh = 12 + hc; kh = 8 + (hc >> 1); oc = 512 + hc * 64; u.sinkl2 = in[I_SINK][l * 4 + hc] * LOG2E; }
                        else              { qh = 16 + hc; kh = 10 + (hc >> 1); oc = 768 + hc * 64; }
                    }
                    u.Q = (const att::bf16*)(Qb + (size_t)qh * MT * 64); u.K = (const att::bf16*)(Kb + (size_t)kh * MT * 64); u.V = (const att::bf16*)(Vb + (size_t)kh * MT * 64);
                    u.O = (att::bf16*)(YS + oc);
#ifndef ATT_MODES
#define ATT_MODES 7
#endif
                    if ((ATT_MODES & 2) && mode == 1) {
                        float* rp = (float*)(shm + att::LDS_RPB);
                        for (int i = ltid(F.wave); i < 15 * 32; i += NTHREADS) { const int c = i & 31; rp[i] = (c < 31) ? in[I_RPB][((size_t)(l * 4 + h) * 15 + (i >> 5)) * 31 + c] * LOG2E : 0.f; }
                        __syncthreads();
                        if (!att::attn_simple<1, 1>(u, shm, F.wave)) att::attn_simple<1>(u, shm, F.wave);
                    } else if ((ATT_MODES & 4) && mode == 2) { if (!att::attn_unit<2, 8, 0, 1>(u, shm, F.wave)) att::attn_unit<2, 8>(u, shm, F.wave); }
                    else if ((ATT_MODES & 1) && j == 1) { if (!att::attn_unit<0, 8, 1, 1>(u, shm, F.wave)) att::attn_unit<0, 8, 1>(u, shm, F.wave); }
                    else if ((ATT_MODES & 1) && j == 2) { if (!att::attn_unit<0, 8, 2, 1>(u, shm, F.wave)) att::attn_unit<0, 8, 2>(u, shm, F.wave); }
                    else if (ATT_MODES & 1) { if (!att::attn_unit<0, 8, 0, 1>(u, shm, F.wave)) att::attn_unit<0, 8>(u, shm, F.wave); }
                }
            }
        }
        GRID_BAR();
#if SELFCHECK
        if (blockIdx.x < 80) { const int b = blockIdx.x, ri = b >> 4; const int r = ri == 0 ? 3 : ri == 1 ? 4227 : ri == 2 ? 16319 : ri == 3 ? 9000 : 16484; chk::ck_attn(l, (b >> 2) & 3, b & 3, r, in, ws, F.ctl, CK_RED, CK_SC, CK_OBUF); }
        GRID_BAR();
#endif
        for (int rep = 0; rep < REPS(5); ++rep) {
            if (rep) GRID_BAR();
            pg8::Gemm g{YS, WBR + (size_t)l * 4 * DM * 256, nMr, 16, 256, DM, 256, 2, 512, 2};
            pg8::StaticOrder S; S.init(g, F.G, (int)blockIdx.x);
#if BP8
            pg8::EpiBranch8 E{(unsigned char*)BP};
            pg8::gemm_phase<pg8::EpiBranch8>(F.lds, g, S, E, F.wave);
#else
            pg8::EpiBranch E{BP};
            pg8::gemm_phase<pg8::EpiBranch>(F.lds, g, S, E, F.wave);
#endif
        }
        GRID_BAR();
#if SELFCHECK
        if (blockIdx.x < 3) { const int b = blockIdx.x; chk::ck_branch(l, b == 0 ? 1 : b == 1 ? 16383 : 16390, in, ws, F.ctl, CK_RED); }
        GRID_BAR();
#endif
        for (int rep = 0; rep < REPS(6); ++rep) {
            if (rep) GRID_BAR();
            pg8::Gemm g{ws + WS_H8, ws + WS_W8GATE + (size_t)l * 4096 * DM, nMr, 16, DM, DM, DM, 0, 0, 1};
            pg8::StaticOrder S; S.init(g, F.G, (int)blockIdx.x);
            pg8::EpiGate E{BP, MIX, in[I_BGATE] + l * 4096};
            pg8::gemm_phase<pg8::EpiGate, true>(F.lds, g, S, E, F.wave);
        }
        GRID_BAR();
#if SELFCHECK
        if (blockIdx.x < 3) { const int b = blockIdx.x; chk::ck_gate(l, b == 0 ? 2 : b == 1 ? 9999 : 16385, in, ws, F.ctl, CK_RED); }
        GRID_BAR();
#endif
        for (int rep = 0; rep < (l == 0 ? REPS(7) : 1); ++rep) {
            if (rep) GRID_BAR();
#if MIX8
            pg8::Gemm g{MIX, ws + WS_W8OUT + (size_t)l * DM * DM, nMr, 4, DM, DM, DM, 0, 0, 1};
#else
            pg8::Gemm g{MIX, WOUT + (size_t)l * DM * DM, nMr, 4, DM, DM, DM, 0, 0, 2};
#endif
            pg8::StaticOrder S; S.init(g, F.G, (int)blockIdx.x);
#ifndef FUSE_NORM2
#define FUSE_NORM2 1
#endif
#if FUSE_NORM2
            pg8::EpiOutNorm E{l == 0 ? in[I_X] : X, l == 0 ? in[I_CTX] : X + (size_t)SEQ * DM, X, modl + 2048, modc + 2048,
                              H, in[I_N2W] + l * DM, modl, modc, (gu32*)(ws + WS_CONST + 704 * 1024), F.ctl + 16384 + l * 65 * 64, F.ctl + 16000, F.lds + MISC_OFF + 1024};
#if MIX8
            pg8::gemm_phase<pg8::EpiOutNorm, true, 0x7A7A7A7A>(F.lds, g, S, E, F.wave);
#else
            pg8::gemm_phase<pg8::EpiOutNorm>(F.lds, g, S, E, F.wave);
#endif
#else
            pg8::EpiOut E{l == 0 ? in[I_X] : X, l == 0 ? in[I_CTX] : X + (size_t)SEQ * DM, X, modl + 2048, modc + 2048};
            pg8::gemm_phase<pg8::EpiOut>(F.lds, g, S, E, F.wave);
#endif
        }
        GRID_BAR();
#if SELFCHECK
        if (blockIdx.x < 3) { const int b = blockIdx.x; chk::ck_out(l, b == 0 ? 4 : b == 1 ? 12345 : 16417, in, ws, F.ctl, CK_RED); }
        GRID_BAR();
#endif
#if !FUSE_NORM2
        { const int lane = ltid(F.wave) & 63;
        for (int m = gw; m < nMr * 256; m += NGW) {
            const float* mv = (m < SEQ) ? modl : modc;
            modnorm_row(X + (size_t)m * DM, H + (size_t)m * DM, in[I_N2W] + l * DM, mv + 3072, mv + 4096, lane);
        } }
        GRID_BAR();
#endif
#if SELFCHECK
        if (blockIdx.x < 3) { const int b = blockIdx.x; const int r = b == 0 ? 7 : b == 1 ? 16383 : 16500; const float* mv = (r < SEQ) ? modl : modc;
            chk::ck_modnorm(X + (size_t)r * DM, H + (size_t)r * DM, in[I_N2W] + l * DM, mv + 3072, mv + 4096, F.ctl, 8, CK_RED); }
        GRID_BAR();
#endif
        for (int rep = 0; rep < REPS(9); ++rep) {
            if (rep) GRID_BAR();
            pg8::Gemm g{H, WSC + (size_t)l * 2048 * DM, nMr, 8, DM, DM, DM, 0, 0, 2};
            pg8::StaticOrder S; S.init(g, F.G, (int)blockIdx.x);
            pg8::EpiS E{SB};
            pg8::gemm_phase<pg8::EpiS>(F.lds, g, S, E, F.wave);
        }
        GRID_BAR();
#if SELFCHECK
        if (blockIdx.x < 3) { const int b = blockIdx.x; chk::ck_scores(l, b == 0 ? 6 : b == 1 ? 16000 : 16385, in, ws, F.ctl, CK_RED, CK_BUF); }
        GRID_BAR();
#endif
#ifndef PEER_SLICED
#define PEER_SLICED 0
#endif
#if !PEER_SLICED
        for (int rep = 0; rep < REPS(10); ++rep) {
            if (rep) GRID_BAR();
            PeerArgs P; P.dry = (rep + 1 < REPS(10)); P.route_reps = REPS(11);
            P.S = SB; P.Hin = H; P.U = (const unsigned char*)(ws + WS_UBF) + (size_t)l * NEXP * DM; P.V = (const unsigned char*)(ws + WS_VBF) + (size_t)l * NEXP * DM; P.SU = (const float*)(ws + WS_SU) + (size_t)l * 2 * NEXP; P.SV = (const float*)(ws + WS_SV) + l * NEXP; P.Xin = X; P.Xout = X;
            P.g2l = modl + 5120; P.g2c = modc + 5120;
            P.Hout = SELFCHECK ? H : (bf16_t*)nullptr; P.H8out = ws + WS_H8; P.nwn = in[I_N1W] + DM; P.shl = modv + 2 * 6144; P.scl = P.shl + 1024; P.shc = modv + 3 * 6144; P.scc = P.shc + 1024;
            P.fout = (l == 1) ? args.out : nullptr; P.fnw = in[I_FNW];
            P.nblocks = nMr * 8; P.dbg_eid = nullptr; P.dbg_gt = nullptr;
#if SELFCHECK
            if (l == 0) { P.Xout = (float*)(ws + WS_DBG); P.Hout = YS; P.H8out = nullptr; }
            P.dbg_eid = (int*)(ws + WS_VBF + 32 * MiB); P.dbg_gt = (float*)(ws + WS_VBF + 41 * MiB);
#endif
            P.H8out_xq = ws + WS_H8;
#ifndef PEER_V2
#define PEER_V2 1
#endif
            if (PEER_V2 && !P.dry) peer_phase2(F, P); else peer_phase(F, P);
        }
#else
        {
            PeerArgs P; P.dry = false; P.route_reps = 1;
            P.S = SB; P.Hin = H; P.U = (const unsigned char*)(ws + WS_UBF) + (size_t)l * NEXP * DM; P.V = (const unsigned char*)(ws + WS_VBF) + (size_t)l * NEXP * DM; P.SU = (const float*)(ws + WS_SU) + (size_t)l * 2 * NEXP; P.SV = (const float*)(ws + WS_SV) + l * NEXP; P.Xin = X; P.Xout = X;
            P.g2l = modl + 5120; P.g2c = modc + 5120;
            P.Hout = SELFCHECK ? H : (bf16_t*)nullptr; P.H8out = ws + WS_H8; P.nwn = in[I_N1W] + DM; P.shl = modv + 2 * 6144; P.scl = P.shl + 1024; P.shc = modv + 3 * 6144; P.scc = P.shc + 1024;
            P.fout = (l == 1) ? args.out : nullptr; P.fnw = in[I_FNW];
            P.nblocks = nMr * 8; P.dbg_eid = nullptr; P.dbg_gt = nullptr;
            PeerBufs B;
#if SELFCHECK
            unsigned char* pb = ws + WS_VBF + 32 * MiB;
            if (l == 0) { P.Xout = (float*)(ws + WS_DBG); P.Hout = YS; }
#else
            unsigned char* pb = ws + WS_YS;
#endif
            B.eid = (int*)pb; B.gt = (float*)(pb + 9 * MiB); B.a = (float*)(pb + 18 * MiB); B.xq = ws + WS_UBF + 32 * MiB; B.sx = (float*)(ws + WS_UBF + 50 * MiB);
            const int ntok = nMr * 256;
            peer_route(F, P, B);
            GRID_BAR();
            peer_u(F, P, B, ntok);
            GRID_BAR();
            peer_v(F, P, B, ntok);
            GRID_BAR();
            peer_norm(F, P, ntok);
        }
#endif
#if SELFCHECK
        break;
#endif
        if (l == 0) GRID_BAR();
    }
#if TIMING
    GRID_BAR(); xcd_barrier(bar);
    {
        const unsigned long long* ts = (const unsigned long long*)(F.ctl + 1024);
        float iv[10];
#pragma unroll
        for (int i = 0; i < 10; ++i) iv[i] = 0.f;
        iv[0] = (float)(ts[1] - ts[0]); iv[1] = (float)(ts[2] - ts[1]);
#pragma unroll
        for (int l = 0; l < 2; ++l)
#pragma unroll
            for (int p = 0; p < 8; ++p) iv[2 + p] += (float)(ts[3 + l * 8 + p] - ts[2 + l * 8 + p]);
        const float total = (float)(ts[18] - ts[0]);
        const int k1 = (int)(100.f * iv[TIMING_A] / total + 0.5f); int k2 = 10 + (int)(100.f * iv[TIMING_B] / total + 0.5f); k2 = k2 > 99 ? 99 : k2;
        const float cval = sqrtf((float)k1);
        for (size_t i = (size_t)blockIdx.x * NTHREADS + ltid(F.wave); i < (size_t)SEQ * DM / 4; i += (size_t)gridDim.x * NTHREADS) ((f32x4*)args.out)[i] = (f32x4){i == 0 ? 100.f * (float)k2 : cval, cval, cval, cval};
    }
#endif
#if SELFCHECK
    GRID_BAR();
    if (blockIdx.x < 5) { const int b = blockIdx.x; const int r = b == 0 ? 0 : b == 1 ? 31 : b == 2 ? 37 : b == 3 ? 16383 : 16639; chk::ck_peer(0, r, in, ws, F.ctl, CK_RED, CK_BUF, CK_IBUF); }
    GRID_BAR();
    {
        float e[32];
#pragma unroll
        for (int i = 0; i < 32; ++i) e[i] = __uint_as_float(__hip_atomic_load(F.ctl + CW_CHK + i, RLX_AGENT));
        const float T = 0.03f; int mask = 0;
#if SELFCHECK == 1
        mask = ((e[0] > T || e[1] > T) ? 1 : 0) | (e[2] > T ? 2 : 0) | (e[3] > T ? 4 : 0) | (e[4] > T ? 8 : 0) | (e[5] > T ? 16 : 0);
#elif SELFCHECK == 2
        mask = (e[6] > T ? 1 : 0) | (e[7] > T ? 2 : 0) | (e[8] > T ? 4 : 0) | (e[9] > T ? 8 : 0) | ((e[10] > T || e[11] > T) ? 16 : 0);
#elif SELFCHECK == 5
        mask = (e[24] > T ? 1 : 0) | (e[25] > T ? 2 : 0) | (e[26] > T ? 4 : 0) | (e[27] > T ? 8 : 0) | (e[28] > T ? 16 : 0);
#elif SELFCHECK == 4
        mask = (e[10] > T ? 1 : 0) | (e[11] > T ? 2 : 0) | (e[12] > T ? 4 : 0) | (e[13] > T ? 8 : 0);
#else
        mask = (e[16] > T ? 1 : 0) | (e[17] > T ? 2 : 0) | (e[18] > T ? 4 : 0) | (e[19] > T ? 8 : 0) | ((e[20] > T || e[21] > T || e[22] > T || e[23] > T) ? 16 : 0);
#endif
        const float cval = sqrtf((float)mask);
        for (size_t i = (size_t)blockIdx.x * NTHREADS + ltid(F.wave); i < (size_t)SEQ * DM / 4; i += (size_t)gridDim.x * NTHREADS) ((f32x4*)args.out)[i] = (f32x4){cval, cval, cval, cval};
    }
#endif
}
#ifndef DUP_MASK
#define DUP_MASK 0
#endif
extern "C" void kernel_launch(void* const* d_in, const int* in_sizes, int n_in, void* d_out, int out_size, void* d_ws, size_t ws_size, hipStream_t stream) {
    static int grid = 0;
    if (grid == 0) {
        size_t need = WS_END;
#if SELFCHECK
        need = WS_DBG + (size_t)MT * DM * 4;
#endif
        if (n_in != 23 || in_sizes[0] != SEQ * DM || out_size != SEQ * DM || ws_size < need) {
            fprintf(stderr, "kernel_launch: unexpected problem shape (n_in %d, in0 %d, out %d, ws %zu, need %zu); nothing launched\n", n_in, n_in > 0 ? in_sizes[0] : -1, out_size, ws_size, need); grid = -1; return; }
        int dev = 0, cus = 0, per_cu = 0;
        if (hipGetDevice(&dev) != hipSuccess || hipDeviceGetAttribute(&cus, hipDeviceAttributeMultiprocessorCount, dev) != hipSuccess) { fprintf(stderr, "kernel_launch: device query failed\n"); grid = -1; return; }
        if (hipFuncSetAttribute((const void*)trunk_fwd, hipFuncAttributeMaxDynamicSharedMemorySize, LDS_BYTES) != hipSuccess) { fprintf(stderr, "kernel_launch: hipFuncSetAttribute failed\n"); grid = -1; return; }
        if (hipOccupancyMaxActiveBlocksPerMultiprocessor(&per_cu, (const void*)trunk_fwd, NTHREADS, LDS_BYTES) != hipSuccess || per_cu < 1) {
            fprintf(stderr, "kernel_launch: occupancy query says %d blocks per CU; nothing launched\n", per_cu); (void)hipGetLastError(); grid = -1; return; }
        grid = cus;
    }
    if (grid < 0) return;
    (void)hipMemsetAsync((char*)d_ws + WS_CTL, 0, CTL_ZERO_BYTES, stream);
    Args a{};
    for (int i = 0; i < 23; ++i) a.in[i] = (const float*)d_in[i];
    a.out = (float*)d_out; a.ws = (unsigned char*)d_ws; a.flags = DUP_MASK; a.pad = 0;
    void* kargs[] = {&a};
    const hipError_t e = hipLaunchCooperativeKernel((const void*)trunk_fwd, dim3(grid), dim3(NTHREADS), kargs, LDS_BYTES, stream);
    if (e != hipSuccess) fprintf(stderr, "kernel_launch: cooperative launch failed: %s (grid %d)\n", hipGetErrorString(e), grid);
}
```

```cpp
#define SELFCHECK 0
#define TIMING 0
#define TIMING_A 0
#define TIMING_B 1
#define DUP_MASK 0
#define PEER_SLICED 0
#include <hip/hip_runtime.h>
#include <hip/hip_cooperative_groups.h>
#include <hip/hip_bf16.h>
#include <cstdio>
#include <cstdint>
#include <cmath>
namespace cg = cooperative_groups;

#ifndef SELFCHECK
#define SELFCHECK 0
#endif

constexpr int SEQ = 16384, CTX = 256, MT = SEQ + CTX, DM = 1024, NQKV = 2560, GRIDW = 64;
constexpr int NEXP = 16384, NKEYS = 128, PEER_H = 8, TOPK = 16;
constexpr float EPS = 1e-6f, LOG2E = 1.4426950408889634f;
constexpr float C2_64 = 0.125f * LOG2E;
constexpr float C2_32 = 0.17677669529663687f * LOG2E;
constexpr int NWAVES = 8, NTHREADS = 512;

constexpr size_t MiB = 1u << 20;
constexpr size_t WS_CTL = 0, CTL_ZERO_BYTES = 1 * MiB;
constexpr size_t WS_CONST = 1 * MiB;
constexpr size_t WS_WIN = 2 * MiB;
constexpr size_t WS_WGATE = 12 * MiB;
constexpr size_t WS_WBR = 28 * MiB;
constexpr size_t WS_WOUT = 32 * MiB;
constexpr size_t WS_WSC = 36 * MiB;
constexpr size_t WS_SU = WS_CONST + 256 * 1024, WS_SV = WS_CONST + 512 * 1024;
constexpr size_t WS_UBF = 44 * MiB;
constexpr size_t WS_VBF = 108 * MiB;
constexpr size_t WS_H8 = WS_UBF + 32 * MiB;
constexpr size_t WS_W8IN = WS_VBF + 32 * MiB, WS_W8GATE = WS_VBF + 40 * MiB, WS_W8OUT = WS_VBF + 48 * MiB, WS_W8S = WS_VBF + 50 * MiB;
constexpr size_t WS_SWS = WS_CONST + 640 * 1024;
constexpr size_t WS_XB2 = WS_WOUT, WS_SXG = WS_WOUT + 1 * MiB;
constexpr size_t WS_X = 172 * MiB;
constexpr size_t WS_H = 237 * MiB;
constexpr size_t WS_YS = 270 * MiB;
constexpr size_t WS_R1 = 303 * MiB;
constexpr size_t WS_Q = WS_R1, WS_K = WS_Q + (size_t)20 * MT * 128, WS_V = WS_K + (size_t)12 * MT * 128;
constexpr size_t WS_END = 433 * MiB;
constexpr size_t WS_DBG = 433 * MiB;
static_assert(WS_V + (size_t)12 * MT * 128 <= WS_END && WS_R1 + (size_t)MT * 4096 * 2 <= WS_END && WS_R1 + (size_t)MT * 2048 * 4 <= WS_END, "ws map");
constexpr int CW_BAR = 4096;
constexpr int CW_CHK = 64;

constexpr int RING_BYTES = 131072;
constexpr int LDSCTL_OFF = RING_BYTES, MISC_OFF = LDSCTL_OFF + 320;
constexpr int LDS_BYTES = 147456;

#define GAS __attribute__((address_space(1)))
#define LAS __attribute__((address_space(3)))
typedef unsigned short bf16_t;
typedef unsigned v4u __attribute__((ext_vector_type(4)));
typedef unsigned v2u __attribute__((ext_vector_type(2)));
typedef float f32x4 __attribute__((ext_vector_type(4)));
typedef float f32x2 __attribute__((ext_vector_type(2)));
typedef float f32x16 __attribute__((ext_vector_type(16)));
typedef short bf16x8 __attribute__((ext_vector_type(8)));
typedef short s16x4 __attribute__((ext_vector_type(4)));
typedef __bf16 bf16x2_t __attribute__((ext_vector_type(2)));
typedef int i32x8 __attribute__((ext_vector_type(8)));
typedef int i32x4 __attribute__((ext_vector_type(4)));
typedef GAS unsigned gu32;
#define RLX_AGENT __ATOMIC_RELAXED, __HIP_MEMORY_SCOPE_AGENT
#define LDS_WAIT() asm volatile("s_waitcnt lgkmcnt(0)" ::: "memory")
#define VM_WAIT() asm volatile("s_waitcnt vmcnt(0)" ::: "memory")

__device__ __forceinline__ int lane_now() { int l; asm volatile("v_mbcnt_lo_u32_b32 %0, -1, 0\n\tv_mbcnt_hi_u32_b32 %0, -1, %0" : "=v"(l)); return l; }
__device__ __forceinline__ int tid_now(int wave) { return (wave << 6) | lane_now(); }
__device__ __forceinline__ unsigned f2bf(float f) { unsigned u = __builtin_bit_cast(unsigned, f); return (u + 0x7fffu + ((u >> 16) & 1u)) >> 16; }
__device__ __forceinline__ unsigned pk2(float lo, float hi) { f32x2 v = {lo, hi}; bf16x2_t b = __builtin_convertvector(v, bf16x2_t); return __builtin_bit_cast(unsigned, b); }
__device__ __forceinline__ unsigned pk4_fp8(float a, float b, float c, float d) { int w = 0; w = __builtin_amdgcn_cvt_pk_fp8_f32(a, b, w, false); w = __builtin_amdgcn_cvt_pk_fp8_f32(c, d, w, true); return (unsigned)w; }
__device__ __forceinline__ float bflo(unsigned w) { return __builtin_bit_cast(float, w << 16); }
__device__ __forceinline__ float bfhi(unsigned w) { return __builtin_bit_cast(float, w & 0xffff0000u); }
__device__ __forceinline__ float bf2f(bf16_t h) { return __builtin_bit_cast(float, (unsigned)h << 16); }
template <int X> __device__ __forceinline__ float xorf(float v) { return __builtin_bit_cast(float, __builtin_amdgcn_ds_swizzle(__builtin_bit_cast(int, v), (X << 10) | 0x1f)); }
__device__ __forceinline__ float x32_sum(float v) { auto r = __builtin_amdgcn_permlane32_swap(__float_as_uint(v), __float_as_uint(v), false, false); return __uint_as_float(r[0]) + __uint_as_float(r[1]); }
__device__ __forceinline__ float x32_max(float v) { auto r = __builtin_amdgcn_permlane32_swap(__float_as_uint(v), __float_as_uint(v), false, false); return __builtin_fmaxf(__uint_as_float(r[0]), __uint_as_float(r[1])); }
__device__ __forceinline__ float wave_sum(float v) { v += xorf<1>(v); v += xorf<2>(v); v += xorf<4>(v); v += xorf<8>(v); v += xorf<16>(v); return x32_sum(v); }
__device__ __forceinline__ float wave_max(float v) { v = __builtin_fmaxf(v, xorf<1>(v)); v = __builtin_fmaxf(v, xorf<2>(v)); v = __builtin_fmaxf(v, xorf<4>(v)); v = __builtin_fmaxf(v, xorf<8>(v)); v = __builtin_fmaxf(v, xorf<16>(v)); return x32_max(v); }
__device__ __forceinline__ float fast_exp2(float x) { return __builtin_amdgcn_exp2f(x); }
__device__ __forceinline__ float fast_rcp(float x) { return __builtin_amdgcn_rcpf(x); }
__device__ __forceinline__ float sigmoidf_(float x) { return fast_rcp(1.0f + fast_exp2(-x * LOG2E)); }
__device__ __forceinline__ float gelu_tanh(float x) {
    const float y = 0.7978845608028654f * (x + 0.044715f * x * x * x);
    const float t = 1.0f - 2.0f * fast_rcp(1.0f + fast_exp2(2.0f * LOG2E * y));
    return 0.5f * x * (1.0f + t);
}
#define XB_TMO      128
#define XB_XCNT(j)  (256  + 64 * (j))
#define XB_XSUB(j)  (1280 + 64 * (j))
#define XB_XGEN(j)  (2304 + 64 * (j))
#define XB_TOP      3328
#define XB_TOPGEN   3392
#define XCD_BAR_WORDS 3456
#define XB_SPIN_CAP (1u << 20)
__device__ __forceinline__ unsigned xb_ld(unsigned* p)              { return __hip_atomic_load(p, __ATOMIC_RELAXED, __HIP_MEMORY_SCOPE_AGENT); }
__device__ __forceinline__ unsigned xb_add(unsigned* p, unsigned v) { return __hip_atomic_fetch_add(p, v, __ATOMIC_RELAXED, __HIP_MEMORY_SCOPE_AGENT); }
__device__ __forceinline__ unsigned xb_xcc_id() { return (unsigned)__builtin_amdgcn_s_getreg((3 << 11) | 20) & 0xFu; }
#define XB_SPIN(cond, bar) do { unsigned _sp = 0; while (cond) { __builtin_amdgcn_s_sleep(1); \
    if ((++_sp & 255u) == 0u) { if (xb_ld(&(bar)[XB_TMO])) break; if (_sp > XB_SPIN_CAP) { atomicAdd(&(bar)[XB_TMO], 1u); break; } } } } while (0)
struct XcdBarrier { unsigned* bar; unsigned x; volatile LAS unsigned* st; int wave; };
__device__ __forceinline__ XcdBarrier xcd_barrier_post(unsigned* bar, volatile LAS unsigned* st, int wave) {
    XcdBarrier b; b.bar = bar; b.x = xb_xcc_id(); b.st = st; b.wave = wave;
    if (tid_now(wave) == 0) (void)xb_add(&bar[XB_XCNT(b.x)], 1u);
    return b;
}
__device__ __forceinline__ void xcd_barrier_complete(unsigned* bar, unsigned x, unsigned& nloc, unsigned& nx) {
    const unsigned G = gridDim.x * gridDim.y * gridDim.z;
    unsigned sum, cnt, mine, sp = 0u;
    for (;;) {
        sum = 0u; cnt = 0u; mine = 0u;
#pragma unroll
        for (unsigned j = 0; j < 16; ++j) { const unsigned c = xb_ld(&bar[XB_XCNT(j)]); sum += c; cnt += (c > 0u) ? 1u : 0u; mine = (j == x) ? c : mine; }
        if (sum == G) break;
        __builtin_amdgcn_s_sleep(1);
        if ((++sp & 255u) == 0u) { if (xb_ld(&bar[XB_TMO])) break; if (sp > XB_SPIN_CAP) { atomicAdd(&bar[XB_TMO], 1u); break; } }
    }
    nloc = mine > 0u ? mine : 1u; nx = cnt > 0u ? cnt : 1u;
}
__device__ __forceinline__ void xcd_barrier(const XcdBarrier& b) {
    asm volatile("s_waitcnt vmcnt(0)" ::: "memory");
    __syncthreads();
    unsigned* bar_ = b.bar; unsigned bx_ = b.x; asm volatile("" : "+s"(bar_), "+s"(bx_));
    if (tid_now(b.wave) == 0) {
        unsigned* bar = bar_; const unsigned bx = bx_;
        __builtin_amdgcn_s_waitcnt(0);
        unsigned nloc = b.st[0], nx = b.st[1];
        if (nloc == 0u) { xcd_barrier_complete(bar, bx, nloc, nx); b.st[0] = nloc; b.st[1] = nx; }
        const unsigned old = xb_add(&bar[XB_XSUB(bx)], 1u);
        const unsigned gen = old / nloc;
        if (old + 1u == (gen + 1u) * nloc) {
            __builtin_amdgcn_fence(__ATOMIC_RELEASE, "agent");
            asm volatile("s_waitcnt vmcnt(0)" ::: "memory");
            const unsigned og = xb_add(&bar[XB_TOP], 1u);
            const unsigned tg = og / nx;
            if (og + 1u == (tg + 1u) * nx) xb_add(&bar[XB_TOPGEN], 1u);
            else XB_SPIN(xb_ld(&bar[XB_TOPGEN]) == tg, bar);
            __builtin_amdgcn_fence(__ATOMIC_ACQUIRE, "agent");
            xb_add(&bar[XB_XGEN(bx)], 1u);
            asm volatile("s_waitcnt vmcnt(0)" ::: "memory");
        } else {
            XB_SPIN(xb_ld(&bar[XB_XGEN(bx)]) == gen, bar);
            __builtin_amdgcn_fence(__ATOMIC_ACQUIRE, "agent");
            asm volatile("s_waitcnt vmcnt(0)" ::: "memory");
        }
    }
    __syncthreads();
}

namespace pg8 {
#define PG8_LAS __attribute__((address_space(3)))
constexpr int BM = 256, BK = 64, HALF = 128, HTB = HALF * BK * 2, STAGE_BYTES = 8 * HTB, NXCD = 8, WGM = 8;
__host__ __device__ __forceinline__ int lds_byte(int r, int c) { const int st = (r >> 4) * 2 + (c >> 5), rr = r & 15, cc = c & 31, ob = rr * 64 + cc * 2; return st * 1024 + (ob ^ (((ob >> 9) & 1) << 5)); }
__host__ __device__ __forceinline__ void stage_rc(int b, int& R, int& C) { const int st = b / 1024, sb = b % 1024, swz = sb ^ (((sb >> 9) & 1) << 5); R = (st >> 1) * 16 + swz / 64; C = (st & 1) * 32 + (swz % 64) / 2; }
__host__ __device__ __forceinline__ int perm32(int rho) { const int n = rho >> 4, i = rho & 15; return 8 * (i >> 2) + 4 * n + (i & 3); }
__host__ __device__ __forceinline__ int wide_row(int R) { return 64 * (R >> 5) + 16 * ((R >> 2) & 3) + 4 * ((R >> 4) & 1) + (R & 3); }
template <class E, class = void> struct IsWide { static constexpr bool v = false; };
template <class E> struct IsWide<E, decltype((void)E::WIDE)> { static constexpr bool v = true; };

struct Unit { int pm, pn; const char* a; const char* b; };
struct Gemm { const void* A; const void* Bt; int nM, nN, K, lda, ldb, a_shift, a_pn_bytes, esz; };

struct StaticOrder {
    int nM, nN, nwg, G, c; const char* A; const char* B; size_t a_pm, b_pn; int a_shift, a_pn;
    __device__ void init(const Gemm& g, int G_, int c_) { nM = g.nM; nN = g.nN; nwg = nM * nN; G = G_; c = c_; A = (const char*)g.A; B = (const char*)g.Bt;
        a_pm = (size_t)BM * g.lda * g.esz; b_pn = (size_t)BM * g.ldb * g.esz; a_shift = g.a_shift; a_pn = g.a_pn_bytes; }
    __device__ bool has(int i) const { int cc = c; asm volatile("" : "+s"(cc)); return (long)i * G + cc < nwg; }
    __device__ bool next(int i, Unit& u) const {
        const long L = (long)i * G + c; if (L >= nwg) return false;
        int wgid = (int)L; { const int q = nwg / NXCD, r = nwg % NXCD, xcd = wgid % NXCD, off = wgid / NXCD; wgid = (xcd < r ? xcd * (q + 1) : r * (q + 1) + (xcd - r) * q) + off; }
        const int nig = WGM * nN, gid = wgid / nig, fm = gid * WGM, gsz = (nM - fm) < WGM ? (nM - fm) : WGM;
        u.pm = fm + ((wgid % nig) % gsz); u.pn = (wgid % nig) / gsz;
        u.a = A + (size_t)u.pm * a_pm + (size_t)(u.pn >> a_shift) * a_pn; u.b = B + (size_t)u.pn * b_pn; return true;
    }
};

template <class Epi, bool FP8 = false, int SCALE_ACT = 0x7F7F7F7F, bool I8 = false>
__device__ __forceinline__ void gemm_phase(PG8_LAS unsigned char* lds, const Gemm g, const StaticOrder& S, const Epi& E, int wave) {
    const int tid = tid_now(wave), wid = wave, lane = tid & 63, wr = wid >> 2, wc = wid & 3, fr = lane & 15, fq = lane >> 4;
    const int K = g.K, nt = (K * g.esz) / (BK * 2);
    unsigned voffA[2], voffB[2];
#pragma unroll
    for (int i = 0; i < 2; ++i) { int R, C; stage_rc(tid * 16 + i * 8192, R, C); const int Rb = IsWide<Epi>::v ? wide_row(R) : (Epi::PERM ? ((R & ~31) + perm32(R & 31)) : R);
        voffA[i] = (unsigned)(R * g.lda * g.esz + C * 2); voffB[i] = (unsigned)(Rb * g.ldb * g.esz + C * 2); }
    const size_t kstep = (size_t)(BK * 2);
    const size_t hstepA = (size_t)HALF * g.lda * g.esz, hstepB = (size_t)(IsWide<Epi>::v ? 8 : HALF) * g.ldb * g.esz;
    const unsigned ldsw = (unsigned)wid * 1024u, ldsbase = (unsigned)(uintptr_t)lds;
    const int aoff = FP8 ? lds_byte(wr * 64 + fr, fq * 16) : lds_byte(wr * 64 + fr, fq * 8), boff = FP8 ? lds_byte(wc * 32 + fr, fq * 16) : lds_byte(wc * 32 + fr, fq * 8);
#define PG8_SA(b, h) (((b) * 2 + (h)) * HTB)
#define PG8_SB(b, h) ((4 + (b) * 2 + (h)) * HTB)
#define PG8_GLDS(sbase, voff32, ldsdst) do { unsigned keep_; asm volatile("s_mov_b32 %0, m0\n\ts_mov_b32 m0, %3\n\ts_nop 0\n\tglobal_load_lds_dwordx4 %1, %2\n\ts_mov_b32 m0, %0" : "=&s"(keep_) : "v"(voff32), "s"(sbase), "s"(ldsdst) : "memory"); } while (0)
#define PG8_STAGE(bufoff, gbase, voff) do { _Pragma("unroll") for (int _i = 0; _i < 2; ++_i) \
        PG8_GLDS((const char*)(gbase), (voff)[_i], (unsigned)__builtin_amdgcn_readfirstlane((int)(ldsbase + (unsigned)(bufoff) + ldsw + _i * 8192))); } while (0)
#define PG8_LDA(dst, b, h) do { if constexpr (FP8) { _Pragma("unroll") for (int m = 0; m < 4; ++m) dst##8[m] = *(const PG8_LAS i32x8*)(lds + PG8_SA(b, h) + aoff + m * 2048); } \
        else { _Pragma("unroll") for (int m = 0; m < 4; ++m) _Pragma("unroll") for (int k = 0; k < 2; ++k) dst[m][k] = *(const PG8_LAS bf16x8*)(lds + PG8_SA(b, h) + aoff + m * 2048 + k * 1024); } } while (0)
#define PG8_LDB(dst, b, h) do { if constexpr (FP8) { _Pragma("unroll") for (int n = 0; n < 2; ++n) dst##8[n] = *(const PG8_LAS i32x8*)(lds + PG8_SB(b, h) + boff + n * 2048); } \
        else { _Pragma("unroll") for (int n = 0; n < 2; ++n) _Pragma("unroll") for (int k = 0; k < 2; ++k) dst[n][k] = *(const PG8_LAS bf16x8*)(lds + PG8_SB(b, h) + boff + n * 2048 + k * 1024); } } while (0)
#define PG8_MMA(ai, bj, At, Bt) do { __builtin_amdgcn_s_setprio(1); \
        if constexpr (FP8) { _Pragma("unroll") for (int m = 0; m < 4; ++m) _Pragma("unroll") for (int n = 0; n < 2; ++n) \
            acc[ai][bj][m][n] = __builtin_amdgcn_mfma_scale_f32_16x16x128_f8f6f4(Bt##8[n], At##8[m], acc[ai][bj][m][n], 0, 0, 0, 0x79797979, 0, SCALE_ACT); } \
        else if constexpr (I8) { _Pragma("unroll") for (int m = 0; m < 4; ++m) _Pragma("unroll") for (int n = 0; n < 2; ++n) _Pragma("unroll") for (int k = 0; k < 2; ++k) \
            acc[ai][bj][m][n] = __builtin_bit_cast(f32x4, __builtin_amdgcn_mfma_i32_16x16x64_i8(__builtin_bit_cast(i32x4, Bt[n][k]), __builtin_bit_cast(i32x4, At[m][k]), __builtin_bit_cast(i32x4, acc[ai][bj][m][n]), 0, 0, 0)); } \
        else { _Pragma("unroll") for (int m = 0; m < 4; ++m) _Pragma("unroll") for (int n = 0; n < 2; ++n) _Pragma("unroll") for (int k = 0; k < 2; ++k) \
            acc[ai][bj][m][n] = __builtin_amdgcn_mfma_f32_16x16x32_bf16(Bt[n][k], At[m][k], acc[ai][bj][m][n], 0, 0, 0); } \
        __builtin_amdgcn_s_setprio(0); } while (0)
#define PG8_WAIT_V(n) asm volatile("s_waitcnt vmcnt(" #n ")" ::: "memory")
#define PG8_WAIT_L(n) asm volatile("s_waitcnt lgkmcnt(" #n ")" ::: "memory")
#define PG8_BAR __builtin_amdgcn_s_barrier()
#define PG8_SCHED __builtin_amdgcn_sched_barrier(0)
    Unit cur, nxt; int ui = 0;
    if (!S.has(0)) return;
    (void)S.next(0, cur);
    f32x4 acc[2][2][4][2];
#pragma unroll
    for (int a = 0; a < 2; ++a)
#pragma unroll
        for (int b = 0; b < 2; ++b)
#pragma unroll
            for (int m = 0; m < 4; ++m)
#pragma unroll
                for (int n = 0; n < 2; ++n) acc[a][b][m][n] = (f32x4){0.f, 0.f, 0.f, 0.f};
    bf16x8 At[4][2], B0[2][2], B1[2][2]; i32x8 At8[4], B08[2], B18[2];
    const char* cA = cur.a; const char* cB = cur.b;
    PG8_STAGE(PG8_SB(0, 0), cB, voffB); PG8_STAGE(PG8_SB(0, 1), cB + hstepB, voffB); PG8_STAGE(PG8_SA(0, 0), cA, voffA); PG8_STAGE(PG8_SA(0, 1), cA + hstepA, voffA);
    { int w_ = wave; asm volatile("" : "+s"(w_)); if ((w_ >> 2) == 1) PG8_BAR; }
    PG8_WAIT_V(2); PG8_BAR;
    PG8_STAGE(PG8_SB(1, 0), cB + kstep, voffB); PG8_STAGE(PG8_SA(1, 0), cA + kstep, voffA); PG8_STAGE(PG8_SB(1, 1), cB + hstepB + kstep, voffB);
    PG8_WAIT_V(6); PG8_BAR;
    for (;;) {
        const bool has_next = S.has(ui + 1); nxt = cur; if (has_next) (void)S.next(ui + 1, nxt);
        const char* nA = has_next ? nxt.a : cA; const char* nB = has_next ? nxt.b : cB;
        for (int t = 0; t < nt; t += 2) {
            const bool last = (t == nt - 2);
            const char* a1 = cA + (size_t)(t + 1) * kstep;
            const char* a2 = last ? nA : cA + (size_t)(t + 2) * kstep; const char* b2 = last ? nB : cB + (size_t)(t + 2) * kstep;
            const char* a3 = a2 + kstep; const char* b3 = b2 + kstep;
            PG8_LDB(B0, 0, 0); PG8_LDB(B1, 0, 1); PG8_SCHED; PG8_LDA(At, 0, 0); PG8_STAGE(PG8_SA(1, 1), a1 + hstepA, voffA);
            PG8_WAIT_V(8); PG8_WAIT_L(0); PG8_BAR; PG8_MMA(0, 0, At, B0); PG8_MMA(0, 1, At, B1); PG8_BAR; PG8_SCHED;
            PG8_LDA(At, 0, 1); PG8_STAGE(PG8_SB(0, 0), b2, voffB); PG8_STAGE(PG8_SB(0, 1), b2 + hstepB, voffB); PG8_STAGE(PG8_SA(0, 0), a2, voffA);
            PG8_WAIT_V(8); PG8_WAIT_L(0); PG8_BAR; PG8_MMA(1, 0, At, B0); PG8_MMA(1, 1, At, B1); PG8_BAR; PG8_SCHED;
            PG8_LDB(B0, 1, 0); PG8_LDB(B1, 1, 1); PG8_SCHED; PG8_LDA(At, 1, 0); PG8_STAGE(PG8_SA(0, 1), a2 + hstepA, voffA);
            PG8_WAIT_V(8); PG8_WAIT_L(0); PG8_BAR; PG8_MMA(0, 0, At, B0); PG8_MMA(0, 1, At, B1); PG8_BAR; PG8_SCHED;
            PG8_LDA(At, 1, 1); PG8_STAGE(PG8_SB(1, 0), b3, voffB); PG8_STAGE(PG8_SB(1, 1), b3 + hstepB, voffB); PG8_STAGE(PG8_SA(1, 0), a3, voffA);
            PG8_WAIT_V(8); PG8_WAIT_L(0); PG8_BAR; PG8_MMA(1, 0, At, B0); PG8_MMA(1, 1, At, B1); PG8_BAR; PG8_SCHED;
        }
        { int w2_ = wave; asm volatile("" : "+s"(w2_));
          if ((w2_ >> 2) == 0) PG8_BAR;
          E(acc, cur, w2_ >> 2, w2_ & 3, 0, 0); }
        if (!S.has(ui + 1)) break;
#pragma unroll
        for (int a = 0; a < 2; ++a)
#pragma unroll
            for (int b = 0; b < 2; ++b)
#pragma unroll
                for (int m = 0; m < 4; ++m)
#pragma unroll
                    for (int n = 0; n < 2; ++n) acc[a][b][m][n] = (f32x4){0.f, 0.f, 0.f, 0.f};
        cur = nxt; cA = nA; cB = nB; ++ui;
        { int w_ = wave; asm volatile("" : "+s"(w_)); if ((w_ >> 2) == 1) PG8_BAR; }
    }
    PG8_WAIT_V(0);
    PG8_BAR;
#undef PG8_SA
#undef PG8_SB
#undef PG8_STAGE
#undef PG8_LDA
#undef PG8_LDB
#undef PG8_MMA
#undef PG8_WAIT_V
#undef PG8_WAIT_L
#undef PG8_BAR
#undef PG8_SCHED
}
}
namespace pg8 {
struct EpiQKV {
    static constexpr bool PERM = true;
    bf16_t *Qb, *Kb, *Vb; const float* qkw;
    __device__ __forceinline__ void operator()(const f32x4 (&acc)[2][2][4][2], const Unit& u, int wr, int wc, int, int) const {
        const int t_ = lane_now(); const int fr = t_ & 15, fq = (t_ >> 4) & 3;
        const int hs = __builtin_amdgcn_readfirstlane(u.pn * 4 + wc);
        bf16_t* dst; int rope = 0, norm = -1, dq = 0; float scale = 1.f;
        if (hs < 4)       { dst = Qb + (size_t)hs * MT * 64; scale = C2_64; }
        else if (hs < 8)  { dst = Kb + (size_t)(hs - 4) * MT * 64; }
        else if (hs < 12) { dst = Vb + (size_t)(hs - 8) * MT * 64; }
        else if (hs < 16) { dst = Qb + (size_t)(4 + 2 * (hs - 12)) * MT * 64; rope = 2; dq = 1; scale = C2_32; }
        else if (hs < 20) { dst = Kb + (size_t)(4 + hs - 16) * MT * 64; rope = 2; }
        else if (hs < 24) { dst = Vb + (size_t)(4 + hs - 20) * MT * 64; }
        else if (hs < 28) { dst = Qb + (size_t)(12 + hs - 24) * MT * 64; rope = 1; scale = C2_64; }
        else if (hs < 30) { dst = Kb + (size_t)(8 + hs - 28) * MT * 64; rope = 1; }
        else if (hs < 32) { dst = Vb + (size_t)(8 + hs - 30) * MT * 64; }
        else if (hs < 36) { dst = Qb + (size_t)(16 + hs - 32) * MT * 64; rope = 1; norm = 0; scale = C2_64; }
        else if (hs < 38) { dst = Kb + (size_t)(10 + hs - 36) * MT * 64; rope = 1; norm = 1; }
        else              { dst = Vb + (size_t)(10 + hs - 38) * MT * 64; }
        const bool latent = u.pm < SEQ / 256;
        if (!latent) rope = 0;
        float fstep = (rope == 2) ? (13.287712379549449f / 8.f) : (13.287712379549449f / 16.f); asm volatile("" : "+v"(fstep));
        const float fbase = (rope == 2) ? 0.f : (float)(8 * (fq & 1)) * fstep;
#define INVF(k) (fast_exp2(-(fbase + (float)(k) * fstep)) * 0.15915494309189535f)
#pragma unroll
        for (int m = 0; m < 4; ++m) {
            float csn[8], ccs[8];
            if (rope == 1) { float pos = (float)(m * 16 + fr); asm volatile("" : "+v"(pos));
#pragma unroll
                for (int k = 0; k < 8; ++k) { const float rev = pos * INVF(k); csn[k] = __builtin_amdgcn_sinf(rev); ccs[k] = __builtin_amdgcn_cosf(rev); } }
#pragma unroll
            for (int ai = 0; ai < 2; ++ai) {
                const int row = u.pm * BM + ai * HALF + wr * 64 + m * 16 + fr;
                float v[16];
#pragma unroll
                for (int bj = 0; bj < 2; ++bj)
#pragma unroll
                    for (int n = 0; n < 2; ++n)
#pragma unroll
                        for (int j = 0; j < 4; ++j) v[bj * 8 + n * 4 + j] = acc[ai][bj][m][n][j];
                if (norm >= 0) {
                    float ss = 0.f;
#pragma unroll
                    for (int k = 0; k < 16; ++k) ss += v[k] * v[k];
                    ss += xorf<16>(ss); ss = x32_sum(ss);
                    const float ri = __builtin_amdgcn_rsqf(ss * (1.f / 64.f) + EPS);
#pragma unroll
                    for (int bj = 0; bj < 2; ++bj) { const f32x4 w0 = *(const f32x4*)(qkw + norm * 64 + 32 * bj + 8 * fq), w1 = *(const f32x4*)(qkw + norm * 64 + 32 * bj + 8 * fq + 4);
#pragma unroll
                        for (int j = 0; j < 4; ++j) { v[bj * 8 + j] = v[bj * 8 + j] * ri * w0[j]; v[bj * 8 + 4 + j] = v[bj * 8 + 4 + j] * ri * w1[j]; } }
                }
                if (rope == 1) {
                    const float sgn = (fq & 2) ? 1.f : -1.f;
                    float pos = (float)(row >> 6); asm volatile("" : "+v"(pos));
#pragma unroll
                    for (int k = 0; k < 8; ++k) {
                        const float rev = pos * INVF(k); const float sn = __builtin_amdgcn_sinf(rev), cs = __builtin_amdgcn_cosf(rev);
                        const float x = v[k]; auto rx = __builtin_amdgcn_permlane32_swap(__float_as_uint(x), __float_as_uint(x), false, false);
                        const float pt = __uint_as_float((fq & 2) ? rx[0] : rx[1]);
                        v[k] = x * cs + sgn * pt * sn;
                        const float y = v[8 + k]; auto ry = __builtin_amdgcn_permlane32_swap(__float_as_uint(y), __float_as_uint(y), false, false);
                        const float qt = __uint_as_float((fq & 2) ? ry[0] : ry[1]);
                        v[8 + k] = y * ccs[k] + sgn * qt * csn[k];
                    }
                } else if (rope == 2) {
                    const float sgn = (fq & 1) ? 1.f : -1.f;
                    float pos = (float)(fq < 2 ? (row >> 6) : (row & 63)); asm volatile("" : "+v"(pos));
#pragma unroll
                    for (int k = 0; k < 8; ++k) {
                        const float rev = pos * INVF(k); const float sn = __builtin_amdgcn_sinf(rev), cs = __builtin_amdgcn_cosf(rev);
#pragma unroll
                        for (int bj = 0; bj < 2; ++bj) { const float x = v[bj * 8 + k], pt = xorf<16>(x); v[bj * 8 + k] = x * cs + sgn * pt * sn; }
                    }
                }
#pragma unroll
                for (int bj = 0; bj < 2; ++bj) {
                    v4u w; w.x = pk2(v[bj * 8 + 0] * scale, v[bj * 8 + 1] * scale); w.y = pk2(v[bj * 8 + 2] * scale, v[bj * 8 + 3] * scale);
                    w.z = pk2(v[bj * 8 + 4] * scale, v[bj * 8 + 5] * scale); w.w = pk2(v[bj * 8 + 6] * scale, v[bj * 8 + 7] * scale);
                    if (dq) {
                        *(v4u*)(dst + (size_t)bj * MT * 64 + (size_t)row * 64 + 32 * bj + 8 * fq) = w;
                        unsigned z0 = 0u; asm volatile("" : "+v"(z0));
                        *(v4u*)(dst + (size_t)(1 - bj) * MT * 64 + (size_t)row * 64 + 32 * bj + 8 * fq) = (v4u){z0, z0, z0, z0};
                    } else *(v4u*)(dst + (size_t)row * 64 + 32 * bj + 8 * fq) = w;
                }
                __builtin_amdgcn_sched_barrier(0);
            }
        }
#undef INVF
    }
};
struct EpiBranch {
    static constexpr bool PERM = true;
    bf16_t* Bp;
    __device__ __forceinline__ void operator()(const f32x4 (&acc)[2][2][4][2], const Unit& u, int wr, int wc, int, int) const {
        const int t_ = lane_now(); const int fr = t_ & 15, fq = (t_ >> 4) & 3;
        const int branch = u.pn >> 2, chb = 256 * (u.pn & 3) + 32 * wc + 8 * fq;
#pragma unroll
        for (int ai = 0; ai < 2; ++ai)
#pragma unroll
            for (int m = 0; m < 4; ++m) { bf16_t* rowp = Bp + (size_t)(u.pm * BM + ai * HALF + wr * 64 + m * 16 + fr) * 4096 + branch * 1024 + chb;
#pragma unroll
                for (int bj = 0; bj < 2; ++bj) { const f32x4 a = acc[ai][bj][m][0], c = acc[ai][bj][m][1];
                    v4u w; w.x = pk2(a[0], a[1]); w.y = pk2(a[2], a[3]); w.z = pk2(c[0], c[1]); w.w = pk2(c[2], c[3]); *(v4u*)(rowp + 128 * bj) = w; } }
    }
};
#ifndef BP8
#define BP8 1
#endif
#ifndef MIX8
#define MIX8 1
#endif
#if MIX8 && !BP8
#error MIX8 needs BP8
#endif
constexpr float BP8_SCALE = 32.f;
struct EpiBranch8 {
    static constexpr bool PERM = false, WIDE = true;
    unsigned char* Bp;
    __device__ __forceinline__ void operator()(const f32x4 (&acc)[2][2][4][2], const Unit& u, int wr, int wc, int, int) const {
        const int t_ = lane_now(); const int fr = t_ & 15, fq = (t_ >> 4) & 3;
        const int branch = u.pn >> 2, off = (4 * (u.pn & 3) + wc) * 256 + branch * 64 + 16 * fq;
#pragma unroll
        for (int ai = 0; ai < 2; ++ai)
#pragma unroll
            for (int m = 0; m < 4; ++m) { unsigned char* rowp = Bp + (size_t)(u.pm * BM + ai * HALF + wr * 64 + m * 16 + fr) * 4096 + off;
                v4u w;
#pragma unroll
                for (int bj = 0; bj < 2; ++bj) { const f32x4 a = acc[ai][bj][m][0] * BP8_SCALE, c = acc[ai][bj][m][1] * BP8_SCALE;
                    w[2 * bj] = pk4_fp8(a[0], a[1], a[2], a[3]); w[2 * bj + 1] = pk4_fp8(c[0], c[1], c[2], c[3]); }
                *(v4u*)rowp = w; }
    }
};
struct EpiGate {
    static constexpr bool PERM = false;
    const bf16_t* Bp; bf16_t* mix; const float* bgate;
    __device__ __forceinline__ void operator()(const f32x4 (&acc)[2][2][4][2], const Unit& u, int wr, int wc, int, int) const {
        const int t_ = lane_now(); const int fr = t_ & 15, fq = (t_ >> 4) & 3;
        const int ch = 64 * u.pn + 16 * wc + 4 * fq;
        f32x4 bias[2][2];
#pragma unroll
        for (int bj = 0; bj < 2; ++bj)
#pragma unroll
            for (int n = 0; n < 2; ++n) bias[bj][n] = *(const f32x4*)(bgate + (2 * bj + n) * 1024 + ch);
#if BP8
        unsigned b8a[2][4][4];
#pragma unroll
        for (int ai = 0; ai < 2; ++ai)
#pragma unroll
            for (int m = 0; m < 4; ++m) { const size_t row = (size_t)(u.pm * BM + ai * HALF + wr * 64 + m * 16 + fr);
#pragma unroll
                for (int b = 0; b < 4; ++b) b8a[ai][m][b] = *(const unsigned*)((const unsigned char*)Bp + row * 4096 + u.pn * 256 + b * 64 + 16 * wc + 4 * fq); }
#endif
#pragma unroll
        for (int ai = 0; ai < 2; ++ai)
#pragma unroll
            for (int m = 0; m < 4; ++m) { const size_t row = (size_t)(u.pm * BM + ai * HALF + wr * 64 + m * 16 + fr);
                f32x4 s = {0.f, 0.f, 0.f, 0.f};
#if BP8
#pragma unroll
                for (int bj = 0; bj < 2; ++bj)
#pragma unroll
                    for (int n = 0; n < 2; ++n) { const f32x4 a = acc[ai][bj][m][n] + bias[bj][n]; const int w = (int)b8a[ai][m][2 * bj + n];
                        const f32x2 lo = __builtin_amdgcn_cvt_pk_f32_fp8(w, false), hi = __builtin_amdgcn_cvt_pk_f32_fp8(w, true);
                        s[0] += sigmoidf_(a[0]) * lo.x; s[1] += sigmoidf_(a[1]) * lo.y; s[2] += sigmoidf_(a[2]) * hi.x; s[3] += sigmoidf_(a[3]) * hi.y; }
#if !MIX8
                s = s * (1.f / BP8_SCALE);
#endif
#else
                v2u bb[4];
#pragma unroll
                for (int b = 0; b < 4; ++b) bb[b] = *(const v2u*)(Bp + row * 4096 + b * 1024 + ch);
#pragma unroll
                for (int bj = 0; bj < 2; ++bj)
#pragma unroll
                    for (int n = 0; n < 2; ++n) { const f32x4 a = acc[ai][bj][m][n] + bias[bj][n]; const unsigned w0 = bb[2 * bj + n].x, w1 = bb[2 * bj + n].y;
                        s[0] += sigmoidf_(a[0]) * bflo(w0); s[1] += sigmoidf_(a[1]) * bfhi(w0); s[2] += sigmoidf_(a[2]) * bflo(w1); s[3] += sigmoidf_(a[3]) * bfhi(w1); }
#endif
#if MIX8
                *(unsigned*)((unsigned char*)mix + row * 1024 + ch) = pk4_fp8(s[0], s[1], s[2], s[3]); }
#else
                v2u w; w.x = pk2(s[0], s[1]); w.y = pk2(s[2], s[3]); *(v2u*)(mix + row * 1024 + ch) = w; }
#endif
    }
};
struct EpiOut {
    static constexpr bool PERM = false;
    const float* xl; const float* xc; float* X; const float* gl; const float* gc;
    __device__ __forceinline__ void operator()(const f32x4 (&acc)[2][2][4][2], const Unit& u, int wr, int wc, int, int) const {
        const int t_ = lane_now(); const int fr = t_ & 15, fq = (t_ >> 4) & 3;
        const bool latent = u.pm < SEQ / 256; const float* gv = latent ? gl : gc; const float* xo = latent ? xl : xc - (size_t)SEQ * DM;
        const int col0 = u.pn * BM + wc * 32 + 4 * fq;
        f32x4 g[2][2];
#pragma unroll
        for (int bj = 0; bj < 2; ++bj)
#pragma unroll
            for (int n = 0; n < 2; ++n) g[bj][n] = *(const f32x4*)(gv + col0 + bj * HALF + n * 16);
#pragma unroll
        for (int ai = 0; ai < 2; ++ai)
#pragma unroll
            for (int m = 0; m < 4; ++m) { const size_t off = (size_t)(u.pm * BM + ai * HALF + wr * 64 + m * 16 + fr) * DM + col0;
#pragma unroll
                for (int bj = 0; bj < 2; ++bj)
#pragma unroll
                    for (int n = 0; n < 2; ++n) { const f32x4 o = *(const f32x4*)(xo + off + bj * HALF + n * 16); *(f32x4*)(X + off + bj * HALF + n * 16) = o + g[bj][n] * acc[ai][bj][m][n]; } }
    }
};
struct EpiOutNorm {
    static constexpr bool PERM = true;
    const float* xl; const float* xc; float* X; const float* gl; const float* gc;
    bf16_t* H; const float* nw; const float* ml; const float* mc;
    gu32* xbuf; gu32* cnt; gu32* tmo; LAS unsigned char* tl;
    gu32* xbuf2; gu32* cnt2; unsigned char* XQ; float* SXG;
    __device__ __forceinline__ void operator()(f32x4 (&acc)[2][2][4][2], const Unit& u, int wr, int wc, int, int) const {
        const int t_ = lane_now(); const int fr = t_ & 15, fq = (t_ >> 4) & 3;
        const bool latent = u.pm < SEQ / 256; const float* gv = latent ? gl : gc; const float* xo = latent ? xl : xc - (size_t)SEQ * DM;
        const int col0 = u.pn * BM + wc * 32 + 8 * fq;
        LAS float* P = (LAS float*)tl; LAS float* Sr = (LAS float*)(tl + 4096); volatile LAS unsigned* flag = (volatile LAS unsigned*)(tl + 5120);
        {
            f32x4 g[2][2];
#pragma unroll
            for (int bj = 0; bj < 2; ++bj)
#pragma unroll
                for (int n = 0; n < 2; ++n) g[bj][n] = *(const f32x4*)(gv + col0 + bj * HALF + n * 4);
            f32x4 xo_c[2][2], xo_n[2][2];
#define EON_LOAD(dst, it_) do { const int r_ = ((it_) >> 2) * HALF + wr * 64 + ((it_) & 3) * 16 + fr; const size_t off_ = (size_t)(u.pm * BM + r_) * DM + col0; \
            _Pragma("unroll") for (int bj = 0; bj < 2; ++bj) _Pragma("unroll") for (int n = 0; n < 2; ++n) dst[bj][n] = *(const f32x4*)(xo + off_ + bj * HALF + n * 4); } while (0)
            EON_LOAD(xo_c, 0);
#pragma unroll
            for (int it = 0; it < 8; ++it) { const int ai = it >> 2, m = it & 3;
                if (it < 7) EON_LOAD(xo_n, it + 1);
                const int r = ai * HALF + wr * 64 + m * 16 + fr; const size_t off = (size_t)(u.pm * BM + r) * DM + col0; float s = 0.f;
#pragma unroll
                for (int bj = 0; bj < 2; ++bj)
#pragma unroll
                    for (int n = 0; n < 2; ++n) { const f32x4 y = xo_c[bj][n] + g[bj][n] * acc[ai][bj][m][n];
                        *(f32x4*)(X + off + bj * HALF + n * 4) = y; acc[ai][bj][m][n] = y; s += (y.x * y.x + y.y * y.y) + (y.z * y.z + y.w * y.w); }
                s += xorf<16>(s); s = x32_sum(s);
                if (fq == 0) P[r * 4 + wc] = s;
#pragma unroll
                for (int bj = 0; bj < 2; ++bj)
#pragma unroll
                    for (int n = 0; n < 2; ++n) xo_c[bj][n] = xo_n[bj][n]; }
#undef EON_LOAD
        }
        asm volatile("s_waitcnt lgkmcnt(0)" ::: "memory"); __builtin_amdgcn_s_barrier(); asm volatile("" ::: "memory");
        const int wid = wr * 4 + wc, row = wid * 32 + (t_ & 31);
        if (t_ < 32) { const float tp = (P[row * 4 + 0] + P[row * 4 + 1]) + (P[row * 4 + 2] + P[row * 4 + 3]);
            __hip_atomic_store(xbuf + ((size_t)(u.pm * BM + row) * 4 + u.pn), __float_as_uint(tp), RLX_AGENT); }
        asm volatile("s_waitcnt vmcnt(0)" ::: "memory");
        if (t_ == 0) (void)__hip_atomic_fetch_add(cnt + 64 * u.pm, 1u, RLX_AGENT);
        if (wid == 0) {
            unsigned sp = 0u, dead = 0u;
            while ((unsigned)__builtin_amdgcn_readfirstlane((int)__hip_atomic_load(cnt + 64 * u.pm, RLX_AGENT)) < 32u) {
                __builtin_amdgcn_s_sleep(2);
                if ((++sp & 255u) == 0u) { if (__builtin_amdgcn_readfirstlane((int)__hip_atomic_load(tmo, RLX_AGENT)) != 0) { dead = 1u; break; }
                    if (sp > (1u << 22)) { if (t_ == 0) __hip_atomic_store(tmo, 1u, RLX_AGENT); dead = 1u; break; } } }
            __builtin_amdgcn_fence(__ATOMIC_ACQUIRE, "agent");
            if (t_ == 0) flag[0] = dead;
        }
        asm volatile("s_waitcnt vmcnt(0) lgkmcnt(0)" ::: "memory"); __builtin_amdgcn_s_barrier(); asm volatile("" ::: "memory");
        if (t_ < 32) { const gu32* sl = xbuf + (size_t)(u.pm * BM + row) * 4; float tot = 0.f;
#pragma unroll
            for (int q = 0; q < 4; ++q) tot += __uint_as_float(__hip_atomic_load(sl + q, RLX_AGENT));
            Sr[row] = __builtin_amdgcn_rsqf(tot * (1.f / DM) + EPS); }
        asm volatile("s_waitcnt vmcnt(0) lgkmcnt(0)" ::: "memory"); __builtin_amdgcn_s_barrier(); asm volatile("" ::: "memory");
        const float* mv = latent ? ml : mc;
        f32x4 wa[2][2], bb[2][2];
#pragma unroll
        for (int bj = 0; bj < 2; ++bj)
#pragma unroll
            for (int n = 0; n < 2; ++n) { const int col = col0 + bj * HALF + 4 * n; const f32x4 w = *(const f32x4*)(nw + col), a = *(const f32x4*)(mv + 4096 + col); bb[bj][n] = *(const f32x4*)(mv + 3072 + col); wa[bj][n] = w * (1.0f + a); }
#pragma unroll
        for (int ai = 0; ai < 2; ++ai)
#pragma unroll
            for (int m = 0; m < 4; ++m) { const int r = ai * HALF + wr * 64 + m * 16 + fr; const float ri = Sr[r]; float mx = 0.f;
#pragma unroll
                for (int bj = 0; bj < 2; ++bj)
#pragma unroll
                    for (int n = 0; n < 2; ++n) { const f32x4 y = (acc[ai][bj][m][n] * ri) * wa[bj][n] + bb[bj][n]; acc[ai][bj][m][n] = y;
                        mx = __builtin_fmaxf(mx, __builtin_fmaxf(__builtin_fmaxf(__builtin_fabsf(y.x), __builtin_fabsf(y.y)), __builtin_fmaxf(__builtin_fabsf(y.z), __builtin_fabsf(y.w)))); }
                mx = __builtin_fmaxf(mx, xorf<16>(mx)); mx = x32_max(mx);
                if (fq == 0) P[r * 4 + wc] = mx; }
        asm volatile("s_waitcnt lgkmcnt(0)" ::: "memory"); __builtin_amdgcn_s_barrier(); asm volatile("" ::: "memory");
        if (t_ < 32) { const float tp = __builtin_fmaxf(__builtin_fmaxf(P[row * 4 + 0], P[row * 4 + 1]), __builtin_fmaxf(P[row * 4 + 2], P[row * 4 + 3]));
            __hip_atomic_store(xbuf2 + ((size_t)(u.pm * BM + row) * 4 + u.pn), __float_as_uint(tp), RLX_AGENT); }
        asm volatile("s_waitcnt vmcnt(0)" ::: "memory");
        if (t_ == 0) (void)__hip_atomic_fetch_add(cnt2 + 64 * u.pm, 1u, RLX_AGENT);
        if (wid == 0) {
            unsigned sp = 0u, dead = 0u;
            while ((unsigned)__builtin_amdgcn_readfirstlane((int)__hip_atomic_load(cnt2 + 64 * u.pm, RLX_AGENT)) < 32u) {
                __builtin_amdgcn_s_sleep(2);
                if ((++sp & 255u) == 0u) { if (__builtin_amdgcn_readfirstlane((int)__hip_atomic_load(tmo, RLX_AGENT)) != 0) { dead = 1u; break; }
                    if (sp > (1u << 22)) { if (t_ == 0) __hip_atomic_store(tmo, 1u, RLX_AGENT); dead = 1u; break; } } }
            __builtin_amdgcn_fence(__ATOMIC_ACQUIRE, "agent");
            if (t_ == 0) flag[0] = dead;
        }
        asm volatile("s_waitcnt vmcnt(0) lgkmcnt(0)" ::: "memory"); __builtin_amdgcn_s_barrier(); asm volatile("" ::: "memory");
        if (t_ < 32) { const gu32* sl = xbuf2 + (size_t)(u.pm * BM + row) * 4; float am = 0.f;
#pragma unroll
            for (int q = 0; q < 4; ++q) am = __builtin_fmaxf(am, __uint_as_float(__hip_atomic_load(sl + q, RLX_AGENT)));
            Sr[row] = am > 0.f ? 127.f / am : 0.f;
            if (u.pn == 0) SXG[u.pm * BM + row] = am * (1.f / 127.f); }
        asm volatile("s_waitcnt vmcnt(0) lgkmcnt(0)" ::: "memory"); __builtin_amdgcn_s_barrier(); asm volatile("" ::: "memory");
#pragma unroll
        for (int ai = 0; ai < 2; ++ai)
#pragma unroll
            for (int m = 0; m < 4; ++m) { const int r = ai * HALF + wr * 64 + m * 16 + fr; const float ix = Sr[r];
#pragma unroll
                for (int bj = 0; bj < 2; ++bj) { v2u o;
#pragma unroll
                    for (int n = 0; n < 2; ++n) { const f32x4 y = acc[ai][bj][m][n] * ix;
                        const int q0 = (int)__builtin_rintf(y.x), q1 = (int)__builtin_rintf(y.y), q2 = (int)__builtin_rintf(y.z), q3 = (int)__builtin_rintf(y.w);
                        o[n] = (unsigned)(q0 & 0xff) | ((unsigned)(q1 & 0xff) << 8) | ((unsigned)(q2 & 0xff) << 16) | ((unsigned)(q3 & 0xff) << 24); }
                    *(v2u*)(XQ + (size_t)(u.pm * BM + r) * DM + col0 + bj * HALF) = o; } }
    }
};
struct EpiS {
    static constexpr bool PERM = true;
    float* S;
    __device__ __forceinline__ void operator()(const f32x4 (&acc)[2][2][4][2], const Unit& u, int wr, int wc, int, int) const {
        const int t_ = lane_now(); const int fr = t_ & 15, fq = (t_ >> 4) & 3;
        const int col0 = u.pn * BM + wc * 32 + 8 * fq;
        bf16_t* Sb = (bf16_t*)S;
#pragma unroll
        for (int ai = 0; ai < 2; ++ai)
#pragma unroll
            for (int m = 0; m < 4; ++m) { bf16_t* rowp = Sb + (size_t)(u.pm * BM + ai * HALF + wr * 64 + m * 16 + fr) * 2048 + col0;
#pragma unroll
                for (int bj = 0; bj < 2; ++bj) { const f32x4 a0 = acc[ai][bj][m][0], a1 = acc[ai][bj][m][1];
                    v4u o; o.x = pk2(a0.x, a0.y); o.y = pk2(a0.z, a0.w); o.z = pk2(a1.x, a1.y); o.w = pk2(a1.z, a1.w);
                    *(v4u*)(rowp + bj * HALF) = o; } }
    }
};
struct EpiS8 {
    static constexpr bool PERM = true;
    float* S; const float* SXG; const float* SW;
    __device__ __forceinline__ void operator()(const f32x4 (&acc)[2][2][4][2], const Unit& u, int wr, int wc, int, int) const {
        const int t_ = lane_now(); const int fr = t_ & 15, fq = (t_ >> 4) & 3;
        const int col0 = u.pn * BM + wc * 32 + 8 * fq;
        bf16_t* Sb = (bf16_t*)S;
        f32x4 sw[2][2];
#pragma unroll
        for (int bj = 0; bj < 2; ++bj)
#pragma unroll
            for (int n = 0; n < 2; ++n) sw[bj][n] = *(const f32x4*)(SW + col0 + bj * HALF + 4 * n);
#pragma unroll
        for (int ai = 0; ai < 2; ++ai)
#pragma unroll
            for (int m = 0; m < 4; ++m) { const int row = u.pm * BM + ai * HALF + wr * 64 + m * 16 + fr; const float sx = SXG[row];
                bf16_t* rowp = Sb + (size_t)row * 2048 + col0;
#pragma unroll
                for (int bj = 0; bj < 2; ++bj) { const i32x4 i0 = __builtin_bit_cast(i32x4, acc[ai][bj][m][0]), i1 = __builtin_bit_cast(i32x4, acc[ai][bj][m][1]);
                    const f32x4 a0 = __builtin_convertvector(i0, f32x4) * sx * sw[bj][0], a1 = __builtin_convertvector(i1, f32x4) * sx * sw[bj][1];
                    v4u o; o.x = pk2(a0.x, a0.y); o.y = pk2(a0.z, a0.w); o.z = pk2(a1.x, a1.y); o.w = pk2(a1.z, a1.w);
                    *(v4u*)(rowp + bj * HALF) = o; } }
    }
};
}
namespace att {
using bf16 = __hip_bfloat16;
constexpr int NW = 8, QBLK = 32, QB = 256, KVBLK = 64;
__device__ __forceinline__ int crow(int r, int hi) { return (r & 3) + 8 * (r >> 2) + 4 * hi; }
#define SBAR() __builtin_amdgcn_sched_barrier(0)
constexpr int NSLOT = 3, SLOTB = 8192;
constexpr int LDS_K = 0, LDS_V = NSLOT * SLOTB, LDS_WS = 2 * NSLOT * SLOTB, LDS_OST = LDS_WS + NW * 64 * 4, LDS_RPB = LDS_OST + NW * 8192, LDS_BYTES = LDS_RPB + 2048;
static_assert(LDS_BYTES <= RING_BYTES, "attention scratch fits the ring region");
__device__ __forceinline__ void glds16(const void* gsrc, unsigned lds_dst) { unsigned keep;
    asm volatile("s_mov_b32 %0, m0\n\ts_mov_b32 m0, %2\n\ts_nop 0\n\tglobal_load_lds_dwordx4 %1, off\n\ts_mov_b32 m0, %0" : "=&s"(keep) : "v"(gsrc), "s"(lds_dst) : "memory"); }
__device__ __forceinline__ float max3f(float a, float b, float c) { float r; asm("v_max3_f32 %0, %1, %2, %3" : "=v"(r) : "v"(a), "v"(b), "v"(c)); return r; }
__device__ __forceinline__ float max2f(float a, float b) { float r; asm("v_max_f32_e32 %0, %1, %2" : "=v"(r) : "v"(a), "v"(b)); return r; }
__device__ __forceinline__ float fadd_s(float a, float b) { float r; asm("v_add_f32_e32 %0, %1, %2" : "=v"(r) : "v"(a), "v"(b)); return r; }
__device__ __forceinline__ float fsub_s(float a, float b) { float r; asm("v_sub_f32_e32 %0, %1, %2" : "=v"(r) : "v"(a), "v"(b)); return r; }
__device__ __forceinline__ unsigned cvtpk_s(float lo, float hi) { f32x2 v = {lo, hi}; bf16x2_t b = __builtin_convertvector(v, bf16x2_t); return __builtin_bit_cast(unsigned, b); }
#define WAIT_BAR(N) asm volatile("s_waitcnt vmcnt(" #N ") lgkmcnt(0)\n\ts_barrier" ::: "memory")

__device__ __forceinline__ void qkt(f32x16& p0, f32x16& p1, const char* Kslot, const bf16x8* qr, const f32x16& negm, int r32, int hi) {
    const char* kb = Kslot + hi * 1024 + r32 * 16;
#pragma unroll
    for (int d0 = 0; d0 < 4; ++d0) {
        const bf16x8 b0 = *reinterpret_cast<const bf16x8*>(kb + d0 * 2048);
        const bf16x8 b1 = *reinterpret_cast<const bf16x8*>(kb + d0 * 2048 + 512);
        if (d0 == 0) { p0 = __builtin_amdgcn_mfma_f32_32x32x16_bf16(b0, qr[0], negm, 0, 0, 0); p1 = __builtin_amdgcn_mfma_f32_32x32x16_bf16(b1, qr[0], negm, 0, 0, 0); }
        else { p0 = __builtin_amdgcn_mfma_f32_32x32x16_bf16(b0, qr[d0], p0, 0, 0, 0); p1 = __builtin_amdgcn_mfma_f32_32x32x16_bf16(b1, qr[d0], p1, 0, 0, 0); } }
}
typedef __attribute__((address_space(3))) const char* lds_cptr;
typedef short v4i16_t __attribute__((ext_vector_type(4)));
__device__ __forceinline__ void kload8(bf16x8* kf, lds_cptr kp) {
    kf[0] = *(const __attribute__((address_space(3))) bf16x8*)(kp);        kf[1] = *(const __attribute__((address_space(3))) bf16x8*)(kp + 512);
    kf[2] = *(const __attribute__((address_space(3))) bf16x8*)(kp + 2048); kf[3] = *(const __attribute__((address_space(3))) bf16x8*)(kp + 2560);
    kf[4] = *(const __attribute__((address_space(3))) bf16x8*)(kp + 4096); kf[5] = *(const __attribute__((address_space(3))) bf16x8*)(kp + 4608);
    kf[6] = *(const __attribute__((address_space(3))) bf16x8*)(kp + 6144); kf[7] = *(const __attribute__((address_space(3))) bf16x8*)(kp + 6656);
}
__device__ __forceinline__ void kload2(bf16x8* kf, lds_cptr kp, int j) { kf[2 * j] = *(const __attribute__((address_space(3))) bf16x8*)(kp + j * 2048); kf[2 * j + 1] = *(const __attribute__((address_space(3))) bf16x8*)(kp + j * 2048 + 512); }
__device__ __forceinline__ s16x4 vtr(lds_cptr p) { return __builtin_bit_cast(s16x4, __builtin_amdgcn_ds_read_tr16_b64_v4i16((__attribute__((address_space(3))) v4i16_t*)p)); }
__device__ __forceinline__ float rowmax(const f32x16& p0, const f32x16& p1) {
    float a = max3f(p0[0], p0[1], p1[0]), b = max3f(p0[2], p0[3], p1[1]); a = max3f(a, p1[2], p1[3]);
#pragma unroll
    for (int r = 4; r < 16; r += 4) { a = max3f(a, p0[r], p0[r + 1]); b = max3f(b, p0[r + 2], p0[r + 3]); a = max3f(a, p1[r], p1[r + 1]); b = max3f(b, p1[r + 2], p1[r + 3]); }
    const float m = max2f(a, b);
    auto rr = __builtin_amdgcn_permlane32_swap(__float_as_uint(m), __float_as_uint(m), false, false);
    return max2f(__uint_as_float(rr[0]), __uint_as_float(rr[1]));
}
__device__ __forceinline__ void pv(f32x16* o, int vb, bf16x8 pa0, bf16x8 pa1, bf16x8 pa2, bf16x8 pa3) {
#pragma unroll
    for (int d0 = 0; d0 < 2; ++d0) { s16x4 lo[4], hi[4];
#pragma unroll
        for (int ks = 0; ks < 4; ++ks) {
            asm volatile("ds_read_b64_tr_b16 %0,%1 offset:%c2" : "=&v"(lo[ks]) : "v"(vb), "i"(d0 * 4096 + ks * 1024) : "memory");
            asm volatile("ds_read_b64_tr_b16 %0,%1 offset:%c2" : "=&v"(hi[ks]) : "v"(vb), "i"(d0 * 4096 + ks * 1024 + 512) : "memory"); }
        asm volatile("s_waitcnt lgkmcnt(0)" ::: "memory"); SBAR();
#define PK(k) (bf16x8){lo[k][0], lo[k][1], lo[k][2], lo[k][3], hi[k][0], hi[k][1], hi[k][2], hi[k][3]}
        o[d0] = __builtin_amdgcn_mfma_f32_32x32x16_bf16(pa0, PK(0), o[d0], 0, 0, 0);
        o[d0] = __builtin_amdgcn_mfma_f32_32x32x16_bf16(pa1, PK(1), o[d0], 0, 0, 0);
        o[d0] = __builtin_amdgcn_mfma_f32_32x32x16_bf16(pa2, PK(2), o[d0], 0, 0, 0);
        o[d0] = __builtin_amdgcn_mfma_f32_32x32x16_bf16(pa3, PK(3), o[d0], 0, 0, 0);
#undef PK
    }
}

struct AU {
    const bf16* Q; const bf16* K; const bf16* V;
    bf16* O;
    int q0, NT, kbase;
    float sinkl2;
    int emode;
    float lam, oscale; const float* subw;
};

template <int MODE> __device__ __forceinline__ void amask(f32x16& p0, f32x16& p1, int t, const AU& u, int wid, int r32, int hi, const float* rpb) {
    if constexpr (MODE == 2) {
        if (t >= 4) {
            const int kp0 = u.kbase + 64 * (t - 4) + 4 * hi, qpos = u.q0 + wid * QBLK + r32;
#pragma unroll
            for (int r = 0; r < 16; ++r) { const int kv = kp0 + (r & 3) + 8 * (r >> 2);
                const bool ok0 = ((unsigned)(kv - qpos + 128) <= 256u) && ((unsigned)kv < (unsigned)SEQ);
                const bool ok1 = ((unsigned)(kv + 32 - qpos + 128) <= 256u) && ((unsigned)(kv + 32) < (unsigned)SEQ);
                if (!ok0) p0[r] = -INFINITY; if (!ok1) p1[r] = -INFINITY; }
        }
    }
    if constexpr (MODE == 1) {
        if (t >= 4) {
            const int jr = (u.kbase >> 6) + (t - 4), qr = (u.q0 >> 6) + (wid >> 1), qc = 32 * (wid & 1) + r32;
            int rs = qr - 4; rs = rs < 0 ? 0 : (rs > 248 ? 248 : rs);
            int cs = qc - 8; cs = cs < 0 ? 0 : (cs > 48 ? 48 : cs);
            const bool rowok = (unsigned)(jr - rs) < 8u;
            int ro = jr - qr + 7; ro = ro < 0 ? 0 : (ro > 14 ? 14 : ro);
            const float* brow = rpb + ro * 32;
#pragma unroll
            for (int r = 0; r < 16; ++r) { const int kc = 4 * hi + (r & 3) + 8 * (r >> 2);
                { int bi = kc - qc + 15; bi = bi < 0 ? 0 : (bi > 30 ? 30 : bi); const bool ok = rowok && ((unsigned)(kc - cs) < 16u); p0[r] = ok ? p0[r] + brow[bi] : -INFINITY; }
                { int bi = kc + 32 - qc + 15; bi = bi < 0 ? 0 : (bi > 30 ? 30 : bi); const bool ok = rowok && ((unsigned)(kc + 32 - cs) < 16u); p1[r] = ok ? p1[r] + brow[bi] : -INFINITY; } }
        }
    }
}

template <int MODE, int THRL, int QKH = 0, int NOMAX = 0> __device__ __forceinline__ bool attn_unit(const AU& u, char* shm, int wave) {
    const int lane = lane_now(), tid = (wave << 6) | lane, r32 = lane & 31, hi = lane >> 5; const int wid = wave;
    const bf16* Qw = u.Q + (size_t)(u.q0 + wid * QBLK) * 64;
    const bf16* Kh = u.K; const bf16* Vh = u.V;
    const unsigned lds0 = (unsigned)(uintptr_t)shm;
    float* wsf = (float*)(shm + LDS_WS) + wid * 64;
    const float* rpb = (const float*)(shm + LDS_RPB);
    const int NT = u.NT;
    volatile int* okflag = (volatile int*)(shm + LDS_RPB + 2040);
    if constexpr (NOMAX) { if (tid == 0) *okflag = 0; }
#define KROW(t) ((t) < 4 ? SEQ + 64 * (t) : (u.kbase + 64 * ((t) - 4) < 0 ? 0 : (u.kbase + 64 * ((t) - 4) > SEQ - 64 ? SEQ - 64 : u.kbase + 64 * ((t) - 4))))
    const bf16* ksrc = Kh + (size_t)lane * 64 + wid * 8;
    const bf16* vsrc = Vh + (size_t)(16 * (wid & 3) + (lane >> 2)) * 64 + (wid >> 2) * 32 + (lane & 3) * 8;
    const unsigned kdst = lds0 + LDS_K + wid * 1024, vdst = lds0 + LDS_V + wid * 1024;
#define DMA_K(t, slot) glds16(ksrc + (size_t)KROW(t) * 64, (unsigned)__builtin_amdgcn_readfirstlane(kdst + (slot)))
#define DMA_V(t, slot) glds16(vsrc + (size_t)KROW(t) * 64, (unsigned)__builtin_amdgcn_readfirstlane(vdst + (slot)))
    const int vb0 = (int)(lds0 + LDS_V) + ((lane >> 4) & 1) * 32 + (lane & 3) * 8 + (4 * hi + ((lane & 15) >> 2)) * 64;
    const char* Kbase = shm + LDS_K; bf16x8 kf[8];
    const lds_cptr shm3 = (lds_cptr)shm; const lds_cptr kp0 = shm3 + LDS_K + hi * 1024 + r32 * 16; const lds_cptr vp0 = shm3 + LDS_V + ((lane >> 4) & 1) * 32 + (lane & 3) * 8 + (4 * hi + ((lane & 15) >> 2)) * 64;
    DMA_K(0, 0); DMA_V(0, 0); DMA_K(1, SLOTB);
    bf16x8 qr[4];
#pragma unroll
    for (int d0 = 0; d0 < 4; ++d0) qr[d0] = *reinterpret_cast<const bf16x8*>(&Qw[(size_t)r32 * 64 + d0 * 16 + hi * 8]);
    float mhat = 0.f, l_reg = 0.f; f32x16 o[2]; o[0] = f32x16{}; o[1] = f32x16{}; f32x16 negm = f32x16{}; asm volatile("" : "+v"(negm));
#define CMASK(P0, P1, t) amask<MODE>(P0, P1, (t), u, wid, r32, hi, rpb)
    bool resc = false;
#define START(P0, P1) do { const float rm = rowmax(P0, P1); resc = false; \
    { const float dl = rm; mhat = fadd_s(mhat, dl); \
      _Pragma("unroll") for (int r = 0; r < 16; ++r) { P0[r] = fsub_s(P0[r], dl); P1[r] = fsub_s(P1[r], dl); } \
      _Pragma("unroll") for (int r = 0; r < 16; ++r) negm[r] = -mhat; asm volatile("" : "+v"(negm)); } \
    _Pragma("unroll") for (int r = 0; r < 16; ++r) P0[r] = __builtin_amdgcn_exp2f(P0[r]); } while (0)
#define RESC() do { if (resc) { asm volatile("s_waitcnt lgkmcnt(0)" ::: "memory"); \
      _Pragma("unroll") for (int d_ = 0; d_ < 2; ++d_) _Pragma("unroll") for (int r = 0; r < 16; ++r) o[d_][r] *= wsf[crow(r, hi)]; } } while (0)
    f32x16 pA0, pA1, pB0, pB1;
    int sl_prev = 0, sl_cur = 0, sl_next = SLOTB;
#define ROT() do { sl_prev = sl_cur; sl_cur = sl_next; sl_next = (sl_next == (NSLOT - 1) * SLOTB) ? 0 : sl_next + SLOTB; } while (0)
    DMA_K(2, 2 * SLOTB);
    WAIT_BAR(3);
    qkt(pA0, pA1, Kbase, qr, negm, r32, hi); asm volatile("s_nop 15\n\ts_nop 7" : "+v"(pA0), "+v"(pA1));
    START(pA0, pA1);
    _Pragma("unroll") for (int r = 0; r < 16; ++r) pA1[r] = __builtin_amdgcn_exp2f(pA1[r]);
    WAIT_BAR(0);
    DMA_K(3, 0); DMA_V(1, SLOTB);
    ROT();
    kload8(kf, kp0 + sl_cur);
    WAIT_BAR(2);
    s16x4 vlo[8], vhi[8]; v4u pw0, pw1, pw2, pw3;
#define PKW(P, B) cvtpk_s(P[B], P[B + 1])
#define PAF(k) __builtin_bit_cast(bf16x8, pw##k)
#define VFR(i) (bf16x8){vlo[i][0], vlo[i][1], vlo[i][2], vlo[i][3], vhi[i][0], vhi[i][1], vhi[i][2], vhi[i][3]}
#define PIN(x) asm volatile("" : "+v"(x))
#define MX3(a, b, c) __builtin_fmaxf(__builtin_fmaxf((a), (b)), (c))
#define GAPA(MF, A0, A1, A2, A3, W0, W1, PW) do { MF; sacc += A0; sacc += A1; sacc += A2; sacc += A3; PIN(sacc); W0; W1; PIN(PW); SBAR(); } while (0)
#define EX(v) __builtin_amdgcn_exp2f(v)
#define GAPB(MF, X, B) do { MF; X[B] = EX(X[B]); X[B + 1] = EX(X[B + 1]); X[B + 2] = EX(X[B + 2]); X[B + 3] = EX(X[B + 3]); PIN(X); SBAR(); } while (0)
#define VRD(i) do { vlo[i] = vtr(vp_ + (((i) >> 2) * 4096 + ((i) & 3) * 1024)); vhi[i] = vtr(vp_ + (((i) >> 2) * 4096 + ((i) & 3) * 1024 + 512)); } while (0)
#define KRD(G, j) do { if constexpr (QKH == 0 || (QKH == 1 && (j) < 2) || (QKH == 2 && (j) >= 2)) { if (G) { kload2(kf, kp0 + sl_next, j); SBAR(); } } } while (0)
#define MF32(a, b, c) __builtin_amdgcn_mfma_f32_32x32x16_bf16(a, b, c, 0, 0, 0)
#define QLO(X) do { if constexpr (QKH != 2) { X; } } while (0)
#define QHI(X0, X2) do { if constexpr (QKH == 0) { X0; } else if constexpr (QKH == 2) { X2; } } while (0)
#define STEP(C0, C1, P0, P1, t, GK, GV, GL) do { SBAR(); \
    const lds_cptr vp_ = vp0 + sl_prev; \
    VRD(0); SBAR(); float sacc = (P0[0] + P0[1]); \
    GAPA(QLO(C0 = MF32(kf[0], qr[0], negm)), P0[2], P0[3], P0[4], P0[5],     pw0[0] = PKW(P0, 0), pw0[1] = PKW(P0, 2), pw0); \
    VRD(4); SBAR(); GAPA(QLO(C1 = MF32(kf[1], qr[0], negm)), P0[6], P0[7], P0[8], P0[9],     pw0[2] = PKW(P0, 4), pw0[3] = PKW(P0, 6), pw0); \
    VRD(1); SBAR(); GAPA(QLO(C0 = MF32(kf[2], qr[1], C0)), P0[10], P0[11], P0[12], P0[13], pw1[0] = PKW(P0, 8), pw1[1] = PKW(P0, 10), pw1); \
    VRD(5); SBAR(); GAPA(QLO(C1 = MF32(kf[3], qr[1], C1)), P0[14], P0[15], P1[0], P1[1],   pw1[2] = PKW(P0, 12), pw1[3] = PKW(P0, 14), pw1); \
    VRD(2); SBAR(); GAPA(QHI(C0 = MF32(kf[4], qr[2], C0), C0 = MF32(kf[4], qr[2], negm)), P1[2], P1[3], P1[4], P1[5],     pw2[0] = PKW(P1, 0), pw2[1] = PKW(P1, 2), pw2); \
    VRD(6); SBAR(); GAPA(QHI(C1 = MF32(kf[5], qr[2], C1), C1 = MF32(kf[5], qr[2], negm)), P1[6], P1[7], P1[8], P1[9],     pw2[2] = PKW(P1, 4), pw2[3] = PKW(P1, 6), pw2); \
    VRD(3); SBAR(); GAPA(QHI(C0 = MF32(kf[6], qr[3], C0), C0 = MF32(kf[6], qr[3], C0)), P1[10], P1[11], P1[12], P1[13], pw3[0] = PKW(P1, 8), pw3[1] = PKW(P1, 10), pw3); \
    VRD(7); SBAR(); GAPA(QHI(C1 = MF32(kf[7], qr[3], C1), C1 = MF32(kf[7], qr[3], C1)), P1[14], P1[15], 0.f, 0.f,       pw3[2] = PKW(P1, 12), pw3[3] = PKW(P1, 14), pw3); \
    l_reg += sacc; \
    if (GK) { DMA_K((t) + 3, sl_cur); } if (GV) { DMA_V((t) + 1, sl_next); } \
    CMASK(C0, C1, t); \
    if constexpr (NOMAX) { resc = false; } else { float a = MX3(C0[0], C0[1], C1[0]), b = MX3(C0[2], C0[3], C1[1]); a = MX3(a, C1[2], C1[3]); \
      _Pragma("unroll") for (int r = 4; r < 16; r += 4) { a = MX3(a, C0[r], C0[r + 1]); b = MX3(b, C0[r + 2], C0[r + 3]); a = MX3(a, C1[r], C1[r + 1]); b = MX3(b, C1[r + 2], C1[r + 3]); } \
      float rm = __builtin_fmaxf(a, b); { auto rr = __builtin_amdgcn_permlane32_swap(__float_as_uint(rm), __float_as_uint(rm), false, false); rm = __builtin_fmaxf(__uint_as_float(rr[0]), __uint_as_float(rr[1])); } \
      resc = false; \
      if (__builtin_expect(__any(rm > (float)THRL), 0)) { const float dl = __builtin_fmaxf(rm, 0.f); mhat += dl; \
        _Pragma("unroll") for (int r = 0; r < 16; ++r) { C0[r] -= dl; C1[r] -= dl; } \
        _Pragma("unroll") for (int r = 0; r < 16; ++r) negm[r] = -mhat; asm volatile("" : "+v"(negm)); \
        const float f = __builtin_amdgcn_exp2f(-dl); l_reg *= f; if (hi == 0) wsf[r32] = f; resc = true; } } \
    SBAR(); \
    GAPB(o[0] = __builtin_amdgcn_mfma_f32_32x32x16_bf16(PAF(0), VFR(0), o[0], 0, 0, 0), C0, 0); \
    GAPB(o[1] = __builtin_amdgcn_mfma_f32_32x32x16_bf16(PAF(0), VFR(4), o[1], 0, 0, 0), C0, 4); \
    KRD(GL, 0); GAPB(o[0] = __builtin_amdgcn_mfma_f32_32x32x16_bf16(PAF(1), VFR(1), o[0], 0, 0, 0), C0, 8); \
    KRD(GL, 1); GAPB(o[1] = __builtin_amdgcn_mfma_f32_32x32x16_bf16(PAF(1), VFR(5), o[1], 0, 0, 0), C0, 12); \
    KRD(GL, 2); GAPB(o[0] = __builtin_amdgcn_mfma_f32_32x32x16_bf16(PAF(2), VFR(2), o[0], 0, 0, 0), C1, 0); \
    KRD(GL, 3); GAPB(o[1] = __builtin_amdgcn_mfma_f32_32x32x16_bf16(PAF(2), VFR(6), o[1], 0, 0, 0), C1, 4); \
    GAPB(o[0] = __builtin_amdgcn_mfma_f32_32x32x16_bf16(PAF(3), VFR(3), o[0], 0, 0, 0), C1, 8); \
    GAPB(o[1] = __builtin_amdgcn_mfma_f32_32x32x16_bf16(PAF(3), VFR(7), o[1], 0, 0, 0), C1, 12); \
    } while (0)
    int t = 1;
    for (; t + 5 < NT; t += 2) {
        STEP(pB0, pB1, pA0, pA1, t, true, true, true);     WAIT_BAR(2); RESC(); ROT();
        STEP(pA0, pA1, pB0, pB1, t + 1, true, true, true);   WAIT_BAR(2); RESC(); ROT();
    }
#define ENDW(tt) do { if ((tt) + 3 < NT) { WAIT_BAR(2); } else if ((tt) + 2 < NT) { WAIT_BAR(1); } else { WAIT_BAR(0); } } while (0)
    for (; t + 1 < NT; t += 2) {
        STEP(pB0, pB1, pA0, pA1, t, (t + 3 < NT), (t + 1 < NT), (t + 1 < NT));       ENDW(t);   RESC(); ROT();
        STEP(pA0, pA1, pB0, pB1, t + 1, (t + 4 < NT), (t + 2 < NT), (t + 2 < NT));     ENDW(t + 1); RESC(); ROT();
    }
    STEP(pB0, pB1, pA0, pA1, NT - 1, false, false, false); RESC();
    { float sacc = pB0[0] + pB0[1]; _Pragma("unroll") for (int r = 2; r < 16; ++r) sacc += pB0[r]; _Pragma("unroll") for (int r = 0; r < 16; ++r) sacc += pB1[r]; l_reg += sacc;
      pw0 = (v4u){PKW(pB0, 0), PKW(pB0, 2), PKW(pB0, 4), PKW(pB0, 6)}; pw1 = (v4u){PKW(pB0, 8), PKW(pB0, 10), PKW(pB0, 12), PKW(pB0, 14)}; pw2 = (v4u){PKW(pB1, 0), PKW(pB1, 2), PKW(pB1, 4), PKW(pB1, 6)}; pw3 = (v4u){PKW(pB1, 8), PKW(pB1, 10), PKW(pB1, 12), PKW(pB1, 14)};
      SBAR(); pv(o, vb0 + sl_cur, PAF(0), PAF(1), PAF(2), PAF(3)); }
#undef PKW
#undef PAF
#undef VFR
#undef PIN
#undef MX3
#undef GAPA
#undef GAPB
#undef EX
#undef VRD
#undef KRD
#undef MF32
#undef QLO
#undef QHI
#undef STEP
#undef ENDW
    { auto rr = __builtin_amdgcn_permlane32_swap(__float_as_uint(l_reg), __float_as_uint(l_reg), false, false); l_reg = __uint_as_float(rr[0]) + __uint_as_float(rr[1]); }
    if constexpr (NOMAX) {
        const bool ok = (l_reg > 0x1p-90f) && (l_reg < 0x1p90f);
        if (__any(!ok)) { if (lane == 0) *okflag = 1; }
        asm volatile("s_waitcnt lgkmcnt(0)\n\ts_barrier" ::: "memory");
        const int bad = __builtin_amdgcn_readfirstlane(*okflag);
        if (bad) { asm volatile("s_waitcnt lgkmcnt(0)\n\ts_barrier" ::: "memory"); return false; }
    }
    l_reg += __builtin_amdgcn_exp2f(u.sinkl2 - mhat);
    if (hi == 0) wsf[32 + r32] = l_reg; asm volatile("s_waitcnt lgkmcnt(0)" ::: "memory");
    float rli[16];
#pragma unroll
    for (int r = 0; r < 16; ++r) rli[r] = __builtin_amdgcn_rcpf(wsf[32 + crow(r, hi)]);
    if (u.emode == 0) {
        bf16* Ow = u.O + (size_t)(u.q0 + wid * QBLK) * 1024;
        bf16* stg = (bf16*)(shm + LDS_OST + wid * 8192);
#pragma unroll
        for (int r = 0; r < 16; ++r) { const int orow = crow(r, hi);
#pragma unroll
            for (int d0 = 0; d0 < 2; ++d0) stg[orow * 64 + d0 * 32 + r32] = __float2bfloat16(o[d0][r] * rli[r]); }
        asm volatile("s_waitcnt lgkmcnt(0)" ::: "memory");
#pragma unroll
        for (int i = 0; i < 4; ++i) { const int row = i * 8 + (lane >> 3), ch = lane & 7; const v4u v = *(const v4u*)(stg + row * 64 + ch * 8); *(v4u*)(Ow + (size_t)row * 1024 + ch * 8) = v; }
    } else {
        float* stf = (float*)(shm + LDS_OST + wid * 8192);
        if (u.emode == 1) {
#pragma unroll
            for (int r = 0; r < 16; ++r) { const int orow = crow(r, hi);
#pragma unroll
                for (int d0 = 0; d0 < 2; ++d0) stf[orow * 64 + d0 * 32 + r32] = o[d0][r] * rli[r]; }
        } else {
#pragma unroll
            for (int r = 0; r < 16; ++r) { const int orow = crow(r, hi);
#pragma unroll
                for (int d0 = 0; d0 < 2; ++d0) { const float y = stf[orow * 64 + d0 * 32 + r32] - u.lam * (o[d0][r] * rli[r]); stf[orow * 64 + d0 * 32 + r32] = y; } }
            asm volatile("s_waitcnt lgkmcnt(0)" ::: "memory");
            bf16* Ow = u.O + (size_t)(u.q0 + wid * QBLK) * 1024;
#pragma unroll
            for (int i = 0; i < 4; ++i) { const int row = i * 8 + (lane >> 3), ch = lane & 7;
                const f32x4 y0 = *(const f32x4*)(stf + row * 64 + ch * 8), y1 = *(const f32x4*)(stf + row * 64 + ch * 8 + 4);
                float ss = (y0[0] * y0[0] + y0[1] * y0[1]) + (y0[2] * y0[2] + y0[3] * y0[3]) + (y1[0] * y1[0] + y1[1] * y1[1]) + (y1[2] * y1[2] + y1[3] * y1[3]);
                ss += xorf<1>(ss); ss += xorf<2>(ss); ss += xorf<4>(ss);
                const float ri = __builtin_amdgcn_rsqf(ss * (1.f / 64.f) + EPS) * u.oscale;
                const f32x4 w0 = *(const f32x4*)(u.subw + ch * 8), w1 = *(const f32x4*)(u.subw + ch * 8 + 4);
                v4u v; v.x = pk2(y0[0] * ri * w0[0], y0[1] * ri * w0[1]); v.y = pk2(y0[2] * ri * w0[2], y0[3] * ri * w0[3]); v.z = pk2(y1[0] * ri * w1[0], y1[1] * ri * w1[1]); v.w = pk2(y1[2] * ri * w1[2], y1[3] * ri * w1[3]);
                *(v4u*)(Ow + (size_t)row * 1024 + ch * 8) = v; }
        }
    }
    asm volatile("s_waitcnt lgkmcnt(0)\n\ts_barrier" ::: "memory");
    return true;
#undef DMA_K
#undef DMA_V
#undef KROW
#undef CMASK
#undef START
#undef RESC
#undef ROT
}

template <int MODE, int NOMAX = 0> __device__ __forceinline__ bool attn_simple(const AU& u, char* shm, int wave) {
    const int lane = lane_now(), tid = (wave << 6) | lane, r32 = lane & 31, hi = lane >> 5; const int wid = wave;
    const bf16* Qw = u.Q + (size_t)(u.q0 + wid * QBLK) * 64;
    const unsigned lds0 = (unsigned)(uintptr_t)shm;
    float* wsf = (float*)(shm + LDS_WS) + wid * 64;
    const float* rpb = (const float*)(shm + LDS_RPB);
    const int NT = u.NT;
    volatile int* okflag = (volatile int*)(shm + LDS_RPB + 2040);
    if constexpr (NOMAX) { if (tid == 0) *okflag = 0; }
#define KROW(t) ((t) < 4 ? SEQ + 64 * (t) : (u.kbase + 64 * ((t) - 4) < 0 ? 0 : (u.kbase + 64 * ((t) - 4) > SEQ - 64 ? SEQ - 64 : u.kbase + 64 * ((t) - 4))))
    const bf16* ksrc = u.K + (size_t)lane * 64 + wid * 8;
    const bf16* vsrc = u.V + (size_t)(16 * (wid & 3) + (lane >> 2)) * 64 + (wid >> 2) * 32 + (lane & 3) * 8;
    const unsigned kdst = lds0 + LDS_K + wid * 1024, vdst = lds0 + LDS_V + wid * 1024;
    const int vb0 = (int)(lds0 + LDS_V) + ((lane >> 4) & 1) * 32 + (lane & 3) * 8 + (4 * hi + ((lane & 15) >> 2)) * 64;
    { const int kr = KROW(0); glds16(ksrc + (size_t)kr * 64, (unsigned)__builtin_amdgcn_readfirstlane(kdst)); glds16(vsrc + (size_t)kr * 64, (unsigned)__builtin_amdgcn_readfirstlane(vdst)); }
    bf16x8 qr[4];
#pragma unroll
    for (int d0 = 0; d0 < 4; ++d0) qr[d0] = *reinterpret_cast<const bf16x8*>(&Qw[(size_t)r32 * 64 + d0 * 16 + hi * 8]);
    float m_run = -INFINITY, l_reg = 0.f; f32x16 o[2]; o[0] = f32x16{}; o[1] = f32x16{};
    const f32x16 zero = f32x16{};
#pragma unroll 1
    for (int t = 0; t < NT; ++t) {
        const int sl = (t & 1) * SLOTB;
        asm volatile("s_waitcnt vmcnt(0) lgkmcnt(0)\n\ts_barrier" ::: "memory");
        if (t + 1 < NT) { const int kr = KROW(t + 1); const int sn = ((t + 1) & 1) * SLOTB;
            glds16(ksrc + (size_t)kr * 64, (unsigned)__builtin_amdgcn_readfirstlane(kdst + sn)); glds16(vsrc + (size_t)kr * 64, (unsigned)__builtin_amdgcn_readfirstlane(vdst + sn)); }
        bool live = true;
        if (t >= 4) {
            if constexpr (MODE == 1) { const int jr = (u.kbase >> 6) + (t - 4), qr_ = (u.q0 >> 6) + (wid >> 1); int rs = qr_ - 4; rs = rs < 0 ? 0 : (rs > 248 ? 248 : rs); live = (unsigned)(jr - rs) < 8u; }
            if constexpr (MODE == 2) { const int k0 = u.kbase + 64 * (t - 4), qa = u.q0 + wid * QBLK; live = (k0 + 63 >= qa - 128) && (k0 <= qa + QBLK - 1 + 128); }
        }
        if (!live) continue;
        f32x16 p0, p1;
        qkt(p0, p1, shm + LDS_K + sl, qr, zero, r32, hi);
        amask<MODE>(p0, p1, t, u, wid, r32, hi, rpb);
        if (NOMAX && t > 0) {
            float sacc = 0.f;
#pragma unroll
            for (int r = 0; r < 16; ++r) { p0[r] = __builtin_amdgcn_exp2f(p0[r] - m_run); p1[r] = __builtin_amdgcn_exp2f(p1[r] - m_run); sacc += p0[r] + p1[r]; }
            l_reg += sacc;
        } else {
        float rm = p0[0];
#pragma unroll
        for (int r = 1; r < 16; ++r) rm = __builtin_fmaxf(rm, p0[r]);
#pragma unroll
        for (int r = 0; r < 16; ++r) rm = __builtin_fmaxf(rm, p1[r]);
        { auto rr = __builtin_amdgcn_permlane32_swap(__float_as_uint(rm), __float_as_uint(rm), false, false); rm = __builtin_fmaxf(__uint_as_float(rr[0]), __uint_as_float(rr[1])); }
        const float m_new = __builtin_fmaxf(m_run, rm);
        const float alpha = __builtin_amdgcn_exp2f(m_run - m_new); m_run = m_new;
        float sacc = 0.f;
#pragma unroll
        for (int r = 0; r < 16; ++r) { p0[r] = __builtin_amdgcn_exp2f(p0[r] - m_new); p1[r] = __builtin_amdgcn_exp2f(p1[r] - m_new); sacc += p0[r] + p1[r]; }
        l_reg = l_reg * alpha + sacc;
        if (hi == 0) wsf[r32] = alpha;
        asm volatile("s_waitcnt lgkmcnt(0)" ::: "memory");
#pragma unroll
        for (int d_ = 0; d_ < 2; ++d_)
#pragma unroll
            for (int r = 0; r < 16; ++r) o[d_][r] *= wsf[crow(r, hi)];
        }
        v4u pw0, pw1, pw2, pw3;
        pw0 = (v4u){cvtpk_s(p0[0], p0[1]), cvtpk_s(p0[2], p0[3]), cvtpk_s(p0[4], p0[5]), cvtpk_s(p0[6], p0[7])}; pw1 = (v4u){cvtpk_s(p0[8], p0[9]), cvtpk_s(p0[10], p0[11]), cvtpk_s(p0[12], p0[13]), cvtpk_s(p0[14], p0[15])};
        pw2 = (v4u){cvtpk_s(p1[0], p1[1]), cvtpk_s(p1[2], p1[3]), cvtpk_s(p1[4], p1[5]), cvtpk_s(p1[6], p1[7])}; pw3 = (v4u){cvtpk_s(p1[8], p1[9]), cvtpk_s(p1[10], p1[11]), cvtpk_s(p1[12], p1[13]), cvtpk_s(p1[14], p1[15])};
        asm volatile("s_waitcnt lgkmcnt(0)" ::: "memory"); SBAR();
        pv(o, vb0 + sl, __builtin_bit_cast(bf16x8, pw0), __builtin_bit_cast(bf16x8, pw1), __builtin_bit_cast(bf16x8, pw2), __builtin_bit_cast(bf16x8, pw3));
    }
    { auto rr = __builtin_amdgcn_permlane32_swap(__float_as_uint(l_reg), __float_as_uint(l_reg), false, false); l_reg = __uint_as_float(rr[0]) + __uint_as_float(rr[1]); }
    if constexpr (NOMAX) {
        const bool ok = (l_reg > 0x1p-90f) && (l_reg < 0x1p90f);
        if (__any(!ok)) { if (lane == 0) *okflag = 1; }
        asm volatile("s_waitcnt vmcnt(0) lgkmcnt(0)\n\ts_barrier" ::: "memory");
        const int bad = __builtin_amdgcn_readfirstlane(*okflag);
        if (bad) { asm volatile("s_waitcnt lgkmcnt(0)\n\ts_barrier" ::: "memory"); return false; }
    }
    l_reg += __builtin_amdgcn_exp2f(u.sinkl2 - m_run);
    asm volatile("s_waitcnt lgkmcnt(0)" ::: "memory");
    if (hi == 0) wsf[32 + r32] = l_reg; asm volatile("s_waitcnt lgkmcnt(0)" ::: "memory");
    float rli[16];
#pragma unroll
    for (int r = 0; r < 16; ++r) rli[r] = __builtin_amdgcn_rcpf(wsf[32 + crow(r, hi)]);
    {
        bf16* Ow = u.O + (size_t)(u.q0 + wid * QBLK) * 1024;
        bf16* stg = (bf16*)(shm + LDS_OST + wid * 8192);
#pragma unroll
        for (int r = 0; r < 16; ++r) { const int orow = crow(r, hi);
#pragma unroll
            for (int d0 = 0; d0 < 2; ++d0) stg[orow * 64 + d0 * 32 + r32] = __float2bfloat16(o[d0][r] * rli[r]); }
        asm volatile("s_waitcnt lgkmcnt(0)" ::: "memory");
#pragma unroll
        for (int i = 0; i < 4; ++i) { const int row = i * 8 + (lane >> 3), ch = lane & 7; const v4u v = *(const v4u*)(stg + row * 64 + ch * 8); *(v4u*)(Ow + (size_t)row * 1024 + ch * 8) = v; }
    }
    asm volatile("s_waitcnt vmcnt(0) lgkmcnt(0)\n\ts_barrier" ::: "memory");
    return true;
#undef KROW
}
#undef SBAR
#undef WAIT_BAR
}
struct Args { const float* in[23]; float* out; unsigned char* ws; int flags; int pad; };
enum { I_X = 0, I_C, I_CTX, I_CCTX, I_N1W, I_N2W, I_ADAW, I_ADAB, I_WIN, I_RPB, I_DLAM, I_SUBW, I_SINK, I_QKNW, I_WBR, I_WGATE, I_BGATE, I_WOUT, I_PWQ, I_PKEYS, I_PU, I_PV, I_FNW };

struct Frame {
    LAS unsigned char* lds; volatile LAS unsigned* MISC; gu32* ctl;
    int wave, vcu, G;
};
__device__ __forceinline__ int ltid(int wave) { return tid_now(wave); }

struct MapId   { __device__ __forceinline__ int operator()(int n) const { return n; } };
struct MapWin  { __device__ __forceinline__ int operator()(int n) const { return (n & ~255) + 128 * ((n >> 5) & 1) + 32 * ((n >> 6) & 3) + (n & 31); } };
struct MapGate { __device__ __forceinline__ int operator()(int n) const { const int br = n >> 10, ch = n & 1023; return 256 * (ch >> 6) + 128 * (br >> 1) + 32 * ((ch >> 4) & 3) + 16 * (br & 1) + (ch & 15); } };
template <class Map, bool F8 = false> __device__ __forceinline__ void transpose_item(const float* W, int K, int N, void* WTv, Map mp, LAS float* scr, int item, int lane) {
    bf16_t* WT = (bf16_t*)WTv; unsigned char* WT8 = (unsigned char*)WTv;
    const int nblk = N / 32, kb = item / nblk, nb = item % nblk, k0 = 64 * kb, n0 = 32 * nb;
#pragma unroll 8
    for (int i = 0; i < 32; ++i) { const int kk = 2 * i + (lane >> 5); scr[kk * 33 + (lane & 31)] = W[(size_t)(k0 + kk) * N + n0 + (lane & 31)]; }
    LDS_WAIT(); asm volatile("" ::: "memory");
    const int c = lane & 7;
#pragma unroll
    for (int j = 0; j < 4; ++j) { const int n = (lane >> 3) + 8 * j; const LAS float* s = scr + (8 * c) * 33 + n;
        int nn = n0 + n; asm volatile("" : "+v"(nn));
        if constexpr (F8) { v2u o; o.x = pk4_fp8(s[0 * 33] * 64.f, s[1 * 33] * 64.f, s[2 * 33] * 64.f, s[3 * 33] * 64.f); o.y = pk4_fp8(s[4 * 33] * 64.f, s[5 * 33] * 64.f, s[6 * 33] * 64.f, s[7 * 33] * 64.f);
            *(GAS v2u*)(WT8 + (size_t)mp(nn) * K + k0 + 8 * c) = o; }
        else { v4u o; o.x = pk2(s[0 * 33], s[1 * 33]); o.y = pk2(s[2 * 33], s[3 * 33]); o.z = pk2(s[4 * 33], s[5 * 33]); o.w = pk2(s[6 * 33], s[7 * 33]);
            *(GAS v4u*)(WT + (size_t)mp(nn) * K + k0 + 8 * c) = o; } }
    LDS_WAIT(); asm volatile("" ::: "memory");
}
__device__ __forceinline__ void modnorm_row(const float* xrow, bf16_t* orow, const float* nw, const float* sh, const float* sc, int lane, unsigned char* o8row = nullptr) {
    const GAS f32x4* xr = (const GAS f32x4*)xrow + lane;
    f32x4 v[4]; float s = 0.f;
#pragma unroll
    for (int j = 0; j < 4; ++j) { v[j] = xr[64 * j]; s += (v[j].x * v[j].x + v[j].y * v[j].y) + (v[j].z * v[j].z + v[j].w * v[j].w); }
    const float ri = __builtin_amdgcn_rsqf(wave_sum(s) * (1.f / DM) + EPS);
    GAS v2u* o8 = (GAS v2u*)orow + lane;
#pragma unroll
    for (int j = 0; j < 4; ++j) { const int col = 256 * j + 4 * lane; const f32x4 w = *(const f32x4*)(nw + col), a = *(const f32x4*)(sc + col), b = *(const f32x4*)(sh + col);
        const f32x4 y = (v[j] * ri * w) * (1.0f + a) + b;
        if (orow) { v2u p; p.x = pk2(y.x, y.y); p.y = pk2(y.z, y.w); o8[64 * j] = p; }
        if (o8row) ((GAS unsigned*)o8row)[64 * j + lane] = pk4_fp8(y.x, y.y, y.z, y.w); }
}

__device__ __forceinline__ void ce_desc(float& a, float& b) { const float hi = __builtin_fmaxf(a, b), lo = __builtin_fminf(a, b); a = hi; b = lo; }
__device__ __forceinline__ void sort16_desc(float (&x)[16]) {
#pragma unroll
    for (int k = 2; k <= 16; k <<= 1)
#pragma unroll
        for (int j = k >> 1; j > 0; j >>= 1)
#pragma unroll
            for (int i = 0; i < 16; ++i) { const int l = i ^ j; if (l > i) { if ((i & k) == 0) ce_desc(x[i], x[l]); else ce_desc(x[l], x[i]); } }
}
__device__ __forceinline__ void merge16_desc(float (&top)[16], const float (&c)[16]) {
#pragma unroll
    for (int i = 0; i < 16; ++i) top[i] = __builtin_fmaxf(top[i], c[15 - i]);
#pragma unroll
    for (int j = 8; j > 0; j >>= 1)
#pragma unroll
        for (int i = 0; i < 16; ++i) { const int l = i ^ j; if (l > i) ce_desc(top[i], top[l]); }
}

struct PeerArgs { unsigned char* H8out_xq; unsigned char* H8out; const float* S; const bf16_t* Hin; const unsigned char* U; const unsigned char* V; const float* SU; const float* SV; const float* Xin; float* Xout;
                  const float* g2l; const float* g2c;
                  bf16_t* Hout; const float* nwn; const float* shl; const float* scl; const float* shc; const float* scc;
                  float* fout; const float* fnw;
                  int nblocks; int* dbg_eid; float* dbg_gt; bool dry; int route_reps; const float* SXG; };
struct PeerBufs;
constexpr int PL_LISTS = 0, PL_EID = 40960, PL_GT = PL_EID + 16384;
__device__ __forceinline__ float dot2bf(unsigned a, unsigned b, float acc) { return __builtin_amdgcn_fdot2_f32_bf16(__builtin_bit_cast(bf16x2_t, a), __builtin_bit_cast(bf16x2_t, b), acc, false); }
__device__ __forceinline__ float dot8(const v4u a, const v4u b, float acc) {
    const unsigned a0 = a.x, a1 = a.y, a2 = a.z, a3 = a.w, b0 = b.x, b1 = b.y, b2 = b.z, b3 = b.w;
    acc = dot2bf(a0, b0, acc); acc = dot2bf(a1, b1, acc); acc = dot2bf(a2, b2, acc); acc = dot2bf(a3, b3, acc);
    return acc;
}
struct PeerBufs { int* eid; float* gt; float* a; unsigned char* xq; float* sx; };
__device__ __forceinline__ void peer_route(Frame& F, const PeerArgs& P, const PeerBufs& B) {
    const int tid = ltid(F.wave), lane = tid & 63;
    LAS unsigned* lists = (LAS unsigned*)(F.lds + PL_LISTS);
    LAS int* eid = (LAS int*)(F.lds + PL_EID);
    LAS float* gt = (LAS float*)(F.lds + PL_GT);
    for (int blk = F.vcu; blk < P.nblocks; blk += F.G) {
        const int row0 = blk * 32;
        {
            const int tok = tid >> 4, lst = tid & 15;
            const float* sp = P.S + (size_t)(row0 + tok) * 2048 + lst * 128;
            float top[16];
#pragma unroll 1
            for (int c = 0; c < 8; ++c) {
                float x[16];
#pragma unroll
                for (int q = 0; q < 4; ++q) { const f32x4 v = *(const f32x4*)(sp + c * 16 + q * 4);
#pragma unroll
                    for (int j = 0; j < 4; ++j) x[q * 4 + j] = __uint_as_float((__float_as_uint(v[j]) & ~127u) | (unsigned)(c * 16 + q * 4 + j)); }
                sort16_desc(x);
                if (c == 0) {
#pragma unroll
                    for (int i = 0; i < 16; ++i) top[i] = x[i];
                } else merge16_desc(top, x);
            }
            LAS unsigned* lp = lists + tid * 20;
#pragma unroll
            for (int q = 0; q < 4; ++q) *(LAS v4u*)(lp + q * 4) = (v4u){__float_as_uint(top[q * 4]), __float_as_uint(top[q * 4 + 1]), __float_as_uint(top[q * 4 + 2]), __float_as_uint(top[q * 4 + 3])};
        }
        __syncthreads();
        if (tid < 256) {
            const int tok = tid >> 3, hd = tid & 7;
            const LAS unsigned* la = lists + (tok * 16 + 2 * hd) * 20; const LAS unsigned* lb = la + 20;
            float av[16], bv[16];
#pragma unroll
            for (int q = 0; q < 4; ++q) { const v4u a = *(const LAS v4u*)(la + q * 4), b = *(const LAS v4u*)(lb + q * 4);
#pragma unroll
                for (int j = 0; j < 4; ++j) { av[q * 4 + j] = __uint_as_float(a[j] & ~127u); bv[q * 4 + j] = __uint_as_float(b[j] & ~127u); } }
            float c0[16], c1[16], c2[16], c3[16];
#pragma unroll
            for (int i = 0; i < 16; ++i) { c0[i] = -INFINITY; c1[i] = -INFINITY; c2[i] = -INFINITY; c3[i] = -INFINITY; }
            {
                int cnt = 0;
#pragma unroll
                for (int i = 0; i < 16; ++i)
#pragma unroll
                    for (int j = 0; j < 16; ++j) if ((i + 1) * (j + 1) <= 16) {
                        const float sm = __uint_as_float((__float_as_uint(av[i] + bv[j]) & ~255u) | (unsigned)(i * 16 + j));
                        const int slot = cnt & 15, arr = cnt >> 4;
                        if (arr == 0) c0[slot] = sm; else if (arr == 1) c1[slot] = sm; else if (arr == 2) c2[slot] = sm; else c3[slot] = sm;
                        ++cnt;
                    }
            }
            sort16_desc(c0); sort16_desc(c1); sort16_desc(c2); sort16_desc(c3);
            merge16_desc(c0, c1); merge16_desc(c0, c2); merge16_desc(c0, c3);
            float ev[16], sum = 0.f; const float m0 = __uint_as_float(__float_as_uint(c0[0]) & ~255u);
#pragma unroll
            for (int k = 0; k < 16; ++k) { ev[k] = fast_exp2((__uint_as_float(__float_as_uint(c0[k]) & ~255u) - m0) * LOG2E); sum += ev[k]; }
            const float rs = 1.0f / sum;
#pragma unroll
            for (int k = 0; k < 16; ++k) { const unsigned code = __float_as_uint(c0[k]) & 255u;
                const int ia = (int)(la[code >> 4] & 127u), ib = (int)(lb[code & 15u] & 127u);
                eid[tok * 128 + hd * 16 + k] = ia * NKEYS + ib; gt[tok * 128 + hd * 16 + k] = ev[k] * rs; }
        }
        __syncthreads();
#pragma unroll
        for (int i = 0; i < 8; ++i) { const int idx = i * NTHREADS + tid; B.eid[(size_t)row0 * 128 + idx] = eid[idx]; B.gt[(size_t)row0 * 128 + idx] = gt[idx]; }
#pragma unroll 1
        for (int tk = 0; tk < 4; ++tk) {
            const size_t row = (size_t)(row0 + F.wave * 4 + tk);
            const bf16_t* hp = P.Hin + row * DM + 16 * lane;
            const v4u h0 = *(const v4u*)hp, h1 = *(const v4u*)(hp + 8);
            float xf[16];
#pragma unroll
            for (int q = 0; q < 4; ++q) { xf[2 * q] = bflo(h0[q]); xf[2 * q + 1] = bfhi(h0[q]); xf[8 + 2 * q] = bflo(h1[q]); xf[8 + 2 * q + 1] = bfhi(h1[q]); }
            float am = 0.f;
#pragma unroll
            for (int i = 0; i < 16; ++i) am = __builtin_fmaxf(am, __builtin_fabsf(xf[i]));
            am = wave_max(am);
            const float ix = am > 0.f ? 127.f / am : 0.f;
            v4u xq;
#pragma unroll
            for (int q = 0; q < 4; ++q) { unsigned w = 0;
#pragma unroll
                for (int j = 0; j < 4; ++j) { const int v = (int)__builtin_rintf(xf[4 * q + j] * ix); w |= (unsigned)(v & 0xff) << (8 * j); }
                xq[q] = w; }
            *(v4u*)(B.xq + row * DM + 16 * lane) = xq;
            if (lane == 0) B.sx[row] = am * (1.f / 127.f);
        }
        __syncthreads();
    }
}
__device__ __forceinline__ int wave_isum(int v) {
    v += __builtin_amdgcn_update_dpp(0, v, 0xB1, 0xf, 0xf, false);
    v += __builtin_amdgcn_update_dpp(0, v, 0x4E, 0xf, 0xf, false);
    v += __builtin_amdgcn_update_dpp(0, v, 0x141, 0xf, 0xf, false);
    v += __builtin_amdgcn_update_dpp(0, v, 0x140, 0xf, 0xf, false);
    v += __builtin_amdgcn_update_dpp(0, v, 0x142, 0xa, 0xf, false);
    v += __builtin_amdgcn_update_dpp(0, v, 0x143, 0xc, 0xf, false);
    return __builtin_amdgcn_readlane(v, 63);
}
__device__ __forceinline__ int bperm_i(int v, int srclane) { return __builtin_amdgcn_ds_bpermute(srclane << 2, v); }
__device__ __forceinline__ float bperm_f(float v, int srclane) { return __builtin_bit_cast(float, __builtin_amdgcn_ds_bpermute(srclane << 2, __builtin_bit_cast(int, v))); }
__device__ __forceinline__ int treduce16(const int (&d)[16], int lane) {
    int s8[8], s4[4], s2[2];
#pragma unroll
    for (int i = 0; i < 8; ++i) { auto r = __builtin_amdgcn_permlane32_swap((unsigned)d[i], (unsigned)d[i + 8], false, false); s8[i] = (int)r[0] + (int)r[1]; }
#pragma unroll
    for (int i = 0; i < 4; ++i) { auto r = __builtin_amdgcn_permlane16_swap((unsigned)s8[i], (unsigned)s8[i + 4], false, false); s4[i] = (int)r[0] + (int)r[1]; }
    const bool b3 = (lane & 8) != 0, b2 = (lane & 4) != 0;
#pragma unroll
    for (int i = 0; i < 2; ++i) { const int keep = b3 ? s4[i + 2] : s4[i], send = b3 ? s4[i] : s4[i + 2]; s2[i] = keep + __builtin_amdgcn_update_dpp(0, send, 0x128, 0xf, 0xf, false); }
    int z; { const int keep = b2 ? s2[1] : s2[0], send = b2 ? s2[0] : s2[1]; z = keep + __builtin_amdgcn_ds_swizzle(send, 0x101F); }
    z += __builtin_amdgcn_update_dpp(0, z, 0x4E, 0xf, 0xf, false);
    z += __builtin_amdgcn_update_dpp(0, z, 0xB1, 0xf, 0xf, false);
    return z;
}
__device__ __forceinline__ void peer_u(Frame& F, const PeerArgs& P, const PeerBufs& B, int ntok) {
    const int lane = ltid(F.wave) & 63;
    const int nsl = 8, wps = (F.G / nsl) * NWAVES;
    const int j = F.vcu / (F.G / nsl), wsl = (F.vcu % (F.G / nsl)) * NWAVES + F.wave;
    const int esel = (lane >> 2) & 15;
    int t = wsl; if (t >= ntok) return;
    int e_lo = B.eid[(size_t)t * 128 + lane], e_hi = B.eid[(size_t)t * 128 + 64 + lane];
    float g_lo = B.gt[(size_t)t * 128 + lane], g_hi = B.gt[(size_t)t * 128 + 64 + lane];
    v4u xq = *(const v4u*)(B.xq + (size_t)t * DM + 16 * lane); float sx = B.sx[t];
    for (;;) {
        const int tn = t + wps; const bool more = tn < ntok; const int tp = more ? tn : t;
        const int ne_lo = B.eid[(size_t)tp * 128 + lane], ne_hi = B.eid[(size_t)tp * 128 + 64 + lane];
        const float ng_lo = B.gt[(size_t)tp * 128 + lane], ng_hi = B.gt[(size_t)tp * 128 + 64 + lane];
        const v4u nxq = *(const v4u*)(B.xq + (size_t)tp * DM + 16 * lane); const float nsx = B.sx[tp];
        unsigned long long m_lo = __ballot((e_lo >> 11) == j), m_hi = __ballot((e_hi >> 11) == j);
        const int n = __popcll(m_lo) + __popcll(m_hi);
        v4u ua[32]; int slotv0 = -1, idv0 = 0, slotv1 = -1, idv1 = 0;
#pragma unroll
        for (int q = 0; q < 32; ++q) {
            ua[q] = (v4u){0u, 0u, 0u, 0u};
            if (q < n) {
                int k, id;
                if (m_lo) { k = __builtin_ctzll(m_lo); m_lo &= m_lo - 1; id = __builtin_amdgcn_readlane(e_lo, k); }
                else { k = __builtin_ctzll(m_hi); m_hi &= m_hi - 1; id = __builtin_amdgcn_readlane(e_hi, k); k += 64; }
                ua[q] = *(const v4u*)(P.U + (size_t)id * DM + 16 * lane);
                if (q < 16) { if (esel == q) { slotv0 = k; idv0 = id; } } else { if (esel == q - 16) { slotv1 = k; idv1 = id; } }
            }
        }
        const float su0 = P.SU[idv0], sv0 = P.SV[idv0], su1 = P.SU[idv1], sv1 = P.SV[idv1];
        const float gl0 = bperm_f(g_lo, slotv0 & 63), gh0 = bperm_f(g_hi, slotv0 & 63), gl1 = bperm_f(g_lo, slotv1 & 63), gh1 = bperm_f(g_hi, slotv1 & 63);
        const float gg0 = slotv0 < 64 ? gl0 : gh0, gg1 = slotv1 < 64 ? gl1 : gh1;
        int d[16];
#pragma unroll
        for (int q = 0; q < 16; ++q) { int di = __builtin_amdgcn_sdot4((int)ua[q][0], (int)xq[0], 0, false); di = __builtin_amdgcn_sdot4((int)ua[q][1], (int)xq[1], di, false);
            di = __builtin_amdgcn_sdot4((int)ua[q][2], (int)xq[2], di, false); d[q] = __builtin_amdgcn_sdot4((int)ua[q][3], (int)xq[3], di, false); }
        { const int z = treduce16(d, lane);
          if (slotv0 >= 0 && (lane & 3) == 0) B.a[(size_t)t * 128 + slotv0] = gg0 * gelu_tanh((float)z * su0 * sx) * sv0; }
        if (n > 16) {
#pragma unroll
            for (int q = 0; q < 16; ++q) { int di = __builtin_amdgcn_sdot4((int)ua[16 + q][0], (int)xq[0], 0, false); di = __builtin_amdgcn_sdot4((int)ua[16 + q][1], (int)xq[1], di, false);
                di = __builtin_amdgcn_sdot4((int)ua[16 + q][2], (int)xq[2], di, false); d[q] = __builtin_amdgcn_sdot4((int)ua[16 + q][3], (int)xq[3], di, false); }
            const int z = treduce16(d, lane);
            if (slotv1 >= 0 && (lane & 3) == 0) B.a[(size_t)t * 128 + slotv1] = gg1 * gelu_tanh((float)z * su1 * sx) * sv1;
        }
        if (n > 32) {
            while (m_lo | m_hi) { int k, id;
                if (m_lo) { k = __builtin_ctzll(m_lo); m_lo &= m_lo - 1; id = __builtin_amdgcn_readlane(e_lo, k); }
                else { k = __builtin_ctzll(m_hi); m_hi &= m_hi - 1; id = __builtin_amdgcn_readlane(e_hi, k); k += 64; }
                const v4u u1 = *(const v4u*)(P.U + (size_t)id * DM + 16 * lane);
                int di = __builtin_amdgcn_sdot4((int)u1[0], (int)xq[0], 0, false); di = __builtin_amdgcn_sdot4((int)u1[1], (int)xq[1], di, false);
                di = __builtin_amdgcn_sdot4((int)u1[2], (int)xq[2], di, false); di = __builtin_amdgcn_sdot4((int)u1[3], (int)xq[3], di, false);
                const int tot = wave_isum(di);
                const float g = __uint_as_float(k < 64 ? __builtin_amdgcn_readlane(__float_as_uint(g_lo), k) : __builtin_amdgcn_readlane(__float_as_uint(g_hi), k - 64));
                if (lane == 0) B.a[(size_t)t * 128 + k] = g * gelu_tanh((float)tot * P.SU[id] * sx) * P.SV[id]; }
        }
        if (!more) break;
        t = tn; e_lo = ne_lo; e_hi = ne_hi; g_lo = ng_lo; g_hi = ng_hi; xq = nxq; sx = nsx;
    }
}
__device__ __forceinline__ void peer_v(Frame& F, const PeerArgs& P, const PeerBufs& B, int ntok) {
    const int lane = ltid(F.wave) & 63;
    const int nsl = 8, wps = (F.G / nsl) * NWAVES;
    const int j = F.vcu / (F.G / nsl), wsl = (F.vcu % (F.G / nsl)) * NWAVES + F.wave;
    const int grp = lane >> 3, ch = lane & 7;
    int t = wsl; if (t >= ntok) return;
#define PV_HDR(tt, EL, EH, CL, CH) do { EL = B.eid[(size_t)(tt) * 128 + lane]; EH = B.eid[(size_t)(tt) * 128 + 64 + lane]; CL = B.a[(size_t)(tt) * 128 + lane]; CH = B.a[(size_t)(tt) * 128 + 64 + lane]; } while (0)
#define PV_ROWS(W, CF, EL, EH, CL, CH) do { _Pragma("unroll") for (int i = 0; i < 16; ++i) { const int src = (8 * i + grp) & 63; const int id = bperm_i(i < 8 ? EL : EH, src); CF[i] = bperm_f(i < 8 ? CL : CH, src); \
            W[i] = *(const v4u*)(P.V + (size_t)id * DM + 128 * j + 16 * ch); } } while (0)
    int e_lo, e_hi, ne_lo, ne_hi; float c_lo, c_hi, nc_lo, nc_hi;
    v4u wA[16], wB[16]; float cfA[16], cfB[16];
    PV_HDR(t, e_lo, e_hi, c_lo, c_hi);
    { const int t1 = (t + wps < ntok) ? t + wps : t; PV_HDR(t1, ne_lo, ne_hi, nc_lo, nc_hi); }
    PV_ROWS(wA, cfA, e_lo, e_hi, c_lo, c_hi);
#define PV_STEP(W, CF, WN, CFN) do { \
        const int tn = t + wps; const bool more = tn < ntok; \
        if (more) { PV_ROWS(WN, CFN, ne_lo, ne_hi, nc_lo, nc_hi); const int t2 = (tn + wps < ntok) ? tn + wps : tn; PV_HDR(t2, ne_lo, ne_hi, nc_lo, nc_hi); } \
        float acc[16]; float asum = 0.f; \
        _Pragma("unroll") for (int c = 0; c < 16; ++c) acc[c] = 0.f; \
        _Pragma("unroll") for (int i = 0; i < 16; ++i) { asum += CF[i]; const f32x2 cf2 = {CF[i], CF[i]}; \
            _Pragma("unroll") for (int q = 0; q < 4; ++q) { const unsigned x = W[i][q]; \
                const f32x2 v01 = {(float)(x & 0xffu), (float)((x >> 8) & 0xffu)}, v23 = {(float)((x >> 16) & 0xffu), (float)(x >> 24)}; \
                f32x2 o01 = {acc[4 * q], acc[4 * q + 1]}, o23 = {acc[4 * q + 2], acc[4 * q + 3]}; \
                o01 = __builtin_elementwise_fma(cf2, v01, o01); o23 = __builtin_elementwise_fma(cf2, v23, o23); \
                acc[4 * q] = o01.x; acc[4 * q + 1] = o01.y; acc[4 * q + 2] = o23.x; acc[4 * q + 3] = o23.y; } } \
        asum += __builtin_bit_cast(float, __builtin_amdgcn_update_dpp(0, __builtin_bit_cast(int, asum), 0x128, 0xf, 0xf, false)); asum += xorf<16>(asum); asum = x32_sum(asum); \
        _Pragma("unroll") for (int c = 0; c < 16; ++c) { acc[c] += __builtin_bit_cast(float, __builtin_amdgcn_update_dpp(0, __builtin_bit_cast(int, acc[c]), 0x128, 0xf, 0xf, false)); acc[c] += xorf<16>(acc[c]); acc[c] = x32_sum(acc[c]); } \
        if (lane < 8) { \
            const int col0 = 128 * j + 16 * lane; const float* g2 = (t < SEQ) ? P.g2l : P.g2c; \
            _Pragma("unroll") for (int q = 0; q < 4; ++q) { const f32x4 xo = *(const f32x4*)(P.Xin + (size_t)t * DM + col0 + 4 * q), g = *(const f32x4*)(g2 + col0 + 4 * q); \
                f32x4 y; y.x = xo.x + g.x * (acc[4 * q] - 128.f * asum); y.y = xo.y + g.y * (acc[4 * q + 1] - 128.f * asum); y.z = xo.z + g.z * (acc[4 * q + 2] - 128.f * asum); y.w = xo.w + g.w * (acc[4 * q + 3] - 128.f * asum); \
                *(f32x4*)(P.Xout + (size_t)t * DM + col0 + 4 * q) = y; } \
        } \
        done = !more; t = tn; } while (0)
    bool done = false;
    for (;;) {
        PV_STEP(wA, cfA, wB, cfB); if (done) break;
        PV_STEP(wB, cfB, wA, cfA); if (done) break;
    }
#undef PV_HDR
#undef PV_ROWS
#undef PV_STEP
}
__device__ __forceinline__ void peer_norm(Frame& F, const PeerArgs& P, int ntok) {
    const int lane = ltid(F.wave) & 63; const int gw = F.vcu * NWAVES + F.wave, NGW = F.G * NWAVES;
    for (int t = gw; t < ntok; t += NGW) {
        const bool latent = t < SEQ;
        if (P.fout) {
            const GAS f32x4* xr = (const GAS f32x4*)(P.Xout + (size_t)t * DM) + lane; f32x4 v[4]; float s = 0.f;
#pragma unroll
            for (int q = 0; q < 4; ++q) { v[q] = xr[64 * q]; s += (v[q].x * v[q].x + v[q].y * v[q].y) + (v[q].z * v[q].z + v[q].w * v[q].w); }
            const float ri = __builtin_amdgcn_rsqf(wave_sum(s) * (1.f / DM) + EPS);
#pragma unroll
            for (int q = 0; q < 4; ++q) { const f32x4 w = *(const f32x4*)(P.fnw + 256 * q + 4 * lane); *(f32x4*)(P.fout + (size_t)t * DM + 256 * q + 4 * lane) = v[q] * ri * w; }
        } else modnorm_row(P.Xout + (size_t)t * DM, P.Hout ? P.Hout + (size_t)t * DM : (bf16_t*)nullptr, P.nwn, latent ? P.shl : P.shc, latent ? P.scl : P.scc, lane, P.H8out ? P.H8out + (size_t)t * DM : (unsigned char*)nullptr);
    }
}

constexpr int P2_Y = 0;
constexpr int P2_EID = 73728, P2_GT = P2_EID + 72 * 128 * 2, P2_SX = P2_GT + 72 * 128 * 4, P2_END = P2_SX + 72 * 4;
static_assert(P2_END <= RING_BYTES, "peer2 LDS map");
template <int NTK> __device__ __forceinline__ void peer2_tokens(Frame& F, const PeerArgs& P, int t_begin, int lt0, int cnt, int lane_in) {
    int lane = lane_in; asm volatile("" : "+v"(lane));
    const LAS unsigned short* eidL = (const LAS unsigned short*)(F.lds + P2_EID); LAS float* gtL = (LAS float*)(F.lds + P2_GT); const LAS float* sxL = (const LAS float*)(F.lds + P2_SX);
#define g (lane >> 3)
#define c (lane & 7)
    const unsigned char* xqb = P.H8out_xq;
    int d[NTK][16];
#pragma unroll
    for (int tk = 0; tk < NTK; ++tk)
#pragma unroll
        for (int i = 0; i < 16; ++i) d[tk][i] = 0;
#pragma unroll 1
    for (int ps = 0; ps < 8; ++ps) {
#pragma unroll
        for (int tk = 0; tk < NTK; ++tk) {
            if (tk < cnt) {
                const int lt = lt0 + tk; const unsigned row = (unsigned)(t_begin + lt);
                const v4u xq = *(const v4u*)(xqb + (unsigned)(row * DM + 128 * ps + 16 * c));
                v4u ua[16];
#pragma unroll
                for (int i = 0; i < 16; ++i) { const int id = eidL[lt * 128 + 8 * i + g]; ua[i] = *(const v4u*)(P.U + (unsigned)((ps * NEXP + id) * 128 + 16 * c)); }
#pragma unroll
                for (int i = 0; i < 16; ++i) { int di = __builtin_amdgcn_sdot4((int)ua[i][0], (int)xq[0], d[tk][i], false); di = __builtin_amdgcn_sdot4((int)ua[i][1], (int)xq[1], di, false);
                    di = __builtin_amdgcn_sdot4((int)ua[i][2], (int)xq[2], di, false); d[tk][i] = __builtin_amdgcn_sdot4((int)ua[i][3], (int)xq[3], di, false); }
                __builtin_amdgcn_sched_barrier(0);
            }
        }
    }
    asm volatile("" : "+v"(lane));
#pragma unroll
    for (int tk = 0; tk < NTK; ++tk) {
        if (tk < cnt) {
            const int lt = lt0 + tk; const float sx = sxL[lt];
            int mine0 = 0, mine1 = 0;
#pragma unroll
            for (int i = 0; i < 16; ++i) { int v = d[tk][i];
                v += __builtin_amdgcn_update_dpp(0, v, 0xB1, 0xf, 0xf, false); v += __builtin_amdgcn_update_dpp(0, v, 0x4E, 0xf, 0xf, false); v += __builtin_amdgcn_update_dpp(0, v, 0x141, 0xf, 0xf, false);
                if ((i & 7) == c) { if (i < 8) mine0 = v; else mine1 = v; } }
#pragma unroll
            for (int hf = 0; hf < 2; ++hf) { const int e = 8 * (8 * hf + c) + g; const int id = eidL[lt * 128 + e];
                const f32x2 suv = ((const f32x2*)P.SU)[id];
                const float pre = (float)(hf ? mine1 : mine0) * (suv.x * sx);
                gtL[lt * 128 + e] = gtL[lt * 128 + e] * gelu_tanh(pre) * suv.y; }
        }
    }
    LDS_WAIT();
    asm volatile("" : "+v"(lane));
    LAS unsigned char* yL = F.lds + P2_Y + F.wave * (4 * 2048);
#pragma unroll 1
    for (int ps = 0; ps < 8; ++ps) {
#pragma unroll
        for (int tk = 0; tk < NTK; ++tk) {
            if (tk < cnt) {
                const int lt = lt0 + tk; const unsigned row = (unsigned)(t_begin + lt);
                v4u w[16]; float cf[16];
#pragma unroll
                for (int i = 0; i < 16; ++i) { const int id = eidL[lt * 128 + 8 * i + g]; cf[i] = gtL[lt * 128 + 8 * i + g]; w[i] = *(const v4u*)(P.V + (unsigned)((ps * NEXP + id) * 128 + 16 * c)); }
                float acc[16]; float asum = 0.f;
#pragma unroll
                for (int q = 0; q < 16; ++q) acc[q] = 0.f;
#pragma unroll
                for (int i = 0; i < 16; ++i) { asum += cf[i]; const f32x2 cf2 = {cf[i], cf[i]};
#pragma unroll
                    for (int q = 0; q < 4; ++q) { const unsigned x = w[i][q];
                        const f32x2 v01 = {(float)(x & 0xffu), (float)((x >> 8) & 0xffu)}, v23 = {(float)((x >> 16) & 0xffu), (float)(x >> 24)};
                        f32x2 o01 = {acc[4 * q], acc[4 * q + 1]}, o23 = {acc[4 * q + 2], acc[4 * q + 3]};
                        o01 = __builtin_elementwise_fma(cf2, v01, o01); o23 = __builtin_elementwise_fma(cf2, v23, o23);
                        acc[4 * q] = o01.x; acc[4 * q + 1] = o01.y; acc[4 * q + 2] = o23.x; acc[4 * q + 3] = o23.y; } }
                asum += __builtin_bit_cast(float, __builtin_amdgcn_update_dpp(0, __builtin_bit_cast(int, asum), 0x128, 0xf, 0xf, false)); asum += xorf<16>(asum); asum = x32_sum(asum);
#pragma unroll
                for (int q = 0; q < 16; ++q) { acc[q] += __builtin_bit_cast(float, __builtin_amdgcn_update_dpp(0, __builtin_bit_cast(int, acc[q]), 0x128, 0xf, 0xf, false)); acc[q] += xorf<16>(acc[q]); acc[q] = x32_sum(acc[q]); }
                if (lane < 8) {
                    v4u y0, y1;
                    y0.x = pk2(acc[0] - 128.f * asum, acc[1] - 128.f * asum); y0.y = pk2(acc[2] - 128.f * asum, acc[3] - 128.f * asum); y0.z = pk2(acc[4] - 128.f * asum, acc[5] - 128.f * asum); y0.w = pk2(acc[6] - 128.f * asum, acc[7] - 128.f * asum);
                    y1.x = pk2(acc[8] - 128.f * asum, acc[9] - 128.f * asum); y1.y = pk2(acc[10] - 128.f * asum, acc[11] - 128.f * asum); y1.z = pk2(acc[12] - 128.f * asum, acc[13] - 128.f * asum); y1.w = pk2(acc[14] - 128.f * asum, acc[15] - 128.f * asum);
                    LAS v4u* yp = (LAS v4u*)(yL + tk * 2048 + (128 * ps + 16 * lane) * 2); yp[0] = y0; yp[1] = y1;
                }
                __builtin_amdgcn_sched_barrier(0);
            }
        }
    }
    asm volatile("" : "+v"(lane));
    LDS_WAIT();
#pragma unroll
    for (int tk = 0; tk < NTK; ++tk) {
        if (tk < cnt) {
            const int lt = lt0 + tk; const unsigned row = (unsigned)(t_begin + lt); const bool latent = row < (unsigned)SEQ;
            const float* g2 = latent ? P.g2l : P.g2c;
            f32x4 xn[4]; float ss = 0.f;
#pragma unroll
            for (int q = 0; q < 4; ++q) { const unsigned col = 256 * q + 4 * lane; const f32x4 xo = __builtin_nontemporal_load((const f32x4*)(P.Xin + (unsigned)(row * DM + col))), gq = *(const f32x4*)(g2 + col);
                const v2u yy = *(const LAS v2u*)(yL + tk * 2048 + col * 2);
                f32x4 y; y.x = xo.x + gq.x * bflo(yy.x); y.y = xo.y + gq.y * bfhi(yy.x); y.z = xo.z + gq.z * bflo(yy.y); y.w = xo.w + gq.w * bfhi(yy.y);
                xn[q] = y; ss += (y.x * y.x + y.y * y.y) + (y.z * y.z + y.w * y.w); }
            const float ri = __builtin_amdgcn_rsqf(wave_sum(ss) * (1.f / DM) + EPS);
            if (P.fout) {
                if (latent) {
#pragma unroll
                    for (int q = 0; q < 4; ++q) { const unsigned col = 256 * q + 4 * lane; const f32x4 wq_ = *(const f32x4*)(P.fnw + col); __builtin_nontemporal_store(xn[q] * ri * wq_, (f32x4*)(P.fout + (unsigned)(row * DM + col))); }
                }
            } else {
                const float* sh = latent ? P.shl : P.shc; const float* sc = latent ? P.scl : P.scc;
#pragma unroll
                for (int q = 0; q < 4; ++q) { const unsigned col = 256 * q + 4 * lane; const f32x4 wn = *(const f32x4*)(P.nwn + col), a = *(const f32x4*)(sc + col), b = *(const f32x4*)(sh + col);
                    __builtin_nontemporal_store(xn[q], (f32x4*)(P.Xout + (unsigned)(row * DM + col)));
                    const f32x4 y = (xn[q] * ri * wn) * (1.0f + a) + b;
                    if (P.Hout) { v2u pk; pk.x = pk2(y.x, y.y); pk.y = pk2(y.z, y.w); *(v2u*)(P.Hout + (unsigned)(row * DM + col)) = pk; }
                    if (P.H8out) *(unsigned*)(P.H8out + (unsigned)(row * DM + col)) = pk4_fp8(y.x, y.y, y.z, y.w); }
            }
        }
    }
}
#undef g
#undef c
__device__ __forceinline__ void peer_phase2(Frame& F, const PeerArgs& P) {
    const int tid = ltid(F.wave), lane = tid & 63;
    LAS unsigned* lists = (LAS unsigned*)(F.lds + PL_LISTS);
    LAS int* eid = (LAS int*)(F.lds + PL_EID);
    LAS float* gt = (LAS float*)(F.lds + PL_GT);
    LAS unsigned short* eidL = (LAS unsigned short*)(F.lds + P2_EID); LAS float* gtL = (LAS float*)(F.lds + P2_GT); LAS float* sxL = (LAS float*)(F.lds + P2_SX);
    const int ntok = P.nblocks * 32, tpc = (ntok + F.G - 1) / F.G, t_begin = F.vcu * tpc, t_end = (t_begin + tpc < ntok) ? t_begin + tpc : ntok;
    if (t_begin >= t_end) return;
    for (int row0 = t_begin; row0 < t_end; row0 += 32) {
        const int nt = (t_end - row0 < 32) ? t_end - row0 : 32;
        for (int rr = 0; rr < P.route_reps; ++rr) {
        if (rr) __syncthreads();
        {
            const int tok = tid >> 4, lst = tid & 15;
            const bf16_t* sp = (const bf16_t*)P.S + (size_t)(row0 + (tok < nt ? tok : nt - 1)) * 2048 + lst * 128;
            float top[16];
            v4u nv[2];
#pragma unroll
            for (int q = 0; q < 2; ++q) nv[q] = *(const v4u*)(sp + q * 8);
#pragma unroll 1
            for (int c = 0; c < 8; ++c) {
                float x[16];
#pragma unroll
                for (int e = 0; e < 16; ++e) { const unsigned w = nv[e >> 3][(e >> 1) & 3];
                    x[e] = __uint_as_float(((e & 1) ? (w & 0xffff0000u) : (w << 16)) | (unsigned)(c * 16 + e)); }
                if (c < 7) {
#pragma unroll
                    for (int q = 0; q < 2; ++q) nv[q] = *(const v4u*)(sp + (c + 1) * 16 + q * 8);
                }
                sort16_desc(x);
                if (c == 0) {
#pragma unroll
                    for (int i = 0; i < 16; ++i) top[i] = x[i];
                } else merge16_desc(top, x);
            }
            LAS unsigned* lp = lists + tid * 20;
#pragma unroll
            for (int q = 0; q < 4; ++q) *(LAS v4u*)(lp + q * 4) = (v4u){__float_as_uint(top[q * 4]), __float_as_uint(top[q * 4 + 1]), __float_as_uint(top[q * 4 + 2]), __float_as_uint(top[q * 4 + 3])};
        }
        __syncthreads();
        if (tid < 256) {
            const int tok = tid >> 3, hd = tid & 7;
            const LAS unsigned* la = lists + (tok * 16 + 2 * hd) * 20; const LAS unsigned* lb = la + 20;
            float av[16], bv[16];
#pragma unroll
            for (int q = 0; q < 4; ++q) { const v4u a = *(const LAS v4u*)(la + q * 4), b = *(const LAS v4u*)(lb + q * 4);
#pragma unroll
                for (int j = 0; j < 4; ++j) { av[q * 4 + j] = __uint_as_float(a[j] & ~127u); bv[q * 4 + j] = __uint_as_float(b[j] & ~127u); } }
            float c0[16], c1[16], c2[16], c3[16];
#pragma unroll
            for (int i = 0; i < 16; ++i) { c0[i] = -INFINITY; c1[i] = -INFINITY; c2[i] = -INFINITY; c3[i] = -INFINITY; }
            {
                int cnt = 0;
#pragma unroll
                for (int i = 0; i < 16; ++i)
#pragma unroll
                    for (int j = 0; j < 16; ++j) if ((i + 1) * (j + 1) <= 16) {
                        const float sm = __uint_as_float((__float_as_uint(av[i] + bv[j]) & ~255u) | (unsigned)(i * 16 + j));
                        const int slot = cnt & 15, arr = cnt >> 4;
                        if (arr == 0) c0[slot] = sm; else if (arr == 1) c1[slot] = sm; else if (arr == 2) c2[slot] = sm; else c3[slot] = sm;
                        ++cnt;
                    }
            }
            sort16_desc(c0); sort16_desc(c1); sort16_desc(c2); sort16_desc(c3);
            merge16_desc(c0, c1); merge16_desc(c0, c2); merge16_desc(c0, c3);
            float ev[16], sum = 0.f; const float m0 = __uint_as_float(__float_as_uint(c0[0]) & ~255u);
#pragma unroll
            for (int k = 0; k < 16; ++k) { ev[k] = fast_exp2((__uint_as_float(__float_as_uint(c0[k]) & ~255u) - m0) * LOG2E); sum += ev[k]; }
            const float rs = 1.0f / sum;
#pragma unroll
            for (int k = 0; k < 16; ++k) { const unsigned code = __float_as_uint(c0[k]) & 255u;
                const int ia = (int)(la[code >> 4] & 127u), ib = (int)(lb[code & 15u] & 127u);
                eid[tok * 128 + hd * 16 + k] = ia * NKEYS + ib; gt[tok * 128 + hd * 16 + k] = ev[k] * rs;
#if SELFCHECK
                if (tok < nt) { P.dbg_eid[(size_t)(row0 + tok) * 128 + hd * 16 + k] = ia * NKEYS + ib; P.dbg_gt[(size_t)(row0 + tok) * 128 + hd * 16 + k] = ev[k] * rs; }
#endif
            }
        }
        }
        __syncthreads();
        { const int lb = row0 - t_begin;
#pragma unroll
          for (int i = 0; i < 8; ++i) { const int idx = i * NTHREADS + tid; if ((idx >> 7) < nt) { eidL[lb * 128 + idx] = (unsigned short)eid[idx]; gtL[lb * 128 + idx] = gt[idx]; } }
          if (tid < nt) sxL[lb + tid] = P.SXG[row0 + tid];
        }
        __syncthreads();
    }
    asm volatile("s_waitcnt vmcnt(0)" ::: "memory"); __syncthreads();
    const int ntot = t_end - t_begin;
#pragma unroll 1
    for (int gi = 0; gi < 2; ++gi) { const int lt0 = F.wave * 4 + 32 * gi; int cnt = ntot - lt0; cnt = cnt < 0 ? 0 : (cnt > 4 ? 4 : cnt); if (cnt > 0) peer2_tokens<4>(F, P, t_begin, lt0, cnt, lane); }
    if (ntot > 64 && F.wave == 0) peer2_tokens<1>(F, P, t_begin, 64, 1, lane);
}

__device__ __forceinline__ void peer_phase(Frame& F, const PeerArgs& P) {
    const int tid = ltid(F.wave), lane = tid & 63;
    LAS unsigned* lists = (LAS unsigned*)(F.lds + PL_LISTS);
    LAS int* eid = (LAS int*)(F.lds + PL_EID);
    LAS float* gt = (LAS float*)(F.lds + PL_GT);
    const int ntok = P.nblocks * 32, tpc = (ntok + F.G - 1) / F.G, t_begin = F.vcu * tpc, t_end = (t_begin + tpc < ntok) ? t_begin + tpc : ntok;
    for (int row0 = t_begin; row0 < t_end; row0 += 32) {
        const int nt = (t_end - row0 < 32) ? t_end - row0 : 32;
        for (int rr = 0; rr < P.route_reps; ++rr) {
        if (rr) __syncthreads();
        {
            const int tok = tid >> 4, lst = tid & 15;
            const bf16_t* sp = (const bf16_t*)P.S + (size_t)(row0 + (tok < nt ? tok : nt - 1)) * 2048 + lst * 128;
            float top[16];
            v4u nv[2];
#pragma unroll
            for (int q = 0; q < 2; ++q) nv[q] = *(const v4u*)(sp + q * 8);
#pragma unroll 1
            for (int c = 0; c < 8; ++c) {
                float x[16];
#pragma unroll
                for (int e = 0; e < 16; ++e) { const unsigned w = nv[e >> 3][(e >> 1) & 3];
                    x[e] = __uint_as_float(((e & 1) ? (w & 0xffff0000u) : (w << 16)) | (unsigned)(c * 16 + e)); }
                if (c < 7) {
#pragma unroll
                    for (int q = 0; q < 2; ++q) nv[q] = *(const v4u*)(sp + (c + 1) * 16 + q * 8);
                }
                sort16_desc(x);
                if (c == 0) {
#pragma unroll
                    for (int i = 0; i < 16; ++i) top[i] = x[i];
                } else merge16_desc(top, x);
            }
            LAS unsigned* lp = lists + tid * 20;
#pragma unroll
            for (int q = 0; q < 4; ++q) *(LAS v4u*)(lp + q * 4) = (v4u){__float_as_uint(top[q * 4]), __float_as_uint(top[q * 4 + 1]), __float_as_uint(top[q * 4 + 2]), __float_as_uint(top[q * 4 + 3])};
        }
        __syncthreads();
        if (tid < 256) {
            const int tok = tid >> 3, hd = tid & 7;
            const LAS unsigned* la = lists + (tok * 16 + 2 * hd) * 20; const LAS unsigned* lb = la + 20;
            float av[16], bv[16];
#pragma unroll
            for (int q = 0; q < 4; ++q) { const v4u a = *(const LAS v4u*)(la + q * 4), b = *(const LAS v4u*)(lb + q * 4);
#pragma unroll
                for (int j = 0; j < 4; ++j) { av[q * 4 + j] = __uint_as_float(a[j] & ~127u); bv[q * 4 + j] = __uint_as_float(b[j] & ~127u); } }
            float c0[16], c1[16], c2[16], c3[16];
#pragma unroll
            for (int i = 0; i < 16; ++i) { c0[i] = -INFINITY; c1[i] = -INFINITY; c2[i] = -INFINITY; c3[i] = -INFINITY; }
            {
                int cnt = 0;
#pragma unroll
                for (int i = 0; i < 16; ++i)
#pragma unroll
                    for (int j = 0; j < 16; ++j) if ((i + 1) * (j + 1) <= 16) {
                        const float sm = __uint_as_float((__float_as_uint(av[i] + bv[j]) & ~255u) | (unsigned)(i * 16 + j));
                        const int slot = cnt & 15, arr = cnt >> 4;
                        if (arr == 0) c0[slot] = sm; else if (arr == 1) c1[slot] = sm; else if (arr == 2) c2[slot] = sm; else c3[slot] = sm;
                        ++cnt;
                    }
            }
            sort16_desc(c0); sort16_desc(c1); sort16_desc(c2); sort16_desc(c3);
            merge16_desc(c0, c1); merge16_desc(c0, c2); merge16_desc(c0, c3);
            float ev[16], sum = 0.f; const float m0 = __uint_as_float(__float_as_uint(c0[0]) & ~255u);
#pragma unroll
            for (int k = 0; k < 16; ++k) { ev[k] = fast_exp2((__uint_as_float(__float_as_uint(c0[k]) & ~255u) - m0) * LOG2E); sum += ev[k]; }
            const float rs = 1.0f / sum;
#pragma unroll
            for (int k = 0; k < 16; ++k) { const unsigned code = __float_as_uint(c0[k]) & 255u;
                const int ia = (int)(la[code >> 4] & 127u), ib = (int)(lb[code & 15u] & 127u);
                eid[tok * 128 + hd * 16 + k] = ia * NKEYS + ib; gt[tok * 128 + hd * 16 + k] = ev[k] * rs;
#if SELFCHECK
                if (tok < nt) { P.dbg_eid[(size_t)(row0 + tok) * 128 + hd * 16 + k] = ia * NKEYS + ib; P.dbg_gt[(size_t)(row0 + tok) * 128 + hd * 16 + k] = ev[k] * rs; }
#endif
            }
        }
        }
        __syncthreads();
#pragma unroll 1
        for (int tk = 0; tk < 4; ++tk) {
            const int tok = F.wave * 4 + tk; if (tok >= nt) break;
            const size_t row = (size_t)(row0 + tok);
            const bool latent = row < (size_t)SEQ;
            const bf16_t* hp = P.Hin + row * DM + 16 * lane;
            const v4u h0 = *(const v4u*)hp, h1 = *(const v4u*)(hp + 8);
            float xf[16];
#pragma unroll
            for (int q = 0; q < 4; ++q) { xf[2 * q] = bflo(h0[q]); xf[2 * q + 1] = bfhi(h0[q]); xf[8 + 2 * q] = bflo(h1[q]); xf[8 + 2 * q + 1] = bfhi(h1[q]); }
            float am = 0.f;
#pragma unroll
            for (int i = 0; i < 16; ++i) am = __builtin_fmaxf(am, __builtin_fabsf(xf[i]));
            am = wave_max(am);
            const float sx = am * (1.f / 127.f), ix = am > 0.f ? 127.f / am : 0.f;
            int xq[4];
#pragma unroll
            for (int q = 0; q < 4; ++q) { int w = 0;
#pragma unroll
                for (int j = 0; j < 4; ++j) { const int v = (int)__builtin_rintf(xf[4 * q + j] * ix); w |= (v & 0xff) << (8 * j); }
                xq[q] = w; }
            float out[16]; float asum = 0.f;
#pragma unroll
            for (int i = 0; i < 16; ++i) out[i] = 0.f;
            const int esel = (lane >> 2) & 15;
#pragma unroll 1
            for (int e0 = 0; e0 < 128; e0 += 16) {
                v4u ua[16], va[16];
#pragma unroll
                for (int k = 0; k < 16; ++k) { const int id = __builtin_amdgcn_readfirstlane(eid[tok * 128 + e0 + k]);
                    ua[k] = *(const v4u*)(P.U + (unsigned)(((lane >> 3) * NEXP + id) * 128 + 16 * (lane & 7))); va[k] = *(const v4u*)(P.V + (unsigned)(((lane >> 3) * NEXP + id) * 128 + 16 * (lane & 7))); }
                const int myid = eid[tok * 128 + e0 + esel]; const float mysu = P.SU[myid], mysv = P.SV[myid], myg = gt[tok * 128 + e0 + esel];
                int d[16];
#pragma unroll
                for (int k = 0; k < 16; ++k) { int di = __builtin_amdgcn_sdot4((int)ua[k][0], xq[0], 0, false); di = __builtin_amdgcn_sdot4((int)ua[k][1], xq[1], di, false);
                    di = __builtin_amdgcn_sdot4((int)ua[k][2], xq[2], di, false); d[k] = __builtin_amdgcn_sdot4((int)ua[k][3], xq[3], di, false); }
                int s8[8], s4[4], s2[2];
#pragma unroll
                for (int i = 0; i < 8; ++i) { auto r = __builtin_amdgcn_permlane32_swap((unsigned)d[i], (unsigned)d[i + 8], false, false); s8[i] = (int)r[0] + (int)r[1]; }
#pragma unroll
                for (int i = 0; i < 4; ++i) { auto r = __builtin_amdgcn_permlane16_swap((unsigned)s8[i], (unsigned)s8[i + 4], false, false); s4[i] = (int)r[0] + (int)r[1]; }
                const bool b3 = (lane & 8) != 0, b2 = (lane & 4) != 0;
#pragma unroll
                for (int i = 0; i < 2; ++i) { const int keep = b3 ? s4[i + 2] : s4[i], send = b3 ? s4[i] : s4[i + 2]; s2[i] = keep + __builtin_amdgcn_update_dpp(0, send, 0x128, 0xf, 0xf, false); }
                int z; { const int keep = b2 ? s2[1] : s2[0], send = b2 ? s2[0] : s2[1]; z = keep + __builtin_amdgcn_ds_swizzle(send, 0x101F); }
                z += __builtin_amdgcn_update_dpp(0, z, 0x4E, 0xf, 0xf, false);
                z += __builtin_amdgcn_update_dpp(0, z, 0xB1, 0xf, 0xf, false);
                const float pre = (float)z * (mysu * sx);
                const float act = myg * gelu_tanh(pre);
#if SELFCHECK
                if ((lane & 3) == 0) P.dbg_gt[(size_t)9 * MiB / 4 + row * 128 + e0 + esel] = gelu_tanh(pre);
#endif
                const float cfl = act * mysv;
#pragma unroll
                for (int k = 0; k < 16; ++k) {
                    const float cf = __uint_as_float(__builtin_amdgcn_readlane(__float_as_uint(cfl), 4 * k));
                    asum += cf;
                    const f32x2 cf2 = {cf, cf};
#pragma unroll
                    for (int q = 0; q < 4; ++q) { const unsigned w = va[k][q];
                        const f32x2 v01 = {(float)(w & 0xffu), (float)((w >> 8) & 0xffu)}, v23 = {(float)((w >> 16) & 0xffu), (float)(w >> 24)};
                        f32x2 o01 = {out[4 * q], out[4 * q + 1]}, o23 = {out[4 * q + 2], out[4 * q + 3]};
                        o01 = __builtin_elementwise_fma(cf2, v01, o01); o23 = __builtin_elementwise_fma(cf2, v23, o23);
                        out[4 * q] = o01.x; out[4 * q + 1] = o01.y; out[4 * q + 2] = o23.x; out[4 * q + 3] = o23.y; }
                }
            }
#pragma unroll
            for (int i = 0; i < 16; ++i) out[i] -= 128.f * asum;
            const float* g2 = latent ? P.g2l : P.g2c;
            float xn[16]; float ss = 0.f;
#pragma unroll
            for (int q = 0; q < 4; ++q) { const int col = 16 * lane + 4 * q; const f32x4 xo = *(const f32x4*)(P.Xin + row * DM + col), g = *(const f32x4*)(g2 + col);
#pragma unroll
                for (int j = 0; j < 4; ++j) { const float v = xo[j] + g[j] * out[4 * q + j]; xn[4 * q + j] = v; ss += v * v; } }
            const float ri = __builtin_amdgcn_rsqf(wave_sum(ss) * (1.f / DM) + EPS);
            if (P.dry) {
                if (ri == 12345.678f) P.Xout[row * DM] = ri;
            } else if (P.fout) {
                if (latent) {
#pragma unroll
                    for (int q = 0; q < 4; ++q) { const int col = 16 * lane + 4 * q; const f32x4 w = *(const f32x4*)(P.fnw + col);
                        f32x4 y; y.x = xn[4 * q] * ri * w.x; y.y = xn[4 * q + 1] * ri * w.y; y.z = xn[4 * q + 2] * ri * w.z; y.w = xn[4 * q + 3] * ri * w.w;
                        *(f32x4*)(P.fout + row * DM + col) = y; }
                }
            } else {
                const float* sh = latent ? P.shl : P.shc; const float* sc = latent ? P.scl : P.scc;
                unsigned hw[8], h8[4];
#pragma unroll
                for (int q = 0; q < 4; ++q) { const int col = 16 * lane + 4 * q;
                    *(f32x4*)(P.Xout + row * DM + col) = (f32x4){xn[4 * q], xn[4 * q + 1], xn[4 * q + 2], xn[4 * q + 3]};
                    const f32x4 w = *(const f32x4*)(P.nwn + col), a = *(const f32x4*)(sc + col), b = *(const f32x4*)(sh + col);
                    float y[4];
#pragma unroll
                    for (int j = 0; j < 4; ++j) y[j] = (xn[4 * q + j] * ri * w[j]) * (1.0f + a[j]) + b[j];
                    hw[2 * q] = pk2(y[0], y[1]); hw[2 * q + 1] = pk2(y[2], y[3]); h8[q] = pk4_fp8(y[0], y[1], y[2], y[3]); }
                if (P.Hout) { *(v4u*)(P.Hout + row * DM + 16 * lane) = (v4u){hw[0], hw[1], hw[2], hw[3]};
                    *(v4u*)(P.Hout + row * DM + 16 * lane + 8) = (v4u){hw[4], hw[5], hw[6], hw[7]}; }
                if (P.H8out) *(v4u*)(P.H8out + row * DM + 16 * lane) = (v4u){h8[0], h8[1], h8[2], h8[3]};
            }
        }
        __syncthreads();
    }
}
__device__ __forceinline__ float lam_init_of(int l) { return l == 0 ? 0.2f : 0.35550906765f; }

#ifndef PHASE_MASK
#define PHASE_MASK 0xffff
#endif
#define PH(n) ((PHASE_MASK >> (n)) & 1)
#define REPS(n) (1 + ((dupmask >> (n)) & 1))
__global__ void __launch_bounds__(NTHREADS, 2) trunk_fwd(Args args) {
    extern __shared__ __attribute__((aligned(16))) unsigned char lds[];
    Frame F;
    F.lds = (LAS unsigned char*)lds;
    F.MISC = (volatile LAS unsigned*)(F.lds + MISC_OFF);
    F.wave = __builtin_amdgcn_readfirstlane((int)threadIdx.x >> 6);
    F.G = gridDim.x; { const int bx = blockIdx.x; F.vcu = (F.G % 8 == 0) ? (bx % 8) * (F.G / 8) + bx / 8 : bx; }
    unsigned char* ws = args.ws;
    F.ctl = (gu32*)(ws + WS_CTL);
    for (int u = ltid(F.wave); u < (LDS_BYTES - LDSCTL_OFF) / 4; u += NTHREADS) ((LAS unsigned*)(F.lds + LDSCTL_OFF))[u] = 0u;
    __syncthreads();
    XcdBarrier bar = xcd_barrier_post((unsigned*)(F.ctl + CW_BAR), F.MISC + 8, F.wave);
#ifndef TIMING
#define TIMING 0
#endif
#if TIMING
    int n_stamp = 0;
#define STAMP() do { if (blockIdx.x == 0 && tid_now(F.wave) == 0) ((unsigned long long*)(F.ctl + 1024))[n_stamp] = __builtin_amdgcn_s_memrealtime(); ++n_stamp; } while (0)
#else
#define STAMP() do {} while (0)
#endif
#define GRID_BAR() do { xcd_barrier(bar); STAMP(); asm volatile("" : "+s"(ws)); } while (0)
    STAMP();

    const float* const* in = args.in;
    const int dupmask = args.flags;
#define modv ((float*)(ws + WS_CONST))
#define lamv (modv + 2 * 2 * 6144)
#define WIN ((bf16_t*)(ws + WS_WIN))
#define WGATE ((bf16_t*)(ws + WS_WGATE))
#define WBR ((bf16_t*)(ws + WS_WBR))
#define WOUT ((bf16_t*)(ws + WS_WOUT))
#define WSC ((bf16_t*)(ws + WS_WSC))
#define X ((float*)(ws + WS_X))
#define H ((bf16_t*)(ws + WS_H))
#define YS ((bf16_t*)(ws + WS_YS))
#define MIX YS
#define Qb ((bf16_t*)(ws + WS_Q))
#define Kb ((bf16_t*)(ws + WS_K))
#define Vb ((bf16_t*)(ws + WS_V))
#define BP ((bf16_t*)(ws + WS_R1))
#define SB ((float*)(ws + WS_R1))
    const int gw = F.vcu * NWAVES + F.wave, NGW = F.G * NWAVES;

    for (int rep = 0; rep < REPS(0); ++rep) {
        const int tid = ltid(F.wave), lane = tid & 63;
        LAS float* scr = (LAS float*)(F.lds + F.wave * 16384);
        for (int un = F.vcu; un < 2 * 128; un += F.G) {
            const int l = un >> 7, col = (un & 127) * 48 + lane; const bool act = lane < 48;
            const float* W = in[I_ADAW] + (size_t)l * DM * 6144;
            float a0 = 0.f, a1 = 0.f;
            if (act) {
#pragma unroll 16
                for (int k = 128 * F.wave; k < 128 * F.wave + 128; ++k) { const float w = W[(size_t)k * 6144 + col]; const float c0 = in[I_C][k], c1 = in[I_CCTX][k];
                    a0 += c0 * sigmoidf_(c0) * w; a1 += c1 * sigmoidf_(c1) * w; }
            }
            LAS float* red = (LAS float*)(F.lds);
            red[(F.wave * 64 + lane) * 2] = a0; red[(F.wave * 64 + lane) * 2 + 1] = a1;
            __syncthreads();
            if (F.wave == 0 && act) { float s0 = in[I_ADAB][l * 6144 + col], s1 = s0;
#pragma unroll
                for (int w = 0; w < 8; ++w) { s0 += red[(w * 64 + lane) * 2]; s1 += red[(w * 64 + lane) * 2 + 1]; }
                modv[(l * 2 + 0) * 6144 + col] = s0; modv[(l * 2 + 1) * 6144 + col] = s1; }
            __syncthreads();
        }
        if (blockIdx.x == 0 && tid < 2) { const float* lf = in[I_DLAM] + tid * 128; float s0 = 0.f, s1 = 0.f;
            for (int i = 0; i < 32; ++i) { s0 += lf[i] * lf[32 + i]; s1 += lf[64 + i] * lf[96 + i]; }
            lamv[tid] = expf(s0) - expf(s1) + lam_init_of(tid); }
        constexpr int I_IN = 16 * 80, I_GT = 16 * 128, I_BR = 4 * 32, I_OT = 16 * 32;
        constexpr int NITEMS = 2 * I_IN + 2 * I_GT + 8 * I_BR + 2 * I_OT;
        unsigned char* W8IN = ws + WS_W8IN; unsigned char* W8GATE = ws + WS_W8GATE;
        for (int it = gw; it < NITEMS; it += NGW) {
            int r = it;
            if (r < 2 * I_IN) { const int l = r / I_IN; transpose_item<MapWin, true>(in[I_WIN] + (size_t)l * DM * NQKV, DM, NQKV, W8IN + (size_t)l * NQKV * DM, MapWin(), scr, r % I_IN, lane); continue; } r -= 2 * I_IN;
            if (r < 2 * I_GT) { const int l = r / I_GT; transpose_item<MapGate, true>(in[I_WGATE] + (size_t)l * DM * 4096, DM, 4096, W8GATE + (size_t)l * 4096 * DM, MapGate(), scr, r % I_GT, lane); continue; } r -= 2 * I_GT;
            if (r < 8 * I_BR) { const int lb = r / I_BR; transpose_item(in[I_WBR] + (size_t)lb * 256 * DM, 256, DM, WBR + (size_t)lb * DM * 256, MapId(), scr, r % I_BR, lane); continue; } r -= 8 * I_BR;
#if MIX8
            { const int l = r / I_OT; transpose_item<MapId, true>(in[I_WOUT] + (size_t)l * DM * DM, DM, DM, ws + WS_W8OUT + (size_t)l * DM * DM, MapId(), scr, r % I_OT, lane); }
#else
            { const int l = r / I_OT; transpose_item(in[I_WOUT] + (size_t)l * DM * DM, DM, DM, WOUT + (size_t)l * DM * DM, MapId(), scr, r % I_OT, lane); }
#endif
        }
        for (int it = gw; it < 2 * 16 * 8 * 64; it += NGW) {
            const int kt = it & 63, nt = (it >> 6) & 7, g = (it >> 9) & 15, l = it >> 13, h = g >> 1, p = g & 1;
            const float* kp = in[I_PKEYS] + ((size_t)((l * 2 + p) * 8 + h) * 128 + nt * 16 + (lane & 15)) * 128 + 4 * (lane >> 4);
            const float* qp = in[I_PWQ] + ((size_t)l * DM + kt * 16 + (lane & 15)) * 2048 + g * 128 + 4 * (lane >> 4);
            f32x4 acc = {0.f, 0.f, 0.f, 0.f};
            f32x4 ka[8], qa[8];
#pragma unroll
            for (int c = 0; c < 8; ++c) { ka[c] = *(const f32x4*)(kp + 16 * c); qa[c] = *(const f32x4*)(qp + 16 * c); }
            __builtin_amdgcn_sched_barrier(0);
#pragma unroll
            for (int c = 0; c < 8; ++c)
#pragma unroll
                for (int j = 0; j < 4; ++j) acc = __builtin_amdgcn_mfma_f32_16x16x4f32(ka[c][j], qa[c][j], acc, 0, 0, 0);
            bf16_t* op = WSC + ((size_t)l * 2048 + g * 128 + nt * 16 + 4 * (lane >> 4)) * DM + kt * 16 + (lane & 15);
#pragma unroll
            for (int r = 0; r < 4; ++r) op[(size_t)r * DM] = (bf16_t)f2bf(acc[r]);
        }
        {
            unsigned char* UQ = (unsigned char*)(ws + WS_UBF); unsigned char* VQ = (unsigned char*)(ws + WS_VBF); float* SU = (float*)(ws + WS_SU); float* SV = (float*)(ws + WS_SV);
            for (int r0 = gw; r0 < 2 * 2 * NEXP; r0 += 4 * NGW) {
                f32x4 v[4][4];
#pragma unroll
                for (int u4 = 0; u4 < 4; ++u4) { const int r = r0 + u4 * NGW; const bool isv = r >= 2 * NEXP; const int rr = isv ? r - 2 * NEXP : r;
                    const float* src = (isv ? in[I_PV] : in[I_PU]) + (size_t)rr * DM + 16 * lane;
#pragma unroll
                    for (int q = 0; q < 4; ++q) v[u4][q] = *(const f32x4*)(src + 4 * q); }
#pragma unroll
                for (int u4 = 0; u4 < 4; ++u4) { const int r = r0 + u4 * NGW; const bool isv = r >= 2 * NEXP; const int rr = isv ? r - 2 * NEXP : r;
                    float am = 0.f;
#pragma unroll
                    for (int q = 0; q < 4; ++q) am = __builtin_fmaxf(am, __builtin_fmaxf(__builtin_fmaxf(__builtin_fabsf(v[u4][q].x), __builtin_fabsf(v[u4][q].y)), __builtin_fmaxf(__builtin_fabsf(v[u4][q].z), __builtin_fabsf(v[u4][q].w))));
                    am = wave_max(am);
                    const float inv = am > 0.f ? 127.f / am : 0.f; const int off = isv ? 128 : 0;
                    v4u w;
#pragma unroll
                    for (int q = 0; q < 4; ++q) { const int a0 = (int)__builtin_rintf(v[u4][q].x * inv) + off, a1 = (int)__builtin_rintf(v[u4][q].y * inv) + off, a2 = (int)__builtin_rintf(v[u4][q].z * inv) + off, a3 = (int)__builtin_rintf(v[u4][q].w * inv) + off;
                        w[q] = (unsigned)(a0 & 0xff) | ((unsigned)(a1 & 0xff) << 8) | ((unsigned)(a2 & 0xff) << 16) | ((unsigned)(a3 & 0xff) << 24); }
                    { const int lyr = rr >> 14, ex = rr & (NEXP - 1);
                      *(v4u*)((isv ? VQ : UQ) + (size_t)lyr * NEXP * DM + (size_t)(((lane >> 3) * NEXP + ex) * 128 + 16 * (lane & 7))) = w; }
                    if (lane == 0) SU[2 * rr + (isv ? 1 : 0)] = am * (1.f / 127.f); }
            }
        }
    }
#if SELFCHECK
    GRID_BAR();
#define CK_RED ((LAS float*)(F.lds))
#define CK_BUF ((LAS float*)(F.lds + 1024))
#define CK_IBUF ((LAS int*)(F.lds + 8192))
#define CK_OBUF ((LAS float*)(F.lds + 20480))
#define CK_SC ((LAS float*)(F.lds + 24576))
    if (blockIdx.x == 0) chk::ck_prologue(in, ws, F.ctl, CK_RED);
    __syncthreads();
#endif
    GRID_BAR();
    { const int lane = ltid(F.wave) & 63;
      for (int r = gw; r < 2 * 2048; r += NGW) {
        const bf16_t* src = WSC + (size_t)r * DM + 16 * lane;
        const v4u h0 = *(const v4u*)src, h1 = *(const v4u*)(src + 8);
        float xf[16];
#pragma unroll
        for (int qq = 0; qq < 4; ++qq) { xf[2 * qq] = bflo(h0[qq]); xf[2 * qq + 1] = bfhi(h0[qq]); xf[8 + 2 * qq] = bflo(h1[qq]); xf[8 + 2 * qq + 1] = bfhi(h1[qq]); }
        float am = 0.f;
#pragma unroll
        for (int i = 0; i < 16; ++i) am = __builtin_fmaxf(am, __builtin_fabsf(xf[i]));
        am = wave_max(am);
        const float ix = am > 0.f ? 127.f / am : 0.f;
        v4u o;
#pragma unroll
        for (int qq = 0; qq < 4; ++qq) { unsigned w = 0;
#pragma unroll
            for (int j = 0; j < 4; ++j) { const int v = (int)__builtin_rintf(xf[4 * qq + j] * ix); w |= (unsigned)(v & 0xff) << (8 * j); }
            o[qq] = w; }
        *(v4u*)(ws + WS_W8S + (size_t)r * DM + 16 * lane) = o;
        if (lane == 0) ((float*)(ws + WS_SWS))[r] = am * (1.f / 127.f); } }
    { const int lane = ltid(F.wave) & 63;
    for (int m = gw; m < MT; m += NGW) {
        const bool lat = m < SEQ; const float* xr = lat ? in[I_X] + (size_t)m * DM : in[I_CTX] + (size_t)(m - SEQ) * DM; const float* mv = modv + (lat ? 0 : 6144);
        modnorm_row(xr, SELFCHECK ? H + (size_t)m * DM : (bf16_t*)nullptr, in[I_N1W], mv, mv + 1024, lane, ws + WS_H8 + (size_t)m * DM);
    } }
    GRID_BAR();
#if SELFCHECK
    if (blockIdx.x < 5) { const int r = blockIdx.x == 0 ? 0 : blockIdx.x == 1 ? 777 : blockIdx.x == 2 ? 16383 : blockIdx.x == 3 ? 16384 : 16639;
        const bool lat = r < SEQ; const float* mv = modv + (lat ? 0 : 6144);
        chk::ck_modnorm(lat ? in[I_X] + (size_t)r * DM : in[I_CTX] + (size_t)(r - SEQ) * DM, H + (size_t)r * DM, in[I_N1W], mv, mv + 1024, F.ctl, 2, CK_RED); }
    GRID_BAR();
#endif

#pragma unroll 1
    for (int l = 0; l < 2; ++l) {
#define modl (modv + (size_t)(l * 2) * 6144)
#define modc (modl + 6144)
        const int nMr = (l == 0) ? MT / 256 : SEQ / 256;
        for (int rep = 0; rep < REPS(2); ++rep) {
            if (rep) GRID_BAR();
            pg8::Gemm g{ws + WS_H8, ws + WS_W8IN + (size_t)l * NQKV * DM, MT / 256, NQKV / 256, DM, DM, DM, 0, 0, 1};
            pg8::StaticOrder S; S.init(g, F.G, (int)blockIdx.x);
            pg8::EpiQKV E{Qb, Kb, Vb, in[I_QKNW] + l * 128};
            pg8::gemm_phase<pg8::EpiQKV, true>(F.lds, g, S, E, F.wave);
        }
        GRID_BAR();
#if SELFCHECK
        if (blockIdx.x < 4) { const int b = blockIdx.x; const int r = b == 0 ? 5 : b == 1 ? 8400 : b == 2 ? 16383 : 16391; chk::ck_qkv(l, r, in, ws, F.ctl, CK_RED, CK_BUF); }
        GRID_BAR();
#endif
        for (int rep = 0; rep < REPS(4); ++rep) {
            if (rep) GRID_BAR();
            char* shm = (char*)lds;
            const float lam = lamv[l];
            for (int ui = F.vcu; ui < 256; ui += F.G) {
                const int h = (ui >> 5) & 3, qb = ((ui >> 7) << 5) | (ui & 31);
                const int njobs = (l == 0 && ui < 16) ? (((ui >> 2) == 1) ? 7 : 6) : 5;
#pragma unroll 1
                for (int j = 0; j < njobs; ++j) {
                    att::AU u; int mode = 0;
                    u.sinkl2 = -INFINITY; u.emode = 0; u.lam = 0.f; u.oscale = 1.f; u.subw = in[I_SUBW] + l * 64; u.kbase = 0; u.q0 = qb * 256; u.NT = 260;
                    int qh, kh, oc;
                    if (j == 0)      { qh = 16 + h; kh = 10 + (h >> 1); oc = 768 + h * 64; }
                    else if (j == 1) { qh = 4 + 2 * h; kh = 4 + h; oc = 256 + h * 64; u.emode = 1; }
                    else if (j == 2) { qh = 5 + 2 * h; kh = 4 + h; oc = 256 + h * 64; u.emode = 2; u.lam = lam; u.oscale = 1.f - lam_init_of(l); }
                    else if (j == 3) { qh = h; kh = h; oc = h * 64; mode = 1; u.NT = 16; int B = 4 * qb - 4; B = B < 0 ? 0 : (B > 244 ? 244 : B); u.kbase = 64 * B; }
                    else if (j == 4) { qh = 12 + h; kh = 8 + (h >> 1); oc = 512 + h * 64; mode = 2; u.NT = 12; u.kbase = 256 * qb - 128; u.sinkl2 = in[I_SINK][l * 4 + h] * LOG2E; }
                    else {
                        const int mx = ui >> 2, hc = ui & 3; u.q0 = SEQ; u.NT = 4;
                        if (mx == 0)      { qh = hc; kh = hc; oc = hc * 64; }
                        else if (mx == 1) { qh = 4 + 2 * hc + (j - 5); kh = 4 + hc; oc = 256 + hc * 64; u.emode = (j == 5) ? 1 : 2; u.lam = lam; u.oscale = 1.f - lam_init_of(l); }
                        else if (mx == 2) { qh = 12 + hc; kh = 8 + (hc >> 1); oc = 512 + hc * 64; u.sinkl2 = in[I_SINK][l * 4 + hc] * LOG2E; }
                        else              { qh = 16 + hc; kh = 10 + (hc >> 1); oc = 768 + hc * 64; }
                    }
                    u.Q = (const att::bf16*)(Qb + (size_t)qh * MT * 64); u.K = (const att::bf16*)(Kb + (size_t)kh * MT * 64); u.V = (const att::bf16*)(Vb + (size_t)kh * MT * 64);
                    u.O = (att::bf16*)(YS + oc);
#ifndef ATT_MODES
#define ATT_MODES 7
#endif
                    if ((ATT_MODES & 2) && mode == 1) {
                        float* rp = (float*)(shm + att::LDS_RPB);
                        for (int i = ltid(F.wave); i < 15 * 32; i += NTHREADS) { const int c = i & 31; rp[i] = (c < 31) ? in[I_RPB][((size_t)(l * 4 + h) * 15 + (i >> 5)) * 31 + c] * LOG2E : 0.f; }
                        __syncthreads();
                        if (!att::attn_simple<1, 1>(u, shm, F.wave)) att::attn_simple<1>(u, shm, F.wave);
                    } else if ((ATT_MODES & 4) && mode == 2) { if (!att::attn_unit<2, 8, 0, 1>(u, shm, F.wave)) att::attn_unit<2, 8>(u, shm, F.wave); }
                    else if ((ATT_MODES & 1) && j == 1) { if (!att::attn_unit<0, 8, 1, 1>(u, shm, F.wave)) att::attn_unit<0, 8, 1>(u, shm, F.wave); }
                    else if ((ATT_MODES & 1) && j == 2) { if (!att::attn_unit<0, 8, 2, 1>(u, shm, F.wave)) att::attn_unit<0, 8, 2>(u, shm, F.wave); }
                    else if (ATT_MODES & 1) { if (!att::attn_unit<0, 8, 0, 1>(u, shm, F.wave)) att::attn_unit<0, 8>(u, shm, F.wave); }
                }
            }
        }
        GRID_BAR();
#if SELFCHECK
        if (blockIdx.x < 80) { const int b = blockIdx.x, ri = b >> 4; const int r = ri == 0 ? 3 : ri == 1 ? 4227 : ri == 2 ? 16319 : ri == 3 ? 9000 : 16484; chk::ck_attn(l, (b >> 2) & 3, b & 3, r, in, ws, F.ctl, CK_RED, CK_SC, CK_OBUF); }
        GRID_BAR();
#endif
        for (int rep = 0; rep < REPS(5); ++rep) {
            if (rep) GRID_BAR();
            pg8::Gemm g{YS, WBR + (size_t)l * 4 * DM * 256, nMr, 16, 256, DM, 256, 2, 512, 2};
            pg8::StaticOrder S; S.init(g, F.G, (int)blockIdx.x);
#if BP8
            pg8::EpiBranch8 E{(unsigned char*)BP};
            pg8::gemm_phase<pg8::EpiBranch8>(F.lds, g, S, E, F.wave);
#else
            pg8::EpiBranch E{BP};
            pg8::gemm_phase<pg8::EpiBranch>(F.lds, g, S, E, F.wave);
#endif
        }
        GRID_BAR();
#if SELFCHECK
        if (blockIdx.x < 3) { const int b = blockIdx.x; chk::ck_branch(l, b == 0 ? 1 : b == 1 ? 16383 : 16390, in, ws, F.ctl, CK_RED); }
        GRID_BAR();
#endif
        for (int rep = 0; rep < REPS(6); ++rep) {
            if (rep) GRID_BAR();
            pg8::Gemm g{ws + WS_H8, ws + WS_W8GATE + (size_t)l * 4096 * DM, nMr, 16, DM, DM, DM, 0, 0, 1};
            pg8::StaticOrder S; S.init(g, F.G, (int)blockIdx.x);
            pg8::EpiGate E{BP, MIX, in[I_BGATE] + l * 4096};
            pg8::gemm_phase<pg8::EpiGate, true>(F.lds, g, S, E, F.wave);
        }
        GRID_BAR();
#if SELFCHECK
        if (blockIdx.x < 3) { const int b = blockIdx.x; chk::ck_gate(l, b == 0 ? 2 : b == 1 ? 9999 : 16385, in, ws, F.ctl, CK_RED); }
        GRID_BAR();
#endif
        for (int rep = 0; rep < (l == 0 ? REPS(7) : 1); ++rep) {
            if (rep) GRID_BAR();
#if MIX8
            pg8::Gemm g{MIX, ws + WS_W8OUT + (size_t)l * DM * DM, nMr, 4, DM, DM, DM, 0, 0, 1};
#else
            pg8::Gemm g{MIX, WOUT + (size_t)l * DM * DM, nMr, 4, DM, DM, DM, 0, 0, 2};
#endif
            pg8::StaticOrder S; S.init(g, F.G, (int)blockIdx.x);
#ifndef FUSE_NORM2
#define FUSE_NORM2 1
#endif
#if FUSE_NORM2
            pg8::EpiOutNorm E{l == 0 ? in[I_X] : X, l == 0 ? in[I_CTX] : X + (size_t)SEQ * DM, X, modl + 2048, modc + 2048,
                              H, in[I_N2W] + l * DM, modl, modc, (gu32*)(ws + WS_CONST + 704 * 1024), F.ctl + 16384 + l * 65 * 64, F.ctl + 16000, F.lds + MISC_OFF + 1024,
                              (gu32*)(ws + WS_XB2), F.ctl + 16384 + (130 + l * 65) * 64, ws + WS_H8, (float*)(ws + WS_SXG)};
#if MIX8
            pg8::gemm_phase<pg8::EpiOutNorm, true, 0x7A7A7A7A>(F.lds, g, S, E, F.wave);
#else
            pg8::gemm_phase<pg8::EpiOutNorm>(F.lds, g, S, E, F.wave);
#endif
#else
            pg8::EpiOut E{l == 0 ? in[I_X] : X, l == 0 ? in[I_CTX] : X + (size_t)SEQ * DM, X, modl + 2048, modc + 2048};
            pg8::gemm_phase<pg8::EpiOut>(F.lds, g, S, E, F.wave);
#endif
        }
        GRID_BAR();
#if SELFCHECK
        if (blockIdx.x < 3) { const int b = blockIdx.x; chk::ck_out(l, b == 0 ? 4 : b == 1 ? 12345 : 16417, in, ws, F.ctl, CK_RED); }
        GRID_BAR();
#endif
#if !FUSE_NORM2
        { const int lane = ltid(F.wave) & 63;
        for (int m = gw; m < nMr * 256; m += NGW) {
            const float* mv = (m < SEQ) ? modl : modc;
            modnorm_row(X + (size_t)m * DM, H + (size_t)m * DM, in[I_N2W] + l * DM, mv + 3072, mv + 4096, lane);
        } }
        GRID_BAR();
#endif
#if SELFCHECK
        if (blockIdx.x < 3) { const int b = blockIdx.x; const int r = b == 0 ? 7 : b == 1 ? 16383 : 16500; const float* mv = (r < SEQ) ? modl : modc;
            chk::ck_modnorm(X + (size_t)r * DM, H + (size_t)r * DM, in[I_N2W] + l * DM, mv + 3072, mv + 4096, F.ctl, 8, CK_RED); }
        GRID_BAR();
#endif
        for (int rep = 0; rep < REPS(9); ++rep) {
            if (rep) GRID_BAR();
            pg8::Gemm g{ws + WS_H8, ws + WS_W8S + (size_t)l * 2048 * DM, nMr, 8, DM, DM, DM, 0, 0, 1};
            pg8::StaticOrder S; S.init(g, F.G, (int)blockIdx.x);
            pg8::EpiS8 E{SB, (const float*)(ws + WS_SXG), (const float*)(ws + WS_SWS) + l * 2048};
            pg8::gemm_phase<pg8::EpiS8, false, 0x7F7F7F7F, true>(F.lds, g, S, E, F.wave);
        }
        GRID_BAR();
#if SELFCHECK
        if (blockIdx.x < 3) { const int b = blockIdx.x; chk::ck_scores(l, b == 0 ? 6 : b == 1 ? 16000 : 16385, in, ws, F.ctl, CK_RED, CK_BUF); }
        GRID_BAR();
#endif
#ifndef PEER_SLICED
#define PEER_SLICED 0
#endif
#if !PEER_SLICED
        for (int rep = 0; rep < REPS(10); ++rep) {
            if (rep) GRID_BAR();
            PeerArgs P; P.dry = (rep + 1 < REPS(10)); P.route_reps = REPS(11);
            P.S = SB; P.Hin = H; P.U = (const unsigned char*)(ws + WS_UBF) + (size_t)l * NEXP * DM; P.V = (const unsigned char*)(ws + WS_VBF) + (size_t)l * NEXP * DM; P.SU = (const float*)(ws + WS_SU) + (size_t)l * 2 * NEXP; P.SV = (const float*)(ws + WS_SV) + l * NEXP; P.Xin = X; P.Xout = X;
            P.g2l = modl + 5120; P.g2c = modc + 5120;
            P.Hout = SELFCHECK ? H : (bf16_t*)nullptr; P.H8out = ws + WS_H8; P.nwn = in[I_N1W] + DM; P.shl = modv + 2 * 6144; P.scl = P.shl + 1024; P.shc = modv + 3 * 6144; P.scc = P.shc + 1024;
            P.fout = (l == 1) ? args.out : nullptr; P.fnw = in[I_FNW];
            P.nblocks = nMr * 8; P.dbg_eid = nullptr; P.dbg_gt = nullptr;
#if SELFCHECK
            if (l == 0) { P.Xout = (float*)(ws + WS_DBG); P.Hout = YS; P.H8out = nullptr; }
            P.dbg_eid = (int*)(ws + WS_VBF + 32 * MiB); P.dbg_gt = (float*)(ws + WS_VBF + 41 * MiB);
#endif
            P.H8out_xq = ws + WS_H8; P.SXG = (const float*)(ws + WS_SXG);
#ifndef PEER_V2
#define PEER_V2 1
#endif
            if (PEER_V2 && !P.dry) peer_phase2(F, P); else peer_phase(F, P);
        }
#else
        {
            PeerArgs P; P.dry = false; P.route_reps = 1;
            P.S = SB; P.Hin = H; P.U = (const unsigned char*)(ws + WS_UBF) + (size_t)l * NEXP * DM; P.V = (const unsigned char*)(ws + WS_VBF) + (size_t)l * NEXP * DM; P.SU = (const float*)(ws + WS_SU) + (size_t)l * 2 * NEXP; P.SV = (const float*)(ws + WS_SV) + l * NEXP; P.Xin = X; P.Xout = X;
            P.g2l = modl + 5120; P.g2c = modc + 5120;
            P.Hout = SELFCHECK ? H : (bf16_t*)nullptr; P.H8out = ws + WS_H8; P.nwn = in[I_N1W] + DM; P.shl = modv + 2 * 6144; P.scl = P.shl + 1024; P.shc = modv + 3 * 6144; P.scc = P.shc + 1024;
            P.fout = (l == 1) ? args.out : nullptr; P.fnw = in[I_FNW];
            P.nblocks = nMr * 8; P.dbg_eid = nullptr; P.dbg_gt = nullptr;
            PeerBufs B;
#if SELFCHECK
            unsigned char* pb = ws + WS_VBF + 32 * MiB;
            if (l == 0) { P.Xout = (float*)(ws + WS_DBG); P.Hout = YS; }
#else
            unsigned char* pb = ws + WS_YS;
#endif
            B.eid = (int*)pb; B.gt = (float*)(pb + 9 * MiB); B.a = (float*)(pb + 18 * MiB); B.xq = ws + WS_UBF + 32 * MiB; B.sx = (float*)(ws + WS_UBF + 50 * MiB);
            const int ntok = nMr * 256;
            peer_route(F, P, B);
            GRID_BAR();
            peer_u(F, P, B, ntok);
            GRID_BAR();
            peer_v(F, P, B, ntok);
            GRID_BAR();
            peer_norm(F, P, ntok);
        }
#endif
#if SELFCHECK
        break;
#endif
        if (l == 0) GRID_BAR();
    }
#if TIMING
    GRID_BAR(); xcd_barrier(bar);
    {
        const unsigned long long* ts = (const unsigned long long*)(F.ctl + 1024);
        float iv[10];
#pragma unroll
        for (int i = 0; i < 10; ++i) iv[i] = 0.f;
        iv[0] = (float)(ts[1] - ts[0]); iv[1] = (float)(ts[2] - ts[1]);
#pragma unroll
        for (int l = 0; l < 2; ++l)
#pragma unroll
            for (int p = 0; p < 8; ++p) iv[2 + p] += (float)(ts[3 + l * 8 + p] - ts[2 + l * 8 + p]);
        const float total = (float)(ts[18] - ts[0]);
        const int k1 = (int)(100.f * iv[TIMING_A] / total + 0.5f); int k2 = 10 + (int)(100.f * iv[TIMING_B] / total + 0.5f); k2 = k2 > 99 ? 99 : k2;
        const float cval = sqrtf((float)k1);
        for (size_t i = (size_t)blockIdx.x * NTHREADS + ltid(F.wave); i < (size_t)SEQ * DM / 4; i += (size_t)gridDim.x * NTHREADS) ((f32x4*)args.out)[i] = (f32x4){i == 0 ? 100.f * (float)k2 : cval, cval, cval, cval};
    }
#endif
#if SELFCHECK
    GRID_BAR();
    if (blockIdx.x < 5) { const int b = blockIdx.x; const int r = b == 0 ? 0 : b == 1 ? 31 : b == 2 ? 37 : b == 3 ? 16383 : 16639; chk::ck_peer(0, r, in, ws, F.ctl, CK_RED, CK_BUF, CK_IBUF); }
    GRID_BAR();
    {
        float e[32];
#pragma unroll
        for (int i = 0; i < 32; ++i) e[i] = __uint_as_float(__hip_atomic_load(F.ctl + CW_CHK + i, RLX_AGENT));
        const float T = 0.03f; int mask = 0;
#if SELFCHECK == 1
        mask = ((e[0] > T || e[1] > T) ? 1 : 0) | (e[2] > T ? 2 : 0) | (e[3] > T ? 4 : 0) | (e[4] > T ? 8 : 0) | (e[5] > T ? 16 : 0);
#elif SELFCHECK == 2
        mask = (e[6] > T ? 1 : 0) | (e[7] > T ? 2 : 0) | (e[8] > T ? 4 : 0) | (e[9] > T ? 8 : 0) | ((e[10] > T || e[11] > T) ? 16 : 0);
#elif SELFCHECK == 5
        mask = (e[24] > T ? 1 : 0) | (e[25] > T ? 2 : 0) | (e[26] > T ? 4 : 0) | (e[27] > T ? 8 : 0) | (e[28] > T ? 16 : 0);
#elif SELFCHECK == 4
        mask = (e[10] > T ? 1 : 0) | (e[11] > T ? 2 : 0) | (e[12] > T ? 4 : 0) | (e[13] > T ? 8 : 0);
#else
        mask = (e[16] > T ? 1 : 0) | (e[17] > T ? 2 : 0) | (e[18] > T ? 4 : 0) | (e[19] > T ? 8 : 0) | ((e[20] > T || e[21] > T || e[22] > T || e[23] > T) ? 16 : 0);
#endif
        const float cval = sqrtf((float)mask);
        for (size_t i = (size_t)blockIdx.x * NTHREADS + ltid(F.wave); i < (size_t)SEQ * DM / 4; i += (size_t)gridDim.x * NTHREADS) ((f32x4*)args.out)[i] = (f32x4){cval, cval, cval, cval};
    }
#endif
}
#ifndef DUP_MASK
#define DUP_MASK 0
#endif
extern "C" void kernel_launch(void* const* d_in, const int* in_sizes, int n_in, void* d_out, int out_size, void* d_ws, size_t ws_size, hipStream_t stream) {
    static int grid = 0;
    if (grid == 0) {
        size_t need = WS_END;
#if SELFCHECK
        need = WS_DBG + (size_t)MT * DM * 4;
#endif
        if (n_in != 23 || in_sizes[0] != SEQ * DM || out_size != SEQ * DM || ws_size < need) {
            fprintf(stderr, "kernel_launch: unexpected problem shape (n_in %d, in0 %d, out %d, ws %zu, need %zu); nothing launched\n", n_in, n_in > 0 ? in_sizes[0] : -1, out_size, ws_size, need); grid = -1; return; }
        int dev = 0, cus = 0, per_cu = 0;
        if (hipGetDevice(&dev) != hipSuccess || hipDeviceGetAttribute(&cus, hipDeviceAttributeMultiprocessorCount, dev) != hipSuccess) { fprintf(stderr, "kernel_launch: device query failed\n"); grid = -1; return; }
        if (hipFuncSetAttribute((const void*)trunk_fwd, hipFuncAttributeMaxDynamicSharedMemorySize, LDS_BYTES) != hipSuccess) { fprintf(stderr, "kernel_launch: hipFuncSetAttribute failed\n"); grid = -1; return; }
        if (hipOccupancyMaxActiveBlocksPerMultiprocessor(&per_cu, (const void*)trunk_fwd, NTHREADS, LDS_BYTES) != hipSuccess || per_cu < 1) {
            fprintf(stderr, "kernel_launch: occupancy query says %d blocks per CU; nothing launched\n", per_cu); (void)hipGetLastError(); grid = -1; return; }
        grid = cus;
    }
    if (grid < 0) return;
    (void)hipMemsetAsync((char*)d_ws + WS_CTL, 0, CTL_ZERO_BYTES, stream);
    Args a{};
    for (int i = 0; i < 23; ++i) a.in[i] = (const float*)d_in[i];
    a.out = (float*)d_out; a.ws = (unsigned char*)d_ws; a.flags = DUP_MASK; a.pad = 0;
    void* kargs[] = {&a};
    const hipError_t e = hipLaunchCooperativeKernel((const void*)trunk_fwd, dim3(grid), dim3(NTHREADS), kargs, LDS_BYTES, stream);
    if (e != hipSuccess) fprintf(stderr, "kernel_launch: cooperative launch failed: %s (grid %d)\n", hipGetErrorString(e), grid);
}
```

```cpp
#define SELFCHECK 0
#define TIMING 0
#define TIMING_A 0
#define TIMING_B 1
#define DUP_MASK 0
#define PEER_SLICED 0
#include <hip/hip_runtime.h>
#include <hip/hip_cooperative_groups.h>
#include <hip/hip_bf16.h>
#include <cstdio>
#include <cstdint>
#include <cmath>
namespace cg = cooperative_groups;

#ifndef SELFCHECK
#define SELFCHECK 0
#endif

constexpr int SEQ = 16384, CTX = 256, MT = SEQ + CTX, DM = 1024, NQKV = 2560, GRIDW = 64;
constexpr int NEXP = 16384, NKEYS = 128, PEER_H = 8, TOPK = 16;
constexpr float EPS = 1e-6f, LOG2E = 1.4426950408889634f;
constexpr float C2_64 = 0.125f * LOG2E;
constexpr float C2_32 = 0.17677669529663687f * LOG2E;
constexpr int NWAVES = 8, NTHREADS = 512;

constexpr size_t MiB = 1u << 20;
constexpr size_t WS_CTL = 0, CTL_ZERO_BYTES = 1 * MiB;
constexpr size_t WS_CONST = 1 * MiB;
constexpr size_t WS_WIN = 2 * MiB;
constexpr size_t WS_WGATE = 12 * MiB;
constexpr size_t WS_WBR = 28 * MiB;
constexpr size_t WS_WOUT = 32 * MiB;
constexpr size_t WS_WSC = 36 * MiB;
constexpr size_t WS_SU = WS_CONST + 256 * 1024, WS_SV = WS_CONST + 512 * 1024;
constexpr size_t WS_UBF = 44 * MiB;
constexpr size_t WS_VBF = 108 * MiB;
constexpr size_t WS_H8 = WS_UBF + 32 * MiB;
constexpr size_t WS_W8IN = WS_VBF + 32 * MiB, WS_W8GATE = WS_VBF + 40 * MiB, WS_W8OUT = WS_VBF + 48 * MiB, WS_W8S = WS_VBF + 50 * MiB;
constexpr size_t WS_SWS = WS_CONST + 640 * 1024;
constexpr size_t WS_XB2 = WS_WOUT, WS_SXG = WS_WOUT + 1 * MiB;
constexpr size_t WS_X = 172 * MiB;
constexpr size_t WS_H = 237 * MiB;
constexpr size_t WS_YS = 270 * MiB;
constexpr size_t WS_R1 = 303 * MiB;
constexpr size_t WS_Q = WS_R1, WS_K = WS_Q + (size_t)20 * MT * 128, WS_V = WS_K + (size_t)12 * MT * 128;
constexpr size_t WS_END = 433 * MiB;
constexpr size_t WS_DBG = 433 * MiB;
static_assert(WS_V + (size_t)12 * MT * 128 <= WS_END && WS_R1 + (size_t)MT * 4096 * 2 <= WS_END && WS_R1 + (size_t)MT * 2048 * 4 <= WS_END, "ws map");
constexpr int CW_BAR = 4096;
constexpr int CW_CHK = 64;

constexpr int RING_BYTES = 131072;
constexpr int LDSCTL_OFF = RING_BYTES, MISC_OFF = LDSCTL_OFF + 320;
constexpr int LDS_BYTES = 147456;

#define GAS __attribute__((address_space(1)))
#define LAS __attribute__((address_space(3)))
typedef unsigned short bf16_t;
typedef unsigned v4u __attribute__((ext_vector_type(4)));
typedef unsigned v2u __attribute__((ext_vector_type(2)));
typedef float f32x4 __attribute__((ext_vector_type(4)));
typedef float f32x2 __attribute__((ext_vector_type(2)));
typedef float f32x16 __attribute__((ext_vector_type(16)));
typedef short bf16x8 __attribute__((ext_vector_type(8)));
typedef short s16x4 __attribute__((ext_vector_type(4)));
typedef __bf16 bf16x2_t __attribute__((ext_vector_type(2)));
typedef int i32x8 __attribute__((ext_vector_type(8)));
typedef int i32x4 __attribute__((ext_vector_type(4)));
typedef GAS unsigned gu32;
#define RLX_AGENT __ATOMIC_RELAXED, __HIP_MEMORY_SCOPE_AGENT
#define LDS_WAIT() asm volatile("s_waitcnt lgkmcnt(0)" ::: "memory")
#define VM_WAIT() asm volatile("s_waitcnt vmcnt(0)" ::: "memory")

__device__ __forceinline__ int lane_now() { int l; asm volatile("v_mbcnt_lo_u32_b32 %0, -1, 0\n\tv_mbcnt_hi_u32_b32 %0, -1, %0" : "=v"(l)); return l; }
__device__ __forceinline__ int tid_now(int wave) { return (wave << 6) | lane_now(); }
__device__ __forceinline__ unsigned f2bf(float f) { unsigned u = __builtin_bit_cast(unsigned, f); return (u + 0x7fffu + ((u >> 16) & 1u)) >> 16; }
__device__ __forceinline__ unsigned pk2(float lo, float hi) { f32x2 v = {lo, hi}; bf16x2_t b = __builtin_convertvector(v, bf16x2_t); return __builtin_bit_cast(unsigned, b); }
__device__ __forceinline__ unsigned pk4_fp8(float a, float b, float c, float d) { int w = 0; w = __builtin_amdgcn_cvt_pk_fp8_f32(a, b, w, false); w = __builtin_amdgcn_cvt_pk_fp8_f32(c, d, w, true); return (unsigned)w; }
__device__ __forceinline__ float bflo(unsigned w) { return __builtin_bit_cast(float, w << 16); }
__device__ __forceinline__ float bfhi(unsigned w) { return __builtin_bit_cast(float, w & 0xffff0000u); }
__device__ __forceinline__ float bf2f(bf16_t h) { return __builtin_bit_cast(float, (unsigned)h << 16); }
template <int X> __device__ __forceinline__ float xorf(float v) { return __builtin_bit_cast(float, __builtin_amdgcn_ds_swizzle(__builtin_bit_cast(int, v), (X << 10) | 0x1f)); }
__device__ __forceinline__ float x32_sum(float v) { auto r = __builtin_amdgcn_permlane32_swap(__float_as_uint(v), __float_as_uint(v), false, false); return __uint_as_float(r[0]) + __uint_as_float(r[1]); }
__device__ __forceinline__ float x32_max(float v) { auto r = __builtin_amdgcn_permlane32_swap(__float_as_uint(v), __float_as_uint(v), false, false); return __builtin_fmaxf(__uint_as_float(r[0]), __uint_as_float(r[1])); }
__device__ __forceinline__ float wave_sum(float v) { v += xorf<1>(v); v += xorf<2>(v); v += xorf<4>(v); v += xorf<8>(v); v += xorf<16>(v); return x32_sum(v); }
__device__ __forceinline__ float wave_max(float v) { v = __builtin_fmaxf(v, xorf<1>(v)); v = __builtin_fmaxf(v, xorf<2>(v)); v = __builtin_fmaxf(v, xorf<4>(v)); v = __builtin_fmaxf(v, xorf<8>(v)); v = __builtin_fmaxf(v, xorf<16>(v)); return x32_max(v); }
__device__ __forceinline__ float fast_exp2(float x) { return __builtin_amdgcn_exp2f(x); }
__device__ __forceinline__ float fast_rcp(float x) { return __builtin_amdgcn_rcpf(x); }
__device__ __forceinline__ float sigmoidf_(float x) { return fast_rcp(1.0f + fast_exp2(-x * LOG2E)); }
__device__ __forceinline__ float gelu_tanh(float x) {
    const float y = 0.7978845608028654f * (x + 0.044715f * x * x * x);
    const float t = 1.0f - 2.0f * fast_rcp(1.0f + fast_exp2(2.0f * LOG2E * y));
    return 0.5f * x * (1.0f + t);
}
#define XB_TMO      128
#define XB_XCNT(j)  (256  + 64 * (j))
#define XB_XSUB(j)  (1280 + 64 * (j))
#define XB_XGEN(j)  (2304 + 64 * (j))
#define XB_TOP      3328
#define XB_TOPGEN   3392
#define XCD_BAR_WORDS 3456
#define XB_SPIN_CAP (1u << 20)
__device__ __forceinline__ unsigned xb_ld(unsigned* p)              { return __hip_atomic_load(p, __ATOMIC_RELAXED, __HIP_MEMORY_SCOPE_AGENT); }
__device__ __forceinline__ unsigned xb_add(unsigned* p, unsigned v) { return __hip_atomic_fetch_add(p, v, __ATOMIC_RELAXED, __HIP_MEMORY_SCOPE_AGENT); }
__device__ __forceinline__ unsigned xb_xcc_id() { return (unsigned)__builtin_amdgcn_s_getreg((3 << 11) | 20) & 0xFu; }
#define XB_SPIN(cond, bar) do { unsigned _sp = 0; while (cond) { __builtin_amdgcn_s_sleep(1); \
    if ((++_sp & 255u) == 0u) { if (xb_ld(&(bar)[XB_TMO])) break; if (_sp > XB_SPIN_CAP) { atomicAdd(&(bar)[XB_TMO], 1u); break; } } } } while (0)
struct XcdBarrier { unsigned* bar; unsigned x; volatile LAS unsigned* st; int wave; };
__device__ __forceinline__ XcdBarrier xcd_barrier_post(unsigned* bar, volatile LAS unsigned* st, int wave) {
    XcdBarrier b; b.bar = bar; b.x = xb_xcc_id(); b.st = st; b.wave = wave;
    if (tid_now(wave) == 0) (void)xb_add(&bar[XB_XCNT(b.x)], 1u);
    return b;
}
__device__ __forceinline__ void xcd_barrier_complete(unsigned* bar, unsigned x, unsigned& nloc, unsigned& nx) {
    const unsigned G = gridDim.x * gridDim.y * gridDim.z;
    unsigned sum, cnt, mine, sp = 0u;
    for (;;) {
        sum = 0u; cnt = 0u; mine = 0u;
#pragma unroll
        for (unsigned j = 0; j < 16; ++j) { const unsigned c = xb_ld(&bar[XB_XCNT(j)]); sum += c; cnt += (c > 0u) ? 1u : 0u; mine = (j == x) ? c : mine; }
        if (sum == G) break;
        __builtin_amdgcn_s_sleep(1);
        if ((++sp & 255u) == 0u) { if (xb_ld(&bar[XB_TMO])) break; if (sp > XB_SPIN_CAP) { atomicAdd(&bar[XB_TMO], 1u); break; } }
    }
    nloc = mine > 0u ? mine : 1u; nx = cnt > 0u ? cnt : 1u;
}
__device__ __forceinline__ void xcd_barrier(const XcdBarrier& b) {
    asm volatile("s_waitcnt vmcnt(0)" ::: "memory");
    __syncthreads();
    unsigned* bar_ = b.bar; unsigned bx_ = b.x; asm volatile("" : "+s"(bar_), "+s"(bx_));
    if (tid_now(b.wave) == 0) {
        unsigned* bar = bar_; const unsigned bx = bx_;
        __builtin_amdgcn_s_waitcnt(0);
        unsigned nloc = b.st[0], nx = b.st[1];
        if (nloc == 0u) { xcd_barrier_complete(bar, bx, nloc, nx); b.st[0] = nloc; b.st[1] = nx; }
        const unsigned old = xb_add(&bar[XB_XSUB(bx)], 1u);
        const unsigned gen = old / nloc;
        if (old + 1u == (gen + 1u) * nloc) {
            __builtin_amdgcn_fence(__ATOMIC_RELEASE, "agent");
            asm volatile("s_waitcnt vmcnt(0)" ::: "memory");
            const unsigned og = xb_add(&bar[XB_TOP], 1u);
            const unsigned tg = og / nx;
            if (og + 1u == (tg + 1u) * nx) xb_add(&bar[XB_TOPGEN], 1u);
            else XB_SPIN(xb_ld(&bar[XB_TOPGEN]) == tg, bar);
            __builtin_amdgcn_fence(__ATOMIC_ACQUIRE, "agent");
            xb_add(&bar[XB_XGEN(bx)], 1u);
            asm volatile("s_waitcnt vmcnt(0)" ::: "memory");
        } else {
            XB_SPIN(xb_ld(&bar[XB_XGEN(bx)]) == gen, bar);
            __builtin_amdgcn_fence(__ATOMIC_ACQUIRE, "agent");
            asm volatile("s_waitcnt vmcnt(0)" ::: "memory");
        }
    }
    __syncthreads();
}

namespace pg8 {
#define PG8_LAS __attribute__((address_space(3)))
constexpr int BM = 256, BK = 64, HALF = 128, HTB = HALF * BK * 2, STAGE_BYTES = 8 * HTB, NXCD = 8, WGM = 8;
__host__ __device__ __forceinline__ int lds_byte(int r, int c) { const int st = (r >> 4) * 2 + (c >> 5), rr = r & 15, cc = c & 31, ob = rr * 64 + cc * 2; return st * 1024 + (ob ^ (((ob >> 9) & 1) << 5)); }
__host__ __device__ __forceinline__ void stage_rc(int b, int& R, int& C) { const int st = b / 1024, sb = b % 1024, swz = sb ^ (((sb >> 9) & 1) << 5); R = (st >> 1) * 16 + swz / 64; C = (st & 1) * 32 + (swz % 64) / 2; }
__host__ __device__ __forceinline__ int perm32(int rho) { const int n = rho >> 4, i = rho & 15; return 8 * (i >> 2) + 4 * n + (i & 3); }
__host__ __device__ __forceinline__ int wide_row(int R) { return 64 * (R >> 5) + 16 * ((R >> 2) & 3) + 4 * ((R >> 4) & 1) + (R & 3); }
template <class E, class = void> struct IsWide { static constexpr bool v = false; };
template <class E> struct IsWide<E, decltype((void)E::WIDE)> { static constexpr bool v = true; };

struct Unit { int pm, pn; const char* a; const char* b; };
struct Gemm { const void* A; const void* Bt; int nM, nN, K, lda, ldb, a_shift, a_pn_bytes, esz; };

struct StaticOrder {
    int nM, nN, nwg, G, c; const char* A; const char* B; size_t a_pm, b_pn; int a_shift, a_pn;
    __device__ void init(const Gemm& g, int G_, int c_) { nM = g.nM; nN = g.nN; nwg = nM * nN; G = G_; c = c_; A = (const char*)g.A; B = (const char*)g.Bt;
        a_pm = (size_t)BM * g.lda * g.esz; b_pn = (size_t)BM * g.ldb * g.esz; a_shift = g.a_shift; a_pn = g.a_pn_bytes; }
    __device__ bool has(int i) const { int cc = c; asm volatile("" : "+s"(cc)); return (long)i * G + cc < nwg; }
    __device__ bool next(int i, Unit& u) const {
        const long L = (long)i * G + c; if (L >= nwg) return false;
        int wgid = (int)L; { const int q = nwg / NXCD, r = nwg % NXCD, xcd = wgid % NXCD, off = wgid / NXCD; wgid = (xcd < r ? xcd * (q + 1) : r * (q + 1) + (xcd - r) * q) + off; }
        const int nig = WGM * nN, gid = wgid / nig, fm = gid * WGM, gsz = (nM - fm) < WGM ? (nM - fm) : WGM;
        u.pm = fm + ((wgid % nig) % gsz); u.pn = (wgid % nig) / gsz;
        u.a = A + (size_t)u.pm * a_pm + (size_t)(u.pn >> a_shift) * a_pn; u.b = B + (size_t)u.pn * b_pn; return true;
    }
};

template <class Epi, bool FP8 = false, int SCALE_ACT = 0x7F7F7F7F, bool I8 = false>
__device__ __forceinline__ void gemm_phase(PG8_LAS unsigned char* lds, const Gemm g, const StaticOrder& S, const Epi& E, int wave) {
    const int tid = tid_now(wave), wid = wave, lane = tid & 63, wr = wid >> 2, wc = wid & 3, fr = lane & 15, fq = lane >> 4;
    const int K = g.K, nt = (K * g.esz) / (BK * 2);
    unsigned voffA[2], voffB[2];
#pragma unroll
    for (int i = 0; i < 2; ++i) { int R, C; stage_rc(tid * 16 + i * 8192, R, C); const int Rb = IsWide<Epi>::v ? wide_row(R) : (Epi::PERM ? ((R & ~31) + perm32(R & 31)) : R);
        voffA[i] = (unsigned)(R * g.lda * g.esz + C * 2); voffB[i] = (unsigned)(Rb * g.ldb * g.esz + C * 2); }
    const size_t kstep = (size_t)(BK * 2);
    const size_t hstepA = (size_t)HALF * g.lda * g.esz, hstepB = (size_t)(IsWide<Epi>::v ? 8 : HALF) * g.ldb * g.esz;
    const unsigned ldsw = (unsigned)wid * 1024u, ldsbase = (unsigned)(uintptr_t)lds;
    const int aoff = FP8 ? lds_byte(wr * 64 + fr, fq * 16) : lds_byte(wr * 64 + fr, fq * 8), boff = FP8 ? lds_byte(wc * 32 + fr, fq * 16) : lds_byte(wc * 32 + fr, fq * 8);
#define PG8_SA(b, h) (((b) * 2 + (h)) * HTB)
#define PG8_SB(b, h) ((4 + (b) * 2 + (h)) * HTB)
#define PG8_GLDS(sbase, voff32, ldsdst) do { unsigned keep_; asm volatile("s_mov_b32 %0, m0\n\ts_mov_b32 m0, %3\n\ts_nop 0\n\tglobal_load_lds_dwordx4 %1, %2\n\ts_mov_b32 m0, %0" : "=&s"(keep_) : "v"(voff32), "s"(sbase), "s"(ldsdst) : "memory"); } while (0)
#define PG8_STAGE(bufoff, gbase, voff) do { _Pragma("unroll") for (int _i = 0; _i < 2; ++_i) \
        PG8_GLDS((const char*)(gbase), (voff)[_i], (unsigned)__builtin_amdgcn_readfirstlane((int)(ldsbase + (unsigned)(bufoff) + ldsw + _i * 8192))); } while (0)
#define PG8_LDA(dst, b, h) do { if constexpr (FP8) { _Pragma("unroll") for (int m = 0; m < 4; ++m) dst##8[m] = *(const PG8_LAS i32x8*)(lds + PG8_SA(b, h) + aoff + m * 2048); } \
        else { _Pragma("unroll") for (int m = 0; m < 4; ++m) _Pragma("unroll") for (int k = 0; k < 2; ++k) dst[m][k] = *(const PG8_LAS bf16x8*)(lds + PG8_SA(b, h) + aoff + m * 2048 + k * 1024); } } while (0)
#define PG8_LDB(dst, b, h) do { if constexpr (FP8) { _Pragma("unroll") for (int n = 0; n < 2; ++n) dst##8[n] = *(const PG8_LAS i32x8*)(lds + PG8_SB(b, h) + boff + n * 2048); } \
        else { _Pragma("unroll") for (int n = 0; n < 2; ++n) _Pragma("unroll") for (int k = 0; k < 2; ++k) dst[n][k] = *(const PG8_LAS bf16x8*)(lds + PG8_SB(b, h) + boff + n * 2048 + k * 1024); } } while (0)
#define PG8_MMA(ai, bj, At, Bt) do { __builtin_amdgcn_s_setprio(1); \
        if constexpr (FP8) { _Pragma("unroll") for (int m = 0; m < 4; ++m) _Pragma("unroll") for (int n = 0; n < 2; ++n) \
            acc[ai][bj][m][n] = __builtin_amdgcn_mfma_scale_f32_16x16x128_f8f6f4(Bt##8[n], At##8[m], acc[ai][bj][m][n], 0, 0, 0, 0x79797979, 0, SCALE_ACT); } \
        else if constexpr (I8) { _Pragma("unroll") for (int m = 0; m < 4; ++m) _Pragma("unroll") for (int n = 0; n < 2; ++n) _Pragma("unroll") for (int k = 0; k < 2; ++k) \
            acc[ai][bj][m][n] = __builtin_bit_cast(f32x4, __builtin_amdgcn_mfma_i32_16x16x64_i8(__builtin_bit_cast(i32x4, Bt[n][k]), __builtin_bit_cast(i32x4, At[m][k]), __builtin_bit_cast(i32x4, acc[ai][bj][m][n]), 0, 0, 0)); } \
        else { _Pragma("unroll") for (int m = 0; m < 4; ++m) _Pragma("unroll") for (int n = 0; n < 2; ++n) _Pragma("unroll") for (int k = 0; k < 2; ++k) \
            acc[ai][bj][m][n] = __builtin_amdgcn_mfma_f32_16x16x32_bf16(Bt[n][k], At[m][k], acc[ai][bj][m][n], 0, 0, 0); } \
        __builtin_amdgcn_s_setprio(0); } while (0)
#define PG8_WAIT_V(n) asm volatile("s_waitcnt vmcnt(" #n ")" ::: "memory")
#define PG8_WAIT_L(n) asm volatile("s_waitcnt lgkmcnt(" #n ")" ::: "memory")
#define PG8_BAR __builtin_amdgcn_s_barrier()
#define PG8_SCHED __builtin_amdgcn_sched_barrier(0)
    Unit cur, nxt; int ui = 0;
    if (!S.has(0)) return;
    (void)S.next(0, cur);
    f32x4 acc[2][2][4][2];
#pragma unroll
    for (int a = 0; a < 2; ++a)
#pragma unroll
        for (int b = 0; b < 2; ++b)
#pragma unroll
            for (int m = 0; m < 4; ++m)
#pragma unroll
                for (int n = 0; n < 2; ++n) acc[a][b][m][n] = (f32x4){0.f, 0.f, 0.f, 0.f};
    bf16x8 At[4][2], B0[2][2], B1[2][2]; i32x8 At8[4], B08[2], B18[2];
    const char* cA = cur.a; const char* cB = cur.b;
    PG8_STAGE(PG8_SB(0, 0), cB, voffB); PG8_STAGE(PG8_SB(0, 1), cB + hstepB, voffB); PG8_STAGE(PG8_SA(0, 0), cA, voffA); PG8_STAGE(PG8_SA(0, 1), cA + hstepA, voffA);
    { int w_ = wave; asm volatile("" : "+s"(w_)); if ((w_ >> 2) == 1) PG8_BAR; }
    PG8_WAIT_V(2); PG8_BAR;
    PG8_STAGE(PG8_SB(1, 0), cB + kstep, voffB); PG8_STAGE(PG8_SA(1, 0), cA + kstep, voffA); PG8_STAGE(PG8_SB(1, 1), cB + hstepB + kstep, voffB);
    PG8_WAIT_V(6); PG8_BAR;
    for (;;) {
        const bool has_next = S.has(ui + 1); nxt = cur; if (has_next) (void)S.next(ui + 1, nxt);
        const char* nA = has_next ? nxt.a : cA; const char* nB = has_next ? nxt.b : cB;
        for (int t = 0; t < nt; t += 2) {
            const bool last = (t == nt - 2);
            const char* a1 = cA + (size_t)(t + 1) * kstep;
            const char* a2 = last ? nA : cA + (size_t)(t + 2) * kstep; const char* b2 = last ? nB : cB + (size_t)(t + 2) * kstep;
            const char* a3 = a2 + kstep; const char* b3 = b2 + kstep;
            PG8_LDB(B0, 0, 0); PG8_LDB(B1, 0, 1); PG8_SCHED; PG8_LDA(At, 0, 0); PG8_STAGE(PG8_SA(1, 1), a1 + hstepA, voffA);
            PG8_WAIT_V(8); PG8_WAIT_L(0); PG8_BAR; PG8_MMA(0, 0, At, B0); PG8_MMA(0, 1, At, B1); PG8_BAR; PG8_SCHED;
            PG8_LDA(At, 0, 1); PG8_STAGE(PG8_SB(0, 0), b2, voffB); PG8_STAGE(PG8_SB(0, 1), b2 + hstepB, voffB); PG8_STAGE(PG8_SA(0, 0), a2, voffA);
            PG8_WAIT_V(8); PG8_WAIT_L(0); PG8_BAR; PG8_MMA(1, 0, At, B0); PG8_MMA(1, 1, At, B1); PG8_BAR; PG8_SCHED;
            PG8_LDB(B0, 1, 0); PG8_LDB(B1, 1, 1); PG8_SCHED; PG8_LDA(At, 1, 0); PG8_STAGE(PG8_SA(0, 1), a2 + hstepA, voffA);
            PG8_WAIT_V(8); PG8_WAIT_L(0); PG8_BAR; PG8_MMA(0, 0, At, B0); PG8_MMA(0, 1, At, B1); PG8_BAR; PG8_SCHED;
            PG8_LDA(At, 1, 1); PG8_STAGE(PG8_SB(1, 0), b3, voffB); PG8_STAGE(PG8_SB(1, 1), b3 + hstepB, voffB); PG8_STAGE(PG8_SA(1, 0), a3, voffA);
            PG8_WAIT_V(8); PG8_WAIT_L(0); PG8_BAR; PG8_MMA(1, 0, At, B0); PG8_MMA(1, 1, At, B1); PG8_BAR; PG8_SCHED;
        }
        { int w2_ = wave; asm volatile("" : "+s"(w2_));
          if ((w2_ >> 2) == 0) PG8_BAR;
          E(acc, cur, w2_ >> 2, w2_ & 3, 0, 0); }
        if (!S.has(ui + 1)) break;
#pragma unroll
        for (int a = 0; a < 2; ++a)
#pragma unroll
            for (int b = 0; b < 2; ++b)
#pragma unroll
                for (int m = 0; m < 4; ++m)
#pragma unroll
                    for (int n = 0; n < 2; ++n) acc[a][b][m][n] = (f32x4){0.f, 0.f, 0.f, 0.f};
        cur = nxt; cA = nA; cB = nB; ++ui;
        { int w_ = wave; asm volatile("" : "+s"(w_)); if ((w_ >> 2) == 1) PG8_BAR; }
    }
    PG8_WAIT_V(0);
    PG8_BAR;
#undef PG8_SA
#undef PG8_SB
#undef PG8_STAGE
#undef PG8_LDA
#undef PG8_LDB
#undef PG8_MMA
#undef PG8_WAIT_V
#undef PG8_WAIT_L
#undef PG8_BAR
#undef PG8_SCHED
}
}
namespace pg8 {
struct EpiQKV {
    static constexpr bool PERM = true;
    bf16_t *Qb, *Kb, *Vb; const float* qkw;
    __device__ __forceinline__ void operator()(const f32x4 (&acc)[2][2][4][2], const Unit& u, int wr, int wc, int, int) const {
        const int t_ = lane_now(); const int fr = t_ & 15, fq = (t_ >> 4) & 3;
        const int hs = __builtin_amdgcn_readfirstlane(u.pn * 4 + wc);
        bf16_t* dst; int rope = 0, norm = -1, dq = 0; float scale = 1.f;
        if (hs < 4)       { dst = Qb + (size_t)hs * MT * 64; scale = C2_64; }
        else if (hs < 8)  { dst = Kb + (size_t)(hs - 4) * MT * 64; }
        else if (hs < 12) { dst = Vb + (size_t)(hs - 8) * MT * 64; }
        else if (hs < 16) { dst = Qb + (size_t)(4 + 2 * (hs - 12)) * MT * 64; rope = 2; dq = 1; scale = C2_32; }
        else if (hs < 20) { dst = Kb + (size_t)(4 + hs - 16) * MT * 64; rope = 2; }
        else if (hs < 24) { dst = Vb + (size_t)(4 + hs - 20) * MT * 64; }
        else if (hs < 28) { dst = Qb + (size_t)(12 + hs - 24) * MT * 64; rope = 1; scale = C2_64; }
        else if (hs < 30) { dst = Kb + (size_t)(8 + hs - 28) * MT * 64; rope = 1; }
        else if (hs < 32) { dst = Vb + (size_t)(8 + hs - 30) * MT * 64; }
        else if (hs < 36) { dst = Qb + (size_t)(16 + hs - 32) * MT * 64; rope = 1; norm = 0; scale = C2_64; }
        else if (hs < 38) { dst = Kb + (size_t)(10 + hs - 36) * MT * 64; rope = 1; norm = 1; }
        else              { dst = Vb + (size_t)(10 + hs - 38) * MT * 64; }
        const bool latent = u.pm < SEQ / 256;
        if (!latent) rope = 0;
        float fstep = (rope == 2) ? (13.287712379549449f / 8.f) : (13.287712379549449f / 16.f); asm volatile("" : "+v"(fstep));
        const float fbase = (rope == 2) ? 0.f : (float)(8 * (fq & 1)) * fstep;
#define INVF(k) (fast_exp2(-(fbase + (float)(k) * fstep)) * 0.15915494309189535f)
#pragma unroll
        for (int m = 0; m < 4; ++m) {
            float csn[8], ccs[8];
            if (rope == 1) { float pos = (float)(m * 16 + fr); asm volatile("" : "+v"(pos));
#pragma unroll
                for (int k = 0; k < 8; ++k) { const float rev = pos * INVF(k); csn[k] = __builtin_amdgcn_sinf(rev); ccs[k] = __builtin_amdgcn_cosf(rev); } }
#pragma unroll
            for (int ai = 0; ai < 2; ++ai) {
                const int row = u.pm * BM + ai * HALF + wr * 64 + m * 16 + fr;
                float v[16];
#pragma unroll
                for (int bj = 0; bj < 2; ++bj)
#pragma unroll
                    for (int n = 0; n < 2; ++n)
#pragma unroll
                        for (int j = 0; j < 4; ++j) v[bj * 8 + n * 4 + j] = acc[ai][bj][m][n][j];
                if (norm >= 0) {
                    float ss = 0.f;
#pragma unroll
                    for (int k = 0; k < 16; ++k) ss += v[k] * v[k];
                    ss += xorf<16>(ss); ss = x32_sum(ss);
                    const float ri = __builtin_amdgcn_rsqf(ss * (1.f / 64.f) + EPS);
#pragma unroll
                    for (int bj = 0; bj < 2; ++bj) { const f32x4 w0 = *(const f32x4*)(qkw + norm * 64 + 32 * bj + 8 * fq), w1 = *(const f32x4*)(qkw + norm * 64 + 32 * bj + 8 * fq + 4);
#pragma unroll
                        for (int j = 0; j < 4; ++j) { v[bj * 8 + j] = v[bj * 8 + j] * ri * w0[j]; v[bj * 8 + 4 + j] = v[bj * 8 + 4 + j] * ri * w1[j]; } }
                }
                if (rope == 1) {
                    const float sgn = (fq & 2) ? 1.f : -1.f;
                    float pos = (float)(row >> 6); asm volatile("" : "+v"(pos));
#pragma unroll
                    for (int k = 0; k < 8; ++k) {
                        const float rev = pos * INVF(k); const float sn = __builtin_amdgcn_sinf(rev), cs = __builtin_amdgcn_cosf(rev);
                        const float x = v[k]; auto rx = __builtin_amdgcn_permlane32_swap(__float_as_uint(x), __float_as_uint(x), false, false);
                        const float pt = __uint_as_float((fq & 2) ? rx[0] : rx[1]);
                        v[k] = x * cs + sgn * pt * sn;
                        const float y = v[8 + k]; auto ry = __builtin_amdgcn_permlane32_swap(__float_as_uint(y), __float_as_uint(y), false, false);
                        const float qt = __uint_as_float((fq & 2) ? ry[0] : ry[1]);
                        v[8 + k] = y * ccs[k] + sgn * qt * csn[k];
                    }
                } else if (rope == 2) {
                    const float sgn = (fq & 1) ? 1.f : -1.f;
                    float pos = (float)(fq < 2 ? (row >> 6) : (row & 63)); asm volatile("" : "+v"(pos));
#pragma unroll
                    for (int k = 0; k < 8; ++k) {
                        const float rev = pos * INVF(k); const float sn = __builtin_amdgcn_sinf(rev), cs = __builtin_amdgcn_cosf(rev);
#pragma unroll
                        for (int bj = 0; bj < 2; ++bj) { const float x = v[bj * 8 + k], pt = xorf<16>(x); v[bj * 8 + k] = x * cs + sgn * pt * sn; }
                    }
                }
#pragma unroll
                for (int bj = 0; bj < 2; ++bj) {
                    v4u w; w.x = pk2(v[bj * 8 + 0] * scale, v[bj * 8 + 1] * scale); w.y = pk2(v[bj * 8 + 2] * scale, v[bj * 8 + 3] * scale);
                    w.z = pk2(v[bj * 8 + 4] * scale, v[bj * 8 + 5] * scale); w.w = pk2(v[bj * 8 + 6] * scale, v[bj * 8 + 7] * scale);
                    if (dq) {
                        *(v4u*)(dst + (size_t)bj * MT * 64 + (size_t)row * 64 + 32 * bj + 8 * fq) = w;
                        unsigned z0 = 0u; asm volatile("" : "+v"(z0));
                        *(v4u*)(dst + (size_t)(1 - bj) * MT * 64 + (size_t)row * 64 + 32 * bj + 8 * fq) = (v4u){z0, z0, z0, z0};
                    } else *(v4u*)(dst + (size_t)row * 64 + 32 * bj + 8 * fq) = w;
                }
                __builtin_amdgcn_sched_barrier(0);
            }
        }
#undef INVF
    }
};
struct EpiBranch {
    static constexpr bool PERM = true;
    bf16_t* Bp;
    __device__ __forceinline__ void operator()(const f32x4 (&acc)[2][2][4][2], const Unit& u, int wr, int wc, int, int) const {
        const int t_ = lane_now(); const int fr = t_ & 15, fq = (t_ >> 4) & 3;
        const int branch = u.pn >> 2, chb = 256 * (u.pn & 3) + 32 * wc + 8 * fq;
#pragma unroll
        for (int ai = 0; ai < 2; ++ai)
#pragma unroll
            for (int m = 0; m < 4; ++m) { bf16_t* rowp = Bp + (size_t)(u.pm * BM + ai * HALF + wr * 64 + m * 16 + fr) * 4096 + branch * 1024 + chb;
#pragma unroll
                for (int bj = 0; bj < 2; ++bj) { const f32x4 a = acc[ai][bj][m][0], c = acc[ai][bj][m][1];
                    v4u w; w.x = pk2(a[0], a[1]); w.y = pk2(a[2], a[3]); w.z = pk2(c[0], c[1]); w.w = pk2(c[2], c[3]); *(v4u*)(rowp + 128 * bj) = w; } }
    }
};
#ifndef BP8
#define BP8 1
#endif
#ifndef MIX8
#define MIX8 1
#endif
#if MIX8 && !BP8
#error MIX8 needs BP8
#endif
constexpr float BP8_SCALE = 32.f;
struct EpiBranch8 {
    static constexpr bool PERM = false, WIDE = true;
    unsigned char* Bp;
    __device__ __forceinline__ void operator()(const f32x4 (&acc)[2][2][4][2], const Unit& u, int wr, int wc, int, int) const {
        const int t_ = lane_now(); const int fr = t_ & 15, fq = (t_ >> 4) & 3;
        const int branch = u.pn >> 2, off = (4 * (u.pn & 3) + wc) * 256 + branch * 64 + 16 * fq;
#pragma unroll
        for (int ai = 0; ai < 2; ++ai)
#pragma unroll
            for (int m = 0; m < 4; ++m) { unsigned char* rowp = Bp + (size_t)(u.pm * BM + ai * HALF + wr * 64 + m * 16 + fr) * 4096 + off;
                v4u w;
#pragma unroll
                for (int bj = 0; bj < 2; ++bj) { const f32x4 a = acc[ai][bj][m][0] * BP8_SCALE, c = acc[ai][bj][m][1] * BP8_SCALE;
                    w[2 * bj] = pk4_fp8(a[0], a[1], a[2], a[3]); w[2 * bj + 1] = pk4_fp8(c[0], c[1], c[2], c[3]); }
                *(v4u*)rowp = w; }
    }
};
struct EpiGate {
    static constexpr bool PERM = false;
    const bf16_t* Bp; bf16_t* mix; const float* bgate;
    __device__ __forceinline__ void operator()(const f32x4 (&acc)[2][2][4][2], const Unit& u, int wr, int wc, int, int) const {
        const int t_ = lane_now(); const int fr = t_ & 15, fq = (t_ >> 4) & 3;
        const int ch = 64 * u.pn + 16 * wc + 4 * fq;
        f32x4 bias[2][2];
#pragma unroll
        for (int bj = 0; bj < 2; ++bj)
#pragma unroll
            for (int n = 0; n < 2; ++n) bias[bj][n] = *(const f32x4*)(bgate + (2 * bj + n) * 1024 + ch);
#if BP8
        unsigned b8a[2][4][4];
#pragma unroll
        for (int ai = 0; ai < 2; ++ai)
#pragma unroll
            for (int m = 0; m < 4; ++m) { const size_t row = (size_t)(u.pm * BM + ai * HALF + wr * 64 + m * 16 + fr);
#pragma unroll
                for (int b = 0; b < 4; ++b) b8a[ai][m][b] = *(const unsigned*)((const unsigned char*)Bp + row * 4096 + u.pn * 256 + b * 64 + 16 * wc + 4 * fq); }
#endif
#pragma unroll
        for (int ai = 0; ai < 2; ++ai)
#pragma unroll
            for (int m = 0; m < 4; ++m) { const size_t row = (size_t)(u.pm * BM + ai * HALF + wr * 64 + m * 16 + fr);
                f32x4 s = {0.f, 0.f, 0.f, 0.f};
#if BP8
#pragma unroll
                for (int bj = 0; bj < 2; ++bj)
#pragma unroll
                    for (int n = 0; n < 2; ++n) { const f32x4 a = acc[ai][bj][m][n] + bias[bj][n]; const int w = (int)b8a[ai][m][2 * bj + n];
                        const f32x2 lo = __builtin_amdgcn_cvt_pk_f32_fp8(w, false), hi = __builtin_amdgcn_cvt_pk_f32_fp8(w, true);
                        s[0] += sigmoidf_(a[0]) * lo.x; s[1] += sigmoidf_(a[1]) * lo.y; s[2] += sigmoidf_(a[2]) * hi.x; s[3] += sigmoidf_(a[3]) * hi.y; }
#if !MIX8
                s = s * (1.f / BP8_SCALE);
#endif
#else
                v2u bb[4];
#pragma unroll
                for (int b = 0; b < 4; ++b) bb[b] = *(const v2u*)(Bp + row * 4096 + b * 1024 + ch);
#pragma unroll
                for (int bj = 0; bj < 2; ++bj)
#pragma unroll
                    for (int n = 0; n < 2; ++n) { const f32x4 a = acc[ai][bj][m][n] + bias[bj][n]; const unsigned w0 = bb[2 * bj + n].x, w1 = bb[2 * bj + n].y;
                        s[0] += sigmoidf_(a[0]) * bflo(w0); s[1] += sigmoidf_(a[1]) * bfhi(w0); s[2] += sigmoidf_(a[2]) * bflo(w1); s[3] += sigmoidf_(a[3]) * bfhi(w1); }
#endif
#if MIX8
                *(unsigned*)((unsigned char*)mix + row * 1024 + ch) = pk4_fp8(s[0], s[1], s[2], s[3]); }
#else
                v2u w; w.x = pk2(s[0], s[1]); w.y = pk2(s[2], s[3]); *(v2u*)(mix + row * 1024 + ch) = w; }
#endif
    }
};
struct EpiOut {
    static constexpr bool PERM = false;
    const float* xl; const float* xc; float* X; const float* gl; const float* gc;
    __device__ __forceinline__ void operator()(const f32x4 (&acc)[2][2][4][2], const Unit& u, int wr, int wc, int, int) const {
        const int t_ = lane_now(); const int fr = t_ & 15, fq = (t_ >> 4) & 3;
        const bool latent = u.pm < SEQ / 256; const float* gv = latent ? gl : gc; const float* xo = latent ? xl : xc - (size_t)SEQ * DM;
        const int col0 = u.pn * BM + wc * 32 + 4 * fq;
        f32x4 g[2][2];
#pragma unroll
        for (int bj = 0; bj < 2; ++bj)
#pragma unroll
            for (int n = 0; n < 2; ++n) g[bj][n] = *(const f32x4*)(gv + col0 + bj * HALF + n * 16);
#pragma unroll
        for (int ai = 0; ai < 2; ++ai)
#pragma unroll
            for (int m = 0; m < 4; ++m) { const size_t off = (size_t)(u.pm * BM + ai * HALF + wr * 64 + m * 16 + fr) * DM + col0;
#pragma unroll
                for (int bj = 0; bj < 2; ++bj)
#pragma unroll
                    for (int n = 0; n < 2; ++n) { const f32x4 o = *(const f32x4*)(xo + off + bj * HALF + n * 16); *(f32x4*)(X + off + bj * HALF + n * 16) = o + g[bj][n] * acc[ai][bj][m][n]; } }
    }
};
struct EpiOutNorm {
    static constexpr bool PERM = true;
    const float* xl; const float* xc; float* X; const float* gl; const float* gc;
    bf16_t* H; const float* nw; const float* ml; const float* mc;
    gu32* xbuf; gu32* cnt; gu32* tmo; LAS unsigned char* tl;
    gu32* xbuf2; gu32* cnt2; unsigned char* XQ; float* SXG;
    __device__ __forceinline__ void operator()(f32x4 (&acc)[2][2][4][2], const Unit& u, int wr, int wc, int, int) const {
        const int t_ = lane_now(); const int fr = t_ & 15, fq = (t_ >> 4) & 3;
        const bool latent = u.pm < SEQ / 256; const float* gv = latent ? gl : gc; const float* xo = latent ? xl : xc - (size_t)SEQ * DM;
        const int col0 = u.pn * BM + wc * 32 + 8 * fq;
        LAS float* P = (LAS float*)tl; LAS float* Sr = (LAS float*)(tl + 4096); volatile LAS unsigned* flag = (volatile LAS unsigned*)(tl + 5120);
        {
            f32x4 g[2][2];
#pragma unroll
            for (int bj = 0; bj < 2; ++bj)
#pragma unroll
                for (int n = 0; n < 2; ++n) g[bj][n] = *(const f32x4*)(gv + col0 + bj * HALF + n * 4);
            f32x4 xo_c[2][2], xo_n[2][2];
#define EON_LOAD(dst, it_) do { const int r_ = ((it_) >> 2) * HALF + wr * 64 + ((it_) & 3) * 16 + fr; const size_t off_ = (size_t)(u.pm * BM + r_) * DM + col0; \
            _Pragma("unroll") for (int bj = 0; bj < 2; ++bj) _Pragma("unroll") for (int n = 0; n < 2; ++n) dst[bj][n] = *(const f32x4*)(xo + off_ + bj * HALF + n * 4); } while (0)
            EON_LOAD(xo_c, 0);
#pragma unroll
            for (int it = 0; it < 8; ++it) { const int ai = it >> 2, m = it & 3;
                if (it < 7) EON_LOAD(xo_n, it + 1);
                const int r = ai * HALF + wr * 64 + m * 16 + fr; const size_t off = (size_t)(u.pm * BM + r) * DM + col0; float s = 0.f;
#pragma unroll
                for (int bj = 0; bj < 2; ++bj)
#pragma unroll
                    for (int n = 0; n < 2; ++n) { const f32x4 y = xo_c[bj][n] + g[bj][n] * acc[ai][bj][m][n];
                        *(f32x4*)(X + off + bj * HALF + n * 4) = y; acc[ai][bj][m][n] = y; s += (y.x * y.x + y.y * y.y) + (y.z * y.z + y.w * y.w); }
                s += xorf<16>(s); s = x32_sum(s);
                if (fq == 0) P[r * 4 + wc] = s;
#pragma unroll
                for (int bj = 0; bj < 2; ++bj)
#pragma unroll
                    for (int n = 0; n < 2; ++n) xo_c[bj][n] = xo_n[bj][n]; }
#undef EON_LOAD
        }
        asm volatile("s_waitcnt lgkmcnt(0)" ::: "memory"); __builtin_amdgcn_s_barrier(); asm volatile("" ::: "memory");
        const int wid = wr * 4 + wc, row = wid * 32 + (t_ & 31);
        if (t_ < 32) { const float tp = (P[row * 4 + 0] + P[row * 4 + 1]) + (P[row * 4 + 2] + P[row * 4 + 3]);
            __hip_atomic_store(xbuf + ((size_t)(u.pm * BM + row) * 4 + u.pn), __float_as_uint(tp), RLX_AGENT); }
        asm volatile("s_waitcnt vmcnt(0)" ::: "memory");
        if (t_ == 0) (void)__hip_atomic_fetch_add(cnt + 64 * u.pm, 1u, RLX_AGENT);
        if (wid == 0) {
            unsigned sp = 0u, dead = 0u;
            while ((unsigned)__builtin_amdgcn_readfirstlane((int)__hip_atomic_load(cnt + 64 * u.pm, RLX_AGENT)) < 32u) {
                __builtin_amdgcn_s_sleep(2);
                if ((++sp & 255u) == 0u) { if (__builtin_amdgcn_readfirstlane((int)__hip_atomic_load(tmo, RLX_AGENT)) != 0) { dead = 1u; break; }
                    if (sp > (1u << 22)) { if (t_ == 0) __hip_atomic_store(tmo, 1u, RLX_AGENT); dead = 1u; break; } } }
            __builtin_amdgcn_fence(__ATOMIC_ACQUIRE, "agent");
            if (t_ == 0) flag[0] = dead;
        }
        asm volatile("s_waitcnt vmcnt(0) lgkmcnt(0)" ::: "memory"); __builtin_amdgcn_s_barrier(); asm volatile("" ::: "memory");
        if (t_ < 32) { const gu32* sl = xbuf + (size_t)(u.pm * BM + row) * 4; float tot = 0.f;
#pragma unroll
            for (int q = 0; q < 4; ++q) tot += __uint_as_float(__hip_atomic_load(sl + q, RLX_AGENT));
            Sr[row] = __builtin_amdgcn_rsqf(tot * (1.f / DM) + EPS); }
        asm volatile("s_waitcnt vmcnt(0) lgkmcnt(0)" ::: "memory"); __builtin_amdgcn_s_barrier(); asm volatile("" ::: "memory");
        const float* mv = latent ? ml : mc;
        f32x4 wa[2][2], bb[2][2];
#pragma unroll
        for (int bj = 0; bj < 2; ++bj)
#pragma unroll
            for (int n = 0; n < 2; ++n) { const int col = col0 + bj * HALF + 4 * n; const f32x4 w = *(const f32x4*)(nw + col), a = *(const f32x4*)(mv + 4096 + col); bb[bj][n] = *(const f32x4*)(mv + 3072 + col); wa[bj][n] = w * (1.0f + a); }
#pragma unroll
        for (int ai = 0; ai < 2; ++ai)
#pragma unroll
            for (int m = 0; m < 4; ++m) { const int r = ai * HALF + wr * 64 + m * 16 + fr; const float ri = Sr[r]; float mx = 0.f;
#pragma unroll
                for (int bj = 0; bj < 2; ++bj)
#pragma unroll
                    for (int n = 0; n < 2; ++n) { const f32x4 y = (acc[ai][bj][m][n] * ri) * wa[bj][n] + bb[bj][n]; acc[ai][bj][m][n] = y;
                        mx = __builtin_fmaxf(mx, __builtin_fmaxf(__builtin_fmaxf(__builtin_fabsf(y.x), __builtin_fabsf(y.y)), __builtin_fmaxf(__builtin_fabsf(y.z), __builtin_fabsf(y.w)))); }
                mx = __builtin_fmaxf(mx, xorf<16>(mx)); mx = x32_max(mx);
                if (fq == 0) P[r * 4 + wc] = mx; }
        asm volatile("s_waitcnt lgkmcnt(0)" ::: "memory"); __builtin_amdgcn_s_barrier(); asm volatile("" ::: "memory");
        if (t_ < 32) { const float tp = __builtin_fmaxf(__builtin_fmaxf(P[row * 4 + 0], P[row * 4 + 1]), __builtin_fmaxf(P[row * 4 + 2], P[row * 4 + 3]));
            __hip_atomic_store(xbuf2 + ((size_t)(u.pm * BM + row) * 4 + u.pn), __float_as_uint(tp), RLX_AGENT); }
        asm volatile("s_waitcnt vmcnt(0)" ::: "memory");
        if (t_ == 0) (void)__hip_atomic_fetch_add(cnt2 + 64 * u.pm, 1u, RLX_AGENT);
        if (wid == 0) {
            unsigned sp = 0u, dead = 0u;
            while ((unsigned)__builtin_amdgcn_readfirstlane((int)__hip_atomic_load(cnt2 + 64 * u.pm, RLX_AGENT)) < 32u) {
                __builtin_amdgcn_s_sleep(2);
                if ((++sp & 255u) == 0u) { if (__builtin_amdgcn_readfirstlane((int)__hip_atomic_load(tmo, RLX_AGENT)) != 0) { dead = 1u; break; }
                    if (sp > (1u << 22)) { if (t_ == 0) __hip_atomic_store(tmo, 1u, RLX_AGENT); dead = 1u; break; } } }
            __builtin_amdgcn_fence(__ATOMIC_ACQUIRE, "agent");
            if (t_ == 0) flag[0] = dead;
        }
        asm volatile("s_waitcnt vmcnt(0) lgkmcnt(0)" ::: "memory"); __builtin_amdgcn_s_barrier(); asm volatile("" ::: "memory");
        if (t_ < 32) { const gu32* sl = xbuf2 + (size_t)(u.pm * BM + row) * 4; float am = 0.f;
#pragma unroll
            for (int q = 0; q < 4; ++q) am = __builtin_fmaxf(am, __uint_as_float(__hip_atomic_load(sl + q, RLX_AGENT)));
            Sr[row] = am > 0.f ? 127.f / am : 0.f;
            if (u.pn == 0) SXG[u.pm * BM + row] = am * (1.f / 127.f); }
        asm volatile("s_waitcnt vmcnt(0) lgkmcnt(0)" ::: "memory"); __builtin_amdgcn_s_barrier(); asm volatile("" ::: "memory");
#pragma unroll
        for (int ai = 0; ai < 2; ++ai)
#pragma unroll
            for (int m = 0; m < 4; ++m) { const int r = ai * HALF + wr * 64 + m * 16 + fr; const float ix = Sr[r];
#pragma unroll
                for (int bj = 0; bj < 2; ++bj) { v2u o;
#pragma unroll
                    for (int n = 0; n < 2; ++n) { const f32x4 y = acc[ai][bj][m][n] * ix;
                        const int q0 = (int)__builtin_rintf(y.x), q1 = (int)__builtin_rintf(y.y), q2 = (int)__builtin_rintf(y.z), q3 = (int)__builtin_rintf(y.w);
                        o[n] = (unsigned)(q0 & 0xff) | ((unsigned)(q1 & 0xff) << 8) | ((unsigned)(q2 & 0xff) << 16) | ((unsigned)(q3 & 0xff) << 24); }
                    *(v2u*)(XQ + (size_t)(u.pm * BM + r) * DM + col0 + bj * HALF) = o; } }
    }
};
struct EpiS {
    static constexpr bool PERM = true;
    float* S;
    __device__ __forceinline__ void operator()(const f32x4 (&acc)[2][2][4][2], const Unit& u, int wr, int wc, int, int) const {
        const int t_ = lane_now(); const int fr = t_ & 15, fq = (t_ >> 4) & 3;
        const int col0 = u.pn * BM + wc * 32 + 8 * fq;
        bf16_t* Sb = (bf16_t*)S;
#pragma unroll
        for (int ai = 0; ai < 2; ++ai)
#pragma unroll
            for (int m = 0; m < 4; ++m) { bf16_t* rowp = Sb + (size_t)(u.pm * BM + ai * HALF + wr * 64 + m * 16 + fr) * 2048 + col0;
#pragma unroll
                for (int bj = 0; bj < 2; ++bj) { const f32x4 a0 = acc[ai][bj][m][0], a1 = acc[ai][bj][m][1];
                    v4u o; o.x = pk2(a0.x, a0.y); o.y = pk2(a0.z, a0.w); o.z = pk2(a1.x, a1.y); o.w = pk2(a1.z, a1.w);
                    *(v4u*)(rowp + bj * HALF) = o; } }
    }
};
struct EpiS8 {
    static constexpr bool PERM = true;
    float* S; const float* SXG; const float* SW;
    __device__ __forceinline__ void operator()(const f32x4 (&acc)[2][2][4][2], const Unit& u, int wr, int wc, int, int) const {
        const int t_ = lane_now(); const int fr = t_ & 15, fq = (t_ >> 4) & 3;
        const int col0 = u.pn * BM + wc * 32 + 8 * fq;
        bf16_t* Sb = (bf16_t*)S;
        f32x4 sw[2][2];
#pragma unroll
        for (int bj = 0; bj < 2; ++bj)
#pragma unroll
            for (int n = 0; n < 2; ++n) sw[bj][n] = *(const f32x4*)(SW + col0 + bj * HALF + 4 * n);
#pragma unroll
        for (int ai = 0; ai < 2; ++ai)
#pragma unroll
            for (int m = 0; m < 4; ++m) { const int row = u.pm * BM + ai * HALF + wr * 64 + m * 16 + fr; const float sx = SXG[row];
                bf16_t* rowp = Sb + (size_t)row * 2048 + col0;
#pragma unroll
                for (int bj = 0; bj < 2; ++bj) { const i32x4 i0 = __builtin_bit_cast(i32x4, acc[ai][bj][m][0]), i1 = __builtin_bit_cast(i32x4, acc[ai][bj][m][1]);
                    const f32x4 a0 = __builtin_convertvector(i0, f32x4) * sx * sw[bj][0], a1 = __builtin_convertvector(i1, f32x4) * sx * sw[bj][1];
                    v4u o; o.x = pk2(a0.x, a0.y); o.y = pk2(a0.z, a0.w); o.z = pk2(a1.x, a1.y); o.w = pk2(a1.z, a1.w);
                    *(v4u*)(rowp + bj * HALF) = o; } }
    }
};
}
namespace att {
using bf16 = __hip_bfloat16;
constexpr int NW = 8, QBLK = 32, QB = 256, KVBLK = 64;
__device__ __forceinline__ int crow(int r, int hi) { return (r & 3) + 8 * (r >> 2) + 4 * hi; }
#define SBAR() __builtin_amdgcn_sched_barrier(0)
constexpr int NSLOT = 3, SLOTB = 8192;
constexpr int LDS_K = 0, LDS_V = NSLOT * SLOTB, LDS_WS = 2 * NSLOT * SLOTB, LDS_OST = LDS_WS + NW * 64 * 4, LDS_RPB = LDS_OST + NW * 8192, LDS_BYTES = LDS_RPB + 2048;
static_assert(LDS_BYTES <= RING_BYTES, "attention scratch fits the ring region");
__device__ __forceinline__ void glds16(const void* gsrc, unsigned lds_dst) { unsigned keep;
    asm volatile("s_mov_b32 %0, m0\n\ts_mov_b32 m0, %2\n\ts_nop 0\n\tglobal_load_lds_dwordx4 %1, off\n\ts_mov_b32 m0, %0" : "=&s"(keep) : "v"(gsrc), "s"(lds_dst) : "memory"); }
__device__ __forceinline__ float max3f(float a, float b, float c) { float r; asm("v_max3_f32 %0, %1, %2, %3" : "=v"(r) : "v"(a), "v"(b), "v"(c)); return r; }
__device__ __forceinline__ float max2f(float a, float b) { float r; asm("v_max_f32_e32 %0, %1, %2" : "=v"(r) : "v"(a), "v"(b)); return r; }
__device__ __forceinline__ float fadd_s(float a, float b) { float r; asm("v_add_f32_e32 %0, %1, %2" : "=v"(r) : "v"(a), "v"(b)); return r; }
__device__ __forceinline__ float fsub_s(float a, float b) { float r; asm("v_sub_f32_e32 %0, %1, %2" : "=v"(r) : "v"(a), "v"(b)); return r; }
__device__ __forceinline__ unsigned cvtpk_s(float lo, float hi) { f32x2 v = {lo, hi}; bf16x2_t b = __builtin_convertvector(v, bf16x2_t); return __builtin_bit_cast(unsigned, b); }
#define WAIT_BAR(N) asm volatile("s_waitcnt vmcnt(" #N ") lgkmcnt(0)\n\ts_barrier" ::: "memory")

__device__ __forceinline__ void qkt(f32x16& p0, f32x16& p1, const char* Kslot, const bf16x8* qr, const f32x16& negm, int r32, int hi) {
    const char* kb = Kslot + hi * 1024 + r32 * 16;
#pragma unroll
    for (int d0 = 0; d0 < 4; ++d0) {
        const bf16x8 b0 = *reinterpret_cast<const bf16x8*>(kb + d0 * 2048);
        const bf16x8 b1 = *reinterpret_cast<const bf16x8*>(kb + d0 * 2048 + 512);
        if (d0 == 0) { p0 = __builtin_amdgcn_mfma_f32_32x32x16_bf16(b0, qr[0], negm, 0, 0, 0); p1 = __builtin_amdgcn_mfma_f32_32x32x16_bf16(b1, qr[0], negm, 0, 0, 0); }
        else { p0 = __builtin_amdgcn_mfma_f32_32x32x16_bf16(b0, qr[d0], p0, 0, 0, 0); p1 = __builtin_amdgcn_mfma_f32_32x32x16_bf16(b1, qr[d0], p1, 0, 0, 0); } }
}
typedef __attribute__((address_space(3))) const char* lds_cptr;
typedef short v4i16_t __attribute__((ext_vector_type(4)));
__device__ __forceinline__ void kload8(bf16x8* kf, lds_cptr kp) {
    kf[0] = *(const __attribute__((address_space(3))) bf16x8*)(kp);        kf[1] = *(const __attribute__((address_space(3))) bf16x8*)(kp + 512);
    kf[2] = *(const __attribute__((address_space(3))) bf16x8*)(kp + 2048); kf[3] = *(const __attribute__((address_space(3))) bf16x8*)(kp + 2560);
    kf[4] = *(const __attribute__((address_space(3))) bf16x8*)(kp + 4096); kf[5] = *(const __attribute__((address_space(3))) bf16x8*)(kp + 4608);
    kf[6] = *(const __attribute__((address_space(3))) bf16x8*)(kp + 6144); kf[7] = *(const __attribute__((address_space(3))) bf16x8*)(kp + 6656);
}
__device__ __forceinline__ void kload2(bf16x8* kf, lds_cptr kp, int j) { kf[2 * j] = *(const __attribute__((address_space(3))) bf16x8*)(kp + j * 2048); kf[2 * j + 1] = *(const __attribute__((address_space(3))) bf16x8*)(kp + j * 2048 + 512); }
__device__ __forceinline__ s16x4 vtr(lds_cptr p) { return __builtin_bit_cast(s16x4, __builtin_amdgcn_ds_read_tr16_b64_v4i16((__attribute__((address_space(3))) v4i16_t*)p)); }
__device__ __forceinline__ float rowmax(const f32x16& p0, const f32x16& p1) {
    float a = max3f(p0[0], p0[1], p1[0]), b = max3f(p0[2], p0[3], p1[1]); a = max3f(a, p1[2], p1[3]);
#pragma unroll
    for (int r = 4; r < 16; r += 4) { a = max3f(a, p0[r], p0[r + 1]); b = max3f(b, p0[r + 2], p0[r + 3]); a = max3f(a, p1[r], p1[r + 1]); b = max3f(b, p1[r + 2], p1[r + 3]); }
    const float m = max2f(a, b);
    auto rr = __builtin_amdgcn_permlane32_swap(__float_as_uint(m), __float_as_uint(m), false, false);
    return max2f(__uint_as_float(rr[0]), __uint_as_float(rr[1]));
}
__device__ __forceinline__ void pv(f32x16* o, int vb, bf16x8 pa0, bf16x8 pa1, bf16x8 pa2, bf16x8 pa3) {
#pragma unroll
    for (int d0 = 0; d0 < 2; ++d0) { s16x4 lo[4], hi[4];
#pragma unroll
        for (int ks = 0; ks < 4; ++ks) {
            asm volatile("ds_read_b64_tr_b16 %0,%1 offset:%c2" : "=&v"(lo[ks]) : "v"(vb), "i"(d0 * 4096 + ks * 1024) : "memory");
            asm volatile("ds_read_b64_tr_b16 %0,%1 offset:%c2" : "=&v"(hi[ks]) : "v"(vb), "i"(d0 * 4096 + ks * 1024 + 512) : "memory"); }
        asm volatile("s_waitcnt lgkmcnt(0)" ::: "memory"); SBAR();
#define PK(k) (bf16x8){lo[k][0], lo[k][1], lo[k][2], lo[k][3], hi[k][0], hi[k][1], hi[k][2], hi[k][3]}
        o[d0] = __builtin_amdgcn_mfma_f32_32x32x16_bf16(pa0, PK(0), o[d0], 0, 0, 0);
        o[d0] = __builtin_amdgcn_mfma_f32_32x32x16_bf16(pa1, PK(1), o[d0], 0, 0, 0);
        o[d0] = __builtin_amdgcn_mfma_f32_32x32x16_bf16(pa2, PK(2), o[d0], 0, 0, 0);
        o[d0] = __builtin_amdgcn_mfma_f32_32x32x16_bf16(pa3, PK(3), o[d0], 0, 0, 0);
#undef PK
    }
}

struct AU {
    const bf16* Q; const bf16* K; const bf16* V;
    bf16* O;
    int q0, NT, kbase;
    float sinkl2;
    int emode;
    float lam, oscale; const float* subw;
};

template <int MODE> __device__ __forceinline__ void amask(f32x16& p0, f32x16& p1, int t, const AU& u, int wid, int r32, int hi, const float* rpb) {
    if constexpr (MODE == 2) {
        if (t >= 4) {
            const int kp0 = u.kbase + 64 * (t - 4) + 4 * hi, qpos = u.q0 + wid * QBLK + r32;
#pragma unroll
            for (int r = 0; r < 16; ++r) { const int kv = kp0 + (r & 3) + 8 * (r >> 2);
                const bool ok0 = ((unsigned)(kv - qpos + 128) <= 256u) && ((unsigned)kv < (unsigned)SEQ);
                const bool ok1 = ((unsigned)(kv + 32 - qpos + 128) <= 256u) && ((unsigned)(kv + 32) < (unsigned)SEQ);
                if (!ok0) p0[r] = -INFINITY; if (!ok1) p1[r] = -INFINITY; }
        }
    }
    if constexpr (MODE == 1) {
        if (t >= 4) {
            const int jr = (u.kbase >> 6) + (t - 4), qr = (u.q0 >> 6) + (wid >> 1), qc = 32 * (wid & 1) + r32;
            int rs = qr - 4; rs = rs < 0 ? 0 : (rs > 248 ? 248 : rs);
            int cs = qc - 8; cs = cs < 0 ? 0 : (cs > 48 ? 48 : cs);
            const bool rowok = (unsigned)(jr - rs) < 8u;
            int ro = jr - qr + 7; ro = ro < 0 ? 0 : (ro > 14 ? 14 : ro);
            const float* brow = rpb + ro * 32;
#pragma unroll
            for (int r = 0; r < 16; ++r) { const int kc = 4 * hi + (r & 3) + 8 * (r >> 2);
                { int bi = kc - qc + 15; bi = bi < 0 ? 0 : (bi > 30 ? 30 : bi); const bool ok = rowok && ((unsigned)(kc - cs) < 16u); p0[r] = ok ? p0[r] + brow[bi] : -INFINITY; }
                { int bi = kc + 32 - qc + 15; bi = bi < 0 ? 0 : (bi > 30 ? 30 : bi); const bool ok = rowok && ((unsigned)(kc + 32 - cs) < 16u); p1[r] = ok ? p1[r] + brow[bi] : -INFINITY; } }
        }
    }
}

template <int MODE, int THRL, int QKH = 0, int NOMAX = 0> __device__ __forceinline__ bool attn_unit(const AU& u, char* shm, int wave) {
    const int lane = lane_now(), tid = (wave << 6) | lane, r32 = lane & 31, hi = lane >> 5; const int wid = wave;
    const bf16* Qw = u.Q + (size_t)(u.q0 + wid * QBLK) * 64;
    const bf16* Kh = u.K; const bf16* Vh = u.V;
    const unsigned lds0 = (unsigned)(uintptr_t)shm;
    float* wsf = (float*)(shm + LDS_WS) + wid * 64;
    const float* rpb = (const float*)(shm + LDS_RPB);
    const int NT = u.NT;
    volatile int* okflag = (volatile int*)(shm + LDS_RPB + 2040);
    if constexpr (NOMAX) { if (tid == 0) *okflag = 0; }
#define KROW(t) ((t) < 4 ? SEQ + 64 * (t) : (u.kbase + 64 * ((t) - 4) < 0 ? 0 : (u.kbase + 64 * ((t) - 4) > SEQ - 64 ? SEQ - 64 : u.kbase + 64 * ((t) - 4))))
    const bf16* ksrc = Kh + (size_t)lane * 64 + wid * 8;
    const bf16* vsrc = Vh + (size_t)(16 * (wid & 3) + (lane >> 2)) * 64 + (wid >> 2) * 32 + (lane & 3) * 8;
    const unsigned kdst = lds0 + LDS_K + wid * 1024, vdst = lds0 + LDS_V + wid * 1024;
#define DMA_K(t, slot) glds16(ksrc + (size_t)KROW(t) * 64, (unsigned)__builtin_amdgcn_readfirstlane(kdst + (slot)))
#define DMA_V(t, slot) glds16(vsrc + (size_t)KROW(t) * 64, (unsigned)__builtin_amdgcn_readfirstlane(vdst + (slot)))
    const int vb0 = (int)(lds0 + LDS_V) + ((lane >> 4) & 1) * 32 + (lane & 3) * 8 + (4 * hi + ((lane & 15) >> 2)) * 64;
    const char* Kbase = shm + LDS_K; bf16x8 kf[8];
    const lds_cptr shm3 = (lds_cptr)shm; const lds_cptr kp0 = shm3 + LDS_K + hi * 1024 + r32 * 16; const lds_cptr vp0 = shm3 + LDS_V + ((lane >> 4) & 1) * 32 + (lane & 3) * 8 + (4 * hi + ((lane & 15) >> 2)) * 64;
    DMA_K(0, 0); DMA_V(0, 0); DMA_K(1, SLOTB);
    bf16x8 qr[4];
#pragma unroll
    for (int d0 = 0; d0 < 4; ++d0) qr[d0] = *reinterpret_cast<const bf16x8*>(&Qw[(size_t)r32 * 64 + d0 * 16 + hi * 8]);
    float mhat = 0.f, l_reg = 0.f; f32x16 o[2]; o[0] = f32x16{}; o[1] = f32x16{}; f32x16 negm = f32x16{}; asm volatile("" : "+v"(negm));
#define CMASK(P0, P1, t) amask<MODE>(P0, P1, (t), u, wid, r32, hi, rpb)
    bool resc = false;
#define START(P0, P1) do { const float rm = rowmax(P0, P1); resc = false; \
    { const float dl = rm; mhat = fadd_s(mhat, dl); \
      _Pragma("unroll") for (int r = 0; r < 16; ++r) { P0[r] = fsub_s(P0[r], dl); P1[r] = fsub_s(P1[r], dl); } \
      _Pragma("unroll") for (int r = 0; r < 16; ++r) negm[r] = -mhat; asm volatile("" : "+v"(negm)); } \
    _Pragma("unroll") for (int r = 0; r < 16; ++r) P0[r] = __builtin_amdgcn_exp2f(P0[r]); } while (0)
#define RESC() do { if (resc) { asm volatile("s_waitcnt lgkmcnt(0)" ::: "memory"); \
      _Pragma("unroll") for (int d_ = 0; d_ < 2; ++d_) _Pragma("unroll") for (int r = 0; r < 16; ++r) o[d_][r] *= wsf[crow(r, hi)]; } } while (0)
    f32x16 pA0, pA1, pB0, pB1;
    int sl_prev = 0, sl_cur = 0, sl_next = SLOTB;
#define ROT() do { sl_prev = sl_cur; sl_cur = sl_next; sl_next = (sl_next == (NSLOT - 1) * SLOTB) ? 0 : sl_next + SLOTB; } while (0)
    DMA_K(2, 2 * SLOTB);
    WAIT_BAR(3);
    qkt(pA0, pA1, Kbase, qr, negm, r32, hi); asm volatile("s_nop 15\n\ts_nop 7" : "+v"(pA0), "+v"(pA1));
    START(pA0, pA1);
    _Pragma("unroll") for (int r = 0; r < 16; ++r) pA1[r] = __builtin_amdgcn_exp2f(pA1[r]);
    WAIT_BAR(0);
    DMA_K(3, 0); DMA_V(1, SLOTB);
    ROT();
    kload8(kf, kp0 + sl_cur);
    WAIT_BAR(2);
    s16x4 vlo[8], vhi[8]; v4u pw0, pw1, pw2, pw3;
#define PKW(P, B) cvtpk_s(P[B], P[B + 1])
#define PAF(k) __builtin_bit_cast(bf16x8, pw##k)
#define VFR(i) (bf16x8){vlo[i][0], vlo[i][1], vlo[i][2], vlo[i][3], vhi[i][0], vhi[i][1], vhi[i][2], vhi[i][3]}
#define PIN(x) asm volatile("" : "+v"(x))
#define MX3(a, b, c) __builtin_fmaxf(__builtin_fmaxf((a), (b)), (c))
#define GAPA(MF, A0, A1, A2, A3, W0, W1, PW) do { MF; sacc += A0; sacc += A1; sacc += A2; sacc += A3; PIN(sacc); W0; W1; PIN(PW); SBAR(); } while (0)
#define EX(v) __builtin_amdgcn_exp2f(v)
#define GAPB(MF, X, B) do { MF; X[B] = EX(X[B]); X[B + 1] = EX(X[B + 1]); X[B + 2] = EX(X[B + 2]); X[B + 3] = EX(X[B + 3]); PIN(X); SBAR(); } while (0)
#define VRD(i) do { vlo[i] = vtr(vp_ + (((i) >> 2) * 4096 + ((i) & 3) * 1024)); vhi[i] = vtr(vp_ + (((i) >> 2) * 4096 + ((i) & 3) * 1024 + 512)); } while (0)
#define KRD(G, j) do { if constexpr (QKH == 0 || (QKH == 1 && (j) < 2) || (QKH == 2 && (j) >= 2)) { if (G) { kload2(kf, kp0 + sl_next, j); SBAR(); } } } while (0)
#define MF32(a, b, c) __builtin_amdgcn_mfma_f32_32x32x16_bf16(a, b, c, 0, 0, 0)
#define QLO(X) do { if constexpr (QKH != 2) { X; } } while (0)
#define QHI(X0, X2) do { if constexpr (QKH == 0) { X0; } else if constexpr (QKH == 2) { X2; } } while (0)
#define STEP(C0, C1, P0, P1, t, GK, GV, GL) do { SBAR(); \
    const lds_cptr vp_ = vp0 + sl_prev; \
    VRD(0); SBAR(); float sacc = (P0[0] + P0[1]); \
    GAPA(QLO(C0 = MF32(kf[0], qr[0], negm)), P0[2], P0[3], P0[4], P0[5],     pw0[0] = PKW(P0, 0), pw0[1] = PKW(P0, 2), pw0); \
    VRD(4); SBAR(); GAPA(QLO(C1 = MF32(kf[1], qr[0], negm)), P0[6], P0[7], P0[8], P0[9],     pw0[2] = PKW(P0, 4), pw0[3] = PKW(P0, 6), pw0); \
    VRD(1); SBAR(); GAPA(QLO(C0 = MF32(kf[2], qr[1], C0)), P0[10], P0[11], P0[12], P0[13], pw1[0] = PKW(P0, 8), pw1[1] = PKW(P0, 10), pw1); \
    VRD(5); SBAR(); GAPA(QLO(C1 = MF32(kf[3], qr[1], C1)), P0[14], P0[15], P1[0], P1[1],   pw1[2] = PKW(P0, 12), pw1[3] = PKW(P0, 14), pw1); \
    VRD(2); SBAR(); GAPA(QHI(C0 = MF32(kf[4], qr[2], C0), C0 = MF32(kf[4], qr[2], negm)), P1[2], P1[3], P1[4], P1[5],     pw2[0] = PKW(P1, 0), pw2[1] = PKW(P1, 2), pw2); \
    VRD(6); SBAR(); GAPA(QHI(C1 = MF32(kf[5], qr[2], C1), C1 = MF32(kf[5], qr[2], negm)), P1[6], P1[7], P1[8], P1[9],     pw2[2] = PKW(P1, 4), pw2[3] = PKW(P1, 6), pw2); \
    VRD(3); SBAR(); GAPA(QHI(C0 = MF32(kf[6], qr[3], C0), C0 = MF32(kf[6], qr[3], C0)), P1[10], P1[11], P1[12], P1[13], pw3[0] = PKW(P1, 8), pw3[1] = PKW(P1, 10), pw3); \
    VRD(7); SBAR(); GAPA(QHI(C1 = MF32(kf[7], qr[3], C1), C1 = MF32(kf[7], qr[3], C1)), P1[14], P1[15], 0.f, 0.f,       pw3[2] = PKW(P1, 12), pw3[3] = PKW(P1, 14), pw3); \
    l_reg += sacc; \
    if (GK) { DMA_K((t) + 3, sl_cur); } if (GV) { DMA_V((t) + 1, sl_next); } \
    CMASK(C0, C1, t); \
    if constexpr (NOMAX) { resc = false; } else { float a = MX3(C0[0], C0[1], C1[0]), b = MX3(C0[2], C0[3], C1[1]); a = MX3(a, C1[2], C1[3]); \
      _Pragma("unroll") for (int r = 4; r < 16; r += 4) { a = MX3(a, C0[r], C0[r + 1]); b = MX3(b, C0[r + 2], C0[r + 3]); a = MX3(a, C1[r], C1[r + 1]); b = MX3(b, C1[r + 2], C1[r + 3]); } \
      float rm = __builtin_fmaxf(a, b); { auto rr = __builtin_amdgcn_permlane32_swap(__float_as_uint(rm), __float_as_uint(rm), false, false); rm = __builtin_fmaxf(__uint_as_float(rr[0]), __uint_as_float(rr[1])); } \
      resc = false; \
      if (__builtin_expect(__any(rm > (float)THRL), 0)) { const float dl = __builtin_fmaxf(rm, 0.f); mhat += dl; \
        _Pragma("unroll") for (int r = 0; r < 16; ++r) { C0[r] -= dl; C1[r] -= dl; } \
        _Pragma("unroll") for (int r = 0; r < 16; ++r) negm[r] = -mhat; asm volatile("" : "+v"(negm)); \
        const float f = __builtin_amdgcn_exp2f(-dl); l_reg *= f; if (hi == 0) wsf[r32] = f; resc = true; } } \
    SBAR(); \
    GAPB(o[0] = __builtin_amdgcn_mfma_f32_32x32x16_bf16(PAF(0), VFR(0), o[0], 0, 0, 0), C0, 0); \
    GAPB(o[1] = __builtin_amdgcn_mfma_f32_32x32x16_bf16(PAF(0), VFR(4), o[1], 0, 0, 0), C0, 4); \
    KRD(GL, 0); GAPB(o[0] = __builtin_amdgcn_mfma_f32_32x32x16_bf16(PAF(1), VFR(1), o[0], 0, 0, 0), C0, 8); \
    KRD(GL, 1); GAPB(o[1] = __builtin_amdgcn_mfma_f32_32x32x16_bf16(PAF(1), VFR(5), o[1], 0, 0, 0), C0, 12); \
    KRD(GL, 2); GAPB(o[0] = __builtin_amdgcn_mfma_f32_32x32x16_bf16(PAF(2), VFR(2), o[0], 0, 0, 0), C1, 0); \
    KRD(GL, 3); GAPB(o[1] = __builtin_amdgcn_mfma_f32_32x32x16_bf16(PAF(2), VFR(6), o[1], 0, 0, 0), C1, 4); \
    GAPB(o[0] = __builtin_amdgcn_mfma_f32_32x32x16_bf16(PAF(3), VFR(3), o[0], 0, 0, 0), C1, 8); \
    GAPB(o[1] = __builtin_amdgcn_mfma_f32_32x32x16_bf16(PAF(3), VFR(7), o[1], 0, 0, 0), C1, 12); \
    } while (0)
    int t = 1;
    for (; t + 5 < NT; t += 2) {
        STEP(pB0, pB1, pA0, pA1, t, true, true, true);     WAIT_BAR(2); RESC(); ROT();
        STEP(pA0, pA1, pB0, pB1, t + 1, true, true, true);   WAIT_BAR(2); RESC(); ROT();
    }
#define ENDW(tt) do { if ((tt) + 3 < NT) { WAIT_BAR(2); } else if ((tt) + 2 < NT) { WAIT_BAR(1); } else { WAIT_BAR(0); } } while (0)
    for (; t + 1 < NT; t += 2) {
        STEP(pB0, pB1, pA0, pA1, t, (t + 3 < NT), (t + 1 < NT), (t + 1 < NT));       ENDW(t);   RESC(); ROT();
        STEP(pA0, pA1, pB0, pB1, t + 1, (t + 4 < NT), (t + 2 < NT), (t + 2 < NT));     ENDW(t + 1); RESC(); ROT();
    }
    STEP(pB0, pB1, pA0, pA1, NT - 1, false, false, false); RESC();
    { float sacc = pB0[0] + pB0[1]; _Pragma("unroll") for (int r = 2; r < 16; ++r) sacc += pB0[r]; _Pragma("unroll") for (int r = 0; r < 16; ++r) sacc += pB1[r]; l_reg += sacc;
      pw0 = (v4u){PKW(pB0, 0), PKW(pB0, 2), PKW(pB0, 4), PKW(pB0, 6)}; pw1 = (v4u){PKW(pB0, 8), PKW(pB0, 10), PKW(pB0, 12), PKW(pB0, 14)}; pw2 = (v4u){PKW(pB1, 0), PKW(pB1, 2), PKW(pB1, 4), PKW(pB1, 6)}; pw3 = (v4u){PKW(pB1, 8), PKW(pB1, 10), PKW(pB1, 12), PKW(pB1, 14)};
      SBAR(); pv(o, vb0 + sl_cur, PAF(0), PAF(1), PAF(2), PAF(3)); }
#undef PKW
#undef PAF
#undef VFR
#undef PIN
#undef MX3
#undef GAPA
#undef GAPB
#undef EX
#undef VRD
#undef KRD
#undef MF32
#undef QLO
#undef QHI
#undef STEP
#undef ENDW
    { auto rr = __builtin_amdgcn_permlane32_swap(__float_as_uint(l_reg), __float_as_uint(l_reg), false, false); l_reg = __uint_as_float(rr[0]) + __uint_as_float(rr[1]); }
    if constexpr (NOMAX) {
        const bool ok = (l_reg > 0x1p-90f) && (l_reg < 0x1p90f);
        if (__any(!ok)) { if (lane == 0) *okflag = 1; }
        asm volatile("s_waitcnt lgkmcnt(0)\n\ts_barrier" ::: "memory");
        const int bad = __builtin_amdgcn_readfirstlane(*okflag);
        if (bad) { asm volatile("s_waitcnt lgkmcnt(0)\n\ts_barrier" ::: "memory"); return false; }
    }
    l_reg += __builtin_amdgcn_exp2f(u.sinkl2 - mhat);
    if (hi == 0) wsf[32 + r32] = l_reg; asm volatile("s_waitcnt lgkmcnt(0)" ::: "memory");
    float rli[16];
#pragma unroll
    for (int r = 0; r < 16; ++r) rli[r] = __builtin_amdgcn_rcpf(wsf[32 + crow(r, hi)]);
    if (u.emode == 0) {
        bf16* Ow = u.O + (size_t)(u.q0 + wid * QBLK) * 1024;
        bf16* stg = (bf16*)(shm + LDS_OST + wid * 8192);
#pragma unroll
        for (int r = 0; r < 16; ++r) { const int orow = crow(r, hi);
#pragma unroll
            for (int d0 = 0; d0 < 2; ++d0) stg[orow * 64 + d0 * 32 + r32] = __float2bfloat16(o[d0][r] * rli[r]); }
        asm volatile("s_waitcnt lgkmcnt(0)" ::: "memory");
#pragma unroll
        for (int i = 0; i < 4; ++i) { const int row = i * 8 + (lane >> 3), ch = lane & 7; const v4u v = *(const v4u*)(stg + row * 64 + ch * 8); *(v4u*)(Ow + (size_t)row * 1024 + ch * 8) = v; }
    } else {
        float* stf = (float*)(shm + LDS_OST + wid * 8192);
        if (u.emode == 1) {
#pragma unroll
            for (int r = 0; r < 16; ++r) { const int orow = crow(r, hi);
#pragma unroll
                for (int d0 = 0; d0 < 2; ++d0) stf[orow * 64 + d0 * 32 + r32] = o[d0][r] * rli[r]; }
        } else {
#pragma unroll
            for (int r = 0; r < 16; ++r) { const int orow = crow(r, hi);
#pragma unroll
                for (int d0 = 0; d0 < 2; ++d0) { const float y = stf[orow * 64 + d0 * 32 + r32] - u.lam * (o[d0][r] * rli[r]); stf[orow * 64 + d0 * 32 + r32] = y; } }
            asm volatile("s_waitcnt lgkmcnt(0)" ::: "memory");
            bf16* Ow = u.O + (size_t)(u.q0 + wid * QBLK) * 1024;
#pragma unroll
            for (int i = 0; i < 4; ++i) { const int row = i * 8 + (lane >> 3), ch = lane & 7;
                const f32x4 y0 = *(const f32x4*)(stf + row * 64 + ch * 8), y1 = *(const f32x4*)(stf + row * 64 + ch * 8 + 4);
                float ss = (y0[0] * y0[0] + y0[1] * y0[1]) + (y0[2] * y0[2] + y0[3] * y0[3]) + (y1[0] * y1[0] + y1[1] * y1[1]) + (y1[2] * y1[2] + y1[3] * y1[3]);
                ss += xorf<1>(ss); ss += xorf<2>(ss); ss += xorf<4>(ss);
                const float ri = __builtin_amdgcn_rsqf(ss * (1.f / 64.f) + EPS) * u.oscale;
                const f32x4 w0 = *(const f32x4*)(u.subw + ch * 8), w1 = *(const f32x4*)(u.subw + ch * 8 + 4);
                v4u v; v.x = pk2(y0[0] * ri * w0[0], y0[1] * ri * w0[1]); v.y = pk2(y0[2] * ri * w0[2], y0[3] * ri * w0[3]); v.z = pk2(y1[0] * ri * w1[0], y1[1] * ri * w1[1]); v.w = pk2(y1[2] * ri * w1[2], y1[3] * ri * w1[3]);
                *(v4u*)(Ow + (size_t)row * 1024 + ch * 8) = v; }
        }
    }
    asm volatile("s_waitcnt lgkmcnt(0)\n\ts_barrier" ::: "memory");
    return true;
#undef DMA_K
#undef DMA_V
#undef KROW
#undef CMASK
#undef START
#undef RESC
#undef ROT
}

template <int MODE, int NOMAX = 0> __device__ __forceinline__ bool attn_simple(const AU& u, char* shm, int wave) {
    const int lane = lane_now(), tid = (wave << 6) | lane, r32 = lane & 31, hi = lane >> 5; const int wid = wave;
    const bf16* Qw = u.Q + (size_t)(u.q0 + wid * QBLK) * 64;
    const unsigned lds0 = (unsigned)(uintptr_t)shm;
    float* wsf = (float*)(shm + LDS_WS) + wid * 64;
    const float* rpb = (const float*)(shm + LDS_RPB);
    const int NT = u.NT;
    volatile int* okflag = (volatile int*)(shm + LDS_RPB + 2040);
    if constexpr (NOMAX) { if (tid == 0) *okflag = 0; }
#define KROW(t) ((t) < 4 ? SEQ + 64 * (t) : (u.kbase + 64 * ((t) - 4) < 0 ? 0 : (u.kbase + 64 * ((t) - 4) > SEQ - 64 ? SEQ - 64 : u.kbase + 64 * ((t) - 4))))
    const bf16* ksrc = u.K + (size_t)lane * 64 + wid * 8;
    const bf16* vsrc = u.V + (size_t)(16 * (wid & 3) + (lane >> 2)) * 64 + (wid >> 2) * 32 + (lane & 3) * 8;
    const unsigned kdst = lds0 + LDS_K + wid * 1024, vdst = lds0 + LDS_V + wid * 1024;
    const int vb0 = (int)(lds0 + LDS_V) + ((lane >> 4) & 1) * 32 + (lane & 3) * 8 + (4 * hi + ((lane & 15) >> 2)) * 64;
    { const int kr = KROW(0); glds16(ksrc + (size_t)kr * 64, (unsigned)__builtin_amdgcn_readfirstlane(kdst)); glds16(vsrc + (size_t)kr * 64, (unsigned)__builtin_amdgcn_readfirstlane(vdst)); }
    bf16x8 qr[4];
#pragma unroll
    for (int d0 = 0; d0 < 4; ++d0) qr[d0] = *reinterpret_cast<const bf16x8*>(&Qw[(size_t)r32 * 64 + d0 * 16 + hi * 8]);
    float m_run = -INFINITY, l_reg = 0.f; f32x16 o[2]; o[0] = f32x16{}; o[1] = f32x16{};
    const f32x16 zero = f32x16{};
#pragma unroll 1
    for (int t = 0; t < NT; ++t) {
        const int sl = (t & 1) * SLOTB;
        asm volatile("s_waitcnt vmcnt(0) lgkmcnt(0)\n\ts_barrier" ::: "memory");
        if (t + 1 < NT) { const int kr = KROW(t + 1); const int sn = ((t + 1) & 1) * SLOTB;
            glds16(ksrc + (size_t)kr * 64, (unsigned)__builtin_amdgcn_readfirstlane(kdst + sn)); glds16(vsrc + (size_t)kr * 64, (unsigned)__builtin_amdgcn_readfirstlane(vdst + sn)); }
        bool live = true;
        if (t >= 4) {
            if constexpr (MODE == 1) { const int jr = (u.kbase >> 6) + (t - 4), qr_ = (u.q0 >> 6) + (wid >> 1); int rs = qr_ - 4; rs = rs < 0 ? 0 : (rs > 248 ? 248 : rs); live = (unsigned)(jr - rs) < 8u; }
            if constexpr (MODE == 2) { const int k0 = u.kbase + 64 * (t - 4), qa = u.q0 + wid * QBLK; live = (k0 + 63 >= qa - 128) && (k0 <= qa + QBLK - 1 + 128); }
        }
        if (!live) continue;
        f32x16 p0, p1;
        qkt(p0, p1, shm + LDS_K + sl, qr, zero, r32, hi);
        amask<MODE>(p0, p1, t, u, wid, r32, hi, rpb);
        if (NOMAX && t > 0) {
            float sacc = 0.f;
#pragma unroll
            for (int r = 0; r < 16; ++r) { p0[r] = __builtin_amdgcn_exp2f(p0[r] - m_run); p1[r] = __builtin_amdgcn_exp2f(p1[r] - m_run); sacc += p0[r] + p1[r]; }
            l_reg += sacc;
        } else {
        float rm = p0[0];
#pragma unroll
        for (int r = 1; r < 16; ++r) rm = __builtin_fmaxf(rm, p0[r]);
#pragma unroll
        for (int r = 0; r < 16; ++r) rm = __builtin_fmaxf(rm, p1[r]);
        { auto rr = __builtin_amdgcn_permlane32_swap(__float_as_uint(rm), __float_as_uint(rm), false, false); rm = __builtin_fmaxf(__uint_as_float(rr[0]), __uint_as_float(rr[1])); }
        const float m_new = __builtin_fmaxf(m_run, rm);
        const float alpha = __builtin_amdgcn_exp2f(m_run - m_new); m_run = m_new;
        float sacc = 0.f;
#pragma unroll
        for (int r = 0; r < 16; ++r) { p0[r] = __builtin_amdgcn_exp2f(p0[r] - m_new); p1[r] = __builtin_amdgcn_exp2f(p1[r] - m_new); sacc += p0[r] + p1[r]; }
        l_reg = l_reg * alpha + sacc;
        if (hi == 0) wsf[r32] = alpha;
        asm volatile("s_waitcnt lgkmcnt(0)" ::: "memory");
#pragma unroll
        for (int d_ = 0; d_ < 2; ++d_)
#pragma unroll
            for (int r = 0; r < 16; ++r) o[d_][r] *= wsf[crow(r, hi)];
        }
        v4u pw0, pw1, pw2, pw3;
        pw0 = (v4u){cvtpk_s(p0[0], p0[1]), cvtpk_s(p0[2], p0[3]), cvtpk_s(p0[4], p0[5]), cvtpk_s(p0[6], p0[7])}; pw1 = (v4u){cvtpk_s(p0[8], p0[9]), cvtpk_s(p0[10], p0[11]), cvtpk_s(p0[12], p0[13]), cvtpk_s(p0[14], p0[15])};
        pw2 = (v4u){cvtpk_s(p1[0], p1[1]), cvtpk_s(p1[2], p1[3]), cvtpk_s(p1[4], p1[5]), cvtpk_s(p1[6], p1[7])}; pw3 = (v4u){cvtpk_s(p1[8], p1[9]), cvtpk_s(p1[10], p1[11]), cvtpk_s(p1[12], p1[13]), cvtpk_s(p1[14], p1[15])};
        asm volatile("s_waitcnt lgkmcnt(0)" ::: "memory"); SBAR();
        pv(o, vb0 + sl, __builtin_bit_cast(bf16x8, pw0), __builtin_bit_cast(bf16x8, pw1), __builtin_bit_cast(bf16x8, pw2), __builtin_bit_cast(bf16x8, pw3));
    }
    { auto rr = __builtin_amdgcn_permlane32_swap(__float_as_uint(l_reg), __float_as_uint(l_reg), false, false); l_reg = __uint_as_float(rr[0]) + __uint_as_float(rr[1]); }
    if constexpr (NOMAX) {
        const bool ok = (l_reg > 0x1p-90f) && (l_reg < 0x1p90f);
        if (__any(!ok)) { if (lane == 0) *okflag = 1; }
        asm volatile("s_waitcnt vmcnt(0) lgkmcnt(0)\n\ts_barrier" ::: "memory");
        const int bad = __builtin_amdgcn_readfirstlane(*okflag);
        if (bad) { asm volatile("s_waitcnt lgkmcnt(0)\n\ts_barrier" ::: "memory"); return false; }
    }
    l_reg += __builtin_amdgcn_exp2f(u.sinkl2 - m_run);
    asm volatile("s_waitcnt lgkmcnt(0)" ::: "memory");
    if (hi == 0) wsf[32 + r32] = l_reg; asm volatile("s_waitcnt lgkmcnt(0)" ::: "memory");
    float rli[16];
#pragma unroll
    for (int r = 0; r < 16; ++r) rli[r] = __builtin_amdgcn_rcpf(wsf[32 + crow(r, hi)]);
    {
        bf16* Ow = u.O + (size_t)(u.q0 + wid * QBLK) * 1024;
        bf16* stg = (bf16*)(shm + LDS_OST + wid * 8192);
#pragma unroll
        for (int r = 0; r < 16; ++r) { const int orow = crow(r, hi);
#pragma unroll
            for (int d0 = 0; d0 < 2; ++d0) stg[orow * 64 + d0 * 32 + r32] = __float2bfloat16(o[d0][r] * rli[r]); }
        asm volatile("s_waitcnt lgkmcnt(0)" ::: "memory");
#pragma unroll
        for (int i = 0; i < 4; ++i) { const int row = i * 8 + (lane >> 3), ch = lane & 7; const v4u v = *(const v4u*)(stg + row * 64 + ch * 8); *(v4u*)(Ow + (size_t)row * 1024 + ch * 8) = v; }
    }
    asm volatile("s_waitcnt vmcnt(0) lgkmcnt(0)\n\ts_barrier" ::: "memory");
    return true;
#undef KROW
}
#undef SBAR
#undef WAIT_BAR
}
struct Args { const float* in[23]; float* out; unsigned char* ws; int flags; int pad; };
enum { I_X = 0, I_C, I_CTX, I_CCTX, I_N1W, I_N2W, I_ADAW, I_ADAB, I_WIN, I_RPB, I_DLAM, I_SUBW, I_SINK, I_QKNW, I_WBR, I_WGATE, I_BGATE, I_WOUT, I_PWQ, I_PKEYS, I_PU, I_PV, I_FNW };

struct Frame {
    LAS unsigned char* lds; volatile LAS unsigned* MISC; gu32* ctl;
    int wave, vcu, G;
};
__device__ __forceinline__ int ltid(int wave) { return tid_now(wave); }

struct MapId   { __device__ __forceinline__ int operator()(int n) const { return n; } };
struct MapWin  { __device__ __forceinline__ int operator()(int n) const { return (n & ~255) + 128 * ((n >> 5) & 1) + 32 * ((n >> 6) & 3) + (n & 31); } };
struct MapGate { __device__ __forceinline__ int operator()(int n) const { const int br = n >> 10, ch = n & 1023; return 256 * (ch >> 6) + 128 * (br >> 1) + 32 * ((ch >> 4) & 3) + 16 * (br & 1) + (ch & 15); } };
template <class Map, bool F8 = false> __device__ __forceinline__ void transpose_item(const float* W, int K, int N, void* WTv, Map mp, LAS float* scr, int item, int lane) {
    bf16_t* WT = (bf16_t*)WTv; unsigned char* WT8 = (unsigned char*)WTv;
    const int nblk = N / 32, kb = item / nblk, nb = item % nblk, k0 = 64 * kb, n0 = 32 * nb;
#pragma unroll 8
    for (int i = 0; i < 32; ++i) { const int kk = 2 * i + (lane >> 5); scr[kk * 33 + (lane & 31)] = W[(size_t)(k0 + kk) * N + n0 + (lane & 31)]; }
    LDS_WAIT(); asm volatile("" ::: "memory");
    const int c = lane & 7;
#pragma unroll
    for (int j = 0; j < 4; ++j) { const int n = (lane >> 3) + 8 * j; const LAS float* s = scr + (8 * c) * 33 + n;
        int nn = n0 + n; asm volatile("" : "+v"(nn));
        if constexpr (F8) { v2u o; o.x = pk4_fp8(s[0 * 33] * 64.f, s[1 * 33] * 64.f, s[2 * 33] * 64.f, s[3 * 33] * 64.f); o.y = pk4_fp8(s[4 * 33] * 64.f, s[5 * 33] * 64.f, s[6 * 33] * 64.f, s[7 * 33] * 64.f);
            *(GAS v2u*)(WT8 + (size_t)mp(nn) * K + k0 + 8 * c) = o; }
        else { v4u o; o.x = pk2(s[0 * 33], s[1 * 33]); o.y = pk2(s[2 * 33], s[3 * 33]); o.z = pk2(s[4 * 33], s[5 * 33]); o.w = pk2(s[6 * 33], s[7 * 33]);
            *(GAS v4u*)(WT + (size_t)mp(nn) * K + k0 + 8 * c) = o; } }
    LDS_WAIT(); asm volatile("" ::: "memory");
}
__device__ __forceinline__ void modnorm_row(const float* xrow, bf16_t* orow, const float* nw, const float* sh, const float* sc, int lane, unsigned char* o8row = nullptr) {
    const GAS f32x4* xr = (const GAS f32x4*)xrow + lane;
    f32x4 v[4]; float s = 0.f;
#pragma unroll
    for (int j = 0; j < 4; ++j) { v[j] = xr[64 * j]; s += (v[j].x * v[j].x + v[j].y * v[j].y) + (v[j].z * v[j].z + v[j].w * v[j].w); }
    const float ri = __builtin_amdgcn_rsqf(wave_sum(s) * (1.f / DM) + EPS);
    GAS v2u* o8 = (GAS v2u*)orow + lane;
#pragma unroll
    for (int j = 0; j < 4; ++j) { const int col = 256 * j + 4 * lane; const f32x4 w = *(const f32x4*)(nw + col), a = *(const f32x4*)(sc + col), b = *(const f32x4*)(sh + col);
        const f32x4 y = (v[j] * ri * w) * (1.0f + a) + b;
        if (orow) { v2u p; p.x = pk2(y.x, y.y); p.y = pk2(y.z, y.w); o8[64 * j] = p; }
        if (o8row) ((GAS unsigned*)o8row)[64 * j + lane] = pk4_fp8(y.x, y.y, y.z, y.w); }
}

__device__ __forceinline__ void ce_desc(float& a, float& b) { const float hi = __builtin_fmaxf(a, b), lo = __builtin_fminf(a, b); a = hi; b = lo; }
__device__ __forceinline__ void sort16_desc(float (&x)[16]) {
#pragma unroll
    for (int k = 2; k <= 16; k <<= 1)
#pragma unroll
        for (int j = k >> 1; j > 0; j >>= 1)
#pragma unroll
            for (int i = 0; i < 16; ++i) { const int l = i ^ j; if (l > i) { if ((i & k) == 0) ce_desc(x[i], x[l]); else ce_desc(x[l], x[i]); } }
}
__device__ __forceinline__ void merge16_desc(float (&top)[16], const float (&c)[16]) {
#pragma unroll
    for (int i = 0; i < 16; ++i) top[i] = __builtin_fmaxf(top[i], c[15 - i]);
#pragma unroll
    for (int j = 8; j > 0; j >>= 1)
#pragma unroll
        for (int i = 0; i < 16; ++i) { const int l = i ^ j; if (l > i) ce_desc(top[i], top[l]); }
}

struct PeerArgs { unsigned char* H8out_xq; unsigned char* H8out; const float* S; const bf16_t* Hin; const unsigned char* U; const unsigned char* V; const float* SU; const float* SV; const float* Xin; float* Xout;
                  const float* g2l; const float* g2c;
                  bf16_t* Hout; const float* nwn; const float* shl; const float* scl; const float* shc; const float* scc;
                  float* fout; const float* fnw;
                  int nblocks; int* dbg_eid; float* dbg_gt; bool dry; int route_reps; const float* SXG; };
struct PeerBufs;
constexpr int PL_LISTS = 0, PL_EID = 40960, PL_GT = PL_EID + 16384;
__device__ __forceinline__ float dot2bf(unsigned a, unsigned b, float acc) { return __builtin_amdgcn_fdot2_f32_bf16(__builtin_bit_cast(bf16x2_t, a), __builtin_bit_cast(bf16x2_t, b), acc, false); }
__device__ __forceinline__ float dot8(const v4u a, const v4u b, float acc) {
    const unsigned a0 = a.x, a1 = a.y, a2 = a.z, a3 = a.w, b0 = b.x, b1 = b.y, b2 = b.z, b3 = b.w;
    acc = dot2bf(a0, b0, acc); acc = dot2bf(a1, b1, acc); acc = dot2bf(a2, b2, acc); acc = dot2bf(a3, b3, acc);
    return acc;
}
struct PeerBufs { int* eid; float* gt; float* a; unsigned char* xq; float* sx; };
__device__ __forceinline__ void peer_route(Frame& F, const PeerArgs& P, const PeerBufs& B) {
    const int tid = ltid(F.wave), lane = tid & 63;
    LAS unsigned* lists = (LAS unsigned*)(F.lds + PL_LISTS);
    LAS int* eid = (LAS int*)(F.lds + PL_EID);
    LAS float* gt = (LAS float*)(F.lds + PL_GT);
    for (int blk = F.vcu; blk < P.nblocks; blk += F.G) {
        const int row0 = blk * 32;
        {
            const int tok = tid >> 4, lst = tid & 15;
            const float* sp = P.S + (size_t)(row0 + tok) * 2048 + lst * 128;
            float top[16];
#pragma unroll 1
            for (int c = 0; c < 8; ++c) {
                float x[16];
#pragma unroll
                for (int q = 0; q < 4; ++q) { const f32x4 v = *(const f32x4*)(sp + c * 16 + q * 4);
#pragma unroll
                    for (int j = 0; j < 4; ++j) x[q * 4 + j] = __uint_as_float((__float_as_uint(v[j]) & ~127u) | (unsigned)(c * 16 + q * 4 + j)); }
                sort16_desc(x);
                if (c == 0) {
#pragma unroll
                    for (int i = 0; i < 16; ++i) top[i] = x[i];
                } else merge16_desc(top, x);
            }
            LAS unsigned* lp = lists + tid * 20;
#pragma unroll
            for (int q = 0; q < 4; ++q) *(LAS v4u*)(lp + q * 4) = (v4u){__float_as_uint(top[q * 4]), __float_as_uint(top[q * 4 + 1]), __float_as_uint(top[q * 4 + 2]), __float_as_uint(top[q * 4 + 3])};
        }
        __syncthreads();
        if (tid < 256) {
            const int tok = tid >> 3, hd = tid & 7;
            const LAS unsigned* la = lists + (tok * 16 + 2 * hd) * 20; const LAS unsigned* lb = la + 20;
            float av[16], bv[16];
#pragma unroll
            for (int q = 0; q < 4; ++q) { const v4u a = *(const LAS v4u*)(la + q * 4), b = *(const LAS v4u*)(lb + q * 4);
#pragma unroll
                for (int j = 0; j < 4; ++j) { av[q * 4 + j] = __uint_as_float(a[j] & ~127u); bv[q * 4 + j] = __uint_as_float(b[j] & ~127u); } }
            float c0[16], c1[16], c2[16], c3[16];
#pragma unroll
            for (int i = 0; i < 16; ++i) { c0[i] = -INFINITY; c1[i] = -INFINITY; c2[i] = -INFINITY; c3[i] = -INFINITY; }
            {
                int cnt = 0;
#pragma unroll
                for (int i = 0; i < 16; ++i)
#pragma unroll
                    for (int j = 0; j < 16; ++j) if ((i + 1) * (j + 1) <= 16) {
                        const float sm = __uint_as_float((__float_as_uint(av[i] + bv[j]) & ~255u) | (unsigned)(i * 16 + j));
                        const int slot = cnt & 15, arr = cnt >> 4;
                        if (arr == 0) c0[slot] = sm; else if (arr == 1) c1[slot] = sm; else if (arr == 2) c2[slot] = sm; else c3[slot] = sm;
                        ++cnt;
                    }
            }
            sort16_desc(c0); sort16_desc(c1); sort16_desc(c2); sort16_desc(c3);
            merge16_desc(c0, c1); merge16_desc(c0, c2); merge16_desc(c0, c3);
            float ev[16], sum = 0.f; const float m0 = __uint_as_float(__float_as_uint(c0[0]) & ~255u);
#pragma unroll
            for (int k = 0; k < 16; ++k) { ev[k] = fast_exp2((__uint_as_float(__float_as_uint(c0[k]) & ~255u) - m0) * LOG2E); sum += ev[k]; }
            const float rs = 1.0f / sum;
#pragma unroll
            for (int k = 0; k < 16; ++k) { const unsigned code = __float_as_uint(c0[k]) & 255u;
                const int ia = (int)(la[code >> 4] & 127u), ib = (int)(lb[code & 15u] & 127u);
                eid[tok * 128 + hd * 16 + k] = ia * NKEYS + ib; gt[tok * 128 + hd * 16 + k] = ev[k] * rs; }
        }
        __syncthreads();
#pragma unroll
        for (int i = 0; i < 8; ++i) { const int idx = i * NTHREADS + tid; B.eid[(size_t)row0 * 128 + idx] = eid[idx]; B.gt[(size_t)row0 * 128 + idx] = gt[idx]; }
#pragma unroll 1
        for (int tk = 0; tk < 4; ++tk) {
            const size_t row = (size_t)(row0 + F.wave * 4 + tk);
            const bf16_t* hp = P.Hin + row * DM + 16 * lane;
            const v4u h0 = *(const v4u*)hp, h1 = *(const v4u*)(hp + 8);
            float xf[16];
#pragma unroll
            for (int q = 0; q < 4; ++q) { xf[2 * q] = bflo(h0[q]); xf[2 * q + 1] = bfhi(h0[q]); xf[8 + 2 * q] = bflo(h1[q]); xf[8 + 2 * q + 1] = bfhi(h1[q]); }
            float am = 0.f;
#pragma unroll
            for (int i = 0; i < 16; ++i) am = __builtin_fmaxf(am, __builtin_fabsf(xf[i]));
            am = wave_max(am);
            const float ix = am > 0.f ? 127.f / am : 0.f;
            v4u xq;
#pragma unroll
            for (int q = 0; q < 4; ++q) { unsigned w = 0;
#pragma unroll
                for (int j = 0; j < 4; ++j) { const int v = (int)__builtin_rintf(xf[4 * q + j] * ix); w |= (unsigned)(v & 0xff) << (8 * j); }
                xq[q] = w; }
            *(v4u*)(B.xq + row * DM + 16 * lane) = xq;
            if (lane == 0) B.sx[row] = am * (1.f / 127.f);
        }
        __syncthreads();
    }
}
__device__ __forceinline__ int wave_isum(int v) {
    v += __builtin_amdgcn_update_dpp(0, v, 0xB1, 0xf, 0xf, false);
    v += __builtin_amdgcn_update_dpp(0, v, 0x4E, 0xf, 0xf, false);
    v += __builtin_amdgcn_update_dpp(0, v, 0x141, 0xf, 0xf, false);
    v += __builtin_amdgcn_update_dpp(0, v, 0x140, 0xf, 0xf, false);
    v += __builtin_amdgcn_update_dpp(0, v, 0x142, 0xa, 0xf, false);
    v += __builtin_amdgcn_update_dpp(0, v, 0x143, 0xc, 0xf, false);
    return __builtin_amdgcn_readlane(v, 63);
}
__device__ __forceinline__ int bperm_i(int v, int srclane) { return __builtin_amdgcn_ds_bpermute(srclane << 2, v); }
__device__ __forceinline__ float bperm_f(float v, int srclane) { return __builtin_bit_cast(float, __builtin_amdgcn_ds_bpermute(srclane << 2, __builtin_bit_cast(int, v))); }
__device__ __forceinline__ int treduce16(const int (&d)[16], int lane) {
    int s8[8], s4[4], s2[2];
#pragma unroll
    for (int i = 0; i < 8; ++i) { auto r = __builtin_amdgcn_permlane32_swap((unsigned)d[i], (unsigned)d[i + 8], false, false); s8[i] = (int)r[0] + (int)r[1]; }
#pragma unroll
    for (int i = 0; i < 4; ++i) { auto r = __builtin_amdgcn_permlane16_swap((unsigned)s8[i], (unsigned)s8[i + 4], false, false); s4[i] = (int)r[0] + (int)r[1]; }
    const bool b3 = (lane & 8) != 0, b2 = (lane & 4) != 0;
#pragma unroll
    for (int i = 0; i < 2; ++i) { const int keep = b3 ? s4[i + 2] : s4[i], send = b3 ? s4[i] : s4[i + 2]; s2[i] = keep + __builtin_amdgcn_update_dpp(0, send, 0x128, 0xf, 0xf, false); }
    int z; { const int keep = b2 ? s2[1] : s2[0], send = b2 ? s2[0] : s2[1]; z = keep + __builtin_amdgcn_ds_swizzle(send, 0x101F); }
    z += __builtin_amdgcn_update_dpp(0, z, 0x4E, 0xf, 0xf, false);
    z += __builtin_amdgcn_update_dpp(0, z, 0xB1, 0xf, 0xf, false);
    return z;
}
__device__ __forceinline__ void peer_u(Frame& F, const PeerArgs& P, const PeerBufs& B, int ntok) {
    const int lane = ltid(F.wave) & 63;
    const int nsl = 8, wps = (F.G / nsl) * NWAVES;
    const int j = F.vcu / (F.G / nsl), wsl = (F.vcu % (F.G / nsl)) * NWAVES + F.wave;
    const int esel = (lane >> 2) & 15;
    int t = wsl; if (t >= ntok) return;
    int e_lo = B.eid[(size_t)t * 128 + lane], e_hi = B.eid[(size_t)t * 128 + 64 + lane];
    float g_lo = B.gt[(size_t)t * 128 + lane], g_hi = B.gt[(size_t)t * 128 + 64 + lane];
    v4u xq = *(const v4u*)(B.xq + (size_t)t * DM + 16 * lane); float sx = B.sx[t];
    for (;;) {
        const int tn = t + wps; const bool more = tn < ntok; const int tp = more ? tn : t;
        const int ne_lo = B.eid[(size_t)tp * 128 + lane], ne_hi = B.eid[(size_t)tp * 128 + 64 + lane];
        const float ng_lo = B.gt[(size_t)tp * 128 + lane], ng_hi = B.gt[(size_t)tp * 128 + 64 + lane];
        const v4u nxq = *(const v4u*)(B.xq + (size_t)tp * DM + 16 * lane); const float nsx = B.sx[tp];
        unsigned long long m_lo = __ballot((e_lo >> 11) == j), m_hi = __ballot((e_hi >> 11) == j);
        const int n = __popcll(m_lo) + __popcll(m_hi);
        v4u ua[32]; int slotv0 = -1, idv0 = 0, slotv1 = -1, idv1 = 0;
#pragma unroll
        for (int q = 0; q < 32; ++q) {
            ua[q] = (v4u){0u, 0u, 0u, 0u};
            if (q < n) {
                int k, id;
                if (m_lo) { k = __builtin_ctzll(m_lo); m_lo &= m_lo - 1; id = __builtin_amdgcn_readlane(e_lo, k); }
                else { k = __builtin_ctzll(m_hi); m_hi &= m_hi - 1; id = __builtin_amdgcn_readlane(e_hi, k); k += 64; }
                ua[q] = *(const v4u*)(P.U + (size_t)id * DM + 16 * lane);
                if (q < 16) { if (esel == q) { slotv0 = k; idv0 = id; } } else { if (esel == q - 16) { slotv1 = k; idv1 = id; } }
            }
        }
        const float su0 = P.SU[idv0], sv0 = P.SV[idv0], su1 = P.SU[idv1], sv1 = P.SV[idv1];
        const float gl0 = bperm_f(g_lo, slotv0 & 63), gh0 = bperm_f(g_hi, slotv0 & 63), gl1 = bperm_f(g_lo, slotv1 & 63), gh1 = bperm_f(g_hi, slotv1 & 63);
        const float gg0 = slotv0 < 64 ? gl0 : gh0, gg1 = slotv1 < 64 ? gl1 : gh1;
        int d[16];
#pragma unroll
        for (int q = 0; q < 16; ++q) { int di = __builtin_amdgcn_sdot4((int)ua[q][0], (int)xq[0], 0, false); di = __builtin_amdgcn_sdot4((int)ua[q][1], (int)xq[1], di, false);
            di = __builtin_amdgcn_sdot4((int)ua[q][2], (int)xq[2], di, false); d[q] = __builtin_amdgcn_sdot4((int)ua[q][3], (int)xq[3], di, false); }
        { const int z = treduce16(d, lane);
          if (slotv0 >= 0 && (lane & 3) == 0) B.a[(size_t)t * 128 + slotv0] = gg0 * gelu_tanh((float)z * su0 * sx) * sv0; }
        if (n > 16) {
#pragma unroll
            for (int q = 0; q < 16; ++q) { int di = __builtin_amdgcn_sdot4((int)ua[16 + q][0], (int)xq[0], 0, false); di = __builtin_amdgcn_sdot4((int)ua[16 + q][1], (int)xq[1], di, false);
                di = __builtin_amdgcn_sdot4((int)ua[16 + q][2], (int)xq[2], di, false); d[q] = __builtin_amdgcn_sdot4((int)ua[16 + q][3], (int)xq[3], di, false); }
            const int z = treduce16(d, lane);
            if (slotv1 >= 0 && (lane & 3) == 0) B.a[(size_t)t * 128 + slotv1] = gg1 * gelu_tanh((float)z * su1 * sx) * sv1;
        }
        if (n > 32) {
            while (m_lo | m_hi) { int k, id;
                if (m_lo) { k = __builtin_ctzll(m_lo); m_lo &= m_lo - 1; id = __builtin_amdgcn_readlane(e_lo, k); }
                else { k = __builtin_ctzll(m_hi); m_hi &= m_hi - 1; id = __builtin_amdgcn_readlane(e_hi, k); k += 64; }
                const v4u u1 = *(const v4u*)(P.U + (size_t)id * DM + 16 * lane);
                int di = __builtin_amdgcn_sdot4((int)u1[0], (int)xq[0], 0, false); di = __builtin_amdgcn_sdot4((int)u1[1], (int)xq[1], di, false);
                di = __builtin_amdgcn_sdot4((int)u1[2], (int)xq[2], di, false); di = __builtin_amdgcn_sdot4((int)u1[3], (int)xq[3], di, false);
                const int tot = wave_isum(di);
                const float g = __uint_as_float(k < 64 ? __builtin_amdgcn_readlane(__float_as_uint(g_lo), k) : __builtin_amdgcn_readlane(__float_as_uint(g_hi), k - 64));
                if (lane == 0) B.a[(size_t)t * 128 + k] = g * gelu_tanh((float)tot * P.SU[id] * sx) * P.SV[id]; }
        }
        if (!more) break;
        t = tn; e_lo = ne_lo; e_hi = ne_hi; g_lo = ng_lo; g_hi = ng_hi; xq = nxq; sx = nsx;
    }
}
__device__ __forceinline__ void peer_v(Frame& F, const PeerArgs& P, const PeerBufs& B, int ntok) {
    const int lane = ltid(F.wave) & 63;
    const int nsl = 8, wps = (F.G / nsl) * NWAVES;
    const int j = F.vcu / (F.G / nsl), wsl = (F.vcu % (F.G / nsl)) * NWAVES + F.wave;
    const int grp = lane >> 3, ch = lane & 7;
    int t = wsl; if (t >= ntok) return;
#define PV_HDR(tt, EL, EH, CL, CH) do { EL = B.eid[(size_t)(tt) * 128 + lane]; EH = B.eid[(size_t)(tt) * 128 + 64 + lane]; CL = B.a[(size_t)(tt) * 128 + lane]; CH = B.a[(size_t)(tt) * 128 + 64 + lane]; } while (0)
#define PV_ROWS(W, CF, EL, EH, CL, CH) do { _Pragma("unroll") for (int i = 0; i < 16; ++i) { const int src = (8 * i + grp) & 63; const int id = bperm_i(i < 8 ? EL : EH, src); CF[i] = bperm_f(i < 8 ? CL : CH, src); \
            W[i] = *(const v4u*)(P.V + (size_t)id * DM + 128 * j + 16 * ch); } } while (0)
    int e_lo, e_hi, ne_lo, ne_hi; float c_lo, c_hi, nc_lo, nc_hi;
    v4u wA[16], wB[16]; float cfA[16], cfB[16];
    PV_HDR(t, e_lo, e_hi, c_lo, c_hi);
    { const int t1 = (t + wps < ntok) ? t + wps : t; PV_HDR(t1, ne_lo, ne_hi, nc_lo, nc_hi); }
    PV_ROWS(wA, cfA, e_lo, e_hi, c_lo, c_hi);
#define PV_STEP(W, CF, WN, CFN) do { \
        const int tn = t + wps; const bool more = tn < ntok; \
        if (more) { PV_ROWS(WN, CFN, ne_lo, ne_hi, nc_lo, nc_hi); const int t2 = (tn + wps < ntok) ? tn + wps : tn; PV_HDR(t2, ne_lo, ne_hi, nc_lo, nc_hi); } \
        float acc[16]; float asum = 0.f; \
        _Pragma("unroll") for (int c = 0; c < 16; ++c) acc[c] = 0.f; \
        _Pragma("unroll") for (int i = 0; i < 16; ++i) { asum += CF[i]; const f32x2 cf2 = {CF[i], CF[i]}; \
            _Pragma("unroll") for (int q = 0; q < 4; ++q) { const unsigned x = W[i][q]; \
                const f32x2 v01 = {(float)(x & 0xffu), (float)((x >> 8) & 0xffu)}, v23 = {(float)((x >> 16) & 0xffu), (float)(x >> 24)}; \
                f32x2 o01 = {acc[4 * q], acc[4 * q + 1]}, o23 = {acc[4 * q + 2], acc[4 * q + 3]}; \
                o01 = __builtin_elementwise_fma(cf2, v01, o01); o23 = __builtin_elementwise_fma(cf2, v23, o23); \
                acc[4 * q] = o01.x; acc[4 * q + 1] = o01.y; acc[4 * q + 2] = o23.x; acc[4 * q + 3] = o23.y; } } \
        asum += __builtin_bit_cast(float, __builtin_amdgcn_update_dpp(0, __builtin_bit_cast(int, asum), 0x128, 0xf, 0xf, false)); asum += xorf<16>(asum); asum = x32_sum(asum); \
        _Pragma("unroll") for (int c = 0; c < 16; ++c) { acc[c] += __builtin_bit_cast(float, __builtin_amdgcn_update_dpp(0, __builtin_bit_cast(int, acc[c]), 0x128, 0xf, 0xf, false)); acc[c] += xorf<16>(acc[c]); acc[c] = x32_sum(acc[c]); } \
        if (lane < 8) { \
            const int col0 = 128 * j + 16 * lane; const float* g2 = (t < SEQ) ? P.g2l : P.g2c; \
            _Pragma("unroll") for (int q = 0; q < 4; ++q) { const f32x4 xo = *(const f32x4*)(P.Xin + (size_t)t * DM + col0 + 4 * q), g = *(const f32x4*)(g2 + col0 + 4 * q); \
                f32x4 y; y.x = xo.x + g.x * (acc[4 * q] - 128.f * asum); y.y = xo.y + g.y * (acc[4 * q + 1] - 128.f * asum); y.z = xo.z + g.z * (acc[4 * q + 2] - 128.f * asum); y.w = xo.w + g.w * (acc[4 * q + 3] - 128.f * asum); \
                *(f32x4*)(P.Xout + (size_t)t * DM + col0 + 4 * q) = y; } \
        } \
        done = !more; t = tn; } while (0)
    bool done = false;
    for (;;) {
        PV_STEP(wA, cfA, wB, cfB); if (done) break;
        PV_STEP(wB, cfB, wA, cfA); if (done) break;
    }
#undef PV_HDR
#undef PV_ROWS
#undef PV_STEP
}
__device__ __forceinline__ void peer_norm(Frame& F, const PeerArgs& P, int ntok) {
    const int lane = ltid(F.wave) & 63; const int gw = F.vcu * NWAVES + F.wave, NGW = F.G * NWAVES;
    for (int t = gw; t < ntok; t += NGW) {
        const bool latent = t < SEQ;
        if (P.fout) {
            const GAS f32x4* xr = (const GAS f32x4*)(P.Xout + (size_t)t * DM) + lane; f32x4 v[4]; float s = 0.f;
#pragma unroll
            for (int q = 0; q < 4; ++q) { v[q] = xr[64 * q]; s += (v[q].x * v[q].x + v[q].y * v[q].y) + (v[q].z * v[q].z + v[q].w * v[q].w); }
            const float ri = __builtin_amdgcn_rsqf(wave_sum(s) * (1.f / DM) + EPS);
#pragma unroll
            for (int q = 0; q < 4; ++q) { const f32x4 w = *(const f32x4*)(P.fnw + 256 * q + 4 * lane); *(f32x4*)(P.fout + (size_t)t * DM + 256 * q + 4 * lane) = v[q] * ri * w; }
        } else modnorm_row(P.Xout + (size_t)t * DM, P.Hout ? P.Hout + (size_t)t * DM : (bf16_t*)nullptr, P.nwn, latent ? P.shl : P.shc, latent ? P.scl : P.scc, lane, P.H8out ? P.H8out + (size_t)t * DM : (unsigned char*)nullptr);
    }
}

constexpr int P2_Y = 0;
constexpr int P2_EID = 73728, P2_GT = P2_EID + 72 * 128 * 2, P2_SX = P2_GT + 72 * 128 * 4, P2_END = P2_SX + 72 * 4;
static_assert(P2_END <= RING_BYTES, "peer2 LDS map");
template <int NTK> __device__ __forceinline__ void peer2_tokens(Frame& F, const PeerArgs& P, int t_begin, int lt0, int cnt, int lane_in) {
    int lane = lane_in; asm volatile("" : "+v"(lane));
    const LAS unsigned short* eidL = (const LAS unsigned short*)(F.lds + P2_EID); LAS float* gtL = (LAS float*)(F.lds + P2_GT); const LAS float* sxL = (const LAS float*)(F.lds + P2_SX);
#define g (lane >> 3)
#define c (lane & 7)
    const unsigned char* xqb = P.H8out_xq;
    int d[NTK][16];
#pragma unroll
    for (int tk = 0; tk < NTK; ++tk)
#pragma unroll
        for (int i = 0; i < 16; ++i) d[tk][i] = 0;
#pragma unroll 1
    for (int ps = 0; ps < 8; ++ps) {
#pragma unroll
        for (int tk = 0; tk < NTK; ++tk) {
            if (tk < cnt) {
                const int lt = lt0 + tk; const unsigned row = (unsigned)(t_begin + lt);
                const v4u xq = *(const GAS v4u*)(xqb + (unsigned)(row * DM + 128 * ps + 16 * c));
                v4u ua[16];
#pragma unroll
                for (int i = 0; i < 16; ++i) { const int id = eidL[lt * 128 + 8 * i + g]; ua[i] = *(const GAS v4u*)(P.U + (unsigned)((ps * NEXP + id) * 128 + 16 * c)); }
#pragma unroll
                for (int i = 0; i < 16; ++i) { int di = __builtin_amdgcn_sdot4((int)ua[i][0], (int)xq[0], d[tk][i], false); di = __builtin_amdgcn_sdot4((int)ua[i][1], (int)xq[1], di, false);
                    di = __builtin_amdgcn_sdot4((int)ua[i][2], (int)xq[2], di, false); d[tk][i] = __builtin_amdgcn_sdot4((int)ua[i][3], (int)xq[3], di, false); }
                __builtin_amdgcn_sched_barrier(0);
            }
        }
    }
    asm volatile("" : "+v"(lane));
#pragma unroll
    for (int tk = 0; tk < NTK; ++tk) {
        if (tk < cnt) {
            const int lt = lt0 + tk; const float sx = sxL[lt];
            int mine0 = 0, mine1 = 0;
#pragma unroll
            for (int i = 0; i < 16; ++i) { int v = d[tk][i];
                v += __builtin_amdgcn_update_dpp(0, v, 0xB1, 0xf, 0xf, false); v += __builtin_amdgcn_update_dpp(0, v, 0x4E, 0xf, 0xf, false); v += __builtin_amdgcn_update_dpp(0, v, 0x141, 0xf, 0xf, false);
                if ((i & 7) == c) { if (i < 8) mine0 = v; else mine1 = v; } }
#pragma unroll
            for (int hf = 0; hf < 2; ++hf) { const int e = 8 * (8 * hf + c) + g; const int id = eidL[lt * 128 + e];
                const f32x2 suv = ((const GAS f32x2*)P.SU)[id];
                const float pre = (float)(hf ? mine1 : mine0) * (suv.x * sx);
                gtL[lt * 128 + e] = gtL[lt * 128 + e] * gelu_tanh(pre) * suv.y; }
        }
    }
    LDS_WAIT();
    asm volatile("" : "+v"(lane));
    LAS unsigned char* yL = F.lds + P2_Y + F.wave * (4 * 2048);
#pragma unroll 1
    for (int ps = 0; ps < 8; ++ps) {
#pragma unroll
        for (int tk = 0; tk < NTK; ++tk) {
            if (tk < cnt) {
                const int lt = lt0 + tk; const unsigned row = (unsigned)(t_begin + lt);
                v4u w[16]; float cf[16];
#pragma unroll
                for (int i = 0; i < 16; ++i) { const int id = eidL[lt * 128 + 8 * i + g]; cf[i] = gtL[lt * 128 + 8 * i + g]; w[i] = *(const GAS v4u*)(P.V + (unsigned)((ps * NEXP + id) * 128 + 16 * c)); }
                float acc[16]; float asum = 0.f;
#pragma unroll
                for (int q = 0; q < 16; ++q) acc[q] = 0.f;
#pragma unroll
                for (int i = 0; i < 16; ++i) { asum += cf[i]; const f32x2 cf2 = {cf[i], cf[i]};
#pragma unroll
                    for (int q = 0; q < 4; ++q) { const unsigned x = w[i][q];
                        const f32x2 v01 = {(float)(x & 0xffu), (float)((x >> 8) & 0xffu)}, v23 = {(float)((x >> 16) & 0xffu), (float)(x >> 24)};
                        f32x2 o01 = {acc[4 * q], acc[4 * q + 1]}, o23 = {acc[4 * q + 2], acc[4 * q + 3]};
                        o01 = __builtin_elementwise_fma(cf2, v01, o01); o23 = __builtin_elementwise_fma(cf2, v23, o23);
                        acc[4 * q] = o01.x; acc[4 * q + 1] = o01.y; acc[4 * q + 2] = o23.x; acc[4 * q + 3] = o23.y; } }
                asum += __builtin_bit_cast(float, __builtin_amdgcn_update_dpp(0, __builtin_bit_cast(int, asum), 0x128, 0xf, 0xf, false)); asum += xorf<16>(asum); asum = x32_sum(asum);
#pragma unroll
                for (int q = 0; q < 16; ++q) { acc[q] += __builtin_bit_cast(float, __builtin_amdgcn_update_dpp(0, __builtin_bit_cast(int, acc[q]), 0x128, 0xf, 0xf, false)); acc[q] += xorf<16>(acc[q]); acc[q] = x32_sum(acc[q]); }
                if (lane < 8) {
                    v4u y0, y1;
                    y0.x = pk2(acc[0] - 128.f * asum, acc[1] - 128.f * asum); y0.y = pk2(acc[2] - 128.f * asum, acc[3] - 128.f * asum); y0.z = pk2(acc[4] - 128.f * asum, acc[5] - 128.f * asum); y0.w = pk2(acc[6] - 128.f * asum, acc[7] - 128.f * asum);
                    y1.x = pk2(acc[8] - 128.f * asum, acc[9] - 128.f * asum); y1.y = pk2(acc[10] - 128.f * asum, acc[11] - 128.f * asum); y1.z = pk2(acc[12] - 128.f * asum, acc[13] - 128.f * asum); y1.w = pk2(acc[14] - 128.f * asum, acc[15] - 128.f * asum);
                    LAS v4u* yp = (LAS v4u*)(yL + tk * 2048 + (128 * ps + 16 * lane) * 2); yp[0] = y0; yp[1] = y1;
                }
                __builtin_amdgcn_sched_barrier(0);
            }
        }
    }
    asm volatile("" : "+v"(lane));
    LDS_WAIT();
#pragma unroll
    for (int tk = 0; tk < NTK; ++tk) {
        if (tk < cnt) {
            const int lt = lt0 + tk; const unsigned row = (unsigned)(t_begin + lt); const bool latent = row < (unsigned)SEQ;
            const float* g2 = latent ? P.g2l : P.g2c;
            f32x4 xn[4]; float ss = 0.f;
#pragma unroll
            for (int q = 0; q < 4; ++q) { const unsigned col = 256 * q + 4 * lane; const f32x4 xo = __builtin_nontemporal_load((const GAS f32x4*)(P.Xin + (unsigned)(row * DM + col))), gq = *(const GAS f32x4*)(g2 + col);
                const v2u yy = *(const LAS v2u*)(yL + tk * 2048 + col * 2);
                f32x4 y; y.x = xo.x + gq.x * bflo(yy.x); y.y = xo.y + gq.y * bfhi(yy.x); y.z = xo.z + gq.z * bflo(yy.y); y.w = xo.w + gq.w * bfhi(yy.y);
                xn[q] = y; ss += (y.x * y.x + y.y * y.y) + (y.z * y.z + y.w * y.w); }
            const float ri = __builtin_amdgcn_rsqf(wave_sum(ss) * (1.f / DM) + EPS);
            if (P.fout) {
                if (latent) {
#pragma unroll
                    for (int q = 0; q < 4; ++q) { const unsigned col = 256 * q + 4 * lane; const f32x4 wq_ = *(const GAS f32x4*)(P.fnw + col); __builtin_nontemporal_store(xn[q] * ri * wq_, (GAS f32x4*)(P.fout + (unsigned)(row * DM + col))); }
                }
            } else {
                const float* sh = latent ? P.shl : P.shc; const float* sc = latent ? P.scl : P.scc;
#pragma unroll
                for (int q = 0; q < 4; ++q) { const unsigned col = 256 * q + 4 * lane; const f32x4 wn = *(const GAS f32x4*)(P.nwn + col), a = *(const GAS f32x4*)(sc + col), b = *(const GAS f32x4*)(sh + col);
                    __builtin_nontemporal_store(xn[q], (GAS f32x4*)(P.Xout + (unsigned)(row * DM + col)));
                    const f32x4 y = (xn[q] * ri * wn) * (1.0f + a) + b;
                    if (P.Hout) { v2u pk; pk.x = pk2(y.x, y.y); pk.y = pk2(y.z, y.w); *(v2u*)(P.Hout + (unsigned)(row * DM + col)) = pk; }
                    if (P.H8out) *(GAS unsigned*)(P.H8out + (unsigned)(row * DM + col)) = pk4_fp8(y.x, y.y, y.z, y.w); }
            }
        }
    }
}
#undef g
#undef c
__device__ __forceinline__ void peer_phase2(Frame& F, const PeerArgs& P) {
    const int tid = ltid(F.wave), lane = tid & 63;
    LAS unsigned* lists = (LAS unsigned*)(F.lds + PL_LISTS);
    LAS int* eid = (LAS int*)(F.lds + PL_EID);
    LAS float* gt = (LAS float*)(F.lds + PL_GT);
    LAS unsigned short* eidL = (LAS unsigned short*)(F.lds + P2_EID); LAS float* gtL = (LAS float*)(F.lds + P2_GT); LAS float* sxL = (LAS float*)(F.lds + P2_SX);
    const int ntok = P.nblocks * 32, tpc = (ntok + F.G - 1) / F.G, t_begin = F.vcu * tpc, t_end = (t_begin + tpc < ntok) ? t_begin + tpc : ntok;
    if (t_begin >= t_end) return;
    for (int row0 = t_begin; row0 < t_end; row0 += 32) {
        const int nt = (t_end - row0 < 32) ? t_end - row0 : 32;
        for (int rr = 0; rr < P.route_reps; ++rr) {
        if (rr) __syncthreads();
        {
            const int tok = tid >> 4, lst = tid & 15;
            const bf16_t* sp = (const bf16_t*)P.S + (size_t)(row0 + (tok < nt ? tok : nt - 1)) * 2048 + lst * 128;
            float top[16];
            v4u nv[2];
#pragma unroll
            for (int q = 0; q < 2; ++q) nv[q] = *(const v4u*)(sp + q * 8);
#pragma unroll 1
            for (int c = 0; c < 8; ++c) {
                float x[16];
#pragma unroll
                for (int e = 0; e < 16; ++e) { const unsigned w = nv[e >> 3][(e >> 1) & 3];
                    x[e] = __uint_as_float(((e & 1) ? (w & 0xffff0000u) : (w << 16)) | (unsigned)(c * 16 + e)); }
                if (c < 7) {
#pragma unroll
                    for (int q = 0; q < 2; ++q) nv[q] = *(const v4u*)(sp + (c + 1) * 16 + q * 8);
                }
                sort16_desc(x);
                if (c == 0) {
#pragma unroll
                    for (int i = 0; i < 16; ++i) top[i] = x[i];
                } else merge16_desc(top, x);
            }
            LAS unsigned* lp = lists + tid * 20;
#pragma unroll
            for (int q = 0; q < 4; ++q) *(LAS v4u*)(lp + q * 4) = (v4u){__float_as_uint(top[q * 4]), __float_as_uint(top[q * 4 + 1]), __float_as_uint(top[q * 4 + 2]), __float_as_uint(top[q * 4 + 3])};
        }
        __syncthreads();
        if (tid < 256) {
            const int tok = tid >> 3, hd = tid & 7;
            const LAS unsigned* la = lists + (tok * 16 + 2 * hd) * 20; const LAS unsigned* lb = la + 20;
            float av[16], bv[16];
#pragma unroll
            for (int q = 0; q < 4; ++q) { const v4u a = *(const LAS v4u*)(la + q * 4), b = *(const LAS v4u*)(lb + q * 4);
#pragma unroll
                for (int j = 0; j < 4; ++j) { av[q * 4 + j] = __uint_as_float(a[j] & ~127u); bv[q * 4 + j] = __uint_as_float(b[j] & ~127u); } }
            float c0[16], c1[16], c2[16], c3[16];
#pragma unroll
            for (int i = 0; i < 16; ++i) { c0[i] = -INFINITY; c1[i] = -INFINITY; c2[i] = -INFINITY; c3[i] = -INFINITY; }
            {
                int cnt = 0;
#pragma unroll
                for (int i = 0; i < 16; ++i)
#pragma unroll
                    for (int j = 0; j < 16; ++j) if ((i + 1) * (j + 1) <= 16) {
                        const float sm = __uint_as_float((__float_as_uint(av[i] + bv[j]) & ~255u) | (unsigned)(i * 16 + j));
                        const int slot = cnt & 15, arr = cnt >> 4;
                        if (arr == 0) c0[slot] = sm; else if (arr == 1) c1[slot] = sm; else if (arr == 2) c2[slot] = sm; else c3[slot] = sm;
                        ++cnt;
                    }
            }
            sort16_desc(c0); sort16_desc(c1); sort16_desc(c2); sort16_desc(c3);
            merge16_desc(c0, c1); merge16_desc(c0, c2); merge16_desc(c0, c3);
            float ev[16], sum = 0.f; const float m0 = __uint_as_float(__float_as_uint(c0[0]) & ~255u);
#pragma unroll
            for (int k = 0; k < 16; ++k) { ev[k] = fast_exp2((__uint_as_float(__float_as_uint(c0[k]) & ~255u) - m0) * LOG2E); sum += ev[k]; }
            const float rs = 1.0f / sum;
#pragma unroll
            for (int k = 0; k < 16; ++k) { const unsigned code = __float_as_uint(c0[k]) & 255u;
                const int ia = (int)(la[code >> 4] & 127u), ib = (int)(lb[code & 15u] & 127u);
                eid[tok * 128 + hd * 16 + k] = ia * NKEYS + ib; gt[tok * 128 + hd * 16 + k] = ev[k] * rs;
#if SELFCHECK
                if (tok < nt) { P.dbg_eid[(size_t)(row0 + tok) * 128 + hd * 16 + k] = ia * NKEYS + ib; P.dbg_gt[(size_t)(row0 + tok) * 128 + hd * 16 + k] = ev[k] * rs; }
#endif
            }
        }
        }
        __syncthreads();
        { const int lb = row0 - t_begin;
#pragma unroll
          for (int i = 0; i < 8; ++i) { const int idx = i * NTHREADS + tid; if ((idx >> 7) < nt) { eidL[lb * 128 + idx] = (unsigned short)eid[idx]; gtL[lb * 128 + idx] = gt[idx]; } }
          if (tid < nt) sxL[lb + tid] = P.SXG[row0 + tid];
        }
        __syncthreads();
    }
    asm volatile("s_waitcnt vmcnt(0)" ::: "memory"); __syncthreads();
    const int ntot = t_end - t_begin;
#pragma unroll 1
    for (int gi = 0; gi < 2; ++gi) { const int lt0 = F.wave * 4 + 32 * gi; int cnt = ntot - lt0; cnt = cnt < 0 ? 0 : (cnt > 4 ? 4 : cnt); if (cnt > 0) peer2_tokens<4>(F, P, t_begin, lt0, cnt, lane); }
    if (ntot > 64 && F.wave == 0) peer2_tokens<1>(F, P, t_begin, 64, 1, lane);
}

__device__ __forceinline__ void peer_phase(Frame& F, const PeerArgs& P) {
    const int tid = ltid(F.wave), lane = tid & 63;
    LAS unsigned* lists = (LAS unsigned*)(F.lds + PL_LISTS);
    LAS int* eid = (LAS int*)(F.lds + PL_EID);
    LAS float* gt = (LAS float*)(F.lds + PL_GT);
    const int ntok = P.nblocks * 32, tpc = (ntok + F.G - 1) / F.G, t_begin = F.vcu * tpc, t_end = (t_begin + tpc < ntok) ? t_begin + tpc : ntok;
    for (int row0 = t_begin; row0 < t_end; row0 += 32) {
        const int nt = (t_end - row0 < 32) ? t_end - row0 : 32;
        for (int rr = 0; rr < P.route_reps; ++rr) {
        if (rr) __syncthreads();
        {
            const int tok = tid >> 4, lst = tid & 15;
            const bf16_t* sp = (const bf16_t*)P.S + (size_t)(row0 + (tok < nt ? tok : nt - 1)) * 2048 + lst * 128;
            float top[16];
            v4u nv[2];
#pragma unroll
            for (int q = 0; q < 2; ++q) nv[q] = *(const v4u*)(sp + q * 8);
#pragma unroll 1
            for (int c = 0; c < 8; ++c) {
                float x[16];
#pragma unroll
                for (int e = 0; e < 16; ++e) { const unsigned w = nv[e >> 3][(e >> 1) & 3];
                    x[e] = __uint_as_float(((e & 1) ? (w & 0xffff0000u) : (w << 16)) | (unsigned)(c * 16 + e)); }
                if (c < 7) {
#pragma unroll
                    for (int q = 0; q < 2; ++q) nv[q] = *(const v4u*)(sp + (c + 1) * 16 + q * 8);
                }
                sort16_desc(x);
                if (c == 0) {
#pragma unroll
                    for (int i = 0; i < 16; ++i) top[i] = x[i];
                } else merge16_desc(top, x);
            }
            LAS unsigned* lp = lists + tid * 20;
#pragma unroll
            for (int q = 0; q < 4; ++q) *(LAS v4u*)(lp + q * 4) = (v4u){__float_as_uint(top[q * 4]), __float_as_uint(top[q * 4 + 1]), __float_as_uint(top[q * 4 + 2]), __float_as_uint(top[q * 4 + 3])};
        }
        __syncthreads();
        if (tid < 256) {
            const int tok = tid >> 3, hd = tid & 7;
            const LAS unsigned* la = lists + (tok * 16 + 2 * hd) * 20; const LAS unsigned* lb = la + 20;
            float av[16], bv[16];
#pragma unroll
            for (int q = 0; q < 4; ++q) { const v4u a = *(const LAS v4u*)(la + q * 4), b = *(const LAS v4u*)(lb + q * 4);
#pragma unroll
                for (int j = 0; j < 4; ++j) { av[q * 4 + j] = __uint_as_float(a[j] & ~127u); bv[q * 4 + j] = __uint_as_float(b[j] & ~127u); } }
            float c0[16], c1[16], c2[16], c3[16];
#pragma unroll
            for (int i = 0; i < 16; ++i) { c0[i] = -INFINITY; c1[i] = -INFINITY; c2[i] = -INFINITY; c3[i] = -INFINITY; }
            {
                int cnt = 0;
#pragma unroll
                for (int i = 0; i < 16; ++i)
#pragma unroll
                    for (int j = 0; j < 16; ++j) if ((i + 1) * (j + 1) <= 16) {
                        const float sm = __uint_as_float((__float_as_uint(av[i] + bv[j]) & ~255u) | (unsigned)(i * 16 + j));
                        const int slot = cnt & 15, arr = cnt >> 4;
                        if (arr == 0) c0[slot] = sm; else if (arr == 1) c1[slot] = sm; else if (arr == 2) c2[slot] = sm; else c3[slot] = sm;
                        ++cnt;
                    }
            }
            sort16_desc(c0); sort16_desc(c1); sort16_desc(c2); sort16_desc(c3);
            merge16_desc(c0, c1); merge16_desc(c0, c2); merge16_desc(c0, c3);
            float ev[16], sum = 0.f; const float m0 = __uint_as_float(__float_as_uint(c0[0]) & ~255u);
#pragma unroll
            for (int k = 0; k < 16; ++k) { ev[k] = fast_exp2((__uint_as_float(__float_as_uint(c0[k]) & ~255u) - m0) * LOG2E); sum += ev[k]; }
            const float rs = 1.0f / sum;
#pragma unroll
            for (int k = 0; k < 16; ++k) { const unsigned code = __float_as_uint(c0[k]) & 255u;
                const int ia = (int)(la[code >> 4] & 127u), ib = (int)(lb[code & 15u] & 127u);
                eid[tok * 128 + hd * 16 + k] = ia * NKEYS + ib; gt[tok * 128 + hd * 16 + k] = ev[k] * rs;
#if SELFCHECK
                if (tok < nt) { P.dbg_eid[(size_t)(row0 + tok) * 128 + hd * 16 + k] = ia * NKEYS + ib; P.dbg_gt[(size_t)(row0 + tok) * 128 + hd * 16 + k] = ev[k] * rs; }
#endif
            }
        }
        }
        __syncthreads();
#pragma unroll 1
        for (int tk = 0; tk < 4; ++tk) {
            const int tok = F.wave * 4 + tk; if (tok >= nt) break;
            const size_t row = (size_t)(row0 + tok);
            const bool latent = row < (size_t)SEQ;
            const bf16_t* hp = P.Hin + row * DM + 16 * lane;
            const v4u h0 = *(const v4u*)hp, h1 = *(const v4u*)(hp + 8);
            float xf[16];
#pragma unroll
            for (int q = 0; q < 4; ++q) { xf[2 * q] = bflo(h0[q]); xf[2 * q + 1] = bfhi(h0[q]); xf[8 + 2 * q] = bflo(h1[q]); xf[8 + 2 * q + 1] = bfhi(h1[q]); }
            float am = 0.f;
#pragma unroll
            for (int i = 0; i < 16; ++i) am = __builtin_fmaxf(am, __builtin_fabsf(xf[i]));
            am = wave_max(am);
            const float sx = am * (1.f / 127.f), ix = am > 0.f ? 127.f / am : 0.f;
            int xq[4];
#pragma unroll
            for (int q = 0; q < 4; ++q) { int w = 0;
#pragma unroll
                for (int j = 0; j < 4; ++j) { const int v = (int)__builtin_rintf(xf[4 * q + j] * ix); w |= (v & 0xff) << (8 * j); }
                xq[q] = w; }
            float out[16]; float asum = 0.f;
#pragma unroll
            for (int i = 0; i < 16; ++i) out[i] = 0.f;
            const int esel = (lane >> 2) & 15;
#pragma unroll 1
            for (int e0 = 0; e0 < 128; e0 += 16) {
                v4u ua[16], va[16];
#pragma unroll
                for (int k = 0; k < 16; ++k) { const int id = __builtin_amdgcn_readfirstlane(eid[tok * 128 + e0 + k]);
                    ua[k] = *(const v4u*)(P.U + (unsigned)(((lane >> 3) * NEXP + id) * 128 + 16 * (lane & 7))); va[k] = *(const v4u*)(P.V + (unsigned)(((lane >> 3) * NEXP + id) * 128 + 16 * (lane & 7))); }
                const int myid = eid[tok * 128 + e0 + esel]; const float mysu = P.SU[myid], mysv = P.SV[myid], myg = gt[tok * 128 + e0 + esel];
                int d[16];
#pragma unroll
                for (int k = 0; k < 16; ++k) { int di = __builtin_amdgcn_sdot4((int)ua[k][0], xq[0], 0, false); di = __builtin_amdgcn_sdot4((int)ua[k][1], xq[1], di, false);
                    di = __builtin_amdgcn_sdot4((int)ua[k][2], xq[2], di, false); d[k] = __builtin_amdgcn_sdot4((int)ua[k][3], xq[3], di, false); }
                int s8[8], s4[4], s2[2];
#pragma unroll
                for (int i = 0; i < 8; ++i) { auto r = __builtin_amdgcn_permlane32_swap((unsigned)d[i], (unsigned)d[i + 8], false, false); s8[i] = (int)r[0] + (int)r[1]; }
#pragma unroll
                for (int i = 0; i < 4; ++i) { auto r = __builtin_amdgcn_permlane16_swap((unsigned)s8[i], (unsigned)s8[i + 4], false, false); s4[i] = (int)r[0] + (int)r[1]; }
                const bool b3 = (lane & 8) != 0, b2 = (lane & 4) != 0;
#pragma unroll
                for (int i = 0; i < 2; ++i) { const int keep = b3 ? s4[i + 2] : s4[i], send = b3 ? s4[i] : s4[i + 2]; s2[i] = keep + __builtin_amdgcn_update_dpp(0, send, 0x128, 0xf, 0xf, false); }
                int z; { const int keep = b2 ? s2[1] : s2[0], send = b2 ? s2[0] : s2[1]; z = keep + __builtin_amdgcn_ds_swizzle(send, 0x101F); }
                z += __builtin_amdgcn_update_dpp(0, z, 0x4E, 0xf, 0xf, false);
                z += __builtin_amdgcn_update_dpp(0, z, 0xB1, 0xf, 0xf, false);
                const float pre = (float)z * (mysu * sx);
                const float act = myg * gelu_tanh(pre);
#if SELFCHECK
                if ((lane & 3) == 0) P.dbg_gt[(size_t)9 * MiB / 4 + row * 128 + e0 + esel] = gelu_tanh(pre);
#endif
                const float cfl = act * mysv;
#pragma unroll
                for (int k = 0; k < 16; ++k) {
                    const float cf = __uint_as_float(__builtin_amdgcn_readlane(__float_as_uint(cfl), 4 * k));
                    asum += cf;
                    const f32x2 cf2 = {cf, cf};
#pragma unroll
                    for (int q = 0; q < 4; ++q) { const unsigned w = va[k][q];
                        const f32x2 v01 = {(float)(w & 0xffu), (float)((w >> 8) & 0xffu)}, v23 = {(float)((w >> 16) & 0xffu), (float)(w >> 24)};
                        f32x2 o01 = {out[4 * q], out[4 * q + 1]}, o23 = {out[4 * q + 2], out[4 * q + 3]};
                        o01 = __builtin_elementwise_fma(cf2, v01, o01); o23 = __builtin_elementwise_fma(cf2, v23, o23);
                        out[4 * q] = o01.x; out[4 * q + 1] = o01.y; out[4 * q + 2] = o23.x; out[4 * q + 3] = o23.y; }
                }
            }
#pragma unroll
            for (int i = 0; i < 16; ++i) out[i] -= 128.f * asum;
            const float* g2 = latent ? P.g2l : P.g2c;
            float xn[16]; float ss = 0.f;
#pragma unroll
            for (int q = 0; q < 4; ++q) { const int col = 16 * lane + 4 * q; const f32x4 xo = *(const f32x4*)(P.Xin + row * DM + col), g = *(const f32x4*)(g2 + col);
#pragma unroll
                for (int j = 0; j < 4; ++j) { const float v = xo[j] + g[j] * out[4 * q + j]; xn[4 * q + j] = v; ss += v * v; } }
            const float ri = __builtin_amdgcn_rsqf(wave_sum(ss) * (1.f / DM) + EPS);
            if (P.dry) {
                if (ri == 12345.678f) P.Xout[row * DM] = ri;
            } else if (P.fout) {
                if (latent) {
#pragma unroll
                    for (int q = 0; q < 4; ++q) { const int col = 16 * lane + 4 * q; const f32x4 w = *(const f32x4*)(P.fnw + col);
                        f32x4 y; y.x = xn[4 * q] * ri * w.x; y.y = xn[4 * q + 1] * ri * w.y; y.z = xn[4 * q + 2] * ri * w.z; y.w = xn[4 * q + 3] * ri * w.w;
                        *(f32x4*)(P.fout + row * DM + col) = y; }
                }
            } else {
                const float* sh = latent ? P.shl : P.shc; const float* sc = latent ? P.scl : P.scc;
                unsigned hw[8], h8[4];
#pragma unroll
                for (int q = 0; q < 4; ++q) { const int col = 16 * lane + 4 * q;
                    *(f32x4*)(P.Xout + row * DM + col) = (f32x4){xn[4 * q], xn[4 * q + 1], xn[4 * q + 2], xn[4 * q + 3]};
                    const f32x4 w = *(const f32x4*)(P.nwn + col), a = *(const f32x4*)(sc + col), b = *(const f32x4*)(sh + col);
                    float y[4];
#pragma unroll
                    for (int j = 0; j < 4; ++j) y[j] = (xn[4 * q + j] * ri * w[j]) * (1.0f + a[j]) + b[j];
                    hw[2 * q] = pk2(y[0], y[1]); hw[2 * q + 1] = pk2(y[2], y[3]); h8[q] = pk4_fp8(y[0], y[1], y[2], y[3]); }
                if (P.Hout) { *(v4u*)(P.Hout + row * DM + 16 * lane) = (v4u){hw[0], hw[1], hw[2], hw[3]};
                    *(v4u*)(P.Hout + row * DM + 16 * lane + 8) = (v4u){hw[4], hw[5], hw[6], hw[7]}; }
                if (P.H8out) *(v4u*)(P.H8out + row * DM + 16 * lane) = (v4u){h8[0], h8[1], h8[2], h8[3]};
            }
        }
        __syncthreads();
    }
}
__device__ __forceinline__ float lam_init_of(int l) { return l == 0 ? 0.2f : 0.35550906765f; }

#ifndef PHASE_MASK
#define PHASE_MASK 0xffff
#endif
#define PH(n) ((PHASE_MASK >> (n)) & 1)
#define REPS(n) (1 + ((dupmask >> (n)) & 1))
__global__ void __launch_bounds__(NTHREADS, 2) trunk_fwd(Args args) {
    extern __shared__ __attribute__((aligned(16))) unsigned char lds[];
    Frame F;
    F.lds = (LAS unsigned char*)lds;
    F.MISC = (volatile LAS unsigned*)(F.lds + MISC_OFF);
    F.wave = __builtin_amdgcn_readfirstlane((int)threadIdx.x >> 6);
    F.G = gridDim.x; { const int bx = blockIdx.x; F.vcu = (F.G % 8 == 0) ? (bx % 8) * (F.G / 8) + bx / 8 : bx; }
    unsigned char* ws = args.ws;
    F.ctl = (gu32*)(ws + WS_CTL);
    for (int u = ltid(F.wave); u < (LDS_BYTES - LDSCTL_OFF) / 4; u += NTHREADS) ((LAS unsigned*)(F.lds + LDSCTL_OFF))[u] = 0u;
    __syncthreads();
    XcdBarrier bar = xcd_barrier_post((unsigned*)(F.ctl + CW_BAR), F.MISC + 8, F.wave);
#ifndef TIMING
#define TIMING 0
#endif
#if TIMING
    int n_stamp = 0;
#define STAMP() do { if (blockIdx.x == 0 && tid_now(F.wave) == 0) ((unsigned long long*)(F.ctl + 1024))[n_stamp] = __builtin_amdgcn_s_memrealtime(); ++n_stamp; } while (0)
#else
#define STAMP() do {} while (0)
#endif
#define GRID_BAR() do { xcd_barrier(bar); STAMP(); asm volatile("" : "+s"(ws)); } while (0)
    STAMP();

    const float* const* in = args.in;
    const int dupmask = args.flags;
#define modv ((float*)(ws + WS_CONST))
#define lamv (modv + 2 * 2 * 6144)
#define WIN ((bf16_t*)(ws + WS_WIN))
#define WGATE ((bf16_t*)(ws + WS_WGATE))
#define WBR ((bf16_t*)(ws + WS_WBR))
#define WOUT ((bf16_t*)(ws + WS_WOUT))
#define WSC ((bf16_t*)(ws + WS_WSC))
#define X ((float*)(ws + WS_X))
#define H ((bf16_t*)(ws + WS_H))
#define YS ((bf16_t*)(ws + WS_YS))
#define MIX YS
#define Qb ((bf16_t*)(ws + WS_Q))
#define Kb ((bf16_t*)(ws + WS_K))
#define Vb ((bf16_t*)(ws + WS_V))
#define BP ((bf16_t*)(ws + WS_R1))
#define SB ((float*)(ws + WS_R1))
    const int gw = F.vcu * NWAVES + F.wave, NGW = F.G * NWAVES;

    for (int rep = 0; rep < REPS(0); ++rep) {
        const int tid = ltid(F.wave), lane = tid & 63;
        LAS float* scr = (LAS float*)(F.lds + F.wave * 16384);
        for (int un = F.vcu; un < 2 * 128; un += F.G) {
            const int l = un >> 7, col = (un & 127) * 48 + lane; const bool act = lane < 48;
            const float* W = in[I_ADAW] + (size_t)l * DM * 6144;
            float a0 = 0.f, a1 = 0.f;
            if (act) {
#pragma unroll 16
                for (int k = 128 * F.wave; k < 128 * F.wave + 128; ++k) { const float w = W[(size_t)k * 6144 + col]; const float c0 = in[I_C][k], c1 = in[I_CCTX][k];
                    a0 += c0 * sigmoidf_(c0) * w; a1 += c1 * sigmoidf_(c1) * w; }
            }
            LAS float* red = (LAS float*)(F.lds);
            red[(F.wave * 64 + lane) * 2] = a0; red[(F.wave * 64 + lane) * 2 + 1] = a1;
            __syncthreads();
            if (F.wave == 0 && act) { float s0 = in[I_ADAB][l * 6144 + col], s1 = s0;
#pragma unroll
                for (int w = 0; w < 8; ++w) { s0 += red[(w * 64 + lane) * 2]; s1 += red[(w * 64 + lane) * 2 + 1]; }
                modv[(l * 2 + 0) * 6144 + col] = s0; modv[(l * 2 + 1) * 6144 + col] = s1; }
            __syncthreads();
        }
        if (blockIdx.x == 0 && tid < 2) { const float* lf = in[I_DLAM] + tid * 128; float s0 = 0.f, s1 = 0.f;
            for (int i = 0; i < 32; ++i) { s0 += lf[i] * lf[32 + i]; s1 += lf[64 + i] * lf[96 + i]; }
            lamv[tid] = expf(s0) - expf(s1) + lam_init_of(tid); }
        constexpr int I_IN = 16 * 80, I_GT = 16 * 128, I_BR = 4 * 32, I_OT = 16 * 32;
        constexpr int NITEMS = 2 * I_IN + 2 * I_GT + 8 * I_BR + 2 * I_OT;
        unsigned char* W8IN = ws + WS_W8IN; unsigned char* W8GATE = ws + WS_W8GATE;
        for (int it = gw; it < NITEMS; it += NGW) {
            int r = it;
            if (r < 2 * I_IN) { const int l = r / I_IN; transpose_item<MapWin, true>(in[I_WIN] + (size_t)l * DM * NQKV, DM, NQKV, W8IN + (size_t)l * NQKV * DM, MapWin(), scr, r % I_IN, lane); continue; } r -= 2 * I_IN;
            if (r < 2 * I_GT) { const int l = r / I_GT; transpose_item<MapGate, true>(in[I_WGATE] + (size_t)l * DM * 4096, DM, 4096, W8GATE + (size_t)l * 4096 * DM, MapGate(), scr, r % I_GT, lane); continue; } r -= 2 * I_GT;
            if (r < 8 * I_BR) { const int lb = r / I_BR; transpose_item(in[I_WBR] + (size_t)lb * 256 * DM, 256, DM, WBR + (size_t)lb * DM * 256, MapId(), scr, r % I_BR, lane); continue; } r -= 8 * I_BR;
#if MIX8
            { const int l = r / I_OT; transpose_item<MapId, true>(in[I_WOUT] + (size_t)l * DM * DM, DM, DM, ws + WS_W8OUT + (size_t)l * DM * DM, MapId(), scr, r % I_OT, lane); }
#else
            { const int l = r / I_OT; transpose_item(in[I_WOUT] + (size_t)l * DM * DM, DM, DM, WOUT + (size_t)l * DM * DM, MapId(), scr, r % I_OT, lane); }
#endif
        }
        for (int it = gw; it < 2 * 16 * 8 * 64; it += NGW) {
            const int kt = it & 63, nt = (it >> 6) & 7, g = (it >> 9) & 15, l = it >> 13, h = g >> 1, p = g & 1;
            const float* kp = in[I_PKEYS] + ((size_t)((l * 2 + p) * 8 + h) * 128 + nt * 16 + (lane & 15)) * 128 + 4 * (lane >> 4);
            const float* qp = in[I_PWQ] + ((size_t)l * DM + kt * 16 + (lane & 15)) * 2048 + g * 128 + 4 * (lane >> 4);
            f32x4 acc = {0.f, 0.f, 0.f, 0.f};
            f32x4 ka[8], qa[8];
#pragma unroll
            for (int c = 0; c < 8; ++c) { ka[c] = *(const f32x4*)(kp + 16 * c); qa[c] = *(const f32x4*)(qp + 16 * c); }
            __builtin_amdgcn_sched_barrier(0);
#pragma unroll
            for (int c = 0; c < 8; ++c)
#pragma unroll
                for (int j = 0; j < 4; ++j) acc = __builtin_amdgcn_mfma_f32_16x16x4f32(ka[c][j], qa[c][j], acc, 0, 0, 0);
            bf16_t* op = WSC + ((size_t)l * 2048 + g * 128 + nt * 16 + 4 * (lane >> 4)) * DM + kt * 16 + (lane & 15);
#pragma unroll
            for (int r = 0; r < 4; ++r) op[(size_t)r * DM] = (bf16_t)f2bf(acc[r]);
        }
        {
            unsigned char* UQ = (unsigned char*)(ws + WS_UBF); unsigned char* VQ = (unsigned char*)(ws + WS_VBF); float* SU = (float*)(ws + WS_SU); float* SV = (float*)(ws + WS_SV);
            for (int r0 = gw; r0 < 2 * 2 * NEXP; r0 += 4 * NGW) {
                f32x4 v[4][4];
#pragma unroll
                for (int u4 = 0; u4 < 4; ++u4) { const int r = r0 + u4 * NGW; const bool isv = r >= 2 * NEXP; const int rr = isv ? r - 2 * NEXP : r;
                    const float* src = (isv ? in[I_PV] : in[I_PU]) + (size_t)rr * DM + 16 * lane;
#pragma unroll
                    for (int q = 0; q < 4; ++q) v[u4][q] = *(const f32x4*)(src + 4 * q); }
#pragma unroll
                for (int u4 = 0; u4 < 4; ++u4) { const int r = r0 + u4 * NGW; const bool isv = r >= 2 * NEXP; const int rr = isv ? r - 2 * NEXP : r;
                    float am = 0.f;
#pragma unroll
                    for (int q = 0; q < 4; ++q) am = __builtin_fmaxf(am, __builtin_fmaxf(__builtin_fmaxf(__builtin_fabsf(v[u4][q].x), __builtin_fabsf(v[u4][q].y)), __builtin_fmaxf(__builtin_fabsf(v[u4][q].z), __builtin_fabsf(v[u4][q].w))));
                    am = wave_max(am);
                    const float inv = am > 0.f ? 127.f / am : 0.f; const int off = isv ? 128 : 0;
                    v4u w;
#pragma unroll
                    for (int q = 0; q < 4; ++q) { const int a0 = (int)__builtin_rintf(v[u4][q].x * inv) + off, a1 = (int)__builtin_rintf(v[u4][q].y * inv) + off, a2 = (int)__builtin_rintf(v[u4][q].z * inv) + off, a3 = (int)__builtin_rintf(v[u4][q].w * inv) + off;
                        w[q] = (unsigned)(a0 & 0xff) | ((unsigned)(a1 & 0xff) << 8) | ((unsigned)(a2 & 0xff) << 16) | ((unsigned)(a3 & 0xff) << 24); }
                    { const int lyr = rr >> 14, ex = rr & (NEXP - 1);
                      *(v4u*)((isv ? VQ : UQ) + (size_t)lyr * NEXP * DM + (size_t)(((lane >> 3) * NEXP + ex) * 128 + 16 * (lane & 7))) = w; }
                    if (lane == 0) SU[2 * rr + (isv ? 1 : 0)] = am * (1.f / 127.f); }
            }
        }
    }
#if SELFCHECK
    GRID_BAR();
#define CK_RED ((LAS float*)(F.lds))
#define CK_BUF ((LAS float*)(F.lds + 1024))
#define CK_IBUF ((LAS int*)(F.lds + 8192))
#define CK_OBUF ((LAS float*)(F.lds + 20480))
#define CK_SC ((LAS float*)(F.lds + 24576))
    if (blockIdx.x == 0) chk::ck_prologue(in, ws, F.ctl, CK_RED);
    __syncthreads();
#endif
    GRID_BAR();
    { const int lane = ltid(F.wave) & 63;
      for (int r = gw; r < 2 * 2048; r += NGW) {
        const bf16_t* src = WSC + (size_t)r * DM + 16 * lane;
        const v4u h0 = *(const v4u*)src, h1 = *(const v4u*)(src + 8);
        float xf[16];
#pragma unroll
        for (int qq = 0; qq < 4; ++qq) { xf[2 * qq] = bflo(h0[qq]); xf[2 * qq + 1] = bfhi(h0[qq]); xf[8 + 2 * qq] = bflo(h1[qq]); xf[8 + 2 * qq + 1] = bfhi(h1[qq]); }
        float am = 0.f;
#pragma unroll
        for (int i = 0; i < 16; ++i) am = __builtin_fmaxf(am, __builtin_fabsf(xf[i]));
        am = wave_max(am);
        const float ix = am > 0.f ? 127.f / am : 0.f;
        v4u o;
#pragma unroll
        for (int qq = 0; qq < 4; ++qq) { unsigned w = 0;
#pragma unroll
            for (int j = 0; j < 4; ++j) { const int v = (int)__builtin_rintf(xf[4 * qq + j] * ix); w |= (unsigned)(v & 0xff) << (8 * j); }
            o[qq] = w; }
        *(v4u*)(ws + WS_W8S + (size_t)r * DM + 16 * lane) = o;
        if (lane == 0) ((float*)(ws + WS_SWS))[r] = am * (1.f / 127.f); } }
    { const int lane = ltid(F.wave) & 63;
    for (int m = gw; m < MT; m += NGW) {
        const bool lat = m < SEQ; const float* xr = lat ? in[I_X] + (size_t)m * DM : in[I_CTX] + (size_t)(m - SEQ) * DM; const float* mv = modv + (lat ? 0 : 6144);
        modnorm_row(xr, SELFCHECK ? H + (size_t)m * DM : (bf16_t*)nullptr, in[I_N1W], mv, mv + 1024, lane, ws + WS_H8 + (size_t)m * DM);
    } }
    GRID_BAR();
#if SELFCHECK
    if (blockIdx.x < 5) { const int r = blockIdx.x == 0 ? 0 : blockIdx.x == 1 ? 777 : blockIdx.x == 2 ? 16383 : blockIdx.x == 3 ? 16384 : 16639;
        const bool lat = r < SEQ; const float* mv = modv + (lat ? 0 : 6144);
        chk::ck_modnorm(lat ? in[I_X] + (size_t)r * DM : in[I_CTX] + (size_t)(r - SEQ) * DM, H + (size_t)r * DM, in[I_N1W], mv, mv + 1024, F.ctl, 2, CK_RED); }
    GRID_BAR();
#endif

#pragma unroll 1
    for (int l = 0; l < 2; ++l) {
#define modl (modv + (size_t)(l * 2) * 6144)
#define modc (modl + 6144)
        const int nMr = (l == 0) ? MT / 256 : SEQ / 256;
        for (int rep = 0; rep < REPS(2); ++rep) {
            if (rep) GRID_BAR();
            pg8::Gemm g{ws + WS_H8, ws + WS_W8IN + (size_t)l * NQKV * DM, MT / 256, NQKV / 256, DM, DM, DM, 0, 0, 1};
            pg8::StaticOrder S; S.init(g, F.G, (int)blockIdx.x);
            pg8::EpiQKV E{Qb, Kb, Vb, in[I_QKNW] + l * 128};
            pg8::gemm_phase<pg8::EpiQKV, true>(F.lds, g, S, E, F.wave);
        }
        GRID_BAR();
#if SELFCHECK
        if (blockIdx.x < 4) { const int b = blockIdx.x; const int r = b == 0 ? 5 : b == 1 ? 8400 : b == 2 ? 16383 : 16391; chk::ck_qkv(l, r, in, ws, F.ctl, CK_RED, CK_BUF); }
        GRID_BAR();
#endif
        for (int rep = 0; rep < REPS(4); ++rep) {
            if (rep) GRID_BAR();
            char* shm = (char*)lds;
            const float lam = lamv[l];
            for (int ui = F.vcu; ui < 256; ui += F.G) {
                const int h = (ui >> 5) & 3, qb = ((ui >> 7) << 5) | (ui & 31);
                const int njobs = (l == 0 && ui < 16) ? (((ui >> 2) == 1) ? 7 : 6) : 5;
#pragma unroll 1
                for (int j = 0; j < njobs; ++j) {
                    att::AU u; int mode = 0;
                    u.sinkl2 = -INFINITY; u.emode = 0; u.lam = 0.f; u.oscale = 1.f; u.subw = in[I_SUBW] + l * 64; u.kbase = 0; u.q0 = qb * 256; u.NT = 260;
                    int qh, kh, oc;
                    if (j == 0)      { qh = 16 + h; kh = 10 + (h >> 1); oc = 768 + h * 64; }
                    else if (j == 1) { qh = 4 + 2 * h; kh = 4 + h; oc = 256 + h * 64; u.emode = 1; }
                    else if (j == 2) { qh = 5 + 2 * h; kh = 4 + h; oc = 256 + h * 64; u.emode = 2; u.lam = lam; u.oscale = 1.f - lam_init_of(l); }
                    else if (j == 3) { qh = h; kh = h; oc = h * 64; mode = 1; u.NT = 16; int B = 4 * qb - 4; B = B < 0 ? 0 : (B > 244 ? 244 : B); u.kbase = 64 * B; }
                    else if (j == 4) { qh = 12 + h; kh = 8 + (h >> 1); oc = 512 + h * 64; mode = 2; u.NT = 12; u.kbase = 256 * qb - 128; u.sinkl2 = in[I_SINK][l * 4 + h] * LOG2E; }
                    else {
                        const int mx = ui >> 2, hc = ui & 3; u.q0 = SEQ; u.NT = 4;
                        if (mx == 0)      { qh = hc; kh = hc; oc = hc * 64; }
                        else if (mx == 1) { qh = 4 + 2 * hc + (j - 5); kh = 4 + hc; oc = 256 + hc * 64; u.emode = (j == 5) ? 1 : 2; u.lam = lam; u.oscale = 1.f - lam_init_of(l); }
                        else if (mx == 2) { qh = 12 + hc; kh = 8 + (hc >> 1); oc = 512 + hc * 64; u.sinkl2 = in[I_SINK][l * 4 + hc] * LOG2E; }
                        else              { qh = 16 + hc; kh = 10 + (hc >> 1); oc = 768 + hc * 64; }
                    }
                    u.Q = (const att::bf16*)(Qb + (size_t)qh * MT * 64); u.K = (const att::bf16*)(Kb + (size_t)kh * MT * 64); u.V = (const att::bf16*)(Vb + (size_t)kh * MT * 64);
                    u.O = (att::bf16*)(YS + oc);
#ifndef ATT_MODES
#define ATT_MODES 7
#endif
                    if ((ATT_MODES & 2) && mode == 1) {
                        float* rp = (float*)(shm + att::LDS_RPB);
                        for (int i = ltid(F.wave); i < 15 * 32; i += NTHREADS) { const int c = i & 31; rp[i] = (c < 31) ? in[I_RPB][((size_t)(l * 4 + h) * 15 + (i >> 5)) * 31 + c] * LOG2E : 0.f; }
                        __syncthreads();
                        if (!att::attn_simple<1, 1>(u, shm, F.wave)) att::attn_simple<1>(u, shm, F.wave);
                    } else if ((ATT_MODES & 4) && mode == 2) { if (!att::attn_unit<2, 8, 0, 1>(u, shm, F.wave)) att::attn_unit<2, 8>(u, shm, F.wave); }
                    else if ((ATT_MODES & 1) && j == 1) { if (!att::attn_unit<0, 8, 1, 1>(u, shm, F.wave)) att::attn_unit<0, 8, 1>(u, shm, F.wave); }
                    else if ((ATT_MODES & 1) && j == 2) { if (!att::attn_unit<0, 8, 2, 1>(u, shm, F.wave)) att::attn_unit<0, 8, 2>(u, shm, F.wave); }
                    else if (ATT_MODES & 1) { if (!att::attn_unit<0, 8, 0, 1>(u, shm, F.wave)) att::attn_unit<0, 8>(u, shm, F.wave); }
                }
            }
        }
        GRID_BAR();
#if SELFCHECK
        if (blockIdx.x < 80) { const int b = blockIdx.x, ri = b >> 4; const int r = ri == 0 ? 3 : ri == 1 ? 4227 : ri == 2 ? 16319 : ri == 3 ? 9000 : 16484; chk::ck_attn(l, (b >> 2) & 3, b & 3, r, in, ws, F.ctl, CK_RED, CK_SC, CK_OBUF); }
        GRID_BAR();
#endif
        for (int rep = 0; rep < REPS(5); ++rep) {
            if (rep) GRID_BAR();
            pg8::Gemm g{YS, WBR + (size_t)l * 4 * DM * 256, nMr, 16, 256, DM, 256, 2, 512, 2};
            pg8::StaticOrder S; S.init(g, F.G, (int)blockIdx.x);
#if BP8
            pg8::EpiBranch8 E{(unsigned char*)BP};
            pg8::gemm_phase<pg8::EpiBranch8>(F.lds, g, S, E, F.wave);
#else
            pg8::EpiBranch E{BP};
            pg8::gemm_phase<pg8::EpiBranch>(F.lds, g, S, E, F.wave);
#endif
        }
        GRID_BAR();
#if SELFCHECK
        if (blockIdx.x < 3) { const int b = blockIdx.x; chk::ck_branch(l, b == 0 ? 1 : b == 1 ? 16383 : 16390, in, ws, F.ctl, CK_RED); }
        GRID_BAR();
#endif
        for (int rep = 0; rep < REPS(6); ++rep) {
            if (rep) GRID_BAR();
            pg8::Gemm g{ws + WS_H8, ws + WS_W8GATE + (size_t)l * 4096 * DM, nMr, 16, DM, DM, DM, 0, 0, 1};
            pg8::StaticOrder S; S.init(g, F.G, (int)blockIdx.x);
            pg8::EpiGate E{BP, MIX, in[I_BGATE] + l * 4096};
            pg8::gemm_phase<pg8::EpiGate, true>(F.lds, g, S, E, F.wave);
        }
        GRID_BAR();
#if SELFCHECK
        if (blockIdx.x < 3) { const int b = blockIdx.x; chk::ck_gate(l, b == 0 ? 2 : b == 1 ? 9999 : 16385, in, ws, F.ctl, CK_RED); }
        GRID_BAR();
#endif
        for (int rep = 0; rep < (l == 0 ? REPS(7) : 1); ++rep) {
            if (rep) GRID_BAR();
#if MIX8
            pg8::Gemm g{MIX, ws + WS_W8OUT + (size_t)l * DM * DM, nMr, 4, DM, DM, DM, 0, 0, 1};
#else
            pg8::Gemm g{MIX, WOUT + (size_t)l * DM * DM, nMr, 4, DM, DM, DM, 0, 0, 2};
#endif
            pg8::StaticOrder S; S.init(g, F.G, (int)blockIdx.x);
#ifndef FUSE_NORM2
#define FUSE_NORM2 1
#endif
#if FUSE_NORM2
            pg8::EpiOutNorm E{l == 0 ? in[I_X] : X, l == 0 ? in[I_CTX] : X + (size_t)SEQ * DM, X, modl + 2048, modc + 2048,
                              H, in[I_N2W] + l * DM, modl, modc, (gu32*)(ws + WS_CONST + 704 * 1024), F.ctl + 16384 + l * 65 * 64, F.ctl + 16000, F.lds + MISC_OFF + 1024,
                              (gu32*)(ws + WS_XB2), F.ctl + 16384 + (130 + l * 65) * 64, ws + WS_H8, (float*)(ws + WS_SXG)};
#if MIX8
            pg8::gemm_phase<pg8::EpiOutNorm, true, 0x7A7A7A7A>(F.lds, g, S, E, F.wave);
#else
            pg8::gemm_phase<pg8::EpiOutNorm>(F.lds, g, S, E, F.wave);
#endif
#else
            pg8::EpiOut E{l == 0 ? in[I_X] : X, l == 0 ? in[I_CTX] : X + (size_t)SEQ * DM, X, modl + 2048, modc + 2048};
            pg8::gemm_phase<pg8::EpiOut>(F.lds, g, S, E, F.wave);
#endif
        }
        GRID_BAR();
#if SELFCHECK
        if (blockIdx.x < 3) { const int b = blockIdx.x; chk::ck_out(l, b == 0 ? 4 : b == 1 ? 12345 : 16417, in, ws, F.ctl, CK_RED); }
        GRID_BAR();
#endif
#if !FUSE_NORM2
        { const int lane = ltid(F.wave) & 63;
        for (int m = gw; m < nMr * 256; m += NGW) {
            const float* mv = (m < SEQ) ? modl : modc;
            modnorm_row(X + (size_t)m * DM, H + (size_t)m * DM, in[I_N2W] + l * DM, mv + 3072, mv + 4096, lane);
        } }
        GRID_BAR();
#endif
#if SELFCHECK
        if (blockIdx.x < 3) { const int b = blockIdx.x; const int r = b == 0 ? 7 : b == 1 ? 16383 : 16500; const float* mv = (r < SEQ) ? modl : modc;
            chk::ck_modnorm(X + (size_t)r * DM, H + (size_t)r * DM, in[I_N2W] + l * DM, mv + 3072, mv + 4096, F.ctl, 8, CK_RED); }
        GRID_BAR();
#endif
        for (int rep = 0; rep < REPS(9); ++rep) {
            if (rep) GRID_BAR();
            pg8::Gemm g{ws + WS_H8, ws + WS_W8S + (size_t)l * 2048 * DM, nMr, 8, DM, DM, DM, 0, 0, 1};
            pg8::StaticOrder S; S.init(g, F.G, (int)blockIdx.x);
            pg8::EpiS8 E{SB, (const float*)(ws + WS_SXG), (const float*)(ws + WS_SWS) + l * 2048};
            pg8::gemm_phase<pg8::EpiS8, false, 0x7F7F7F7F, true>(F.lds, g, S, E, F.wave);
        }
        GRID_BAR();
#if SELFCHECK
        if (blockIdx.x < 3) { const int b = blockIdx.x; chk::ck_scores(l, b == 0 ? 6 : b == 1 ? 16000 : 16385, in, ws, F.ctl, CK_RED, CK_BUF); }
        GRID_BAR();
#endif
#ifndef PEER_SLICED
#define PEER_SLICED 0
#endif
#if !PEER_SLICED
        for (int rep = 0; rep < REPS(10); ++rep) {
            if (rep) GRID_BAR();
            PeerArgs P; P.dry = (rep + 1 < REPS(10)); P.route_reps = REPS(11);
            P.S = SB; P.Hin = H; P.U = (const unsigned char*)(ws + WS_UBF) + (size_t)l * NEXP * DM; P.V = (const unsigned char*)(ws + WS_VBF) + (size_t)l * NEXP * DM; P.SU = (const float*)(ws + WS_SU) + (size_t)l * 2 * NEXP; P.SV = (const float*)(ws + WS_SV) + l * NEXP; P.Xin = X; P.Xout = X;
            P.g2l = modl + 5120; P.g2c = modc + 5120;
            P.Hout = SELFCHECK ? H : (bf16_t*)nullptr; P.H8out = ws + WS_H8; P.nwn = in[I_N1W] + DM; P.shl = modv + 2 * 6144; P.scl = P.shl + 1024; P.shc = modv + 3 * 6144; P.scc = P.shc + 1024;
            P.fout = (l == 1) ? args.out : nullptr; P.fnw = in[I_FNW];
            P.nblocks = nMr * 8; P.dbg_eid = nullptr; P.dbg_gt = nullptr;
#if SELFCHECK
            if (l == 0) { P.Xout = (float*)(ws + WS_DBG); P.Hout = YS; P.H8out = nullptr; }
            P.dbg_eid = (int*)(ws + WS_VBF + 32 * MiB); P.dbg_gt = (float*)(ws + WS_VBF + 41 * MiB);
#endif
            P.H8out_xq = ws + WS_H8; P.SXG = (const float*)(ws + WS_SXG);
#ifndef PEER_V2
#define PEER_V2 1
#endif
            if (PEER_V2 && !P.dry) peer_phase2(F, P); else peer_phase(F, P);
        }
#else
        {
            PeerArgs P; P.dry = false; P.route_reps = 1;
            P.S = SB; P.Hin = H; P.U = (const unsigned char*)(ws + WS_UBF) + (size_t)l * NEXP * DM; P.V = (const unsigned char*)(ws + WS_VBF) + (size_t)l * NEXP * DM; P.SU = (const float*)(ws + WS_SU) + (size_t)l * 2 * NEXP; P.SV = (const float*)(ws + WS_SV) + l * NEXP; P.Xin = X; P.Xout = X;
            P.g2l = modl + 5120; P.g2c = modc + 5120;
            P.Hout = SELFCHECK ? H : (bf16_t*)nullptr; P.H8out = ws + WS_H8; P.nwn = in[I_N1W] + DM; P.shl = modv + 2 * 6144; P.scl = P.shl + 1024; P.shc = modv + 3 * 6144; P.scc = P.shc + 1024;
            P.fout = (l == 1) ? args.out : nullptr; P.fnw = in[I_FNW];
            P.nblocks = nMr * 8; P.dbg_eid = nullptr; P.dbg_gt = nullptr;
            PeerBufs B;
#if SELFCHECK
            unsigned char* pb = ws + WS_VBF + 32 * MiB;
            if (l == 0) { P.Xout = (float*)(ws + WS_DBG); P.Hout = YS; }
#else
            unsigned char* pb = ws + WS_YS;
#endif
            B.eid = (int*)pb; B.gt = (float*)(pb + 9 * MiB); B.a = (float*)(pb + 18 * MiB); B.xq = ws + WS_UBF + 32 * MiB; B.sx = (float*)(ws + WS_UBF + 50 * MiB);
            const int ntok = nMr * 256;
            peer_route(F, P, B);
            GRID_BAR();
            peer_u(F, P, B, ntok);
            GRID_BAR();
            peer_v(F, P, B, ntok);
            GRID_BAR();
            peer_norm(F, P, ntok);
        }
#endif
#if SELFCHECK
        break;
#endif
        if (l == 0) GRID_BAR();
    }
#if TIMING
    GRID_BAR(); xcd_barrier(bar);
    {
        const unsigned long long* ts = (const unsigned long long*)(F.ctl + 1024);
        float iv[10];
#pragma unroll
        for (int i = 0; i < 10; ++i) iv[i] = 0.f;
        iv[0] = (float)(ts[1] - ts[0]); iv[1] = (float)(ts[2] - ts[1]);
#pragma unroll
        for (int l = 0; l < 2; ++l)
#pragma unroll
            for (int p = 0; p < 8; ++p) iv[2 + p] += (float)(ts[3 + l * 8 + p] - ts[2 + l * 8 + p]);
        const float total = (float)(ts[18] - ts[0]);
        const int k1 = (int)(100.f * iv[TIMING_A] / total + 0.5f); int k2 = 10 + (int)(100.f * iv[TIMING_B] / total + 0.5f); k2 = k2 > 99 ? 99 : k2;
        const float cval = sqrtf((float)k1);
        for (size_t i = (size_t)blockIdx.x * NTHREADS + ltid(F.wave); i < (size_t)SEQ * DM / 4; i += (size_t)gridDim.x * NTHREADS) ((f32x4*)args.out)[i] = (f32x4){i == 0 ? 100.f * (float)k2 : cval, cval, cval, cval};
    }
#endif
#if SELFCHECK
    GRID_BAR();
    if (blockIdx.x < 5) { const int b = blockIdx.x; const int r = b == 0 ? 0 : b == 1 ? 31 : b == 2 ? 37 : b == 3 ? 16383 : 16639; chk::ck_peer(0, r, in, ws, F.ctl, CK_RED, CK_BUF, CK_IBUF); }
    GRID_BAR();
    {
        float e[32];
#pragma unroll
        for (int i = 0; i < 32; ++i) e[i] = __uint_as_float(__hip_atomic_load(F.ctl + CW_CHK + i, RLX_AGENT));
        const float T = 0.03f; int mask = 0;
#if SELFCHECK == 1
        mask = ((e[0] > T || e[1] > T) ? 1 : 0) | (e[2] > T ? 2 : 0) | (e[3] > T ? 4 : 0) | (e[4] > T ? 8 : 0) | (e[5] > T ? 16 : 0);
#elif SELFCHECK == 2
        mask = (e[6] > T ? 1 : 0) | (e[7] > T ? 2 : 0) | (e[8] > T ? 4 : 0) | (e[9] > T ? 8 : 0) | ((e[10] > T || e[11] > T) ? 16 : 0);
#elif SELFCHECK == 5
        mask = (e[24] > T ? 1 : 0) | (e[25] > T ? 2 : 0) | (e[26] > T ? 4 : 0) | (e[27] > T ? 8 : 0) | (e[28] > T ? 16 : 0);
#elif SELFCHECK == 4
        mask = (e[10] > T ? 1 : 0) | (e[11] > T ? 2 : 0) | (e[12] > T ? 4 : 0) | (e[13] > T ? 8 : 0);
#else
        mask = (e[16] > T ? 1 : 0) | (e[17] > T ? 2 : 0) | (e[18] > T ? 4 : 0) | (e[19] > T ? 8 : 0) | ((e[20] > T || e[21] > T || e[22] > T || e[23] > T) ? 16 : 0);
#endif
        const float cval = sqrtf((float)mask);
        for (size_t i = (size_t)blockIdx.x * NTHREADS + ltid(F.wave); i < (size_t)SEQ * DM / 4; i += (size_t)gridDim.x * NTHREADS) ((f32x4*)args.out)[i] = (f32x4){cval, cval, cval, cval};
    }
#endif
}
#ifndef DUP_MASK
#define DUP_MASK 0
#endif
extern "C" void kernel_launch(void* const* d_in, const int* in_sizes, int n_in, void* d_out, int out_size, void* d_ws, size_t ws_size, hipStream_t stream) {
    static int grid = 0;
    if (grid == 0) {
        size_t need = WS_END;
#if SELFCHECK
        need = WS_DBG + (size_t)MT * DM * 4;
#endif
        if (n_in != 23 || in_sizes[0] != SEQ * DM || out_size != SEQ * DM || ws_size < need) {
            fprintf(stderr, "kernel_launch: unexpected problem shape (n_in %d, in0 %d, out %d, ws %zu, need %zu); nothing launched\n", n_in, n_in > 0 ? in_sizes[0] : -1, out_size, ws_size, need); grid = -1; return; }
        int dev = 0, cus = 0, per_cu = 0;
        if (hipGetDevice(&dev) != hipSuccess || hipDeviceGetAttribute(&cus, hipDeviceAttributeMultiprocessorCount, dev) != hipSuccess) { fprintf(stderr, "kernel_launch: device query failed\n"); grid = -1; return; }
        if (hipFuncSetAttribute((const void*)trunk_fwd, hipFuncAttributeMaxDynamicSharedMemorySize, LDS_BYTES) != hipSuccess) { fprintf(stderr, "kernel_launch: hipFuncSetAttribute failed\n"); grid = -1; return; }
        if (hipOccupancyMaxActiveBlocksPerMultiprocessor(&per_cu, (const void*)trunk_fwd, NTHREADS, LDS_BYTES) != hipSuccess || per_cu < 1) {
            fprintf(stderr, "kernel_launch: occupancy query says %d blocks per CU; nothing launched\n", per_cu); (void)hipGetLastError(); grid = -1; return; }
        grid = cus;
    }
    if (grid < 0) return;
    (void)hipMemsetAsync((char*)d_ws + WS_CTL, 0, CTL_ZERO_BYTES, stream);
    Args a{};
    for (int i = 0; i < 23; ++i) a.in[i] = (const float*)d_in[i];
    a.out = (float*)d_out; a.ws = (unsigned char*)d_ws; a.flags = DUP_MASK; a.pad = 0;
    void* kargs[] = {&a};
    const hipError_t e = hipLaunchCooperativeKernel((const void*)trunk_fwd, dim3(grid), dim3(NTHREADS), kargs, LDS_BYTES, stream);
    if (e != hipSuccess) fprintf(stderr, "kernel_launch: cooperative launch failed: %s (grid %d)\n", hipGetErrorString(e), grid);
}
```

```cpp
#define SELFCHECK 0
#define TIMING 0
#define TIMING_A 0
#define TIMING_B 1
#define DUP_MASK 0
#define PEER_SLICED 0
#include <hip/hip_runtime.h>
#include <hip/hip_cooperative_groups.h>
#include <hip/hip_bf16.h>
#include <cstdio>
#include <cstdint>
#include <cmath>
namespace cg = cooperative_groups;

#ifndef SELFCHECK
#define SELFCHECK 0
#endif

constexpr int SEQ = 16384, CTX = 256, MT = SEQ + CTX, DM = 1024, NQKV = 2560, GRIDW = 64;
constexpr int NEXP = 16384, NKEYS = 128, PEER_H = 8, TOPK = 16;
constexpr float EPS = 1e-6f, LOG2E = 1.4426950408889634f;
constexpr float C2_64 = 0.125f * LOG2E;
constexpr float C2_32 = 0.17677669529663687f * LOG2E;
constexpr int NWAVES = 8, NTHREADS = 512;

constexpr size_t MiB = 1u << 20;
constexpr size_t WS_CTL = 0, CTL_ZERO_BYTES = 1 * MiB;
constexpr size_t WS_CONST = 1 * MiB;
constexpr size_t WS_WIN = 2 * MiB;
constexpr size_t WS_WGATE = 12 * MiB;
constexpr size_t WS_WBR = 28 * MiB;
constexpr size_t WS_WOUT = 32 * MiB;
constexpr size_t WS_WSC = 36 * MiB;
constexpr size_t WS_SU = WS_CONST + 256 * 1024, WS_SV = WS_CONST + 512 * 1024;
constexpr size_t WS_UBF = 44 * MiB;
constexpr size_t WS_VBF = 108 * MiB;
constexpr size_t WS_H8 = WS_UBF + 32 * MiB;
constexpr size_t WS_W8IN = WS_VBF + 32 * MiB, WS_W8GATE = WS_VBF + 40 * MiB, WS_W8OUT = WS_VBF + 48 * MiB, WS_W8S = WS_VBF + 50 * MiB;
constexpr size_t WS_SWS = WS_CONST + 640 * 1024;
constexpr size_t WS_XB2 = WS_WOUT, WS_SXG = WS_WOUT + 1 * MiB;
constexpr size_t WS_X = 172 * MiB;
constexpr size_t WS_H = 237 * MiB;
constexpr size_t WS_YS = 270 * MiB;
constexpr size_t WS_R1 = 303 * MiB;
constexpr size_t WS_Q = WS_R1, WS_K = WS_Q + (size_t)20 * MT * 128, WS_V = WS_K + (size_t)12 * MT * 128;
constexpr size_t WS_END = 433 * MiB;
constexpr size_t WS_DBG = 433 * MiB;
static_assert(WS_V + (size_t)12 * MT * 128 <= WS_END && WS_R1 + (size_t)MT * 4096 * 2 <= WS_END && WS_R1 + (size_t)MT * 2048 * 4 <= WS_END, "ws map");
constexpr int CW_BAR = 4096;
constexpr int CW_CHK = 64;

constexpr int RING_BYTES = 131072;
constexpr int LDSCTL_OFF = RING_BYTES, MISC_OFF = LDSCTL_OFF + 320;
constexpr int LDS_BYTES = 147456;

#define GAS __attribute__((address_space(1)))
#define LAS __attribute__((address_space(3)))
typedef unsigned short bf16_t;
typedef unsigned v4u __attribute__((ext_vector_type(4)));
typedef unsigned v2u __attribute__((ext_vector_type(2)));
typedef float f32x4 __attribute__((ext_vector_type(4)));
typedef float f32x2 __attribute__((ext_vector_type(2)));
typedef float f32x16 __attribute__((ext_vector_type(16)));
typedef short bf16x8 __attribute__((ext_vector_type(8)));
typedef short s16x4 __attribute__((ext_vector_type(4)));
typedef __bf16 bf16x2_t __attribute__((ext_vector_type(2)));
typedef int i32x8 __attribute__((ext_vector_type(8)));
typedef int i32x4 __attribute__((ext_vector_type(4)));
typedef GAS unsigned gu32;
#define RLX_AGENT __ATOMIC_RELAXED, __HIP_MEMORY_SCOPE_AGENT
#define LDS_WAIT() asm volatile("s_waitcnt lgkmcnt(0)" ::: "memory")
#define VM_WAIT() asm volatile("s_waitcnt vmcnt(0)" ::: "memory")

__device__ __forceinline__ int lane_now() { int l; asm volatile("v_mbcnt_lo_u32_b32 %0, -1, 0\n\tv_mbcnt_hi_u32_b32 %0, -1, %0" : "=v"(l)); return l; }
__device__ __forceinline__ int tid_now(int wave) { return (wave << 6) | lane_now(); }
__device__ __forceinline__ unsigned f2bf(float f) { unsigned u = __builtin_bit_cast(unsigned, f); return (u + 0x7fffu + ((u >> 16) & 1u)) >> 16; }
__device__ __forceinline__ unsigned pk2(float lo, float hi) { f32x2 v = {lo, hi}; bf16x2_t b = __builtin_convertvector(v, bf16x2_t); return __builtin_bit_cast(unsigned, b); }
__device__ __forceinline__ unsigned pk4_fp8(float a, float b, float c, float d) { int w = 0; w = __builtin_amdgcn_cvt_pk_fp8_f32(a, b, w, false); w = __builtin_amdgcn_cvt_pk_fp8_f32(c, d, w, true); return (unsigned)w; }
__device__ __forceinline__ float bflo(unsigned w) { return __builtin_bit_cast(float, w << 16); }
__device__ __forceinline__ float bfhi(unsigned w) { return __builtin_bit_cast(float, w & 0xffff0000u); }
__device__ __forceinline__ float bf2f(bf16_t h) { return __builtin_bit_cast(float, (unsigned)h << 16); }
template <int X> __device__ __forceinline__ float xorf(float v) { return __builtin_bit_cast(float, __builtin_amdgcn_ds_swizzle(__builtin_bit_cast(int, v), (X << 10) | 0x1f)); }
__device__ __forceinline__ float x32_sum(float v) { auto r = __builtin_amdgcn_permlane32_swap(__float_as_uint(v), __float_as_uint(v), false, false); return __uint_as_float(r[0]) + __uint_as_float(r[1]); }
__device__ __forceinline__ float x32_max(float v) { auto r = __builtin_amdgcn_permlane32_swap(__float_as_uint(v), __float_as_uint(v), false, false); return __builtin_fmaxf(__uint_as_float(r[0]), __uint_as_float(r[1])); }
__device__ __forceinline__ float wave_sum(float v) { v += xorf<1>(v); v += xorf<2>(v); v += xorf<4>(v); v += xorf<8>(v); v += xorf<16>(v); return x32_sum(v); }
__device__ __forceinline__ float wave_max(float v) { v = __builtin_fmaxf(v, xorf<1>(v)); v = __builtin_fmaxf(v, xorf<2>(v)); v = __builtin_fmaxf(v, xorf<4>(v)); v = __builtin_fmaxf(v, xorf<8>(v)); v = __builtin_fmaxf(v, xorf<16>(v)); return x32_max(v); }
__device__ __forceinline__ float fast_exp2(float x) { return __builtin_amdgcn_exp2f(x); }
__device__ __forceinline__ float fast_rcp(float x) { return __builtin_amdgcn_rcpf(x); }
__device__ __forceinline__ float sigmoidf_(float x) { return fast_rcp(1.0f + fast_exp2(-x * LOG2E)); }
__device__ __forceinline__ float gelu_tanh(float x) {
    const float y = 0.7978845608028654f * (x + 0.044715f * x * x * x);
    const float t = 1.0f - 2.0f * fast_rcp(1.0f + fast_exp2(2.0f * LOG2E * y));
    return 0.5f * x * (1.0f + t);
}
#define XB_TMO      128
#define XB_XCNT(j)  (256  + 64 * (j))
#define XB_XSUB(j)  (1280 + 64 * (j))
#define XB_XGEN(j)  (2304 + 64 * (j))
#define XB_TOP      3328
#define XB_TOPGEN   3392
#define XCD_BAR_WORDS 3456
#define XB_SPIN_CAP (1u << 20)
__device__ __forceinline__ unsigned xb_ld(unsigned* p)              { return __hip_atomic_load(p, __ATOMIC_RELAXED, __HIP_MEMORY_SCOPE_AGENT); }
__device__ __forceinline__ unsigned xb_add(unsigned* p, unsigned v) { return __hip_atomic_fetch_add(p, v, __ATOMIC_RELAXED, __HIP_MEMORY_SCOPE_AGENT); }
__device__ __forceinline__ unsigned xb_xcc_id() { return (unsigned)__builtin_amdgcn_s_getreg((3 << 11) | 20) & 0xFu; }
#define XB_SPIN(cond, bar) do { unsigned _sp = 0; while (cond) { __builtin_amdgcn_s_sleep(1); \
    if ((++_sp & 255u) == 0u) { if (xb_ld(&(bar)[XB_TMO])) break; if (_sp > XB_SPIN_CAP) { atomicAdd(&(bar)[XB_TMO], 1u); break; } } } } while (0)
struct XcdBarrier { unsigned* bar; unsigned x; volatile LAS unsigned* st; int wave; };
__device__ __forceinline__ XcdBarrier xcd_barrier_post(unsigned* bar, volatile LAS unsigned* st, int wave) {
    XcdBarrier b; b.bar = bar; b.x = xb_xcc_id(); b.st = st; b.wave = wave;
    if (tid_now(wave) == 0) (void)xb_add(&bar[XB_XCNT(b.x)], 1u);
    return b;
}
__device__ __forceinline__ void xcd_barrier_complete(unsigned* bar, unsigned x, unsigned& nloc, unsigned& nx) {
    const unsigned G = gridDim.x * gridDim.y * gridDim.z;
    unsigned sum, cnt, mine, sp = 0u;
    for (;;) {
        sum = 0u; cnt = 0u; mine = 0u;
#pragma unroll
        for (unsigned j = 0; j < 16; ++j) { const unsigned c = xb_ld(&bar[XB_XCNT(j)]); sum += c; cnt += (c > 0u) ? 1u : 0u; mine = (j == x) ? c : mine; }
        if (sum == G) break;
        __builtin_amdgcn_s_sleep(1);
        if ((++sp & 255u) == 0u) { if (xb_ld(&bar[XB_TMO])) break; if (sp > XB_SPIN_CAP) { atomicAdd(&bar[XB_TMO], 1u); break; } }
    }
    nloc = mine > 0u ? mine : 1u; nx = cnt > 0u ? cnt : 1u;
}
__device__ __forceinline__ void xcd_barrier(const XcdBarrier& b) {
    asm volatile("s_waitcnt vmcnt(0)" ::: "memory");
    __syncthreads();
    unsigned* bar_ = b.bar; unsigned bx_ = b.x; asm volatile("" : "+s"(bar_), "+s"(bx_));
    if (tid_now(b.wave) == 0) {
        unsigned* bar = bar_; const unsigned bx = bx_;
        __builtin_amdgcn_s_waitcnt(0);
        unsigned nloc = b.st[0], nx = b.st[1];
        if (nloc == 0u) { xcd_barrier_complete(bar, bx, nloc, nx); b.st[0] = nloc; b.st[1] = nx; }
        const unsigned old = xb_add(&bar[XB_XSUB(bx)], 1u);
        const unsigned gen = old / nloc;
        if (old + 1u == (gen + 1u) * nloc) {
            __builtin_amdgcn_fence(__ATOMIC_RELEASE, "agent");
            asm volatile("s_waitcnt vmcnt(0)" ::: "memory");
            const unsigned og = xb_add(&bar[XB_TOP], 1u);
            const unsigned tg = og / nx;
            if (og + 1u == (tg + 1u) * nx) xb_add(&bar[XB_TOPGEN], 1u);
            else XB_SPIN(xb_ld(&bar[XB_TOPGEN]) == tg, bar);
            __builtin_amdgcn_fence(__ATOMIC_ACQUIRE, "agent");
            xb_add(&bar[XB_XGEN(bx)], 1u);
            asm volatile("s_waitcnt vmcnt(0)" ::: "memory");
        } else {
            XB_SPIN(xb_ld(&bar[XB_XGEN(bx)]) == gen, bar);
            __builtin_amdgcn_fence(__ATOMIC_ACQUIRE, "agent");
            asm volatile("s_waitcnt vmcnt(0)" ::: "memory");
        }
    }
    __syncthreads();
}

namespace pg8 {
#define PG8_LAS __attribute__((address_space(3)))
constexpr int BM = 256, BK = 64, HALF = 128, HTB = HALF * BK * 2, STAGE_BYTES = 8 * HTB, NXCD = 8, WGM = 8;
__host__ __device__ __forceinline__ int lds_byte(int r, int c) { const int st = (r >> 4) * 2 + (c >> 5), rr = r & 15, cc = c & 31, ob = rr * 64 + cc * 2; return st * 1024 + (ob ^ (((ob >> 9) & 1) << 5)); }
__host__ __device__ __forceinline__ void stage_rc(int b, int& R, int& C) { const int st = b / 1024, sb = b % 1024, swz = sb ^ (((sb >> 9) & 1) << 5); R = (st >> 1) * 16 + swz / 64; C = (st & 1) * 32 + (swz % 64) / 2; }
__host__ __device__ __forceinline__ int perm32(int rho) { const int n = rho >> 4, i = rho & 15; return 8 * (i >> 2) + 4 * n + (i & 3); }
__host__ __device__ __forceinline__ int wide_row(int R) { return 64 * (R >> 5) + 16 * ((R >> 2) & 3) + 4 * ((R >> 4) & 1) + (R & 3); }
template <class E, class = void> struct IsWide { static constexpr bool v = false; };
template <class E> struct IsWide<E, decltype((void)E::WIDE)> { static constexpr bool v = true; };

struct Unit { int pm, pn; const char* a; const char* b; };
struct Gemm { const void* A; const void* Bt; int nM, nN, K, lda, ldb, a_shift, a_pn_bytes, esz; };

struct StaticOrder {
    int nM, nN, nwg, G, c; const char* A; const char* B; size_t a_pm, b_pn; int a_shift, a_pn;
    __device__ void init(const Gemm& g, int G_, int c_) { nM = g.nM; nN = g.nN; nwg = nM * nN; G = G_; c = c_; A = (const char*)g.A; B = (const char*)g.Bt;
        a_pm = (size_t)BM * g.lda * g.esz; b_pn = (size_t)BM * g.ldb * g.esz; a_shift = g.a_shift; a_pn = g.a_pn_bytes; }
    __device__ bool has(int i) const { int cc = c; asm volatile("" : "+s"(cc)); return (long)i * G + cc < nwg; }
    __device__ bool next(int i, Unit& u) const {
        const long L = (long)i * G + c; if (L >= nwg) return false;
        int wgid = (int)L; { const int q = nwg / NXCD, r = nwg % NXCD, xcd = wgid % NXCD, off = wgid / NXCD; wgid = (xcd < r ? xcd * (q + 1) : r * (q + 1) + (xcd - r) * q) + off; }
        const int nig = WGM * nN, gid = wgid / nig, fm = gid * WGM, gsz = (nM - fm) < WGM ? (nM - fm) : WGM;
        u.pm = fm + ((wgid % nig) % gsz); u.pn = (wgid % nig) / gsz;
        u.a = A + (size_t)u.pm * a_pm + (size_t)(u.pn >> a_shift) * a_pn; u.b = B + (size_t)u.pn * b_pn; return true;
    }
};

template <class Epi, bool FP8 = false, int SCALE_ACT = 0x7F7F7F7F, bool I8 = false>
__device__ __forceinline__ void gemm_phase(PG8_LAS unsigned char* lds, const Gemm g, const StaticOrder& S, const Epi& E, int wave) {
    const int tid = tid_now(wave), wid = wave, lane = tid & 63, wr = wid >> 2, wc = wid & 3, fr = lane & 15, fq = lane >> 4;
    const int K = g.K, nt = (K * g.esz) / (BK * 2);
    unsigned voffA[2], voffB[2];
#pragma unroll
    for (int i = 0; i < 2; ++i) { int R, C; stage_rc(tid * 16 + i * 8192, R, C); const int Rb = IsWide<Epi>::v ? wide_row(R) : (Epi::PERM ? ((R & ~31) + perm32(R & 31)) : R);
        voffA[i] = (unsigned)(R * g.lda * g.esz + C * 2); voffB[i] = (unsigned)(Rb * g.ldb * g.esz + C * 2); }
    const size_t kstep = (size_t)(BK * 2);
    const size_t hstepA = (size_t)HALF * g.lda * g.esz, hstepB = (size_t)(IsWide<Epi>::v ? 8 : HALF) * g.ldb * g.esz;
    const unsigned ldsw = (unsigned)wid * 1024u, ldsbase = (unsigned)(uintptr_t)lds;
    const int aoff = FP8 ? lds_byte(wr * 64 + fr, fq * 16) : lds_byte(wr * 64 + fr, fq * 8), boff = FP8 ? lds_byte(wc * 32 + fr, fq * 16) : lds_byte(wc * 32 + fr, fq * 8);
#define PG8_SA(b, h) (((b) * 2 + (h)) * HTB)
#define PG8_SB(b, h) ((4 + (b) * 2 + (h)) * HTB)
#define PG8_GLDS(sbase, voff32, ldsdst) do { unsigned keep_; asm volatile("s_mov_b32 %0, m0\n\ts_mov_b32 m0, %3\n\ts_nop 0\n\tglobal_load_lds_dwordx4 %1, %2\n\ts_mov_b32 m0, %0" : "=&s"(keep_) : "v"(voff32), "s"(sbase), "s"(ldsdst) : "memory"); } while (0)
#define PG8_STAGE(bufoff, gbase, voff) do { _Pragma("unroll") for (int _i = 0; _i < 2; ++_i) \
        PG8_GLDS((const char*)(gbase), (voff)[_i], (unsigned)__builtin_amdgcn_readfirstlane((int)(ldsbase + (unsigned)(bufoff) + ldsw + _i * 8192))); } while (0)
#define PG8_LDA(dst, b, h) do { if constexpr (FP8) { _Pragma("unroll") for (int m = 0; m < 4; ++m) dst##8[m] = *(const PG8_LAS i32x8*)(lds + PG8_SA(b, h) + aoff + m * 2048); } \
        else { _Pragma("unroll") for (int m = 0; m < 4; ++m) _Pragma("unroll") for (int k = 0; k < 2; ++k) dst[m][k] = *(const PG8_LAS bf16x8*)(lds + PG8_SA(b, h) + aoff + m * 2048 + k * 1024); } } while (0)
#define PG8_LDB(dst, b, h) do { if constexpr (FP8) { _Pragma("unroll") for (int n = 0; n < 2; ++n) dst##8[n] = *(const PG8_LAS i32x8*)(lds + PG8_SB(b, h) + boff + n * 2048); } \
        else { _Pragma("unroll") for (int n = 0; n < 2; ++n) _Pragma("unroll") for (int k = 0; k < 2; ++k) dst[n][k] = *(const PG8_LAS bf16x8*)(lds + PG8_SB(b, h) + boff + n * 2048 + k * 1024); } } while (0)
#define PG8_MMA(ai, bj, At, Bt) do { __builtin_amdgcn_s_setprio(1); \
        if constexpr (FP8) { _Pragma("unroll") for (int m = 0; m < 4; ++m) _Pragma("unroll") for (int n = 0; n < 2; ++n) \
            acc[ai][bj][m][n] = __builtin_amdgcn_mfma_scale_f32_16x16x128_f8f6f4(Bt##8[n], At##8[m], acc[ai][bj][m][n], 0, 0, 0, 0x79797979, 0, SCALE_ACT); } \
        else if constexpr (I8) { _Pragma("unroll") for (int m = 0; m < 4; ++m) _Pragma("unroll") for (int n = 0; n < 2; ++n) _Pragma("unroll") for (int k = 0; k < 2; ++k) \
            acc[ai][bj][m][n] = __builtin_bit_cast(f32x4, __builtin_amdgcn_mfma_i32_16x16x64_i8(__builtin_bit_cast(i32x4, Bt[n][k]), __builtin_bit_cast(i32x4, At[m][k]), __builtin_bit_cast(i32x4, acc[ai][bj][m][n]), 0, 0, 0)); } \
        else { _Pragma("unroll") for (int m = 0; m < 4; ++m) _Pragma("unroll") for (int n = 0; n < 2; ++n) _Pragma("unroll") for (int k = 0; k < 2; ++k) \
            acc[ai][bj][m][n] = __builtin_amdgcn_mfma_f32_16x16x32_bf16(Bt[n][k], At[m][k], acc[ai][bj][m][n], 0, 0, 0); } \
        __builtin_amdgcn_s_setprio(0); } while (0)
#define PG8_WAIT_V(n) asm volatile("s_waitcnt vmcnt(" #n ")" ::: "memory")
#define PG8_WAIT_L(n) asm volatile("s_waitcnt lgkmcnt(" #n ")" ::: "memory")
#define PG8_BAR __builtin_amdgcn_s_barrier()
#define PG8_SCHED __builtin_amdgcn_sched_barrier(0)
    Unit cur, nxt; int ui = 0;
    if (!S.has(0)) return;
    (void)S.next(0, cur);
    f32x4 acc[2][2][4][2];
#pragma unroll
    for (int a = 0; a < 2; ++a)
#pragma unroll
        for (int b = 0; b < 2; ++b)
#pragma unroll
            for (int m = 0; m < 4; ++m)
#pragma unroll
                for (int n = 0; n < 2; ++n) acc[a][b][m][n] = (f32x4){0.f, 0.f, 0.f, 0.f};
    bf16x8 At[4][2], B0[2][2], B1[2][2]; i32x8 At8[4], B08[2], B18[2];
    const char* cA = cur.a; const char* cB = cur.b;
    PG8_STAGE(PG8_SB(0, 0), cB, voffB); PG8_STAGE(PG8_SB(0, 1), cB + hstepB, voffB); PG8_STAGE(PG8_SA(0, 0), cA, voffA); PG8_STAGE(PG8_SA(0, 1), cA + hstepA, voffA);
    { int w_ = wave; asm volatile("" : "+s"(w_)); if ((w_ >> 2) == 1) PG8_BAR; }
    PG8_WAIT_V(2); PG8_BAR;
    PG8_STAGE(PG8_SB(1, 0), cB + kstep, voffB); PG8_STAGE(PG8_SA(1, 0), cA + kstep, voffA); PG8_STAGE(PG8_SB(1, 1), cB + hstepB + kstep, voffB);
    PG8_WAIT_V(6); PG8_BAR;
    for (;;) {
        const bool has_next = S.has(ui + 1); nxt = cur; if (has_next) (void)S.next(ui + 1, nxt);
        const char* nA = has_next ? nxt.a : cA; const char* nB = has_next ? nxt.b : cB;
        for (int t = 0; t < nt; t += 2) {
            const bool last = (t == nt - 2);
            const char* a1 = cA + (size_t)(t + 1) * kstep;
            const char* a2 = last ? nA : cA + (size_t)(t + 2) * kstep; const char* b2 = last ? nB : cB + (size_t)(t + 2) * kstep;
            const char* a3 = a2 + kstep; const char* b3 = b2 + kstep;
            PG8_LDB(B0, 0, 0); PG8_LDB(B1, 0, 1); PG8_SCHED; PG8_LDA(At, 0, 0); PG8_STAGE(PG8_SA(1, 1), a1 + hstepA, voffA);
            PG8_WAIT_V(8); PG8_WAIT_L(0); PG8_BAR; PG8_MMA(0, 0, At, B0); PG8_MMA(0, 1, At, B1); PG8_BAR; PG8_SCHED;
            PG8_LDA(At, 0, 1); PG8_STAGE(PG8_SB(0, 0), b2, voffB); PG8_STAGE(PG8_SB(0, 1), b2 + hstepB, voffB); PG8_STAGE(PG8_SA(0, 0), a2, voffA);
            PG8_WAIT_V(8); PG8_WAIT_L(0); PG8_BAR; PG8_MMA(1, 0, At, B0); PG8_MMA(1, 1, At, B1); PG8_BAR; PG8_SCHED;
            PG8_LDB(B0, 1, 0); PG8_LDB(B1, 1, 1); PG8_SCHED; PG8_LDA(At, 1, 0); PG8_STAGE(PG8_SA(0, 1), a2 + hstepA, voffA);
            PG8_WAIT_V(8); PG8_WAIT_L(0); PG8_BAR; PG8_MMA(0, 0, At, B0); PG8_MMA(0, 1, At, B1); PG8_BAR; PG8_SCHED;
            PG8_LDA(At, 1, 1); PG8_STAGE(PG8_SB(1, 0), b3, voffB); PG8_STAGE(PG8_SB(1, 1), b3 + hstepB, voffB); PG8_STAGE(PG8_SA(1, 0), a3, voffA);
            PG8_WAIT_V(8); PG8_WAIT_L(0); PG8_BAR; PG8_MMA(1, 0, At, B0); PG8_MMA(1, 1, At, B1); PG8_BAR; PG8_SCHED;
        }
        { int w2_ = wave; asm volatile("" : "+s"(w2_));
          if ((w2_ >> 2) == 0) PG8_BAR;
          E(acc, cur, w2_ >> 2, w2_ & 3, 0, 0); }
        if (!S.has(ui + 1)) break;
#pragma unroll
        for (int a = 0; a < 2; ++a)
#pragma unroll
            for (int b = 0; b < 2; ++b)
#pragma unroll
                for (int m = 0; m < 4; ++m)
#pragma unroll
                    for (int n = 0; n < 2; ++n) acc[a][b][m][n] = (f32x4){0.f, 0.f, 0.f, 0.f};
        cur = nxt; cA = nA; cB = nB; ++ui;
        { int w_ = wave; asm volatile("" : "+s"(w_)); if ((w_ >> 2) == 1) PG8_BAR; }
    }
    PG8_WAIT_V(0);
    PG8_BAR;
#undef PG8_SA
#undef PG8_SB
#undef PG8_STAGE
#undef PG8_LDA
#undef PG8_LDB
#undef PG8_MMA
#undef PG8_WAIT_V
#undef PG8_WAIT_L
#undef PG8_BAR
#undef PG8_SCHED
}
}
namespace pg8 {
struct EpiQKV {
    static constexpr bool PERM = true;
    bf16_t *Qb, *Kb, *Vb; const float* qkw;
    __device__ __forceinline__ void operator()(const f32x4 (&acc)[2][2][4][2], const Unit& u, int wr, int wc, int, int) const {
        const int t_ = lane_now(); const int fr = t_ & 15, fq = (t_ >> 4) & 3;
        const int hs = __builtin_amdgcn_readfirstlane(u.pn * 4 + wc);
        bf16_t* dst; int rope = 0, norm = -1, dq = 0; float scale = 1.f;
        if (hs < 4)       { dst = Qb + (size_t)hs * MT * 64; scale = C2_64; }
        else if (hs < 8)  { dst = Kb + (size_t)(hs - 4) * MT * 64; }
        else if (hs < 12) { dst = Vb + (size_t)(hs - 8) * MT * 64; }
        else if (hs < 16) { dst = Qb + (size_t)(4 + 2 * (hs - 12)) * MT * 64; rope = 2; dq = 1; scale = C2_32; }
        else if (hs < 20) { dst = Kb + (size_t)(4 + hs - 16) * MT * 64; rope = 2; }
        else if (hs < 24) { dst = Vb + (size_t)(4 + hs - 20) * MT * 64; }
        else if (hs < 28) { dst = Qb + (size_t)(12 + hs - 24) * MT * 64; rope = 1; scale = C2_64; }
        else if (hs < 30) { dst = Kb + (size_t)(8 + hs - 28) * MT * 64; rope = 1; }
        else if (hs < 32) { dst = Vb + (size_t)(8 + hs - 30) * MT * 64; }
        else if (hs < 36) { dst = Qb + (size_t)(16 + hs - 32) * MT * 64; rope = 1; norm = 0; scale = C2_64; }
        else if (hs < 38) { dst = Kb + (size_t)(10 + hs - 36) * MT * 64; rope = 1; norm = 1; }
        else              { dst = Vb + (size_t)(10 + hs - 38) * MT * 64; }
        const bool latent = u.pm < SEQ / 256;
        if (!latent) rope = 0;
        float fstep = (rope == 2) ? (13.287712379549449f / 8.f) : (13.287712379549449f / 16.f); asm volatile("" : "+v"(fstep));
        const float fbase = (rope == 2) ? 0.f : (float)(8 * (fq & 1)) * fstep;
#define INVF(k) (fast_exp2(-(fbase + (float)(k) * fstep)) * 0.15915494309189535f)
#pragma unroll
        for (int m = 0; m < 4; ++m) {
            float csn[8], ccs[8];
            if (rope == 1) { float pos = (float)(m * 16 + fr); asm volatile("" : "+v"(pos));
#pragma unroll
                for (int k = 0; k < 8; ++k) { const float rev = pos * INVF(k); csn[k] = __builtin_amdgcn_sinf(rev); ccs[k] = __builtin_amdgcn_cosf(rev); } }
#pragma unroll
            for (int ai = 0; ai < 2; ++ai) {
                const int row = u.pm * BM + ai * HALF + wr * 64 + m * 16 + fr;
                float v[16];
#pragma unroll
                for (int bj = 0; bj < 2; ++bj)
#pragma unroll
                    for (int n = 0; n < 2; ++n)
#pragma unroll
                        for (int j = 0; j < 4; ++j) v[bj * 8 + n * 4 + j] = acc[ai][bj][m][n][j];
                if (norm >= 0) {
                    float ss = 0.f;
#pragma unroll
                    for (int k = 0; k < 16; ++k) ss += v[k] * v[k];
                    ss += xorf<16>(ss); ss = x32_sum(ss);
                    const float ri = __builtin_amdgcn_rsqf(ss * (1.f / 64.f) + EPS);
#pragma unroll
                    for (int bj = 0; bj < 2; ++bj) { const f32x4 w0 = *(const GAS f32x4*)(qkw + norm * 64 + 32 * bj + 8 * fq), w1 = *(const GAS f32x4*)(qkw + norm * 64 + 32 * bj + 8 * fq + 4);
#pragma unroll
                        for (int j = 0; j < 4; ++j) { v[bj * 8 + j] = v[bj * 8 + j] * ri * w0[j]; v[bj * 8 + 4 + j] = v[bj * 8 + 4 + j] * ri * w1[j]; } }
                }
                if (rope == 1) {
                    const float sgn = (fq & 2) ? 1.f : -1.f;
                    float pos = (float)(row >> 6); asm volatile("" : "+v"(pos));
#pragma unroll
                    for (int k = 0; k < 8; ++k) {
                        const float rev = pos * INVF(k); const float sn = __builtin_amdgcn_sinf(rev), cs = __builtin_amdgcn_cosf(rev);
                        const float x = v[k]; auto rx = __builtin_amdgcn_permlane32_swap(__float_as_uint(x), __float_as_uint(x), false, false);
                        const float pt = __uint_as_float((fq & 2) ? rx[0] : rx[1]);
                        v[k] = x * cs + sgn * pt * sn;
                        const float y = v[8 + k]; auto ry = __builtin_amdgcn_permlane32_swap(__float_as_uint(y), __float_as_uint(y), false, false);
                        const float qt = __uint_as_float((fq & 2) ? ry[0] : ry[1]);
                        v[8 + k] = y * ccs[k] + sgn * qt * csn[k];
                    }
                } else if (rope == 2) {
                    const float sgn = (fq & 1) ? 1.f : -1.f;
                    float pos = (float)(fq < 2 ? (row >> 6) : (row & 63)); asm volatile("" : "+v"(pos));
#pragma unroll
                    for (int k = 0; k < 8; ++k) {
                        const float rev = pos * INVF(k); const float sn = __builtin_amdgcn_sinf(rev), cs = __builtin_amdgcn_cosf(rev);
#pragma unroll
                        for (int bj = 0; bj < 2; ++bj) { const float x = v[bj * 8 + k], pt = xorf<16>(x); v[bj * 8 + k] = x * cs + sgn * pt * sn; }
                    }
                }
#pragma unroll
                for (int bj = 0; bj < 2; ++bj) {
                    v4u w; w.x = pk2(v[bj * 8 + 0] * scale, v[bj * 8 + 1] * scale); w.y = pk2(v[bj * 8 + 2] * scale, v[bj * 8 + 3] * scale);
                    w.z = pk2(v[bj * 8 + 4] * scale, v[bj * 8 + 5] * scale); w.w = pk2(v[bj * 8 + 6] * scale, v[bj * 8 + 7] * scale);
                    if (dq) {
                        *(GAS v4u*)(dst + (size_t)bj * MT * 64 + (size_t)row * 64 + 32 * bj + 8 * fq) = w;
                        unsigned z0 = 0u; asm volatile("" : "+v"(z0));
                        *(GAS v4u*)(dst + (size_t)(1 - bj) * MT * 64 + (size_t)row * 64 + 32 * bj + 8 * fq) = (v4u){z0, z0, z0, z0};
                    } else *(GAS v4u*)(dst + (size_t)row * 64 + 32 * bj + 8 * fq) = w;
                }
                __builtin_amdgcn_sched_barrier(0);
            }
        }
#undef INVF
    }
};
struct EpiBranch {
    static constexpr bool PERM = true;
    bf16_t* Bp;
    __device__ __forceinline__ void operator()(const f32x4 (&acc)[2][2][4][2], const Unit& u, int wr, int wc, int, int) const {
        const int t_ = lane_now(); const int fr = t_ & 15, fq = (t_ >> 4) & 3;
        const int branch = u.pn >> 2, chb = 256 * (u.pn & 3) + 32 * wc + 8 * fq;
#pragma unroll
        for (int ai = 0; ai < 2; ++ai)
#pragma unroll
            for (int m = 0; m < 4; ++m) { bf16_t* rowp = Bp + (size_t)(u.pm * BM + ai * HALF + wr * 64 + m * 16 + fr) * 4096 + branch * 1024 + chb;
#pragma unroll
                for (int bj = 0; bj < 2; ++bj) { const f32x4 a = acc[ai][bj][m][0], c = acc[ai][bj][m][1];
                    v4u w; w.x = pk2(a[0], a[1]); w.y = pk2(a[2], a[3]); w.z = pk2(c[0], c[1]); w.w = pk2(c[2], c[3]); *(GAS v4u*)(rowp + 128 * bj) = w; } }
    }
};
#ifndef BP8
#define BP8 1
#endif
#ifndef MIX8
#define MIX8 1
#endif
#if MIX8 && !BP8
#error MIX8 needs BP8
#endif
constexpr float BP8_SCALE = 32.f;
struct EpiBranch8 {
    static constexpr bool PERM = false, WIDE = true;
    unsigned char* Bp;
    __device__ __forceinline__ void operator()(const f32x4 (&acc)[2][2][4][2], const Unit& u, int wr, int wc, int, int) const {
        const int t_ = lane_now(); const int fr = t_ & 15, fq = (t_ >> 4) & 3;
        const int branch = u.pn >> 2, off = (4 * (u.pn & 3) + wc) * 256 + branch * 64 + 16 * fq;
#pragma unroll
        for (int ai = 0; ai < 2; ++ai)
#pragma unroll
            for (int m = 0; m < 4; ++m) { unsigned char* rowp = Bp + (size_t)(u.pm * BM + ai * HALF + wr * 64 + m * 16 + fr) * 4096 + off;
                v4u w;
#pragma unroll
                for (int bj = 0; bj < 2; ++bj) { const f32x4 a = acc[ai][bj][m][0] * BP8_SCALE, c = acc[ai][bj][m][1] * BP8_SCALE;
                    w[2 * bj] = pk4_fp8(a[0], a[1], a[2], a[3]); w[2 * bj + 1] = pk4_fp8(c[0], c[1], c[2], c[3]); }
                *(GAS v4u*)rowp = w; }
    }
};
struct EpiGate {
    static constexpr bool PERM = false;
    const bf16_t* Bp; bf16_t* mix; const float* bgate;
    __device__ __forceinline__ void operator()(const f32x4 (&acc)[2][2][4][2], const Unit& u, int wr, int wc, int, int) const {
        const int t_ = lane_now(); const int fr = t_ & 15, fq = (t_ >> 4) & 3;
        const int ch = 64 * u.pn + 16 * wc + 4 * fq;
        f32x4 bias[2][2];
#pragma unroll
        for (int bj = 0; bj < 2; ++bj)
#pragma unroll
            for (int n = 0; n < 2; ++n) bias[bj][n] = *(const GAS f32x4*)(bgate + (2 * bj + n) * 1024 + ch);
#if BP8
        unsigned b8a[2][4][4];
#pragma unroll
        for (int ai = 0; ai < 2; ++ai)
#pragma unroll
            for (int m = 0; m < 4; ++m) { const size_t row = (size_t)(u.pm * BM + ai * HALF + wr * 64 + m * 16 + fr);
#pragma unroll
                for (int b = 0; b < 4; ++b) b8a[ai][m][b] = *(const GAS unsigned*)((const unsigned char*)Bp + row * 4096 + u.pn * 256 + b * 64 + 16 * wc + 4 * fq); }
#endif
#pragma unroll
        for (int ai = 0; ai < 2; ++ai)
#pragma unroll
            for (int m = 0; m < 4; ++m) { const size_t row = (size_t)(u.pm * BM + ai * HALF + wr * 64 + m * 16 + fr);
                f32x4 s = {0.f, 0.f, 0.f, 0.f};
#if BP8
#pragma unroll
                for (int bj = 0; bj < 2; ++bj)
#pragma unroll
                    for (int n = 0; n < 2; ++n) { const f32x4 a = acc[ai][bj][m][n] + bias[bj][n]; const int w = (int)b8a[ai][m][2 * bj + n];
                        const f32x2 lo = __builtin_amdgcn_cvt_pk_f32_fp8(w, false), hi = __builtin_amdgcn_cvt_pk_f32_fp8(w, true);
                        s[0] += sigmoidf_(a[0]) * lo.x; s[1] += sigmoidf_(a[1]) * lo.y; s[2] += sigmoidf_(a[2]) * hi.x; s[3] += sigmoidf_(a[3]) * hi.y; }
#if !MIX8
                s = s * (1.f / BP8_SCALE);
#endif
#else
                v2u bb[4];
#pragma unroll
                for (int b = 0; b < 4; ++b) bb[b] = *(const GAS v2u*)(Bp + row * 4096 + b * 1024 + ch);
#pragma unroll
                for (int bj = 0; bj < 2; ++bj)
#pragma unroll
                    for (int n = 0; n < 2; ++n) { const f32x4 a = acc[ai][bj][m][n] + bias[bj][n]; const unsigned w0 = bb[2 * bj + n].x, w1 = bb[2 * bj + n].y;
                        s[0] += sigmoidf_(a[0]) * bflo(w0); s[1] += sigmoidf_(a[1]) * bfhi(w0); s[2] += sigmoidf_(a[2]) * bflo(w1); s[3] += sigmoidf_(a[3]) * bfhi(w1); }
#endif
#if MIX8
                *(GAS unsigned*)((unsigned char*)mix + row * 1024 + ch) = pk4_fp8(s[0], s[1], s[2], s[3]); }
#else
                v2u w; w.x = pk2(s[0], s[1]); w.y = pk2(s[2], s[3]); *(GAS v2u*)(mix + row * 1024 + ch) = w; }
#endif
    }
};
struct EpiOut {
    static constexpr bool PERM = false;
    const float* xl; const float* xc; float* X; const float* gl; const float* gc;
    __device__ __forceinline__ void operator()(const f32x4 (&acc)[2][2][4][2], const Unit& u, int wr, int wc, int, int) const {
        const int t_ = lane_now(); const int fr = t_ & 15, fq = (t_ >> 4) & 3;
        const bool latent = u.pm < SEQ / 256; const float* gv = latent ? gl : gc; const float* xo = latent ? xl : xc - (size_t)SEQ * DM;
        const int col0 = u.pn * BM + wc * 32 + 4 * fq;
        f32x4 g[2][2];
#pragma unroll
        for (int bj = 0; bj < 2; ++bj)
#pragma unroll
            for (int n = 0; n < 2; ++n) g[bj][n] = *(const GAS f32x4*)(gv + col0 + bj * HALF + n * 16);
#pragma unroll
        for (int ai = 0; ai < 2; ++ai)
#pragma unroll
            for (int m = 0; m < 4; ++m) { const size_t off = (size_t)(u.pm * BM + ai * HALF + wr * 64 + m * 16 + fr) * DM + col0;
#pragma unroll
                for (int bj = 0; bj < 2; ++bj)
#pragma unroll
                    for (int n = 0; n < 2; ++n) { const f32x4 o = *(const GAS f32x4*)(xo + off + bj * HALF + n * 16); *(GAS f32x4*)(X + off + bj * HALF + n * 16) = o + g[bj][n] * acc[ai][bj][m][n]; } }
    }
};
struct EpiOutNorm {
    static constexpr bool PERM = true;
    const float* xl; const float* xc; float* X; const float* gl; const float* gc;
    bf16_t* H; const float* nw; const float* ml; const float* mc;
    gu32* xbuf; gu32* cnt; gu32* tmo; LAS unsigned char* tl;
    gu32* xbuf2; gu32* cnt2; unsigned char* XQ; float* SXG;
    __device__ __forceinline__ void operator()(f32x4 (&acc)[2][2][4][2], const Unit& u, int wr, int wc, int, int) const {
        const int t_ = lane_now(); const int fr = t_ & 15, fq = (t_ >> 4) & 3;
        const bool latent = u.pm < SEQ / 256; const float* gv = latent ? gl : gc; const float* xo = latent ? xl : xc - (size_t)SEQ * DM;
        const int col0 = u.pn * BM + wc * 32 + 8 * fq;
        LAS float* P = (LAS float*)tl; LAS float* Sr = (LAS float*)(tl + 4096); volatile LAS unsigned* flag = (volatile LAS unsigned*)(tl + 5120);
        {
            f32x4 g[2][2];
#pragma unroll
            for (int bj = 0; bj < 2; ++bj)
#pragma unroll
                for (int n = 0; n < 2; ++n) g[bj][n] = *(const GAS f32x4*)(gv + col0 + bj * HALF + n * 4);
            f32x4 xo_c[2][2], xo_n[2][2];
#define EON_LOAD(dst, it_) do { const int r_ = ((it_) >> 2) * HALF + wr * 64 + ((it_) & 3) * 16 + fr; const size_t off_ = (size_t)(u.pm * BM + r_) * DM + col0; \
            _Pragma("unroll") for (int bj = 0; bj < 2; ++bj) _Pragma("unroll") for (int n = 0; n < 2; ++n) dst[bj][n] = *(const GAS f32x4*)(xo + off_ + bj * HALF + n * 4); } while (0)
            EON_LOAD(xo_c, 0);
#pragma unroll
            for (int it = 0; it < 8; ++it) { const int ai = it >> 2, m = it & 3;
                if (it < 7) EON_LOAD(xo_n, it + 1);
                const int r = ai * HALF + wr * 64 + m * 16 + fr; const size_t off = (size_t)(u.pm * BM + r) * DM + col0; float s = 0.f;
#pragma unroll
                for (int bj = 0; bj < 2; ++bj)
#pragma unroll
                    for (int n = 0; n < 2; ++n) { const f32x4 y = xo_c[bj][n] + g[bj][n] * acc[ai][bj][m][n];
                        *(GAS f32x4*)(X + off + bj * HALF + n * 4) = y; acc[ai][bj][m][n] = y; s += (y.x * y.x + y.y * y.y) + (y.z * y.z + y.w * y.w); }
                s += xorf<16>(s); s = x32_sum(s);
                if (fq == 0) P[r * 4 + wc] = s;
#pragma unroll
                for (int bj = 0; bj < 2; ++bj)
#pragma unroll
                    for (int n = 0; n < 2; ++n) xo_c[bj][n] = xo_n[bj][n]; }
#undef EON_LOAD
        }
        asm volatile("s_waitcnt lgkmcnt(0)" ::: "memory"); __builtin_amdgcn_s_barrier(); asm volatile("" ::: "memory");
        const int wid = wr * 4 + wc, row = wid * 32 + (t_ & 31);
        if (t_ < 32) { const float tp = (P[row * 4 + 0] + P[row * 4 + 1]) + (P[row * 4 + 2] + P[row * 4 + 3]);
            __hip_atomic_store(xbuf + ((size_t)(u.pm * BM + row) * 4 + u.pn), __float_as_uint(tp), RLX_AGENT); }
        asm volatile("s_waitcnt vmcnt(0)" ::: "memory");
        if (t_ == 0) (void)__hip_atomic_fetch_add(cnt + 64 * u.pm, 1u, RLX_AGENT);
        if (wid == 0) {
            unsigned sp = 0u, dead = 0u;
            while ((unsigned)__builtin_amdgcn_readfirstlane((int)__hip_atomic_load(cnt + 64 * u.pm, RLX_AGENT)) < 32u) {
                __builtin_amdgcn_s_sleep(2);
                if ((++sp & 255u) == 0u) { if (__builtin_amdgcn_readfirstlane((int)__hip_atomic_load(tmo, RLX_AGENT)) != 0) { dead = 1u; break; }
                    if (sp > (1u << 22)) { if (t_ == 0) __hip_atomic_store(tmo, 1u, RLX_AGENT); dead = 1u; break; } } }
            __builtin_amdgcn_fence(__ATOMIC_ACQUIRE, "agent");
            if (t_ == 0) flag[0] = dead;
        }
        asm volatile("s_waitcnt vmcnt(0) lgkmcnt(0)" ::: "memory"); __builtin_amdgcn_s_barrier(); asm volatile("" ::: "memory");
        if (t_ < 32) { const gu32* sl = xbuf + (size_t)(u.pm * BM + row) * 4; float tot = 0.f;
#pragma unroll
            for (int q = 0; q < 4; ++q) tot += __uint_as_float(__hip_atomic_load(sl + q, RLX_AGENT));
            Sr[row] = __builtin_amdgcn_rsqf(tot * (1.f / DM) + EPS); }
        asm volatile("s_waitcnt vmcnt(0) lgkmcnt(0)" ::: "memory"); __builtin_amdgcn_s_barrier(); asm volatile("" ::: "memory");
        const float* mv = latent ? ml : mc;
        f32x4 wa[2][2], bb[2][2];
#pragma unroll
        for (int bj = 0; bj < 2; ++bj)
#pragma unroll
            for (int n = 0; n < 2; ++n) { const int col = col0 + bj * HALF + 4 * n; const f32x4 w = *(const GAS f32x4*)(nw + col), a = *(const GAS f32x4*)(mv + 4096 + col); bb[bj][n] = *(const GAS f32x4*)(mv + 3072 + col); wa[bj][n] = w * (1.0f + a); }
#pragma unroll
        for (int ai = 0; ai < 2; ++ai)
#pragma unroll
            for (int m = 0; m < 4; ++m) { const int r = ai * HALF + wr * 64 + m * 16 + fr; const float ri = Sr[r]; float mx = 0.f;
#pragma unroll
                for (int bj = 0; bj < 2; ++bj)
#pragma unroll
                    for (int n = 0; n < 2; ++n) { const f32x4 y = (acc[ai][bj][m][n] * ri) * wa[bj][n] + bb[bj][n]; acc[ai][bj][m][n] = y;
                        mx = __builtin_fmaxf(mx, __builtin_fmaxf(__builtin_fmaxf(__builtin_fabsf(y.x), __builtin_fabsf(y.y)), __builtin_fmaxf(__builtin_fabsf(y.z), __builtin_fabsf(y.w)))); }
                mx = __builtin_fmaxf(mx, xorf<16>(mx)); mx = x32_max(mx);
                if (fq == 0) P[r * 4 + wc] = mx; }
        asm volatile("s_waitcnt lgkmcnt(0)" ::: "memory"); __builtin_amdgcn_s_barrier(); asm volatile("" ::: "memory");
        if (t_ < 32) { const float tp = __builtin_fmaxf(__builtin_fmaxf(P[row * 4 + 0], P[row * 4 + 1]), __builtin_fmaxf(P[row * 4 + 2], P[row * 4 + 3]));
            __hip_atomic_store(xbuf2 + ((size_t)(u.pm * BM + row) * 4 + u.pn), __float_as_uint(tp), RLX_AGENT); }
        asm volatile("s_waitcnt vmcnt(0)" ::: "memory");
        if (t_ == 0) (void)__hip_atomic_fetch_add(cnt2 + 64 * u.pm, 1u, RLX_AGENT);
        if (wid == 0) {
            unsigned sp = 0u, dead = 0u;
            while ((unsigned)__builtin_amdgcn_readfirstlane((int)__hip_atomic_load(cnt2 + 64 * u.pm, RLX_AGENT)) < 32u) {
                __builtin_amdgcn_s_sleep(2);
                if ((++sp & 255u) == 0u) { if (__builtin_amdgcn_readfirstlane((int)__hip_atomic_load(tmo, RLX_AGENT)) != 0) { dead = 1u; break; }
                    if (sp > (1u << 22)) { if (t_ == 0) __hip_atomic_store(tmo, 1u, RLX_AGENT); dead = 1u; break; } } }
            __builtin_amdgcn_fence(__ATOMIC_ACQUIRE, "agent");
            if (t_ == 0) flag[0] = dead;
        }
        asm volatile("s_waitcnt vmcnt(0) lgkmcnt(0)" ::: "memory"); __builtin_amdgcn_s_barrier(); asm volatile("" ::: "memory");
        if (t_ < 32) { const gu32* sl = xbuf2 + (size_t)(u.pm * BM + row) * 4; float am = 0.f;
#pragma unroll
            for (int q = 0; q < 4; ++q) am = __builtin_fmaxf(am, __uint_as_float(__hip_atomic_load(sl + q, RLX_AGENT)));
            Sr[row] = am > 0.f ? 127.f / am : 0.f;
            if (u.pn == 0) ((GAS float*)SXG)[u.pm * BM + row] = am * (1.f / 127.f); }
        asm volatile("s_waitcnt vmcnt(0) lgkmcnt(0)" ::: "memory"); __builtin_amdgcn_s_barrier(); asm volatile("" ::: "memory");
#pragma unroll
        for (int ai = 0; ai < 2; ++ai)
#pragma unroll
            for (int m = 0; m < 4; ++m) { const int r = ai * HALF + wr * 64 + m * 16 + fr; const float ix = Sr[r];
#pragma unroll
                for (int bj = 0; bj < 2; ++bj) { v2u o;
#pragma unroll
                    for (int n = 0; n < 2; ++n) { const f32x4 y = acc[ai][bj][m][n] * ix;
                        const int q0 = (int)__builtin_rintf(y.x), q1 = (int)__builtin_rintf(y.y), q2 = (int)__builtin_rintf(y.z), q3 = (int)__builtin_rintf(y.w);
                        o[n] = (unsigned)(q0 & 0xff) | ((unsigned)(q1 & 0xff) << 8) | ((unsigned)(q2 & 0xff) << 16) | ((unsigned)(q3 & 0xff) << 24); }
                    *(GAS v2u*)(XQ + (size_t)(u.pm * BM + r) * DM + col0 + bj * HALF) = o; } }
    }
};
struct EpiS {
    static constexpr bool PERM = true;
    float* S;
    __device__ __forceinline__ void operator()(const f32x4 (&acc)[2][2][4][2], const Unit& u, int wr, int wc, int, int) const {
        const int t_ = lane_now(); const int fr = t_ & 15, fq = (t_ >> 4) & 3;
        const int col0 = u.pn * BM + wc * 32 + 8 * fq;
        bf16_t* Sb = (bf16_t*)S;
#pragma unroll
        for (int ai = 0; ai < 2; ++ai)
#pragma unroll
            for (int m = 0; m < 4; ++m) { bf16_t* rowp = Sb + (size_t)(u.pm * BM + ai * HALF + wr * 64 + m * 16 + fr) * 2048 + col0;
#pragma unroll
                for (int bj = 0; bj < 2; ++bj) { const f32x4 a0 = acc[ai][bj][m][0], a1 = acc[ai][bj][m][1];
                    v4u o; o.x = pk2(a0.x, a0.y); o.y = pk2(a0.z, a0.w); o.z = pk2(a1.x, a1.y); o.w = pk2(a1.z, a1.w);
                    *(GAS v4u*)(rowp + bj * HALF) = o; } }
    }
};
struct EpiS8 {
    static constexpr bool PERM = true;
    float* S; const float* SXG; const float* SW;
    __device__ __forceinline__ void operator()(const f32x4 (&acc)[2][2][4][2], const Unit& u, int wr, int wc, int, int) const {
        const int t_ = lane_now(); const int fr = t_ & 15, fq = (t_ >> 4) & 3;
        const int col0 = u.pn * BM + wc * 32 + 8 * fq;
        bf16_t* Sb = (bf16_t*)S;
        f32x4 sw[2][2];
#pragma unroll
        for (int bj = 0; bj < 2; ++bj)
#pragma unroll
            for (int n = 0; n < 2; ++n) sw[bj][n] = *(const GAS f32x4*)(SW + col0 + bj * HALF + 4 * n);
#pragma unroll
        for (int ai = 0; ai < 2; ++ai)
#pragma unroll
            for (int m = 0; m < 4; ++m) { const int row = u.pm * BM + ai * HALF + wr * 64 + m * 16 + fr; const float sx = ((const GAS float*)SXG)[row];
                bf16_t* rowp = Sb + (size_t)row * 2048 + col0;
#pragma unroll
                for (int bj = 0; bj < 2; ++bj) { const i32x4 i0 = __builtin_bit_cast(i32x4, acc[ai][bj][m][0]), i1 = __builtin_bit_cast(i32x4, acc[ai][bj][m][1]);
                    const f32x4 a0 = __builtin_convertvector(i0, f32x4) * sx * sw[bj][0], a1 = __builtin_convertvector(i1, f32x4) * sx * sw[bj][1];
                    v4u o; o.x = pk2(a0.x, a0.y); o.y = pk2(a0.z, a0.w); o.z = pk2(a1.x, a1.y); o.w = pk2(a1.z, a1.w);
                    *(GAS v4u*)(rowp + bj * HALF) = o; } }
    }
};
}
namespace att {
using bf16 = __hip_bfloat16;
constexpr int NW = 8, QBLK = 32, QB = 256, KVBLK = 64;
__device__ __forceinline__ int crow(int r, int hi) { return (r & 3) + 8 * (r >> 2) + 4 * hi; }
#define SBAR() __builtin_amdgcn_sched_barrier(0)
constexpr int NSLOT = 3, SLOTB = 8192;
constexpr int LDS_K = 0, LDS_V = NSLOT * SLOTB, LDS_WS = 2 * NSLOT * SLOTB, LDS_OST = LDS_WS + NW * 64 * 4, LDS_RPB = LDS_OST + NW * 8192, LDS_BYTES = LDS_RPB + 2048;
static_assert(LDS_BYTES <= RING_BYTES, "attention scratch fits the ring region");
__device__ __forceinline__ void glds16(const void* gsrc, unsigned lds_dst) { unsigned keep;
    asm volatile("s_mov_b32 %0, m0\n\ts_mov_b32 m0, %2\n\ts_nop 0\n\tglobal_load_lds_dwordx4 %1, off\n\ts_mov_b32 m0, %0" : "=&s"(keep) : "v"(gsrc), "s"(lds_dst) : "memory"); }
__device__ __forceinline__ float max3f(float a, float b, float c) { float r; asm("v_max3_f32 %0, %1, %2, %3" : "=v"(r) : "v"(a), "v"(b), "v"(c)); return r; }
__device__ __forceinline__ float max2f(float a, float b) { float r; asm("v_max_f32_e32 %0, %1, %2" : "=v"(r) : "v"(a), "v"(b)); return r; }
__device__ __forceinline__ float fadd_s(float a, float b) { float r; asm("v_add_f32_e32 %0, %1, %2" : "=v"(r) : "v"(a), "v"(b)); return r; }
__device__ __forceinline__ float fsub_s(float a, float b) { float r; asm("v_sub_f32_e32 %0, %1, %2" : "=v"(r) : "v"(a), "v"(b)); return r; }
__device__ __forceinline__ unsigned cvtpk_s(float lo, float hi) { f32x2 v = {lo, hi}; bf16x2_t b = __builtin_convertvector(v, bf16x2_t); return __builtin_bit_cast(unsigned, b); }
#define WAIT_BAR(N) asm volatile("s_waitcnt vmcnt(" #N ") lgkmcnt(0)\n\ts_barrier" ::: "memory")

__device__ __forceinline__ void qkt(f32x16& p0, f32x16& p1, const char* Kslot, const bf16x8* qr, const f32x16& negm, int r32, int hi) {
    const LAS char* kb = (const LAS char*)Kslot + hi * 1024 + r32 * 16;
#pragma unroll
    for (int d0 = 0; d0 < 4; ++d0) {
        const bf16x8 b0 = *(const LAS bf16x8*)(kb + d0 * 2048);
        const bf16x8 b1 = *(const LAS bf16x8*)(kb + d0 * 2048 + 512);
        if (d0 == 0) { p0 = __builtin_amdgcn_mfma_f32_32x32x16_bf16(b0, qr[0], negm, 0, 0, 0); p1 = __builtin_amdgcn_mfma_f32_32x32x16_bf16(b1, qr[0], negm, 0, 0, 0); }
        else { p0 = __builtin_amdgcn_mfma_f32_32x32x16_bf16(b0, qr[d0], p0, 0, 0, 0); p1 = __builtin_amdgcn_mfma_f32_32x32x16_bf16(b1, qr[d0], p1, 0, 0, 0); } }
}
typedef __attribute__((address_space(3))) const char* lds_cptr;
typedef short v4i16_t __attribute__((ext_vector_type(4)));
__device__ __forceinline__ void kload8(bf16x8* kf, lds_cptr kp) {
    kf[0] = *(const __attribute__((address_space(3))) bf16x8*)(kp);        kf[1] = *(const __attribute__((address_space(3))) bf16x8*)(kp + 512);
    kf[2] = *(const __attribute__((address_space(3))) bf16x8*)(kp + 2048); kf[3] = *(const __attribute__((address_space(3))) bf16x8*)(kp + 2560);
    kf[4] = *(const __attribute__((address_space(3))) bf16x8*)(kp + 4096); kf[5] = *(const __attribute__((address_space(3))) bf16x8*)(kp + 4608);
    kf[6] = *(const __attribute__((address_space(3))) bf16x8*)(kp + 6144); kf[7] = *(const __attribute__((address_space(3))) bf16x8*)(kp + 6656);
}
__device__ __forceinline__ void kload2(bf16x8* kf, lds_cptr kp, int j) { kf[2 * j] = *(const __attribute__((address_space(3))) bf16x8*)(kp + j * 2048); kf[2 * j + 1] = *(const __attribute__((address_space(3))) bf16x8*)(kp + j * 2048 + 512); }
__device__ __forceinline__ s16x4 vtr(lds_cptr p) { return __builtin_bit_cast(s16x4, __builtin_amdgcn_ds_read_tr16_b64_v4i16((__attribute__((address_space(3))) v4i16_t*)p)); }
__device__ __forceinline__ float rowmax(const f32x16& p0, const f32x16& p1) {
    float a = max3f(p0[0], p0[1], p1[0]), b = max3f(p0[2], p0[3], p1[1]); a = max3f(a, p1[2], p1[3]);
#pragma unroll
    for (int r = 4; r < 16; r += 4) { a = max3f(a, p0[r], p0[r + 1]); b = max3f(b, p0[r + 2], p0[r + 3]); a = max3f(a, p1[r], p1[r + 1]); b = max3f(b, p1[r + 2], p1[r + 3]); }
    const float m = max2f(a, b);
    auto rr = __builtin_amdgcn_permlane32_swap(__float_as_uint(m), __float_as_uint(m), false, false);
    return max2f(__uint_as_float(rr[0]), __uint_as_float(rr[1]));
}
__device__ __forceinline__ void pv(f32x16* o, int vb, bf16x8 pa0, bf16x8 pa1, bf16x8 pa2, bf16x8 pa3) {
#pragma unroll
    for (int d0 = 0; d0 < 2; ++d0) { s16x4 lo[4], hi[4];
#pragma unroll
        for (int ks = 0; ks < 4; ++ks) {
            asm volatile("ds_read_b64_tr_b16 %0,%1 offset:%c2" : "=&v"(lo[ks]) : "v"(vb), "i"(d0 * 4096 + ks * 1024) : "memory");
            asm volatile("ds_read_b64_tr_b16 %0,%1 offset:%c2" : "=&v"(hi[ks]) : "v"(vb), "i"(d0 * 4096 + ks * 1024 + 512) : "memory"); }
        asm volatile("s_waitcnt lgkmcnt(0)" ::: "memory"); SBAR();
#define PK(k) (bf16x8){lo[k][0], lo[k][1], lo[k][2], lo[k][3], hi[k][0], hi[k][1], hi[k][2], hi[k][3]}
        o[d0] = __builtin_amdgcn_mfma_f32_32x32x16_bf16(pa0, PK(0), o[d0], 0, 0, 0);
        o[d0] = __builtin_amdgcn_mfma_f32_32x32x16_bf16(pa1, PK(1), o[d0], 0, 0, 0);
        o[d0] = __builtin_amdgcn_mfma_f32_32x32x16_bf16(pa2, PK(2), o[d0], 0, 0, 0);
        o[d0] = __builtin_amdgcn_mfma_f32_32x32x16_bf16(pa3, PK(3), o[d0], 0, 0, 0);
#undef PK
    }
}

struct AU {
    const bf16* Q; const bf16* K; const bf16* V;
    bf16* O;
    int q0, NT, kbase;
    float sinkl2;
    int emode;
    float lam, oscale; const float* subw;
};

template <int MODE> __device__ __forceinline__ void amask(f32x16& p0, f32x16& p1, int t, const AU& u, int wid, int r32, int hi, const LAS float* rpb) {
    if constexpr (MODE == 2) {
        if (t >= 4) {
            const int kp0 = u.kbase + 64 * (t - 4) + 4 * hi, qpos = u.q0 + wid * QBLK + r32;
#pragma unroll
            for (int r = 0; r < 16; ++r) { const int kv = kp0 + (r & 3) + 8 * (r >> 2);
                const bool ok0 = ((unsigned)(kv - qpos + 128) <= 256u) && ((unsigned)kv < (unsigned)SEQ);
                const bool ok1 = ((unsigned)(kv + 32 - qpos + 128) <= 256u) && ((unsigned)(kv + 32) < (unsigned)SEQ);
                if (!ok0) p0[r] = -INFINITY; if (!ok1) p1[r] = -INFINITY; }
        }
    }
    if constexpr (MODE == 1) {
        if (t >= 4) {
            const int jr = (u.kbase >> 6) + (t - 4), qr = (u.q0 >> 6) + (wid >> 1), qc = 32 * (wid & 1) + r32;
            int rs = qr - 4; rs = rs < 0 ? 0 : (rs > 248 ? 248 : rs);
            int cs = qc - 8; cs = cs < 0 ? 0 : (cs > 48 ? 48 : cs);
            const bool rowok = (unsigned)(jr - rs) < 8u;
            int ro = jr - qr + 7; ro = ro < 0 ? 0 : (ro > 14 ? 14 : ro);
            const LAS float* brow = rpb + ro * 32;
#pragma unroll
            for (int r = 0; r < 16; ++r) { const int kc = 4 * hi + (r & 3) + 8 * (r >> 2);
                { int bi = kc - qc + 15; bi = bi < 0 ? 0 : (bi > 30 ? 30 : bi); const bool ok = rowok && ((unsigned)(kc - cs) < 16u); p0[r] = ok ? p0[r] + brow[bi] : -INFINITY; }
                { int bi = kc + 32 - qc + 15; bi = bi < 0 ? 0 : (bi > 30 ? 30 : bi); const bool ok = rowok && ((unsigned)(kc + 32 - cs) < 16u); p1[r] = ok ? p1[r] + brow[bi] : -INFINITY; } }
        }
    }
}

template <int MODE, int THRL, int QKH = 0, int NOMAX = 0> __device__ __forceinline__ bool attn_unit(const AU& u, char* shm, int wave) {
    const int lane = lane_now(), tid = (wave << 6) | lane, r32 = lane & 31, hi = lane >> 5; const int wid = wave;
    const bf16* Qw = u.Q + (size_t)(u.q0 + wid * QBLK) * 64;
    const bf16* Kh = u.K; const bf16* Vh = u.V;
    const unsigned lds0 = (unsigned)(uintptr_t)shm;
    LAS float* wsf = (LAS float*)((LAS char*)shm + LDS_WS) + wid * 64;
    const LAS float* rpb = (const LAS float*)((LAS char*)shm + LDS_RPB);
    const int NT = u.NT;
    volatile LAS int* okflag = (volatile LAS int*)((LAS char*)shm + LDS_RPB + 2040);
    if constexpr (NOMAX) { if (tid == 0) *okflag = 0; }
#define KROW(t) ((t) < 4 ? SEQ + 64 * (t) : (u.kbase + 64 * ((t) - 4) < 0 ? 0 : (u.kbase + 64 * ((t) - 4) > SEQ - 64 ? SEQ - 64 : u.kbase + 64 * ((t) - 4))))
    const bf16* ksrc = Kh + (size_t)lane * 64 + wid * 8;
    const bf16* vsrc = Vh + (size_t)(16 * (wid & 3) + (lane >> 2)) * 64 + (wid >> 2) * 32 + (lane & 3) * 8;
    const unsigned kdst = lds0 + LDS_K + wid * 1024, vdst = lds0 + LDS_V + wid * 1024;
#define DMA_K(t, slot) glds16(ksrc + (size_t)KROW(t) * 64, (unsigned)__builtin_amdgcn_readfirstlane(kdst + (slot)))
#define DMA_V(t, slot) glds16(vsrc + (size_t)KROW(t) * 64, (unsigned)__builtin_amdgcn_readfirstlane(vdst + (slot)))
    const int vb0 = (int)(lds0 + LDS_V) + ((lane >> 4) & 1) * 32 + (lane & 3) * 8 + (4 * hi + ((lane & 15) >> 2)) * 64;
    const char* Kbase = shm + LDS_K; bf16x8 kf[8];
    const lds_cptr shm3 = (lds_cptr)shm; const lds_cptr kp0 = shm3 + LDS_K + hi * 1024 + r32 * 16; const lds_cptr vp0 = shm3 + LDS_V + ((lane >> 4) & 1) * 32 + (lane & 3) * 8 + (4 * hi + ((lane & 15) >> 2)) * 64;
    DMA_K(0, 0); DMA_V(0, 0); DMA_K(1, SLOTB);
    bf16x8 qr[4];
#pragma unroll
    for (int d0 = 0; d0 < 4; ++d0) qr[d0] = *(const GAS bf16x8*)((const GAS char*)Qw + ((size_t)r32 * 64 + d0 * 16 + hi * 8) * 2);
    float mhat = 0.f, l_reg = 0.f; f32x16 o[2]; o[0] = f32x16{}; o[1] = f32x16{}; f32x16 negm = f32x16{}; asm volatile("" : "+v"(negm));
#define CMASK(P0, P1, t) amask<MODE>(P0, P1, (t), u, wid, r32, hi, rpb)
    bool resc = false;
#define START(P0, P1) do { const float rm = rowmax(P0, P1); resc = false; \
    { const float dl = rm; mhat = fadd_s(mhat, dl); \
      _Pragma("unroll") for (int r = 0; r < 16; ++r) { P0[r] = fsub_s(P0[r], dl); P1[r] = fsub_s(P1[r], dl); } \
      _Pragma("unroll") for (int r = 0; r < 16; ++r) negm[r] = -mhat; asm volatile("" : "+v"(negm)); } \
    _Pragma("unroll") for (int r = 0; r < 16; ++r) P0[r] = __builtin_amdgcn_exp2f(P0[r]); } while (0)
#define RESC() do { if (resc) { asm volatile("s_waitcnt lgkmcnt(0)" ::: "memory"); \
      _Pragma("unroll") for (int d_ = 0; d_ < 2; ++d_) _Pragma("unroll") for (int r = 0; r < 16; ++r) o[d_][r] *= wsf[crow(r, hi)]; } } while (0)
    f32x16 pA0, pA1, pB0, pB1;
    int sl_prev = 0, sl_cur = 0, sl_next = SLOTB;
#define ROT() do { sl_prev = sl_cur; sl_cur = sl_next; sl_next = (sl_next == (NSLOT - 1) * SLOTB) ? 0 : sl_next + SLOTB; } while (0)
    DMA_K(2, 2 * SLOTB);
    WAIT_BAR(3);
    qkt(pA0, pA1, Kbase, qr, negm, r32, hi); asm volatile("s_nop 15\n\ts_nop 7" : "+v"(pA0), "+v"(pA1));
    START(pA0, pA1);
    _Pragma("unroll") for (int r = 0; r < 16; ++r) pA1[r] = __builtin_amdgcn_exp2f(pA1[r]);
    WAIT_BAR(0);
    DMA_K(3, 0); DMA_V(1, SLOTB);
    ROT();
    kload8(kf, kp0 + sl_cur);
    WAIT_BAR(2);
    s16x4 vlo[8], vhi[8]; v4u pw0, pw1, pw2, pw3;
#define PKW(P, B) cvtpk_s(P[B], P[B + 1])
#define PAF(k) __builtin_bit_cast(bf16x8, pw##k)
#define VFR(i) (bf16x8){vlo[i][0], vlo[i][1], vlo[i][2], vlo[i][3], vhi[i][0], vhi[i][1], vhi[i][2], vhi[i][3]}
#define PIN(x) asm volatile("" : "+v"(x))
#define MX3(a, b, c) __builtin_fmaxf(__builtin_fmaxf((a), (b)), (c))
#define GAPA(MF, A0, A1, A2, A3, W0, W1, PW) do { MF; sacc += A0; sacc += A1; sacc += A2; sacc += A3; PIN(sacc); W0; W1; PIN(PW); SBAR(); } while (0)
#define EX(v) __builtin_amdgcn_exp2f(v)
#define GAPB(MF, X, B) do { MF; X[B] = EX(X[B]); X[B + 1] = EX(X[B + 1]); X[B + 2] = EX(X[B + 2]); X[B + 3] = EX(X[B + 3]); PIN(X); SBAR(); } while (0)
#define VRD(i) do { vlo[i] = vtr(vp_ + (((i) >> 2) * 4096 + ((i) & 3) * 1024)); vhi[i] = vtr(vp_ + (((i) >> 2) * 4096 + ((i) & 3) * 1024 + 512)); } while (0)
#define KRD(G, j) do { if constexpr (QKH == 0 || (QKH == 1 && (j) < 2) || (QKH == 2 && (j) >= 2)) { if (G) { kload2(kf, kp0 + sl_next, j); SBAR(); } } } while (0)
#define MF32(a, b, c) __builtin_amdgcn_mfma_f32_32x32x16_bf16(a, b, c, 0, 0, 0)
#define QLO(X) do { if constexpr (QKH != 2) { X; } } while (0)
#define QHI(X0, X2) do { if constexpr (QKH == 0) { X0; } else if constexpr (QKH == 2) { X2; } } while (0)
#define STEP(C0, C1, P0, P1, t, GK, GV, GL) do { SBAR(); \
    const lds_cptr vp_ = vp0 + sl_prev; \
    VRD(0); SBAR(); float sacc = (P0[0] + P0[1]); \
    GAPA(QLO(C0 = MF32(kf[0], qr[0], negm)), P0[2], P0[3], P0[4], P0[5],     pw0[0] = PKW(P0, 0), pw0[1] = PKW(P0, 2), pw0); \
    VRD(4); SBAR(); GAPA(QLO(C1 = MF32(kf[1], qr[0], negm)), P0[6], P0[7], P0[8], P0[9],     pw0[2] = PKW(P0, 4), pw0[3] = PKW(P0, 6), pw0); \
    VRD(1); SBAR(); GAPA(QLO(C0 = MF32(kf[2], qr[1], C0)), P0[10], P0[11], P0[12], P0[13], pw1[0] = PKW(P0, 8), pw1[1] = PKW(P0, 10), pw1); \
    VRD(5); SBAR(); GAPA(QLO(C1 = MF32(kf[3], qr[1], C1)), P0[14], P0[15], P1[0], P1[1],   pw1[2] = PKW(P0, 12), pw1[3] = PKW(P0, 14), pw1); \
    VRD(2); SBAR(); GAPA(QHI(C0 = MF32(kf[4], qr[2], C0), C0 = MF32(kf[4], qr[2], negm)), P1[2], P1[3], P1[4], P1[5],     pw2[0] = PKW(P1, 0), pw2[1] = PKW(P1, 2), pw2); \
    VRD(6); SBAR(); GAPA(QHI(C1 = MF32(kf[5], qr[2], C1), C1 = MF32(kf[5], qr[2], negm)), P1[6], P1[7], P1[8], P1[9],     pw2[2] = PKW(P1, 4), pw2[3] = PKW(P1, 6), pw2); \
    VRD(3); SBAR(); GAPA(QHI(C0 = MF32(kf[6], qr[3], C0), C0 = MF32(kf[6], qr[3], C0)), P1[10], P1[11], P1[12], P1[13], pw3[0] = PKW(P1, 8), pw3[1] = PKW(P1, 10), pw3); \
    VRD(7); SBAR(); GAPA(QHI(C1 = MF32(kf[7], qr[3], C1), C1 = MF32(kf[7], qr[3], C1)), P1[14], P1[15], 0.f, 0.f,       pw3[2] = PKW(P1, 12), pw3[3] = PKW(P1, 14), pw3); \
    l_reg += sacc; \
    if (GK) { DMA_K((t) + 3, sl_cur); } if (GV) { DMA_V((t) + 1, sl_next); } \
    CMASK(C0, C1, t); \
    if constexpr (NOMAX) { resc = false; } else { float a = MX3(C0[0], C0[1], C1[0]), b = MX3(C0[2], C0[3], C1[1]); a = MX3(a, C1[2], C1[3]); \
      _Pragma("unroll") for (int r = 4; r < 16; r += 4) { a = MX3(a, C0[r], C0[r + 1]); b = MX3(b, C0[r + 2], C0[r + 3]); a = MX3(a, C1[r], C1[r + 1]); b = MX3(b, C1[r + 2], C1[r + 3]); } \
      float rm = __builtin_fmaxf(a, b); { auto rr = __builtin_amdgcn_permlane32_swap(__float_as_uint(rm), __float_as_uint(rm), false, false); rm = __builtin_fmaxf(__uint_as_float(rr[0]), __uint_as_float(rr[1])); } \
      resc = false; \
      if (__builtin_expect(__any(rm > (float)THRL), 0)) { const float dl = __builtin_fmaxf(rm, 0.f); mhat += dl; \
        _Pragma("unroll") for (int r = 0; r < 16; ++r) { C0[r] -= dl; C1[r] -= dl; } \
        _Pragma("unroll") for (int r = 0; r < 16; ++r) negm[r] = -mhat; asm volatile("" : "+v"(negm)); \
        const float f = __builtin_amdgcn_exp2f(-dl); l_reg *= f; if (hi == 0) wsf[r32] = f; resc = true; } } \
    SBAR(); \
    GAPB(o[0] = __builtin_amdgcn_mfma_f32_32x32x16_bf16(PAF(0), VFR(0), o[0], 0, 0, 0), C0, 0); \
    GAPB(o[1] = __builtin_amdgcn_mfma_f32_32x32x16_bf16(PAF(0), VFR(4), o[1], 0, 0, 0), C0, 4); \
    KRD(GL, 0); GAPB(o[0] = __builtin_amdgcn_mfma_f32_32x32x16_bf16(PAF(1), VFR(1), o[0], 0, 0, 0), C0, 8); \
    KRD(GL, 1); GAPB(o[1] = __builtin_amdgcn_mfma_f32_32x32x16_bf16(PAF(1), VFR(5), o[1], 0, 0, 0), C0, 12); \
    KRD(GL, 2); GAPB(o[0] = __builtin_amdgcn_mfma_f32_32x32x16_bf16(PAF(2), VFR(2), o[0], 0, 0, 0), C1, 0); \
    KRD(GL, 3); GAPB(o[1] = __builtin_amdgcn_mfma_f32_32x32x16_bf16(PAF(2), VFR(6), o[1], 0, 0, 0), C1, 4); \
    GAPB(o[0] = __builtin_amdgcn_mfma_f32_32x32x16_bf16(PAF(3), VFR(3), o[0], 0, 0, 0), C1, 8); \
    GAPB(o[1] = __builtin_amdgcn_mfma_f32_32x32x16_bf16(PAF(3), VFR(7), o[1], 0, 0, 0), C1, 12); \
    } while (0)
    int t = 1;
    for (; t + 5 < NT; t += 2) {
        STEP(pB0, pB1, pA0, pA1, t, true, true, true);     WAIT_BAR(2); RESC(); ROT();
        STEP(pA0, pA1, pB0, pB1, t + 1, true, true, true);   WAIT_BAR(2); RESC(); ROT();
    }
#define ENDW(tt) do { if ((tt) + 3 < NT) { WAIT_BAR(2); } else if ((tt) + 2 < NT) { WAIT_BAR(1); } else { WAIT_BAR(0); } } while (0)
    for (; t + 1 < NT; t += 2) {
        STEP(pB0, pB1, pA0, pA1, t, (t + 3 < NT), (t + 1 < NT), (t + 1 < NT));       ENDW(t);   RESC(); ROT();
        STEP(pA0, pA1, pB0, pB1, t + 1, (t + 4 < NT), (t + 2 < NT), (t + 2 < NT));     ENDW(t + 1); RESC(); ROT();
    }
    STEP(pB0, pB1, pA0, pA1, NT - 1, false, false, false); RESC();
    { float sacc = pB0[0] + pB0[1]; _Pragma("unroll") for (int r = 2; r < 16; ++r) sacc += pB0[r]; _Pragma("unroll") for (int r = 0; r < 16; ++r) sacc += pB1[r]; l_reg += sacc;
      pw0 = (v4u){PKW(pB0, 0), PKW(pB0, 2), PKW(pB0, 4), PKW(pB0, 6)}; pw1 = (v4u){PKW(pB0, 8), PKW(pB0, 10), PKW(pB0, 12), PKW(pB0, 14)}; pw2 = (v4u){PKW(pB1, 0), PKW(pB1, 2), PKW(pB1, 4), PKW(pB1, 6)}; pw3 = (v4u){PKW(pB1, 8), PKW(pB1, 10), PKW(pB1, 12), PKW(pB1, 14)};
      SBAR(); pv(o, vb0 + sl_cur, PAF(0), PAF(1), PAF(2), PAF(3)); }
#undef PKW
#undef PAF
#undef VFR
#undef PIN
#undef MX3
#undef GAPA
#undef GAPB
#undef EX
#undef VRD
#undef KRD
#undef MF32
#undef QLO
#undef QHI
#undef STEP
#undef ENDW
    { auto rr = __builtin_amdgcn_permlane32_swap(__float_as_uint(l_reg), __float_as_uint(l_reg), false, false); l_reg = __uint_as_float(rr[0]) + __uint_as_float(rr[1]); }
    if constexpr (NOMAX) {
        const bool ok = (l_reg > 0x1p-90f) && (l_reg < 0x1p90f);
        if (__any(!ok)) { if (lane == 0) *okflag = 1; }
        asm volatile("s_waitcnt lgkmcnt(0)\n\ts_barrier" ::: "memory");
        const int bad = __builtin_amdgcn_readfirstlane(*okflag);
        if (bad) { asm volatile("s_waitcnt lgkmcnt(0)\n\ts_barrier" ::: "memory"); return false; }
    }
    l_reg += __builtin_amdgcn_exp2f(u.sinkl2 - mhat);
    if (hi == 0) wsf[32 + r32] = l_reg; asm volatile("s_waitcnt lgkmcnt(0)" ::: "memory");
    float rli[16];
#pragma unroll
    for (int r = 0; r < 16; ++r) rli[r] = __builtin_amdgcn_rcpf(wsf[32 + crow(r, hi)]);
    if (u.emode == 0) {
        bf16* Ow = u.O + (size_t)(u.q0 + wid * QBLK) * 1024;
        LAS unsigned short* stg = (LAS unsigned short*)((LAS char*)shm + LDS_OST + wid * 8192);
#pragma unroll
        for (int r = 0; r < 16; ++r) { const int orow = crow(r, hi);
#pragma unroll
            for (int d0 = 0; d0 < 2; ++d0) stg[orow * 64 + d0 * 32 + r32] = (unsigned short)f2bf(o[d0][r] * rli[r]); }
        asm volatile("s_waitcnt lgkmcnt(0)" ::: "memory");
#pragma unroll
        for (int i = 0; i < 4; ++i) { const int row = i * 8 + (lane >> 3), ch = lane & 7; const v4u v = *(const LAS v4u*)(stg + row * 64 + ch * 8); *(GAS v4u*)((GAS char*)Ow + ((size_t)row * 1024 + ch * 8) * 2) = v; }
    } else {
        LAS float* stf = (LAS float*)((LAS char*)shm + LDS_OST + wid * 8192);
        if (u.emode == 1) {
#pragma unroll
            for (int r = 0; r < 16; ++r) { const int orow = crow(r, hi);
#pragma unroll
                for (int d0 = 0; d0 < 2; ++d0) stf[orow * 64 + d0 * 32 + r32] = o[d0][r] * rli[r]; }
        } else {
#pragma unroll
            for (int r = 0; r < 16; ++r) { const int orow = crow(r, hi);
#pragma unroll
                for (int d0 = 0; d0 < 2; ++d0) { const float y = stf[orow * 64 + d0 * 32 + r32] - u.lam * (o[d0][r] * rli[r]); stf[orow * 64 + d0 * 32 + r32] = y; } }
            asm volatile("s_waitcnt lgkmcnt(0)" ::: "memory");
            bf16* Ow = u.O + (size_t)(u.q0 + wid * QBLK) * 1024;
#pragma unroll
            for (int i = 0; i < 4; ++i) { const int row = i * 8 + (lane >> 3), ch = lane & 7;
                const f32x4 y0 = *(const LAS f32x4*)(stf + row * 64 + ch * 8), y1 = *(const LAS f32x4*)(stf + row * 64 + ch * 8 + 4);
                float ss = (y0[0] * y0[0] + y0[1] * y0[1]) + (y0[2] * y0[2] + y0[3] * y0[3]) + (y1[0] * y1[0] + y1[1] * y1[1]) + (y1[2] * y1[2] + y1[3] * y1[3]);
                ss += xorf<1>(ss); ss += xorf<2>(ss); ss += xorf<4>(ss);
                const float ri = __builtin_amdgcn_rsqf(ss * (1.f / 64.f) + EPS) * u.oscale;
                const f32x4 w0 = *(const GAS f32x4*)(u.subw + ch * 8), w1 = *(const GAS f32x4*)(u.subw + ch * 8 + 4);
                v4u v; v.x = pk2(y0[0] * ri * w0[0], y0[1] * ri * w0[1]); v.y = pk2(y0[2] * ri * w0[2], y0[3] * ri * w0[3]); v.z = pk2(y1[0] * ri * w1[0], y1[1] * ri * w1[1]); v.w = pk2(y1[2] * ri * w1[2], y1[3] * ri * w1[3]);
                *(GAS v4u*)((GAS char*)Ow + ((size_t)row * 1024 + ch * 8) * 2) = v; }
        }
    }
    asm volatile("s_waitcnt lgkmcnt(0)\n\ts_barrier" ::: "memory");
    return true;
#undef DMA_K
#undef DMA_V
#undef KROW
#undef CMASK
#undef START
#undef RESC
#undef ROT
}

template <int MODE, int NOMAX = 0> __device__ __forceinline__ bool attn_simple(const AU& u, char* shm, int wave) {
    const int lane = lane_now(), tid = (wave << 6) | lane, r32 = lane & 31, hi = lane >> 5; const int wid = wave;
    const bf16* Qw = u.Q + (size_t)(u.q0 + wid * QBLK) * 64;
    const unsigned lds0 = (unsigned)(uintptr_t)shm;
    LAS float* wsf = (LAS float*)((LAS char*)shm + LDS_WS) + wid * 64;
    const LAS float* rpb = (const LAS float*)((LAS char*)shm + LDS_RPB);
    const int NT = u.NT;
    volatile LAS int* okflag = (volatile LAS int*)((LAS char*)shm + LDS_RPB + 2040);
    if constexpr (NOMAX) { if (tid == 0) *okflag = 0; }
#define KROW(t) ((t) < 4 ? SEQ + 64 * (t) : (u.kbase + 64 * ((t) - 4) < 0 ? 0 : (u.kbase + 64 * ((t) - 4) > SEQ - 64 ? SEQ - 64 : u.kbase + 64 * ((t) - 4))))
    const bf16* ksrc = u.K + (size_t)lane * 64 + wid * 8;
    const bf16* vsrc = u.V + (size_t)(16 * (wid & 3) + (lane >> 2)) * 64 + (wid >> 2) * 32 + (lane & 3) * 8;
    const unsigned kdst = lds0 + LDS_K + wid * 1024, vdst = lds0 + LDS_V + wid * 1024;
    const int vb0 = (int)(lds0 + LDS_V) + ((lane >> 4) & 1) * 32 + (lane & 3) * 8 + (4 * hi + ((lane & 15) >> 2)) * 64;
    { const int kr = KROW(0); glds16(ksrc + (size_t)kr * 64, (unsigned)__builtin_amdgcn_readfirstlane(kdst)); glds16(vsrc + (size_t)kr * 64, (unsigned)__builtin_amdgcn_readfirstlane(vdst)); }
    bf16x8 qr[4];
#pragma unroll
    for (int d0 = 0; d0 < 4; ++d0) qr[d0] = *(const GAS bf16x8*)((const GAS char*)Qw + ((size_t)r32 * 64 + d0 * 16 + hi * 8) * 2);
    float m_run = -INFINITY, l_reg = 0.f; f32x16 o[2]; o[0] = f32x16{}; o[1] = f32x16{};
    const f32x16 zero = f32x16{};
#pragma unroll 1
    for (int t = 0; t < NT; ++t) {
        const int sl = (t & 1) * SLOTB;
        asm volatile("s_waitcnt vmcnt(0) lgkmcnt(0)\n\ts_barrier" ::: "memory");
        if (t + 1 < NT) { const int kr = KROW(t + 1); const int sn = ((t + 1) & 1) * SLOTB;
            glds16(ksrc + (size_t)kr * 64, (unsigned)__builtin_amdgcn_readfirstlane(kdst + sn)); glds16(vsrc + (size_t)kr * 64, (unsigned)__builtin_amdgcn_readfirstlane(vdst + sn)); }
        bool live = true;
        if (t >= 4) {
            if constexpr (MODE == 1) { const int jr = (u.kbase >> 6) + (t - 4), qr_ = (u.q0 >> 6) + (wid >> 1); int rs = qr_ - 4; rs = rs < 0 ? 0 : (rs > 248 ? 248 : rs); live = (unsigned)(jr - rs) < 8u; }
            if constexpr (MODE == 2) { const int k0 = u.kbase + 64 * (t - 4), qa = u.q0 + wid * QBLK; live = (k0 + 63 >= qa - 128) && (k0 <= qa + QBLK - 1 + 128); }
        }
        if (!live) continue;
        f32x16 p0, p1;
        qkt(p0, p1, shm + LDS_K + sl, qr, zero, r32, hi);
        amask<MODE>(p0, p1, t, u, wid, r32, hi, rpb);
        if (NOMAX && t > 0) {
            float sacc = 0.f;
#pragma unroll
            for (int r = 0; r < 16; ++r) { p0[r] = __builtin_amdgcn_exp2f(p0[r] - m_run); p1[r] = __builtin_amdgcn_exp2f(p1[r] - m_run); sacc += p0[r] + p1[r]; }
            l_reg += sacc;
        } else {
        float rm = p0[0];
#pragma unroll
        for (int r = 1; r < 16; ++r) rm = __builtin_fmaxf(rm, p0[r]);
#pragma unroll
        for (int r = 0; r < 16; ++r) rm = __builtin_fmaxf(rm, p1[r]);
        { auto rr = __builtin_amdgcn_permlane32_swap(__float_as_uint(rm), __float_as_uint(rm), false, false); rm = __builtin_fmaxf(__uint_as_float(rr[0]), __uint_as_float(rr[1])); }
        const float m_new = __builtin_fmaxf(m_run, rm);
        const float alpha = __builtin_amdgcn_exp2f(m_run - m_new); m_run = m_new;
        float sacc = 0.f;
#pragma unroll
        for (int r = 0; r < 16; ++r) { p0[r] = __builtin_amdgcn_exp2f(p0[r] - m_new); p1[r] = __builtin_amdgcn_exp2f(p1[r] - m_new); sacc += p0[r] + p1[r]; }
        l_reg = l_reg * alpha + sacc;
        if (hi == 0) wsf[r32] = alpha;
        asm volatile("s_waitcnt lgkmcnt(0)" ::: "memory");
#pragma unroll
        for (int d_ = 0; d_ < 2; ++d_)
#pragma unroll
            for (int r = 0; r < 16; ++r) o[d_][r] *= wsf[crow(r, hi)];
        }
        v4u pw0, pw1, pw2, pw3;
        pw0 = (v4u){cvtpk_s(p0[0], p0[1]), cvtpk_s(p0[2], p0[3]), cvtpk_s(p0[4], p0[5]), cvtpk_s(p0[6], p0[7])}; pw1 = (v4u){cvtpk_s(p0[8], p0[9]), cvtpk_s(p0[10], p0[11]), cvtpk_s(p0[12], p0[13]), cvtpk_s(p0[14], p0[15])};
        pw2 = (v4u){cvtpk_s(p1[0], p1[1]), cvtpk_s(p1[2], p1[3]), cvtpk_s(p1[4], p1[5]), cvtpk_s(p1[6], p1[7])}; pw3 = (v4u){cvtpk_s(p1[8], p1[9]), cvtpk_s(p1[10], p1[11]), cvtpk_s(p1[12], p1[13]), cvtpk_s(p1[14], p1[15])};
        asm volatile("s_waitcnt lgkmcnt(0)" ::: "memory"); SBAR();
        pv(o, vb0 + sl, __builtin_bit_cast(bf16x8, pw0), __builtin_bit_cast(bf16x8, pw1), __builtin_bit_cast(bf16x8, pw2), __builtin_bit_cast(bf16x8, pw3));
    }
    { auto rr = __builtin_amdgcn_permlane32_swap(__float_as_uint(l_reg), __float_as_uint(l_reg), false, false); l_reg = __uint_as_float(rr[0]) + __uint_as_float(rr[1]); }
    if constexpr (NOMAX) {
        const bool ok = (l_reg > 0x1p-90f) && (l_reg < 0x1p90f);
        if (__any(!ok)) { if (lane == 0) *okflag = 1; }
        asm volatile("s_waitcnt vmcnt(0) lgkmcnt(0)\n\ts_barrier" ::: "memory");
        const int bad = __builtin_amdgcn_readfirstlane(*okflag);
        if (bad) { asm volatile("s_waitcnt lgkmcnt(0)\n\ts_barrier" ::: "memory"); return false; }
    }
    l_reg += __builtin_amdgcn_exp2f(u.sinkl2 - m_run);
    asm volatile("s_waitcnt lgkmcnt(0)" ::: "memory");
    if (hi == 0) wsf[32 + r32] = l_reg; asm volatile("s_waitcnt lgkmcnt(0)" ::: "memory");
    float rli[16];
#pragma unroll
    for (int r = 0; r < 16; ++r) rli[r] = __builtin_amdgcn_rcpf(wsf[32 + crow(r, hi)]);
    {
        bf16* Ow = u.O + (size_t)(u.q0 + wid * QBLK) * 1024;
        LAS unsigned short* stg = (LAS unsigned short*)((LAS char*)shm + LDS_OST + wid * 8192);
#pragma unroll
        for (int r = 0; r < 16; ++r) { const int orow = crow(r, hi);
#pragma unroll
            for (int d0 = 0; d0 < 2; ++d0) stg[orow * 64 + d0 * 32 + r32] = (unsigned short)f2bf(o[d0][r] * rli[r]); }
        asm volatile("s_waitcnt lgkmcnt(0)" ::: "memory");
#pragma unroll
        for (int i = 0; i < 4; ++i) { const int row = i * 8 + (lane >> 3), ch = lane & 7; const v4u v = *(const LAS v4u*)(stg + row * 64 + ch * 8); *(GAS v4u*)((GAS char*)Ow + ((size_t)row * 1024 + ch * 8) * 2) = v; }
    }
    asm volatile("s_waitcnt vmcnt(0) lgkmcnt(0)\n\ts_barrier" ::: "memory");
    return true;
#undef KROW
}
#undef SBAR
#undef WAIT_BAR
}
struct Args { const float* in[23]; float* out; unsigned char* ws; int flags; int pad; };
enum { I_X = 0, I_C, I_CTX, I_CCTX, I_N1W, I_N2W, I_ADAW, I_ADAB, I_WIN, I_RPB, I_DLAM, I_SUBW, I_SINK, I_QKNW, I_WBR, I_WGATE, I_BGATE, I_WOUT, I_PWQ, I_PKEYS, I_PU, I_PV, I_FNW };

struct Frame {
    LAS unsigned char* lds; volatile LAS unsigned* MISC; gu32* ctl;
    int wave, vcu, G;
};
__device__ __forceinline__ int ltid(int wave) { return tid_now(wave); }

struct MapId   { __device__ __forceinline__ int operator()(int n) const { return n; } };
struct MapWin  { __device__ __forceinline__ int operator()(int n) const { return (n & ~255) + 128 * ((n >> 5) & 1) + 32 * ((n >> 6) & 3) + (n & 31); } };
struct MapGate { __device__ __forceinline__ int operator()(int n) const { const int br = n >> 10, ch = n & 1023; return 256 * (ch >> 6) + 128 * (br >> 1) + 32 * ((ch >> 4) & 3) + 16 * (br & 1) + (ch & 15); } };
template <class Map, bool F8 = false> __device__ __forceinline__ void transpose_item(const float* W, int K, int N, void* WTv, Map mp, LAS float* scr, int item, int lane) {
    bf16_t* WT = (bf16_t*)WTv; unsigned char* WT8 = (unsigned char*)WTv;
    const int nblk = N / 32, kb = item / nblk, nb = item % nblk, k0 = 64 * kb, n0 = 32 * nb;
#pragma unroll 8
    for (int i = 0; i < 32; ++i) { const int kk = 2 * i + (lane >> 5); scr[kk * 33 + (lane & 31)] = W[(size_t)(k0 + kk) * N + n0 + (lane & 31)]; }
    LDS_WAIT(); asm volatile("" ::: "memory");
    const int c = lane & 7;
#pragma unroll
    for (int j = 0; j < 4; ++j) { const int n = (lane >> 3) + 8 * j; const LAS float* s = scr + (8 * c) * 33 + n;
        int nn = n0 + n; asm volatile("" : "+v"(nn));
        if constexpr (F8) { v2u o; o.x = pk4_fp8(s[0 * 33] * 64.f, s[1 * 33] * 64.f, s[2 * 33] * 64.f, s[3 * 33] * 64.f); o.y = pk4_fp8(s[4 * 33] * 64.f, s[5 * 33] * 64.f, s[6 * 33] * 64.f, s[7 * 33] * 64.f);
            *(GAS v2u*)(WT8 + (size_t)mp(nn) * K + k0 + 8 * c) = o; }
        else { v4u o; o.x = pk2(s[0 * 33], s[1 * 33]); o.y = pk2(s[2 * 33], s[3 * 33]); o.z = pk2(s[4 * 33], s[5 * 33]); o.w = pk2(s[6 * 33], s[7 * 33]);
            *(GAS v4u*)(WT + (size_t)mp(nn) * K + k0 + 8 * c) = o; } }
    LDS_WAIT(); asm volatile("" ::: "memory");
}
__device__ __forceinline__ void modnorm_row(const float* xrow, bf16_t* orow, const float* nw, const float* sh, const float* sc, int lane, unsigned char* o8row = nullptr) {
    const GAS f32x4* xr = (const GAS f32x4*)xrow + lane;
    f32x4 v[4]; float s = 0.f;
#pragma unroll
    for (int j = 0; j < 4; ++j) { v[j] = xr[64 * j]; s += (v[j].x * v[j].x + v[j].y * v[j].y) + (v[j].z * v[j].z + v[j].w * v[j].w); }
    const float ri = __builtin_amdgcn_rsqf(wave_sum(s) * (1.f / DM) + EPS);
    GAS v2u* o8 = (GAS v2u*)orow + lane;
#pragma unroll
    for (int j = 0; j < 4; ++j) { const int col = 256 * j + 4 * lane; const f32x4 w = *(const f32x4*)(nw + col), a = *(const f32x4*)(sc + col), b = *(const f32x4*)(sh + col);
        const f32x4 y = (v[j] * ri * w) * (1.0f + a) + b;
        if (orow) { v2u p; p.x = pk2(y.x, y.y); p.y = pk2(y.z, y.w); o8[64 * j] = p; }
        if (o8row) ((GAS unsigned*)o8row)[64 * j + lane] = pk4_fp8(y.x, y.y, y.z, y.w); }
}

__device__ __forceinline__ void ce_desc(float& a, float& b) { const float hi = __builtin_fmaxf(a, b), lo = __builtin_fminf(a, b); a = hi; b = lo; }
__device__ __forceinline__ void sort16_desc(float (&x)[16]) {
#pragma unroll
    for (int k = 2; k <= 16; k <<= 1)
#pragma unroll
        for (int j = k >> 1; j > 0; j >>= 1)
#pragma unroll
            for (int i = 0; i < 16; ++i) { const int l = i ^ j; if (l > i) { if ((i & k) == 0) ce_desc(x[i], x[l]); else ce_desc(x[l], x[i]); } }
}
__device__ __forceinline__ void merge16_desc(float (&top)[16], const float (&c)[16]) {
#pragma unroll
    for (int i = 0; i < 16; ++i) top[i] = __builtin_fmaxf(top[i], c[15 - i]);
#pragma unroll
    for (int j = 8; j > 0; j >>= 1)
#pragma unroll
        for (int i = 0; i < 16; ++i) { const int l = i ^ j; if (l > i) ce_desc(top[i], top[l]); }
}

struct PeerArgs { unsigned char* H8out_xq; unsigned char* H8out; const float* S; const bf16_t* Hin; const unsigned char* U; const unsigned char* V; const float* SU; const float* SV; const float* Xin; float* Xout;
                  const float* g2l; const float* g2c;
                  bf16_t* Hout; const float* nwn; const float* shl; const float* scl; const float* shc; const float* scc;
                  float* fout; const float* fnw;
                  int nblocks; int* dbg_eid; float* dbg_gt; bool dry; int route_reps; const float* SXG; };
struct PeerBufs;
constexpr int PL_LISTS = 0, PL_EID = 40960, PL_GT = PL_EID + 16384;
__device__ __forceinline__ float dot2bf(unsigned a, unsigned b, float acc) { return __builtin_amdgcn_fdot2_f32_bf16(__builtin_bit_cast(bf16x2_t, a), __builtin_bit_cast(bf16x2_t, b), acc, false); }
__device__ __forceinline__ float dot8(const v4u a, const v4u b, float acc) {
    const unsigned a0 = a.x, a1 = a.y, a2 = a.z, a3 = a.w, b0 = b.x, b1 = b.y, b2 = b.z, b3 = b.w;
    acc = dot2bf(a0, b0, acc); acc = dot2bf(a1, b1, acc); acc = dot2bf(a2, b2, acc); acc = dot2bf(a3, b3, acc);
    return acc;
}
struct PeerBufs { int* eid; float* gt; float* a; unsigned char* xq; float* sx; };
__device__ __forceinline__ void peer_route(Frame& F, const PeerArgs& P, const PeerBufs& B) {
    const int tid = ltid(F.wave), lane = tid & 63;
    LAS unsigned* lists = (LAS unsigned*)(F.lds + PL_LISTS);
    LAS int* eid = (LAS int*)(F.lds + PL_EID);
    LAS float* gt = (LAS float*)(F.lds + PL_GT);
    for (int blk = F.vcu; blk < P.nblocks; blk += F.G) {
        const int row0 = blk * 32;
        {
            const int tok = tid >> 4, lst = tid & 15;
            const float* sp = P.S + (size_t)(row0 + tok) * 2048 + lst * 128;
            float top[16];
#pragma unroll 1
            for (int c = 0; c < 8; ++c) {
                float x[16];
#pragma unroll
                for (int q = 0; q < 4; ++q) { const f32x4 v = *(const f32x4*)(sp + c * 16 + q * 4);
#pragma unroll
                    for (int j = 0; j < 4; ++j) x[q * 4 + j] = __uint_as_float((__float_as_uint(v[j]) & ~127u) | (unsigned)(c * 16 + q * 4 + j)); }
                sort16_desc(x);
                if (c == 0) {
#pragma unroll
                    for (int i = 0; i < 16; ++i) top[i] = x[i];
                } else merge16_desc(top, x);
            }
            LAS unsigned* lp = lists + tid * 20;
#pragma unroll
            for (int q = 0; q < 4; ++q) *(LAS v4u*)(lp + q * 4) = (v4u){__float_as_uint(top[q * 4]), __float_as_uint(top[q * 4 + 1]), __float_as_uint(top[q * 4 + 2]), __float_as_uint(top[q * 4 + 3])};
        }
        __syncthreads();
        if (tid < 256) {
            const int tok = tid >> 3, hd = tid & 7;
            const LAS unsigned* la = lists + (tok * 16 + 2 * hd) * 20; const LAS unsigned* lb = la + 20;
            float av[16], bv[16];
#pragma unroll
            for (int q = 0; q < 4; ++q) { const v4u a = *(const LAS v4u*)(la + q * 4), b = *(const LAS v4u*)(lb + q * 4);
#pragma unroll
                for (int j = 0; j < 4; ++j) { av[q * 4 + j] = __uint_as_float(a[j] & ~127u); bv[q * 4 + j] = __uint_as_float(b[j] & ~127u); } }
            float c0[16], c1[16], c2[16], c3[16];
#pragma unroll
            for (int i = 0; i < 16; ++i) { c0[i] = -INFINITY; c1[i] = -INFINITY; c2[i] = -INFINITY; c3[i] = -INFINITY; }
            {
                int cnt = 0;
#pragma unroll
                for (int i = 0; i < 16; ++i)
#pragma unroll
                    for (int j = 0; j < 16; ++j) if ((i + 1) * (j + 1) <= 16) {
                        const float sm = __uint_as_float((__float_as_uint(av[i] + bv[j]) & ~255u) | (unsigned)(i * 16 + j));
                        const int slot = cnt & 15, arr = cnt >> 4;
                        if (arr == 0) c0[slot] = sm; else if (arr == 1) c1[slot] = sm; else if (arr == 2) c2[slot] = sm; else c3[slot] = sm;
                        ++cnt;
                    }
            }
            sort16_desc(c0); sort16_desc(c1); sort16_desc(c2); sort16_desc(c3);
            merge16_desc(c0, c1); merge16_desc(c0, c2); merge16_desc(c0, c3);
            float ev[16], sum = 0.f; const float m0 = __uint_as_float(__float_as_uint(c0[0]) & ~255u);
#pragma unroll
            for (int k = 0; k < 16; ++k) { ev[k] = fast_exp2((__uint_as_float(__float_as_uint(c0[k]) & ~255u) - m0) * LOG2E); sum += ev[k]; }
            const float rs = 1.0f / sum;
#pragma unroll
            for (int k = 0; k < 16; ++k) { const unsigned code = __float_as_uint(c0[k]) & 255u;
                const int ia = (int)(la[code >> 4] & 127u), ib = (int)(lb[code & 15u] & 127u);
                eid[tok * 128 + hd * 16 + k] = ia * NKEYS + ib; gt[tok * 128 + hd * 16 + k] = ev[k] * rs; }
        }
        __syncthreads();
#pragma unroll
        for (int i = 0; i < 8; ++i) { const int idx = i * NTHREADS + tid; B.eid[(size_t)row0 * 128 + idx] = eid[idx]; B.gt[(size_t)row0 * 128 + idx] = gt[idx]; }
#pragma unroll 1
        for (int tk = 0; tk < 4; ++tk) {
            const size_t row = (size_t)(row0 + F.wave * 4 + tk);
            const bf16_t* hp = P.Hin + row * DM + 16 * lane;
            const v4u h0 = *(const v4u*)hp, h1 = *(const v4u*)(hp + 8);
            float xf[16];
#pragma unroll
            for (int q = 0; q < 4; ++q) { xf[2 * q] = bflo(h0[q]); xf[2 * q + 1] = bfhi(h0[q]); xf[8 + 2 * q] = bflo(h1[q]); xf[8 + 2 * q + 1] = bfhi(h1[q]); }
            float am = 0.f;
#pragma unroll
            for (int i = 0; i < 16; ++i) am = __builtin_fmaxf(am, __builtin_fabsf(xf[i]));
            am = wave_max(am);
            const float ix = am > 0.f ? 127.f / am : 0.f;
            v4u xq;
#pragma unroll
            for (int q = 0; q < 4; ++q) { unsigned w = 0;
#pragma unroll
                for (int j = 0; j < 4; ++j) { const int v = (int)__builtin_rintf(xf[4 * q + j] * ix); w |= (unsigned)(v & 0xff) << (8 * j); }
                xq[q] = w; }
            *(v4u*)(B.xq + row * DM + 16 * lane) = xq;
            if (lane == 0) B.sx[row] = am * (1.f / 127.f);
        }
        __syncthreads();
    }
}
__device__ __forceinline__ int wave_isum(int v) {
    v += __builtin_amdgcn_update_dpp(0, v, 0xB1, 0xf, 0xf, false);
    v += __builtin_amdgcn_update_dpp(0, v, 0x4E, 0xf, 0xf, false);
    v += __builtin_amdgcn_update_dpp(0, v, 0x141, 0xf, 0xf, false);
    v += __builtin_amdgcn_update_dpp(0, v, 0x140, 0xf, 0xf, false);
    v += __builtin_amdgcn_update_dpp(0, v, 0x142, 0xa, 0xf, false);
    v += __builtin_amdgcn_update_dpp(0, v, 0x143, 0xc, 0xf, false);
    return __builtin_amdgcn_readlane(v, 63);
}
__device__ __forceinline__ int bperm_i(int v, int srclane) { return __builtin_amdgcn_ds_bpermute(srclane << 2, v); }
__device__ __forceinline__ float bperm_f(float v, int srclane) { return __builtin_bit_cast(float, __builtin_amdgcn_ds_bpermute(srclane << 2, __builtin_bit_cast(int, v))); }
__device__ __forceinline__ int treduce16(const int (&d)[16], int lane) {
    int s8[8], s4[4], s2[2];
#pragma unroll
    for (int i = 0; i < 8; ++i) { auto r = __builtin_amdgcn_permlane32_swap((unsigned)d[i], (unsigned)d[i + 8], false, false); s8[i] = (int)r[0] + (int)r[1]; }
#pragma unroll
    for (int i = 0; i < 4; ++i) { auto r = __builtin_amdgcn_permlane16_swap((unsigned)s8[i], (unsigned)s8[i + 4], false, false); s4[i] = (int)r[0] + (int)r[1]; }
    const bool b3 = (lane & 8) != 0, b2 = (lane & 4) != 0;
#pragma unroll
    for (int i = 0; i < 2; ++i) { const int keep = b3 ? s4[i + 2] : s4[i], send = b3 ? s4[i] : s4[i + 2]; s2[i] = keep + __builtin_amdgcn_update_dpp(0, send, 0x128, 0xf, 0xf, false); }
    int z; { const int keep = b2 ? s2[1] : s2[0], send = b2 ? s2[0] : s2[1]; z = keep + __builtin_amdgcn_ds_swizzle(send, 0x101F); }
    z += __builtin_amdgcn_update_dpp(0, z, 0x4E, 0xf, 0xf, false);
    z += __builtin_amdgcn_update_dpp(0, z, 0xB1, 0xf, 0xf, false);
    return z;
}
__device__ __forceinline__ void peer_u(Frame& F, const PeerArgs& P, const PeerBufs& B, int ntok) {
    const int lane = ltid(F.wave) & 63;
    const int nsl = 8, wps = (F.G / nsl) * NWAVES;
    const int j = F.vcu / (F.G / nsl), wsl = (F.vcu % (F.G / nsl)) * NWAVES + F.wave;
    const int esel = (lane >> 2) & 15;
    int t = wsl; if (t >= ntok) return;
    int e_lo = B.eid[(size_t)t * 128 + lane], e_hi = B.eid[(size_t)t * 128 + 64 + lane];
    float g_lo = B.gt[(size_t)t * 128 + lane], g_hi = B.gt[(size_t)t * 128 + 64 + lane];
    v4u xq = *(const v4u*)(B.xq + (size_t)t * DM + 16 * lane); float sx = B.sx[t];
    for (;;) {
        const int tn = t + wps; const bool more = tn < ntok; const int tp = more ? tn : t;
        const int ne_lo = B.eid[(size_t)tp * 128 + lane], ne_hi = B.eid[(size_t)tp * 128 + 64 + lane];
        const float ng_lo = B.gt[(size_t)tp * 128 + lane], ng_hi = B.gt[(size_t)tp * 128 + 64 + lane];
        const v4u nxq = *(const v4u*)(B.xq + (size_t)tp * DM + 16 * lane); const float nsx = B.sx[tp];
        unsigned long long m_lo = __ballot((e_lo >> 11) == j), m_hi = __ballot((e_hi >> 11) == j);
        const int n = __popcll(m_lo) + __popcll(m_hi);
        v4u ua[32]; int slotv0 = -1, idv0 = 0, slotv1 = -1, idv1 = 0;
#pragma unroll
        for (int q = 0; q < 32; ++q) {
            ua[q] = (v4u){0u, 0u, 0u, 0u};
            if (q < n) {
                int k, id;
                if (m_lo) { k = __builtin_ctzll(m_lo); m_lo &= m_lo - 1; id = __builtin_amdgcn_readlane(e_lo, k); }
                else { k = __builtin_ctzll(m_hi); m_hi &= m_hi - 1; id = __builtin_amdgcn_readlane(e_hi, k); k += 64; }
                ua[q] = *(const v4u*)(P.U + (size_t)id * DM + 16 * lane);
                if (q < 16) { if (esel == q) { slotv0 = k; idv0 = id; } } else { if (esel == q - 16) { slotv1 = k; idv1 = id; } }
            }
        }
        const float su0 = P.SU[idv0], sv0 = P.SV[idv0], su1 = P.SU[idv1], sv1 = P.SV[idv1];
        const float gl0 = bperm_f(g_lo, slotv0 & 63), gh0 = bperm_f(g_hi, slotv0 & 63), gl1 = bperm_f(g_lo, slotv1 & 63), gh1 = bperm_f(g_hi, slotv1 & 63);
        const float gg0 = slotv0 < 64 ? gl0 : gh0, gg1 = slotv1 < 64 ? gl1 : gh1;
        int d[16];
#pragma unroll
        for (int q = 0; q < 16; ++q) { int di = __builtin_amdgcn_sdot4((int)ua[q][0], (int)xq[0], 0, false); di = __builtin_amdgcn_sdot4((int)ua[q][1], (int)xq[1], di, false);
            di = __builtin_amdgcn_sdot4((int)ua[q][2], (int)xq[2], di, false); d[q] = __builtin_amdgcn_sdot4((int)ua[q][3], (int)xq[3], di, false); }
        { const int z = treduce16(d, lane);
          if (slotv0 >= 0 && (lane & 3) == 0) B.a[(size_t)t * 128 + slotv0] = gg0 * gelu_tanh((float)z * su0 * sx) * sv0; }
        if (n > 16) {
#pragma unroll
            for (int q = 0; q < 16; ++q) { int di = __builtin_amdgcn_sdot4((int)ua[16 + q][0], (int)xq[0], 0, false); di = __builtin_amdgcn_sdot4((int)ua[16 + q][1], (int)xq[1], di, false);
                di = __builtin_amdgcn_sdot4((int)ua[16 + q][2], (int)xq[2], di, false); d[q] = __builtin_amdgcn_sdot4((int)ua[16 + q][3], (int)xq[3], di, false); }
            const int z = treduce16(d, lane);
            if (slotv1 >= 0 && (lane & 3) == 0) B.a[(size_t)t * 128 + slotv1] = gg1 * gelu_tanh((float)z * su1 * sx) * sv1;
        }
        if (n > 32) {
            while (m_lo | m_hi) { int k, id;
                if (m_lo) { k = __builtin_ctzll(m_lo); m_lo &= m_lo - 1; id = __builtin_amdgcn_readlane(e_lo, k); }
                else { k = __builtin_ctzll(m_hi); m_hi &= m_hi - 1; id = __builtin_amdgcn_readlane(e_hi, k); k += 64; }
                const v4u u1 = *(const v4u*)(P.U + (size_t)id * DM + 16 * lane);
                int di = __builtin_amdgcn_sdot4((int)u1[0], (int)xq[0], 0, false); di = __builtin_amdgcn_sdot4((int)u1[1], (int)xq[1], di, false);
                di = __builtin_amdgcn_sdot4((int)u1[2], (int)xq[2], di, false); di = __builtin_amdgcn_sdot4((int)u1[3], (int)xq[3], di, false);
                const int tot = wave_isum(di);
                const float g = __uint_as_float(k < 64 ? __builtin_amdgcn_readlane(__float_as_uint(g_lo), k) : __builtin_amdgcn_readlane(__float_as_uint(g_hi), k - 64));
                if (lane == 0) B.a[(size_t)t * 128 + k] = g * gelu_tanh((float)tot * P.SU[id] * sx) * P.SV[id]; }
        }
        if (!more) break;
        t = tn; e_lo = ne_lo; e_hi = ne_hi; g_lo = ng_lo; g_hi = ng_hi; xq = nxq; sx = nsx;
    }
}
__device__ __forceinline__ void peer_v(Frame& F, const PeerArgs& P, const PeerBufs& B, int ntok) {
    const int lane = ltid(F.wave) & 63;
    const int nsl = 8, wps = (F.G / nsl) * NWAVES;
    const int j = F.vcu / (F.G / nsl), wsl = (F.vcu % (F.G / nsl)) * NWAVES + F.wave;
    const int grp = lane >> 3, ch = lane & 7;
    int t = wsl; if (t >= ntok) return;
#define PV_HDR(tt, EL, EH, CL, CH) do { EL = B.eid[(size_t)(tt) * 128 + lane]; EH = B.eid[(size_t)(tt) * 128 + 64 + lane]; CL = B.a[(size_t)(tt) * 128 + lane]; CH = B.a[(size_t)(tt) * 128 + 64 + lane]; } while (0)
#define PV_ROWS(W, CF, EL, EH, CL, CH) do { _Pragma("unroll") for (int i = 0; i < 16; ++i) { const int src = (8 * i + grp) & 63; const int id = bperm_i(i < 8 ? EL : EH, src); CF[i] = bperm_f(i < 8 ? CL : CH, src); \
            W[i] = *(const v4u*)(P.V + (size_t)id * DM + 128 * j + 16 * ch); } } while (0)
    int e_lo, e_hi, ne_lo, ne_hi; float c_lo, c_hi, nc_lo, nc_hi;
    v4u wA[16], wB[16]; float cfA[16], cfB[16];
    PV_HDR(t, e_lo, e_hi, c_lo, c_hi);
    { const int t1 = (t + wps < ntok) ? t + wps : t; PV_HDR(t1, ne_lo, ne_hi, nc_lo, nc_hi); }
    PV_ROWS(wA, cfA, e_lo, e_hi, c_lo, c_hi);
#define PV_STEP(W, CF, WN, CFN) do { \
        const int tn = t + wps; const bool more = tn < ntok; \
        if (more) { PV_ROWS(WN, CFN, ne_lo, ne_hi, nc_lo, nc_hi); const int t2 = (tn + wps < ntok) ? tn + wps : tn; PV_HDR(t2, ne_lo, ne_hi, nc_lo, nc_hi); } \
        float acc[16]; float asum = 0.f; \
        _Pragma("unroll") for (int c = 0; c < 16; ++c) acc[c] = 0.f; \
        _Pragma("unroll") for (int i = 0; i < 16; ++i) { asum += CF[i]; const f32x2 cf2 = {CF[i], CF[i]}; \
            _Pragma("unroll") for (int q = 0; q < 4; ++q) { const unsigned x = W[i][q]; \
                const f32x2 v01 = {(float)(x & 0xffu), (float)((x >> 8) & 0xffu)}, v23 = {(float)((x >> 16) & 0xffu), (float)(x >> 24)}; \
                f32x2 o01 = {acc[4 * q], acc[4 * q + 1]}, o23 = {acc[4 * q + 2], acc[4 * q + 3]}; \
                o01 = __builtin_elementwise_fma(cf2, v01, o01); o23 = __builtin_elementwise_fma(cf2, v23, o23); \
                acc[4 * q] = o01.x; acc[4 * q + 1] = o01.y; acc[4 * q + 2] = o23.x; acc[4 * q + 3] = o23.y; } } \
        asum += __builtin_bit_cast(float, __builtin_amdgcn_update_dpp(0, __builtin_bit_cast(int, asum), 0x128, 0xf, 0xf, false)); asum += xorf<16>(asum); asum = x32_sum(asum); \
        _Pragma("unroll") for (int c = 0; c < 16; ++c) { acc[c] += __builtin_bit_cast(float, __builtin_amdgcn_update_dpp(0, __builtin_bit_cast(int, acc[c]), 0x128, 0xf, 0xf, false)); acc[c] += xorf<16>(acc[c]); acc[c] = x32_sum(acc[c]); } \
        if (lane < 8) { \
            const int col0 = 128 * j + 16 * lane; const float* g2 = (t < SEQ) ? P.g2l : P.g2c; \
            _Pragma("unroll") for (int q = 0; q < 4; ++q) { const f32x4 xo = *(const f32x4*)(P.Xin + (size_t)t * DM + col0 + 4 * q), g = *(const f32x4*)(g2 + col0 + 4 * q); \
                f32x4 y; y.x = xo.x + g.x * (acc[4 * q] - 128.f * asum); y.y = xo.y + g.y * (acc[4 * q + 1] - 128.f * asum); y.z = xo.z + g.z * (acc[4 * q + 2] - 128.f * asum); y.w = xo.w + g.w * (acc[4 * q + 3] - 128.f * asum); \
                *(f32x4*)(P.Xout + (size_t)t * DM + col0 + 4 * q) = y; } \
        } \
        done = !more; t = tn; } while (0)
    bool done = false;
    for (;;) {
        PV_STEP(wA, cfA, wB, cfB); if (done) break;
        PV_STEP(wB, cfB, wA, cfA); if (done) break;
    }
#undef PV_HDR
#undef PV_ROWS
#undef PV_STEP
}
__device__ __forceinline__ void peer_norm(Frame& F, const PeerArgs& P, int ntok) {
    const int lane = ltid(F.wave) & 63; const int gw = F.vcu * NWAVES + F.wave, NGW = F.G * NWAVES;
    for (int t = gw; t < ntok; t += NGW) {
        const bool latent = t < SEQ;
        if (P.fout) {
            const GAS f32x4* xr = (const GAS f32x4*)(P.Xout + (size_t)t * DM) + lane; f32x4 v[4]; float s = 0.f;
#pragma unroll
            for (int q = 0; q < 4; ++q) { v[q] = xr[64 * q]; s += (v[q].x * v[q].x + v[q].y * v[q].y) + (v[q].z * v[q].z + v[q].w * v[q].w); }
            const float ri = __builtin_amdgcn_rsqf(wave_sum(s) * (1.f / DM) + EPS);
#pragma unroll
            for (int q = 0; q < 4; ++q) { const f32x4 w = *(const f32x4*)(P.fnw + 256 * q + 4 * lane); *(f32x4*)(P.fout + (size_t)t * DM + 256 * q + 4 * lane) = v[q] * ri * w; }
        } else modnorm_row(P.Xout + (size_t)t * DM, P.Hout ? P.Hout + (size_t)t * DM : (bf16_t*)nullptr, P.nwn, latent ? P.shl : P.shc, latent ? P.scl : P.scc, lane, P.H8out ? P.H8out + (size_t)t * DM : (unsigned char*)nullptr);
    }
}

constexpr int P2_Y = 0;
constexpr int P2_EID = 73728, P2_GT = P2_EID + 72 * 128 * 2, P2_SX = P2_GT + 72 * 128 * 4, P2_END = P2_SX + 72 * 4;
static_assert(P2_END <= RING_BYTES, "peer2 LDS map");
template <int NTK> __device__ __forceinline__ void peer2_tokens(Frame& F, const PeerArgs& P, int t_begin, int lt0, int cnt, int lane_in) {
    int lane = lane_in; asm volatile("" : "+v"(lane));
    const LAS unsigned short* eidL = (const LAS unsigned short*)(F.lds + P2_EID); LAS float* gtL = (LAS float*)(F.lds + P2_GT); const LAS float* sxL = (const LAS float*)(F.lds + P2_SX);
#define g (lane >> 3)
#define c (lane & 7)
    const unsigned char* xqb = P.H8out_xq;
    int d[NTK][16];
#pragma unroll
    for (int tk = 0; tk < NTK; ++tk)
#pragma unroll
        for (int i = 0; i < 16; ++i) d[tk][i] = 0;
#pragma unroll 1
    for (int ps = 0; ps < 8; ++ps) {
#pragma unroll
        for (int tk = 0; tk < NTK; ++tk) {
            if (tk < cnt) {
                const int lt = lt0 + tk; const unsigned row = (unsigned)(t_begin + lt);
                const v4u xq = *(const GAS v4u*)(xqb + (unsigned)(row * DM + 128 * ps + 16 * c));
                v4u ua[16];
#pragma unroll
                for (int i = 0; i < 16; ++i) { const int id = eidL[lt * 128 + 8 * i + g]; ua[i] = *(const GAS v4u*)(P.U + (unsigned)((ps * NEXP + id) * 128 + 16 * c)); }
#pragma unroll
                for (int i = 0; i < 16; ++i) { int di = __builtin_amdgcn_sdot4((int)ua[i][0], (int)xq[0], d[tk][i], false); di = __builtin_amdgcn_sdot4((int)ua[i][1], (int)xq[1], di, false);
                    di = __builtin_amdgcn_sdot4((int)ua[i][2], (int)xq[2], di, false); d[tk][i] = __builtin_amdgcn_sdot4((int)ua[i][3], (int)xq[3], di, false); }
                __builtin_amdgcn_sched_barrier(0);
            }
        }
    }
    asm volatile("" : "+v"(lane));
#pragma unroll
    for (int tk = 0; tk < NTK; ++tk) {
        if (tk < cnt) {
            const int lt = lt0 + tk; const float sx = sxL[lt];
            int mine0 = 0, mine1 = 0;
#pragma unroll
            for (int i = 0; i < 16; ++i) { int v = d[tk][i];
                v += __builtin_amdgcn_update_dpp(0, v, 0xB1, 0xf, 0xf, false); v += __builtin_amdgcn_update_dpp(0, v, 0x4E, 0xf, 0xf, false); v += __builtin_amdgcn_update_dpp(0, v, 0x141, 0xf, 0xf, false);
                if ((i & 7) == c) { if (i < 8) mine0 = v; else mine1 = v; } }
#pragma unroll
            for (int hf = 0; hf < 2; ++hf) { const int e = 8 * (8 * hf + c) + g; const int id = eidL[lt * 128 + e];
                const f32x2 suv = ((const GAS f32x2*)P.SU)[id];
                const float pre = (float)(hf ? mine1 : mine0) * (suv.x * sx);
                gtL[lt * 128 + e] = gtL[lt * 128 + e] * gelu_tanh(pre) * suv.y; }
        }
    }
    LDS_WAIT();
    asm volatile("" : "+v"(lane));
    LAS unsigned char* yL = F.lds + P2_Y + F.wave * (4 * 2048);
#pragma unroll 1
    for (int ps = 0; ps < 8; ++ps) {
#pragma unroll
        for (int tk = 0; tk < NTK; ++tk) {
            if (tk < cnt) {
                const int lt = lt0 + tk; const unsigned row = (unsigned)(t_begin + lt);
                v4u w[16]; float cf[16];
#pragma unroll
                for (int i = 0; i < 16; ++i) { const int id = eidL[lt * 128 + 8 * i + g]; cf[i] = gtL[lt * 128 + 8 * i + g]; w[i] = *(const GAS v4u*)(P.V + (unsigned)((ps * NEXP + id) * 128 + 16 * c)); }
                float acc[16]; float asum = 0.f;
#pragma unroll
                for (int q = 0; q < 16; ++q) acc[q] = 0.f;
#pragma unroll
                for (int i = 0; i < 16; ++i) { asum += cf[i]; const f32x2 cf2 = {cf[i], cf[i]};
#pragma unroll
                    for (int q = 0; q < 4; ++q) { const unsigned x = w[i][q];
                        const f32x2 v01 = {(float)(x & 0xffu), (float)((x >> 8) & 0xffu)}, v23 = {(float)((x >> 16) & 0xffu), (float)(x >> 24)};
                        f32x2 o01 = {acc[4 * q], acc[4 * q + 1]}, o23 = {acc[4 * q + 2], acc[4 * q + 3]};
                        o01 = __builtin_elementwise_fma(cf2, v01, o01); o23 = __builtin_elementwise_fma(cf2, v23, o23);
                        acc[4 * q] = o01.x; acc[4 * q + 1] = o01.y; acc[4 * q + 2] = o23.x; acc[4 * q + 3] = o23.y; } }
                asum += __builtin_bit_cast(float, __builtin_amdgcn_update_dpp(0, __builtin_bit_cast(int, asum), 0x128, 0xf, 0xf, false)); asum += xorf<16>(asum); asum = x32_sum(asum);
#pragma unroll
                for (int q = 0; q < 16; ++q) { acc[q] += __builtin_bit_cast(float, __builtin_amdgcn_update_dpp(0, __builtin_bit_cast(int, acc[q]), 0x128, 0xf, 0xf, false)); acc[q] += xorf<16>(acc[q]); acc[q] = x32_sum(acc[q]); }
                if (lane < 8) {
                    v4u y0, y1;
                    y0.x = pk2(acc[0] - 128.f * asum, acc[1] - 128.f * asum); y0.y = pk2(acc[2] - 128.f * asum, acc[3] - 128.f * asum); y0.z = pk2(acc[4] - 128.f * asum, acc[5] - 128.f * asum); y0.w = pk2(acc[6] - 128.f * asum, acc[7] - 128.f * asum);
                    y1.x = pk2(acc[8] - 128.f * asum, acc[9] - 128.f * asum); y1.y = pk2(acc[10] - 128.f * asum, acc[11] - 128.f * asum); y1.z = pk2(acc[12] - 128.f * asum, acc[13] - 128.f * asum); y1.w = pk2(acc[14] - 128.f * asum, acc[15] - 128.f * asum);
                    LAS v4u* yp = (LAS v4u*)(yL + tk * 2048 + (128 * ps + 16 * lane) * 2); yp[0] = y0; yp[1] = y1;
                }
                __builtin_amdgcn_sched_barrier(0);
            }
        }
    }
    asm volatile("" : "+v"(lane));
    LDS_WAIT();
#pragma unroll
    for (int tk = 0; tk < NTK; ++tk) {
        if (tk < cnt) {
            const int lt = lt0 + tk; const unsigned row = (unsigned)(t_begin + lt); const bool latent = row < (unsigned)SEQ;
            const float* g2 = latent ? P.g2l : P.g2c;
            f32x4 xn[4]; float ss = 0.f;
#pragma unroll
            for (int q = 0; q < 4; ++q) { const unsigned col = 256 * q + 4 * lane; const f32x4 xo = __builtin_nontemporal_load((const GAS f32x4*)(P.Xin + (unsigned)(row * DM + col))), gq = *(const GAS f32x4*)(g2 + col);
                const v2u yy = *(const LAS v2u*)(yL + tk * 2048 + col * 2);
                f32x4 y; y.x = xo.x + gq.x * bflo(yy.x); y.y = xo.y + gq.y * bfhi(yy.x); y.z = xo.z + gq.z * bflo(yy.y); y.w = xo.w + gq.w * bfhi(yy.y);
                xn[q] = y; ss += (y.x * y.x + y.y * y.y) + (y.z * y.z + y.w * y.w); }
            const float ri = __builtin_amdgcn_rsqf(wave_sum(ss) * (1.f / DM) + EPS);
            if (P.fout) {
                if (latent) {
#pragma unroll
                    for (int q = 0; q < 4; ++q) { const unsigned col = 256 * q + 4 * lane; const f32x4 wq_ = *(const GAS f32x4*)(P.fnw + col); __builtin_nontemporal_store(xn[q] * ri * wq_, (GAS f32x4*)(P.fout + (unsigned)(row * DM + col))); }
                }
            } else {
                const float* sh = latent ? P.shl : P.shc; const float* sc = latent ? P.scl : P.scc;
#pragma unroll
                for (int q = 0; q < 4; ++q) { const unsigned col = 256 * q + 4 * lane; const f32x4 wn = *(const GAS f32x4*)(P.nwn + col), a = *(const GAS f32x4*)(sc + col), b = *(const GAS f32x4*)(sh + col);
                    __builtin_nontemporal_store(xn[q], (GAS f32x4*)(P.Xout + (unsigned)(row * DM + col)));
                    const f32x4 y = (xn[q] * ri * wn) * (1.0f + a) + b;
                    if (P.Hout) { v2u pk; pk.x = pk2(y.x, y.y); pk.y = pk2(y.z, y.w); *(v2u*)(P.Hout + (unsigned)(row * DM + col)) = pk; }
                    if (P.H8out) *(GAS unsigned*)(P.H8out + (unsigned)(row * DM + col)) = pk4_fp8(y.x, y.y, y.z, y.w); }
            }
        }
    }
}
#undef g
#undef c
__device__ __forceinline__ void peer_phase2(Frame& F, const PeerArgs& P) {
    const int tid = ltid(F.wave), lane = tid & 63;
    LAS unsigned* lists = (LAS unsigned*)(F.lds + PL_LISTS);
    LAS int* eid = (LAS int*)(F.lds + PL_EID);
    LAS float* gt = (LAS float*)(F.lds + PL_GT);
    LAS unsigned short* eidL = (LAS unsigned short*)(F.lds + P2_EID); LAS float* gtL = (LAS float*)(F.lds + P2_GT); LAS float* sxL = (LAS float*)(F.lds + P2_SX);
    const int ntok = P.nblocks * 32, tpc = (ntok + F.G - 1) / F.G, t_begin = F.vcu * tpc, t_end = (t_begin + tpc < ntok) ? t_begin + tpc : ntok;
    if (t_begin >= t_end) return;
    for (int row0 = t_begin; row0 < t_end; row0 += 32) {
        const int nt = (t_end - row0 < 32) ? t_end - row0 : 32;
        for (int rr = 0; rr < P.route_reps; ++rr) {
        if (rr) __syncthreads();
        {
            const int tok = tid >> 4, lst = tid & 15;
            const bf16_t* sp = (const bf16_t*)P.S + (size_t)(row0 + (tok < nt ? tok : nt - 1)) * 2048 + lst * 128;
            float top[16];
            v4u nv[2];
#pragma unroll
            for (int q = 0; q < 2; ++q) nv[q] = *(const v4u*)(sp + q * 8);
#pragma unroll 1
            for (int c = 0; c < 8; ++c) {
                float x[16];
#pragma unroll
                for (int e = 0; e < 16; ++e) { const unsigned w = nv[e >> 3][(e >> 1) & 3];
                    x[e] = __uint_as_float(((e & 1) ? (w & 0xffff0000u) : (w << 16)) | (unsigned)(c * 16 + e)); }
                if (c < 7) {
#pragma unroll
                    for (int q = 0; q < 2; ++q) nv[q] = *(const v4u*)(sp + (c + 1) * 16 + q * 8);
                }
                sort16_desc(x);
                if (c == 0) {
#pragma unroll
                    for (int i = 0; i < 16; ++i) top[i] = x[i];
                } else merge16_desc(top, x);
            }
            LAS unsigned* lp = lists + tid * 20;
#pragma unroll
            for (int q = 0; q < 4; ++q) *(LAS v4u*)(lp + q * 4) = (v4u){__float_as_uint(top[q * 4]), __float_as_uint(top[q * 4 + 1]), __float_as_uint(top[q * 4 + 2]), __float_as_uint(top[q * 4 + 3])};
        }
        __syncthreads();
        if (tid < 256) {
            const int tok = tid >> 3, hd = tid & 7;
            const LAS unsigned* la = lists + (tok * 16 + 2 * hd) * 20; const LAS unsigned* lb = la + 20;
            float av[16], bv[16];
#pragma unroll
            for (int q = 0; q < 4; ++q) { const v4u a = *(const LAS v4u*)(la + q * 4), b = *(const LAS v4u*)(lb + q * 4);
#pragma unroll
                for (int j = 0; j < 4; ++j) { av[q * 4 + j] = __uint_as_float(a[j] & ~127u); bv[q * 4 + j] = __uint_as_float(b[j] & ~127u); } }
            float c0[16], c1[16], c2[16], c3[16];
#pragma unroll
            for (int i = 0; i < 16; ++i) { c0[i] = -INFINITY; c1[i] = -INFINITY; c2[i] = -INFINITY; c3[i] = -INFINITY; }
            {
                int cnt = 0;
#pragma unroll
                for (int i = 0; i < 16; ++i)
#pragma unroll
                    for (int j = 0; j < 16; ++j) if ((i + 1) * (j + 1) <= 16) {
                        const float sm = __uint_as_float((__float_as_uint(av[i] + bv[j]) & ~255u) | (unsigned)(i * 16 + j));
                        const int slot = cnt & 15, arr = cnt >> 4;
                        if (arr == 0) c0[slot] = sm; else if (arr == 1) c1[slot] = sm; else if (arr == 2) c2[slot] = sm; else c3[slot] = sm;
                        ++cnt;
                    }
            }
            sort16_desc(c0); sort16_desc(c1); sort16_desc(c2); sort16_desc(c3);
            merge16_desc(c0, c1); merge16_desc(c0, c2); merge16_desc(c0, c3);
            float ev[16], sum = 0.f; const float m0 = __uint_as_float(__float_as_uint(c0[0]) & ~255u);
#pragma unroll
            for (int k = 0; k < 16; ++k) { ev[k] = fast_exp2((__uint_as_float(__float_as_uint(c0[k]) & ~255u) - m0) * LOG2E); sum += ev[k]; }
            const float rs = 1.0f / sum;
#pragma unroll
            for (int k = 0; k < 16; ++k) { const unsigned code = __float_as_uint(c0[k]) & 255u;
                const int ia = (int)(la[code >> 4] & 127u), ib = (int)(lb[code & 15u] & 127u);
                eid[tok * 128 + hd * 16 + k] = ia * NKEYS + ib; gt[tok * 128 + hd * 16 + k] = ev[k] * rs;
#if SELFCHECK
                if (tok < nt) { P.dbg_eid[(size_t)(row0 + tok) * 128 + hd * 16 + k] = ia * NKEYS + ib; P.dbg_gt[(size_t)(row0 + tok) * 128 + hd * 16 + k] = ev[k] * rs; }
#endif
            }
        }
        }
        __syncthreads();
        { const int lb = row0 - t_begin;
#pragma unroll
          for (int i = 0; i < 8; ++i) { const int idx = i * NTHREADS + tid; if ((idx >> 7) < nt) { eidL[lb * 128 + idx] = (unsigned short)eid[idx]; gtL[lb * 128 + idx] = gt[idx]; } }
          if (tid < nt) sxL[lb + tid] = P.SXG[row0 + tid];
        }
        __syncthreads();
    }
    asm volatile("s_waitcnt vmcnt(0)" ::: "memory"); __syncthreads();
    const int ntot = t_end - t_begin;
#pragma unroll 1
    for (int gi = 0; gi < 2; ++gi) { const int lt0 = F.wave * 4 + 32 * gi; int cnt = ntot - lt0; cnt = cnt < 0 ? 0 : (cnt > 4 ? 4 : cnt); if (cnt > 0) peer2_tokens<4>(F, P, t_begin, lt0, cnt, lane); }
    if (ntot > 64 && F.wave == 0) peer2_tokens<1>(F, P, t_begin, 64, 1, lane);
}

__device__ __forceinline__ void peer_phase(Frame& F, const PeerArgs& P) {
    const int tid = ltid(F.wave), lane = tid & 63;
    LAS unsigned* lists = (LAS unsigned*)(F.lds + PL_LISTS);
    LAS int* eid = (LAS int*)(F.lds + PL_EID);
    LAS float* gt = (LAS float*)(F.lds + PL_GT);
    const int ntok = P.nblocks * 32, tpc = (ntok + F.G - 1) / F.G, t_begin = F.vcu * tpc, t_end = (t_begin + tpc < ntok) ? t_begin + tpc : ntok;
    for (int row0 = t_begin; row0 < t_end; row0 += 32) {
        const int nt = (t_end - row0 < 32) ? t_end - row0 : 32;
        for (int rr = 0; rr < P.route_reps; ++rr) {
        if (rr) __syncthreads();
        {
            const int tok = tid >> 4, lst = tid & 15;
            const bf16_t* sp = (const bf16_t*)P.S + (size_t)(row0 + (tok < nt ? tok : nt - 1)) * 2048 + lst * 128;
            float top[16];
            v4u nv[2];
#pragma unroll
            for (int q = 0; q < 2; ++q) nv[q] = *(const v4u*)(sp + q * 8);
#pragma unroll 1
            for (int c = 0; c < 8; ++c) {
                float x[16];
#pragma unroll
                for (int e = 0; e < 16; ++e) { const unsigned w = nv[e >> 3][(e >> 1) & 3];
                    x[e] = __uint_as_float(((e & 1) ? (w & 0xffff0000u) : (w << 16)) | (unsigned)(c * 16 + e)); }
                if (c < 7) {
#pragma unroll
                    for (int q = 0; q < 2; ++q) nv[q] = *(const v4u*)(sp + (c + 1) * 16 + q * 8);
                }
                sort16_desc(x);
                if (c == 0) {
#pragma unroll
                    for (int i = 0; i < 16; ++i) top[i] = x[i];
                } else merge16_desc(top, x);
            }
            LAS unsigned* lp = lists + tid * 20;
#pragma unroll
            for (int q = 0; q < 4; ++q) *(LAS v4u*)(lp + q * 4) = (v4u){__float_as_uint(top[q * 4]), __float_as_uint(top[q * 4 + 1]), __float_as_uint(top[q * 4 + 2]), __float_as_uint(top[q * 4 + 3])};
        }
        __syncthreads();
        if (tid < 256) {
            const int tok = tid >> 3, hd = tid & 7;
            const LAS unsigned* la = lists + (tok * 16 + 2 * hd) * 20; const LAS unsigned* lb = la + 20;
            float av[16], bv[16];
#pragma unroll
            for (int q = 0; q < 4; ++q) { const v4u a = *(const LAS v4u*)(la + q * 4), b = *(const LAS v4u*)(lb + q * 4);
#pragma unroll
                for (int j = 0; j < 4; ++j) { av[q * 4 + j] = __uint_as_float(a[j] & ~127u); bv[q * 4 + j] = __uint_as_float(b[j] & ~127u); } }
            float c0[16], c1[16], c2[16], c3[16];
#pragma unroll
            for (int i = 0; i < 16; ++i) { c0[i] = -INFINITY; c1[i] = -INFINITY; c2[i] = -INFINITY; c3[i] = -INFINITY; }
            {
                int cnt = 0;
#pragma unroll
                for (int i = 0; i < 16; ++i)
#pragma unroll
                    for (int j = 0; j < 16; ++j) if ((i + 1) * (j + 1) <= 16) {
                        const float sm = __uint_as_float((__float_as_uint(av[i] + bv[j]) & ~255u) | (unsigned)(i * 16 + j));
                        const int slot = cnt & 15, arr = cnt >> 4;
                        if (arr == 0) c0[slot] = sm; else if (arr == 1) c1[slot] = sm; else if (arr == 2) c2[slot] = sm; else c3[slot] = sm;
                        ++cnt;
                    }
            }
            sort16_desc(c0); sort16_desc(c1); sort16_desc(c2); sort16_desc(c3);
            merge16_desc(c0, c1); merge16_desc(c0, c2); merge16_desc(c0, c3);
            float ev[16], sum = 0.f; const float m0 = __uint_as_float(__float_as_uint(c0[0]) & ~255u);
#pragma unroll
            for (int k = 0; k < 16; ++k) { ev[k] = fast_exp2((__uint_as_float(__float_as_uint(c0[k]) & ~255u) - m0) * LOG2E); sum += ev[k]; }
            const float rs = 1.0f / sum;
#pragma unroll
            for (int k = 0; k < 16; ++k) { const unsigned code = __float_as_uint(c0[k]) & 255u;
                const int ia = (int)(la[code >> 4] & 127u), ib = (int)(lb[code & 15u] & 127u);
                eid[tok * 128 + hd * 16 + k] = ia * NKEYS + ib; gt[tok * 128 + hd * 16 + k] = ev[k] * rs;
#if SELFCHECK
                if (tok < nt) { P.dbg_eid[(size_t)(row0 + tok) * 128 + hd * 16 + k] = ia * NKEYS + ib; P.dbg_gt[(size_t)(row0 + tok) * 128 + hd * 16 + k] = ev[k] * rs; }
#endif
            }
        }
        }
        __syncthreads();
#pragma unroll 1
        for (int tk = 0; tk < 4; ++tk) {
            const int tok = F.wave * 4 + tk; if (tok >= nt) break;
            const size_t row = (size_t)(row0 + tok);
            const bool latent = row < (size_t)SEQ;
            const bf16_t* hp = P.Hin + row * DM + 16 * lane;
            const v4u h0 = *(const v4u*)hp, h1 = *(const v4u*)(hp + 8);
            float xf[16];
#pragma unroll
            for (int q = 0; q < 4; ++q) { xf[2 * q] = bflo(h0[q]); xf[2 * q + 1] = bfhi(h0[q]); xf[8 + 2 * q] = bflo(h1[q]); xf[8 + 2 * q + 1] = bfhi(h1[q]); }
            float am = 0.f;
#pragma unroll
            for (int i = 0; i < 16; ++i) am = __builtin_fmaxf(am, __builtin_fabsf(xf[i]));
            am = wave_max(am);
            const float sx = am * (1.f / 127.f), ix = am > 0.f ? 127.f / am : 0.f;
            int xq[4];
#pragma unroll
            for (int q = 0; q < 4; ++q) { int w = 0;
#pragma unroll
                for (int j = 0; j < 4; ++j) { const int v = (int)__builtin_rintf(xf[4 * q + j] * ix); w |= (v & 0xff) << (8 * j); }
                xq[q] = w; }
            float out[16]; float asum = 0.f;
#pragma unroll
            for (int i = 0; i < 16; ++i) out[i] = 0.f;
            const int esel = (lane >> 2) & 15;
#pragma unroll 1
            for (int e0 = 0; e0 < 128; e0 += 16) {
                v4u ua[16], va[16];
#pragma unroll
                for (int k = 0; k < 16; ++k) { const int id = __builtin_amdgcn_readfirstlane(eid[tok * 128 + e0 + k]);
                    ua[k] = *(const v4u*)(P.U + (unsigned)(((lane >> 3) * NEXP + id) * 128 + 16 * (lane & 7))); va[k] = *(const v4u*)(P.V + (unsigned)(((lane >> 3) * NEXP + id) * 128 + 16 * (lane & 7))); }
                const int myid = eid[tok * 128 + e0 + esel]; const float mysu = P.SU[myid], mysv = P.SV[myid], myg = gt[tok * 128 + e0 + esel];
                int d[16];
#pragma unroll
                for (int k = 0; k < 16; ++k) { int di = __builtin_amdgcn_sdot4((int)ua[k][0], xq[0], 0, false); di = __builtin_amdgcn_sdot4((int)ua[k][1], xq[1], di, false);
                    di = __builtin_amdgcn_sdot4((int)ua[k][2], xq[2], di, false); d[k] = __builtin_amdgcn_sdot4((int)ua[k][3], xq[3], di, false); }
                int s8[8], s4[4], s2[2];
#pragma unroll
                for (int i = 0; i < 8; ++i) { auto r = __builtin_amdgcn_permlane32_swap((unsigned)d[i], (unsigned)d[i + 8], false, false); s8[i] = (int)r[0] + (int)r[1]; }
#pragma unroll
                for (int i = 0; i < 4; ++i) { auto r = __builtin_amdgcn_permlane16_swap((unsigned)s8[i], (unsigned)s8[i + 4], false, false); s4[i] = (int)r[0] + (int)r[1]; }
                const bool b3 = (lane & 8) != 0, b2 = (lane & 4) != 0;
#pragma unroll
                for (int i = 0; i < 2; ++i) { const int keep = b3 ? s4[i + 2] : s4[i], send = b3 ? s4[i] : s4[i + 2]; s2[i] = keep + __builtin_amdgcn_update_dpp(0, send, 0x128, 0xf, 0xf, false); }
                int z; { const int keep = b2 ? s2[1] : s2[0], send = b2 ? s2[0] : s2[1]; z = keep + __builtin_amdgcn_ds_swizzle(send, 0x101F); }
                z += __builtin_amdgcn_update_dpp(0, z, 0x4E, 0xf, 0xf, false);
                z += __builtin_amdgcn_update_dpp(0, z, 0xB1, 0xf, 0xf, false);
                const float pre = (float)z * (mysu * sx);
                const float act = myg * gelu_tanh(pre);
#if SELFCHECK
                if ((lane & 3) == 0) P.dbg_gt[(size_t)9 * MiB / 4 + row * 128 + e0 + esel] = gelu_tanh(pre);
#endif
                const float cfl = act * mysv;
#pragma unroll
                for (int k = 0; k < 16; ++k) {
                    const float cf = __uint_as_float(__builtin_amdgcn_readlane(__float_as_uint(cfl), 4 * k));
                    asum += cf;
                    const f32x2 cf2 = {cf, cf};
#pragma unroll
                    for (int q = 0; q < 4; ++q) { const unsigned w = va[k][q];
                        const f32x2 v01 = {(float)(w & 0xffu), (float)((w >> 8) & 0xffu)}, v23 = {(float)((w >> 16) & 0xffu), (float)(w >> 24)};
                        f32x2 o01 = {out[4 * q], out[4 * q + 1]}, o23 = {out[4 * q + 2], out[4 * q + 3]};
                        o01 = __builtin_elementwise_fma(cf2, v01, o01); o23 = __builtin_elementwise_fma(cf2, v23, o23);
                        out[4 * q] = o01.x; out[4 * q + 1] = o01.y; out[4 * q + 2] = o23.x; out[4 * q + 3] = o23.y; }
                }
            }
#pragma unroll
            for (int i = 0; i < 16; ++i) out[i] -= 128.f * asum;
            const float* g2 = latent ? P.g2l : P.g2c;
            float xn[16]; float ss = 0.f;
#pragma unroll
            for (int q = 0; q < 4; ++q) { const int col = 16 * lane + 4 * q; const f32x4 xo = *(const f32x4*)(P.Xin + row * DM + col), g = *(const f32x4*)(g2 + col);
#pragma unroll
                for (int j = 0; j < 4; ++j) { const float v = xo[j] + g[j] * out[4 * q + j]; xn[4 * q + j] = v; ss += v * v; } }
            const float ri = __builtin_amdgcn_rsqf(wave_sum(ss) * (1.f / DM) + EPS);
            if (P.dry) {
                if (ri == 12345.678f) P.Xout[row * DM] = ri;
            } else if (P.fout) {
                if (latent) {
#pragma unroll
                    for (int q = 0; q < 4; ++q) { const int col = 16 * lane + 4 * q; const f32x4 w = *(const f32x4*)(P.fnw + col);
                        f32x4 y; y.x = xn[4 * q] * ri * w.x; y.y = xn[4 * q + 1] * ri * w.y; y.z = xn[4 * q + 2] * ri * w.z; y.w = xn[4 * q + 3] * ri * w.w;
                        *(f32x4*)(P.fout + row * DM + col) = y; }
                }
            } else {
                const float* sh = latent ? P.shl : P.shc; const float* sc = latent ? P.scl : P.scc;
                unsigned hw[8], h8[4];
#pragma unroll
                for (int q = 0; q < 4; ++q) { const int col = 16 * lane + 4 * q;
                    *(f32x4*)(P.Xout + row * DM + col) = (f32x4){xn[4 * q], xn[4 * q + 1], xn[4 * q + 2], xn[4 * q + 3]};
                    const f32x4 w = *(const f32x4*)(P.nwn + col), a = *(const f32x4*)(sc + col), b = *(const f32x4*)(sh + col);
                    float y[4];
#pragma unroll
                    for (int j = 0; j < 4; ++j) y[j] = (xn[4 * q + j] * ri * w[j]) * (1.0f + a[j]) + b[j];
                    hw[2 * q] = pk2(y[0], y[1]); hw[2 * q + 1] = pk2(y[2], y[3]); h8[q] = pk4_fp8(y[0], y[1], y[2], y[3]); }
                if (P.Hout) { *(v4u*)(P.Hout + row * DM + 16 * lane) = (v4u){hw[0], hw[1], hw[2], hw[3]};
                    *(v4u*)(P.Hout + row * DM + 16 * lane + 8) = (v4u){hw[4], hw[5], hw[6], hw[7]}; }
                if (P.H8out) *(v4u*)(P.H8out + row * DM + 16 * lane) = (v4u){h8[0], h8[1], h8[2], h8[3]};
            }
        }
        __syncthreads();
    }
}
__device__ __forceinline__ float lam_init_of(int l) { return l == 0 ? 0.2f : 0.35550906765f; }

#ifndef PHASE_MASK
#define PHASE_MASK 0xffff
#endif
#define PH(n) ((PHASE_MASK >> (n)) & 1)
#define REPS(n) (1 + ((dupmask >> (n)) & 1))
__global__ void __launch_bounds__(NTHREADS, 2) trunk_fwd(Args args) {
    extern __shared__ __attribute__((aligned(16))) unsigned char lds[];
    Frame F;
    F.lds = (LAS unsigned char*)lds;
    F.MISC = (volatile LAS unsigned*)(F.lds + MISC_OFF);
    F.wave = __builtin_amdgcn_readfirstlane((int)threadIdx.x >> 6);
    F.G = gridDim.x; { const int bx = blockIdx.x; F.vcu = (F.G % 8 == 0) ? (bx % 8) * (F.G / 8) + bx / 8 : bx; }
    unsigned char* ws = args.ws;
    F.ctl = (gu32*)(ws + WS_CTL);
    for (int u = ltid(F.wave); u < (LDS_BYTES - LDSCTL_OFF) / 4; u += NTHREADS) ((LAS unsigned*)(F.lds + LDSCTL_OFF))[u] = 0u;
    __syncthreads();
    XcdBarrier bar = xcd_barrier_post((unsigned*)(F.ctl + CW_BAR), F.MISC + 8, F.wave);
#ifndef TIMING
#define TIMING 0
#endif
#if TIMING
    int n_stamp = 0;
#define STAMP() do { if (blockIdx.x == 0 && tid_now(F.wave) == 0) ((unsigned long long*)(F.ctl + 1024))[n_stamp] = __builtin_amdgcn_s_memrealtime(); ++n_stamp; } while (0)
#else
#define STAMP() do {} while (0)
#endif
#define GRID_BAR() do { xcd_barrier(bar); STAMP(); asm volatile("" : "+s"(ws)); } while (0)
    STAMP();

    const float* const* in = args.in;
    const int dupmask = args.flags;
#define modv ((float*)(ws + WS_CONST))
#define lamv (modv + 2 * 2 * 6144)
#define WIN ((bf16_t*)(ws + WS_WIN))
#define WGATE ((bf16_t*)(ws + WS_WGATE))
#define WBR ((bf16_t*)(ws + WS_WBR))
#define WOUT ((bf16_t*)(ws + WS_WOUT))
#define WSC ((bf16_t*)(ws + WS_WSC))
#define X ((float*)(ws + WS_X))
#define H ((bf16_t*)(ws + WS_H))
#define YS ((bf16_t*)(ws + WS_YS))
#define MIX YS
#define Qb ((bf16_t*)(ws + WS_Q))
#define Kb ((bf16_t*)(ws + WS_K))
#define Vb ((bf16_t*)(ws + WS_V))
#define BP ((bf16_t*)(ws + WS_R1))
#define SB ((float*)(ws + WS_R1))
    const int gw = F.vcu * NWAVES + F.wave, NGW = F.G * NWAVES;

    for (int rep = 0; rep < REPS(0); ++rep) {
        const int tid = ltid(F.wave), lane = tid & 63;
        LAS float* scr = (LAS float*)(F.lds + F.wave * 16384);
        for (int un = F.vcu; un < 2 * 128; un += F.G) {
            const int l = un >> 7, col = (un & 127) * 48 + lane; const bool act = lane < 48;
            const float* W = in[I_ADAW] + (size_t)l * DM * 6144;
            float a0 = 0.f, a1 = 0.f;
            if (act) {
#pragma unroll 16
                for (int k = 128 * F.wave; k < 128 * F.wave + 128; ++k) { const float w = W[(size_t)k * 6144 + col]; const float c0 = in[I_C][k], c1 = in[I_CCTX][k];
                    a0 += c0 * sigmoidf_(c0) * w; a1 += c1 * sigmoidf_(c1) * w; }
            }
            LAS float* red = (LAS float*)(F.lds);
            red[(F.wave * 64 + lane) * 2] = a0; red[(F.wave * 64 + lane) * 2 + 1] = a1;
            __syncthreads();
            if (F.wave == 0 && act) { float s0 = in[I_ADAB][l * 6144 + col], s1 = s0;
#pragma unroll
                for (int w = 0; w < 8; ++w) { s0 += red[(w * 64 + lane) * 2]; s1 += red[(w * 64 + lane) * 2 + 1]; }
                modv[(l * 2 + 0) * 6144 + col] = s0; modv[(l * 2 + 1) * 6144 + col] = s1; }
            __syncthreads();
        }
        if (blockIdx.x == 0 && tid < 2) { const float* lf = in[I_DLAM] + tid * 128; float s0 = 0.f, s1 = 0.f;
            for (int i = 0; i < 32; ++i) { s0 += lf[i] * lf[32 + i]; s1 += lf[64 + i] * lf[96 + i]; }
            lamv[tid] = expf(s0) - expf(s1) + lam_init_of(tid); }
        constexpr int I_IN = 16 * 80, I_GT = 16 * 128, I_BR = 4 * 32, I_OT = 16 * 32;
        constexpr int NITEMS = 2 * I_IN + 2 * I_GT + 8 * I_BR + 2 * I_OT;
        unsigned char* W8IN = ws + WS_W8IN; unsigned char* W8GATE = ws + WS_W8GATE;
        for (int it = gw; it < NITEMS; it += NGW) {
            int r = it;
            if (r < 2 * I_IN) { const int l = r / I_IN; transpose_item<MapWin, true>(in[I_WIN] + (size_t)l * DM * NQKV, DM, NQKV, W8IN + (size_t)l * NQKV * DM, MapWin(), scr, r % I_IN, lane); continue; } r -= 2 * I_IN;
            if (r < 2 * I_GT) { const int l = r / I_GT; transpose_item<MapGate, true>(in[I_WGATE] + (size_t)l * DM * 4096, DM, 4096, W8GATE + (size_t)l * 4096 * DM, MapGate(), scr, r % I_GT, lane); continue; } r -= 2 * I_GT;
            if (r < 8 * I_BR) { const int lb = r / I_BR; transpose_item(in[I_WBR] + (size_t)lb * 256 * DM, 256, DM, WBR + (size_t)lb * DM * 256, MapId(), scr, r % I_BR, lane); continue; } r -= 8 * I_BR;
#if MIX8
            { const int l = r / I_OT; transpose_item<MapId, true>(in[I_WOUT] + (size_t)l * DM * DM, DM, DM, ws + WS_W8OUT + (size_t)l * DM * DM, MapId(), scr, r % I_OT, lane); }
#else
            { const int l = r / I_OT; transpose_item(in[I_WOUT] + (size_t)l * DM * DM, DM, DM, WOUT + (size_t)l * DM * DM, MapId(), scr, r % I_OT, lane); }
#endif
        }
        for (int it = gw; it < 2 * 16 * 8 * 64; it += NGW) {
            const int kt = it & 63, nt = (it >> 6) & 7, g = (it >> 9) & 15, l = it >> 13, h = g >> 1, p = g & 1;
            const float* kp = in[I_PKEYS] + ((size_t)((l * 2 + p) * 8 + h) * 128 + nt * 16 + (lane & 15)) * 128 + 4 * (lane >> 4);
            const float* qp = in[I_PWQ] + ((size_t)l * DM + kt * 16 + (lane & 15)) * 2048 + g * 128 + 4 * (lane >> 4);
            f32x4 acc = {0.f, 0.f, 0.f, 0.f};
            f32x4 ka[8], qa[8];
#pragma unroll
            for (int c = 0; c < 8; ++c) { ka[c] = *(const f32x4*)(kp + 16 * c); qa[c] = *(const f32x4*)(qp + 16 * c); }
            __builtin_amdgcn_sched_barrier(0);
#pragma unroll
            for (int c = 0; c < 8; ++c)
#pragma unroll
                for (int j = 0; j < 4; ++j) acc = __builtin_amdgcn_mfma_f32_16x16x4f32(ka[c][j], qa[c][j], acc, 0, 0, 0);
            bf16_t* op = WSC + ((size_t)l * 2048 + g * 128 + nt * 16 + 4 * (lane >> 4)) * DM + kt * 16 + (lane & 15);
#pragma unroll
            for (int r = 0; r < 4; ++r) op[(size_t)r * DM] = (bf16_t)f2bf(acc[r]);
        }
        {
            unsigned char* UQ = (unsigned char*)(ws + WS_UBF); unsigned char* VQ = (unsigned char*)(ws + WS_VBF); float* SU = (float*)(ws + WS_SU); float* SV = (float*)(ws + WS_SV);
            for (int r0 = gw; r0 < 2 * 2 * NEXP; r0 += 4 * NGW) {
                f32x4 v[4][4];
#pragma unroll
                for (int u4 = 0; u4 < 4; ++u4) { const int r = r0 + u4 * NGW; const bool isv = r >= 2 * NEXP; const int rr = isv ? r - 2 * NEXP : r;
                    const float* src = (isv ? in[I_PV] : in[I_PU]) + (size_t)rr * DM + 16 * lane;
#pragma unroll
                    for (int q = 0; q < 4; ++q) v[u4][q] = *(const f32x4*)(src + 4 * q); }
#pragma unroll
                for (int u4 = 0; u4 < 4; ++u4) { const int r = r0 + u4 * NGW; const bool isv = r >= 2 * NEXP; const int rr = isv ? r - 2 * NEXP : r;
                    float am = 0.f;
#pragma unroll
                    for (int q = 0; q < 4; ++q) am = __builtin_fmaxf(am, __builtin_fmaxf(__builtin_fmaxf(__builtin_fabsf(v[u4][q].x), __builtin_fabsf(v[u4][q].y)), __builtin_fmaxf(__builtin_fabsf(v[u4][q].z), __builtin_fabsf(v[u4][q].w))));
                    am = wave_max(am);
                    const float inv = am > 0.f ? 127.f / am : 0.f; const int off = isv ? 128 : 0;
                    v4u w;
#pragma unroll
                    for (int q = 0; q < 4; ++q) { const int a0 = (int)__builtin_rintf(v[u4][q].x * inv) + off, a1 = (int)__builtin_rintf(v[u4][q].y * inv) + off, a2 = (int)__builtin_rintf(v[u4][q].z * inv) + off, a3 = (int)__builtin_rintf(v[u4][q].w * inv) + off;
                        w[q] = (unsigned)(a0 & 0xff) | ((unsigned)(a1 & 0xff) << 8) | ((unsigned)(a2 & 0xff) << 16) | ((unsigned)(a3 & 0xff) << 24); }
                    { const int lyr = rr >> 14, ex = rr & (NEXP - 1);
                      *(v4u*)((isv ? VQ : UQ) + (size_t)lyr * NEXP * DM + (size_t)(((lane >> 3) * NEXP + ex) * 128 + 16 * (lane & 7))) = w; }
                    if (lane == 0) SU[2 * rr + (isv ? 1 : 0)] = am * (1.f / 127.f); }
            }
        }
    }
#if SELFCHECK
    GRID_BAR();
#define CK_RED ((LAS float*)(F.lds))
#define CK_BUF ((LAS float*)(F.lds + 1024))
#define CK_IBUF ((LAS int*)(F.lds + 8192))
#define CK_OBUF ((LAS float*)(F.lds + 20480))
#define CK_SC ((LAS float*)(F.lds + 24576))
    if (blockIdx.x == 0) chk::ck_prologue(in, ws, F.ctl, CK_RED);
    __syncthreads();
#endif
    GRID_BAR();
    { const int lane = ltid(F.wave) & 63;
      for (int r = gw; r < 2 * 2048; r += NGW) {
        const bf16_t* src = WSC + (size_t)r * DM + 16 * lane;
        const v4u h0 = *(const v4u*)src, h1 = *(const v4u*)(src + 8);
        float xf[16];
#pragma unroll
        for (int qq = 0; qq < 4; ++qq) { xf[2 * qq] = bflo(h0[qq]); xf[2 * qq + 1] = bfhi(h0[qq]); xf[8 + 2 * qq] = bflo(h1[qq]); xf[8 + 2 * qq + 1] = bfhi(h1[qq]); }
        float am = 0.f;
#pragma unroll
        for (int i = 0; i < 16; ++i) am = __builtin_fmaxf(am, __builtin_fabsf(xf[i]));
        am = wave_max(am);
        const float ix = am > 0.f ? 127.f / am : 0.f;
        v4u o;
#pragma unroll
        for (int qq = 0; qq < 4; ++qq) { unsigned w = 0;
#pragma unroll
            for (int j = 0; j < 4; ++j) { const int v = (int)__builtin_rintf(xf[4 * qq + j] * ix); w |= (unsigned)(v & 0xff) << (8 * j); }
            o[qq] = w; }
        *(v4u*)(ws + WS_W8S + (size_t)r * DM + 16 * lane) = o;
        if (lane == 0) ((float*)(ws + WS_SWS))[r] = am * (1.f / 127.f); } }
    { const int lane = ltid(F.wave) & 63;
    for (int m = gw; m < MT; m += NGW) {
        const bool lat = m < SEQ; const float* xr = lat ? in[I_X] + (size_t)m * DM : in[I_CTX] + (size_t)(m - SEQ) * DM; const float* mv = modv + (lat ? 0 : 6144);
        modnorm_row(xr, SELFCHECK ? H + (size_t)m * DM : (bf16_t*)nullptr, in[I_N1W], mv, mv + 1024, lane, ws + WS_H8 + (size_t)m * DM);
    } }
    GRID_BAR();
#if SELFCHECK
    if (blockIdx.x < 5) { const int r = blockIdx.x == 0 ? 0 : blockIdx.x == 1 ? 777 : blockIdx.x == 2 ? 16383 : blockIdx.x == 3 ? 16384 : 16639;
        const bool lat = r < SEQ; const float* mv = modv + (lat ? 0 : 6144);
        chk::ck_modnorm(lat ? in[I_X] + (size_t)r * DM : in[I_CTX] + (size_t)(r - SEQ) * DM, H + (size_t)r * DM, in[I_N1W], mv, mv + 1024, F.ctl, 2, CK_RED); }
    GRID_BAR();
#endif

#pragma unroll 1
    for (int l = 0; l < 2; ++l) {
#define modl (modv + (size_t)(l * 2) * 6144)
#define modc (modl + 6144)
        const int nMr = (l == 0) ? MT / 256 : SEQ / 256;
        for (int rep = 0; rep < REPS(2); ++rep) {
            if (rep) GRID_BAR();
            pg8::Gemm g{ws + WS_H8, ws + WS_W8IN + (size_t)l * NQKV * DM, MT / 256, NQKV / 256, DM, DM, DM, 0, 0, 1};
            pg8::StaticOrder S; S.init(g, F.G, (int)blockIdx.x);
            pg8::EpiQKV E{Qb, Kb, Vb, in[I_QKNW] + l * 128};
            pg8::gemm_phase<pg8::EpiQKV, true>(F.lds, g, S, E, F.wave);
        }
        GRID_BAR();
#if SELFCHECK
        if (blockIdx.x < 4) { const int b = blockIdx.x; const int r = b == 0 ? 5 : b == 1 ? 8400 : b == 2 ? 16383 : 16391; chk::ck_qkv(l, r, in, ws, F.ctl, CK_RED, CK_BUF); }
        GRID_BAR();
#endif
        for (int rep = 0; rep < REPS(4); ++rep) {
            if (rep) GRID_BAR();
            char* shm = (char*)lds;
            const float lam = lamv[l];
            for (int ui = F.vcu; ui < 256; ui += F.G) {
                const int h = (ui >> 5) & 3, qb = ((ui >> 7) << 5) | (ui & 31);
                const int njobs = (l == 0 && ui < 16) ? (((ui >> 2) == 1) ? 7 : 6) : 5;
#pragma unroll 1
                for (int j = 0; j < njobs; ++j) {
                    att::AU u; int mode = 0;
                    u.sinkl2 = -INFINITY; u.emode = 0; u.lam = 0.f; u.oscale = 1.f; u.subw = in[I_SUBW] + l * 64; u.kbase = 0; u.q0 = qb * 256; u.NT = 260;
                    int qh, kh, oc;
                    if (j == 0)      { qh = 16 + h; kh = 10 + (h >> 1); oc = 768 + h * 64; }
                    else if (j == 1) { qh = 4 + 2 * h; kh = 4 + h; oc = 256 + h * 64; u.emode = 1; }
                    else if (j == 2) { qh = 5 + 2 * h; kh = 4 + h; oc = 256 + h * 64; u.emode = 2; u.lam = lam; u.oscale = 1.f - lam_init_of(l); }
                    else if (j == 3) { qh = h; kh = h; oc = h * 64; mode = 1; u.NT = 16; int B = 4 * qb - 4; B = B < 0 ? 0 : (B > 244 ? 244 : B); u.kbase = 64 * B; }
                    else if (j == 4) { qh = 12 + h; kh = 8 + (h >> 1); oc = 512 + h * 64; mode = 2; u.NT = 12; u.kbase = 256 * qb - 128; u.sinkl2 = in[I_SINK][l * 4 + h] * LOG2E; }
                    else {
                        const int mx = ui >> 2, hc = ui & 3; u.q0 = SEQ; u.NT = 4;
                        if (mx == 0)      { qh = hc; kh = hc; oc = hc * 64; }
                        else if (mx == 1) { qh = 4 + 2 * hc + (j - 5); kh = 4 + hc; oc = 256 + hc * 64; u.emode = (j == 5) ? 1 : 2; u.lam = lam; u.oscale = 1.f - lam_init_of(l); }
                        else if (mx == 2) { qh = 12 + hc; kh = 8 + (hc >> 1); oc = 512 + hc * 64; u.sinkl2 = in[I_SINK][l * 4 + hc] * LOG2E; }
                        else              { qh = 16 + hc; kh = 10 + (hc >> 1); oc = 768 + hc * 64; }
                    }
                    u.Q = (const att::bf16*)(Qb + (size_t)qh * MT * 64); u.K = (const att::bf16*)(Kb + (size_t)kh * MT * 64); u.V = (const att::bf16*)(Vb + (size_t)kh * MT * 64);
                    u.O = (att::bf16*)(YS + oc);
#ifndef ATT_MODES
#define ATT_MODES 7
#endif
                    if ((ATT_MODES & 2) && mode == 1) {
                        float* rp = (float*)(shm + att::LDS_RPB);
                        for (int i = ltid(F.wave); i < 15 * 32; i += NTHREADS) { const int c = i & 31; rp[i] = (c < 31) ? in[I_RPB][((size_t)(l * 4 + h) * 15 + (i >> 5)) * 31 + c] * LOG2E : 0.f; }
                        __syncthreads();
                        if (!att::attn_simple<1, 1>(u, shm, F.wave)) att::attn_simple<1>(u, shm, F.wave);
                    } else if ((ATT_MODES & 4) && mode == 2) { if (!att::attn_unit<2, 8, 0, 1>(u, shm, F.wave)) att::attn_unit<2, 8>(u, shm, F.wave); }
                    else if ((ATT_MODES & 1) && j == 1) { if (!att::attn_unit<0, 8, 1, 1>(u, shm, F.wave)) att::attn_unit<0, 8, 1>(u, shm, F.wave); }
                    else if ((ATT_MODES & 1) && j == 2) { if (!att::attn_unit<0, 8, 2, 1>(u, shm, F.wave)) att::attn_unit<0, 8, 2>(u, shm, F.wave); }
                    else if (ATT_MODES & 1) { if (!att::attn_unit<0, 8, 0, 1>(u, shm, F.wave)) att::attn_unit<0, 8>(u, shm, F.wave); }
                }
            }
        }
        GRID_BAR();
#if SELFCHECK
        if (blockIdx.x < 80) { const int b = blockIdx.x, ri = b >> 4; const int r = ri == 0 ? 3 : ri == 1 ? 4227 : ri == 2 ? 16319 : ri == 3 ? 9000 : 16484; chk::ck_attn(l, (b >> 2) & 3, b & 3, r, in, ws, F.ctl, CK_RED, CK_SC, CK_OBUF); }
        GRID_BAR();
#endif
        for (int rep = 0; rep < REPS(5); ++rep) {
            if (rep) GRID_BAR();
            pg8::Gemm g{YS, WBR + (size_t)l * 4 * DM * 256, nMr, 16, 256, DM, 256, 2, 512, 2};
            pg8::StaticOrder S; S.init(g, F.G, (int)blockIdx.x);
#if BP8
            pg8::EpiBranch8 E{(unsigned char*)BP};
            pg8::gemm_phase<pg8::EpiBranch8>(F.lds, g, S, E, F.wave);
#else
            pg8::EpiBranch E{BP};
            pg8::gemm_phase<pg8::EpiBranch>(F.lds, g, S, E, F.wave);
#endif
        }
        GRID_BAR();
#if SELFCHECK
        if (blockIdx.x < 3) { const int b = blockIdx.x; chk::ck_branch(l, b == 0 ? 1 : b == 1 ? 16383 : 16390, in, ws, F.ctl, CK_RED); }
        GRID_BAR();
#endif
        for (int rep = 0; rep < REPS(6); ++rep) {
            if (rep) GRID_BAR();
            pg8::Gemm g{ws + WS_H8, ws + WS_W8GATE + (size_t)l * 4096 * DM, nMr, 16, DM, DM, DM, 0, 0, 1};
            pg8::StaticOrder S; S.init(g, F.G, (int)blockIdx.x);
            pg8::EpiGate E{BP, MIX, in[I_BGATE] + l * 4096};
            pg8::gemm_phase<pg8::EpiGate, true>(F.lds, g, S, E, F.wave);
        }
        GRID_BAR();
#if SELFCHECK
        if (blockIdx.x < 3) { const int b = blockIdx.x; chk::ck_gate(l, b == 0 ? 2 : b == 1 ? 9999 : 16385, in, ws, F.ctl, CK_RED); }
        GRID_BAR();
#endif
        for (int rep = 0; rep < (l == 0 ? REPS(7) : 1); ++rep) {
            if (rep) GRID_BAR();
#if MIX8
            pg8::Gemm g{MIX, ws + WS_W8OUT + (size_t)l * DM * DM, nMr, 4, DM, DM, DM, 0, 0, 1};
#else
            pg8::Gemm g{MIX, WOUT + (size_t)l * DM * DM, nMr, 4, DM, DM, DM, 0, 0, 2};
#endif
            pg8::StaticOrder S; S.init(g, F.G, (int)blockIdx.x);
#ifndef FUSE_NORM2
#define FUSE_NORM2 1
#endif
#if FUSE_NORM2
            pg8::EpiOutNorm E{l == 0 ? in[I_X] : X, l == 0 ? in[I_CTX] : X + (size_t)SEQ * DM, X, modl + 2048, modc + 2048,
                              H, in[I_N2W] + l * DM, modl, modc, (gu32*)(ws + WS_CONST + 704 * 1024), F.ctl + 16384 + l * 65 * 64, F.ctl + 16000, F.lds + MISC_OFF + 1024,
                              (gu32*)(ws + WS_XB2), F.ctl + 16384 + (130 + l * 65) * 64, ws + WS_H8, (float*)(ws + WS_SXG)};
#if MIX8
            pg8::gemm_phase<pg8::EpiOutNorm, true, 0x7A7A7A7A>(F.lds, g, S, E, F.wave);
#else
            pg8::gemm_phase<pg8::EpiOutNorm>(F.lds, g, S, E, F.wave);
#endif
#else
            pg8::EpiOut E{l == 0 ? in[I_X] : X, l == 0 ? in[I_CTX] : X + (size_t)SEQ * DM, X, modl + 2048, modc + 2048};
            pg8::gemm_phase<pg8::EpiOut>(F.lds, g, S, E, F.wave);
#endif
        }
        GRID_BAR();
#if SELFCHECK
        if (blockIdx.x < 3) { const int b = blockIdx.x; chk::ck_out(l, b == 0 ? 4 : b == 1 ? 12345 : 16417, in, ws, F.ctl, CK_RED); }
        GRID_BAR();
#endif
#if !FUSE_NORM2
        { const int lane = ltid(F.wave) & 63;
        for (int m = gw; m < nMr * 256; m += NGW) {
            const float* mv = (m < SEQ) ? modl : modc;
            modnorm_row(X + (size_t)m * DM, H + (size_t)m * DM, in[I_N2W] + l * DM, mv + 3072, mv + 4096, lane);
        } }
        GRID_BAR();
#endif
#if SELFCHECK
        if (blockIdx.x < 3) { const int b = blockIdx.x; const int r = b == 0 ? 7 : b == 1 ? 16383 : 16500; const float* mv = (r < SEQ) ? modl : modc;
            chk::ck_modnorm(X + (size_t)r * DM, H + (size_t)r * DM, in[I_N2W] + l * DM, mv + 3072, mv + 4096, F.ctl, 8, CK_RED); }
        GRID_BAR();
#endif
        for (int rep = 0; rep < REPS(9); ++rep) {
            if (rep) GRID_BAR();
            pg8::Gemm g{ws + WS_H8, ws + WS_W8S + (size_t)l * 2048 * DM, nMr, 8, DM, DM, DM, 0, 0, 1};
            pg8::StaticOrder S; S.init(g, F.G, (int)blockIdx.x);
            pg8::EpiS8 E{SB, (const float*)(ws + WS_SXG), (const float*)(ws + WS_SWS) + l * 2048};
            pg8::gemm_phase<pg8::EpiS8, false, 0x7F7F7F7F, true>(F.lds, g, S, E, F.wave);
        }
        GRID_BAR();
#if SELFCHECK
        if (blockIdx.x < 3) { const int b = blockIdx.x; chk::ck_scores(l, b == 0 ? 6 : b == 1 ? 16000 : 16385, in, ws, F.ctl, CK_RED, CK_BUF); }
        GRID_BAR();
#endif
#ifndef PEER_SLICED
#define PEER_SLICED 0
#endif
#if !PEER_SLICED
        for (int rep = 0; rep < REPS(10); ++rep) {
            if (rep) GRID_BAR();
            PeerArgs P; P.dry = (rep + 1 < REPS(10)); P.route_reps = REPS(11);
            P.S = SB; P.Hin = H; P.U = (const unsigned char*)(ws + WS_UBF) + (size_t)l * NEXP * DM; P.V = (const unsigned char*)(ws + WS_VBF) + (size_t)l * NEXP * DM; P.SU = (const float*)(ws + WS_SU) + (size_t)l * 2 * NEXP; P.SV = (const float*)(ws + WS_SV) + l * NEXP; P.Xin = X; P.Xout = X;
            P.g2l = modl + 5120; P.g2c = modc + 5120;
            P.Hout = SELFCHECK ? H : (bf16_t*)nullptr; P.H8out = ws + WS_H8; P.nwn = in[I_N1W] + DM; P.shl = modv + 2 * 6144; P.scl = P.shl + 1024; P.shc = modv + 3 * 6144; P.scc = P.shc + 1024;
            P.fout = (l == 1) ? args.out : nullptr; P.fnw = in[I_FNW];
            P.nblocks = nMr * 8; P.dbg_eid = nullptr; P.dbg_gt = nullptr;
#if SELFCHECK
            if (l == 0) { P.Xout = (float*)(ws + WS_DBG); P.Hout = YS; P.H8out = nullptr; }
            P.dbg_eid = (int*)(ws + WS_VBF + 32 * MiB); P.dbg_gt = (float*)(ws + WS_VBF + 41 * MiB);
#endif
            P.H8out_xq = ws + WS_H8; P.SXG = (const float*)(ws + WS_SXG);
#ifndef PEER_V2
#define PEER_V2 1
#endif
            if (PEER_V2 && !P.dry) peer_phase2(F, P); else peer_phase(F, P);
        }
#else
        {
            PeerArgs P; P.dry = false; P.route_reps = 1;
            P.S = SB; P.Hin = H; P.U = (const unsigned char*)(ws + WS_UBF) + (size_t)l * NEXP * DM; P.V = (const unsigned char*)(ws + WS_VBF) + (size_t)l * NEXP * DM; P.SU = (const float*)(ws + WS_SU) + (size_t)l * 2 * NEXP; P.SV = (const float*)(ws + WS_SV) + l * NEXP; P.Xin = X; P.Xout = X;
            P.g2l = modl + 5120; P.g2c = modc + 5120;
            P.Hout = SELFCHECK ? H : (bf16_t*)nullptr; P.H8out = ws + WS_H8; P.nwn = in[I_N1W] + DM; P.shl = modv + 2 * 6144; P.scl = P.shl + 1024; P.shc = modv + 3 * 6144; P.scc = P.shc + 1024;
            P.fout = (l == 1) ? args.out : nullptr; P.fnw = in[I_FNW];
            P.nblocks = nMr * 8; P.dbg_eid = nullptr; P.dbg_gt = nullptr;
            PeerBufs B;
#if SELFCHECK
            unsigned char* pb = ws + WS_VBF + 32 * MiB;
            if (l == 0) { P.Xout = (float*)(ws + WS_DBG); P.Hout = YS; }
#else
            unsigned char* pb = ws + WS_YS;
#endif
            B.eid = (int*)pb; B.gt = (float*)(pb + 9 * MiB); B.a = (float*)(pb + 18 * MiB); B.xq = ws + WS_UBF + 32 * MiB; B.sx = (float*)(ws + WS_UBF + 50 * MiB);
            const int ntok = nMr * 256;
            peer_route(F, P, B);
            GRID_BAR();
            peer_u(F, P, B, ntok);
            GRID_BAR();
            peer_v(F, P, B, ntok);
            GRID_BAR();
            peer_norm(F, P, ntok);
        }
#endif
#if SELFCHECK
        break;
#endif
        if (l == 0) GRID_BAR();
    }
#if TIMING
    GRID_BAR(); xcd_barrier(bar);
    {
        const unsigned long long* ts = (const unsigned long long*)(F.ctl + 1024);
        float iv[10];
#pragma unroll
        for (int i = 0; i < 10; ++i) iv[i] = 0.f;
        iv[0] = (float)(ts[1] - ts[0]); iv[1] = (float)(ts[2] - ts[1]);
#pragma unroll
        for (int l = 0; l < 2; ++l)
#pragma unroll
            for (int p = 0; p < 8; ++p) iv[2 + p] += (float)(ts[3 + l * 8 + p] - ts[2 + l * 8 + p]);
        const float total = (float)(ts[18] - ts[0]);
        const int k1 = (int)(100.f * iv[TIMING_A] / total + 0.5f); int k2 = 10 + (int)(100.f * iv[TIMING_B] / total + 0.5f); k2 = k2 > 99 ? 99 : k2;
        const float cval = sqrtf((float)k1);
        for (size_t i = (size_t)blockIdx.x * NTHREADS + ltid(F.wave); i < (size_t)SEQ * DM / 4; i += (size_t)gridDim.x * NTHREADS) ((f32x4*)args.out)[i] = (f32x4){i == 0 ? 100.f * (float)k2 : cval, cval, cval, cval};
    }
#endif
#if SELFCHECK
    GRID_BAR();
    if (blockIdx.x < 5) { const int b = blockIdx.x; const int r = b == 0 ? 0 : b == 1 ? 31 : b == 2 ? 37 : b == 3 ? 16383 : 16639; chk::ck_peer(0, r, in, ws, F.ctl, CK_RED, CK_BUF, CK_IBUF); }
    GRID_BAR();
    {
        float e[32];
#pragma unroll
        for (int i = 0; i < 32; ++i) e[i] = __uint_as_float(__hip_atomic_load(F.ctl + CW_CHK + i, RLX_AGENT));
        const float T = 0.03f; int mask = 0;
#if SELFCHECK == 1
        mask = ((e[0] > T || e[1] > T) ? 1 : 0) | (e[2] > T ? 2 : 0) | (e[3] > T ? 4 : 0) | (e[4] > T ? 8 : 0) | (e[5] > T ? 16 : 0);
#elif SELFCHECK == 2
        mask = (e[6] > T ? 1 : 0) | (e[7] > T ? 2 : 0) | (e[8] > T ? 4 : 0) | (e[9] > T ? 8 : 0) | ((e[10] > T || e[11] > T) ? 16 : 0);
#elif SELFCHECK == 5
        mask = (e[24] > T ? 1 : 0) | (e[25] > T ? 2 : 0) | (e[26] > T ? 4 : 0) | (e[27] > T ? 8 : 0) | (e[28] > T ? 16 : 0);
#elif SELFCHECK == 4
        mask = (e[10] > T ? 1 : 0) | (e[11] > T ? 2 : 0) | (e[12] > T ? 4 : 0) | (e[13] > T ? 8 : 0);
#else
        mask = (e[16] > T ? 1 : 0) | (e[17] > T ? 2 : 0) | (e[18] > T ? 4 : 0) | (e[19] > T ? 8 : 0) | ((e[20] > T || e[21] > T || e[22] > T || e[23] > T) ? 16 : 0);
#endif
        const float cval = sqrtf((float)mask);
        for (size_t i = (size_t)blockIdx.x * NTHREADS + ltid(F.wave); i < (size_t)SEQ * DM / 4; i += (size_t)gridDim.x * NTHREADS) ((f32x4*)args.out)[i] = (f32x4){cval, cval, cval, cval};
    }
#endif
}
#ifndef DUP_MASK
#define DUP_MASK 0
#endif
extern "C" void kernel_launch(void* const* d_in, const int* in_sizes, int n_in, void* d_out, int out_size, void* d_ws, size_t ws_size, hipStream_t stream) {
    static int grid = 0;
    if (grid == 0) {
        size_t need = WS_END;
#if SELFCHECK
        need = WS_DBG + (size_t)MT * DM * 4;
#endif
        if (n_in != 23 || in_sizes[0] != SEQ * DM || out_size != SEQ * DM || ws_size < need) {
            fprintf(stderr, "kernel_launch: unexpected problem shape (n_in %d, in0 %d, out %d, ws %zu, need %zu); nothing launched\n", n_in, n_in > 0 ? in_sizes[0] : -1, out_size, ws_size, need); grid = -1; return; }
        int dev = 0, cus = 0, per_cu = 0;
        if (hipGetDevice(&dev) != hipSuccess || hipDeviceGetAttribute(&cus, hipDeviceAttributeMultiprocessorCount, dev) != hipSuccess) { fprintf(stderr, "kernel_launch: device query failed\n"); grid = -1; return; }
        if (hipFuncSetAttribute((const void*)trunk_fwd, hipFuncAttributeMaxDynamicSharedMemorySize, LDS_BYTES) != hipSuccess) { fprintf(stderr, "kernel_launch: hipFuncSetAttribute failed\n"); grid = -1; return; }
        if (hipOccupancyMaxActiveBlocksPerMultiprocessor(&per_cu, (const void*)trunk_fwd, NTHREADS, LDS_BYTES) != hipSuccess || per_cu < 1) {
            fprintf(stderr, "kernel_launch: occupancy query says %d blocks per CU; nothing launched\n", per_cu); (void)hipGetLastError(); grid = -1; return; }
        grid = cus;
    }
    if (grid < 0) return;
    (void)hipMemsetAsync((char*)d_ws + WS_CTL, 0, CTL_ZERO_BYTES, stream);
    Args a{};
    for (int i = 0; i < 23; ++i) a.in[i] = (const float*)d_in[i];
    a.out = (float*)d_out; a.ws = (unsigned char*)d_ws; a.flags = DUP_MASK; a.pad = 0;
    void* kargs[] = {&a};
    const hipError_t e = hipLaunchCooperativeKernel((const void*)trunk_fwd, dim3(grid), dim3(NTHREADS), kargs, LDS_BYTES, stream);
    if (e != hipSuccess) fprintf(stderr, "kernel_launch: cooperative launch failed: %s (grid %d)\n", hipGetErrorString(e), grid);
}
```
